# Optimizing an MI355X kernel written in HIP

```python
import math
import jax, jax.numpy as jnp
from jax import lax
import numpy as np

D_MODEL = 1024
BATCH = 8
SEQ = 4096
DEPTH = 1

GRID_W = 64
CTX_LEN = 256
DA_HEADS = 4
DA_QK_DIM = 64
DA_V_DIM = 2 * DA_QK_DIM
DA_WIDTH = DA_HEADS * DA_V_DIM
Q_BLOCK = 128
ROPE_THETA = 10000.0
ROPE_FREQS = DA_QK_DIM // 4
HY_WIDTH = D_MODEL // 2
HY_EMB_DIM = 33
HY_BANDS = (HY_EMB_DIM - 1) // 2
HY_FILTER_WIDTH = 64
HY_DECAY_TARGET = 1e-2
HY_FAST_DECAY = 0.3
HY_SLOW_DECAY = 1.5
N_EXPERTS = 32
TOP_K = 4
D_FF_EXPERT = D_MODEL
SWIGLU_LIMIT = 7.0
SWIGLU_ALPHA = 1.702
EXPERT_BLOCK = 256
EPS = 1e-6
Q_COLS = DA_HEADS * 2 * DA_QK_DIM
K_COLS = DA_HEADS * 2 * DA_QK_DIM
V_COLS = DA_WIDTH
HY_COLS = 3 * HY_WIDTH
GATE_COLS = 2 * D_MODEL
IN_COLS = Q_COLS + K_COLS + V_COLS + HY_COLS + GATE_COLS
IN_SPLITS = (Q_COLS, Q_COLS + K_COLS, Q_COLS + K_COLS + V_COLS, Q_COLS + K_COLS + V_COLS + HY_COLS)

kernel_name = "hybrid_diffattn_hyena_moe_dit_block"


def rms_norm(x, g):
    xf = x.astype(jnp.float32)
    y = xf * lax.rsqrt(jnp.mean(xf * xf, axis=-1, keepdims=True) + EPS)
    return (y * g.astype(jnp.float32)).astype(x.dtype)


def modulate(x, g, shift, scale):
    return rms_norm(x, g) * (1 + scale) + shift


def axial_rope_tables(rows):
    row = jnp.repeat(jnp.arange(rows), GRID_W)
    col = jnp.tile(jnp.arange(GRID_W), rows)
    pos = jnp.stack([row, col], axis=-1).astype(jnp.float32)
    freqs = ROPE_THETA ** (-jnp.arange(ROPE_FREQS, dtype=jnp.float32) / ROPE_FREQS)
    ang = pos[:, :, None] * freqs
    return jnp.cos(ang), jnp.sin(ang)


def rope_2d(x, cos, sin):
    xr = x.reshape(*x.shape[:-1], 2, 2, ROPE_FREQS)
    x1, x2 = xr[..., 0, :], xr[..., 1, :]
    c = cos[None, :, None, None]
    s = sin[None, :, None, None]
    out = jnp.stack([x1 * c - x2 * s, x2 * c + x1 * s], axis=-2)
    return out.reshape(x.shape).astype(x.dtype)


def split_proj(p):
    b, L = p.shape[:2]
    q, k, v, hy, gates = jnp.split(p, IN_SPLITS, axis=-1)
    return (q.reshape(b, L, DA_HEADS, 2, DA_QK_DIM),
            k.reshape(b, L, DA_HEADS, 2, DA_QK_DIM),
            v.reshape(b, L, DA_HEADS, DA_V_DIM),
            hy, gates)


def diff_attention(q, k, v, lam):
    b, sq, h, m, dh = q.shape
    nb = sq // Q_BLOCK
    qb = jnp.moveaxis(q.reshape(b, nb, Q_BLOCK, h, m, dh), 1, 0)
    scale = DA_QK_DIM ** -0.5

    def one_block(qblk):
        s = jnp.einsum("bqhmd,bkhmd->bhmqk", qblk, k).astype(jnp.float32) * scale
        p = jax.nn.softmax(s, axis=-1)
        p = p[:, :, 0] - lam * p[:, :, 1]
        return jnp.einsum("bhqk,bkhe->bqhe", p.astype(v.dtype), v)

    o = lax.map(one_block, qb)
    return jnp.moveaxis(o, 0, 1).reshape(b, sq, h, v.shape[-1])


def diff_out(o, subln_g, lambda_init):
    b, L = o.shape[:2]
    return (rms_norm(o, subln_g) * (1.0 - lambda_init)).reshape(b, L, DA_WIDTH)


def short_conv3(u, w, bias):
    up = jnp.pad(u, ((0, 0), (1, 1), (0, 0)))
    return up[:, :-2] * w[0] + up[:, 1:-1] * w[1] + up[:, 2:] * w[2] + bias


def implicit_filter(L, w1, b1, w2, b2, w3, b3, w4, freq):
    t = jnp.linspace(0.0, 1.0, L, dtype=jnp.float32)[:, None]
    w = 2.0 * math.pi * jnp.arange(L, dtype=jnp.float32)[:, None] / L
    f = jnp.linspace(1e-4, HY_BANDS - 1, HY_BANDS, dtype=jnp.float32)
    z = jnp.concatenate([t, jnp.cos(f * w), -jnp.sin(f * w)], axis=-1)
    freq = freq.astype(jnp.float32)
    hdn = jnp.sin(freq * (z @ w1 + b1))
    hdn = jnp.sin(freq * (hdn @ w2 + b2))
    hdn = jnp.sin(freq * (hdn @ w3 + b3))
    k = (hdn @ w4).astype(jnp.float32).reshape(L, 2, HY_WIDTH)
    deltas = jnp.abs(jnp.linspace(math.log(HY_DECAY_TARGET) / HY_SLOW_DECAY,
                                  math.log(HY_DECAY_TARGET) / HY_FAST_DECAY,
                                  HY_WIDTH, dtype=jnp.float32))
    decay = jnp.exp(-t * deltas)
    return k * decay[:, None, :]


def long_conv_bidir(u, k_fwd, k_bwd, bias):
    L, W = k_fwd.shape
    k_full = jnp.concatenate([k_fwd, jnp.zeros((1, W), jnp.float32), k_bwd[:0:-1]], axis=0)
    kf = jnp.fft.rfft(k_full, n=2 * L, axis=0)
    uf = jnp.fft.rfft(u.astype(jnp.float32), n=2 * L, axis=1)
    y = jnp.fft.irfft(uf * kf[None], n=2 * L, axis=1)[:, :L]
    return (y + u.astype(jnp.float32) * bias.astype(jnp.float32)).astype(u.dtype)


def hyena_branch(hy, conv_w, conv_b, fw1, fb1, fw2, fb2, fw3, fb3, fw4, ffreq, hbias):
    L = hy.shape[1]
    z = short_conv3(hy, conv_w, conv_b)
    x0, x1, v = jnp.split(z, 3, axis=-1)
    k = implicit_filter(L, fw1, fb1, fw2, fb2, fw3, fb3, fw4, ffreq)
    return x0 * long_conv_bidir(x1 * v, k[:, 0], k[:, 1], hbias)


def merge_branches(oa, ob, gates, w_up_a, w_up_b, w_out):
    ga, gb = jnp.split(jax.nn.sigmoid(gates), 2, axis=-1)
    return (ga * (oa @ w_up_a) + gb * (ob @ w_up_b)) @ w_out


def moe_ffn(h, router_w, router_b, w1, b1, w2, b2):
    b, L, d = h.shape
    xt = h.reshape(-1, d)
    T = xt.shape[0]
    logits = (xt @ router_w + router_b).astype(jnp.float32)
    top_v, top_i = lax.top_k(logits, TOP_K)
    wts = jax.nn.softmax(top_v, axis=-1)
    A = T * TOP_K
    e_flat = top_i.reshape(-1)
    tok_flat = jnp.arange(A, dtype=jnp.int32) // TOP_K
    w_flat = wts.reshape(-1)
    order = jnp.argsort(e_flat)
    e_s, tok_s, w_s = e_flat[order], tok_flat[order], w_flat[order]
    counts = jnp.bincount(e_flat, length=N_EXPERTS)
    padded = (counts + EXPERT_BLOCK - 1) // EXPERT_BLOCK * EXPERT_BLOCK
    pend = jnp.cumsum(padded)
    pstart = pend - padded
    start = jnp.cumsum(counts) - counts
    dest = pstart[e_s] + jnp.arange(A, dtype=jnp.int32) - start[e_s]
    n_rows = A + N_EXPERTS * EXPERT_BLOCK
    n_blocks = n_rows // EXPERT_BLOCK
    row_tok = jnp.full((n_rows,), T, jnp.int32).at[dest].set(tok_s)
    row_w = jnp.zeros((n_rows,), jnp.float32).at[dest].set(w_s)
    block_e = jnp.minimum(jnp.searchsorted(pend, jnp.arange(n_blocks) * EXPERT_BLOCK, side="right"),
                          N_EXPERTS - 1)
    x_pad = jnp.concatenate([xt, jnp.zeros((1, d), xt.dtype)], axis=0)
    xb = x_pad[row_tok].reshape(n_blocks, EXPERT_BLOCK, d)

    def expert_block(args):
        xblk, e = args
        gu = xblk @ w1[e] + b1[e]
        gate, up = jnp.split(gu, 2, axis=-1)
        gate = jnp.minimum(gate, SWIGLU_LIMIT)
        up = jnp.clip(up, -SWIGLU_LIMIT, SWIGLU_LIMIT)
        act = (up + 1) * gate * jax.nn.sigmoid(SWIGLU_ALPHA * gate)
        return act @ w2[e] + b2[e]

    yb = lax.map(expert_block, (xb, block_e)).reshape(n_rows, d)
    y = jnp.zeros((T + 1, d), jnp.float32).at[row_tok].add(yb.astype(jnp.float32) * row_w[:, None])
    return y[:T].reshape(b, L, d).astype(h.dtype)


def setup_inputs(seed: int = 0) -> dict:
    key = jax.random.key(seed)
    ks = iter(jax.random.split(key, 40))

    def nrm(shape, std):
        return std * jax.random.normal(next(ks), shape, jnp.float32)

    L, D, F = DEPTH, D_MODEL, D_FF_EXPERT
    return {
        "x": nrm((BATCH, SEQ, D), 1.0),
        "c": nrm((BATCH, D), 1.0),
        "ctx": nrm((BATCH, CTX_LEN, D), 1.0),
        "c_ctx": nrm((D,), 1.0),
        "ada_w": nrm((L, D, 6 * D), 0.5 * D ** -0.5),
        "ada_b": nrm((L, 6 * D), 0.02),
        "norm1_g": 1.0 + nrm((L, D), 0.05),
        "norm2_g": 1.0 + nrm((L, D), 0.05),
        "w_in": nrm((L, D, IN_COLS), D ** -0.5),
        "b_in": nrm((L, IN_COLS), 0.02),
        "q_norm_g": 1.0 + nrm((L, DA_QK_DIM), 0.05),
        "k_norm_g": 1.0 + nrm((L, DA_QK_DIM), 0.05),
        "lambda_q1": nrm((L, DA_QK_DIM), 0.1),
        "lambda_k1": nrm((L, DA_QK_DIM), 0.1),
        "lambda_q2": nrm((L, DA_QK_DIM), 0.1),
        "lambda_k2": nrm((L, DA_QK_DIM), 0.1),
        "subln_g": 1.0 + nrm((L, DA_V_DIM), 0.05),
        "conv_w": nrm((L, 3, HY_COLS), 3 ** -0.5),
        "conv_b": nrm((L, HY_COLS), 0.02),
        "filt_w1": nrm((L, HY_EMB_DIM, HY_FILTER_WIDTH), HY_EMB_DIM ** -0.5),
        "filt_b1": nrm((L, HY_FILTER_WIDTH), 0.1),
        "filt_w2": nrm((L, HY_FILTER_WIDTH, HY_FILTER_WIDTH), HY_FILTER_WIDTH ** -0.5),
        "filt_b2": nrm((L, HY_FILTER_WIDTH), 0.1),
        "filt_w3": nrm((L, HY_FILTER_WIDTH, HY_FILTER_WIDTH), HY_FILTER_WIDTH ** -0.5),
        "filt_b3": nrm((L, HY_FILTER_WIDTH), 0.1),
        "filt_w4": nrm((L, HY_FILTER_WIDTH, 2 * HY_WIDTH), 0.1 * HY_FILTER_WIDTH ** -0.5),
        "filt_freq": 1.0 + nrm((L, HY_FILTER_WIDTH), 0.05),
        "hyena_bias": nrm((L, HY_WIDTH), 0.1),
        "w_up_a": nrm((L, DA_WIDTH, D), DA_WIDTH ** -0.5),
        "w_up_b": nrm((L, HY_WIDTH, D), HY_WIDTH ** -0.5),
        "w_out": nrm((L, D, D), D ** -0.5),
        "router_w": nrm((L, D, N_EXPERTS), D ** -0.5),
        "router_b": nrm((L, N_EXPERTS), 0.01),
        "exp_w1": nrm((L, N_EXPERTS, D, 2 * F), D ** -0.5),
        "exp_b1": nrm((L, N_EXPERTS, 2 * F), 0.02),
        "exp_w2": nrm((L, N_EXPERTS, F, D), F ** -0.5),
        "exp_b2": nrm((L, N_EXPERTS, D), 0.02),
    }


def reference(x, c, ctx, c_ctx, ada_w, ada_b, norm1_g, norm2_g, w_in, b_in, q_norm_g, k_norm_g,
              lambda_q1, lambda_k1, lambda_q2, lambda_k2, subln_g, conv_w, conv_b,
              filt_w1, filt_b1, filt_w2, filt_b2, filt_w3, filt_b3, filt_w4, filt_freq, hyena_bias,
              w_up_a, w_up_b, w_out, router_w, router_b, exp_w1, exp_b1, exp_w2, exp_b2):
    ROWS = x.shape[1] // GRID_W
    cos, sin = axial_rope_tables(ROWS)
    xc = ctx
    for l in range(DEPTH):
        lambda_init = 0.8 - 0.6 * math.exp(-0.3 * l)
        lam = (jnp.exp(jnp.sum(lambda_q1[l].astype(jnp.float32) * lambda_k1[l].astype(jnp.float32)))
               - jnp.exp(jnp.sum(lambda_q2[l].astype(jnp.float32) * lambda_k2[l].astype(jnp.float32)))
               + lambda_init)
        sh1, sc1, g1, sh2, sc2, g2 = [m[:, None, :] for m in
                                      jnp.split(jax.nn.silu(c) @ ada_w[l] + ada_b[l], 6, axis=-1)]
        sh1c, sc1c, g1c, sh2c, sc2c, g2c = jnp.split(jax.nn.silu(c_ctx) @ ada_w[l] + ada_b[l], 6, axis=-1)
        hy_params = (conv_w[l], conv_b[l], filt_w1[l], filt_b1[l], filt_w2[l], filt_b2[l],
                     filt_w3[l], filt_b3[l], filt_w4[l], filt_freq[l], hyena_bias[l])
        merge_params = (w_up_a[l], w_up_b[l], w_out[l])
        moe_params = (router_w[l], router_b[l], exp_w1[l], exp_b1[l], exp_w2[l], exp_b2[l])

        px = modulate(x, norm1_g[l], sh1, sc1) @ w_in[l] + b_in[l]
        pc = modulate(xc, norm1_g[l], sh1c, sc1c) @ w_in[l] + b_in[l]
        qx, kx, vx, hyx, gx = split_proj(px)
        qc, kc, vc, hyc, gc = split_proj(pc)
        qx = rope_2d(rms_norm(qx, q_norm_g[l]), cos, sin)
        kx = rope_2d(rms_norm(kx, k_norm_g[l]), cos, sin)
        qc = rms_norm(qc, q_norm_g[l])
        kc = rms_norm(kc, k_norm_g[l])
        k_all = jnp.concatenate([kc, kx], axis=1)
        v_all = jnp.concatenate([vc, vx], axis=1)
        oa = diff_out(diff_attention(qx, k_all, v_all, lam), subln_g[l], lambda_init)
        ob = hyena_branch(hyx, *hy_params)
        x_new = x + g1 * merge_branches(oa, ob, gx, *merge_params)
        x_new = x_new + g2 * moe_ffn(modulate(x_new, norm2_g[l], sh2, sc2), *moe_params)

        if l < DEPTH - 1:
            oac = diff_out(diff_attention(qc, kc, vc, lam), subln_g[l], lambda_init)
            obc = hyena_branch(hyc, *hy_params)
            xc = xc + g1c * merge_branches(oac, obc, gc, *merge_params)
            xc = xc + g2c * moe_ffn(modulate(xc, norm2_g[l], sh2c, sc2c), *moe_params)
        x = x_new
    return x
```

```cpp
#include <hip/hip_runtime.h>
#include <hip/hip_bf16.h>
#include <hip/hip_cooperative_groups.h>
#include <cstdio>
#include <cstdint>
#include <cmath>
namespace pg8 {
#define PG8_LAS __attribute__((address_space(3)))
typedef unsigned short bf16_t;
typedef short bf16x8 __attribute__((ext_vector_type(8)));
typedef float f32x4 __attribute__((ext_vector_type(4)));
typedef unsigned u32x4 __attribute__((ext_vector_type(4)));
constexpr int BM = 256, BK = 64, HALF = 128, HTB = HALF * BK * 2  , STAGE_BYTES = 8 * HTB, NXCD = 8, WGM = 8;

__host__ __device__ __forceinline__ int lds_byte(int r, int c) { const int st = (r >> 4) * 2 + (c >> 5), rr = r & 15, cc = c & 31, ob = rr * 64 + cc * 2; return st * 1024 + (ob ^ (((ob >> 9) & 1) << 5)); }
__host__ __device__ __forceinline__ void stage_rc(int b, int& R, int& C) { const int st = b / 1024, sb = b % 1024, swz = sb ^ (((sb >> 9) & 1) << 5); R = (st >> 1) * 16 + swz / 64; C = (st & 1) * 32 + (swz % 64) / 2; }
__host__ __device__ __forceinline__ int perm32(int rho) { const int n = rho >> 4, i = rho & 15; return 8 * (i >> 2) + 4 * n + (i & 3); }

struct Unit { int pm, pn, be; };
struct Gemm { const bf16_t* A; const bf16_t* Bt; int M, N, K; size_t bstride; };

struct StaticOrder {
    int nM, nN, nwg, G, c;
    __host__ __device__ void init(int M, int N, int G_, int c_) { nM = M / BM; nN = N / BM; nwg = nM * nN; G = G_; c = c_; }
    __host__ __device__ bool next(int i, Unit& u) const {
        const long L = (long)i * G + c; if (L >= nwg) return false;
        int wgid = (int)L; { const int q = nwg / NXCD, r = nwg % NXCD, xcd = wgid % NXCD, off = wgid / NXCD; wgid = (xcd < r ? xcd * (q + 1) : r * (q + 1) + (xcd - r) * q) + off; }
        const int nig = WGM * nN, gid = wgid / nig, fm = gid * WGM, gsz = (nM - fm) < WGM ? (nM - fm) : WGM;
        u.pm = fm + ((wgid % nig) % gsz); u.pn = (wgid % nig) / gsz; u.be = 0; return true;
    }
    __device__ __forceinline__ void a_ready(const Unit&) const {}
    __device__ __forceinline__ void done(const Unit&) const {}
};

__device__ __forceinline__ unsigned cvt_pk_bf16(float lo, float hi) { unsigned r; asm volatile("v_cvt_pk_bf16_f32 %0, %1, %2" : "=v"(r) : "v"(lo), "v"(hi)); return r; }
typedef float f32x2 __attribute__((ext_vector_type(2)));
__device__ __forceinline__ f32x2 gelu_pk(f32x2 v) {
    const f32x2 av = __builtin_elementwise_abs(v), d = av * 0.2316418882f + 1.0f;
    f32x2 t; t.x = __builtin_amdgcn_rcpf(d.x); t.y = __builtin_amdgcn_rcpf(d.y);
    f32x2 q = t * 0.5307027145f + (-0.7265760135f); q = q * t + 0.7107068705f; q = q * t + (-0.142248368f); q = q * t + 0.127414796f; q = q * t;
    const f32x2 s = (v * v) * (-0.72134752044f);
    f32x2 e; e.x = __builtin_amdgcn_exp2f(s.x); e.y = __builtin_amdgcn_exp2f(s.y);
    const f32x2 m = v * (q * e), r = v - m;
    f32x2 o; o.x = v.x < 0.f ? m.x : r.x; o.y = v.y < 0.f ? m.y : r.y; return o;
}

template <int ACT  > struct EpiBf16 {
    static constexpr bool PERM = true, AFTER_DRAIN = false; static_assert(ACT == 0 || ACT == 1, "EpiBf16: ACT is 0 (none) or 1 (gelu_pk)");
    bf16_t* O; int ldc; const float* bias; int split_cols; size_t split_stride; float scale0;
    __device__ __forceinline__ void operator()(const f32x4 (&acc)[2][2][4][2], const Unit& u, int wr, int wc, int fr, int fq) const {
        const int row0 = u.pm * BM + wr * 64 + fr; int colt = u.pn * BM; bf16_t* base = O;
        float sc = 1.f; if (split_cols) { const int t = colt / split_cols; base += (size_t)t * split_stride; colt -= t * split_cols; if (t == 0) sc = scale0; }
        const int col0 = colt + wc * 32 + 8 * fq, bcol0 = u.pn * BM + wc * 32 + 8 * fq;
        f32x4 bv[2][2];
#pragma unroll
        for (int bj = 0; bj < 2; ++bj)
#pragma unroll
            for (int n = 0; n < 2; ++n) bv[bj][n] = bias ? *(const f32x4*)(bias + bcol0 + bj * HALF + 4 * n) : (f32x4){0.f, 0.f, 0.f, 0.f};
#pragma unroll
        for (int ai = 0; ai < 2; ++ai)
#pragma unroll
            for (int m = 0; m < 4; ++m) { bf16_t* rowp = base + (size_t)(row0 + ai * HALF + m * 16) * ldc + col0;
#pragma unroll
                for (int bj = 0; bj < 2; ++bj) { f32x4 v0 = acc[ai][bj][m][0] + bv[bj][0], v1 = acc[ai][bj][m][1] + bv[bj][1];
                    if (ACT == 1) { f32x2 a = gelu_pk((f32x2){v0[0], v0[1]}), b = gelu_pk((f32x2){v0[2], v0[3]}), c = gelu_pk((f32x2){v1[0], v1[1]}), d = gelu_pk((f32x2){v1[2], v1[3]});
                        v0 = (f32x4){a.x, a.y, b.x, b.y}; v1 = (f32x4){c.x, c.y, d.x, d.y}; }
                    v0 = v0 * sc; v1 = v1 * sc; u32x4 w; w.x = cvt_pk_bf16(v0[0], v0[1]); w.y = cvt_pk_bf16(v0[2], v0[3]); w.z = cvt_pk_bf16(v1[0], v1[1]); w.w = cvt_pk_bf16(v1[2], v1[3]);
                    *(u32x4*)(rowp + bj * HALF) = w; } }
    }
};
struct EpiF32 {
    static constexpr bool PERM = false, AFTER_DRAIN = false;
    float* C; int ldc; const float* bias;
    __device__ __forceinline__ void operator()(const f32x4 (&acc)[2][2][4][2], const Unit& u, int wr, int wc, int fr, int fq) const {
        const int row0 = u.pm * BM + wr * 64 + fr, col0 = u.pn * BM + wc * 32 + 4 * fq;
        f32x4 bv[2][2];
#pragma unroll
        for (int bj = 0; bj < 2; ++bj)
#pragma unroll
            for (int n = 0; n < 2; ++n) bv[bj][n] = bias ? *(const f32x4*)(bias + col0 + bj * HALF + n * 16) : (f32x4){0.f, 0.f, 0.f, 0.f};
#pragma unroll
        for (int ai = 0; ai < 2; ++ai)
#pragma unroll
            for (int m = 0; m < 4; ++m) { float* rowp = C + (size_t)(row0 + ai * HALF + m * 16) * ldc + col0;
#pragma unroll
                for (int bj = 0; bj < 2; ++bj)
#pragma unroll
                    for (int n = 0; n < 2; ++n) *(f32x4*)(rowp + bj * HALF + n * 16) = acc[ai][bj][m][n] + bv[bj][n]; }
    }
};
struct EpiSwiglu {
    static constexpr bool PERM = true, AFTER_DRAIN = false;
    bf16_t* O; const float* b1;
    __device__ __forceinline__ void operator()(const f32x4 (&acc)[2][2][4][2], const Unit& u, int wr, int wc, int fr, int fq) const {
        const int row0 = u.pm * BM + wr * 64 + fr; const int ch0 = u.pn * HALF + wc * 32 + 8 * fq;
        const float* bb = b1 + (size_t)u.be * 2048 + ch0;
        f32x4 bg[2], bu[2];
#pragma unroll
        for (int n = 0; n < 2; ++n) { bg[n] = *(const f32x4*)(bb + 4 * n); bu[n] = *(const f32x4*)(bb + 1024 + 4 * n); }
#pragma unroll
        for (int ai = 0; ai < 2; ++ai)
#pragma unroll
            for (int m = 0; m < 4; ++m) { bf16_t* rowp = O + (size_t)(row0 + ai * HALF + m * 16) * 1024 + ch0;
                f32x4 a[2];
#pragma unroll
                for (int n = 0; n < 2; ++n) { const f32x4 g = acc[ai][0][m][n] + bg[n], up = acc[ai][1][m][n] + bu[n];
#pragma unroll
                    for (int e = 0; e < 4; ++e) { const float gg = fminf(g[e], 7.0f), uu = fminf(fmaxf(up[e], -7.0f), 7.0f);
                        const float sg = __builtin_amdgcn_rcpf(1.0f + __builtin_amdgcn_exp2f(-1.702f * 1.4426950408889634f * gg));
                        a[n][e] = (uu + 1.0f) * gg * sg; } }
                u32x4 w; w.x = cvt_pk_bf16(a[0][0], a[0][1]); w.y = cvt_pk_bf16(a[0][2], a[0][3]); w.z = cvt_pk_bf16(a[1][0], a[1][1]); w.w = cvt_pk_bf16(a[1][2], a[1][3]);
                *(u32x4*)rowp = w; }
    }
};
struct EpiY {
    static constexpr bool PERM = true, AFTER_DRAIN = false;
    bf16_t* O; const float* b2; const float* roww;
    __device__ __forceinline__ void operator()(const f32x4 (&acc)[2][2][4][2], const Unit& u, int wr, int wc, int fr, int fq) const {
        const int row0 = u.pm * BM + wr * 64 + fr; const int col0 = u.pn * BM + wc * 32 + 8 * fq;
        const float* bb = b2 + (size_t)u.be * 1024 + col0;
        f32x4 bv[2][2];
#pragma unroll
        for (int bj = 0; bj < 2; ++bj)
#pragma unroll
            for (int n = 0; n < 2; ++n) bv[bj][n] = *(const f32x4*)(bb + bj * HALF + 4 * n);
#pragma unroll
        for (int ai = 0; ai < 2; ++ai)
#pragma unroll
            for (int m = 0; m < 4; ++m) { const int row = row0 + ai * HALF + m * 16; const float rw = roww[row]; bf16_t* rowp = O + (size_t)row * 1024 + col0;
#pragma unroll
                for (int bj = 0; bj < 2; ++bj) { const f32x4 v0 = (acc[ai][bj][m][0] + bv[bj][0]) * rw, v1 = (acc[ai][bj][m][1] + bv[bj][1]) * rw;
                    u32x4 w; w.x = cvt_pk_bf16(v0[0], v0[1]); w.y = cvt_pk_bf16(v0[2], v0[3]); w.z = cvt_pk_bf16(v1[0], v1[1]); w.w = cvt_pk_bf16(v1[2], v1[3]);
                    *(u32x4*)(rowp + bj * HALF) = w; } }
    }
};
struct MoeOrder {
    StaticOrder so; const int* blke;
    __device__ __forceinline__ bool next(int i, Unit& u) const { if (!so.next(i, u)) return false; u.be = blke[u.pm]; return true; }
    __device__ __forceinline__ void a_ready(const Unit&) const {}
    __device__ __forceinline__ void done(const Unit&) const {}
};
template <class Epi, class Sched, bool ALIGN_EPI = false, bool SP2 = false>
__device__ __forceinline__ void gemm_phase(PG8_LAS unsigned char* lds, const Gemm g, const Sched& S, const Epi& E) {
    const int tid = threadIdx.x, wid = __builtin_amdgcn_readfirstlane(tid >> 6), lane = tid & 63, wr = wid >> 2, wc = wid & 3, fr = lane & 15, fq = lane >> 4;
    const int K = g.K, nt = K / BK;
    unsigned voffA[2], voffB[2];
#pragma unroll
    for (int i = 0; i < 2; ++i) { int R, C; stage_rc(tid * 16 + i * 8192, R, C); const int Rb = Epi::PERM ? ((R & ~31) + perm32(R & 31)) : R;
        voffA[i] = (unsigned)(R * K + C) * 2u; voffB[i] = (unsigned)(Rb * K + C) * 2u; }
    const size_t kstep = (size_t)(BK * 2);
    const size_t hstep = (size_t)HALF * K * 2;
    const size_t tstep = 2 * hstep;
    const unsigned ldsw = (unsigned)wid * 1024u;
    const int aoff = lds_byte(wr * 64 + fr, fq * 8), boff = lds_byte(wc * 32 + fr, fq * 8);
#define PG8_SA(b, h) (((b) * 2 + (h)) * HTB)
#define PG8_SB(b, h) ((4 + (b) * 2 + (h)) * HTB)
#define PG8_STAGE(bufoff, gbase, voff) do { _Pragma("unroll") for (int _i = 0; _i < 2; ++_i) \
        __builtin_amdgcn_global_load_lds((const unsigned*)((const char*)(gbase) + (voff)[_i]), (PG8_LAS unsigned*)(lds + (bufoff) + ldsw + _i * 8192), 16, 0, 0); } while (0)
#define PG8_LDA(dst, b, h) do { _Pragma("unroll") for (int m = 0; m < 4; ++m) _Pragma("unroll") for (int k = 0; k < 2; ++k) dst[m][k] = *(const PG8_LAS bf16x8*)(lds + PG8_SA(b, h) + aoff + m * 2048 + k * 1024); } while (0)
#define PG8_LDB(dst, b, h) do { _Pragma("unroll") for (int n = 0; n < 2; ++n) _Pragma("unroll") for (int k = 0; k < 2; ++k) dst[n][k] = *(const PG8_LAS bf16x8*)(lds + PG8_SB(b, h) + boff + n * 2048 + k * 1024); } while (0)
#define PG8_MMA(ai, bj, At, Bt) do { __builtin_amdgcn_s_setprio(1); _Pragma("unroll") for (int m = 0; m < 4; ++m) _Pragma("unroll") for (int n = 0; n < 2; ++n) _Pragma("unroll") for (int k = 0; k < 2; ++k) \
        acc[ai][bj][m][n] = __builtin_amdgcn_mfma_f32_16x16x32_bf16(Bt[n][k], At[m][k], acc[ai][bj][m][n], 0, 0, 0); __builtin_amdgcn_s_setprio(0); } while (0)
#define PG8_WAIT_V(n) asm volatile("s_waitcnt vmcnt(" #n ")" ::: "memory")
#define PG8_WAIT_L(n) asm volatile("s_waitcnt lgkmcnt(" #n ")" ::: "memory")
#define PG8_BAR __builtin_amdgcn_s_barrier()
#define PG8_SCHED __builtin_amdgcn_sched_barrier(0)
    Unit cur, nxt; int ui = 0;
    if (!S.next(0, cur)) return;
    f32x4 acc[2][2][4][2];
#pragma unroll
    for (int a = 0; a < 2; ++a)
#pragma unroll
        for (int b = 0; b < 2; ++b)
#pragma unroll
            for (int m = 0; m < 4; ++m)
#pragma unroll
                for (int n = 0; n < 2; ++n) acc[a][b][m][n] = (f32x4){0.f, 0.f, 0.f, 0.f};
    bf16x8 At[4][2], B0[2][2], B1[2][2];
    const char* cA = (const char*)g.A + (size_t)cur.pm * tstep; const char* cB = (const char*)g.Bt + (size_t)cur.be * g.bstride + (size_t)cur.pn * tstep;
    S.a_ready(cur);
    if constexpr (SP2) {
        PG8_STAGE(PG8_SB(0, 0), cB, voffB); PG8_STAGE(PG8_SB(0, 1), cB + hstep, voffB); PG8_STAGE(PG8_SA(0, 0), cA, voffA); PG8_STAGE(PG8_SA(0, 1), cA + hstep, voffA);
        if (wr == 1) PG8_BAR;
        PG8_WAIT_V(2); PG8_BAR;
        PG8_STAGE(PG8_SB(1, 0), cB + kstep, voffB); PG8_STAGE(PG8_SA(1, 0), cA + kstep, voffA); PG8_STAGE(PG8_SB(1, 1), cB + hstep + kstep, voffB);
        PG8_WAIT_V(6); PG8_BAR;
    } else {
        PG8_STAGE(PG8_SB(0, 0), cB, voffB); PG8_STAGE(PG8_SA(0, 0), cA, voffA); PG8_STAGE(PG8_SB(0, 1), cB + hstep, voffB); PG8_STAGE(PG8_SA(0, 1), cA + hstep, voffA);
        if (wr == 1) PG8_BAR;
        PG8_WAIT_V(4); PG8_BAR;
        PG8_STAGE(PG8_SB(1, 0), cB + kstep, voffB); PG8_STAGE(PG8_SA(1, 0), cA + kstep, voffA); PG8_STAGE(PG8_SB(1, 1), cB + hstep + kstep, voffB);
        PG8_WAIT_V(6); PG8_BAR;
    }
    for (;;) {
        const bool has_next = S.next(ui + 1, nxt);
        const char* nA = has_next ? (const char*)g.A + (size_t)nxt.pm * tstep : cA; const char* nB = has_next ? (const char*)g.Bt + (size_t)nxt.be * g.bstride + (size_t)nxt.pn * tstep : cB;
        for (int t = 0; t < nt; t += 2) {
            const bool last = (t == nt - 2);
            const char* a1 = cA + (size_t)(t + 1) * kstep;
            const char* a2 = last ? nA : cA + (size_t)(t + 2) * kstep; const char* b2 = last ? nB : cB + (size_t)(t + 2) * kstep;
            const char* a3 = a2 + kstep; const char* b3 = b2 + kstep;
            if (last && has_next) S.a_ready(nxt);
            if constexpr (SP2) {
            PG8_LDB(B0, 0, 0); PG8_LDB(B1, 0, 1); PG8_SCHED; PG8_LDA(At, 0, 0); PG8_STAGE(PG8_SA(1, 1), a1 + hstep, voffA);
            PG8_WAIT_V(8); PG8_WAIT_L(0); PG8_BAR; PG8_MMA(0, 0, At, B0); PG8_MMA(0, 1, At, B1); PG8_BAR; PG8_SCHED;
            PG8_LDA(At, 0, 1); PG8_STAGE(PG8_SB(0, 0), b2, voffB); PG8_STAGE(PG8_SB(0, 1), b2 + hstep, voffB); PG8_STAGE(PG8_SA(0, 0), a2, voffA);
            PG8_WAIT_V(8); PG8_WAIT_L(0); PG8_BAR; PG8_MMA(1, 0, At, B0); PG8_MMA(1, 1, At, B1); PG8_BAR; PG8_SCHED;
            PG8_LDB(B0, 1, 0); PG8_LDB(B1, 1, 1); PG8_SCHED; PG8_LDA(At, 1, 0); PG8_STAGE(PG8_SA(0, 1), a2 + hstep, voffA);
            PG8_WAIT_V(8); PG8_WAIT_L(0); PG8_BAR; PG8_MMA(0, 0, At, B0); PG8_MMA(0, 1, At, B1); PG8_BAR; PG8_SCHED;
            PG8_LDA(At, 1, 1); PG8_STAGE(PG8_SB(1, 0), b3, voffB); PG8_STAGE(PG8_SB(1, 1), b3 + hstep, voffB); PG8_STAGE(PG8_SA(1, 0), a3, voffA);
            PG8_WAIT_V(8); PG8_WAIT_L(0); PG8_BAR; PG8_MMA(1, 0, At, B0); PG8_MMA(1, 1, At, B1); PG8_BAR; PG8_SCHED;
            } else {
            PG8_LDB(B0, 0, 0); PG8_SCHED; PG8_LDA(At, 0, 0); PG8_STAGE(PG8_SA(1, 1), a1 + hstep, voffA);
            PG8_WAIT_L(8); PG8_BAR; PG8_WAIT_L(0); PG8_MMA(0, 0, At, B0); PG8_BAR; PG8_SCHED;
            PG8_LDB(B1, 0, 1); PG8_STAGE(PG8_SB(0, 0), b2, voffB);
            PG8_BAR; PG8_WAIT_L(0); PG8_MMA(0, 1, At, B1); PG8_BAR;
            PG8_LDA(At, 0, 1); PG8_STAGE(PG8_SA(0, 0), a2, voffA);
            PG8_BAR; PG8_WAIT_L(0); PG8_MMA(1, 0, At, B0); PG8_BAR; PG8_SCHED;
            PG8_STAGE(PG8_SB(0, 1), b2 + hstep, voffB);
            PG8_WAIT_V(6); PG8_BAR; PG8_MMA(1, 1, At, B1); PG8_BAR;
            PG8_LDB(B0, 1, 0); PG8_SCHED; PG8_LDA(At, 1, 0); PG8_STAGE(PG8_SA(0, 1), a2 + hstep, voffA);
            PG8_WAIT_L(8); PG8_BAR; PG8_WAIT_L(0); PG8_MMA(0, 0, At, B0); PG8_BAR; PG8_SCHED;
            PG8_LDB(B1, 1, 1); PG8_STAGE(PG8_SB(1, 0), b3, voffB);
            PG8_BAR; PG8_WAIT_L(0); PG8_MMA(0, 1, At, B1); PG8_BAR;
            PG8_LDA(At, 1, 1); PG8_STAGE(PG8_SA(1, 0), a3, voffA);
            PG8_BAR; PG8_WAIT_L(0); PG8_MMA(1, 0, At, B0); PG8_BAR; PG8_SCHED;
            PG8_STAGE(PG8_SB(1, 1), b3 + hstep, voffB);
            PG8_WAIT_V(6); PG8_BAR; PG8_MMA(1, 1, At, B1); PG8_BAR;
            }
        }
        if constexpr (ALIGN_EPI) { if (wr == 0) PG8_BAR; }
        if constexpr (!Epi::AFTER_DRAIN) { E(acc, cur, wr, wc, fr, fq); S.done(cur); }
        if (!has_next) break;
#pragma unroll
        for (int a = 0; a < 2; ++a)
#pragma unroll
            for (int b = 0; b < 2; ++b)
#pragma unroll
                for (int m = 0; m < 4; ++m)
#pragma unroll
                    for (int n = 0; n < 2; ++n) acc[a][b][m][n] = (f32x4){0.f, 0.f, 0.f, 0.f};
        cur = nxt; cA = nA; cB = nB; ++ui;
        if constexpr (ALIGN_EPI) { if (wr == 1) PG8_BAR; }
    }
    PG8_WAIT_V(0);
    if constexpr (!ALIGN_EPI) { if (wr == 0) PG8_BAR; }
    PG8_BAR;
    if constexpr (Epi::AFTER_DRAIN) { E.fused(acc, cur, wr, wc, fr, fq, lds, wid, lane); S.done(cur); }
#undef PG8_SA
#undef PG8_SB
#undef PG8_STAGE
#undef PG8_LDA
#undef PG8_LDB
#undef PG8_MMA
#undef PG8_WAIT_V
#undef PG8_WAIT_L
#undef PG8_BAR
#undef PG8_SCHED
}
}
namespace att {
using bf16 = __hip_bfloat16;
constexpr int   D = 128, NW = 8, QBLK = 32, KVBLK = 64;
constexpr float SCALE = 0.125f;
constexpr float THR = 8.f;
constexpr int SDEPTH = 2;
constexpr int LDQ = 8 * D, LDK = 4 * D, LDO = LDQ;
constexpr size_t SHM_V = KVBLK * D * 2, SHM_K = KVBLK * D * 2, SHM_ATTN = 2 * SHM_V + 2 * SHM_K + NW * 64 * 4;
using bf16x8 = __attribute__((ext_vector_type(8))) short;
using s16x4  = __attribute__((ext_vector_type(4))) short;
using f32x16 = __attribute__((ext_vector_type(16))) float;
using f32x8  = __attribute__((ext_vector_type(8))) float;
using u32x4  = __attribute__((ext_vector_type(4))) unsigned;
#define KSWZ(row, colB) ((row) * 256 + ((colB) ^ (((row) & 7) << 4)))
#define SBAR() __builtin_amdgcn_sched_barrier(0)
__device__ __forceinline__ int crow(int r, int hi) { return (r & 3) + 8 * (r >> 2) + 4 * hi; }
__device__ __forceinline__ unsigned cvtpk(float lo, float hi) {
  unsigned r; asm volatile("v_cvt_pk_bf16_f32 %0, %1, %2" : "=v"(r) : "v"(lo), "v"(hi)); return r;
}
template <typename TIn> struct Stage;
template <> struct Stage<bf16>  { using T = bf16x8;
  __device__ static __forceinline__ T ld8(const bf16* p) { return *reinterpret_cast<const bf16x8*>(p); }
  __device__ static __forceinline__ bf16x8 tobf(T x) { return x; } };
template <> struct Stage<float> { using T = f32x8;
  __device__ static __forceinline__ T ld8(const float* p) { return *reinterpret_cast<const f32x8*>(p); }
  __device__ static __forceinline__ bf16x8 tobf(T x) {
    u32x4 w = {cvtpk(x[0], x[1]), cvtpk(x[2], x[3]), cvtpk(x[4], x[5]), cvtpk(x[6], x[7])}; return *reinterpret_cast<bf16x8*>(&w); } };

__device__ __forceinline__ void partialSM(f32x16& p0, f32x16& p1, float& m_reg, float& mn, float& alpha) {
  constexpr float C = SCALE * 1.4426950408889634f;
  float pmax = p0[0]; for (int r = 1; r < 16; ++r) pmax = fmaxf(pmax, p0[r]); for (int r = 0; r < 16; ++r) pmax = fmaxf(pmax, p1[r]);
  { auto rr = __builtin_amdgcn_permlane32_swap(__float_as_uint(pmax), __float_as_uint(pmax), false, false);
    pmax = fmaxf(__uint_as_float(rr[0]), __uint_as_float(rr[1])); }
  if (__builtin_expect(__all(pmax - m_reg <= THR / SCALE), 1)) { mn = m_reg; alpha = 1.f; }
  else { mn = fmaxf(m_reg, pmax); alpha = __builtin_amdgcn_exp2f((m_reg - mn) * C); m_reg = mn; }
  float mnC = -mn * C;
  for (int r = 0; r < 16; ++r) p0[r] = fmaf(p0[r], C, mnC); for (int r = 0; r < 16; ++r) p1[r] = fmaf(p1[r], C, mnC);
  for (int r = 0; r < 16; ++r) p0[r] = __builtin_amdgcn_exp2f(p0[r]);
}
__device__ __forceinline__ void finishSM(f32x16& p0, f32x16& p1, float alpha, float& l_reg, bf16x8& pa0, bf16x8& pa1, bf16x8& pa2, bf16x8& pa3) {
  for (int r = 0; r < 16; ++r) p1[r] = __builtin_amdgcn_exp2f(p1[r]);
  float ps = 0; for (int r = 0; r < 16; ++r) ps += p0[r]; for (int r = 0; r < 16; ++r) ps += p1[r];
  { auto rr = __builtin_amdgcn_permlane32_swap(__float_as_uint(ps), __float_as_uint(ps), false, false);
    ps = __uint_as_float(rr[0]) + __uint_as_float(rr[1]); }
  l_reg = l_reg * alpha + ps;
#define PK4(P, BASE, OUT) do { unsigned a0 = cvtpk(P[BASE + 0], P[BASE + 1]), a1 = cvtpk(P[BASE + 2], P[BASE + 3]);   \
    unsigned b0 = cvtpk(P[BASE + 4], P[BASE + 5]), b1 = cvtpk(P[BASE + 6], P[BASE + 7]);                              \
    auto r0 = __builtin_amdgcn_permlane32_swap(a0, b0, false, false); auto r1 = __builtin_amdgcn_permlane32_swap(a1, b1, false, false); \
    u32x4 w = {r0[0], r1[0], r0[1], r1[1]}; OUT = *reinterpret_cast<bf16x8*>(&w); } while (0)
  PK4(p0, 0, pa0); PK4(p0, 8, pa1); PK4(p1, 0, pa2); PK4(p1, 8, pa3);
#undef PK4
}
__device__ __forceinline__ void qkt(f32x16& p0, f32x16& p1, const bf16* Ks, const bf16x8* qr, int r32, int hi) {
  p0 = f32x16{}; p1 = f32x16{};
  for (int d0 = 0; d0 < 8; ++d0) { int cb = (d0 * 16 + hi * 8) * 2;
    bf16x8 b0 = *reinterpret_cast<const bf16x8*>((const char*)Ks + KSWZ(r32, cb));
    bf16x8 b1 = *reinterpret_cast<const bf16x8*>((const char*)Ks + KSWZ(32 + r32, cb));
    p0 = __builtin_amdgcn_mfma_f32_32x32x16_bf16(b0, qr[d0], p0, 0, 0, 0);
    p1 = __builtin_amdgcn_mfma_f32_32x32x16_bf16(b1, qr[d0], p1, 0, 0, 0); }
}
__device__ __forceinline__ int v_st(int k, int c) { const int kk = (k & ~0xC) | ((k & 4) << 1) | ((k & 8) >> 1); return ((kk >> 3) * 4 + (c >> 5)) * 512 + ((kk & 7) * 32 + (c & 31)) * 2; }
__device__ __forceinline__ int v_rd_base(int lane) { return ((lane & 3) << 3) | (((lane >> 2) & 3) << 6) | (((lane >> 4) & 1) << 5) | (((lane >> 5) & 1) << 8); }
constexpr int v_rd_off(int d0, int ks, int half) { return d0 * 512 + ks * 4096 + half * 2048; }
template <int OFF> __device__ __forceinline__ s16x4 tr_read(int vb) {
  s16x4 r; asm volatile("ds_read_b64_tr_b16 %0, %1 offset:%2" : "=&v"(r) : "v"(vb), "i"(OFF) : "memory"); return r;
}
template <int D0> __device__ __forceinline__ void pv_one(f32x16& od, int vb, bf16x8 pa0, bf16x8 pa1, bf16x8 pa2, bf16x8 pa3) {
  const s16x4 l0 = tr_read<v_rd_off(D0, 0, 0)>(vb), h0 = tr_read<v_rd_off(D0, 0, 1)>(vb), l1 = tr_read<v_rd_off(D0, 1, 0)>(vb), h1 = tr_read<v_rd_off(D0, 1, 1)>(vb);
  const s16x4 l2 = tr_read<v_rd_off(D0, 2, 0)>(vb), h2 = tr_read<v_rd_off(D0, 2, 1)>(vb), l3 = tr_read<v_rd_off(D0, 3, 0)>(vb), h3 = tr_read<v_rd_off(D0, 3, 1)>(vb);
  asm volatile("s_waitcnt lgkmcnt(0)" ::: "memory"); SBAR();
#define PK(L, H) (bf16x8){L[0], L[1], L[2], L[3], H[0], H[1], H[2], H[3]}
  od = __builtin_amdgcn_mfma_f32_32x32x16_bf16(pa0, PK(l0, h0), od, 0, 0, 0);
  od = __builtin_amdgcn_mfma_f32_32x32x16_bf16(pa1, PK(l1, h1), od, 0, 0, 0);
  od = __builtin_amdgcn_mfma_f32_32x32x16_bf16(pa2, PK(l2, h2), od, 0, 0, 0);
  od = __builtin_amdgcn_mfma_f32_32x32x16_bf16(pa3, PK(l3, h3), od, 0, 0, 0);
#undef PK
}
__device__ __forceinline__ void pv_d0(f32x16* o, int vb, bf16x8 pa0, bf16x8 pa1, bf16x8 pa2, bf16x8 pa3) {
  pv_one<0>(o[0], vb, pa0, pa1, pa2, pa3); pv_one<1>(o[1], vb, pa0, pa1, pa2, pa3); pv_one<2>(o[2], vb, pa0, pa1, pa2, pa3); pv_one<3>(o[3], vb, pa0, pa1, pa2, pa3);
}

template <typename TQ>
__device__ __forceinline__ void attn_dense_body(const TQ* __restrict__ Qb, const bf16* __restrict__ Kh, const bf16* __restrict__ Vh,
                                                float* __restrict__ Ob, int seq, char* lds) {
  using St = Stage<bf16>; using SQ = Stage<TQ>;
  const int tid = threadIdx.x, wid = tid >> 6, lane = tid & 63, r32 = lane & 31, hi = lane >> 5;
  bf16* V_lds = (bf16*)lds; bf16* K_lds = (bf16*)(lds + 2 * SHM_V);
  float* ws = (float*)(lds + 2 * SHM_V + 2 * SHM_K) + wid * 64; float* li_l = ws; float* al_l = ws + 32;
  float m_reg = -1e30f, l_reg = 0; f32x16 o[4] = {}; bf16x8 qr[8];
  const TQ* Qw = Qb + (long)(wid * QBLK + r32) * LDQ + hi * 8;
#pragma unroll
  for (int d0 = 0; d0 < 8; ++d0) qr[d0] = SQ::tobf(SQ::ld8(Qw + d0 * 16));
  const int sr = tid >> 4, sc = (tid & 15) * 8, vst0 = v_st(sr, sc), vst1 = v_st(32 + sr, sc);
  const int vb0 = (int)(uintptr_t)V_lds + v_rd_base(lane);
  struct { typename St::T vs0, vs1, ks0, ks1; } sr_[SDEPTH];
#define SLOAD(i, k0) do { sr_[i].vs0 = St::ld8(&Vh[(long)((k0) + sr) * LDK + sc]); sr_[i].vs1 = St::ld8(&Vh[(long)((k0) + 32 + sr) * LDK + sc]); \
    sr_[i].ks0 = St::ld8(&Kh[(long)((k0) + sr) * LDK + sc]); sr_[i].ks1 = St::ld8(&Kh[(long)((k0) + 32 + sr) * LDK + sc]); } while (0)
#define SWRITE(b, i) do { *(bf16x8*)((char*)V_lds + (b) * SHM_V + vst0) = St::tobf(sr_[i].vs0);          \
    *(bf16x8*)((char*)V_lds + (b) * SHM_V + vst1) = St::tobf(sr_[i].vs1); int kc = sc * 2;               \
    *(bf16x8*)((char*)K_lds + (b) * SHM_K + KSWZ(sr, kc)) = St::tobf(sr_[i].ks0);                       \
    *(bf16x8*)((char*)K_lds + (b) * SHM_K + KSWZ(32 + sr, kc)) = St::tobf(sr_[i].ks1); } while (0)
#define SWAIT() do { if constexpr (SDEPTH == 2) asm volatile("s_waitcnt vmcnt(4)" ::: "memory"); else asm volatile("s_waitcnt vmcnt(0)" ::: "memory"); } while (0)
#define RESC(a) do { if (__any((a) < 1.f)) { if (hi == 0) al_l[r32] = (a); asm volatile("s_waitcnt lgkmcnt(0)" ::: "memory"); \
    for (int d = 0; d < 4; ++d) for (int r = 0; r < 16; ++r) o[d][r] *= al_l[crow(r, hi)]; } } while (0)
  f32x16 pA0, pA1, pB0, pB1; float mnA, mnB, alA, alB; bf16x8 pa0, pa1, pa2, pa3; const int NT = seq / KVBLK;
  constexpr int SE = 0, SO = SDEPTH - 1;
  SLOAD(SE, 0); asm volatile("s_waitcnt vmcnt(0)" ::: "memory"); SWRITE(0, SE); __syncthreads();
  qkt(pA0, pA1, K_lds, qr, r32, hi); partialSM(pA0, pA1, m_reg, mnA, alA);
  SLOAD(SO, KVBLK); if constexpr (SDEPTH == 2) { if (2 < NT) SLOAD(SE, 2 * KVBLK); }
  SWAIT(); SWRITE(1, SO); __syncthreads();
  for (int j = 1; j + 1 < NT; j += 2) {
    SBAR(); qkt(pB0, pB1, (bf16*)((char*)K_lds + SHM_K), qr, r32, hi);
    finishSM(pA0, pA1, alA, l_reg, pa0, pa1, pa2, pa3); SBAR();
    SLOAD(SO, (j + SDEPTH) * KVBLK); SBAR();
    pv_d0(o, vb0, pa0, pa1, pa2, pa3); partialSM(pB0, pB1, m_reg, mnB, alB);
    __syncthreads(); SWAIT(); SWRITE(0, SE);
    RESC(alB); __syncthreads();
    SBAR(); qkt(pA0, pA1, K_lds, qr, r32, hi);
    finishSM(pB0, pB1, alB, l_reg, pa0, pa1, pa2, pa3); SBAR();
    if (SDEPTH == 1 || j + 3 < NT) SLOAD(SE, (j + 1 + SDEPTH) * KVBLK); SBAR();
    pv_d0(o, vb0 + (int)SHM_V, pa0, pa1, pa2, pa3); partialSM(pA0, pA1, m_reg, mnA, alA);
    __syncthreads(); SWAIT(); SWRITE(1, SO);
    RESC(alA); __syncthreads();
  }
  SBAR(); qkt(pB0, pB1, (bf16*)((char*)K_lds + SHM_K), qr, r32, hi);
  finishSM(pA0, pA1, alA, l_reg, pa0, pa1, pa2, pa3); SBAR();
  pv_d0(o, vb0, pa0, pa1, pa2, pa3); partialSM(pB0, pB1, m_reg, mnB, alB);
  __syncthreads(); RESC(alB);
  finishSM(pB0, pB1, alB, l_reg, pa0, pa1, pa2, pa3); SBAR();
  pv_d0(o, vb0 + (int)SHM_V, pa0, pa1, pa2, pa3);
  if (hi == 0) li_l[r32] = l_reg; asm volatile("s_waitcnt lgkmcnt(0)" ::: "memory");
  float rli[16];
#pragma unroll
  for (int r = 0; r < 16; ++r) rli[r] = __builtin_amdgcn_rcpf(li_l[crow(r, hi)]);
  float* Ow = Ob + (long)(wid * QBLK) * LDO;
#pragma unroll
  for (int r = 0; r < 16; ++r) { int orow = crow(r, hi);
    for (int d0 = 0; d0 < 4; ++d0) Ow[(long)orow * LDO + d0 * 32 + r32] = o[d0][r] * rli[r]; }
#undef SLOAD
#undef SWRITE
#undef SWAIT
#undef RESC
}
}
#define GAS __attribute__((address_space(1)))
#define LAS __attribute__((address_space(3)))
typedef unsigned short bf16;
typedef unsigned v4u __attribute__((ext_vector_type(4)));
typedef float f32x4 __attribute__((ext_vector_type(4)));
typedef short bf16x8 __attribute__((ext_vector_type(8)));
typedef GAS unsigned gu32;
typedef GAS unsigned long long gu64;
#define RLX_AGENT __ATOMIC_RELAXED, __HIP_MEMORY_SCOPE_AGENT
#define LDS_WAIT() asm volatile("s_waitcnt lgkmcnt(0)" ::: "memory")
#define VM_WAIT() asm volatile("s_waitcnt vmcnt(0)" ::: "memory")
__device__ __forceinline__ unsigned long long rt() { return __builtin_amdgcn_s_memrealtime(); }
__device__ __forceinline__ unsigned f2bf(float f) { unsigned u = __builtin_bit_cast(unsigned, f); return (u + 0x7fffu + ((u >> 16) & 1u)) >> 16; }
__device__ __forceinline__ unsigned pk2(float lo, float hi) { return f2bf(lo) | (f2bf(hi) << 16); }

constexpr int DM = 1024, NB = 8, SEQ = 4096, CTX = 256, T = NB * SEQ, TC = NB * CTX, SKV = CTX + SEQ, MROWS = T + TC;
constexpr int NIN = 5120;
constexpr int C_Q = 0, C_K = 512, C_V = 1024, C_HY = 1536, C_G = 3072;
constexpr int NE = 32, TOPK = 4, NA = T * TOPK, NROWS = NA + NE * 256, NBLK = NROWS / 256;
constexpr float EPS = 1e-6f;
enum { IX_X = 0, IX_C, IX_CTX, IX_CCTX, IX_ADAW, IX_ADAB, IX_N1G, IX_N2G, IX_WIN, IX_BIN, IX_QNG, IX_KNG, IX_LQ1, IX_LK1, IX_LQ2, IX_LK2, IX_SUBG,
       IX_CONVW, IX_CONVB, IX_FW1, IX_FB1, IX_FW2, IX_FB2, IX_FW3, IX_FB3, IX_FW4, IX_FFREQ, IX_HBIAS, IX_WUA, IX_WUB, IX_WOUT, IX_RW, IX_RB,
       IX_EW1, IX_EB1, IX_EW2, IX_EB2, N_INPUTS };
constexpr size_t MiB = 1u << 20;
constexpr size_t WS_CTL = 0, CTL_BYTES = 1 * MiB;
constexpr size_t WS_MOD = 1 * MiB;
constexpr size_t WS_LAM = WS_MOD + 256 * 1024;
constexpr size_t WS_ROPEC = WS_LAM + 1024, WS_ROPES = WS_ROPEC + 4096;
constexpr size_t WS_BLKE = WS_ROPES + 4096;
constexpr size_t WS_TOPE = 2 * MiB, WS_TOPW = WS_TOPE + 512 * 1024, WS_TOKPOS = WS_TOPW + 512 * 1024;
constexpr size_t WS_ROWTOK = WS_TOKPOS + 512 * 1024, WS_ROWW = WS_ROWTOK + 576 * 1024;
static_assert(WS_ROWW + 576 * 1024 <= 5 * MiB && (size_t)NROWS * 4 <= 576 * 1024, "small tables");
constexpr size_t WS_HF = 6 * MiB;
constexpr size_t WS_WIN = 22 * MiB;
constexpr size_t WS_WA = 32 * MiB, WS_WB = 33 * MiB, WS_WO = 34 * MiB;
constexpr size_t WS_W1 = 36 * MiB;
constexpr size_t WS_W2 = 164 * MiB;
constexpr size_t WS_ACT0 = 228 * MiB;
constexpr size_t WS_PX = WS_ACT0;
constexpr size_t WS_XM = 568 * MiB;
constexpr size_t WS_OATT = 568 * MiB;
constexpr size_t WS_QP = 696 * MiB;
constexpr size_t WS_KA = 760 * MiB, WS_VA = 794 * MiB;
constexpr size_t WS_U = 828 * MiB;
constexpr size_t WS_OB = 892 * MiB, WS_OA = 924 * MiB;
constexpr size_t WS_TA = 696 * MiB;
constexpr size_t WS_TB = 568 * MiB;
constexpr size_t WS_MB = 828 * MiB;
constexpr size_t WS_TM = 696 * MiB;
constexpr size_t WS_H = 568 * MiB;
constexpr size_t WS_HS = 228 * MiB;
constexpr size_t WS_ACT = 696 * MiB;
constexpr size_t WS_Y = 228 * MiB;
constexpr size_t WS_END = 968 * MiB;
constexpr int CW_CNT = 0;
constexpr int CW_BAR = 4096;
constexpr int RING_BYTES = 131072, MISC_OFF = RING_BYTES + 320, LDS_BYTES = 147456;
constexpr int NWAVES = 8, NTHREADS = 512;

typedef __attribute__((address_space(3))) float lds_f32;
__device__ __forceinline__ float bf2f(bf16 v) { return __builtin_bit_cast(float, (unsigned)v << 16); }
__device__ __forceinline__ float wave_sum(float v) {
#pragma unroll
    for (int o = 1; o < 64; o <<= 1) v += __shfl_xor(v, o);
    return v;
}
__device__ __forceinline__ float sigmoidf_(float x) { return 1.0f / (1.0f + __expf(-x)); }

struct Ctx {
    float* out; unsigned char* ws;
    LAS unsigned char* lds; char* ldsg;
    int tid, lane, wave, gwave, nwaves, gtid, gthreads;
};
#define WSP(T_, off) ((T_*)(C.ws + (off)))
#define INP(i) (((const float* const __attribute__((address_space(4)))*)__builtin_amdgcn_kernarg_segment_ptr())[i])

__device__ __forceinline__ void tr_item(const float* W, int N, bf16* WT, int Kout, int k0, int n0, int orow0, LAS float* scr, int lane) {
#pragma unroll 8
    for (int i = 0; i < 32; ++i) { const int kk = 2 * i + (lane >> 5); scr[kk * 33 + (lane & 31)] = W[(size_t)(k0 + kk) * N + n0 + (lane & 31)]; }
    LDS_WAIT(); asm volatile("" ::: "memory");
    const int c = lane & 7;
#pragma unroll
    for (int j = 0; j < 4; ++j) { const int n = (lane >> 3) + 8 * j; const LAS float* s = scr + (8 * c) * 33 + n;
        v4u o; o.x = pk2(s[0 * 33], s[1 * 33]); o.y = pk2(s[2 * 33], s[3 * 33]); o.z = pk2(s[4 * 33], s[5 * 33]); o.w = pk2(s[6 * 33], s[7 * 33]);
        *(v4u*)(WT + (size_t)(orow0 + n) * Kout + k0 + 8 * c) = o; }
    LDS_WAIT(); asm volatile("" ::: "memory");
}
__device__ __forceinline__ void ph_prep_weights(const Ctx& C) {
    LAS float* scr = (LAS float*)(C.lds + C.wave * 16384);
    constexpr int I_IN = 16 * 160, I_A = 8 * 32, I_O = 16 * 32, I_E1 = 16 * 64, I_E2 = 16 * 32;
    constexpr int NIT = I_IN + 2 * I_A + I_O + NE * (I_E1 + I_E2);
    for (int it = C.gwave; it < NIT; it += C.nwaves) {
        int r = it;
        if (r < I_IN) { const int kb = r / 160, nb = r % 160; tr_item(INP(IX_WIN), NIN, WSP(bf16, WS_WIN), 1024, 64 * kb, 32 * nb, 32 * nb, scr, C.lane); continue; } r -= I_IN;
        if (r < I_A) { const int kb = r / 32, nb = r % 32; tr_item(INP(IX_WUA), 1024, WSP(bf16, WS_WA), 512, 64 * kb, 32 * nb, 32 * nb, scr, C.lane); continue; } r -= I_A;
        if (r < I_A) { const int kb = r / 32, nb = r % 32; tr_item(INP(IX_WUB), 1024, WSP(bf16, WS_WB), 512, 64 * kb, 32 * nb, 32 * nb, scr, C.lane); continue; } r -= I_A;
        if (r < I_O) { const int kb = r / 32, nb = r % 32; tr_item(INP(IX_WOUT), 1024, WSP(bf16, WS_WO), 1024, 64 * kb, 32 * nb, 32 * nb, scr, C.lane); continue; } r -= I_O;
        if (r < NE * I_E1) { const int e = r / I_E1, q = r % I_E1, kb = q / 64, nb = q % 64; const int L0 = 32 * nb, half = L0 >> 10, ch = L0 & 1023;
            const int phys = (ch >> 7) * 256 + half * 128 + (ch & 127);
            tr_item(INP(IX_EW1) + (size_t)e * 1024 * 2048, 2048, WSP(bf16, WS_W1) + (size_t)e * 2048 * 1024, 1024, 64 * kb, L0, phys, scr, C.lane); continue; } r -= NE * I_E1;
        { const int e = r / I_E2, q = r % I_E2, kb = q / 32, nb = q % 32;
            tr_item(INP(IX_EW2) + (size_t)e * 1024 * 1024, 1024, WSP(bf16, WS_W2) + (size_t)e * 1024 * 1024, 1024, 64 * kb, 32 * nb, 32 * nb, scr, C.lane); }
    }
}
__device__ __forceinline__ void ph_prep_ada(const Ctx& C) {
    LAS float* s = (LAS float*)C.lds;
    LAS float* red = s + 9 * 1024;
    const float* W = INP(IX_ADAW); float* MOD = WSP(float, WS_MOD);
    for (int g = blockIdx.x; g < 96; g += gridDim.x) {
        __syncthreads();
        for (int i = C.tid; i < 9 * 1024; i += NTHREADS) { const int r = i >> 10, k = i & 1023; const float v = r < 8 ? INP(IX_C)[r * 1024 + k] : INP(IX_CCTX)[k]; s[i] = v / (1.0f + __expf(-v)); }
        __syncthreads();
        float acc[9];
#pragma unroll
        for (int r = 0; r < 9; ++r) acc[r] = 0.f;
        const int col = 64 * g + C.lane;
#pragma unroll 4
        for (int k = 128 * C.wave; k < 128 * C.wave + 128; ++k) { const float wv = W[(size_t)k * 6144 + col];
#pragma unroll
            for (int r = 0; r < 9; ++r) acc[r] += s[r * 1024 + k] * wv; }
#pragma unroll
        for (int r = 0; r < 9; ++r) red[(C.wave * 9 + r) * 64 + C.lane] = acc[r];
        __syncthreads();
        for (int i = C.tid; i < 9 * 64; i += NTHREADS) { const int r = i >> 6, l = i & 63; float a = 0.f;
#pragma unroll
            for (int w = 0; w < 8; ++w) a += red[(w * 9 + r) * 64 + l];
            MOD[r * 6144 + 64 * g + l] = a + INP(IX_ADAB)[64 * g + l]; }
    }
    __syncthreads();
}
__device__ __forceinline__ void ph_prep_misc(const Ctx& C) {
    if (blockIdx.x == 0) {
        if (C.wave == 0) { const float a = wave_sum(INP(IX_LQ1)[C.lane] * INP(IX_LK1)[C.lane]), b = wave_sum(INP(IX_LQ2)[C.lane] * INP(IX_LK2)[C.lane]);
            if (C.lane == 0) *WSP(float, WS_LAM) = expf(a) - expf(b) + 0.2f; }
        for (int i = C.tid; i < 64 * 16; i += NTHREADS) { const int p = i >> 4, f = i & 15; const double fr = pow(10000.0, -(double)f / 16.0), ang = (double)p * fr;
            WSP(float, WS_ROPEC)[i] = (float)cos(ang); WSP(float, WS_ROPES)[i] = (float)sin(ang); }
    }
}
__device__ __forceinline__ void ph_prep_filter(const Ctx& C) {
    LAS float* sc = (LAS float*)(C.lds + C.wave * 2048);
    float* HF = WSP(float, WS_HF);
    const float* w1 = INP(IX_FW1); const float* w2 = INP(IX_FW2); const float* w3 = INP(IX_FW3); const float* w4 = INP(IX_FW4);
    const int lane = C.lane; const float fq = INP(IX_FFREQ)[lane];
    for (int i = C.gtid; i < 512; i += C.gthreads) HF[i] = 0.f;
    for (int n = C.gwave; n < SEQ; n += C.nwaves) {
        float zv = 0.f;
        if (lane == 0) zv = (float)n / 4095.0f;
        else if (lane <= 32) { const int i = (lane - 1) & 15; const double f = 1e-4 + (double)i * ((15.0 - 1e-4) / 15.0); const double ang = f * (6.283185307179586 * (double)n / 4096.0);
            zv = lane <= 16 ? (float)cos(ang) : -(float)sin(ang); }
        sc[lane] = zv; LDS_WAIT();
        float a = INP(IX_FB1)[lane];
#pragma unroll 3
        for (int i = 0; i < 33; ++i) a += sc[i] * w1[i * 64 + lane];
        sc[64 + lane] = sinf(fq * a); LDS_WAIT();
        a = INP(IX_FB2)[lane];
#pragma unroll 4
        for (int i = 0; i < 64; ++i) a += sc[64 + i] * w2[i * 64 + lane];
        sc[128 + lane] = sinf(fq * a); LDS_WAIT();
        a = INP(IX_FB3)[lane];
#pragma unroll 4
        for (int i = 0; i < 64; ++i) a += sc[128 + i] * w3[i * 64 + lane];
        sc[192 + lane] = sinf(fq * a); LDS_WAIT();
        const float tn = (float)n / 4095.0f;
#pragma unroll 1
        for (int q = 0; q < 16; ++q) { const int o = 64 * q + lane; float v = 0.f;
#pragma unroll 8
            for (int j = 0; j < 64; ++j) v += sc[192 + j] * w4[j * 1024 + o];
            const int dir = o >> 9, c = o & 511;
            const float lo = logf(0.01f) / 1.5f, hi = logf(0.01f) / 0.3f; const float dl = fabsf(lo + (hi - lo) * ((float)c / 511.0f));
            v *= expf(-tn * dl);
            if (dir == 0) { if (n == 0) v += INP(IX_HBIAS)[c]; HF[(size_t)(4096 + n) * 512 + c] = v; }
            else if (n > 0) HF[(size_t)(4096 - n) * 512 + c] = v; }
        LDS_WAIT();
    }
}
__device__ __forceinline__ void ph_modulate1(const Ctx& C) {
    const float* MOD = WSP(float, WS_MOD); bf16* XM = WSP(bf16, WS_XM); const float* g = INP(IX_N1G);
    for (int r = C.gwave; r < MROWS; r += C.nwaves) {
        const float* xr = r < T ? INP(IX_X) + (size_t)r * DM : INP(IX_CTX) + (size_t)(r - T) * DM;
        const float* mrow = MOD + (r < T ? (r >> 12) : 8) * 6144;
        f32x4 v[4]; float ss = 0.f;
#pragma unroll
        for (int j = 0; j < 4; ++j) { v[j] = *(const f32x4*)(xr + 4 * C.lane + 256 * j); ss += (v[j].x * v[j].x + v[j].y * v[j].y) + (v[j].z * v[j].z + v[j].w * v[j].w); }
        const float rstd = rsqrtf(wave_sum(ss) * (1.0f / DM) + EPS);
#pragma unroll
        for (int j = 0; j < 4; ++j) { const int col = 4 * C.lane + 256 * j; const f32x4 gg = *(const f32x4*)(g + col), sh = *(const f32x4*)(mrow + col), sc = *(const f32x4*)(mrow + 1024 + col);
            const f32x4 y = v[j] * rstd * gg * (sc + 1.0f) + sh;
            *(unsigned long long*)(XM + (size_t)r * DM + col) = (unsigned long long)pk2(y.x, y.y) | ((unsigned long long)pk2(y.z, y.w) << 32); }
    }
}
__device__ __forceinline__ void ph_post_proj(const Ctx& C) {
    const bf16* PX = WSP(bf16, WS_PX); bf16* QP = WSP(bf16, WS_QP); bf16* KA = WSP(bf16, WS_KA); bf16* VA = WSP(bf16, WS_VA); float* U = WSP(float, WS_U);
    const float* RC = WSP(float, WS_ROPEC); const float* RS = WSP(float, WS_ROPES);
    const int lane = C.lane;
    for (int it = C.gwave; it < T * 16 + TC * 8; it += C.nwaves) {
        int r, which, h, m, rc = 0; bool latent;
        if (it < T * 16) { r = it >> 4; const int v = it & 15; which = v >> 3; h = (v >> 1) & 3; m = v & 1; latent = true; }
        else { const int j = it - T * 16; rc = j >> 3; const int v = j & 7; which = 1; h = v >> 1; m = v & 1; r = T + rc; latent = false; }
        const float x = bf2f(PX[(size_t)r * NIN + which * 512 + h * 128 + m * 64 + lane]);
        const float rstd = rsqrtf(wave_sum(x * x) * (1.0f / 64.0f) + EPS);
        float y = x * rstd * (which ? INP(IX_KNG)[lane] : INP(IX_QNG)[lane]);
        const int t = r & 4095;
        if (latent) { const int axis = lane >> 5, half = (lane >> 4) & 1, f = lane & 15, pos = axis ? (t & 63) : (t >> 6);
            const float cs = RC[pos * 16 + f], sn = RS[pos * 16 + f]; const float pr = __shfl_xor(y, 16);
            y = half == 0 ? y * cs - pr * sn : y * cs + pr * sn; }
        if (which == 0) { const size_t base = ((size_t)r * 8 + (h * 2 + m)) * 128; QP[base + m * 64 + lane] = (bf16)f2bf(y); QP[base + (1 - m) * 64 + lane] = 0; }
        else { const size_t krow = latent ? (size_t)(r >> 12) * SKV + CTX + t : (size_t)(rc >> 8) * SKV + (rc & 255); KA[krow * 512 + h * 128 + m * 64 + lane] = (bf16)f2bf(y); }
    }
    for (int i = C.gtid; i < MROWS * 64; i += C.gthreads) { const int r = i >> 6, ch = i & 63;
        const size_t vrow = r < T ? (size_t)(r >> 12) * SKV + CTX + (r & 4095) : (size_t)((r - T) >> 8) * SKV + ((r - T) & 255);
        *(v4u*)(VA + vrow * 512 + ch * 8) = *(const v4u*)(PX + (size_t)r * NIN + C_V + ch * 8); }
    const float* cw = INP(IX_CONVW); const float* cb = INP(IX_CONVB);
    for (int i = C.gtid; i < T * 512; i += C.gthreads) { const int r = i >> 9, c = i & 511, t = r & 4095; float z[2];
#pragma unroll
        for (int gsel = 0; gsel < 2; ++gsel) { const int chn = 512 * (gsel + 1) + c; const bf16* p = PX + (size_t)r * NIN + C_HY + chn;
            const float xm = t > 0 ? bf2f(p[-NIN]) : 0.f, x0 = bf2f(p[0]), xp = t < 4095 ? bf2f(p[NIN]) : 0.f;
            z[gsel] = xm * cw[chn] + x0 * cw[1536 + chn] + xp * cw[3072 + chn] + cb[chn]; }
        U[i] = z[0] * z[1]; }
}
__device__ __forceinline__ void ph_hyena_naive(const Ctx& C) {
    const float* U = WSP(float, WS_U); const float* HF = WSP(float, WS_HF); const bf16* PX = WSP(bf16, WS_PX); bf16* OB = WSP(bf16, WS_OB);
    const float* cw = INP(IX_CONVW); const float* cb = INP(IX_CONVB);
    for (int i = C.gtid; i < T * 512 / 8; i += C.gthreads) {
        const int c = i & 511, tg = i >> 9, b = tg >> 9, t0 = (tg & 511) * 8;
        float acc[8], tap[8];
#pragma unroll
        for (int j = 0; j < 8; ++j) { acc[j] = 0.f; tap[j] = HF[(size_t)(t0 + j + 4096) * 512 + c]; }
        const float* up = U + (size_t)b * SEQ * 512 + c; const float* hp = HF + (size_t)(t0 + 4095) * 512 + c;
        for (int s = 0; s < SEQ; ++s) { const float uv = up[(size_t)s * 512]; const float nt = hp[-(long)s * 512];
#pragma unroll
            for (int j = 0; j < 8; ++j) acc[j] += uv * tap[j];
#pragma unroll
            for (int j = 7; j > 0; --j) tap[j] = tap[j - 1];
            tap[0] = nt; }
#pragma unroll
        for (int j = 0; j < 8; ++j) { const int t = t0 + j; const size_t r = (size_t)b * SEQ + t; const bf16* p = PX + r * NIN + C_HY + c;
            const float xm = t > 0 ? bf2f(p[-NIN]) : 0.f, x0 = bf2f(p[0]), xp = t < 4095 ? bf2f(p[NIN]) : 0.f;
            const float z0 = xm * cw[c] + x0 * cw[1536 + c] + xp * cw[3072 + c] + cb[c];
            OB[r * 512 + c] = (bf16)f2bf(z0 * acc[j]); }
    }
}
__device__ __forceinline__ void ph_attn_post(const Ctx& C) {
    const float* O = WSP(float, WS_OATT); bf16* OA = WSP(bf16, WS_OA); const float lam = *WSP(float, WS_LAM); const float* sg = INP(IX_SUBG);
    for (int it = C.gwave; it < T * 4; it += C.nwaves) { const int r = it >> 2, h = it & 3; const float* p = O + (size_t)r * 1024 + h * 256 + C.lane;
        const float o0 = p[0] - lam * p[128], o1 = p[64] - lam * p[192];
        const float rstd = rsqrtf(wave_sum(o0 * o0 + o1 * o1) * (1.0f / 128.0f) + EPS);
        OA[(size_t)r * 512 + h * 128 + C.lane] = (bf16)f2bf(o0 * rstd * sg[C.lane] * 0.8f); OA[(size_t)r * 512 + h * 128 + 64 + C.lane] = (bf16)f2bf(o1 * rstd * sg[64 + C.lane] * 0.8f); }
}
__device__ __forceinline__ void ph_gate(const Ctx& C) {
    const float* TA = WSP(float, WS_TA); const float* TB = WSP(float, WS_TB); const bf16* PX = WSP(bf16, WS_PX); bf16* MB = WSP(bf16, WS_MB);
    for (int i = C.gtid; i < T * 256; i += C.gthreads) { const int r = i >> 8, c = (i & 255) * 4; const f32x4 a = *(const f32x4*)(TA + (size_t)r * 1024 + c), b = *(const f32x4*)(TB + (size_t)r * 1024 + c);
        const bf16* g = PX + (size_t)r * NIN + C_G + c; float o[4];
#pragma unroll
        for (int e = 0; e < 4; ++e) o[e] = sigmoidf_(bf2f(g[e])) * a[e] + sigmoidf_(bf2f(g[1024 + e])) * b[e];
        *(unsigned long long*)(MB + (size_t)r * 1024 + c) = (unsigned long long)pk2(o[0], o[1]) | ((unsigned long long)pk2(o[2], o[3]) << 32); }
}
__device__ __forceinline__ void ph_router(const Ctx& C) {
    const float* MOD = WSP(float, WS_MOD); const float* TM = WSP(float, WS_TM); bf16* H = WSP(bf16, WS_H); const float* g2n = INP(IX_N2G); const float* RW = INP(IX_RW);
    int* TOPE = WSP(int, WS_TOPE); float* TOPW = WSP(float, WS_TOPW); unsigned* CNT = WSP(unsigned, WS_CTL) + CW_CNT;
    LAS unsigned* hist = (LAS unsigned*)C.lds;
    if (C.tid < 32) hist[C.tid] = 0u;
    __syncthreads();
    for (int r = C.gwave; r < T; r += C.nwaves) {
        const float* mrow = MOD + (r >> 12) * 6144;
        f32x4 v[4]; float ss = 0.f;
#pragma unroll
        for (int j = 0; j < 4; ++j) { const int col = 4 * C.lane + 256 * j; const f32x4 x = *(const f32x4*)(INP(IX_X) + (size_t)r * DM + col), tm = *(const f32x4*)(TM + (size_t)r * DM + col), g1 = *(const f32x4*)(mrow + 2048 + col);
            v[j] = x + g1 * tm; *(f32x4*)(C.out + (size_t)r * DM + col) = v[j]; ss += (v[j].x * v[j].x + v[j].y * v[j].y) + (v[j].z * v[j].z + v[j].w * v[j].w); }
        const float rstd = rsqrtf(wave_sum(ss) * (1.0f / DM) + EPS);
        f32x4 y[4];
#pragma unroll
        for (int j = 0; j < 4; ++j) { const int col = 4 * C.lane + 256 * j; const f32x4 gg = *(const f32x4*)(g2n + col), sh = *(const f32x4*)(mrow + 3072 + col), sc = *(const f32x4*)(mrow + 4096 + col);
            y[j] = v[j] * rstd * gg * (sc + 1.0f) + sh;
            *(unsigned long long*)(H + (size_t)r * DM + col) = (unsigned long long)pk2(y[j].x, y[j].y) | ((unsigned long long)pk2(y[j].z, y[j].w) << 32); }
        LAS float* lg = (LAS float*)(C.lds + 1024) + C.wave * 32;
#pragma unroll 1
        for (int e = 0; e < 32; ++e) { float a = 0.f;
#pragma unroll
            for (int j = 0; j < 4; ++j) { const float* wr = RW + (size_t)(4 * C.lane + 256 * j) * 32 + e; a += y[j].x * wr[0] + y[j].y * wr[32] + y[j].z * wr[64] + y[j].w * wr[96]; }
            a = wave_sum(a) + INP(IX_RB)[e];
            if (C.lane == 0) lg[e] = a; }
        LDS_WAIT();
        float p[32];
#pragma unroll
        for (int e = 0; e < 32; ++e) p[e] = lg[e];
        unsigned taken = 0u; float tv[4]; int ti[4];
#pragma unroll
        for (int k = 0; k < 4; ++k) { float best = -INFINITY; int bi = 0;
#pragma unroll
            for (int e = 0; e < 32; ++e) { const bool ok = !((taken >> e) & 1u) && p[e] > best; best = ok ? p[e] : best; bi = ok ? e : bi; }
            taken |= 1u << bi; tv[k] = best; ti[k] = bi; }
        const float e1 = __expf(tv[1] - tv[0]), e2 = __expf(tv[2] - tv[0]), e3 = __expf(tv[3] - tv[0]); const float inv = 1.0f / (1.0f + e1 + e2 + e3);
        if (C.lane == 0) { *(int4*)(TOPE + (size_t)r * 4) = make_int4(ti[0], ti[1], ti[2], ti[3]); *(f32x4*)(TOPW + (size_t)r * 4) = (f32x4){inv, e1 * inv, e2 * inv, e3 * inv};
            atomicAdd((unsigned*)&hist[ti[0]], 1u); atomicAdd((unsigned*)&hist[ti[1]], 1u); atomicAdd((unsigned*)&hist[ti[2]], 1u); atomicAdd((unsigned*)&hist[ti[3]], 1u); }
    }
    __syncthreads();
    if (C.tid < 32) atomicAdd(CNT + C.tid, hist[C.tid]);
}
__device__ __forceinline__ void ph_sort(const Ctx& C) {
    const unsigned* CNT = WSP(unsigned, WS_CTL) + CW_CNT; const int* TOPE = WSP(int, WS_TOPE); const float* TOPW = WSP(float, WS_TOPW);
    int* TOKPOS = WSP(int, WS_TOKPOS); int* ROWTOK = WSP(int, WS_ROWTOK); float* ROWW = WSP(float, WS_ROWW); int* BLKE = WSP(int, WS_BLKE);
    LAS int* wtot = (LAS int*)C.lds;
    for (int e = blockIdx.x; e < NE; e += gridDim.x) {
        int pstart = 0, cnt = 0, padded = 0;
        for (int i = 0; i <= e; ++i) { pstart += padded; cnt = (int)__hip_atomic_load(CNT + i, __ATOMIC_RELAXED, __HIP_MEMORY_SCOPE_AGENT); padded = (cnt + 255) / 256 * 256; }
        int running = 0;
        for (int a0 = 0; a0 < NA; a0 += NTHREADS) { const int a = a0 + C.tid; const bool flag = TOPE[a] == e;
            const unsigned long long bal = __ballot(flag); const int pre = __popcll(bal & ((1ull << C.lane) - 1ull)), tot = __popcll(bal);
            __syncthreads();
            if (C.lane == 0) wtot[C.wave] = tot;
            __syncthreads();
            int woff = 0, all = 0;
#pragma unroll
            for (int w = 0; w < 8; ++w) { const int x = wtot[w]; woff += (w < C.wave) ? x : 0; all += x; }
            if (flag) { const int pos = pstart + running + woff + pre; ROWTOK[pos] = a >> 2; ROWW[pos] = TOPW[a]; TOKPOS[a] = pos; }
            running += all; }
        for (int i = cnt + C.tid; i < padded; i += NTHREADS) { ROWTOK[pstart + i] = T; ROWW[pstart + i] = 0.f; }
        __syncthreads();
    }
    if (blockIdx.x == gridDim.x - 1) {
        for (int blk = C.tid; blk <= NBLK; blk += NTHREADS) { int pend = 0, e = 0; bool found = false;
            for (int i = 0; i < NE; ++i) { const int cnt = (int)__hip_atomic_load(CNT + i, __ATOMIC_RELAXED, __HIP_MEMORY_SCOPE_AGENT); pend += (cnt + 255) / 256 * 256; if (!found && blk * 256 < pend) { e = i; found = true; } }
            if (blk < NBLK) BLKE[blk] = found ? e : NE - 1; else BLKE[NBLK] = pend / 256; }
    }
}
__device__ __forceinline__ void ph_gather(const Ctx& C) {
    const int nrows = WSP(int, WS_BLKE)[NBLK] * 256; const int* ROWTOK = WSP(int, WS_ROWTOK); const bf16* H = WSP(bf16, WS_H); bf16* HS = WSP(bf16, WS_HS);
    for (int r = C.gwave; r < nrows; r += C.nwaves) { const int tok = ROWTOK[r]; v4u a = {0u, 0u, 0u, 0u}, b = {0u, 0u, 0u, 0u};
        if (tok < T) { a = *(const v4u*)(H + (size_t)tok * DM + C.lane * 16); b = *(const v4u*)(H + (size_t)tok * DM + C.lane * 16 + 8); }
        *(v4u*)(HS + (size_t)r * DM + C.lane * 16) = a; *(v4u*)(HS + (size_t)r * DM + C.lane * 16 + 8) = b; }
}
__device__ __forceinline__ void ph_combine(const Ctx& C) {
    const float* MOD = WSP(float, WS_MOD); const int* TOKPOS = WSP(int, WS_TOKPOS); const bf16* Y = WSP(bf16, WS_Y);
    for (int i = C.gtid; i < T * 256; i += C.gthreads) { const int r = i >> 8, c = (i & 255) * 4; const int4 ps = *(const int4*)(TOKPOS + (size_t)r * 4);
        const f32x4 g2 = *(const f32x4*)(MOD + (r >> 12) * 6144 + 5120 + c); f32x4 acc = {0.f, 0.f, 0.f, 0.f};
        const int pp[4] = {ps.x, ps.y, ps.z, ps.w};
#pragma unroll
        for (int k = 0; k < 4; ++k) { const unsigned long long w = *(const unsigned long long*)(Y + (size_t)pp[k] * DM + c);
            acc.x += __builtin_bit_cast(float, (unsigned)(w & 0xffffu) << 16); acc.y += __builtin_bit_cast(float, (unsigned)((w >> 16) & 0xffffu) << 16);
            acc.z += __builtin_bit_cast(float, (unsigned)((w >> 32) & 0xffffu) << 16); acc.w += __builtin_bit_cast(float, (unsigned)((w >> 48) & 0xffffu) << 16); }
        f32x4* o = (f32x4*)(C.out + (size_t)r * DM + c); *o = *o + g2 * acc; }
}
__device__ __forceinline__ void ph_attention(const Ctx& C) {
    const att::bf16* Q = (const att::bf16*)WSP(bf16, WS_QP); const att::bf16* K = (const att::bf16*)WSP(bf16, WS_KA); const att::bf16* V = (const att::bf16*)WSP(bf16, WS_VA); float* O = WSP(float, WS_OATT);
    for (int u = blockIdx.x; u < NB * 8 * (SEQ / 256); u += gridDim.x) {
        const int qb = u & 15, vh = (u >> 4) & 7, b = u >> 7;
        const long q0 = (((long)b * SEQ + qb * 256) * 8 + vh) * 128, k0 = ((long)b * SKV * 4 + (vh >> 1)) * 128;
        __syncthreads();
        att::attn_dense_body<att::bf16>(Q + q0, K + k0, V + k0, O + q0, SKV, C.ldsg);
    }
    __syncthreads();
}
enum { PH_PREP = 0, PH_MOD1, PH_INPROJ, PH_POST, PH_ATTN, PH_HYENA, PH_ATTNPOST, PH_MERGEUP, PH_GATE, PH_WOUT, PH_ROUTER, PH_SORT, PH_GATHER, PH_MOE1, PH_MOE2, PH_COMBINE, N_PHASES };
struct Args { const float* in[N_INPUTS]; float* out; unsigned char* ws; int ph_lo, ph_hi; };
static_assert(sizeof(Args) == N_INPUTS * 8 + 8 + 8 + 8, "Args has no padding");

__global__ void __launch_bounds__(NTHREADS, 2) fwd(Args args) {
    extern __shared__ __attribute__((aligned(16))) unsigned char lds_raw[];
    Ctx C;
    C.out = args.out; C.ws = args.ws; C.lds = (LAS unsigned char*)lds_raw; C.ldsg = (char*)lds_raw;
    C.tid = threadIdx.x; C.lane = C.tid & 63; C.wave = __builtin_amdgcn_readfirstlane(C.tid >> 6);
    C.gwave = blockIdx.x * NWAVES + C.wave; C.nwaves = gridDim.x * NWAVES; C.gtid = blockIdx.x * NTHREADS + C.tid; C.gthreads = gridDim.x * NTHREADS;
    const int lo = args.ph_lo, hi = args.ph_hi;
#define IN(k) (lo <= (k) && (k) < hi)
    if (IN(PH_PREP)) { ph_prep_weights(C); __syncthreads(); ph_prep_ada(C); __syncthreads(); ph_prep_misc(C); ph_prep_filter(C); }
    if (IN(PH_MOD1)) { ph_modulate1(C); }
    if (IN(PH_INPROJ)) {
        pg8::Gemm g{WSP(bf16, WS_XM), WSP(bf16, WS_WIN), MROWS, NIN, DM, 0}; pg8::StaticOrder S; S.init(MROWS, NIN, gridDim.x, (int)blockIdx.x);
        pg8::EpiBf16<0> E{WSP(bf16, WS_PX), NIN, INP(IX_BIN), 0, 0, 1.f};
        pg8::gemm_phase<pg8::EpiBf16<0>, pg8::StaticOrder, true, true>(C.lds, g, S, E);
    }
    if (IN(PH_POST)) { ph_post_proj(C); }
    if (IN(PH_ATTN)) { ph_attention(C); }
    if (IN(PH_HYENA)) { ph_hyena_naive(C); }
    if (IN(PH_ATTNPOST)) { ph_attn_post(C); }
    if (IN(PH_MERGEUP)) {
        { pg8::Gemm g{WSP(bf16, WS_OA), WSP(bf16, WS_WA), T, DM, 512, 0}; pg8::StaticOrder S; S.init(T, DM, gridDim.x, (int)blockIdx.x);
          pg8::EpiF32 E{WSP(float, WS_TA), DM, nullptr}; pg8::gemm_phase<pg8::EpiF32, pg8::StaticOrder, true, true>(C.lds, g, S, E); }
        { pg8::Gemm g{WSP(bf16, WS_OB), WSP(bf16, WS_WB), T, DM, 512, 0}; pg8::StaticOrder S; S.init(T, DM, gridDim.x, (int)blockIdx.x);
          pg8::EpiF32 E{WSP(float, WS_TB), DM, nullptr}; pg8::gemm_phase<pg8::EpiF32, pg8::StaticOrder, true, true>(C.lds, g, S, E); }
    }
    if (IN(PH_GATE)) { ph_gate(C); }
    if (IN(PH_WOUT)) {
        pg8::Gemm g{WSP(bf16, WS_MB), WSP(bf16, WS_WO), T, DM, DM, 0}; pg8::StaticOrder S; S.init(T, DM, gridDim.x, (int)blockIdx.x);
        pg8::EpiF32 E{WSP(float, WS_TM), DM, nullptr}; pg8::gemm_phase<pg8::EpiF32, pg8::StaticOrder, true, true>(C.lds, g, S, E);
    }
    if (IN(PH_ROUTER)) { ph_router(C); }
    if (IN(PH_SORT)) { ph_sort(C); }
    if (IN(PH_GATHER)) { ph_gather(C); }
    if (IN(PH_MOE1)) {
        const int nblk = WSP(int, WS_BLKE)[NBLK];
        pg8::Gemm g{WSP(bf16, WS_HS), WSP(bf16, WS_W1), nblk * 256, 2048, DM, (size_t)2048 * 1024 * 2}; pg8::MoeOrder S; S.so.init(nblk * 256, 2048, gridDim.x, (int)blockIdx.x); S.blke = WSP(int, WS_BLKE);
        pg8::EpiSwiglu E{WSP(bf16, WS_ACT), INP(IX_EB1)}; pg8::gemm_phase<pg8::EpiSwiglu, pg8::MoeOrder, true, true>(C.lds, g, S, E);
    }
    if (IN(PH_MOE2)) {
        const int nblk = WSP(int, WS_BLKE)[NBLK];
        pg8::Gemm g{WSP(bf16, WS_ACT), WSP(bf16, WS_W2), nblk * 256, DM, DM, (size_t)1024 * 1024 * 2}; pg8::MoeOrder S; S.so.init(nblk * 256, DM, gridDim.x, (int)blockIdx.x); S.blke = WSP(int, WS_BLKE);
        pg8::EpiY E{WSP(bf16, WS_Y), INP(IX_EB2), WSP(float, WS_ROWW)}; pg8::gemm_phase<pg8::EpiY, pg8::MoeOrder, true, true>(C.lds, g, S, E);
    }
    if (IN(PH_COMBINE)) { ph_combine(C); }
#undef IN
}

extern "C" void kernel_launch(void* const* d_in, const int* in_sizes, int n_in, void* d_out, int out_size, void* d_ws, size_t ws_size, hipStream_t stream) {
    static int grid = 0;
    if (grid == 0) {
        if (n_in != N_INPUTS || in_sizes[0] != T * DM || out_size != T * DM || ws_size < WS_END) { fprintf(stderr, "kernel_launch: unexpected shapes n_in %d in0 %d out %d ws %zu (need %zu)\n", n_in, n_in > 0 ? in_sizes[0] : -1, out_size, ws_size, (size_t)WS_END); grid = -1; return; }
        int dev = 0, cus = 0;
        if (hipGetDevice(&dev) != hipSuccess || hipDeviceGetAttribute(&cus, hipDeviceAttributeMultiprocessorCount, dev) != hipSuccess) { grid = -1; return; }
        if (hipFuncSetAttribute((const void*)fwd, hipFuncAttributeMaxDynamicSharedMemorySize, LDS_BYTES) != hipSuccess) { fprintf(stderr, "kernel_launch: hipFuncSetAttribute failed\n"); grid = -1; return; }
        grid = cus;
    }
    if (grid < 0) return;
    (void)hipMemsetAsync((char*)d_ws + WS_CTL, 0, CTL_BYTES, stream);
    Args a{};
    for (int i = 0; i < N_INPUTS; ++i) a.in[i] = (const float*)d_in[i];
    a.out = (float*)d_out; a.ws = (unsigned char*)d_ws;
    for (int ph = 0; ph < N_PHASES; ++ph) { a.ph_lo = ph; a.ph_hi = ph + 1; hipLaunchKernelGGL(fwd, dim3(grid), dim3(NTHREADS), LDS_BYTES, stream, a); }
}
```

```cpp
#include <hip/hip_runtime.h>
#include <hip/hip_bf16.h>
#include <hip/hip_cooperative_groups.h>
#include <cstdio>
#include <cstdint>
#include <cmath>
namespace pg8 {
#define PG8_LAS __attribute__((address_space(3)))
typedef unsigned short bf16_t;
typedef short bf16x8 __attribute__((ext_vector_type(8)));
typedef float f32x4 __attribute__((ext_vector_type(4)));
typedef unsigned u32x4 __attribute__((ext_vector_type(4)));
typedef int v4i_t __attribute__((ext_vector_type(4)));
typedef int v8i_t __attribute__((ext_vector_type(8)));
constexpr int EPI_OFF = 131072 + 16384;
constexpr int BM = 256, BK = 64, HALF = 128, HTB = HALF * BK * 2  , STAGE_BYTES = 8 * HTB, NXCD = 8, WGM = 8;

__host__ __device__ __forceinline__ int lds_byte(int r, int c) { const int st = (r >> 4) * 2 + (c >> 5), rr = r & 15, cc = c & 31, ob = rr * 64 + cc * 2; return st * 1024 + (ob ^ (((ob >> 9) & 1) << 5)); }
__host__ __device__ __forceinline__ void stage_rc(int b, int& R, int& C) { const int st = b / 1024, sb = b % 1024, swz = sb ^ (((sb >> 9) & 1) << 5); R = (st >> 1) * 16 + swz / 64; C = (st & 1) * 32 + (swz % 64) / 2; }
__host__ __device__ __forceinline__ int perm32(int rho) { const int n = rho >> 4, i = rho & 15; return 8 * (i >> 2) + 4 * n + (i & 3); }

struct Unit { int pm, pn, be, es; };
struct Gemm { const bf16_t* A; const bf16_t* Bt; int M, N, K; size_t bstride; };

struct StaticOrder {
    static constexpr bool GATHER = false;
    int nM, nN, nwg, G, c;
    __host__ __device__ __forceinline__ void init(int M, int N, int G_, int c_) { nM = M / BM; nN = N / BM; nwg = nM * nN; G = G_; c = c_; }
    __host__ __device__ __forceinline__ bool next(int i, Unit& u) const {
        const long L = (long)i * G + c; if (L >= nwg) return false;
        int wgid = (int)L; { const int q = nwg / NXCD, r = nwg % NXCD, xcd = wgid % NXCD, off = wgid / NXCD; wgid = (xcd < r ? xcd * (q + 1) : r * (q + 1) + (xcd - r) * q) + off; }
        const int nig = WGM * nN, gid = wgid / nig, fm = gid * WGM, gsz = (nM - fm) < WGM ? (nM - fm) : WGM;
        u.pm = fm + ((wgid % nig) % gsz); u.pn = (wgid % nig) / gsz; u.be = 0; u.es = 0; return true;
    }
    __device__ __forceinline__ void a_ready(const Unit&) const {}
    __device__ __forceinline__ void done(const Unit&) const {}
};

__device__ __forceinline__ unsigned cvt_pk_bf16(float lo, float hi) { unsigned r; asm volatile("v_cvt_pk_bf16_f32 %0, %1, %2" : "=v"(r) : "v"(lo), "v"(hi)); return r; }
typedef float f32x2 __attribute__((ext_vector_type(2)));
__device__ __forceinline__ f32x2 gelu_pk(f32x2 v) {
    const f32x2 av = __builtin_elementwise_abs(v), d = av * 0.2316418882f + 1.0f;
    f32x2 t; t.x = __builtin_amdgcn_rcpf(d.x); t.y = __builtin_amdgcn_rcpf(d.y);
    f32x2 q = t * 0.5307027145f + (-0.7265760135f); q = q * t + 0.7107068705f; q = q * t + (-0.142248368f); q = q * t + 0.127414796f; q = q * t;
    const f32x2 s = (v * v) * (-0.72134752044f);
    f32x2 e; e.x = __builtin_amdgcn_exp2f(s.x); e.y = __builtin_amdgcn_exp2f(s.y);
    const f32x2 m = v * (q * e), r = v - m;
    f32x2 o; o.x = v.x < 0.f ? m.x : r.x; o.y = v.y < 0.f ? m.y : r.y; return o;
}

template <int ACT  > struct EpiBf16 {
    static constexpr bool PERM = true, AFTER_DRAIN = false, HAS_MID = false, F8 = false, PREFETCH = false; static constexpr int WSCALE = 0x7F7F7F7F; static_assert(ACT == 0 || ACT == 1, "EpiBf16: ACT is 0 (none) or 1 (gelu_pk)");
    bf16_t* O; int ldc; const float* bias; int split_cols; size_t split_stride; float scale0;
    __device__ __forceinline__ void operator()(const f32x4 (&acc)[2][2][4][2], const Unit& u, int wr, int wc, int fr, int fq) const {
        const int row0 = u.pm * BM + wr * 64 + fr; int colt = u.pn * BM; bf16_t* base = O;
        float sc = 1.f; if (split_cols) { const int t = colt / split_cols; base += (size_t)t * split_stride; colt -= t * split_cols; if (t == 0) sc = scale0; }
        const int col0 = colt + wc * 32 + 8 * fq, bcol0 = u.pn * BM + wc * 32 + 8 * fq;
        f32x4 bv[2][2];
#pragma unroll
        for (int bj = 0; bj < 2; ++bj)
#pragma unroll
            for (int n = 0; n < 2; ++n) bv[bj][n] = bias ? *(const f32x4*)(bias + bcol0 + bj * HALF + 4 * n) : (f32x4){0.f, 0.f, 0.f, 0.f};
#pragma unroll
        for (int ai = 0; ai < 2; ++ai)
#pragma unroll
            for (int m = 0; m < 4; ++m) { bf16_t* rowp = base + (size_t)(row0 + ai * HALF + m * 16) * ldc + col0;
#pragma unroll
                for (int bj = 0; bj < 2; ++bj) { f32x4 v0 = acc[ai][bj][m][0] + bv[bj][0], v1 = acc[ai][bj][m][1] + bv[bj][1];
                    if (ACT == 1) { f32x2 a = gelu_pk((f32x2){v0[0], v0[1]}), b = gelu_pk((f32x2){v0[2], v0[3]}), c = gelu_pk((f32x2){v1[0], v1[1]}), d = gelu_pk((f32x2){v1[2], v1[3]});
                        v0 = (f32x4){a.x, a.y, b.x, b.y}; v1 = (f32x4){c.x, c.y, d.x, d.y}; }
                    v0 = v0 * sc; v1 = v1 * sc; u32x4 w; w.x = cvt_pk_bf16(v0[0], v0[1]); w.y = cvt_pk_bf16(v0[2], v0[3]); w.z = cvt_pk_bf16(v1[0], v1[1]); w.w = cvt_pk_bf16(v1[2], v1[3]);
                    *(u32x4*)(rowp + bj * HALF) = w; } }
    }
};
struct EpiF32 {
    static constexpr bool PERM = false, AFTER_DRAIN = false, HAS_MID = false, F8 = false, PREFETCH = false; static constexpr int WSCALE = 0x7F7F7F7F;
    float* C; int ldc; const float* bias;
    __device__ __forceinline__ void operator()(const f32x4 (&acc)[2][2][4][2], const Unit& u, int wr, int wc, int fr, int fq) const {
        const int row0 = u.pm * BM + wr * 64 + fr, col0 = u.pn * BM + wc * 32 + 4 * fq;
        f32x4 bv[2][2];
#pragma unroll
        for (int bj = 0; bj < 2; ++bj)
#pragma unroll
            for (int n = 0; n < 2; ++n) bv[bj][n] = bias ? *(const f32x4*)(bias + col0 + bj * HALF + n * 16) : (f32x4){0.f, 0.f, 0.f, 0.f};
#pragma unroll
        for (int ai = 0; ai < 2; ++ai)
#pragma unroll
            for (int m = 0; m < 4; ++m) { float* rowp = C + (size_t)(row0 + ai * HALF + m * 16) * ldc + col0;
#pragma unroll
                for (int bj = 0; bj < 2; ++bj)
#pragma unroll
                    for (int n = 0; n < 2; ++n) *(f32x4*)(rowp + bj * HALF + n * 16) = acc[ai][bj][m][n] + bv[bj][n]; }
    }
};
__device__ __forceinline__ void epi_dma(const void* src, PG8_LAS unsigned char* dst) { __builtin_amdgcn_global_load_lds((const unsigned*)src, (PG8_LAS unsigned*)dst, 16, 0, 0); }
__device__ __forceinline__ unsigned pk4_fp8(float a, float b, float c, float d) {
    a = __builtin_fminf(__builtin_fmaxf(a, -448.f), 448.f); b = __builtin_fminf(__builtin_fmaxf(b, -448.f), 448.f); c = __builtin_fminf(__builtin_fmaxf(c, -448.f), 448.f); d = __builtin_fminf(__builtin_fmaxf(d, -448.f), 448.f);
    int w = 0; w = __builtin_amdgcn_cvt_pk_fp8_f32(a, b, w, false); w = __builtin_amdgcn_cvt_pk_fp8_f32(c, d, w, true); return (unsigned)w; }
struct EpiSwiglu {
    static constexpr bool PERM = true, AFTER_DRAIN = false, HAS_MID = false, F8 = true, PREFETCH = true; static constexpr int WSCALE = 0x7A7A7A7A;
    unsigned char* O; const float* b1; PG8_LAS unsigned char* el;
    __device__ __forceinline__ void prefetch(const Unit& u, int slot, int wid, int lane) const {
        if (wid == 0) epi_dma(b1 + (size_t)u.be * 2048 + (lane >> 5) * 1024 + u.pn * HALF + (lane & 31) * 4, el + EPI_OFF + slot * 2048); }
    __device__ __forceinline__ void operator()(const f32x4 (&acc)[2][2][4][2], const Unit& u, int wr, int wc, int fr, int fq) const {
        const int row0 = u.pm * BM + wr * 64 + fr; const int ch0 = u.pn * HALF + wc * 32 + 8 * fq;
        const PG8_LAS float* bb = (const PG8_LAS float*)(el + EPI_OFF + u.es * 2048) + wc * 32 + 8 * fq;
        f32x4 bg[2], bu[2];
#pragma unroll
        for (int n = 0; n < 2; ++n) { bg[n] = *(const PG8_LAS f32x4*)(bb + 4 * n); bu[n] = *(const PG8_LAS f32x4*)(bb + 128 + 4 * n); }
#pragma unroll
        for (int ai = 0; ai < 2; ++ai)
#pragma unroll
            for (int m = 0; m < 4; ++m) { unsigned char* rowp = O + (size_t)(row0 + ai * HALF + m * 16) * 1024 + ch0;
                f32x4 a[2];
#pragma unroll
                for (int n = 0; n < 2; ++n) { const f32x4 g = acc[ai][0][m][n] + bg[n], up = acc[ai][1][m][n] + bu[n];
#pragma unroll
                    for (int e = 0; e < 4; ++e) { const float gg = fminf(g[e], 7.0f), uu = fminf(fmaxf(up[e], -7.0f), 7.0f);
                        const float sg = __builtin_amdgcn_rcpf(1.0f + __builtin_amdgcn_exp2f(-1.702f * 1.4426950408889634f * gg));
                        a[n][e] = (uu + 1.0f) * gg * sg; } }
                *(unsigned long long*)rowp = (unsigned long long)pk4_fp8(a[0][0], a[0][1], a[0][2], a[0][3]) | ((unsigned long long)pk4_fp8(a[1][0], a[1][1], a[1][2], a[1][3]) << 32); }
    }
};
struct EpiY {
    static constexpr bool PERM = true, AFTER_DRAIN = false, HAS_MID = false, F8 = true; static constexpr int WSCALE = 0x7A7A7A7A;
    unsigned char* O; const float* b2; const float* roww; PG8_LAS unsigned char* el;
    static constexpr bool PREFETCH = true;
    __device__ __forceinline__ void prefetch(const Unit& u, int slot, int wid, int lane) const {
        if (wid == 0) epi_dma(b2 + (size_t)u.be * 1024 + u.pn * BM + lane * 4, el + EPI_OFF + slot * 2048);
        if (wid == 1) epi_dma(roww + (size_t)u.pm * BM + lane * 4, el + EPI_OFF + slot * 2048 + 1024); }
    __device__ __forceinline__ void operator()(const f32x4 (&acc)[2][2][4][2], const Unit& u, int wr, int wc, int fr, int fq) const {
        const int row0 = u.pm * BM + wr * 64 + fr; const int col0 = u.pn * BM + wc * 32 + 8 * fq;
        const PG8_LAS float* sl = (const PG8_LAS float*)(el + EPI_OFF + u.es * 2048); const PG8_LAS float* bb = sl + wc * 32 + 8 * fq;
        f32x4 bv[2][2];
#pragma unroll
        for (int bj = 0; bj < 2; ++bj)
#pragma unroll
            for (int n = 0; n < 2; ++n) bv[bj][n] = *(const PG8_LAS f32x4*)(bb + bj * HALF + 4 * n);
#pragma unroll
        for (int ai = 0; ai < 2; ++ai)
#pragma unroll
            for (int m = 0; m < 4; ++m) { const int row = row0 + ai * HALF + m * 16; const float rw = sl[256 + ai * HALF + wr * 64 + m * 16 + fr] * 16.0f; unsigned char* rowp = O + (size_t)row * 1024 + col0;
#pragma unroll
                for (int bj = 0; bj < 2; ++bj) { const f32x4 v0 = (acc[ai][bj][m][0] + bv[bj][0]) * rw, v1 = (acc[ai][bj][m][1] + bv[bj][1]) * rw;
                    *(unsigned long long*)(rowp + bj * HALF) = (unsigned long long)pk4_fp8(v0[0], v0[1], v0[2], v0[3]) | ((unsigned long long)pk4_fp8(v1[0], v1[1], v1[2], v1[3]) << 32); } }
    }
};
struct MoeOrder {
    static constexpr bool GATHER = false;
    StaticOrder so; const int* blke;
    __device__ __forceinline__ bool next(int i, Unit& u) const { if (!so.next(i, u)) return false; u.be = blke[u.pm]; return true; }
    __device__ __forceinline__ void a_ready(const Unit&) const {}
    __device__ __forceinline__ void done(const Unit&) const {}
};
__device__ __forceinline__ void st_bf16x4(bf16_t* p, const f32x4& v) { *(unsigned long long*)p = (unsigned long long)cvt_pk_bf16(v[0], v[1]) | ((unsigned long long)cvt_pk_bf16(v[2], v[3]) << 32); }
template <bool F8_> struct EpiInProjT {
    static constexpr bool PERM = false, AFTER_DRAIN = false, HAS_MID = false, F8 = F8_, PREFETCH = true; static constexpr int WSCALE = F8_ ? 0x7A7A7A7A : 0x7F7F7F7F;
    bf16_t *QP, *KA, *VA, *HY, *GT; const float* bias; PG8_LAS unsigned char* el; int T_, SKV_, CTX_; unsigned* nmax;
    static constexpr int TAB_OFF = 131072 + 20480;
    __device__ __forceinline__ void prefetch(const Unit& u, int slot, int wid, int lane) const { if (wid == 0) epi_dma(bias + 256 * u.pn + lane * 4, el + EPI_OFF + slot * 2048); }
    __device__ __forceinline__ void operator()(const f32x4 (&acc)[2][2][4][2], const Unit& u, int wr, int wc, int fr_, int fq_) const {
        int fr = fr_, fq = fq_; asm volatile("" : "+v"(fr), "+v"(fq));
        const int pn = u.pn;
        if (pn < 4) {
            const bool isk = pn >= 2; const PG8_LAS float* g = (const PG8_LAS float*)(el + TAB_OFF + 8192 + (isk ? 256 : 0)); const PG8_LAS float* bsl = (const PG8_LAS float*)(el + EPI_OFF + u.es * 2048);
            const PG8_LAS float* rc = (const PG8_LAS float*)(el + TAB_OFF); const PG8_LAS float* rs = rc + 1024;
            f32x4 bv[2][2], gv[2][2];
#pragma unroll
            for (int bj = 0; bj < 2; ++bj)
#pragma unroll
                for (int n = 0; n < 2; ++n) { bv[bj][n] = *(const PG8_LAS f32x4*)(bsl + 64 * wc + 32 * bj + 16 * n + 4 * fq); gv[bj][n] = *(const PG8_LAS f32x4*)(g + 32 * bj + 16 * n + 4 * fq); }
            float nrm2 = 0.f;
#pragma unroll
            for (int ai = 0; ai < 2; ++ai)
#pragma unroll
                for (int m = 0; m < 4; ++m) { const int r = u.pm * BM + ai * HALF + wr * 64 + m * 16 + fr;
                    f32x4 x[2][2]; float ss = 0.f;
#pragma unroll
                    for (int bj = 0; bj < 2; ++bj)
#pragma unroll
                        for (int n = 0; n < 2; ++n) { x[bj][n] = acc[ai][bj][m][n] + bv[bj][n]; ss += (x[bj][n][0] * x[bj][n][0] + x[bj][n][1] * x[bj][n][1]) + (x[bj][n][2] * x[bj][n][2] + x[bj][n][3] * x[bj][n][3]); }
                    ss += __shfl_xor(ss, 16); ss += __shfl_xor(ss, 32);
                    const float rstd = rsqrtf(ss * (1.0f / 64.0f) + 1e-6f);
#pragma unroll
                    for (int bj = 0; bj < 2; ++bj)
#pragma unroll
                        for (int n = 0; n < 2; ++n) x[bj][n] = x[bj][n] * rstd * gv[bj][n];
                    { float s2 = 0.f;
#pragma unroll
                      for (int bj = 0; bj < 2; ++bj)
#pragma unroll
                        for (int n = 0; n < 2; ++n) s2 += (x[bj][n][0] * x[bj][n][0] + x[bj][n][1] * x[bj][n][1]) + (x[bj][n][2] * x[bj][n][2] + x[bj][n][3] * x[bj][n][3]);
                      s2 += __shfl_xor(s2, 16); s2 += __shfl_xor(s2, 32); nrm2 = fmaxf(nrm2, s2); }
                    const bool latent = r < T_; const int t = r & 4095;
                    if (latent) {
#pragma unroll
                        for (int bj = 0; bj < 2; ++bj) { const int pos = bj ? (t & 63) : (t >> 6); const f32x4 cs = *(const PG8_LAS f32x4*)(rc + pos * 16 + 4 * fq), sn = *(const PG8_LAS f32x4*)(rs + pos * 16 + 4 * fq);
                            const f32x4 x1 = x[bj][0], x2 = x[bj][1]; x[bj][0] = x1 * cs - x2 * sn; x[bj][1] = x2 * cs + x1 * sn; } }
                    if (!isk) { unsigned char* base = (unsigned char*)QP + (size_t)r * 512 + 256 * (pn & 1) + 64 * wc;
#pragma unroll
                        for (int bj = 0; bj < 2; ++bj)
#pragma unroll
                            for (int n = 0; n < 2; ++n) { const f32x4 v = x[bj][n] * 0.72134752044448170f; *(unsigned*)(base + 32 * bj + 16 * n + 4 * fq) = pk4_fp8(v[0], v[1], v[2], v[3]); } }
                    else { const size_t krow = latent ? (size_t)(r >> 12) * SKV_ + CTX_ + t : (size_t)((r - T_) >> 8) * SKV_ + ((r - T_) & 255); unsigned char* base = (unsigned char*)KA + krow * 512 + 256 * (pn & 1) + 64 * wc;
#pragma unroll
                        for (int bj = 0; bj < 2; ++bj)
#pragma unroll
                            for (int n = 0; n < 2; ++n) { const f32x4 v = x[bj][n]; *(unsigned*)(base + 32 * bj + 16 * n + 4 * fq) = pk4_fp8(v[0], v[1], v[2], v[3]); } }
                }
            nrm2 = fmaxf(nrm2, __shfl_xor(nrm2, 1)); nrm2 = fmaxf(nrm2, __shfl_xor(nrm2, 2)); nrm2 = fmaxf(nrm2, __shfl_xor(nrm2, 4)); nrm2 = fmaxf(nrm2, __shfl_xor(nrm2, 8));
            if (fr == 0 && fq == 0) (void)__hip_atomic_fetch_max(nmax + (isk ? 64 : 0), __float_as_uint(nrm2), __ATOMIC_RELAXED, __HIP_MEMORY_SCOPE_AGENT);
        } else {
            const int kind = pn < 6 ? 0 : (pn < 12 ? 1 : 2);
            const int lc0 = 32 * wc + 8 * fq;
            f32x4 bv[2][2];
#pragma unroll
            for (int bj = 0; bj < 2; ++bj)
#pragma unroll
                for (int n = 0; n < 2; ++n) bv[bj][n] = *(const PG8_LAS f32x4*)((const PG8_LAS float*)(el + EPI_OFF + u.es * 2048) + 128 * bj + lc0 + 4 * n);
#pragma unroll
            for (int ai = 0; ai < 2; ++ai)
#pragma unroll
                for (int m = 0; m < 4; ++m) { const int r = u.pm * BM + ai * HALF + wr * 64 + m * 16 + fr;
                    bf16_t* rowp;
                    if (kind == 0) { const size_t vrow = r < T_ ? (size_t)(r >> 12) * SKV_ + CTX_ + (r & 4095) : (size_t)((r - T_) >> 8) * SKV_ + ((r - T_) & 255); rowp = VA + vrow * 512 + 256 * (pn - 4) + lc0; }
                    else if (kind == 1) rowp = HY + (size_t)r * 1536 + 256 * (pn - 6) + lc0;
                    else rowp = GT + (size_t)r * 2048 + 256 * (pn - 12) + lc0;
#pragma unroll
                    for (int bj = 0; bj < 2; ++bj) { f32x4 v0 = acc[ai][bj][m][0] + bv[bj][0], v1 = acc[ai][bj][m][1] + bv[bj][1];
                        if (kind == 2) {
#pragma unroll
                            for (int e = 0; e < 4; ++e) { v0[e] = __builtin_amdgcn_rcpf(1.0f + __builtin_amdgcn_exp2f(-1.4426950408889634f * v0[e])); v1[e] = __builtin_amdgcn_rcpf(1.0f + __builtin_amdgcn_exp2f(-1.4426950408889634f * v1[e])); } }
                        u32x4 w; w.x = cvt_pk_bf16(v0[0], v0[1]); w.y = cvt_pk_bf16(v0[2], v0[3]); w.z = cvt_pk_bf16(v1[0], v1[1]); w.w = cvt_pk_bf16(v1[2], v1[3]);
                        *(u32x4*)(rowp + bj * HALF) = w; } }
        }
    }
};
typedef EpiInProjT<false> EpiInProj;
struct WinOrder {
    static constexpr bool GATHER = false;
    StaticOrder so; int pn0;
    __device__ __forceinline__ bool next(int i, Unit& u) const { if (!so.next(i, u)) return false; u.pn += pn0; return true; }
    __device__ __forceinline__ void a_ready(const Unit&) const {}
    __device__ __forceinline__ void done(const Unit&) const {}
};
struct CtxOrder {
    static constexpr bool GATHER = false;
    int G, c;
    __device__ __forceinline__ bool next(int i, Unit& u) const { const int L = i * G + c; if (L >= 32) return false; u.pm = 128 + (L & 7); u.pn = 2 + (L >> 3); u.be = 0; u.es = 0; return true; }
    __device__ __forceinline__ void a_ready(const Unit&) const {}
    __device__ __forceinline__ void done(const Unit&) const {}
};

__device__ __forceinline__ float bf_lo(unsigned d) { return __builtin_bit_cast(float, d << 16); }
__device__ __forceinline__ float bf_hi(unsigned d) { return __builtin_bit_cast(float, d & 0xffff0000u); }
struct EpiMerge {
    static constexpr bool PERM = true, AFTER_DRAIN = false, HAS_MID = true, F8 = false, PREFETCH = false; static constexpr int WSCALE = 0x7F7F7F7F;
    bf16_t* O; const bf16_t* GT;
    __device__ __forceinline__ void mid(f32x4 (&acc)[2][2][4][2], const Unit& u, int wr, int wc, int fr_, int fq_) const {
        int fr = fr_, fq = fq_; asm volatile("" : "+v"(fr), "+v"(fq));
        const bf16_t* __restrict__ G = GT;
        const int row0 = u.pm * BM + wr * 64 + fr, col0 = u.pn * BM + wc * 32 + 8 * fq;
#pragma unroll
        for (int ai = 0; ai < 2; ++ai)
#pragma unroll
            for (int mp = 0; mp < 2; ++mp) { u32x4 ga[2][2], gb[2][2];
#pragma unroll
                for (int q = 0; q < 2; ++q) { const bf16_t* gp = G + (size_t)(row0 + ai * HALF + (2 * mp + q) * 16) * 2048 + col0;
#pragma unroll
                    for (int bj = 0; bj < 2; ++bj) { ga[q][bj] = *(const u32x4*)(gp + bj * HALF); gb[q][bj] = *(const u32x4*)(gp + 1024 + bj * HALF); } }
#pragma unroll
                for (int q = 0; q < 2; ++q) { const int m = 2 * mp + q;
#pragma unroll
                    for (int bj = 0; bj < 2; ++bj) { const u32x4 a = ga[q][bj], b = gb[q][bj]; f32x4 r0, r1;
                        r0[0] = bf_lo(a.x) * __builtin_amdgcn_rcpf(bf_lo(b.x)); r0[1] = bf_hi(a.x) * __builtin_amdgcn_rcpf(bf_hi(b.x)); r0[2] = bf_lo(a.y) * __builtin_amdgcn_rcpf(bf_lo(b.y)); r0[3] = bf_hi(a.y) * __builtin_amdgcn_rcpf(bf_hi(b.y));
                        r1[0] = bf_lo(a.z) * __builtin_amdgcn_rcpf(bf_lo(b.z)); r1[1] = bf_hi(a.z) * __builtin_amdgcn_rcpf(bf_hi(b.z)); r1[2] = bf_lo(a.w) * __builtin_amdgcn_rcpf(bf_lo(b.w)); r1[3] = bf_hi(a.w) * __builtin_amdgcn_rcpf(bf_hi(b.w));
                        acc[ai][bj][m][0] = acc[ai][bj][m][0] * r0; acc[ai][bj][m][1] = acc[ai][bj][m][1] * r1; } }
                asm volatile("" ::: "memory"); }
    }
    __device__ __forceinline__ void operator()(const f32x4 (&acc)[2][2][4][2], const Unit& u, int wr, int wc, int fr, int fq) const {
        const bf16_t* __restrict__ G = GT; bf16_t* __restrict__ Or = O;
        const int row0 = u.pm * BM + wr * 64 + fr, col0 = u.pn * BM + wc * 32 + 8 * fq;
#pragma unroll
        for (int ai = 0; ai < 2; ++ai) { u32x4 gb[4][2];
#pragma unroll
            for (int m = 0; m < 4; ++m)
#pragma unroll
                for (int bj = 0; bj < 2; ++bj) gb[m][bj] = *(const u32x4*)(G + (size_t)(row0 + ai * HALF + m * 16) * 2048 + 1024 + col0 + bj * HALF);
#pragma unroll
            for (int m = 0; m < 4; ++m) { bf16_t* rowp = Or + (size_t)(row0 + ai * HALF + m * 16) * 1024 + col0;
#pragma unroll
                for (int bj = 0; bj < 2; ++bj) { const u32x4 b = gb[m][bj]; const f32x4 v0 = acc[ai][bj][m][0], v1 = acc[ai][bj][m][1];
                    u32x4 w; w.x = cvt_pk_bf16(v0[0] * bf_lo(b.x), v0[1] * bf_hi(b.x)); w.y = cvt_pk_bf16(v0[2] * bf_lo(b.y), v0[3] * bf_hi(b.y));
                    w.z = cvt_pk_bf16(v1[0] * bf_lo(b.z), v1[1] * bf_hi(b.z)); w.w = cvt_pk_bf16(v1[2] * bf_lo(b.w), v1[3] * bf_hi(b.w));
                    *(u32x4*)(rowp + bj * HALF) = w; } } }
    }
};
struct EpiWout {
    static constexpr bool PERM = false, AFTER_DRAIN = false, HAS_MID = false, F8 = false, PREFETCH = false; static constexpr int WSCALE = 0x7F7F7F7F;
    const float* X; float* O; const float* MOD; float* SSQ;
    __device__ __forceinline__ void operator()(const f32x4 (&acc)[2][2][4][2], const Unit& u, int wr, int wc, int fr, int fq) const {
        const float* __restrict__ Xr = X; float* __restrict__ Or = O; float* __restrict__ Sr = SSQ;
        const int row0 = u.pm * BM + wr * 64 + fr, col0 = u.pn * BM + wc * 32 + 4 * fq;
        const float* g1p = MOD + (row0 >> 12) * 6144 + 2048 + col0;
        f32x4 g1[2][2];
#pragma unroll
        for (int bj = 0; bj < 2; ++bj)
#pragma unroll
            for (int n = 0; n < 2; ++n) g1[bj][n] = *(const f32x4*)(g1p + bj * HALF + n * 16);
#pragma unroll
        for (int ai = 0; ai < 2; ++ai)
#pragma unroll
            for (int mp = 0; mp < 2; ++mp) { f32x4 xv[2][2][2];
#pragma unroll
                for (int q = 0; q < 2; ++q) { const size_t off = (size_t)(row0 + ai * HALF + (2 * mp + q) * 16) * 1024 + col0;
#pragma unroll
                    for (int bj = 0; bj < 2; ++bj)
#pragma unroll
                        for (int n = 0; n < 2; ++n) xv[q][bj][n] = *(const f32x4*)(Xr + off + bj * HALF + n * 16); }
#pragma unroll
                for (int q = 0; q < 2; ++q) { const int m = 2 * mp + q; const int row = row0 + ai * HALF + m * 16; const size_t off = (size_t)row * 1024 + col0; float ss = 0.f;
#pragma unroll
                    for (int bj = 0; bj < 2; ++bj)
#pragma unroll
                        for (int n = 0; n < 2; ++n) { const f32x4 v = xv[q][bj][n] + g1[bj][n] * acc[ai][bj][m][n];
                            *(f32x4*)(Or + off + bj * HALF + n * 16) = v; ss += (v[0] * v[0] + v[1] * v[1]) + (v[2] * v[2] + v[3] * v[3]); }
                    ss += __shfl_xor(ss, 16); ss += __shfl_xor(ss, 32);
                    if (fq == 0) Sr[(size_t)row * 16 + u.pn * 4 + wc] = ss; } }
    }
};

struct MoeGatherOrder {
    static constexpr bool GATHER = true;
    StaticOrder so; const int* blke; const PG8_LAS unsigned short* tokl;
    __device__ __forceinline__ bool next(int i, Unit& u) const { if (!so.next(i, u)) return false; u.be = blke[u.pm]; return true; }
    __device__ __forceinline__ int gather_tok(int ui, int row) const { return (int)tokl[ui * 256 + row]; }
    __device__ __forceinline__ void a_ready(const Unit&) const {}
    __device__ __forceinline__ void done(const Unit&) const {}
};
template <bool F8> struct FragT { typedef bf16x8 A[4][2]; typedef bf16x8 B[2][2]; };
template <> struct FragT<true> { typedef v8i_t A[4]; typedef v8i_t B[2]; };
template <class Epi, class Sched, bool ALIGN_EPI = false, bool SP2 = false>
__device__ __forceinline__ void gemm_phase(PG8_LAS unsigned char* lds, const Gemm g, const Sched& S, const Epi& E) {
    const int tid = threadIdx.x, wid = __builtin_amdgcn_readfirstlane(tid >> 6), lane = tid & 63, wr = wid >> 2, wc = wid & 3, fr = lane & 15, fq = lane >> 4;
    const int K = g.K, nt = K / BK;
    unsigned voffA[2], voffB[2];
#pragma unroll
    for (int i = 0; i < 2; ++i) { int R, C; stage_rc(tid * 16 + i * 8192, R, C); const int Rb = Epi::PERM ? ((R & ~31) + perm32(R & 31)) : R;
        voffA[i] = (unsigned)(R * K + C) * 2u; voffB[i] = (unsigned)(Rb * K + C) * 2u; }
    const size_t kstep = (size_t)(BK * 2);
    const size_t hstep = (size_t)HALF * K * 2;
    const size_t tstep = 2 * hstep;
    const unsigned ldsw = (unsigned)wid * 1024u;
    const int aoff = lds_byte(wr * 64 + fr, fq * 8), boff = lds_byte(wc * 32 + fr, fq * 8);
    const int aoff8 = lds_byte(wr * 64 + fr, 32 * (fq >> 1) + 16 * (fq & 1)), boff8 = lds_byte(wc * 32 + fr, 32 * (fq >> 1) + 16 * (fq & 1));
#define PG8_SA(b, h) (((b) * 2 + (h)) * HTB)
#define PG8_SB(b, h) ((4 + (b) * 2 + (h)) * HTB)
#define PG8_STAGE(bufoff, gbase, voff) do { _Pragma("unroll") for (int _i = 0; _i < 2; ++_i) \
        __builtin_amdgcn_global_load_lds((const unsigned*)((const char*)(gbase) + (voff)[_i]), (PG8_LAS unsigned*)(lds + (bufoff) + ldsw + _i * 8192), 16, 0, 0); } while (0)
#define PG8_STAGE_A(bufoff, gbase, h, nx) do { if constexpr (Sched::GATHER) { unsigned gv_[2]; \
        if (nx) { _Pragma("unroll") for (int i_ = 0; i_ < 2; ++i_) { int R_, C_; stage_rc(tid * 16 + i_ * 8192, R_, C_); gv_[i_] = (unsigned)(S.gather_tok(ui + 1, 128 * (h) + R_) * K + C_) * 2u; } } \
        else { gv_[0] = cvA[h][0]; gv_[1] = cvA[h][1]; } \
        PG8_STAGE(bufoff, gbase, gv_); } \
        else { PG8_STAGE(bufoff, (gbase) + (h) * hstep, voffA); } } while (0)
#define PG8_LD32(off_) __builtin_shufflevector(__builtin_bit_cast(v4i_t, *(const PG8_LAS bf16x8*)(lds + (off_))), __builtin_bit_cast(v4i_t, *(const PG8_LAS bf16x8*)(lds + (off_) + 16)), 0, 1, 2, 3, 4, 5, 6, 7)
#define PG8_LDA(dst, b, h) do { if constexpr (Epi::F8) { _Pragma("unroll") for (int m = 0; m < 4; ++m) dst[m] = PG8_LD32(PG8_SA(b, h) + aoff8 + m * 2048); } else { \
        _Pragma("unroll") for (int m = 0; m < 4; ++m) _Pragma("unroll") for (int k = 0; k < 2; ++k) dst[m][k] = *(const PG8_LAS bf16x8*)(lds + PG8_SA(b, h) + aoff + m * 2048 + k * 1024); } } while (0)
#define PG8_LDB(dst, b, h) do { if constexpr (Epi::F8) { _Pragma("unroll") for (int n = 0; n < 2; ++n) dst[n] = PG8_LD32(PG8_SB(b, h) + boff8 + n * 2048); } else { \
        _Pragma("unroll") for (int n = 0; n < 2; ++n) _Pragma("unroll") for (int k = 0; k < 2; ++k) dst[n][k] = *(const PG8_LAS bf16x8*)(lds + PG8_SB(b, h) + boff + n * 2048 + k * 1024); } } while (0)
#define PG8_MMA(ai, bj, At, Bt) do { __builtin_amdgcn_s_setprio(1); if constexpr (Epi::F8) { \
        _Pragma("unroll") for (int m = 0; m < 4; ++m) _Pragma("unroll") for (int n = 0; n < 2; ++n) \
            acc[ai][bj][m][n] = __builtin_amdgcn_mfma_scale_f32_16x16x128_f8f6f4(Bt[n], At[m], acc[ai][bj][m][n], 0, 0, 0, Epi::WSCALE, 0, 0x7F7F7F7F); \
        _Pragma("unroll") for (int m = 0; m < 4; ++m) _Pragma("unroll") for (int n = 0; n < 2; ++n) asm volatile("" : "+v"(acc[ai][bj][m][n])); } else { \
        _Pragma("unroll") for (int m = 0; m < 4; ++m) _Pragma("unroll") for (int n = 0; n < 2; ++n) _Pragma("unroll") for (int k = 0; k < 2; ++k) \
        acc[ai][bj][m][n] = __builtin_amdgcn_mfma_f32_16x16x32_bf16(Bt[n][k], At[m][k], acc[ai][bj][m][n], 0, 0, 0); } __builtin_amdgcn_s_setprio(0); } while (0)
#define PG8_WAIT_V(n) asm volatile("s_waitcnt vmcnt(" #n ")" ::: "memory")
#define PG8_WAIT_L(n) asm volatile("s_waitcnt lgkmcnt(" #n ")" ::: "memory")
#define PG8_BAR __builtin_amdgcn_s_barrier()
#define PG8_SCHED __builtin_amdgcn_sched_barrier(0)
    Unit cur, nxt; int ui = 0;
    if (!S.next(0, cur)) return;
    f32x4 acc[2][2][4][2];
#pragma unroll
    for (int a = 0; a < 2; ++a)
#pragma unroll
        for (int b = 0; b < 2; ++b)
#pragma unroll
            for (int m = 0; m < 4; ++m)
#pragma unroll
                for (int n = 0; n < 2; ++n) acc[a][b][m][n] = (f32x4){0.f, 0.f, 0.f, 0.f};
    typename FragT<Epi::F8>::A At; typename FragT<Epi::F8>::B B0, B1;
    const char* cA = (const char*)g.A + (Sched::GATHER ? (size_t)0 : (size_t)cur.pm * tstep);
    unsigned cvA[2][2];
    if constexpr (Sched::GATHER) {
#pragma unroll
        for (int h = 0; h < 2; ++h)
#pragma unroll
            for (int i = 0; i < 2; ++i) { int R, Cc; stage_rc(tid * 16 + i * 8192, R, Cc); cvA[h][i] = (unsigned)(S.gather_tok(0, 128 * h + R) * K + Cc) * 2u; } } const char* cB = (const char*)g.Bt + (size_t)cur.be * g.bstride + (size_t)cur.pn * tstep;
    S.a_ready(cur);
    if constexpr (Epi::PREFETCH) E.prefetch(cur, 0, wid, lane);
    if constexpr (SP2) {
        PG8_STAGE(PG8_SB(0, 0), cB, voffB); PG8_STAGE(PG8_SB(0, 1), cB + hstep, voffB); PG8_STAGE_A(PG8_SA(0, 0), cA, 0, false); PG8_STAGE_A(PG8_SA(0, 1), cA, 1, false);
        if (wr == 1) PG8_BAR;
        PG8_WAIT_V(2); PG8_BAR;
        PG8_STAGE(PG8_SB(1, 0), cB + kstep, voffB); PG8_STAGE_A(PG8_SA(1, 0), cA + kstep, 0, false); PG8_STAGE(PG8_SB(1, 1), cB + hstep + kstep, voffB);
        PG8_WAIT_V(6); PG8_BAR;
    } else {
        PG8_STAGE(PG8_SB(0, 0), cB, voffB); PG8_STAGE_A(PG8_SA(0, 0), cA, 0, false); PG8_STAGE(PG8_SB(0, 1), cB + hstep, voffB); PG8_STAGE_A(PG8_SA(0, 1), cA, 1, false);
        if (wr == 1) PG8_BAR;
        PG8_WAIT_V(4); PG8_BAR;
        PG8_STAGE(PG8_SB(1, 0), cB + kstep, voffB); PG8_STAGE_A(PG8_SA(1, 0), cA + kstep, 0, false); PG8_STAGE(PG8_SB(1, 1), cB + hstep + kstep, voffB);
        PG8_WAIT_V(6); PG8_BAR;
    }
    for (;;) {
        const bool has_next = S.next(ui + 1, nxt);
        const char* nA = (has_next && !Sched::GATHER) ? (const char*)g.A + (size_t)nxt.pm * tstep : cA;
 const char* nB = has_next ? (const char*)g.Bt + (size_t)nxt.be * g.bstride + (size_t)nxt.pn * tstep : cB;
        for (int t = 0; t < nt; t += 2) {
            const bool last = (t == nt - 2);
            const char* a1 = cA + (size_t)(t + 1) * kstep;
            const char* a2 = last ? nA : cA + (size_t)(t + 2) * kstep; const char* b2 = last ? nB : cB + (size_t)(t + 2) * kstep;
            const char* a3 = a2 + kstep; const char* b3 = b2 + kstep;
            if (last && has_next) S.a_ready(nxt);
            if constexpr (Epi::HAS_MID) { if (t == nt / 2) E.mid(acc, cur, wr, wc, fr, fq); }
            if constexpr (SP2) {
            PG8_LDB(B0, 0, 0); PG8_LDB(B1, 0, 1); PG8_SCHED; PG8_LDA(At, 0, 0); PG8_STAGE_A(PG8_SA(1, 1), a1, 1, false);
            PG8_WAIT_V(8); PG8_WAIT_L(0); PG8_BAR; PG8_MMA(0, 0, At, B0); PG8_MMA(0, 1, At, B1); PG8_BAR; PG8_SCHED;
            PG8_LDA(At, 0, 1); PG8_STAGE(PG8_SB(0, 0), b2, voffB); PG8_STAGE(PG8_SB(0, 1), b2 + hstep, voffB); PG8_STAGE_A(PG8_SA(0, 0), a2, 0, last && has_next);
            PG8_WAIT_V(8); PG8_WAIT_L(0); PG8_BAR; PG8_MMA(1, 0, At, B0); PG8_MMA(1, 1, At, B1); PG8_BAR; PG8_SCHED;
            PG8_LDB(B0, 1, 0); PG8_LDB(B1, 1, 1); PG8_SCHED; PG8_LDA(At, 1, 0); PG8_STAGE_A(PG8_SA(0, 1), a2, 1, last && has_next);
            PG8_WAIT_V(8); PG8_WAIT_L(0); PG8_BAR; PG8_MMA(0, 0, At, B0); PG8_MMA(0, 1, At, B1); PG8_BAR; PG8_SCHED;
            PG8_LDA(At, 1, 1); PG8_STAGE(PG8_SB(1, 0), b3, voffB); PG8_STAGE(PG8_SB(1, 1), b3 + hstep, voffB); PG8_STAGE_A(PG8_SA(1, 0), a3, 0, last && has_next);
            PG8_WAIT_V(8); PG8_WAIT_L(0); PG8_BAR; PG8_MMA(1, 0, At, B0); PG8_MMA(1, 1, At, B1); PG8_BAR; PG8_SCHED;
            } else {
            PG8_LDB(B0, 0, 0); PG8_SCHED; PG8_LDA(At, 0, 0); PG8_STAGE_A(PG8_SA(1, 1), a1, 1, false);
            PG8_WAIT_L(8); PG8_BAR; PG8_WAIT_L(0); PG8_MMA(0, 0, At, B0); PG8_BAR; PG8_SCHED;
            PG8_LDB(B1, 0, 1); PG8_STAGE(PG8_SB(0, 0), b2, voffB);
            PG8_BAR; PG8_WAIT_L(0); PG8_MMA(0, 1, At, B1); PG8_BAR;
            PG8_LDA(At, 0, 1); PG8_STAGE_A(PG8_SA(0, 0), a2, 0, last && has_next);
            PG8_BAR; PG8_WAIT_L(0); PG8_MMA(1, 0, At, B0); PG8_BAR; PG8_SCHED;
            PG8_STAGE(PG8_SB(0, 1), b2 + hstep, voffB);
            PG8_WAIT_V(6); PG8_BAR; PG8_MMA(1, 1, At, B1); PG8_BAR;
            PG8_LDB(B0, 1, 0); PG8_SCHED; PG8_LDA(At, 1, 0); PG8_STAGE_A(PG8_SA(0, 1), a2, 1, last && has_next);
            PG8_WAIT_L(8); PG8_BAR; PG8_WAIT_L(0); PG8_MMA(0, 0, At, B0); PG8_BAR; PG8_SCHED;
            PG8_LDB(B1, 1, 1); PG8_STAGE(PG8_SB(1, 0), b3, voffB);
            PG8_BAR; PG8_WAIT_L(0); PG8_MMA(0, 1, At, B1); PG8_BAR;
            PG8_LDA(At, 1, 1); PG8_STAGE_A(PG8_SA(1, 0), a3, 0, last && has_next);
            PG8_BAR; PG8_WAIT_L(0); PG8_MMA(1, 0, At, B0); PG8_BAR; PG8_SCHED;
            PG8_STAGE(PG8_SB(1, 1), b3 + hstep, voffB);
            PG8_WAIT_V(6); PG8_BAR; PG8_MMA(1, 1, At, B1); PG8_BAR;
            }
        }
        if constexpr (ALIGN_EPI) { if (wr == 0) PG8_BAR; }
        if constexpr (!Epi::AFTER_DRAIN) { cur.es = ui & 1; E(acc, cur, wr, wc, fr, fq); S.done(cur); }
        if (!has_next) break;
        if constexpr (Epi::PREFETCH) E.prefetch(nxt, (ui + 1) & 1, wid, lane);
#pragma unroll
        for (int a = 0; a < 2; ++a)
#pragma unroll
            for (int b = 0; b < 2; ++b)
#pragma unroll
                for (int m = 0; m < 4; ++m)
#pragma unroll
                    for (int n = 0; n < 2; ++n) acc[a][b][m][n] = (f32x4){0.f, 0.f, 0.f, 0.f};
        cur = nxt; cA = nA; cB = nB; ++ui;
        if constexpr (Sched::GATHER) {
#pragma unroll
            for (int h = 0; h < 2; ++h)
#pragma unroll
                for (int i = 0; i < 2; ++i) { int R, Cc; stage_rc(tid * 16 + i * 8192, R, Cc); cvA[h][i] = (unsigned)(S.gather_tok(ui, 128 * h + R) * K + Cc) * 2u; } }
        if constexpr (ALIGN_EPI) { if (wr == 1) PG8_BAR; }
    }
    PG8_WAIT_V(0);
    if constexpr (!ALIGN_EPI) { if (wr == 0) PG8_BAR; }
    PG8_BAR;
    if constexpr (Epi::AFTER_DRAIN) { E.fused(acc, cur, wr, wc, fr, fq, lds, wid, lane); S.done(cur); }
#undef PG8_SA
#undef PG8_SB
#undef PG8_STAGE
#undef PG8_STAGE_A
#undef PG8_LD32
#undef PG8_LDA
#undef PG8_LDB
#undef PG8_MMA
#undef PG8_WAIT_V
#undef PG8_WAIT_L
#undef PG8_BAR
#undef PG8_SCHED
}
}
namespace att {
using bf16 = __hip_bfloat16;
constexpr int   D = 128, NW = 8, QBLK = 32, KVBLK = 64;
constexpr float SCALE = 0.125f;
constexpr float THR = 8.f;
constexpr int SDEPTH = 2;
constexpr int LDQ = 8 * D, LDK = 4 * D, LDO = LDQ;
constexpr size_t SHM_V = KVBLK * D * 2, SHM_K = KVBLK * D * 2, SHM_ATTN = 2 * SHM_V + 2 * SHM_K + NW * 64 * 4;
using bf16x8 = __attribute__((ext_vector_type(8))) short;
using s16x4  = __attribute__((ext_vector_type(4))) short;
using f32x16 = __attribute__((ext_vector_type(16))) float;
using f32x8  = __attribute__((ext_vector_type(8))) float;
using u32x4  = __attribute__((ext_vector_type(4))) unsigned;
#define KSWZ(row, colB) ((row) * 256 + ((colB) ^ (((row) & 7) << 4)))
#define SBAR() __builtin_amdgcn_sched_barrier(0)
__device__ __forceinline__ int crow(int r, int hi) { return (r & 3) + 8 * (r >> 2) + 4 * hi; }
__device__ __forceinline__ unsigned cvtpk(float lo, float hi) {
  unsigned r; asm volatile("v_cvt_pk_bf16_f32 %0, %1, %2" : "=v"(r) : "v"(lo), "v"(hi)); return r;
}
template <typename TIn> struct Stage;
template <> struct Stage<bf16>  { using T = bf16x8;
  __device__ static __forceinline__ T ld8(const bf16* p) { return *reinterpret_cast<const bf16x8*>(p); }
  __device__ static __forceinline__ bf16x8 tobf(T x) { return x; } };
template <> struct Stage<float> { using T = f32x8;
  __device__ static __forceinline__ T ld8(const float* p) { return *reinterpret_cast<const f32x8*>(p); }
  __device__ static __forceinline__ bf16x8 tobf(T x) {
    u32x4 w = {cvtpk(x[0], x[1]), cvtpk(x[2], x[3]), cvtpk(x[4], x[5]), cvtpk(x[6], x[7])}; return *reinterpret_cast<bf16x8*>(&w); } };

__device__ __forceinline__ void partialSM(f32x16& p0, f32x16& p1, float& m_reg, float& mn, float& alpha) {
  constexpr float C = SCALE * 1.4426950408889634f;
  float pmax = p0[0]; for (int r = 1; r < 16; ++r) pmax = fmaxf(pmax, p0[r]); for (int r = 0; r < 16; ++r) pmax = fmaxf(pmax, p1[r]);
  { auto rr = __builtin_amdgcn_permlane32_swap(__float_as_uint(pmax), __float_as_uint(pmax), false, false);
    pmax = fmaxf(__uint_as_float(rr[0]), __uint_as_float(rr[1])); }
  if (__builtin_expect(__all(pmax - m_reg <= THR / SCALE), 1)) { mn = m_reg; alpha = 1.f; }
  else { mn = fmaxf(m_reg, pmax); alpha = __builtin_amdgcn_exp2f((m_reg - mn) * C); m_reg = mn; }
  float mnC = -mn * C;
  for (int r = 0; r < 16; ++r) p0[r] = fmaf(p0[r], C, mnC); for (int r = 0; r < 16; ++r) p1[r] = fmaf(p1[r], C, mnC);
  for (int r = 0; r < 16; ++r) p0[r] = __builtin_amdgcn_exp2f(p0[r]);
}
__device__ __forceinline__ void finishSM(f32x16& p0, f32x16& p1, float alpha, float& l_reg, bf16x8& pa0, bf16x8& pa1, bf16x8& pa2, bf16x8& pa3) {
  for (int r = 0; r < 16; ++r) p1[r] = __builtin_amdgcn_exp2f(p1[r]);
  float ps = 0; for (int r = 0; r < 16; ++r) ps += p0[r]; for (int r = 0; r < 16; ++r) ps += p1[r];
  { auto rr = __builtin_amdgcn_permlane32_swap(__float_as_uint(ps), __float_as_uint(ps), false, false);
    ps = __uint_as_float(rr[0]) + __uint_as_float(rr[1]); }
  l_reg = l_reg * alpha + ps;
#define PK4(P, BASE, OUT) do { unsigned a0 = cvtpk(P[BASE + 0], P[BASE + 1]), a1 = cvtpk(P[BASE + 2], P[BASE + 3]);   \
    unsigned b0 = cvtpk(P[BASE + 4], P[BASE + 5]), b1 = cvtpk(P[BASE + 6], P[BASE + 7]);                              \
    auto r0 = __builtin_amdgcn_permlane32_swap(a0, b0, false, false); auto r1 = __builtin_amdgcn_permlane32_swap(a1, b1, false, false); \
    u32x4 w = {r0[0], r1[0], r0[1], r1[1]}; OUT = *reinterpret_cast<bf16x8*>(&w); } while (0)
  PK4(p0, 0, pa0); PK4(p0, 8, pa1); PK4(p1, 0, pa2); PK4(p1, 8, pa3);
#undef PK4
}
__device__ __forceinline__ void qkt(f32x16& p0, f32x16& p1, const bf16* Ks, const bf16x8* qr, int r32, int hi) {
  p0 = f32x16{}; p1 = f32x16{};
  for (int d0 = 0; d0 < 8; ++d0) { int cb = (d0 * 16 + hi * 8) * 2;
    bf16x8 b0 = *reinterpret_cast<const bf16x8*>((const char*)Ks + KSWZ(r32, cb));
    bf16x8 b1 = *reinterpret_cast<const bf16x8*>((const char*)Ks + KSWZ(32 + r32, cb));
    p0 = __builtin_amdgcn_mfma_f32_32x32x16_bf16(b0, qr[d0], p0, 0, 0, 0);
    p1 = __builtin_amdgcn_mfma_f32_32x32x16_bf16(b1, qr[d0], p1, 0, 0, 0); }
}
__device__ __forceinline__ int v_st(int k, int c) { const int kk = (k & ~0xC) | ((k & 4) << 1) | ((k & 8) >> 1); return ((kk >> 3) * 4 + (c >> 5)) * 512 + ((kk & 7) * 32 + (c & 31)) * 2; }
__device__ __forceinline__ int v_rd_base(int lane) { return ((lane & 3) << 3) | (((lane >> 2) & 3) << 6) | (((lane >> 4) & 1) << 5) | (((lane >> 5) & 1) << 8); }
constexpr int v_rd_off(int d0, int ks, int half) { return d0 * 512 + ks * 4096 + half * 2048; }
template <int OFF> __device__ __forceinline__ s16x4 tr_read(int vb) {
  s16x4 r; asm volatile("ds_read_b64_tr_b16 %0, %1 offset:%2" : "=&v"(r) : "v"(vb), "i"(OFF) : "memory"); return r;
}
template <int D0> __device__ __forceinline__ void pv_one(f32x16& od, int vb, bf16x8 pa0, bf16x8 pa1, bf16x8 pa2, bf16x8 pa3) {
  const s16x4 l0 = tr_read<v_rd_off(D0, 0, 0)>(vb), h0 = tr_read<v_rd_off(D0, 0, 1)>(vb), l1 = tr_read<v_rd_off(D0, 1, 0)>(vb), h1 = tr_read<v_rd_off(D0, 1, 1)>(vb);
  const s16x4 l2 = tr_read<v_rd_off(D0, 2, 0)>(vb), h2 = tr_read<v_rd_off(D0, 2, 1)>(vb), l3 = tr_read<v_rd_off(D0, 3, 0)>(vb), h3 = tr_read<v_rd_off(D0, 3, 1)>(vb);
  asm volatile("s_waitcnt lgkmcnt(0)" ::: "memory"); SBAR();
#define PK(L, H) (bf16x8){L[0], L[1], L[2], L[3], H[0], H[1], H[2], H[3]}
  od = __builtin_amdgcn_mfma_f32_32x32x16_bf16(pa0, PK(l0, h0), od, 0, 0, 0);
  od = __builtin_amdgcn_mfma_f32_32x32x16_bf16(pa1, PK(l1, h1), od, 0, 0, 0);
  od = __builtin_amdgcn_mfma_f32_32x32x16_bf16(pa2, PK(l2, h2), od, 0, 0, 0);
  od = __builtin_amdgcn_mfma_f32_32x32x16_bf16(pa3, PK(l3, h3), od, 0, 0, 0);
#undef PK
}
__device__ __forceinline__ void pv_d0(f32x16* o, int vb, bf16x8 pa0, bf16x8 pa1, bf16x8 pa2, bf16x8 pa3) {
  pv_one<0>(o[0], vb, pa0, pa1, pa2, pa3); pv_one<1>(o[1], vb, pa0, pa1, pa2, pa3); pv_one<2>(o[2], vb, pa0, pa1, pa2, pa3); pv_one<3>(o[3], vb, pa0, pa1, pa2, pa3);
}

template <typename TQ>
__device__ __forceinline__ void attn_dense_body(const TQ* __restrict__ Qb, const bf16* __restrict__ Kh, const bf16* __restrict__ Vh,
                                                float* __restrict__ Ob, int seq, char* lds) {
  using St = Stage<bf16>; using SQ = Stage<TQ>;
  const int tid = threadIdx.x, wid = tid >> 6, lane = tid & 63, r32 = lane & 31, hi = lane >> 5;
  bf16* V_lds = (bf16*)lds; bf16* K_lds = (bf16*)(lds + 2 * SHM_V);
  float* ws = (float*)(lds + 2 * SHM_V + 2 * SHM_K) + wid * 64; float* li_l = ws; float* al_l = ws + 32;
  float m_reg = -1e30f, l_reg = 0; f32x16 o[4] = {}; bf16x8 qr[8];
  const TQ* Qw = Qb + (long)(wid * QBLK + r32) * LDQ + hi * 8;
#pragma unroll
  for (int d0 = 0; d0 < 8; ++d0) qr[d0] = SQ::tobf(SQ::ld8(Qw + d0 * 16));
  const int sr = tid >> 4, sc = (tid & 15) * 8, vst0 = v_st(sr, sc), vst1 = v_st(32 + sr, sc);
  const int vb0 = (int)(uintptr_t)V_lds + v_rd_base(lane);
  struct { typename St::T vs0, vs1, ks0, ks1; } sr_[SDEPTH];
#define SLOAD(i, k0) do { sr_[i].vs0 = St::ld8(&Vh[(long)((k0) + sr) * LDK + sc]); sr_[i].vs1 = St::ld8(&Vh[(long)((k0) + 32 + sr) * LDK + sc]); \
    sr_[i].ks0 = St::ld8(&Kh[(long)((k0) + sr) * LDK + sc]); sr_[i].ks1 = St::ld8(&Kh[(long)((k0) + 32 + sr) * LDK + sc]); } while (0)
#define SWRITE(b, i) do { *(bf16x8*)((char*)V_lds + (b) * SHM_V + vst0) = St::tobf(sr_[i].vs0);          \
    *(bf16x8*)((char*)V_lds + (b) * SHM_V + vst1) = St::tobf(sr_[i].vs1); int kc = sc * 2;               \
    *(bf16x8*)((char*)K_lds + (b) * SHM_K + KSWZ(sr, kc)) = St::tobf(sr_[i].ks0);                       \
    *(bf16x8*)((char*)K_lds + (b) * SHM_K + KSWZ(32 + sr, kc)) = St::tobf(sr_[i].ks1); } while (0)
#define SWAIT() do { if constexpr (SDEPTH == 2) asm volatile("s_waitcnt vmcnt(4)" ::: "memory"); else asm volatile("s_waitcnt vmcnt(0)" ::: "memory"); } while (0)
#define RESC(a) do { if (__any((a) < 1.f)) { if (hi == 0) al_l[r32] = (a); asm volatile("s_waitcnt lgkmcnt(0)" ::: "memory"); \
    for (int d = 0; d < 4; ++d) for (int r = 0; r < 16; ++r) o[d][r] *= al_l[crow(r, hi)]; } } while (0)
  f32x16 pA0, pA1, pB0, pB1; float mnA, mnB, alA, alB; bf16x8 pa0, pa1, pa2, pa3; const int NT = seq / KVBLK;
  constexpr int SE = 0, SO = SDEPTH - 1;
  SLOAD(SE, 0); asm volatile("s_waitcnt vmcnt(0)" ::: "memory"); SWRITE(0, SE); __syncthreads();
  qkt(pA0, pA1, K_lds, qr, r32, hi); partialSM(pA0, pA1, m_reg, mnA, alA);
  SLOAD(SO, KVBLK); if constexpr (SDEPTH == 2) { if (2 < NT) SLOAD(SE, 2 * KVBLK); }
  SWAIT(); SWRITE(1, SO); __syncthreads();
  for (int j = 1; j + 1 < NT; j += 2) {
    SBAR(); qkt(pB0, pB1, (bf16*)((char*)K_lds + SHM_K), qr, r32, hi);
    finishSM(pA0, pA1, alA, l_reg, pa0, pa1, pa2, pa3); SBAR();
    SLOAD(SO, (j + SDEPTH) * KVBLK); SBAR();
    pv_d0(o, vb0, pa0, pa1, pa2, pa3); partialSM(pB0, pB1, m_reg, mnB, alB);
    __syncthreads(); SWAIT(); SWRITE(0, SE);
    RESC(alB); __syncthreads();
    SBAR(); qkt(pA0, pA1, K_lds, qr, r32, hi);
    finishSM(pB0, pB1, alB, l_reg, pa0, pa1, pa2, pa3); SBAR();
    if (SDEPTH == 1 || j + 3 < NT) SLOAD(SE, (j + 1 + SDEPTH) * KVBLK); SBAR();
    pv_d0(o, vb0 + (int)SHM_V, pa0, pa1, pa2, pa3); partialSM(pA0, pA1, m_reg, mnA, alA);
    __syncthreads(); SWAIT(); SWRITE(1, SO);
    RESC(alA); __syncthreads();
  }
  SBAR(); qkt(pB0, pB1, (bf16*)((char*)K_lds + SHM_K), qr, r32, hi);
  finishSM(pA0, pA1, alA, l_reg, pa0, pa1, pa2, pa3); SBAR();
  pv_d0(o, vb0, pa0, pa1, pa2, pa3); partialSM(pB0, pB1, m_reg, mnB, alB);
  __syncthreads(); RESC(alB);
  finishSM(pB0, pB1, alB, l_reg, pa0, pa1, pa2, pa3); SBAR();
  pv_d0(o, vb0 + (int)SHM_V, pa0, pa1, pa2, pa3);
  if (hi == 0) li_l[r32] = l_reg; asm volatile("s_waitcnt lgkmcnt(0)" ::: "memory");
  float rli[16];
#pragma unroll
  for (int r = 0; r < 16; ++r) rli[r] = __builtin_amdgcn_rcpf(li_l[crow(r, hi)]);
  float* Ow = Ob + (long)(wid * QBLK) * LDO;
#pragma unroll
  for (int r = 0; r < 16; ++r) { int orow = crow(r, hi);
    for (int d0 = 0; d0 < 4; ++d0) Ow[(long)orow * LDO + d0 * 32 + r32] = o[d0][r] * rli[r]; }
#undef SLOAD
#undef SWRITE
#undef SWAIT
#undef RESC
}
__device__ __forceinline__ void qkt2(f32x16& p0, f32x16& p1, const bf16* Ks, const bf16x8* qr, int r32, int hi, int mp) {
  p0 = f32x16{}; p1 = f32x16{};
  __builtin_amdgcn_s_setprio(1);
#pragma unroll
  for (int d0 = 0; d0 < 4; ++d0) { int cb = (mp * 64 + d0 * 16 + hi * 8) * 2;
    bf16x8 b0 = *reinterpret_cast<const bf16x8*>((const char*)Ks + KSWZ(r32, cb));
    bf16x8 b1 = *reinterpret_cast<const bf16x8*>((const char*)Ks + KSWZ(32 + r32, cb));
    p0 = __builtin_amdgcn_mfma_f32_32x32x16_bf16(b0, qr[d0], p0, 0, 0, 0);
    p1 = __builtin_amdgcn_mfma_f32_32x32x16_bf16(b1, qr[d0], p1, 0, 0, 0); }
  __builtin_amdgcn_s_setprio(0);
}
constexpr int LDQ2 = 512, LDOB = 1024;
__device__ __forceinline__ void attn_diff_body(const bf16* __restrict__ Qb, const bf16* __restrict__ Kh, const bf16* __restrict__ Vh,
                                               unsigned short* __restrict__ Ob, int seq, char* lds, float lam, const float* __restrict__ subg, float osc) {
  using St = Stage<bf16>; using SQ = Stage<bf16>;
  const int tid = threadIdx.x, wid = tid >> 6, lane = tid & 63, r32 = lane & 31, hi = lane >> 5, mp = wid >> 2, wq = wid & 3;
  bf16* V_lds = (bf16*)lds; bf16* K_lds = (bf16*)(lds + 2 * SHM_V);
  float* ws = (float*)(lds + 2 * SHM_V + 2 * SHM_K) + wid * 64; float* li_l = ws; float* al_l = ws + 32;
  float m_reg = -1e30f, l_reg = 0; f32x16 o[4] = {}; bf16x8 qr[4];
  const bf16* Qw = Qb + (long)(wq * QBLK + r32) * LDQ2 + mp * 64 + hi * 8;
#pragma unroll
  for (int d0 = 0; d0 < 4; ++d0) qr[d0] = SQ::tobf(SQ::ld8(Qw + d0 * 16));
  const int sr = tid >> 4, sc = (tid & 15) * 8, vst0 = v_st(sr, sc), vst1 = v_st(32 + sr, sc);
  const int vb0 = (int)(uintptr_t)V_lds + v_rd_base(lane);
  struct { typename St::T vs0, vs1, ks0, ks1; } sr_[SDEPTH];
#define SLOAD(i, k0) do { sr_[i].vs0 = St::ld8(&Vh[(long)((k0) + sr) * LDK + sc]); sr_[i].vs1 = St::ld8(&Vh[(long)((k0) + 32 + sr) * LDK + sc]); \
    sr_[i].ks0 = St::ld8(&Kh[(long)((k0) + sr) * LDK + sc]); sr_[i].ks1 = St::ld8(&Kh[(long)((k0) + 32 + sr) * LDK + sc]); } while (0)
#define SWRITE(b, i) do { *(bf16x8*)((char*)V_lds + (b) * SHM_V + vst0) = St::tobf(sr_[i].vs0);          \
    *(bf16x8*)((char*)V_lds + (b) * SHM_V + vst1) = St::tobf(sr_[i].vs1); int kc = sc * 2;               \
    *(bf16x8*)((char*)K_lds + (b) * SHM_K + KSWZ(sr, kc)) = St::tobf(sr_[i].ks0);                       \
    *(bf16x8*)((char*)K_lds + (b) * SHM_K + KSWZ(32 + sr, kc)) = St::tobf(sr_[i].ks1); } while (0)
#define SWAIT() do { if constexpr (SDEPTH == 2) asm volatile("s_waitcnt vmcnt(4)" ::: "memory"); else asm volatile("s_waitcnt vmcnt(0)" ::: "memory"); } while (0)
#define RESC(a) do { if (__any((a) < 1.f)) { if (hi == 0) al_l[r32] = (a); asm volatile("s_waitcnt lgkmcnt(0)" ::: "memory"); \
    for (int d = 0; d < 4; ++d) for (int r = 0; r < 16; ++r) o[d][r] *= al_l[crow(r, hi)]; } } while (0)
  f32x16 pA0, pA1, pB0, pB1; float mnA, mnB, alA, alB; bf16x8 pa0, pa1, pa2, pa3; const int NT = seq / KVBLK;
  constexpr int SE = 0, SO = SDEPTH - 1;
  SLOAD(SE, 0); asm volatile("s_waitcnt vmcnt(0)" ::: "memory"); SWRITE(0, SE); __syncthreads();
  qkt2(pA0, pA1, K_lds, qr, r32, hi, mp); partialSM(pA0, pA1, m_reg, mnA, alA);
  SLOAD(SO, KVBLK); if constexpr (SDEPTH == 2) { if (2 < NT) SLOAD(SE, 2 * KVBLK); }
  SWAIT(); SWRITE(1, SO); __syncthreads();
  for (int j = 1; j + 1 < NT; j += 2) {
    SBAR(); qkt2(pB0, pB1, (bf16*)((char*)K_lds + SHM_K), qr, r32, hi, mp);
    finishSM(pA0, pA1, alA, l_reg, pa0, pa1, pa2, pa3); SBAR();
    SLOAD(SO, (j + SDEPTH) * KVBLK); SBAR();
    pv_d0(o, vb0, pa0, pa1, pa2, pa3); partialSM(pB0, pB1, m_reg, mnB, alB);
    __syncthreads(); SWAIT(); SWRITE(0, SE);
    RESC(alB); __syncthreads();
    SBAR(); qkt2(pA0, pA1, K_lds, qr, r32, hi, mp);
    finishSM(pB0, pB1, alB, l_reg, pa0, pa1, pa2, pa3); SBAR();
    if (SDEPTH == 1 || j + 3 < NT) SLOAD(SE, (j + 1 + SDEPTH) * KVBLK); SBAR();
    pv_d0(o, vb0 + (int)SHM_V, pa0, pa1, pa2, pa3); partialSM(pA0, pA1, m_reg, mnA, alA);
    __syncthreads(); SWAIT(); SWRITE(1, SO);
    RESC(alA); __syncthreads();
  }
  SBAR(); qkt2(pB0, pB1, (bf16*)((char*)K_lds + SHM_K), qr, r32, hi, mp);
  finishSM(pA0, pA1, alA, l_reg, pa0, pa1, pa2, pa3); SBAR();
  pv_d0(o, vb0, pa0, pa1, pa2, pa3); partialSM(pB0, pB1, m_reg, mnB, alB);
  __syncthreads(); RESC(alB);
  finishSM(pB0, pB1, alB, l_reg, pa0, pa1, pa2, pa3); SBAR();
  pv_d0(o, vb0 + (int)SHM_V, pa0, pa1, pa2, pa3);
  if (hi == 0) li_l[r32] = l_reg; asm volatile("s_waitcnt lgkmcnt(0)" ::: "memory");
  float rli[16];
#pragma unroll
  for (int r = 0; r < 16; ++r) rli[r] = __builtin_amdgcn_rcpf(li_l[crow(r, hi)]);
#pragma unroll
  for (int d0 = 0; d0 < 4; ++d0)
#pragma unroll
    for (int r = 0; r < 16; ++r) o[d0][r] *= rli[r];
  __syncthreads();
  float* xch = (float*)lds + wq * 4096 + lane;
  if (mp == 1) {
#pragma unroll
    for (int d0 = 0; d0 < 4; ++d0)
#pragma unroll
      for (int r = 0; r < 16; ++r) xch[(d0 * 16 + r) * 64] = o[d0][r]; }
  __syncthreads();
  if (mp == 0) {
    int lane_e = lane; asm volatile("" : "+v"(lane_e));
    const int r32e = lane_e & 31, hie = lane_e >> 5;
    float ssq[16];
#pragma unroll
    for (int r = 0; r < 16; ++r) ssq[r] = 0.f;
#pragma unroll
    for (int d0 = 0; d0 < 4; ++d0)
#pragma unroll
      for (int r = 0; r < 16; ++r) { const float v = o[d0][r] - lam * xch[(d0 * 16 + r) * 64]; o[d0][r] = v; ssq[r] += v * v; }
#pragma unroll
    for (int r = 0; r < 16; ++r) { float s = ssq[r]; s += __shfl_xor(s, 1); s += __shfl_xor(s, 2); s += __shfl_xor(s, 4); s += __shfl_xor(s, 8); s += __shfl_xor(s, 16); ssq[r] = rsqrtf(s * (1.0f / 128.0f) + 1e-6f) * osc; }
    unsigned short* Ow = Ob + (long)(wq * QBLK) * LDOB;
#pragma unroll
    for (int d0 = 0; d0 < 4; ++d0) { const float gsc = subg[d0 * 32 + r32e];
#pragma unroll
      for (int r = 0; r < 16; ++r) { const float v = o[d0][r] * ssq[r] * gsc; const unsigned u = __float_as_uint(v); Ow[(long)crow(r, hie) * LDOB + d0 * 32 + r32e] = (unsigned short)((u + 0x7fffu + ((u >> 16) & 1u)) >> 16); } } }
  __syncthreads();
#undef SLOAD
#undef SWRITE
#undef SWAIT
#undef RESC
}
__device__ __forceinline__ void qkt3(f32x16& p0, f32x16& p1, const bf16* Ks, const bf16x8* qr, const f32x16& negm, int r32, int hi, int mp) {
#pragma unroll
  for (int d0 = 0; d0 < 4; ++d0) { int cb = (mp * 64 + d0 * 16 + hi * 8) * 2;
    bf16x8 b0 = *reinterpret_cast<const bf16x8*>((const char*)Ks + KSWZ(r32, cb));
    bf16x8 b1 = *reinterpret_cast<const bf16x8*>((const char*)Ks + KSWZ(32 + r32, cb));
    if (d0 == 0) { p0 = __builtin_amdgcn_mfma_f32_32x32x16_bf16(b0, qr[0], negm, 0, 0, 0); p1 = __builtin_amdgcn_mfma_f32_32x32x16_bf16(b1, qr[0], negm, 0, 0, 0); }
    else { p0 = __builtin_amdgcn_mfma_f32_32x32x16_bf16(b0, qr[d0], p0, 0, 0, 0); p1 = __builtin_amdgcn_mfma_f32_32x32x16_bf16(b1, qr[d0], p1, 0, 0, 0); } }
}
constexpr float THR2 = THR * 1.4426950408889634f;
__device__ __forceinline__ void partialSM2(f32x16& p0, f32x16& p1, float& m_reg, f32x16& negm, float& alpha, bool nomax) {
  if (nomax) { alpha = 1.f; for (int r = 0; r < 16; ++r) p0[r] = __builtin_amdgcn_exp2f(p0[r]); return; }
  float pmax = p0[0]; for (int r = 1; r < 16; ++r) pmax = fmaxf(pmax, p0[r]); for (int r = 0; r < 16; ++r) pmax = fmaxf(pmax, p1[r]);
  { auto rr = __builtin_amdgcn_permlane32_swap(__float_as_uint(pmax), __float_as_uint(pmax), false, false);
    pmax = fmaxf(__uint_as_float(rr[0]), __uint_as_float(rr[1])); }
  if (__builtin_expect(__all(pmax <= THR2), 1)) { alpha = 1.f; }
  else { const float dl = fmaxf(pmax, 0.f); m_reg += dl; alpha = __builtin_amdgcn_exp2f(-dl);
    for (int r = 0; r < 16; ++r) { p0[r] -= dl; p1[r] -= dl; }
    for (int r = 0; r < 16; ++r) negm[r] = -m_reg; }
  for (int r = 0; r < 16; ++r) p0[r] = __builtin_amdgcn_exp2f(p0[r]);
}
__device__ __forceinline__ void finishSM2(f32x16& p0, f32x16& p1, float alpha, float& l_reg, bf16x8& pa0, bf16x8& pa1, bf16x8& pa2, bf16x8& pa3) {
  for (int r = 0; r < 16; ++r) p1[r] = __builtin_amdgcn_exp2f(p1[r]);
  float ps = 0; for (int r = 0; r < 16; ++r) ps += p0[r]; for (int r = 0; r < 16; ++r) ps += p1[r];
  { auto rr = __builtin_amdgcn_permlane32_swap(__float_as_uint(ps), __float_as_uint(ps), false, false);
    ps = __uint_as_float(rr[0]) + __uint_as_float(rr[1]); }
  l_reg = l_reg * alpha + ps;
#define PK8(P, BASE, OUT) do { u32x4 w = {cvtpk(P[BASE + 0], P[BASE + 1]), cvtpk(P[BASE + 2], P[BASE + 3]), cvtpk(P[BASE + 4], P[BASE + 5]), cvtpk(P[BASE + 6], P[BASE + 7])}; OUT = *reinterpret_cast<bf16x8*>(&w); } while (0)
  PK8(p0, 0, pa0); PK8(p0, 8, pa1); PK8(p1, 0, pa2); PK8(p1, 8, pa3);
#undef PK8
}
typedef short v4i16b_t __attribute__((ext_vector_type(4)));
__device__ __forceinline__ v4i16b_t vtrb(int vb, int off) { return __builtin_amdgcn_ds_read_tr16_b64_v4i16((__attribute__((address_space(3))) v4i16b_t*)(unsigned)(vb + off)); }
#define PVB_F(L, H) __builtin_bit_cast(bf16x8, __builtin_shufflevector(L, H, 0, 1, 2, 3, 4, 5, 6, 7))
template <int D0> __device__ __forceinline__ void pv_oneb(f32x16& od, int vb, bf16x8 pa0, bf16x8 pa1, bf16x8 pa2, bf16x8 pa3) {
  const v4i16b_t l0 = vtrb(vb, v_rd_off(D0, 0, 0)), h0 = vtrb(vb, v_rd_off(D0, 0, 1)), l1 = vtrb(vb, v_rd_off(D0, 1, 0)), h1 = vtrb(vb, v_rd_off(D0, 1, 1));
  const v4i16b_t l2 = vtrb(vb, v_rd_off(D0, 2, 0)), h2 = vtrb(vb, v_rd_off(D0, 2, 1)), l3 = vtrb(vb, v_rd_off(D0, 3, 0)), h3 = vtrb(vb, v_rd_off(D0, 3, 1));
  __builtin_amdgcn_s_setprio(1);
  od = __builtin_amdgcn_mfma_f32_32x32x16_bf16(pa0, PVB_F(l0, h0), od, 0, 0, 0);
  od = __builtin_amdgcn_mfma_f32_32x32x16_bf16(pa1, PVB_F(l1, h1), od, 0, 0, 0);
  od = __builtin_amdgcn_mfma_f32_32x32x16_bf16(pa2, PVB_F(l2, h2), od, 0, 0, 0);
  od = __builtin_amdgcn_mfma_f32_32x32x16_bf16(pa3, PVB_F(l3, h3), od, 0, 0, 0);
  __builtin_amdgcn_s_setprio(0);
}
__device__ __forceinline__ void pv_d0b(f32x16* o, int vb, bf16x8 pa0, bf16x8 pa1, bf16x8 pa2, bf16x8 pa3) {
  pv_oneb<0>(o[0], vb, pa0, pa1, pa2, pa3); SBAR(); pv_oneb<1>(o[1], vb, pa0, pa1, pa2, pa3); SBAR(); pv_oneb<2>(o[2], vb, pa0, pa1, pa2, pa3); SBAR(); pv_oneb<3>(o[3], vb, pa0, pa1, pa2, pa3);
}
#define PVP_RD(A, D0) do { A[0] = tr_read<v_rd_off(D0, 0, 0)>(vb); A[1] = tr_read<v_rd_off(D0, 0, 1)>(vb); A[2] = tr_read<v_rd_off(D0, 1, 0)>(vb); A[3] = tr_read<v_rd_off(D0, 1, 1)>(vb); \
    A[4] = tr_read<v_rd_off(D0, 2, 0)>(vb); A[5] = tr_read<v_rd_off(D0, 2, 1)>(vb); A[6] = tr_read<v_rd_off(D0, 3, 0)>(vb); A[7] = tr_read<v_rd_off(D0, 3, 1)>(vb); } while (0)
#define PVP_PK(L, H) (bf16x8){L[0], L[1], L[2], L[3], H[0], H[1], H[2], H[3]}
#define PVP_MM(OD, A) do { OD = __builtin_amdgcn_mfma_f32_32x32x16_bf16(pa0, PVP_PK(A[0], A[1]), OD, 0, 0, 0); OD = __builtin_amdgcn_mfma_f32_32x32x16_bf16(pa1, PVP_PK(A[2], A[3]), OD, 0, 0, 0); \
    OD = __builtin_amdgcn_mfma_f32_32x32x16_bf16(pa2, PVP_PK(A[4], A[5]), OD, 0, 0, 0); OD = __builtin_amdgcn_mfma_f32_32x32x16_bf16(pa3, PVP_PK(A[6], A[7]), OD, 0, 0, 0); } while (0)
__device__ __forceinline__ void pv_pipe(f32x16* o, int vb, bf16x8 pa0, bf16x8 pa1, bf16x8 pa2, bf16x8 pa3) {
  s16x4 A0[8], A1[8];
  PVP_RD(A0, 0); PVP_RD(A1, 1);
  asm volatile("s_waitcnt lgkmcnt(8)" ::: "memory"); SBAR(); PVP_MM(o[0], A0); SBAR();
  PVP_RD(A0, 2);
  asm volatile("s_waitcnt lgkmcnt(8)" ::: "memory"); SBAR(); PVP_MM(o[1], A1); SBAR();
  PVP_RD(A1, 3);
  asm volatile("s_waitcnt lgkmcnt(8)" ::: "memory"); SBAR(); PVP_MM(o[2], A0); SBAR();
  asm volatile("s_waitcnt lgkmcnt(0)" ::: "memory"); SBAR(); PVP_MM(o[3], A1);
}
#undef PVP_RD
#undef PVP_PK
#undef PVP_MM
__device__ __forceinline__ void attn_diff_body3(const bf16* __restrict__ Qb, const bf16* __restrict__ Kh, const bf16* __restrict__ Vh,
                                               unsigned short* __restrict__ Ob, int seq, char* lds, __attribute__((address_space(3))) unsigned char* ldsl, float lam, const float* __restrict__ subg, float osc, bool nomax) {
  using St = Stage<bf16>; using SQ = Stage<bf16>;
  const int tid = threadIdx.x, wid = tid >> 6, lane = tid & 63, r32 = lane & 31, hi = lane >> 5, mp = wid >> 2, wq = wid & 3;
  constexpr int VR = 0, KR = 3 * 16384, WSO = 6 * 16384;
  bf16* V_lds = (bf16*)(lds + VR); bf16* K_lds = (bf16*)(lds + KR);
  float* ws = (float*)(lds + WSO) + wid * 64; float* li_l = ws; float* al_l = ws + 32;
  float m_reg = 0.f, l_reg = 0; f32x16 o[4] = {}; bf16x8 qr[4]; f32x16 negm = {}; asm volatile("" : "+v"(negm));
  const bf16* Qw = Qb + (long)(wq * QBLK + r32) * LDQ2 + mp * 64 + hi * 8;
#pragma unroll
  for (int d0 = 0; d0 < 4; ++d0) qr[d0] = SQ::tobf(SQ::ld8(Qw + d0 * 16));
  const int vb0 = (int)(uintptr_t)V_lds + v_rd_base(lane);
  int kso[2], vso[2];
#pragma unroll
  for (int i = 0; i < 2; ++i) { const int ob = (i * 8 + wid) * 1024 + 16 * lane; const int row = ob >> 8, cb = (ob & 255) ^ ((row & 7) << 4); kso[i] = row * LDK + (cb >> 1);
    const int st = ob >> 9, e = (ob & 511) >> 1, kk = (st >> 2) * 8 + (e >> 5); vso[i] = kk * LDK + (st & 3) * 32 + (e & 31); }
  const int wu = __builtin_amdgcn_readfirstlane(wid);
  typedef __attribute__((address_space(3))) unsigned las_u32;
  const int NT = seq / KVBLK;
#define DMA_K(t, slot) do { const int tt_ = (t) < NT ? (t) : NT - 1; const bf16* g_ = Kh + (long)tt_ * KVBLK * LDK; _Pragma("unroll") for (int i_ = 0; i_ < 2; ++i_) \
    __builtin_amdgcn_global_load_lds((const unsigned*)(g_ + kso[i_]), (las_u32*)(ldsl + KR + (slot) * 16384 + (i_ * 8 + wu) * 1024), 16, 0, 0); } while (0)
#define DMA_V(t, slot) do { const int tt_ = (t) < NT ? (t) : NT - 1; const bf16* g_ = Vh + (long)tt_ * KVBLK * LDK; _Pragma("unroll") for (int i_ = 0; i_ < 2; ++i_) \
    __builtin_amdgcn_global_load_lds((const unsigned*)(g_ + vso[i_]), (las_u32*)(ldsl + VR + (slot) * 16384 + (i_ * 8 + wu) * 1024), 16, 0, 0); } while (0)
#define CLOSE() do { asm volatile("s_waitcnt vmcnt(4) lgkmcnt(0)" ::: "memory"); __builtin_amdgcn_s_barrier(); asm volatile("" ::: "memory"); } while (0)
#define RESC(a) do { if (__any((a) < 1.f)) { if (hi == 0) al_l[r32] = (a); asm volatile("s_waitcnt lgkmcnt(0)" ::: "memory"); \
    for (int d = 0; d < 4; ++d) for (int r = 0; r < 16; ++r) o[d][r] *= al_l[crow(r, hi)]; } } while (0)
  f32x16 pA0, pA1, pB0, pB1; float mnA, mnB, alA, alB; bf16x8 pa0, pa1, pa2, pa3;
  DMA_K(0, 0); DMA_K(1, 1); DMA_V(0, 0);
  asm volatile("s_waitcnt vmcnt(4)" ::: "memory"); __builtin_amdgcn_s_barrier(); asm volatile("" ::: "memory");
  DMA_K(2, 2); DMA_V(1, 1);
  qkt2(pA0, pA1, K_lds, qr, r32, hi, mp); partialSM2(pA0, pA1, m_reg, negm, alA, nomax);
  CLOSE();
  int kcur = 1, vcur = 0;
#define ROT3(x) ((x) == 2 ? 0 : (x) + 1)
#define PRV3(x) ((x) == 0 ? 2 : (x) - 1)
#define ITER(PC0, PC1, MNC, ALC, PP0, PP1, ALP, j_) do { \
    DMA_K((j_) + 2, PRV3(kcur)); DMA_V((j_) + 1, PRV3(vcur)); \
    SBAR(); if (__builtin_expect(__all(m_reg == 0.f), 1)) { qkt2(PC0, PC1, (bf16*)((char*)K_lds + kcur * 16384), qr, r32, hi, mp); } else { qkt3(PC0, PC1, (bf16*)((char*)K_lds + kcur * 16384), qr, negm, r32, hi, mp); } \
    finishSM2(PP0, PP1, ALP, l_reg, pa0, pa1, pa2, pa3); SBAR(); \
    pv_d0b(o, vb0 + vcur * 16384, pa0, pa1, pa2, pa3); partialSM2(PC0, PC1, m_reg, negm, ALC, nomax); \
    if (!nomax) { RESC(ALC); } CLOSE(); kcur = ROT3(kcur); vcur = ROT3(vcur); } while (0)
  for (int j = 1; j + 1 < NT; j += 2) {
    ITER(pB0, pB1, mnB, alB, pA0, pA1, alA, j);
    ITER(pA0, pA1, mnA, alA, pB0, pB1, alB, j + 1);
  }
  ITER(pB0, pB1, mnB, alB, pA0, pA1, alA, NT - 1);
  finishSM2(pB0, pB1, alB, l_reg, pa0, pa1, pa2, pa3); SBAR();
  pv_d0b(o, vb0 + vcur * 16384, pa0, pa1, pa2, pa3);
  asm volatile("s_waitcnt vmcnt(0)" ::: "memory");
#undef ITER
#undef ROT3
#undef PRV3
#undef DMA_K
#undef DMA_V
#undef CLOSE
  if (hi == 0) li_l[r32] = l_reg; asm volatile("s_waitcnt lgkmcnt(0)" ::: "memory");
  float rli[16];
#pragma unroll
  for (int r = 0; r < 16; ++r) rli[r] = __builtin_amdgcn_rcpf(li_l[crow(r, hi)]);
#pragma unroll
  for (int d0 = 0; d0 < 4; ++d0)
#pragma unroll
    for (int r = 0; r < 16; ++r) o[d0][r] *= rli[r];
  __syncthreads();
  float* xch = (float*)lds + wq * 4096 + lane;
  if (mp == 1) {
#pragma unroll
    for (int d0 = 0; d0 < 4; ++d0)
#pragma unroll
      for (int r = 0; r < 16; ++r) xch[(d0 * 16 + r) * 64] = o[d0][r]; }
  __syncthreads();
  if (mp == 0) {
    int lane_e = lane; asm volatile("" : "+v"(lane_e));
    const int r32e = lane_e & 31, hie = lane_e >> 5;
    float ssq[16];
#pragma unroll
    for (int r = 0; r < 16; ++r) ssq[r] = 0.f;
#pragma unroll
    for (int d0 = 0; d0 < 4; ++d0)
#pragma unroll
      for (int r = 0; r < 16; ++r) { const float v = o[d0][r] - lam * xch[(d0 * 16 + r) * 64]; o[d0][r] = v; ssq[r] += v * v; }
#pragma unroll
    for (int r = 0; r < 16; ++r) { float s = ssq[r]; s += __shfl_xor(s, 1); s += __shfl_xor(s, 2); s += __shfl_xor(s, 4); s += __shfl_xor(s, 8); s += __shfl_xor(s, 16); ssq[r] = rsqrtf(s * (1.0f / 128.0f) + 1e-6f) * osc; }
    unsigned short* Ow = Ob + (long)(wq * QBLK) * LDOB;
#pragma unroll
    for (int d0 = 0; d0 < 4; ++d0) { const float gsc = subg[d0 * 32 + r32e];
#pragma unroll
      for (int r = 0; r < 16; ++r) { const float v = o[d0][r] * ssq[r] * gsc; const unsigned u = __float_as_uint(v); Ow[(long)crow(r, hie) * LDOB + d0 * 32 + r32e] = (unsigned short)((u + 0x7fffu + ((u >> 16) & 1u)) >> 16); } } }
  __syncthreads();
#undef RESC
}
typedef int v8i_a8 __attribute__((ext_vector_type(8)));
typedef int v4i_a8 __attribute__((ext_vector_type(4)));
constexpr float THR8 = 8.5f;
__device__ __forceinline__ unsigned pk4f8(float a, float b, float c, float d) { int w = 0; w = __builtin_amdgcn_cvt_pk_fp8_f32(a, b, w, false); w = __builtin_amdgcn_cvt_pk_fp8_f32(c, d, w, true); return (unsigned)w; }
__device__ __forceinline__ void partialSM8(f32x16& p0, f32x16& p1, float& m_reg, float& alpha) {
  float pmax = p0[0]; for (int r = 1; r < 16; ++r) pmax = fmaxf(pmax, p0[r]); for (int r = 0; r < 16; ++r) pmax = fmaxf(pmax, p1[r]);
  { auto rr = __builtin_amdgcn_permlane32_swap(__float_as_uint(pmax), __float_as_uint(pmax), false, false);
    pmax = fmaxf(__uint_as_float(rr[0]), __uint_as_float(rr[1])); }
  if (__builtin_expect(__all(pmax <= THR8), 1)) { alpha = 1.f; }
  else { const float dl = fmaxf(pmax, 0.f); m_reg += dl; alpha = __builtin_amdgcn_exp2f(-dl);
    for (int r = 0; r < 16; ++r) { p0[r] -= dl; p1[r] -= dl; } }
  for (int r = 0; r < 16; ++r) p0[r] = __builtin_amdgcn_exp2f(p0[r]);
}
__device__ __forceinline__ void finishSM8(f32x16& p0, f32x16& p1, float alpha, float& l_reg, v8i_a8& pa) {
  for (int r = 0; r < 16; ++r) p1[r] = __builtin_amdgcn_exp2f(p1[r]);
  float ps = 0; for (int r = 0; r < 16; ++r) ps += p0[r]; for (int r = 0; r < 16; ++r) ps += p1[r];
  { auto rr = __builtin_amdgcn_permlane32_swap(__float_as_uint(ps), __float_as_uint(ps), false, false);
    ps = __uint_as_float(rr[0]) + __uint_as_float(rr[1]); }
  l_reg = l_reg * alpha + ps;
  pa[0] = (int)pk4f8(p0[0], p0[1], p0[2], p0[3]); pa[1] = (int)pk4f8(p0[4], p0[5], p0[6], p0[7]); pa[2] = (int)pk4f8(p0[8], p0[9], p0[10], p0[11]); pa[3] = (int)pk4f8(p0[12], p0[13], p0[14], p0[15]);
  pa[4] = (int)pk4f8(p1[0], p1[1], p1[2], p1[3]); pa[5] = (int)pk4f8(p1[4], p1[5], p1[6], p1[7]); pa[6] = (int)pk4f8(p1[8], p1[9], p1[10], p1[11]); pa[7] = (int)pk4f8(p1[12], p1[13], p1[14], p1[15]);
}
typedef __attribute__((address_space(3))) unsigned char las_u8;
__device__ __forceinline__ v8i_a8 kfrag8(const las_u8* kt, int row, int mp, int hi) {
  const int sw = (row >> 1) & 7, c0 = 4 * mp + 2 * hi;
  const v4i_a8 lo = *(const __attribute__((address_space(3))) v4i_a8*)(kt + row * 128 + ((c0 ^ sw) << 4)), hi4 = *(const __attribute__((address_space(3))) v4i_a8*)(kt + row * 128 + (((c0 + 1) ^ sw) << 4));
  return __builtin_shufflevector(lo, hi4, 0, 1, 2, 3, 4, 5, 6, 7);
}
#define QS8 0x7D7D7D7D
#define US8 0x7F7F7F7F
__device__ __forceinline__ void qkt8(f32x16& p0, f32x16& p1, const las_u8* kt, const v8i_a8& qf, const f32x16& c0, int r32, int hi, int mp) {
  const v8i_a8 k0 = kfrag8(kt, r32, mp, hi), k1 = kfrag8(kt, 32 + r32, mp, hi);
  p0 = __builtin_amdgcn_mfma_scale_f32_32x32x64_f8f6f4(k0, qf, c0, 0, 0, 0, US8, 0, QS8);
  p1 = __builtin_amdgcn_mfma_scale_f32_32x32x64_f8f6f4(k1, qf, c0, 0, 0, 0, US8, 0, QS8);
}
__device__ __forceinline__ void pv8(f32x16* o, const las_u8* vt, int lane, const v8i_a8& pa) {
#pragma unroll
  for (int d0 = 0; d0 < 4; ++d0) {
    const v4i_a8 lo = *(const __attribute__((address_space(3))) v4i_a8*)(vt + ((d0 * 2 + 0) * 64 + lane) * 16), hi4 = *(const __attribute__((address_space(3))) v4i_a8*)(vt + ((d0 * 2 + 1) * 64 + lane) * 16);
    const v8i_a8 vf = __builtin_shufflevector(lo, hi4, 0, 1, 2, 3, 4, 5, 6, 7);
    o[d0] = __builtin_amdgcn_mfma_scale_f32_32x32x64_f8f6f4(pa, vf, o[d0], 0, 0, 0, US8, 0, US8); }
}
__device__ __forceinline__ unsigned pk4b8(float a, float b, float c, float d) { int w = 0; w = __builtin_amdgcn_cvt_pk_bf8_f32(a, b, w, false); w = __builtin_amdgcn_cvt_pk_bf8_f32(c, d, w, true); return (unsigned)w; }
__device__ __forceinline__ void finishSM8b(f32x16& p0, f32x16& p1, v8i_a8& pa) {
  for (int r = 0; r < 16; ++r) p1[r] = __builtin_amdgcn_exp2f(p1[r]);
  pa[0] = (int)pk4b8(p0[0], p0[1], p0[2], p0[3]); pa[1] = (int)pk4b8(p0[4], p0[5], p0[6], p0[7]); pa[2] = (int)pk4b8(p0[8], p0[9], p0[10], p0[11]); pa[3] = (int)pk4b8(p0[12], p0[13], p0[14], p0[15]);
  pa[4] = (int)pk4b8(p1[0], p1[1], p1[2], p1[3]); pa[5] = (int)pk4b8(p1[4], p1[5], p1[6], p1[7]); pa[6] = (int)pk4b8(p1[8], p1[9], p1[10], p1[11]); pa[7] = (int)pk4b8(p1[12], p1[13], p1[14], p1[15]);
}
__device__ __forceinline__ void pv8b(f32x16* o, f32x16& osum, const v8i_a8& ones, const las_u8* vt, int lane, const v8i_a8& pa) {
  osum = __builtin_amdgcn_mfma_scale_f32_32x32x64_f8f6f4(pa, ones, osum, 1, 0, 0, US8, 0, US8);
#pragma unroll
  for (int d0 = 0; d0 < 4; ++d0) {
    const v4i_a8 lo = *(const __attribute__((address_space(3))) v4i_a8*)(vt + ((d0 * 2 + 0) * 64 + lane) * 16), hi4 = *(const __attribute__((address_space(3))) v4i_a8*)(vt + ((d0 * 2 + 1) * 64 + lane) * 16);
    const v8i_a8 vf = __builtin_shufflevector(lo, hi4, 0, 1, 2, 3, 4, 5, 6, 7);
    o[d0] = __builtin_amdgcn_mfma_scale_f32_32x32x64_f8f6f4(pa, vf, o[d0], 1, 0, 0, US8, 0, US8); }
}
template <bool NOMAX> __device__ __forceinline__ void attn_diff_body8(const unsigned char* __restrict__ Q8b, const unsigned char* __restrict__ K8h, const unsigned char* __restrict__ V8h,
                                               unsigned short* __restrict__ Ob, int seq, char* lds, las_u8* ldsl, float lam, const float* __restrict__ subg, float osc) {
  constexpr bool nomax = NOMAX;
  const int tid = threadIdx.x, wid = tid >> 6, lane = tid & 63, r32 = lane & 31, hi = lane >> 5, mp = wid >> 2, wq = wid & 3;
  constexpr int VR = 0, KR = 4 * 8192, WSO = 65536;
  typedef __attribute__((address_space(3))) float las_f32;
  las_f32* li_l = (las_f32*)(ldsl + WSO) + wid * 64; las_f32* al_l = li_l + 32;
  float m_reg = 0.f, l_reg = 0; f32x16 o[4] = {};
  v8i_a8 qf;
  { const unsigned char* qp = Q8b + (long)(wq * QBLK + r32) * 512 + mp * 64 + hi * 32; const v4i_a8 lo = *(const v4i_a8*)qp, h4 = *(const v4i_a8*)(qp + 16); qf = __builtin_shufflevector(lo, h4, 0, 1, 2, 3, 4, 5, 6, 7); }
  const int wu = __builtin_amdgcn_readfirstlane(wid);
  const int krow = 8 * wid + (lane >> 3), kso = krow * 512 + (((lane & 7) ^ ((krow >> 1) & 7)) << 4), vso = wid * 1024 + 16 * lane;
  typedef __attribute__((address_space(3))) unsigned las_u32;
  const int NT = seq / KVBLK;
#define DMA_K(t, slot) do { const int tt_ = (t) < NT ? (t) : NT - 1; __builtin_amdgcn_global_load_lds((const unsigned*)(K8h + (long)tt_ * KVBLK * 512 + kso), (las_u32*)(ldsl + KR + (slot) * 8192 + wu * 1024), 16, 0, 0); } while (0)
#define DMA_V(t, slot) do { const int tt_ = (t) < NT ? (t) : NT - 1; __builtin_amdgcn_global_load_lds((const unsigned*)(V8h + (long)tt_ * 8192 + vso), (las_u32*)(ldsl + VR + (slot) * 8192 + wu * 1024), 16, 0, 0); } while (0)
#define CLOSE() do { asm volatile("s_waitcnt vmcnt(2) lgkmcnt(0)" ::: "memory"); __builtin_amdgcn_s_barrier(); asm volatile("" ::: "memory"); } while (0)
#define RESC(a) do { if (__any((a) < 1.f)) { if (hi == 0) al_l[r32] = (a); asm volatile("s_waitcnt lgkmcnt(0)" ::: "memory"); \
    for (int d = 0; d < 4; ++d) for (int r = 0; r < 16; ++r) o[d][r] *= al_l[crow(r, hi)]; } } while (0)
  f32x16 pA0, pA1, pB0, pB1; float alA, alB; v8i_a8 pa;
  f32x16 osum = {}; v8i_a8 ones8;
  { const int ob = r32 == 0 ? 0x38383838 : 0; ones8 = (v8i_a8){ob, ob, ob, ob, ob, ob, ob, ob}; }
  int kcur = 1, vcur = 0;
  if constexpr (!nomax) {
  DMA_K(0, 0); DMA_K(1, 1); DMA_V(0, 0);
  asm volatile("s_waitcnt vmcnt(2)" ::: "memory"); __builtin_amdgcn_s_barrier(); asm volatile("" ::: "memory");
  DMA_K(2, 2); DMA_V(1, 1);
  { const f32x16 z0 = {}; qkt8(pA0, pA1, ldsl + KR, qf, z0, r32, hi, mp); }
  partialSM8(pA0, pA1, m_reg, alA);
  CLOSE();
  }
#define ROT3(x) ((x) == 2 ? 0 : (x) + 1)
#define PRV3(x) ((x) == 0 ? 2 : (x) - 1)
#define ITER(PC0, PC1, ALC, PP0, PP1, ALP, j_) do { \
    DMA_K((j_) + 2, PRV3(kcur)); DMA_V((j_) + 1, PRV3(vcur)); \
    SBAR(); if (__builtin_expect(__all(m_reg == 0.f), 1)) { const f32x16 z0_ = {}; qkt8(PC0, PC1, ldsl + KR + kcur * 8192, qf, z0_, r32, hi, mp); } \
    else { f32x16 nm_; _Pragma("unroll") for (int r_ = 0; r_ < 16; ++r_) nm_[r_] = -m_reg; qkt8(PC0, PC1, ldsl + KR + kcur * 8192, qf, nm_, r32, hi, mp); } \
    finishSM8(PP0, PP1, ALP, l_reg, pa); SBAR(); \
    pv8(o, ldsl + VR + vcur * 8192, lane, pa); partialSM8(PC0, PC1, m_reg, ALC); \
    RESC(ALC); CLOSE(); kcur = ROT3(kcur); vcur = ROT3(vcur); } while (0)
  if constexpr (nomax) {
    v8i_a8 kf0, kf1, vf0, vf1, pa0, pa1;
#define LDV8(d0_, vt_) ({ const v4i_a8 lo_ = *(const __attribute__((address_space(3))) v4i_a8*)((vt_) + (((d0_) * 2 + 0) * 64 + lane) * 16), hi_ = *(const __attribute__((address_space(3))) v4i_a8*)((vt_) + (((d0_) * 2 + 1) * 64 + lane) * 16); \
      (v8i_a8)__builtin_shufflevector(lo_, hi_, 0, 1, 2, 3, 4, 5, 6, 7); })
#define MF8(A_, B_, C_) __builtin_amdgcn_mfma_scale_f32_32x32x64_f8f6f4(A_, B_, C_, 1, 0, 0, US8, 0, US8)
#define PV01(PA_) do { osum = MF8(PA_, ones8, osum); o[0] = MF8(PA_, vf0, o[0]); o[1] = MF8(PA_, vf1, o[1]); asm volatile("" : "+v"(o[0]), "+v"(o[1]), "+v"(osum)); } while (0)
#define PV23(PA_) do { o[2] = MF8(PA_, vf0, o[2]); o[3] = MF8(PA_, vf1, o[3]); asm volatile("" : "+v"(o[2]), "+v"(o[3])); } while (0)
#define QKB(PC0, PC1) do { const f32x16 z0_ = {}; PC0 = __builtin_amdgcn_mfma_scale_f32_32x32x64_f8f6f4(kf0, qf, z0_, 0, 0, 0, US8, 0, QS8); PC1 = __builtin_amdgcn_mfma_scale_f32_32x32x64_f8f6f4(kf1, qf, z0_, 0, 0, 0, US8, 0, QS8); asm volatile("" : "+v"(PC0), "+v"(PC1)); } while (0)
#define LDK8(t_) do { const las_u8* kt_ = ldsl + KR + ((t_) & 3) * 8192; kf0 = kfrag8(kt_, r32, mp, hi); kf1 = kfrag8(kt_, 32 + r32, mp, hi); } while (0)
#define LDV01(t_) do { const las_u8* vt_ = ldsl + VR + ((t_) & 3) * 8192; vf0 = LDV8(0, vt_); vf1 = LDV8(1, vt_); } while (0)
#define LDV23(t_) do { const las_u8* vt_ = ldsl + VR + ((t_) & 3) * 8192; vf0 = LDV8(2, vt_); vf1 = LDV8(3, vt_); } while (0)
#define ITERD(PC0, PC1, PP0, PP1, PAC, PAP, j_, DOPV) do { \
    DMA_K((j_) + 3, ((j_) + 3) & 3); DMA_V((j_) + 1, ((j_) + 1) & 3); \
    SBAR(); QKB(PC0, PC1); if (DOPV) { PV01(PAC); } SBAR(); \
    if (DOPV) { LDV23((j_) - 2); } SBAR(); \
    finishSM8b(PP0, PP1, PAP); SBAR(); \
    if (DOPV) { PV23(PAC); } SBAR(); \
    LDK8((j_) + 1); LDV01((j_) - 1); SBAR(); \
    _Pragma("unroll") for (int r_ = 0; r_ < 16; ++r_) PC0[r_] = __builtin_amdgcn_exp2f(PC0[r_]); \
    SBAR(); CLOSE(); } while (0)
    DMA_K(0, 0); DMA_V(0, 0); DMA_K(1, 1); DMA_K(2, 2);
    asm volatile("s_waitcnt vmcnt(1)" ::: "memory"); __builtin_amdgcn_s_barrier(); asm volatile("" ::: "memory");
    LDK8(0); QKB(pA0, pA1); SBAR(); LDK8(1); SBAR();
    DMA_K(3, 3); DMA_V(1, 1);
    for (int r = 0; r < 16; ++r) pA0[r] = __builtin_amdgcn_exp2f(pA0[r]);
    CLOSE();
    ITERD(pB0, pB1, pA0, pA1, pa1, pa0, 1, false);
    for (int j = 2; j < NT; j += 2) { ITERD(pA0, pA1, pB0, pB1, pa0, pa1, j, true); ITERD(pB0, pB1, pA0, pA1, pa1, pa0, j + 1, true); }
    PV01(pa0); SBAR(); LDV23(NT - 2); SBAR(); finishSM8b(pB0, pB1, pa1); SBAR(); PV23(pa0); SBAR();
    LDV01(NT - 1); SBAR(); PV01(pa1); SBAR(); LDV23(NT - 1); SBAR(); PV23(pa1);
#undef ITERD
#undef LDV01
#undef LDV23
#undef LDK8
#undef QKB
#undef PV01
#undef PV23
#undef MF8
#undef LDV8
  } else {
    for (int j = 1; j + 1 < NT; j += 2) { ITER(pB0, pB1, alB, pA0, pA1, alA, j); ITER(pA0, pA1, alA, pB0, pB1, alB, j + 1); }
    ITER(pB0, pB1, alB, pA0, pA1, alA, NT - 1);
    finishSM8(pB0, pB1, alB, l_reg, pa); SBAR(); pv8(o, ldsl + VR + vcur * 8192, lane, pa);
  }
  asm volatile("s_waitcnt vmcnt(0)" ::: "memory");
#undef ITER
#undef ROT3
#undef PRV3
#undef DMA_K
#undef DMA_V
#undef CLOSE
  if constexpr (nomax) { if (r32 == 0) {
#pragma unroll
      for (int r = 0; r < 16; ++r) li_l[crow(r, hi)] = osum[r]; } }
  else { if (hi == 0) li_l[r32] = l_reg; }
  asm volatile("s_waitcnt lgkmcnt(0)" ::: "memory");
  float rli[16];
#pragma unroll
  for (int r = 0; r < 16; ++r) rli[r] = __builtin_amdgcn_rcpf(li_l[crow(r, hi)]);
#pragma unroll
  for (int d0 = 0; d0 < 4; ++d0)
#pragma unroll
    for (int r = 0; r < 16; ++r) o[d0][r] *= rli[r];
  __syncthreads();
  las_f32* xch = (las_f32*)ldsl + wq * 4096 + lane;
  if (mp == 1) {
#pragma unroll
    for (int d0 = 0; d0 < 4; ++d0)
#pragma unroll
      for (int r = 0; r < 16; ++r) xch[(d0 * 16 + r) * 64] = o[d0][r]; }
  __syncthreads();
  if (mp == 0) {
    int lane_e = lane; asm volatile("" : "+v"(lane_e));
    const int r32e = lane_e & 31, hie = lane_e >> 5;
    float ssq[16];
#pragma unroll
    for (int r = 0; r < 16; ++r) ssq[r] = 0.f;
#pragma unroll
    for (int d0 = 0; d0 < 4; ++d0)
#pragma unroll
      for (int r = 0; r < 16; ++r) { const float v = o[d0][r] - lam * xch[(d0 * 16 + r) * 64]; o[d0][r] = v; ssq[r] += v * v; }
#pragma unroll
    for (int r = 0; r < 16; ++r) { float s = ssq[r]; s += __shfl_xor(s, 1); s += __shfl_xor(s, 2); s += __shfl_xor(s, 4); s += __shfl_xor(s, 8); s += __shfl_xor(s, 16); ssq[r] = rsqrtf(s * (1.0f / 128.0f) + 1e-6f) * osc; }
    unsigned short* Ow = Ob + (long)(wq * QBLK) * LDOB;
#pragma unroll
    for (int d0 = 0; d0 < 4; ++d0) { const float gsc = subg[d0 * 32 + r32e];
#pragma unroll
      for (int r = 0; r < 16; ++r) { const float v = o[d0][r] * ssq[r] * gsc; const unsigned u = __float_as_uint(v); Ow[(long)crow(r, hie) * LDOB + d0 * 32 + r32e] = (unsigned short)((u + 0x7fffu + ((u >> 16) & 1u)) >> 16); } } }
  __syncthreads();
#undef RESC
}
}
#define GAS __attribute__((address_space(1)))
#define LAS __attribute__((address_space(3)))
typedef unsigned short bf16;
typedef unsigned v4u __attribute__((ext_vector_type(4)));
typedef float f32x4 __attribute__((ext_vector_type(4)));
typedef short bf16x8 __attribute__((ext_vector_type(8)));
typedef GAS unsigned gu32;
typedef GAS unsigned long long gu64;
#define RLX_AGENT __ATOMIC_RELAXED, __HIP_MEMORY_SCOPE_AGENT
#define LDS_WAIT() asm volatile("s_waitcnt lgkmcnt(0)" ::: "memory")
#define VM_WAIT() asm volatile("s_waitcnt vmcnt(0)" ::: "memory")
__device__ __forceinline__ unsigned long long rt() { return __builtin_amdgcn_s_memrealtime(); }
__device__ __forceinline__ unsigned f2bf(float f) { unsigned u = __builtin_bit_cast(unsigned, f); return (u + 0x7fffu + ((u >> 16) & 1u)) >> 16; }
__device__ __forceinline__ unsigned pk2(float lo, float hi) { return f2bf(lo) | (f2bf(hi) << 16); }

#define XB_TMO      128
#define XB_XCNT(j)  (256  + 64 * (j))
#define XB_XSUB(j)  (1280 + 64 * (j))
#define XB_XGEN(j)  (2304 + 64 * (j))
#define XB_TOP      3328
#define XB_TOPGEN   3392
#define XCD_BAR_WORDS 3456
#define XB_SPIN_CAP (1u << 23)

__device__ __forceinline__ unsigned xb_ld(unsigned* p)              { return __hip_atomic_load(p, __ATOMIC_RELAXED, __HIP_MEMORY_SCOPE_AGENT); }
__device__ __forceinline__ unsigned xb_add(unsigned* p, unsigned v) { return __hip_atomic_fetch_add(p, v, __ATOMIC_RELAXED, __HIP_MEMORY_SCOPE_AGENT); }
__device__ __forceinline__ unsigned xb_xcc_id() { return (unsigned)__builtin_amdgcn_s_getreg((3 << 11) | 20) & 0xFu; }
#define XB_SPIN(cond, bar) do { unsigned _sp = 0; while (cond) { __builtin_amdgcn_s_sleep(1); \
    if ((++_sp & 255u) == 0u) { if (xb_ld(&(bar)[XB_TMO])) break; if (_sp > XB_SPIN_CAP) { atomicAdd(&(bar)[XB_TMO], 1u); break; } } } } while (0)

struct XcdBarrier {
    unsigned* bar; unsigned x;
    volatile LAS unsigned* st;
};

__device__ __forceinline__ XcdBarrier xcd_barrier_post(unsigned* bar, volatile LAS unsigned* st) {
    XcdBarrier b; b.bar = bar; b.x = xb_xcc_id(); b.st = st;
    if (threadIdx.x == 0) (void)xb_add(&bar[XB_XCNT(b.x)], 1u);
    return b;
}
__device__ __forceinline__ void xcd_barrier_complete(unsigned* bar, unsigned x, unsigned& nloc, unsigned& nx) {
    const unsigned G = gridDim.x * gridDim.y * gridDim.z;
    unsigned sum, cnt, mine, sp = 0u;
    for (;;) {
        sum = 0u; cnt = 0u; mine = 0u;
#pragma unroll
        for (unsigned j = 0; j < 16; ++j) { const unsigned c = xb_ld(&bar[XB_XCNT(j)]); sum += c; cnt += (c > 0u) ? 1u : 0u; mine = (j == x) ? c : mine; }
        if (sum == G) break;
        __builtin_amdgcn_s_sleep(1);
        if ((++sp & 255u) == 0u) { if (xb_ld(&bar[XB_TMO])) break; if (sp > XB_SPIN_CAP) { atomicAdd(&bar[XB_TMO], 1u); break; } }
    }
    nloc = mine > 0u ? mine : 1u; nx = cnt > 0u ? cnt : 1u;
}

__device__ __forceinline__ void xcd_barrier(const XcdBarrier& b) {
    asm volatile("s_waitcnt vmcnt(0)" ::: "memory");
    __syncthreads();
    if (threadIdx.x == 0) {
        unsigned* bar = b.bar;
        __builtin_amdgcn_s_waitcnt(0);
        unsigned nloc = b.st[0], nx = b.st[1];
        if (nloc == 0u) { xcd_barrier_complete(bar, b.x, nloc, nx); b.st[0] = nloc; b.st[1] = nx; }
        const unsigned old = xb_add(&bar[XB_XSUB(b.x)], 1u);
        const unsigned gen = old / nloc;
        if (old + 1u == (gen + 1u) * nloc) {
            __builtin_amdgcn_fence(__ATOMIC_RELEASE, "agent");
            asm volatile("s_waitcnt vmcnt(0)" ::: "memory");
            const unsigned og = xb_add(&bar[XB_TOP], 1u);
            const unsigned tg = og / nx;
            if (og + 1u == (tg + 1u) * nx) xb_add(&bar[XB_TOPGEN], 1u);
            else XB_SPIN(xb_ld(&bar[XB_TOPGEN]) == tg, bar);
            __builtin_amdgcn_fence(__ATOMIC_ACQUIRE, "agent");
            xb_add(&bar[XB_XGEN(b.x)], 1u);
            asm volatile("s_waitcnt vmcnt(0)" ::: "memory");
        } else {
            XB_SPIN(xb_ld(&bar[XB_XGEN(b.x)]) == gen, bar);
            __builtin_amdgcn_fence(__ATOMIC_ACQUIRE, "agent");
            asm volatile("s_waitcnt vmcnt(0)" ::: "memory");
        }
    }
    __syncthreads();
}
constexpr int DM = 1024, NB = 8, SEQ = 4096, CTX = 256, T = NB * SEQ, TC = NB * CTX, SKV = CTX + SEQ, MROWS = T + TC;
constexpr int NIN = 5120;
constexpr int C_Q = 0, C_K = 512, C_V = 1024, C_HY = 1536, C_G = 3072;
constexpr int NE = 32, TOPK = 4, NA = T * TOPK, NROWS = NA + NE * 256, NBLK = NROWS / 256;
constexpr float EPS = 1e-6f;
enum { IX_X = 0, IX_C, IX_CTX, IX_CCTX, IX_ADAW, IX_ADAB, IX_N1G, IX_N2G, IX_WIN, IX_BIN, IX_QNG, IX_KNG, IX_LQ1, IX_LK1, IX_LQ2, IX_LK2, IX_SUBG,
       IX_CONVW, IX_CONVB, IX_FW1, IX_FB1, IX_FW2, IX_FB2, IX_FW3, IX_FB3, IX_FW4, IX_FFREQ, IX_HBIAS, IX_WUA, IX_WUB, IX_WOUT, IX_RW, IX_RB,
       IX_EW1, IX_EB1, IX_EW2, IX_EB2, N_INPUTS };
constexpr size_t MiB = 1u << 20;
constexpr size_t WS_CTL = 0, CTL_BYTES = 1 * MiB;
constexpr size_t WS_MOD = 1 * MiB;
constexpr size_t WS_LAM = WS_MOD + 256 * 1024;
constexpr size_t WS_ROPEC = WS_LAM + 1024, WS_ROPES = WS_ROPEC + 4096;
constexpr size_t WS_BLKE = WS_ROPES + 4096;
constexpr size_t WS_CNTB = WS_BLKE + 4096;
constexpr size_t WS_TOPE = 2 * MiB, WS_TOPW = WS_TOPE + 512 * 1024, WS_TOKPOS = WS_TOPW + 512 * 1024;
constexpr size_t WS_ROWTOK = WS_TOKPOS + 512 * 1024, WS_ROWW = WS_ROWTOK + 576 * 1024;
static_assert(WS_CNTB + 32768 <= 2 * MiB && WS_ROWW + 576 * 1024 <= 5 * MiB && (size_t)NROWS * 4 <= 576 * 1024, "small tables");
constexpr size_t WS_HF = 6 * MiB;
constexpr size_t WS_WIN = 22 * MiB;
constexpr size_t WS_WIN8 = 5 * MiB + 512 * 1024;
constexpr size_t WS_WA = 32 * MiB, WS_WB = 33 * MiB, WS_WO = 34 * MiB;
constexpr size_t WS_W1 = 36 * MiB;
constexpr size_t WS_W2 = 164 * MiB;
constexpr size_t WS_ACT0 = 228 * MiB;
constexpr size_t WS_HY = 228 * MiB;
constexpr size_t WS_GT = 324 * MiB;
constexpr size_t WS_PX = WS_ACT0;
constexpr size_t WS_XM = 568 * MiB;
constexpr size_t WS_XM8 = 636 * MiB;
constexpr size_t WS_WG8 = 668 * MiB;
constexpr size_t WS_OATT = 568 * MiB;
constexpr size_t WS_QP = 696 * MiB;
constexpr size_t WS_V8T = 728 * MiB;
constexpr size_t WS_KA = 760 * MiB, WS_VA = 794 * MiB;
constexpr size_t WS_U = 828 * MiB;
constexpr size_t WS_UT = 828 * MiB, WS_YT = 860 * MiB;
constexpr size_t WS_CP = 956 * MiB;
constexpr size_t WS_OAB = 892 * MiB;
constexpr size_t WS_SSQ = 228 * MiB;
constexpr size_t WS_OB = 892 * MiB, WS_OA = 924 * MiB;
constexpr size_t WS_TA = 696 * MiB;
constexpr size_t WS_TB = 568 * MiB;
constexpr size_t WS_MB = 828 * MiB;
constexpr size_t WS_TM = 696 * MiB;
constexpr size_t WS_H = 568 * MiB;
constexpr size_t WS_HS = 228 * MiB;
constexpr size_t WS_ACT = 860 * MiB;
constexpr size_t WS_Y = 568 * MiB;
constexpr size_t WS_END = 1020 * MiB;
constexpr int CW_CNT = 0;
constexpr int CW_BAR = 4096;
constexpr int CW_NMAX = 1024;
constexpr int RING_BYTES = 131072, MISC_OFF = RING_BYTES + 320, LDS_BYTES = 163840;
constexpr int NWAVES = 8, NTHREADS = 512;

typedef __attribute__((address_space(3))) float lds_f32;
__device__ __forceinline__ float bf2f(bf16 v) { return __builtin_bit_cast(float, (unsigned)v << 16); }
__device__ __forceinline__ float wave_sum(float v) {
#pragma unroll
    for (int o = 1; o < 64; o <<= 1) v += __shfl_xor(v, o);
    return v;
}
__device__ __forceinline__ float sigmoidf_(float x) { return 1.0f / (1.0f + __expf(-x)); }

struct Ctx {
    float* out; unsigned char* ws;
    LAS unsigned char* lds; char* ldsg;
    int tid, lane, wave, gwave, nwaves, gtid, gthreads;
};
#define WSP(T_, off) ((T_*)(C.ws + (off)))
#define INP(i) (((const float* const __attribute__((address_space(4)))*)__builtin_amdgcn_kernarg_segment_ptr())[i])

__device__ __forceinline__ void tr_item(const float* W, int N, bf16* WT, int Kout, int k0, int n0, int orow0, LAS float* scr, int lane, bool perm = false) {
    { const int kr = lane >> 3, c4 = (lane & 7) * 4; f32x4 v[8];
#pragma unroll
      for (int i = 0; i < 8; ++i) v[i] = *(const f32x4*)(W + (size_t)(k0 + 8 * i + kr) * N + n0 + c4);
#pragma unroll
      for (int i = 0; i < 8; ++i) { LAS float* d = scr + (8 * i + kr) * 33 + c4; d[0] = v[i].x; d[1] = v[i].y; d[2] = v[i].z; d[3] = v[i].w; } }
    LDS_WAIT(); asm volatile("" ::: "memory");
    const int c = lane & 7;
#pragma unroll
    for (int j = 0; j < 4; ++j) { const int n = (lane >> 3) + 8 * j; const LAS float* s = scr + (8 * c) * 33 + n;
        v4u o; o.x = pk2(s[0 * 33], s[1 * 33]); o.y = pk2(s[2 * 33], s[3 * 33]); o.z = pk2(s[4 * 33], s[5 * 33]); o.w = pk2(s[6 * 33], s[7 * 33]);
        const int nr = perm ? (16 * ((n >> 2) & 1) + 4 * (n >> 3) + (n & 3)) : n;
        *(v4u*)(WT + (size_t)(orow0 + nr) * Kout + k0 + 8 * c) = o; }
    LDS_WAIT(); asm volatile("" ::: "memory");
}
__device__ __forceinline__ void tr_item8(const float* W, int N, unsigned char* WT, int Kout, int k0, int n0, int orow0, LAS float* scr, int lane, float mul, bool perm = false) {
    { const int kr = lane >> 3, c4 = (lane & 7) * 4; f32x4 v[8];
#pragma unroll
      for (int i = 0; i < 8; ++i) v[i] = *(const f32x4*)(W + (size_t)(k0 + 8 * i + kr) * N + n0 + c4);
#pragma unroll
      for (int i = 0; i < 8; ++i) { LAS float* d = scr + (8 * i + kr) * 33 + c4; d[0] = v[i].x; d[1] = v[i].y; d[2] = v[i].z; d[3] = v[i].w; } }
    LDS_WAIT(); asm volatile("" ::: "memory");
    const int c = lane & 7;
#pragma unroll
    for (int j = 0; j < 4; ++j) { const int n = (lane >> 3) + 8 * j; const LAS float* s = scr + (8 * c) * 33 + n;
        const unsigned lo = pg8::pk4_fp8(s[0 * 33] * mul, s[1 * 33] * mul, s[2 * 33] * mul, s[3 * 33] * mul), hi = pg8::pk4_fp8(s[4 * 33] * mul, s[5 * 33] * mul, s[6 * 33] * mul, s[7 * 33] * mul);
        const int nr = perm ? (16 * ((n >> 2) & 1) + 4 * (n >> 3) + (n & 3)) : n;
        *(unsigned long long*)(WT + (size_t)(orow0 + nr) * Kout + k0 + 8 * c) = (unsigned long long)lo | ((unsigned long long)hi << 32); }
    LDS_WAIT(); asm volatile("" ::: "memory");
}
struct PrepItem { const float* src; unsigned char* dst; int N, k0, n0, orow0, fl; };
__device__ __forceinline__ void prep_decode(const Ctx& C, int r, PrepItem& p) {
    constexpr int I_INB = 16 * 96, I_ING = 8 * 32, I_A = 8 * 32, I_O = 16 * 32, I_E1 = 8 * 32, I_E2 = 8 * 16;
    if (r < I_INB) { const int kb = r / 96, nb = r % 96; const int L0 = 32 * nb, pn = L0 >> 8;
        p.src = INP(IX_WIN); p.N = NIN; p.k0 = 64 * kb; p.n0 = L0; p.dst = WSP(unsigned char, WS_WIN);
        p.orow0 = pn < 4 ? (256 * pn + 128 * ((L0 >> 5) & 1) + 32 * ((L0 >> 6) & 3)) : L0; p.fl = pn >= 4 ? 2 : 0; return; } r -= I_INB;
    if (r < I_ING) { const int kb = r / 32, nb = r % 32; p.src = INP(IX_WIN); p.N = NIN; p.k0 = 128 * kb; p.n0 = 3072 + 64 * nb; p.dst = WSP(unsigned char, WS_WG8); p.orow0 = 64 * nb; p.fl = 3; return; } r -= I_ING;
    if (r < 2 * I_A) { const int hb = r >= I_A; if (hb) r -= I_A; const int kb = r / 32, nb = r % 32;
        p.src = hb ? INP(IX_WUB) : INP(IX_WUA); p.N = 1024; p.k0 = 64 * kb; p.n0 = 32 * nb; p.dst = WSP(unsigned char, WS_WA) + (hb ? 1024 : 0); p.orow0 = 32 * nb; p.fl = 0; return; } r -= 2 * I_A;
    if (r < I_O) { const int kb = r / 32, nb = r % 32; p.src = INP(IX_WOUT); p.N = 1024; p.k0 = 64 * kb; p.n0 = 32 * nb; p.dst = WSP(unsigned char, WS_WO); p.orow0 = 32 * nb; p.fl = 0; return; } r -= I_O;
    if (r < NE * I_E1) { const int e = r / I_E1, q = r % I_E1, kb = q / 32, nb = q % 32; const int L0 = 64 * nb, half = L0 >> 10, ch = L0 & 1023;
        p.src = INP(IX_EW1) + (size_t)e * 1024 * 2048; p.N = 2048; p.k0 = 128 * kb; p.n0 = L0; p.dst = WSP(unsigned char, WS_W1) + (size_t)e * 2048 * 1024; p.orow0 = (ch >> 7) * 256 + half * 128 + (ch & 127); p.fl = 1; return; }
    r -= NE * I_E1;
    { const int e = r / I_E2, q = r % I_E2, kb = q / 16, nb = q % 16;
      p.src = INP(IX_EW2) + (size_t)e * 1024 * 1024; p.N = 1024; p.k0 = 128 * kb; p.n0 = 64 * nb; p.dst = WSP(unsigned char, WS_W2) + (size_t)e * 1024 * 1024; p.orow0 = 64 * nb; p.fl = 1; }
}
__device__ __forceinline__ void ph_prep_weights(const Ctx& C) {
    LAS float* scr = (LAS float*)(C.lds + C.wave * 16384);
    constexpr int NIT = 16 * 96 + 8 * 32 + 2 * 8 * 32 + 16 * 32 + NE * (8 * 32 + 8 * 16);
    const int lane = C.lane;
    for (int it = C.gwave; it < NIT; it += C.nwaves) {
        PrepItem p; prep_decode(C, it, p);
        if (p.fl & 1) {
            const int kq = lane >> 4, c = lane & 15;
            const float* src = p.src + (size_t)(p.k0 + 32 * kq) * p.N + p.n0 + 4 * c;
            LAS unsigned char* sb = (LAS unsigned char*)scr;
#pragma unroll
            for (int h = 0; h < 2; ++h) { f32x4 v[16];
#pragma unroll
                for (int i = 0; i < 16; ++i) v[i] = *(const f32x4*)(src + (size_t)(16 * h + i) * p.N);
#pragma unroll
                for (int e = 0; e < 4; ++e) { v4u o;
                    o.x = pg8::pk4_fp8(v[0][e] * 32.0f, v[1][e] * 32.0f, v[2][e] * 32.0f, v[3][e] * 32.0f); o.y = pg8::pk4_fp8(v[4][e] * 32.0f, v[5][e] * 32.0f, v[6][e] * 32.0f, v[7][e] * 32.0f);
                    o.z = pg8::pk4_fp8(v[8][e] * 32.0f, v[9][e] * 32.0f, v[10][e] * 32.0f, v[11][e] * 32.0f); o.w = pg8::pk4_fp8(v[12][e] * 32.0f, v[13][e] * 32.0f, v[14][e] * 32.0f, v[15][e] * 32.0f);
                    *(LAS v4u*)(sb + (4 * c + e) * 144 + 32 * kq + 16 * h) = o; } }
            LDS_WAIT(); asm volatile("" ::: "memory");
#pragma unroll
            for (int j = 0; j < 8; ++j) { const int n = (lane >> 3) + 8 * j, ch = lane & 7; const v4u o = *(const LAS v4u*)(sb + n * 144 + 16 * ch);
                const int n32 = n & 31, nr = (p.fl & 2) ? (16 * ((n32 >> 2) & 1) + 4 * (n32 >> 3) + (n32 & 3)) : n32;
                *(v4u*)(p.dst + (size_t)(p.orow0 + (n & 32) + nr) * 1024 + p.k0 + 16 * ch) = o; }
        } else {
            const int kr = lane >> 3, c4 = (lane & 7) * 4;
            f32x4 v[8];
#pragma unroll
            for (int i = 0; i < 8; ++i) v[i] = *(const f32x4*)(p.src + (size_t)(p.k0 + 8 * i + kr) * p.N + p.n0 + c4);
#pragma unroll
            for (int i = 0; i < 8; ++i) { LAS float* d = scr + (8 * i + kr) * 33 + c4; d[0] = v[i].x; d[1] = v[i].y; d[2] = v[i].z; d[3] = v[i].w; }
            LDS_WAIT(); asm volatile("" ::: "memory");
            const int c = lane & 7;
#pragma unroll
            for (int j = 0; j < 4; ++j) { const int n = (lane >> 3) + 8 * j; const LAS float* s = scr + (8 * c) * 33 + n;
                v4u o; o.x = pk2(s[0 * 33], s[1 * 33]); o.y = pk2(s[2 * 33], s[3 * 33]); o.z = pk2(s[4 * 33], s[5 * 33]); o.w = pk2(s[6 * 33], s[7 * 33]);
                const int nr = (p.fl & 2) ? (16 * ((n >> 2) & 1) + 4 * (n >> 3) + (n & 3)) : n;
                *(v4u*)((bf16*)p.dst + (size_t)(p.orow0 + nr) * 1024 + p.k0 + 8 * c) = o; }
        }
        LDS_WAIT(); asm volatile("" ::: "memory");
    }
}
__device__ __forceinline__ void ph_prep_ada(const Ctx& C) {
    LAS float* s = (LAS float*)C.lds;
    LAS float* red = s + 9 * 1024;
    const float* W = INP(IX_ADAW); float* MOD = WSP(float, WS_MOD);
    for (int g = blockIdx.x; g < 192; g += gridDim.x) {
        __syncthreads();
        for (int i = C.tid; i < 9 * 1024; i += NTHREADS) { const int r = i >> 10, k = i & 1023; const float v = r < 8 ? INP(IX_C)[r * 1024 + k] : INP(IX_CCTX)[k]; s[i] = v / (1.0f + __expf(-v)); }
        __syncthreads();
        float acc[9];
#pragma unroll
        for (int r = 0; r < 9; ++r) acc[r] = 0.f;
        const int col = 32 * g + (C.lane & 31), kp = C.wave * 2 + (C.lane >> 5);
#pragma unroll 8
        for (int k = 64 * kp; k < 64 * kp + 64; ++k) { const float wv = W[(size_t)k * 6144 + col];
#pragma unroll
            for (int r = 0; r < 9; ++r) acc[r] += s[r * 1024 + k] * wv; }
#pragma unroll
        for (int r = 0; r < 9; ++r) red[(kp * 9 + r) * 32 + (C.lane & 31)] = acc[r];
        __syncthreads();
        for (int i = C.tid; i < 9 * 32; i += NTHREADS) { const int r = i >> 5, l = i & 31; float a = 0.f;
#pragma unroll
            for (int w = 0; w < 16; ++w) a += red[(w * 9 + r) * 32 + l];
            MOD[r * 6144 + 32 * g + l] = a + INP(IX_ADAB)[32 * g + l]; }
    }
    __syncthreads();
}
__device__ __forceinline__ void ph_prep_misc(const Ctx& C) {
    if (blockIdx.x == gridDim.x - 1) {
        if (C.wave == 0) { const float a = wave_sum(INP(IX_LQ1)[C.lane] * INP(IX_LK1)[C.lane]), b = wave_sum(INP(IX_LQ2)[C.lane] * INP(IX_LK2)[C.lane]);
            if (C.lane == 0) *WSP(float, WS_LAM) = expf(a) - expf(b) + 0.2f;
            float gq = fabsf(INP(IX_QNG)[C.lane]), gk = fabsf(INP(IX_KNG)[C.lane]);
#pragma unroll
            for (int o = 1; o < 64; o <<= 1) { gq = fmaxf(gq, __shfl_xor(gq, o)); gk = fmaxf(gk, __shfl_xor(gk, o)); }
            if (C.lane == 0) WSP(float, WS_LAM)[1] = 11.541560327111707f * gq * gk + 0.5f; }
        for (int i = C.tid; i < 64 * 16; i += NTHREADS) { const int p = i >> 4, f = i & 15; const double fr = pow(10000.0, -(double)f / 16.0), ang = (double)p * fr;
            WSP(float, WS_ROPEC)[i] = (float)cos(ang); WSP(float, WS_ROPES)[i] = (float)sin(ang); }
    }
}
__device__ __forceinline__ void ph_prep_filter(const Ctx& C) {
    LAS float* sc = (LAS float*)(C.lds + C.wave * 4096);
    LAS float* wl = (LAS float*)(C.lds + 32768);
    float* HF = WSP(float, WS_HF);
    const float* w4 = INP(IX_FW4);
    const int lane = C.lane; const float fq = INP(IX_FFREQ)[lane];
    for (int i = C.gtid; i < 512; i += C.gthreads) HF[i] = 0.f;
    __syncthreads();
    { const float* w1 = INP(IX_FW1); const float* w2 = INP(IX_FW2); const float* w3 = INP(IX_FW3);
      for (int i = C.tid; i < (33 + 64 + 64) * 16; i += NTHREADS) { const int e = 4 * i; const float* src = e < 33 * 64 ? w1 + e : (e < 97 * 64 ? w2 + (e - 33 * 64) : w3 + (e - 97 * 64));
          const f32x4 v = *(const f32x4*)src; LAS float* d = wl + e; d[0] = v.x; d[1] = v.y; d[2] = v.z; d[3] = v.w; } }
    __syncthreads();
    const float lo = logf(0.01f) / 1.5f, hi = logf(0.01f) / 0.3f;
    for (int pb = blockIdx.x; pb < SEQ / 16; pb += gridDim.x) {
        const int n0 = 16 * pb + 2 * C.wave;
#pragma unroll
        for (int p = 0; p < 2; ++p) { const int n = n0 + p; float zv = 0.f;
            if (lane == 0) zv = (float)n / 4095.0f;
            else if (lane <= 32) { const int i = (lane - 1) & 15; const double f = 1e-4 + (double)i * ((15.0 - 1e-4) / 15.0); const double ang = f * (6.283185307179586 * (double)n / 4096.0);
                zv = lane <= 16 ? (float)cos(ang) : -(float)sin(ang); }
            sc[p * 256 + lane] = zv; }
        LDS_WAIT();
        float a0, a1;
        a0 = a1 = INP(IX_FB1)[lane];
#pragma unroll 11
        for (int i = 0; i < 33; ++i) { const float wv = wl[i * 64 + lane]; a0 += sc[i] * wv; a1 += sc[256 + i] * wv; }
        sc[64 + lane] = sinf(fq * a0); sc[256 + 64 + lane] = sinf(fq * a1); LDS_WAIT();
        a0 = a1 = INP(IX_FB2)[lane];
#pragma unroll 16
        for (int i = 0; i < 64; ++i) { const float wv = wl[(33 + i) * 64 + lane]; a0 += sc[64 + i] * wv; a1 += sc[256 + 64 + i] * wv; }
        sc[128 + lane] = sinf(fq * a0); sc[256 + 128 + lane] = sinf(fq * a1); LDS_WAIT();
        a0 = a1 = INP(IX_FB3)[lane];
#pragma unroll 16
        for (int i = 0; i < 64; ++i) { const float wv = wl[(97 + i) * 64 + lane]; a0 += sc[128 + i] * wv; a1 += sc[256 + 128 + i] * wv; }
        sc[192 + lane] = sinf(fq * a0); sc[256 + 192 + lane] = sinf(fq * a1);
        __syncthreads();
        float acc0[16], acc1[16];
#pragma unroll
        for (int q = 0; q < 16; ++q) { acc0[q] = 0.f; acc1[q] = 0.f; }
        const int o0 = 128 * C.wave + lane;
#pragma unroll 1
        for (int j0 = 0; j0 < 64; j0 += 16) { float wa[16], wb[16];
#pragma unroll
            for (int j = 0; j < 16; ++j) { wa[j] = w4[(j0 + j) * 1024 + o0]; wb[j] = w4[(j0 + j) * 1024 + o0 + 64]; }
#pragma unroll
            for (int q = 0; q < 16; ++q) { const LAS float* hq = (const LAS float*)(C.lds + (q >> 1) * 4096 + (q & 1) * 1024) + 192 + j0;
#pragma unroll
                for (int j4 = 0; j4 < 16; j4 += 4) { const f32x4 h = *(const LAS f32x4*)(hq + j4);
                    acc0[q] += h.x * wa[j4] + h.y * wa[j4 + 1] + h.z * wa[j4 + 2] + h.w * wa[j4 + 3]; acc1[q] += h.x * wb[j4] + h.y * wb[j4 + 1] + h.z * wb[j4 + 2] + h.w * wb[j4 + 3]; } } }
#pragma unroll
        for (int cc = 0; cc < 2; ++cc) { const int o = o0 + 64 * cc, dir = o >> 9, c = o & 511; const float dl = fabsf(lo + (hi - lo) * ((float)c / 511.0f)); const float hb = INP(IX_HBIAS)[c];
#pragma unroll
            for (int q = 0; q < 16; ++q) { const int n = 16 * pb + q; const float tn = (float)n / 4095.0f;
                float v = (cc ? acc1[q] : acc0[q]) * expf(-tn * dl);
                if (dir == 0) { if (n == 0) v += hb; HF[(size_t)(4096 + n) * 512 + c] = v; }
                else if (n > 0) HF[(size_t)(4096 - n) * 512 + c] = v; } }
        __syncthreads();
    }
}
__device__ __forceinline__ void ph_modulate1(const Ctx& C) {
    const float* MOD = WSP(float, WS_MOD); bf16* XM = WSP(bf16, WS_XM); unsigned char* XM8 = WSP(unsigned char, WS_XM8); const float* g = INP(IX_N1G);
    for (int r0 = C.gwave; r0 < MROWS; r0 += 2 * C.nwaves) {
        f32x4 v[2][4];
#pragma unroll
        for (int q = 0; q < 2; ++q) { const int r = r0 + q * C.nwaves; if (r < MROWS) { const float* xr = r < T ? INP(IX_X) + (size_t)r * DM : INP(IX_CTX) + (size_t)(r - T) * DM;
#pragma unroll
            for (int j = 0; j < 4; ++j) v[q][j] = *(const f32x4*)(xr + 4 * C.lane + 256 * j); } }
#pragma unroll
        for (int q = 0; q < 2; ++q) { const int r = r0 + q * C.nwaves; if (r < MROWS) {
            const float* mrow = MOD + (r < T ? (r >> 12) : 8) * 6144;
            float ss = 0.f;
#pragma unroll
            for (int j = 0; j < 4; ++j) ss += (v[q][j].x * v[q][j].x + v[q][j].y * v[q][j].y) + (v[q][j].z * v[q][j].z + v[q][j].w * v[q][j].w);
            const float rstd = rsqrtf(wave_sum(ss) * (1.0f / DM) + EPS);
#pragma unroll
            for (int j = 0; j < 4; ++j) { const int col = 4 * C.lane + 256 * j; const f32x4 gg = *(const f32x4*)(g + col), sh = *(const f32x4*)(mrow + col), sc = *(const f32x4*)(mrow + 1024 + col);
                const f32x4 y = v[q][j] * rstd * gg * (sc + 1.0f) + sh;
                *(unsigned long long*)(XM + (size_t)r * DM + col) = (unsigned long long)pk2(y.x, y.y) | ((unsigned long long)pk2(y.z, y.w) << 32);
                if (r < T) *(unsigned*)(XM8 + (size_t)r * DM + col) = pg8::pk4_fp8(y.x, y.y, y.z, y.w); } } }
    }
}
__device__ __forceinline__ void ph_post_proj(const Ctx& C) {
    const bf16* PX = WSP(bf16, WS_PX); bf16* QP = WSP(bf16, WS_QP); bf16* KA = WSP(bf16, WS_KA); bf16* VA = WSP(bf16, WS_VA); float* U = WSP(float, WS_U);
    const float* RC = WSP(float, WS_ROPEC); const float* RS = WSP(float, WS_ROPES);
    const int lane = C.lane;
    for (int it = C.gwave; it < T * 16 + TC * 8; it += C.nwaves) {
        int r, which, h, m, rc = 0; bool latent;
        if (it < T * 16) { r = it >> 4; const int v = it & 15; which = v >> 3; h = (v >> 1) & 3; m = v & 1; latent = true; }
        else { const int j = it - T * 16; rc = j >> 3; const int v = j & 7; which = 1; h = v >> 1; m = v & 1; r = T + rc; latent = false; }
        const float x = bf2f(PX[(size_t)r * NIN + which * 512 + h * 128 + m * 64 + lane]);
        const float rstd = rsqrtf(wave_sum(x * x) * (1.0f / 64.0f) + EPS);
        float y = x * rstd * (which ? INP(IX_KNG)[lane] : INP(IX_QNG)[lane]);
        const int t = r & 4095;
        if (latent) { const int axis = lane >> 5, half = (lane >> 4) & 1, f = lane & 15, pos = axis ? (t & 63) : (t >> 6);
            const float cs = RC[pos * 16 + f], sn = RS[pos * 16 + f]; const float pr = __shfl_xor(y, 16);
            y = half == 0 ? y * cs - pr * sn : y * cs + pr * sn; }
        if (which == 0) { const size_t base = ((size_t)r * 8 + (h * 2 + m)) * 128; QP[base + m * 64 + lane] = (bf16)f2bf(y); QP[base + (1 - m) * 64 + lane] = 0; }
        else { const size_t krow = latent ? (size_t)(r >> 12) * SKV + CTX + t : (size_t)(rc >> 8) * SKV + (rc & 255); KA[krow * 512 + h * 128 + m * 64 + lane] = (bf16)f2bf(y); }
    }
    for (int i = C.gtid; i < MROWS * 64; i += C.gthreads) { const int r = i >> 6, ch = i & 63;
        const size_t vrow = r < T ? (size_t)(r >> 12) * SKV + CTX + (r & 4095) : (size_t)((r - T) >> 8) * SKV + ((r - T) & 255);
        *(v4u*)(VA + vrow * 512 + ch * 8) = *(const v4u*)(PX + (size_t)r * NIN + C_V + ch * 8); }
    const float* cw = INP(IX_CONVW); const float* cb = INP(IX_CONVB);
    for (int i = C.gtid; i < T * 512; i += C.gthreads) { const int r = i >> 9, c = i & 511, t = r & 4095; float z[2];
#pragma unroll
        for (int gsel = 0; gsel < 2; ++gsel) { const int chn = 512 * (gsel + 1) + c; const bf16* p = PX + (size_t)r * NIN + C_HY + chn;
            const float xm = t > 0 ? bf2f(p[-NIN]) : 0.f, x0 = bf2f(p[0]), xp = t < 4095 ? bf2f(p[NIN]) : 0.f;
            z[gsel] = xm * cw[chn] + x0 * cw[1536 + chn] + xp * cw[3072 + chn] + cb[chn]; }
        U[i] = z[0] * z[1]; }
}
__device__ __forceinline__ void ph_hyena_naive(const Ctx& C) {
    const float* U = WSP(float, WS_U); const float* HF = WSP(float, WS_HF); const bf16* PX = WSP(bf16, WS_PX); bf16* OB = WSP(bf16, WS_OB);
    const float* cw = INP(IX_CONVW); const float* cb = INP(IX_CONVB);
    for (int i = C.gtid; i < T * 512 / 8; i += C.gthreads) {
        const int c = i & 511, tg = i >> 9, b = tg >> 9, t0 = (tg & 511) * 8;
        float acc[8], tap[8];
#pragma unroll
        for (int j = 0; j < 8; ++j) { acc[j] = 0.f; tap[j] = HF[(size_t)(t0 + j + 4096) * 512 + c]; }
        const float* up = U + (size_t)b * SEQ * 512 + c; const float* hp = HF + (size_t)(t0 + 4095) * 512 + c;
        for (int s = 0; s < SEQ; ++s) { const float uv = up[(size_t)s * 512]; const float nt = hp[-(long)s * 512];
#pragma unroll
            for (int j = 0; j < 8; ++j) acc[j] += uv * tap[j];
#pragma unroll
            for (int j = 7; j > 0; --j) tap[j] = tap[j - 1];
            tap[0] = nt; }
#pragma unroll
        for (int j = 0; j < 8; ++j) { const int t = t0 + j; const size_t r = (size_t)b * SEQ + t; const bf16* p = PX + r * NIN + C_HY + c;
            const float xm = t > 0 ? bf2f(p[-NIN]) : 0.f, x0 = bf2f(p[0]), xp = t < 4095 ? bf2f(p[NIN]) : 0.f;
            const float z0 = xm * cw[c] + x0 * cw[1536 + c] + xp * cw[3072 + c] + cb[c];
            OB[r * 512 + c] = (bf16)f2bf(z0 * acc[j]); }
    }
}
__device__ __forceinline__ void ph_attn_post(const Ctx& C) {
    const float* O = WSP(float, WS_OATT); bf16* OA = WSP(bf16, WS_OA); const float lam = *WSP(float, WS_LAM); const float* sg = INP(IX_SUBG);
    for (int it = C.gwave; it < T * 4; it += C.nwaves) { const int r = it >> 2, h = it & 3; const float* p = O + (size_t)r * 1024 + h * 256 + C.lane;
        const float o0 = p[0] - lam * p[128], o1 = p[64] - lam * p[192];
        const float rstd = rsqrtf(wave_sum(o0 * o0 + o1 * o1) * (1.0f / 128.0f) + EPS);
        OA[(size_t)r * 512 + h * 128 + C.lane] = (bf16)f2bf(o0 * rstd * sg[C.lane] * 0.8f); OA[(size_t)r * 512 + h * 128 + 64 + C.lane] = (bf16)f2bf(o1 * rstd * sg[64 + C.lane] * 0.8f); }
}
__device__ __forceinline__ void ph_gate(const Ctx& C) {
    const float* TA = WSP(float, WS_TA); const float* TB = WSP(float, WS_TB); const bf16* GT = WSP(bf16, WS_GT); bf16* MB = WSP(bf16, WS_MB);
    for (int i = C.gtid; i < T * 256; i += C.gthreads) { const int r = i >> 8, c = (i & 255) * 4; const f32x4 a = *(const f32x4*)(TA + (size_t)r * 1024 + c), b = *(const f32x4*)(TB + (size_t)r * 1024 + c);
        const bf16* g = GT + (size_t)r * 2048 + c; float o[4];
#pragma unroll
        for (int e = 0; e < 4; ++e) o[e] = bf2f(g[e]) * a[e] + bf2f(g[1024 + e]) * b[e];
        *(unsigned long long*)(MB + (size_t)r * 1024 + c) = (unsigned long long)pk2(o[0], o[1]) | ((unsigned long long)pk2(o[2], o[3]) << 32); }
}
__device__ __forceinline__ void ph_router(const Ctx& C) {
    const float* MOD = WSP(float, WS_MOD); const float* TM = WSP(float, WS_TM); bf16* H = WSP(bf16, WS_H); const float* g2n = INP(IX_N2G); const float* RW = INP(IX_RW);
    int* TOPE = WSP(int, WS_TOPE); float* TOPW = WSP(float, WS_TOPW); unsigned* CNT = WSP(unsigned, WS_CTL) + CW_CNT;
    LAS unsigned* hist = (LAS unsigned*)C.lds;
    if (C.tid < 32) hist[C.tid] = 0u;
    __syncthreads();
    for (int r = C.gwave; r < T; r += C.nwaves) {
        const float* mrow = MOD + (r >> 12) * 6144;
        f32x4 v[4]; float ss = 0.f;
#pragma unroll
        for (int j = 0; j < 4; ++j) { const int col = 4 * C.lane + 256 * j; const f32x4 x = *(const f32x4*)(INP(IX_X) + (size_t)r * DM + col), tm = *(const f32x4*)(TM + (size_t)r * DM + col), g1 = *(const f32x4*)(mrow + 2048 + col);
            v[j] = x + g1 * tm; *(f32x4*)(C.out + (size_t)r * DM + col) = v[j]; ss += (v[j].x * v[j].x + v[j].y * v[j].y) + (v[j].z * v[j].z + v[j].w * v[j].w); }
        const float rstd = rsqrtf(wave_sum(ss) * (1.0f / DM) + EPS);
        f32x4 y[4];
#pragma unroll
        for (int j = 0; j < 4; ++j) { const int col = 4 * C.lane + 256 * j; const f32x4 gg = *(const f32x4*)(g2n + col), sh = *(const f32x4*)(mrow + 3072 + col), sc = *(const f32x4*)(mrow + 4096 + col);
            y[j] = v[j] * rstd * gg * (sc + 1.0f) + sh;
            *(unsigned long long*)(H + (size_t)r * DM + col) = (unsigned long long)pk2(y[j].x, y[j].y) | ((unsigned long long)pk2(y[j].z, y[j].w) << 32); }
        LAS float* lg = (LAS float*)(C.lds + 1024) + C.wave * 32;
#pragma unroll 1
        for (int e = 0; e < 32; ++e) { float a = 0.f;
#pragma unroll
            for (int j = 0; j < 4; ++j) { const float* wr = RW + (size_t)(4 * C.lane + 256 * j) * 32 + e; a += y[j].x * wr[0] + y[j].y * wr[32] + y[j].z * wr[64] + y[j].w * wr[96]; }
            a = wave_sum(a) + INP(IX_RB)[e];
            if (C.lane == 0) lg[e] = a; }
        LDS_WAIT();
        float p[32];
#pragma unroll
        for (int e = 0; e < 32; ++e) p[e] = lg[e];
        unsigned taken = 0u; float tv[4]; int ti[4];
#pragma unroll
        for (int k = 0; k < 4; ++k) { float best = -INFINITY; int bi = 0;
#pragma unroll
            for (int e = 0; e < 32; ++e) { const bool ok = !((taken >> e) & 1u) && p[e] > best; best = ok ? p[e] : best; bi = ok ? e : bi; }
            taken |= 1u << bi; tv[k] = best; ti[k] = bi; }
        const float e1 = __expf(tv[1] - tv[0]), e2 = __expf(tv[2] - tv[0]), e3 = __expf(tv[3] - tv[0]); const float inv = 1.0f / (1.0f + e1 + e2 + e3);
        if (C.lane == 0) { *(int4*)(TOPE + (size_t)r * 4) = make_int4(ti[0], ti[1], ti[2], ti[3]); *(f32x4*)(TOPW + (size_t)r * 4) = (f32x4){inv, e1 * inv, e2 * inv, e3 * inv};
            atomicAdd((unsigned*)&hist[ti[0]], 1u); atomicAdd((unsigned*)&hist[ti[1]], 1u); atomicAdd((unsigned*)&hist[ti[2]], 1u); atomicAdd((unsigned*)&hist[ti[3]], 1u); }
    }
    __syncthreads();
    if (C.tid < 32) atomicAdd(CNT + C.tid, hist[C.tid]);
}
__device__ __forceinline__ void ph_sort(const Ctx& C) {
    const unsigned* CNT = WSP(unsigned, WS_CTL) + CW_CNT; const int* TOPE = WSP(int, WS_TOPE); const float* TOPW = WSP(float, WS_TOPW);
    int* TOKPOS = WSP(int, WS_TOKPOS); int* ROWTOK = WSP(int, WS_ROWTOK); float* ROWW = WSP(float, WS_ROWW); int* BLKE = WSP(int, WS_BLKE);
    LAS int* wtot = (LAS int*)C.lds;
    for (int e = blockIdx.x; e < NE; e += gridDim.x) {
        int pstart = 0, cnt = 0, padded = 0;
        for (int i = 0; i <= e; ++i) { pstart += padded; cnt = (int)__hip_atomic_load(CNT + i, __ATOMIC_RELAXED, __HIP_MEMORY_SCOPE_AGENT); padded = (cnt + 255) / 256 * 256; }
        int running = 0;
        for (int a0 = 0; a0 < NA; a0 += NTHREADS) { const int a = a0 + C.tid; const bool flag = TOPE[a] == e;
            const unsigned long long bal = __ballot(flag); const int pre = __popcll(bal & ((1ull << C.lane) - 1ull)), tot = __popcll(bal);
            __syncthreads();
            if (C.lane == 0) wtot[C.wave] = tot;
            __syncthreads();
            int woff = 0, all = 0;
#pragma unroll
            for (int w = 0; w < 8; ++w) { const int x = wtot[w]; woff += (w < C.wave) ? x : 0; all += x; }
            if (flag) { const int pos = pstart + running + woff + pre; ROWTOK[pos] = a >> 2; ROWW[pos] = TOPW[a]; TOKPOS[a] = pos; }
            running += all; }
        for (int i = cnt + C.tid; i < padded; i += NTHREADS) { ROWTOK[pstart + i] = T; ROWW[pstart + i] = 0.f; }
        __syncthreads();
    }
    if (blockIdx.x == gridDim.x - 1) {
        for (int blk = C.tid; blk <= NBLK; blk += NTHREADS) { int pend = 0, e = 0; bool found = false;
            for (int i = 0; i < NE; ++i) { const int cnt = (int)__hip_atomic_load(CNT + i, __ATOMIC_RELAXED, __HIP_MEMORY_SCOPE_AGENT); pend += (cnt + 255) / 256 * 256; if (!found && blk * 256 < pend) { e = i; found = true; } }
            if (blk < NBLK) BLKE[blk] = found ? e : NE - 1; else BLKE[NBLK] = pend / 256; }
    }
}
__device__ __forceinline__ void ph_gather(const Ctx& C) {
    const int nrows = WSP(int, WS_BLKE)[NBLK] * 256; const int* ROWTOK = WSP(int, WS_ROWTOK); const bf16* H = WSP(bf16, WS_H); bf16* HS = WSP(bf16, WS_HS);
    for (int r = C.gwave; r < nrows; r += C.nwaves) { const int tok = ROWTOK[r]; v4u a = {0u, 0u, 0u, 0u}, b = {0u, 0u, 0u, 0u};
        if (tok < T) { a = *(const v4u*)(H + (size_t)tok * DM + C.lane * 16); b = *(const v4u*)(H + (size_t)tok * DM + C.lane * 16 + 8); }
        *(v4u*)(HS + (size_t)r * DM + C.lane * 16) = a; *(v4u*)(HS + (size_t)r * DM + C.lane * 16 + 8) = b; }
}
__device__ __forceinline__ void ph_combine(const Ctx& C) {
    const float* MOD = WSP(float, WS_MOD); const int* TOKPOS = WSP(int, WS_TOKPOS); const unsigned char* Y = WSP(unsigned char, WS_Y);
    typedef float f32x2_t __attribute__((ext_vector_type(2)));
    for (int i0 = C.gtid; i0 < T * 256; i0 += 4 * C.gthreads) {
        int4 ps[4]; f32x4 xo[4], g2[4]; unsigned w[4][4];
#pragma unroll
        for (int q = 0; q < 4; ++q) { const int i = i0 + q * C.gthreads; if (i < T * 256) ps[q] = *(const int4*)(TOKPOS + (size_t)(i >> 8) * 4); }
#pragma unroll
        for (int q = 0; q < 4; ++q) { const int i = i0 + q * C.gthreads; if (i < T * 256) { const int r = i >> 8, c = (i & 255) * 4;
            w[q][0] = *(const unsigned*)(Y + (size_t)ps[q].x * DM + c); w[q][1] = *(const unsigned*)(Y + (size_t)ps[q].y * DM + c); w[q][2] = *(const unsigned*)(Y + (size_t)ps[q].z * DM + c); w[q][3] = *(const unsigned*)(Y + (size_t)ps[q].w * DM + c);
            xo[q] = *(const f32x4*)(C.out + (size_t)r * DM + c); g2[q] = *(const f32x4*)(MOD + (r >> 12) * 6144 + 5120 + c); } }
#pragma unroll
        for (int q = 0; q < 4; ++q) { const int i = i0 + q * C.gthreads; if (i < T * 256) { const int r = i >> 8, c = (i & 255) * 4; f32x4 acc = {0.f, 0.f, 0.f, 0.f};
#pragma unroll
            for (int k = 0; k < 4; ++k) { const f32x2_t lo = __builtin_amdgcn_cvt_pk_f32_fp8((int)w[q][k], false), hi = __builtin_amdgcn_cvt_pk_f32_fp8((int)w[q][k], true); acc.x += lo.x; acc.y += lo.y; acc.z += hi.x; acc.w += hi.y; }
            *(f32x4*)(C.out + (size_t)r * DM + c) = xo[q] + g2[q] * acc * 0.0625f; } }
    }
}
__device__ __forceinline__ unsigned bfx(const v4u& w, int e) { const unsigned d = e < 2 ? w.x : e < 4 ? w.y : e < 6 ? w.z : w.w; return (e & 1) ? (d & 0xffff0000u) : (d << 16); }
__device__ __forceinline__ float bfe(const v4u& w, int e) { return __builtin_bit_cast(float, bfx(w, e)); }
__device__ __forceinline__ void ph_hyena_pre(const Ctx& C) {
    const bf16* HY = WSP(bf16, WS_HY); bf16* UT = WSP(bf16, WS_UT); bf16* CP = WSP(bf16, WS_CP); const float* HF = WSP(float, WS_HF);
    const float* cw = INP(IX_CONVW); const float* cb_ = INP(IX_CONVB);
    LAS bf16* tile = (LAS bf16*)C.lds;
    const int tid = C.tid;
    const bool skew = gridDim.x >= 64 && (gridDim.x & 7) == 0; const int vb0 = skew ? (int)blockIdx.x - 32 : (int)blockIdx.x, vnb = skew ? (int)gridDim.x - 32 : (int)gridDim.x;
    const bool fixc = (vnb & 7) == 0;
    const int tl = tid >> 3, c8 = (tid & 7) * 8;
    float w0[2][8], w1[2][8], w2[2][8], wb[2][8];
    if (fixc) {
#pragma unroll
        for (int gsel = 0; gsel < 2; ++gsel) { const int chn = 512 * (gsel + 1) + ((int)blockIdx.x & 7) * 64 + c8;
#pragma unroll
            for (int e = 0; e < 8; ++e) { w0[gsel][e] = cw[chn + e]; w1[gsel][e] = cw[1536 + chn + e]; w2[gsel][e] = cw[3072 + chn + e]; wb[gsel][e] = cb_[chn + e]; } } }
    const v4u zero4 = {0u, 0u, 0u, 0u};
#define HP_LOAD(IT, M, X, Q) do { const int cb_i = (IT) & 7, tb_i = ((IT) >> 3) & 63, b_i = (IT) >> 9; const int t_i = tb_i * 64 + tl; const size_t r_i = (size_t)b_i * SEQ + t_i; \
        _Pragma("unroll") for (int gsel = 0; gsel < 2; ++gsel) { const bf16* p_ = HY + r_i * 1536 + 512 * (gsel + 1) + cb_i * 64 + c8; \
            M[gsel] = t_i > 0 ? *(const v4u*)(p_ - 1536) : zero4; X[gsel] = *(const v4u*)p_; Q[gsel] = t_i < SEQ - 1 ? *(const v4u*)(p_ + 1536) : zero4; } } while (0)
    v4u cm[2], cx[2], cq[2], nm[2], nx[2], nq[2];
    int it = vb0 < 0 ? 8 * 64 * 8 : vb0;
    if (it < 8 * 64 * 8) HP_LOAD(it, cm, cx, cq);
    for (; it < 8 * 64 * 8; it += vnb) {
        const int cb = it & 7, tb = (it >> 3) & 63, b = it >> 9, c0 = cb * 64, t0 = tb * 64;
        const bool has_n = it + vnb < 8 * 64 * 8;
        if (has_n) HP_LOAD(it + vnb, nm, nx, nq);
        if (!fixc) {
#pragma unroll
            for (int gsel = 0; gsel < 2; ++gsel) { const int chn = 512 * (gsel + 1) + c0 + c8;
#pragma unroll
                for (int e = 0; e < 8; ++e) { w0[gsel][e] = cw[chn + e]; w1[gsel][e] = cw[1536 + chn + e]; w2[gsel][e] = cw[3072 + chn + e]; wb[gsel][e] = cb_[chn + e]; } } }
        float z[2][8];
#pragma unroll
        for (int gsel = 0; gsel < 2; ++gsel)
#pragma unroll
            for (int e = 0; e < 8; ++e) z[gsel][e] = bfe(cm[gsel], e) * w0[gsel][e] + bfe(cx[gsel], e) * w1[gsel][e] + bfe(cq[gsel], e) * w2[gsel][e] + wb[gsel][e];
        __syncthreads();
#pragma unroll
        for (int e = 0; e < 8; ++e) tile[(c8 + e) * 72 + tl] = (bf16)f2bf(z[0][e] * z[1][e]);
        __syncthreads();
        const v4u o = *(const LAS v4u*)(tile + (tid >> 3) * 72 + (tid & 7) * 8);
        *(v4u*)(UT + ((size_t)(c0 + (tid >> 3)) * 8 + b) * SEQ + t0 + (tid & 7) * 8) = o;
        if (has_n) {
#pragma unroll
            for (int gsel = 0; gsel < 2; ++gsel) { cm[gsel] = nm[gsel]; cx[gsel] = nx[gsel]; cq[gsel] = nq[gsel]; } }
    }
#undef HP_LOAD
    __syncthreads();
    LAS float* hfl = (LAS float*)(C.lds + 16384);
    for (int it = vb0 < 0 ? 8 * 128 : vb0; it < 8 * 128; it += vnb) {
        const int cb = it & 7, xb = it >> 3, c0 = cb * 64, x0 = xb * 64, mbase = 8192 - x0 - 70;
        __syncthreads();
        for (int idx = tid; idx < 71 * 64; idx += NTHREADS) { const int lr = idx >> 6, cc = idx & 63, mp = mbase + lr; hfl[lr * 65 + cc] = (mp >= 1 && mp <= 8191) ? HF[(size_t)mp * 512 + c0 + cc] : 0.f; }
        __syncthreads();
        const int c = tid >> 3, x8 = (tid & 7) * 8;
#pragma unroll
        for (int rho = 0; rho < 8; ++rho) { float v[8];
#pragma unroll
            for (int e = 0; e < 8; ++e) v[e] = hfl[(70 - (x8 + e) - rho) * 65 + c];
            v4u o; o.x = pk2(v[0], v[1]); o.y = pk2(v[2], v[3]); o.z = pk2(v[4], v[5]); o.w = pk2(v[6], v[7]);
            *(v4u*)(CP + ((size_t)(c0 + c) * 8 + rho) * 8192 + x0 + x8) = o; }
    }
    __syncthreads();
}
typedef float f32x16_t __attribute__((ext_vector_type(16)));
constexpr int HY_RING = 8, HY_TB = 65536;
__device__ __forceinline__ void ph_hyena_mfma(const Ctx& C) {
    const bf16* UT = WSP(bf16, WS_UT); const bf16* CP = WSP(bf16, WS_CP); bf16* YT = WSP(bf16, WS_YT);
    const int lane = C.lane, n = lane & 31, hh = lane >> 5, b = C.wave;
    LAS unsigned char* ub = C.lds + b * 8192;
    const unsigned ubo = (unsigned)b * 8192u, zrow = (unsigned)(HY_TB + HY_RING * 8192);
    const int rho = (-n) & 7, cn = (n + rho) >> 3;
    if (C.tid < 32) ((LAS unsigned*)(C.lds + HY_TB + HY_RING * 8192))[C.tid] = 0u;
    __syncthreads();
    const int fnb = b >> 2, fks = b & 3;
    const int wfix = 512 - 4 * fnb + 2 * fks + hh - cn;
    for (int c = blockIdx.x; c < 512; c += gridDim.x) {
        const bf16* src = UT + ((size_t)c * 8 + b) * SEQ;
#pragma unroll
        for (int it = 0; it < 8; ++it) { const int g = it * 64 + lane, p = g >> 3, ch = g & 7; const v4u v = *(const v4u*)(src + g * 8);
            *(LAS v4u*)(ub + p * 128 + ((ch ^ ((p >> 1) & 7)) << 4)) = v; }
        asm volatile("s_waitcnt vmcnt(0) lgkmcnt(0)" ::: "memory");
        f32x16_t acc[2][2];
#pragma unroll
        for (int i = 0; i < 2; ++i)
#pragma unroll
            for (int j = 0; j < 2; ++j)
#pragma unroll
                for (int r = 0; r < 16; ++r) acc[i][j][r] = 0.f;
        const bf16* cpl = CP + ((size_t)c * 8 + rho) * 8192;
#define HY_ISSUE2(D_, slot_) do { _Pragma("unroll") for (int h_ = 0; h_ < 2; ++h_) { const int sc_ = (2 * (D_) + h_) > 126 ? 126 : (2 * (D_) + h_); const int W_ = wfix - 8 * (sc_ - 63); \
        __builtin_amdgcn_global_load_lds((const unsigned*)(cpl + 8 * W_), (LAS unsigned*)(C.lds + HY_TB + (slot_) * 16384 + h_ * 8192 + b * 1024), 16, 0, 0); } } while (0)
#define HY_READ(TF, AF, s_, off_) do { const int d_ = (s_) - 63; const LAS unsigned char* tb_ = C.lds + HY_TB + (off_) + lane * 16; \
        _Pragma("unroll") for (int nb = 0; nb < 2; ++nb) _Pragma("unroll") for (int ks = 0; ks < 4; ++ks) TF[nb][ks] = *(const LAS bf16x8*)(tb_ + (nb * 4 + ks) * 1024); \
        _Pragma("unroll") for (int ib = 0; ib < 2; ++ib) { if (ib == 0 ? (d_ <= 31) : (d_ >= -31)) { const int p_ = 32 * ib - d_ + n; const bool v_ = (unsigned)p_ < 64u; \
            const unsigned a0_ = v_ ? (ubo + (unsigned)(p_ * 128 + (((p_ >> 1) & 7) << 4))) : zrow; \
            _Pragma("unroll") for (int ks = 0; ks < 4; ++ks) AF[ib][ks] = *(const LAS bf16x8*)(C.lds + (a0_ ^ (unsigned)((2 * ks + hh) << 4))); } } } while (0)
#define HY_MMA(TF, AF, s_) do { const int d_ = (s_) - 63; if ((s_) <= 126) { _Pragma("unroll") for (int ib = 0; ib < 2; ++ib) { if (ib == 0 ? (d_ <= 31) : (d_ >= -31)) { \
        _Pragma("unroll") for (int ks = 0; ks < 4; ++ks) _Pragma("unroll") for (int nb = 0; nb < 2; ++nb) acc[ib][nb] = __builtin_amdgcn_mfma_f32_32x32x16_bf16(AF[ib][ks], TF[nb][ks], acc[ib][nb], 0, 0, 0); } } } } while (0)
        HY_ISSUE2(0, 0); HY_ISSUE2(1, 1); HY_ISSUE2(2, 2);
        asm volatile("s_waitcnt vmcnt(2)" ::: "memory"); __builtin_amdgcn_s_barrier(); asm volatile("" ::: "memory");
        bf16x8 tfA[2][4], afA[2][4], tfB[2][4], afB[2][4];
        HY_READ(tfA, afA, 0, 0);
#pragma unroll 1
        for (int D = 0; D < 64; ++D) {
            const int slot = D & 3;
            HY_ISSUE2(D + 3, (D + 3) & 3);
            HY_READ(tfB, afB, 2 * D + 1, slot * 16384 + 8192);
            HY_MMA(tfA, afA, 2 * D);
            if (D < 63) HY_READ(tfA, afA, 2 * D + 2, ((D + 1) & 3) * 16384);
            HY_MMA(tfB, afB, 2 * D + 1);
            asm volatile("s_waitcnt vmcnt(2) lgkmcnt(0)" ::: "memory"); __builtin_amdgcn_s_barrier(); asm volatile("" ::: "memory");
        }
#undef HY_ISSUE2
#undef HY_READ
#undef HY_MMA
        asm volatile("s_waitcnt vmcnt(0)" ::: "memory");
        bf16* dst = YT + ((size_t)c * 8 + b) * SEQ;
#pragma unroll
        for (int ib = 0; ib < 2; ++ib)
#pragma unroll
            for (int nb = 0; nb < 2; ++nb)
#pragma unroll
                for (int r = 0; r < 16; ++r) { const int i = 32 * ib + (r & 3) + 8 * (r >> 2) + 4 * hh; dst[64 * i + 32 * nb + n] = (bf16)f2bf(acc[ib][nb][r]); }
        asm volatile("s_waitcnt vmcnt(0) lgkmcnt(0)" ::: "memory"); __builtin_amdgcn_s_barrier(); asm volatile("" ::: "memory");
    }
    __syncthreads();
}
__device__ __forceinline__ void ph_hyena_post(const Ctx& C) {
    const bf16* HY = WSP(bf16, WS_HY); const bf16* YT = WSP(bf16, WS_YT); bf16* OAB = WSP(bf16, WS_OAB);
    const float* cw = INP(IX_CONVW); const float* cb_ = INP(IX_CONVB);
    LAS bf16* tile = (LAS bf16*)C.lds; const int tid = C.tid;
    const int vb0 = (int)blockIdx.x, vnb = (int)gridDim.x; const bool fixc = (vnb & 7) == 0;
    const int tl = tid >> 3, c8 = (tid & 7) * 8;
    float w0[8], w1[8], w2[8], wb[8];
    if (fixc) { const int chn = (vb0 & 7) * 64 + c8;
#pragma unroll
        for (int e = 0; e < 8; ++e) { w0[e] = cw[chn + e]; w1[e] = cw[1536 + chn + e]; w2[e] = cw[3072 + chn + e]; wb[e] = cb_[chn + e]; } }
    const v4u zero4 = {0u, 0u, 0u, 0u};
#define HQ_LOAD(IT, YV, M, X, Q) do { const int cb_i = (IT) & 7, tb_i = ((IT) >> 3) & 63, b_i = (IT) >> 9; const int t_i = tb_i * 64 + tl; \
        YV = *(const v4u*)(YT + ((size_t)(cb_i * 64 + (tid >> 3)) * 8 + b_i) * SEQ + tb_i * 64 + (tid & 7) * 8); \
        const bf16* p_ = HY + ((size_t)b_i * SEQ + t_i) * 1536 + cb_i * 64 + c8; \
        M = t_i > 0 ? *(const v4u*)(p_ - 1536) : zero4; X = *(const v4u*)p_; Q = t_i < SEQ - 1 ? *(const v4u*)(p_ + 1536) : zero4; } while (0)
    v4u cy, cm, cx, cq, ny, nm, nx, nq;
    int it = vb0;
    if (it < 8 * 64 * 8) HQ_LOAD(it, cy, cm, cx, cq);
    for (; it < 8 * 64 * 8; it += vnb) {
        const int cb = it & 7, tb = (it >> 3) & 63, b = it >> 9, c0 = cb * 64, t0 = tb * 64;
        const bool has_n = it + vnb < 8 * 64 * 8;
        if (has_n) HQ_LOAD(it + vnb, ny, nm, nx, nq);
        if (!fixc) { const int chn = c0 + c8;
#pragma unroll
            for (int e = 0; e < 8; ++e) { w0[e] = cw[chn + e]; w1[e] = cw[1536 + chn + e]; w2[e] = cw[3072 + chn + e]; wb[e] = cb_[chn + e]; } }
        __syncthreads();
        *(LAS v4u*)(tile + (tid >> 3) * 72 + (tid & 7) * 8) = cy;
        __syncthreads();
        const int t = t0 + tl, chn = c0 + c8; const size_t r = (size_t)b * SEQ + t;
        float o[8];
#pragma unroll
        for (int e = 0; e < 8; ++e) { const float z0 = bfe(cm, e) * w0[e] + bfe(cx, e) * w1[e] + bfe(cq, e) * w2[e] + wb[e]; o[e] = z0 * bf2f(tile[(c8 + e) * 72 + tl]); }
        v4u w; w.x = pk2(o[0], o[1]); w.y = pk2(o[2], o[3]); w.z = pk2(o[4], o[5]); w.w = pk2(o[6], o[7]);
        *(v4u*)(OAB + r * 1024 + 512 + chn) = w;
        if (has_n) { cy = ny; cm = nm; cx = nx; cq = nq; }
    }
#undef HQ_LOAD
    __syncthreads();
}

__device__ __forceinline__ void v8t_chunk(const bf16* VA, unsigned char* V8T, int b, int h, int tk, int ci) {
    const int d0 = ci >> 7, half = (ci >> 6) & 1, ln = ci & 63, n = ln & 31, kg = ln >> 5;
    const bf16* src = VA + ((size_t)b * SKV + 64 * tk + 32 * half + 4 * kg) * 512 + h * 128 + 32 * d0 + n;
    float v[16];
#pragma unroll
    for (int e = 0; e < 16; ++e) v[e] = bf2f(src[(size_t)((e & 3) + 8 * (e >> 2)) * 512]);
    v4u o; o.x = pg8::pk4_fp8(v[0], v[1], v[2], v[3]); o.y = pg8::pk4_fp8(v[4], v[5], v[6], v[7]); o.z = pg8::pk4_fp8(v[8], v[9], v[10], v[11]); o.w = pg8::pk4_fp8(v[12], v[13], v[14], v[15]);
    *(v4u*)(V8T + ((size_t)((b * 4 + h) * (SKV / 64) + tk) * 512 + ci) * 16) = o;
}
__device__ __forceinline__ void ph_v8t(const Ctx& C) {
    const bf16* VA = WSP(bf16, WS_VA); unsigned char* V8T = WSP(unsigned char, WS_V8T);
    constexpr int NTL = SKV / 64 - 4;
    const bool skew = gridDim.x >= 64; const int t0 = skew ? C.gtid - 32 * NTHREADS : C.gtid, tn = skew ? C.gthreads - 32 * NTHREADS : C.gthreads;
    for (int i = t0 < 0 ? NB * 4 * NTL * 512 : t0; i < NB * 4 * NTL * 512; i += tn) { const int ci = i & 511, tk = 4 + (i >> 9) % NTL, bh = (i >> 9) / NTL; v8t_chunk(VA, V8T, bh >> 2, bh & 3, tk, ci); }
}
__device__ __forceinline__ void ph_v8t_ctx(const Ctx& C, int b, int h0) {
    const bf16* VA = WSP(bf16, WS_VA); unsigned char* V8T = WSP(unsigned char, WS_V8T);
    for (int i = C.tid; i < 2 * 4 * 512; i += NTHREADS) v8t_chunk(VA, V8T, b, h0 + (i >> 11), (i >> 9) & 3, i & 511);
}
__device__ __forceinline__ unsigned char f8b(float v) { return (unsigned char)(pg8::pk4_fp8(v, 0.f, 0.f, 0.f) & 0xffu); }
__device__ __forceinline__ void ph_hyena_pre8(const Ctx& C) {
    const bf16* HY = WSP(bf16, WS_HY); unsigned char* UT = WSP(unsigned char, WS_UT); unsigned char* CP = WSP(unsigned char, WS_CP); const float* HF = WSP(float, WS_HF);
    const float* cw = INP(IX_CONVW); const float* cb_ = INP(IX_CONVB);
    LAS unsigned char* tile = C.lds;
    const int tid = C.tid;
    const bool skew = gridDim.x >= 64 && (gridDim.x & 7) == 0; const int vb0 = skew ? (int)blockIdx.x - 32 : (int)blockIdx.x, vnb = skew ? (int)gridDim.x - 32 : (int)gridDim.x;
    const bool fixc = (vnb & 7) == 0;
    const int tl = tid >> 3, c8 = (tid & 7) * 8;
    float w0[2][8], w1[2][8], w2[2][8], wb[2][8];
    if (fixc) {
#pragma unroll
        for (int gsel = 0; gsel < 2; ++gsel) { const int chn = 512 * (gsel + 1) + ((int)blockIdx.x & 7) * 64 + c8;
#pragma unroll
            for (int e = 0; e < 8; ++e) { w0[gsel][e] = cw[chn + e]; w1[gsel][e] = cw[1536 + chn + e]; w2[gsel][e] = cw[3072 + chn + e]; wb[gsel][e] = cb_[chn + e]; } } }
    const v4u zero4 = {0u, 0u, 0u, 0u};
#define HP_LOAD(IT, M, X, Q) do { const int cb_i = (IT) & 7, tb_i = ((IT) >> 3) & 63, b_i = (IT) >> 9; const int t_i = tb_i * 64 + tl; const size_t r_i = (size_t)b_i * SEQ + t_i; \
        _Pragma("unroll") for (int gsel = 0; gsel < 2; ++gsel) { const bf16* p_ = HY + r_i * 1536 + 512 * (gsel + 1) + cb_i * 64 + c8; \
            M[gsel] = t_i > 0 ? *(const v4u*)(p_ - 1536) : zero4; X[gsel] = *(const v4u*)p_; Q[gsel] = t_i < SEQ - 1 ? *(const v4u*)(p_ + 1536) : zero4; } } while (0)
    v4u cm[2], cx[2], cq[2], nm[2], nx[2], nq[2];
    int it = vb0 < 0 ? 8 * 64 * 8 : vb0;
    if (it < 8 * 64 * 8) HP_LOAD(it, cm, cx, cq);
    for (; it < 8 * 64 * 8; it += vnb) {
        const int cb = it & 7, tb = (it >> 3) & 63, b = it >> 9, c0 = cb * 64, t0 = tb * 64;
        const bool has_n = it + vnb < 8 * 64 * 8;
        if (has_n) HP_LOAD(it + vnb, nm, nx, nq);
        if (!fixc) {
#pragma unroll
            for (int gsel = 0; gsel < 2; ++gsel) { const int chn = 512 * (gsel + 1) + c0 + c8;
#pragma unroll
                for (int e = 0; e < 8; ++e) { w0[gsel][e] = cw[chn + e]; w1[gsel][e] = cw[1536 + chn + e]; w2[gsel][e] = cw[3072 + chn + e]; wb[gsel][e] = cb_[chn + e]; } } }
        float z[2][8];
#pragma unroll
        for (int gsel = 0; gsel < 2; ++gsel)
#pragma unroll
            for (int e = 0; e < 8; ++e) z[gsel][e] = bfe(cm[gsel], e) * w0[gsel][e] + bfe(cx[gsel], e) * w1[gsel][e] + bfe(cq[gsel], e) * w2[gsel][e] + wb[gsel][e];
        __syncthreads();
#pragma unroll
        for (int e = 0; e < 8; ++e) tile[(c8 + e) * 80 + tl] = f8b(z[0][e] * z[1][e]);
        __syncthreads();
        const unsigned long long o = *(const LAS unsigned long long*)(tile + (tid >> 3) * 80 + (tid & 7) * 8);
        *(unsigned long long*)(UT + ((size_t)(c0 + (tid >> 3)) * 8 + b) * SEQ + t0 + (tid & 7) * 8) = o;
        if (has_n) {
#pragma unroll
            for (int gsel = 0; gsel < 2; ++gsel) { cm[gsel] = nm[gsel]; cx[gsel] = nx[gsel]; cq[gsel] = nq[gsel]; } }
    }
#undef HP_LOAD
    __syncthreads();
    LAS float* hfl = (LAS float*)(C.lds + 16384);
    for (int it2 = vb0 < 0 ? 8 * 128 : vb0; it2 < 8 * 128; it2 += vnb) {
        const int cb = it2 & 7, xb = it2 >> 3, c0 = cb * 64, x0 = xb * 64, mbase = 8192 - x0 - 78;
        __syncthreads();
        for (int idx = tid; idx < 79 * 64; idx += NTHREADS) { const int lr = idx >> 6, cc = idx & 63, mp = mbase + lr; hfl[lr * 65 + cc] = (mp >= 1 && mp <= 8191) ? HF[(size_t)mp * 512 + c0 + cc] * 64.0f : 0.f; }
        __syncthreads();
        const int c = tid >> 3, x8 = (tid & 7) * 8;
#pragma unroll 4
        for (int rho = 0; rho < 16; ++rho) { float v[8];
#pragma unroll
            for (int e = 0; e < 8; ++e) v[e] = hfl[(78 - (x8 + e) - rho) * 65 + c];
            *(unsigned long long*)(CP + ((size_t)(c0 + c) * 16 + rho) * 8192 + x0 + x8) = (unsigned long long)pg8::pk4_fp8(v[0], v[1], v[2], v[3]) | ((unsigned long long)pg8::pk4_fp8(v[4], v[5], v[6], v[7]) << 32); }
    }
    __syncthreads();
}
typedef int v8i_h8 __attribute__((ext_vector_type(8)));
typedef int v4i_h8 __attribute__((ext_vector_type(4)));
constexpr int H8_TB = 32768, H8_Z = 65536;
__device__ __forceinline__ void ph_hyena_mfma8(const Ctx& C) {
    const unsigned char* UT = WSP(unsigned char, WS_UT); const unsigned char* CP = WSP(unsigned char, WS_CP); bf16* YT = WSP(bf16, WS_YT);
    const int lane = C.lane, n = lane & 31, hh = lane >> 5, b = C.wave;
    const unsigned ubo = (unsigned)b * 4096u, zrow = (unsigned)H8_Z;
    const int rho = (-n) & 15, cn = (n + rho) >> 4;
    if (C.tid < 16) ((LAS unsigned*)(C.lds + H8_Z))[C.tid] = 0u;
    __syncthreads();
    const int fh = b >> 2, fnb = (b >> 1) & 1, fhalf = b & 1;
    const int wfix = 256 - 2 * fnb + 2 * hh - cn;
    for (int c = blockIdx.x; c < 512; c += gridDim.x) {
        const unsigned char* src = UT + ((size_t)c * 8 + b) * SEQ;
#pragma unroll
        for (int it = 0; it < 4; ++it) { const int g = it * 64 + lane, p = g >> 2, c4 = g & 3; const v4u v = *(const v4u*)(src + g * 16);
            *(LAS v4u*)(C.lds + ubo + p * 64 + ((c4 ^ ((p >> 2) & 3)) << 4)) = v; }
        asm volatile("s_waitcnt vmcnt(0) lgkmcnt(0)" ::: "memory");
        f32x16_t acc[2][2];
#pragma unroll
        for (int i = 0; i < 2; ++i)
#pragma unroll
            for (int j = 0; j < 2; ++j)
#pragma unroll
                for (int r = 0; r < 16; ++r) acc[i][j][r] = 0.f;
        const unsigned char* cpl = CP + ((size_t)c * 16 + rho) * 8192 + 16 * fhalf;
#define H8_ISSUE(D_, slot_) do { const int sc_ = (2 * (D_) + fh) > 126 ? 126 : (2 * (D_) + fh); const int W_ = wfix - 4 * (sc_ - 63); \
        __builtin_amdgcn_global_load_lds((const unsigned*)(cpl + 16 * W_), (LAS unsigned*)(C.lds + H8_TB + (slot_) * 8192 + b * 1024), 16, 0, 0); } while (0)
#define H8_READ(TF, AF, s_, off_) do { const int d_ = (s_) - 63; const LAS unsigned char* tb_ = C.lds + H8_TB + (off_) + lane * 16; \
        _Pragma("unroll") for (int nb = 0; nb < 2; ++nb) { const v4i_h8 lo_ = *(const LAS v4i_h8*)(tb_ + (nb * 2 + 0) * 1024), hi_ = *(const LAS v4i_h8*)(tb_ + (nb * 2 + 1) * 1024); TF[nb] = __builtin_shufflevector(lo_, hi_, 0, 1, 2, 3, 4, 5, 6, 7); } \
        _Pragma("unroll") for (int ib = 0; ib < 2; ++ib) { if (ib == 0 ? (d_ <= 31) : (d_ >= -31)) { const int p_ = 32 * ib - d_ + n; const bool v_ = (unsigned)p_ < 64u; \
            const unsigned a0_ = v_ ? (ubo + (unsigned)(p_ * 64 + (((p_ >> 2) & 3) << 4))) : zrow; \
            const v4i_h8 lo_ = *(const LAS v4i_h8*)(C.lds + (a0_ ^ (unsigned)((2 * hh) << 4))), hi_ = *(const LAS v4i_h8*)(C.lds + (a0_ ^ (unsigned)((2 * hh + 1) << 4))); AF[ib] = __builtin_shufflevector(lo_, hi_, 0, 1, 2, 3, 4, 5, 6, 7); } } } while (0)
#define H8_MMA(TF, AF, s_) do { const int d_ = (s_) - 63; if ((s_) <= 126) { _Pragma("unroll") for (int ib = 0; ib < 2; ++ib) { if (ib == 0 ? (d_ <= 31) : (d_ >= -31)) { \
        _Pragma("unroll") for (int nb = 0; nb < 2; ++nb) acc[ib][nb] = __builtin_amdgcn_mfma_scale_f32_32x32x64_f8f6f4(AF[ib], TF[nb], acc[ib][nb], 0, 0, 0, 0x7F7F7F7F, 0, 0x79797979); } } } } while (0)
        H8_ISSUE(0, 0); H8_ISSUE(1, 1); H8_ISSUE(2, 2);
        asm volatile("s_waitcnt vmcnt(1)" ::: "memory"); __builtin_amdgcn_s_barrier(); asm volatile("" ::: "memory");
        v8i_h8 tfA[2], afA[2], tfB[2], afB[2];
#pragma unroll
        for (int i = 0; i < 2; ++i) { afA[i] = (v8i_h8){0, 0, 0, 0, 0, 0, 0, 0}; afB[i] = (v8i_h8){0, 0, 0, 0, 0, 0, 0, 0}; }
        H8_READ(tfA, afA, 0, 0);
#pragma unroll 1
        for (int D = 0; D < 64; ++D) {
            const int slot = D & 3;
            H8_ISSUE(D + 3, (D + 3) & 3);
            H8_READ(tfB, afB, 2 * D + 1, slot * 8192 + 4096);
            H8_MMA(tfA, afA, 2 * D);
            if (D < 63) H8_READ(tfA, afA, 2 * D + 2, ((D + 1) & 3) * 8192);
            H8_MMA(tfB, afB, 2 * D + 1);
            asm volatile("s_waitcnt vmcnt(1) lgkmcnt(0)" ::: "memory"); __builtin_amdgcn_s_barrier(); asm volatile("" ::: "memory");
        }
#undef H8_ISSUE
#undef H8_READ
#undef H8_MMA
        asm volatile("s_waitcnt vmcnt(0)" ::: "memory");
        bf16* dst = YT + ((size_t)c * 8 + b) * SEQ;
#pragma unroll
        for (int ib = 0; ib < 2; ++ib)
#pragma unroll
            for (int nb = 0; nb < 2; ++nb)
#pragma unroll
                for (int r = 0; r < 16; ++r) { const int i = 32 * ib + (r & 3) + 8 * (r >> 2) + 4 * hh; dst[64 * i + 32 * nb + n] = (bf16)f2bf(acc[ib][nb][r]); }
        asm volatile("s_waitcnt vmcnt(0) lgkmcnt(0)" ::: "memory"); __builtin_amdgcn_s_barrier(); asm volatile("" ::: "memory");
    }
    __syncthreads();
}
constexpr int LDS_HIST = RING_BYTES + 1024, LDS_LG = RING_BYTES + 2048;
__device__ __forceinline__ void ph_router2(const Ctx& C) {
    const float* MOD = WSP(float, WS_MOD); const float* SSQ = WSP(float, WS_SSQ); bf16* H = WSP(bf16, WS_H); const float* g2n = INP(IX_N2G); const float* RW = INP(IX_RW);
    int* TOPE = WSP(int, WS_TOPE); float* TOPW = WSP(float, WS_TOPW); unsigned* CNTB = WSP(unsigned, WS_CNTB);
    LAS unsigned* hist = (LAS unsigned*)(C.lds + LDS_HIST);
    const int lane = C.lane, tid = C.tid;
    for (int i = tid; i < 1024 * 8; i += NTHREADS) { const int k = i >> 3, ch = i & 7; const f32x4 w = *(const f32x4*)(RW + (size_t)k * 32 + ch * 4);
        *(LAS f32x4*)(C.lds + k * 128 + ((ch ^ ((k >> 1) & 7)) << 4)) = w; }
    const float rb = INP(IX_RB)[lane >> 1];
    for (int chk = blockIdx.x; chk < T / 128; chk += gridDim.x) {
        __syncthreads();
        if (tid < 32) hist[tid] = 0u;
        __syncthreads();
#pragma unroll 1
        for (int ri = 0; ri < 16; ++ri) {
            const int r = chk * 128 + C.wave * 16 + ri; const float* mrow = MOD + (r >> 12) * 6144;
            float v[16]; float ss = 0.f;
#pragma unroll
            for (int m = 0; m < 16; ++m) { const int col = lane + 64 * m; v[m] = C.out[(size_t)r * DM + col]; }
            ss = lane < 16 ? SSQ[(size_t)r * 16 + lane] : 0.f;
            const float rstd = rsqrtf(wave_sum(ss) * (1.0f / DM) + EPS);
            float p[32];
#pragma unroll
            for (int e = 0; e < 32; ++e) p[e] = 0.f;
#pragma unroll
            for (int m = 0; m < 16; ++m) { const int col = lane + 64 * m; const float y = v[m] * rstd * g2n[col] * (mrow[4096 + col] + 1.0f) + mrow[3072 + col];
                H[(size_t)r * DM + col] = (bf16)f2bf(y);
                const LAS unsigned char* wrow = C.lds + col * 128; const int sw = (col >> 1) & 7; asm volatile("" ::: "memory");
#pragma unroll
                for (int q = 0; q < 8; ++q) { const f32x4 w = *(const LAS f32x4*)(wrow + ((q ^ sw) << 4)); p[4 * q] += y * w.x; p[4 * q + 1] += y * w.y; p[4 * q + 2] += y * w.z; p[4 * q + 3] += y * w.w; } }
#define HALVE(N_, MASK_) _Pragma("unroll") for (int e = 0; e < (N_); ++e) { const float a = p[e], b2 = p[e + (N_)]; const bool up = (lane & (MASK_)) != 0; const float send = up ? a : b2, keep = up ? b2 : a; p[e] = keep + __shfl_xor(send, (MASK_)); }
            HALVE(16, 32) HALVE(8, 16) HALVE(4, 8) HALVE(2, 4) HALVE(1, 2)
#undef HALVE
            float lg = p[0] + __shfl_xor(p[0], 1) + rb;
            const int myid = lane >> 1;
            float tv[4]; int ti[4];
#pragma unroll
            for (int k = 0; k < 4; ++k) { float bv = lg; int bi = myid;
#pragma unroll
                for (int mask = 2; mask < 64; mask <<= 1) { const float ov = __shfl_xor(bv, mask); const int oi = __shfl_xor(bi, mask); const bool take = ov > bv || (ov == bv && oi < bi); bv = take ? ov : bv; bi = take ? oi : bi; }
                tv[k] = bv; ti[k] = bi; if (myid == bi) lg = -INFINITY; }
            const float e1 = __expf(tv[1] - tv[0]), e2 = __expf(tv[2] - tv[0]), e3 = __expf(tv[3] - tv[0]); const float inv = 1.0f / (1.0f + e1 + e2 + e3);
            if (lane == 0) { *(int4*)(TOPE + (size_t)r * 4) = make_int4(ti[0], ti[1], ti[2], ti[3]); *(f32x4*)(TOPW + (size_t)r * 4) = (f32x4){inv, e1 * inv, e2 * inv, e3 * inv};
                __hip_atomic_fetch_add(&hist[ti[0]], 1u, __ATOMIC_RELAXED, __HIP_MEMORY_SCOPE_WORKGROUP); __hip_atomic_fetch_add(&hist[ti[1]], 1u, __ATOMIC_RELAXED, __HIP_MEMORY_SCOPE_WORKGROUP);
                __hip_atomic_fetch_add(&hist[ti[2]], 1u, __ATOMIC_RELAXED, __HIP_MEMORY_SCOPE_WORKGROUP); __hip_atomic_fetch_add(&hist[ti[3]], 1u, __ATOMIC_RELAXED, __HIP_MEMORY_SCOPE_WORKGROUP); }
        }
        __syncthreads();
        if (tid < 32) CNTB[chk * 32 + tid] = hist[tid];
    }
    __syncthreads();
}
__device__ __forceinline__ void ph_sort2(const Ctx& C) {
    const unsigned* CNTB = WSP(unsigned, WS_CNTB); const int* TOPE = WSP(int, WS_TOPE); const float* TOPW = WSP(float, WS_TOPW);
    int* TOKPOS = WSP(int, WS_TOKPOS); int* ROWTOK = WSP(int, WS_ROWTOK); float* ROWW = WSP(float, WS_ROWW); int* BLKE = WSP(int, WS_BLKE);
    LAS int* ptot = (LAS int*)C.lds;
    LAS int* pbef = ptot + 512;
    LAS int* tot = pbef + 512;
    LAS int* base = tot + 32;
    LAS int* pst = base + 32;
    LAS int* wt = pst + 64;
    const int tid = C.tid, lane = C.lane;
    for (int chk = blockIdx.x; chk < T / 128; chk += gridDim.x) {
        __syncthreads();
        { const int e = tid & 31, part = tid >> 5; int s = 0, sb = 0;
          for (int c2 = part * 16; c2 < part * 16 + 16; ++c2) { const int v = (int)CNTB[c2 * 32 + e]; s += v; sb += (c2 < chk) ? v : 0; }
          ptot[part * 32 + e] = s; pbef[part * 32 + e] = sb; }
        __syncthreads();
        if (tid < 32) { int s = 0, sb = 0;
#pragma unroll
            for (int pp = 0; pp < 16; ++pp) { s += ptot[pp * 32 + tid]; sb += pbef[pp * 32 + tid]; }
            tot[tid] = s; base[tid] = sb; }
        __syncthreads();
        if (tid < 33) { int ps = 0; for (int i = 0; i < tid; ++i) ps += (tot[i] + 255) / 256 * 256; pst[tid] = ps; }
        __syncthreads();
        const int a = chk * 512 + tid; const int ea = TOPE[a]; int pre = 0;
#pragma unroll 4
        for (int e = 0; e < 32; ++e) { const unsigned long long bal = __ballot(ea == e); if (lane == 0) wt[C.wave * 32 + e] = __popcll(bal); if (ea == e) pre = __popcll(bal & ((1ull << lane) - 1ull)); }
        __syncthreads();
        int woff = 0;
#pragma unroll
        for (int w = 0; w < 8; ++w) woff += (w < C.wave) ? wt[w * 32 + ea] : 0;
        const int pos = pst[ea] + base[ea] + woff + pre;
        ROWTOK[pos] = a >> 2; ROWW[pos] = TOPW[a]; TOKPOS[a] = pos;
        if (chk < NE) { const int e = chk, st = pst[e] + tot[e], en = pst[e + 1]; for (int i = st + tid; i < en; i += NTHREADS) { ROWTOK[i] = T; ROWW[i] = 0.f; } }
        if (chk == 0 && tid < DM / 16) ((v4u*)(WSP(unsigned char, WS_H) + (size_t)T * DM))[tid] = (v4u){0u, 0u, 0u, 0u};
        if (chk == T / 128 - 1) { for (int blk = tid; blk <= NBLK; blk += NTHREADS) { int e = NE - 1;
#pragma unroll 1
                for (int i = NE - 1; i >= 0; --i) if (blk * 256 < pst[i + 1]) e = i;
                if (blk < NBLK) BLKE[blk] = e; else BLKE[NBLK] = pst[NE] / 256; } }
    }
    __syncthreads();
}
constexpr int LDS_GS = RING_BYTES + 4096;
__device__ __forceinline__ void ph_router3(const Ctx& C) {
    const float* MOD = WSP(float, WS_MOD); const float* SSQ = WSP(float, WS_SSQ); unsigned char* H = WSP(unsigned char, WS_H); const float* g2n = INP(IX_N2G); const float* RW = INP(IX_RW);
    int* TOPE = WSP(int, WS_TOPE); float* TOPW = WSP(float, WS_TOPW); unsigned* CNTB = WSP(unsigned, WS_CNTB);
    LAS float* Wl = (LAS float*)C.lds; LAS float* gsl = (LAS float*)(C.lds + LDS_GS); LAS float* shl = gsl + 1024;
    LAS unsigned* hist = (LAS unsigned*)(C.lds + LDS_HIST);
    const int lane = C.lane, tid = C.tid, i = lane & 15, kk = lane >> 4;
    for (int i0 = tid; i0 < 1024 * 32; i0 += 8 * NTHREADS) { float wv[8];
#pragma unroll
        for (int u = 0; u < 8; ++u) wv[u] = RW[i0 + u * NTHREADS];
#pragma unroll
        for (int u = 0; u < 8; ++u) { const int idx = i0 + u * NTHREADS, k = idx >> 5, ex = idx & 31, q = k >> 4, k2 = (k >> 2) & 3, e = k & 3, nb = ex >> 4, j = ex & 15;
            Wl[((q * 4 + e) * 2 + nb) * 64 + k2 * 16 + j] = wv[u]; } }
    const float rb0 = INP(IX_RB)[i], rb1 = INP(IX_RB)[16 + i];
    for (int chk = blockIdx.x; chk < T / 128; chk += gridDim.x) {
        __syncthreads();
        const float* mrow = MOD + (chk >> 5) * 6144;
        for (int k = tid; k < 1024; k += NTHREADS) { gsl[k] = g2n[k] * (1.0f + mrow[4096 + k]); shl[k] = mrow[3072 + k]; }
        if (tid < 32) hist[tid] = 0u;
        __syncthreads();
        const int r0 = chk * 128 + C.wave * 16, r = r0 + i;
        float ss; { const f32x4 s4 = *(const f32x4*)(SSQ + (size_t)r * 16 + 4 * kk); ss = (s4[0] + s4[1]) + (s4[2] + s4[3]); ss += __shfl_xor(ss, 16); ss += __shfl_xor(ss, 32); }
        const float rstd = rsqrtf(ss * (1.0f / DM) + EPS);
        f32x4 acc0 = {0.f, 0.f, 0.f, 0.f}, acc1 = {0.f, 0.f, 0.f, 0.f};
        const float* xr = C.out + (size_t)r * DM + 4 * kk; unsigned char* hr = H + (size_t)r * DM + 4 * kk;
#pragma unroll 8
        for (int q = 0; q < 64; ++q) {
            const f32x4 x = *(const f32x4*)(xr + 16 * q); const f32x4 gs = *(const LAS f32x4*)(gsl + 16 * q + 4 * kk), sh = *(const LAS f32x4*)(shl + 16 * q + 4 * kk);
            const f32x4 h = x * rstd * gs + sh;
            *(unsigned*)(hr + 16 * q) = pg8::pk4_fp8(h[0], h[1], h[2], h[3]);
#pragma unroll
            for (int e = 0; e < 4; ++e) { const float b0 = Wl[((q * 4 + e) * 2 + 0) * 64 + lane], b1 = Wl[((q * 4 + e) * 2 + 1) * 64 + lane];
                acc0 = __builtin_amdgcn_mfma_f32_16x16x4f32(h[e], b0, acc0, 0, 0, 0); acc1 = __builtin_amdgcn_mfma_f32_16x16x4f32(h[e], b1, acc1, 0, 0, 0); }
        }
#pragma unroll
        for (int reg = 0; reg < 4; ++reg) {
            float v0 = acc0[reg] + rb0, v1 = acc1[reg] + rb1; float tv[4]; int ti[4];
#pragma unroll
            for (int k = 0; k < 4; ++k) { const bool f0 = v0 >= v1; float bv = f0 ? v0 : v1; int bi = f0 ? i : 16 + i;
#pragma unroll
                for (int mask = 1; mask < 16; mask <<= 1) { const float ov = __shfl_xor(bv, mask); const int oi = __shfl_xor(bi, mask); const bool take = ov > bv || (ov == bv && oi < bi); bv = take ? ov : bv; bi = take ? oi : bi; }
                tv[k] = bv; ti[k] = bi; if (bi == i) v0 = -INFINITY; if (bi == 16 + i) v1 = -INFINITY; }
            const float e1 = __expf(tv[1] - tv[0]), e2 = __expf(tv[2] - tv[0]), e3 = __expf(tv[3] - tv[0]); const float inv = 1.0f / (1.0f + e1 + e2 + e3);
            if (i == 0) { const size_t row = (size_t)(r0 + 4 * kk + reg); *(int4*)(TOPE + row * 4) = make_int4(ti[0], ti[1], ti[2], ti[3]); *(f32x4*)(TOPW + row * 4) = (f32x4){inv, e1 * inv, e2 * inv, e3 * inv};
                __hip_atomic_fetch_add(&hist[ti[0]], 1u, __ATOMIC_RELAXED, __HIP_MEMORY_SCOPE_WORKGROUP); __hip_atomic_fetch_add(&hist[ti[1]], 1u, __ATOMIC_RELAXED, __HIP_MEMORY_SCOPE_WORKGROUP);
                __hip_atomic_fetch_add(&hist[ti[2]], 1u, __ATOMIC_RELAXED, __HIP_MEMORY_SCOPE_WORKGROUP); __hip_atomic_fetch_add(&hist[ti[3]], 1u, __ATOMIC_RELAXED, __HIP_MEMORY_SCOPE_WORKGROUP); }
        }
        __syncthreads();
        if (tid < 32) CNTB[chk * 32 + tid] = hist[tid];
    }
    __syncthreads();
}
__device__ __forceinline__ void ph_attention(const Ctx& C) {
    const unsigned char* Q8 = WSP(unsigned char, WS_QP); const unsigned char* K8 = WSP(unsigned char, WS_KA); const unsigned char* V8T = WSP(unsigned char, WS_V8T); bf16* OA = WSP(bf16, WS_OAB);
    const float lam = *WSP(float, WS_LAM); const float* sg = INP(IX_SUBG);
    const float sbound = 0.20358f * sqrtf(__uint_as_float(WSP(unsigned, WS_CTL)[CW_NMAX]) * __uint_as_float(WSP(unsigned, WS_CTL)[CW_NMAX + 64]));
    const bool nomax = (SKV / 64) % 2 == 0 && __builtin_amdgcn_readfirstlane((int)(sbound > 0.f && sbound <= 15.6f)) != 0;
    const bool xl = gridDim.x == 256;
#define ATT_UNITS(NM) for (int it = 0; it < (xl ? 4 : (NB * 4 * (SEQ / 128) + (int)gridDim.x - 1) / (int)gridDim.x); ++it) { \
        int u; \
        if (xl) { const int x = blockIdx.x & 7, j = blockIdx.x >> 3; u = ((4 * x + it) << 5) | j; } else { u = blockIdx.x + it * gridDim.x; if (u >= NB * 4 * (SEQ / 128)) break; } \
        const int qb = u & 31, h = (u >> 5) & 3, b = u >> 7; \
        const long q0 = ((long)b * SEQ + qb * 128) * 512 + h * 128, k0 = (long)b * SKV * 512 + h * 128, o0 = ((long)b * SEQ + qb * 128) * 1024 + h * 128, v0 = (long)(b * 4 + h) * (SKV / 64) * 8192; \
        __syncthreads(); \
        att::attn_diff_body8<NM>(Q8 + q0, K8 + k0, V8T + v0, OA + o0, SKV, C.ldsg, C.lds, lam, sg, 0.8f); }
    if (nomax) { ATT_UNITS(true) } else { ATT_UNITS(false) }
#undef ATT_UNITS
    __syncthreads();
}
enum { PH_PREP = 0, PH_MOD1, PH_INPROJ, PH_POST, PH_ATTN, PH_HYENA, PH_ATTNPOST, PH_MERGEUP, PH_WOUT, PH_ROUTER, PH_SORT, PH_MOE1, PH_MOE2, PH_COMBINE, N_PHASES };
struct Args { const float* in[N_INPUTS]; float* out; unsigned char* ws; int ph_lo, ph_hi, li, pad; };
static_assert(sizeof(Args) == N_INPUTS * 8 + 8 + 8 + 16, "Args has no padding");

#ifndef PG8_ALIGN
#define PG8_ALIGN true
#endif
namespace cg = cooperative_groups;
__global__ void __launch_bounds__(NTHREADS, 2) fwd(Args args) {
    cg::grid_group grid_g = cg::this_grid();
    extern __shared__ __attribute__((aligned(16))) unsigned char lds_raw[];
    Ctx C;
    C.out = args.out; C.ws = args.ws; C.lds = (LAS unsigned char*)lds_raw; C.ldsg = (char*)lds_raw;
    C.tid = threadIdx.x; C.lane = C.tid & 63; C.wave = __builtin_amdgcn_readfirstlane(C.tid >> 6);
    C.gwave = blockIdx.x * NWAVES + C.wave; C.nwaves = gridDim.x * NWAVES; C.gtid = blockIdx.x * NTHREADS + C.tid; C.gthreads = gridDim.x * NTHREADS;
    const int lo = args.ph_lo, hi = args.ph_hi;
    volatile LAS unsigned* MISC = (volatile LAS unsigned*)(C.lds + MISC_OFF);
    if (C.tid < 32) MISC[C.tid] = 0u;
    __syncthreads();
    unsigned* barw = (unsigned*)(C.ws + WS_CTL) + CW_BAR + args.li * XCD_BAR_WORDS;
    XcdBarrier xbar; xbar.bar = barw; xbar.x = 0; xbar.st = nullptr;
    if (hi - lo > 1) xbar = xcd_barrier_post(barw, MISC + 8);
#define IN(k) (lo <= (k) && (k) < hi)
#define SEAM(k) do { if (IN(k) && IN((k) + 1)) { if (args.li < 0) grid_g.sync(); else xcd_barrier(xbar); } } while (0)
    if (IN(PH_PREP)) { ph_prep_weights(C); __syncthreads(); ph_prep_ada(C); __syncthreads(); ph_prep_misc(C); ph_prep_filter(C); }
    SEAM(PH_PREP);
    if (IN(PH_MOD1)) { ph_modulate1(C); }
    SEAM(PH_MOD1);
    if (IN(PH_INPROJ)) {
        {
            LAS float* tb = (LAS float*)(C.lds + RING_BYTES + 20480);
            for (int i = C.tid; i < 1024; i += NTHREADS) { tb[i] = WSP(float, WS_ROPEC)[i]; tb[1024 + i] = WSP(float, WS_ROPES)[i]; }
            if (C.tid < 64) { tb[2048 + C.tid] = INP(IX_QNG)[C.tid]; tb[2048 + 64 + C.tid] = INP(IX_KNG)[C.tid]; }
            __syncthreads(); }
        {
            pg8::Gemm g{WSP(bf16, WS_XM), WSP(bf16, WS_WIN), T, 3072, DM, 0}; pg8::WinOrder S; S.so.init(T, 3072, gridDim.x, (int)blockIdx.x); S.pn0 = 0;
            pg8::EpiInProj E{WSP(bf16, WS_QP), WSP(bf16, WS_KA), WSP(bf16, WS_VA), WSP(bf16, WS_HY), WSP(bf16, WS_GT), INP(IX_BIN), C.lds, T, SKV, CTX, WSP(unsigned, WS_CTL) + CW_NMAX};
            pg8::gemm_phase<pg8::EpiInProj, pg8::WinOrder, PG8_ALIGN, true>(C.lds, g, S, E); }
        {
            pg8::Gemm g{WSP(bf16, WS_XM8), (const bf16*)(WSP(unsigned char, WS_WG8) - (size_t)12 * 256 * 1024), T, 2048, DM / 2, 0}; pg8::WinOrder S; S.so.init(T, 2048, gridDim.x, (int)blockIdx.x); S.pn0 = 12;
            pg8::EpiInProjT<true> E{WSP(bf16, WS_QP), WSP(bf16, WS_KA), WSP(bf16, WS_VA), WSP(bf16, WS_HY), WSP(bf16, WS_GT), INP(IX_BIN), C.lds, T, SKV, CTX, WSP(unsigned, WS_CTL) + CW_NMAX};
            pg8::gemm_phase<pg8::EpiInProjT<true>, pg8::WinOrder, PG8_ALIGN, true>(C.lds, g, S, E); }
    }
    SEAM(PH_INPROJ);
    if (IN(PH_POST)) {
        {
            LAS float* tb = (LAS float*)(C.lds + RING_BYTES + 20480);
            for (int i = C.tid; i < 1024; i += NTHREADS) { tb[i] = WSP(float, WS_ROPEC)[i]; tb[1024 + i] = WSP(float, WS_ROPES)[i]; }
            if (C.tid < 64) { tb[2048 + C.tid] = INP(IX_QNG)[C.tid]; tb[2048 + 64 + C.tid] = INP(IX_KNG)[C.tid]; }
            __syncthreads(); }
        { pg8::Gemm g{WSP(bf16, WS_XM), WSP(bf16, WS_WIN), MROWS, NIN, DM, 0}; pg8::CtxOrder S{(int)gridDim.x, (int)blockIdx.x};
          pg8::EpiInProj E{WSP(bf16, WS_QP), WSP(bf16, WS_KA), WSP(bf16, WS_VA), WSP(bf16, WS_HY), WSP(bf16, WS_GT), INP(IX_BIN), C.lds, T, SKV, CTX, WSP(unsigned, WS_CTL) + CW_NMAX};
          pg8::gemm_phase<pg8::EpiInProj, pg8::CtxOrder, true, true>(C.lds, g, S, E); }
        asm volatile("s_waitcnt vmcnt(0)" ::: "memory"); __syncthreads();
        if (gridDim.x >= 32 && blockIdx.x >= 16 && blockIdx.x < 32) ph_v8t_ctx(C, (int)blockIdx.x & 7, 2 * (((int)blockIdx.x >> 3) - 2));
        __syncthreads(); ph_hyena_pre8(C); ph_v8t(C); }
    SEAM(PH_POST);
    if (IN(PH_ATTN)) { ph_attention(C); }
    if (IN(PH_HYENA)) { ph_hyena_mfma8(C); }
    SEAM(PH_HYENA);
    if (IN(PH_ATTNPOST)) { ph_hyena_post(C); }
    SEAM(PH_ATTNPOST);
    if (IN(PH_MERGEUP)) {
        pg8::Gemm g{WSP(bf16, WS_OAB), WSP(bf16, WS_WA), T, DM, DM, 0}; pg8::StaticOrder S; S.init(T, DM, gridDim.x, (int)blockIdx.x);
        pg8::EpiMerge E{WSP(bf16, WS_MB), WSP(bf16, WS_GT)}; pg8::gemm_phase<pg8::EpiMerge, pg8::StaticOrder, PG8_ALIGN, true>(C.lds, g, S, E);
    }
    SEAM(PH_MERGEUP);
    if (IN(PH_WOUT)) {
        pg8::Gemm g{WSP(bf16, WS_MB), WSP(bf16, WS_WO), T, DM, DM, 0}; pg8::StaticOrder S; S.init(T, DM, gridDim.x, (int)blockIdx.x);
        pg8::EpiWout E{INP(IX_X), C.out, WSP(float, WS_MOD), WSP(float, WS_SSQ)}; pg8::gemm_phase<pg8::EpiWout, pg8::StaticOrder, PG8_ALIGN, true>(C.lds, g, S, E);
    }
    SEAM(PH_WOUT);
    if (IN(PH_ROUTER)) { ph_router3(C); }
    SEAM(PH_ROUTER);
    if (IN(PH_SORT)) { ph_sort2(C); }
    SEAM(PH_SORT);
    if (IN(PH_MOE1)) {
        const int nblk = WSP(int, WS_BLKE)[NBLK];
        pg8::MoeGatherOrder S; S.so.init(nblk * 256, 2048, gridDim.x, (int)blockIdx.x); S.blke = WSP(int, WS_BLKE); S.tokl = (const LAS unsigned short*)(C.lds + LDS_GS);
        {
            LAS unsigned short* tl = (LAS unsigned short*)(C.lds + LDS_GS); const int* ROWTOK = WSP(int, WS_ROWTOK); pg8::Unit uu;
            LAS int* pml = (LAS int*)(C.lds + LDS_GS + 10240);
            if (C.tid == 0) { for (int ui = 0; ui < 20; ++ui) pml[ui] = S.so.next(ui, uu) ? uu.pm : -1; }
            __syncthreads();
#define TL_LD(u) const int pm##u = pml[u]; int tv##u = 0; if (pm##u >= 0 && C.tid < 256) tv##u = ROWTOK[pm##u * 256 + C.tid];
#define TL_ST(u) if (C.tid < 256) tl[(u) * 256 + C.tid] = (unsigned short)tv##u;
            TL_LD(0) TL_LD(1) TL_LD(2) TL_LD(3) TL_LD(4) TL_LD(5) TL_LD(6) TL_LD(7) TL_LD(8) TL_LD(9) TL_LD(10) TL_LD(11) TL_LD(12) TL_LD(13) TL_LD(14) TL_LD(15) TL_LD(16) TL_LD(17) TL_LD(18) TL_LD(19)
            TL_ST(0) TL_ST(1) TL_ST(2) TL_ST(3) TL_ST(4) TL_ST(5) TL_ST(6) TL_ST(7) TL_ST(8) TL_ST(9) TL_ST(10) TL_ST(11) TL_ST(12) TL_ST(13) TL_ST(14) TL_ST(15) TL_ST(16) TL_ST(17) TL_ST(18) TL_ST(19)
#undef TL_LD
#undef TL_ST
        }
        __syncthreads();
        pg8::Gemm g{WSP(bf16, WS_H), WSP(bf16, WS_W1), nblk * 256, 2048, DM / 2, (size_t)2048 * 1024};
        pg8::EpiSwiglu E{WSP(unsigned char, WS_ACT), INP(IX_EB1), C.lds}; pg8::gemm_phase<pg8::EpiSwiglu, pg8::MoeGatherOrder, PG8_ALIGN, true>(C.lds, g, S, E);
    }
    SEAM(PH_MOE1);
    if (IN(PH_MOE2)) {
        const int nblk = WSP(int, WS_BLKE)[NBLK];
        pg8::Gemm g{WSP(bf16, WS_ACT), WSP(bf16, WS_W2), nblk * 256, DM, DM / 2, (size_t)1024 * 1024}; pg8::MoeOrder S; S.so.init(nblk * 256, DM, gridDim.x, (int)blockIdx.x); S.blke = WSP(int, WS_BLKE);
        pg8::EpiY E{WSP(unsigned char, WS_Y), INP(IX_EB2), WSP(float, WS_ROWW), C.lds}; pg8::gemm_phase<pg8::EpiY, pg8::MoeOrder, PG8_ALIGN, true>(C.lds, g, S, E);
    }
    SEAM(PH_MOE2);
    if (IN(PH_COMBINE)) { ph_combine(C); }
#undef IN
#undef SEAM
}

extern "C" void kernel_launch(void* const* d_in, const int* in_sizes, int n_in, void* d_out, int out_size, void* d_ws, size_t ws_size, hipStream_t stream) {
    static int grid = 0;
    if (grid == 0) {
        if (n_in != N_INPUTS || in_sizes[0] != T * DM || out_size != T * DM || ws_size < WS_END) { fprintf(stderr, "kernel_launch: unexpected shapes n_in %d in0 %d out %d ws %zu (need %zu)\n", n_in, n_in > 0 ? in_sizes[0] : -1, out_size, ws_size, (size_t)WS_END); grid = -1; return; }
        int dev = 0, cus = 0;
        if (hipGetDevice(&dev) != hipSuccess || hipDeviceGetAttribute(&cus, hipDeviceAttributeMultiprocessorCount, dev) != hipSuccess) { grid = -1; return; }
        if (hipFuncSetAttribute((const void*)fwd, hipFuncAttributeMaxDynamicSharedMemorySize, LDS_BYTES) != hipSuccess) { fprintf(stderr, "kernel_launch: hipFuncSetAttribute failed\n"); grid = -1; return; }
        int per_cu = 0;
        if (hipOccupancyMaxActiveBlocksPerMultiprocessor(&per_cu, (const void*)fwd, NTHREADS, LDS_BYTES) != hipSuccess || per_cu < 1) { fprintf(stderr, "kernel_launch: occupancy query says %d blocks per CU\n", per_cu); grid = -1; return; }
        grid = cus;
    }
    if (grid < 0) return;
    (void)hipMemsetAsync((char*)d_ws + WS_CTL, 0, CTL_BYTES, stream);
    Args a{};
    for (int i = 0; i < N_INPUTS; ++i) a.in[i] = (const float*)d_in[i];
    a.out = (float*)d_out; a.ws = (unsigned char*)d_ws;
#ifndef PROBE_DUP
#define PROBE_DUP -1
#endif
    int cuts[5] = {0, N_PHASES, N_PHASES, N_PHASES, N_PHASES}, nl = 1;
    if (PROBE_DUP >= 0) { cuts[1] = PROBE_DUP + 1; cuts[2] = PROBE_DUP; cuts[3] = PROBE_DUP + 1; nl = 4; }
    for (int li = 0; li < (PROBE_DUP >= 0 ? 3 : 1); ++li) {
        if (PROBE_DUP >= 0) { a.ph_lo = li == 0 ? 0 : (li == 1 ? PROBE_DUP : PROBE_DUP + 1); a.ph_hi = li == 2 ? N_PHASES : PROBE_DUP + 1; } else { a.ph_lo = 0; a.ph_hi = N_PHASES; }
        a.li = li; (void)cuts; (void)nl;
        if (a.ph_lo >= a.ph_hi) continue;
        void* kargs[] = {&a};
        const hipError_t le = hipLaunchCooperativeKernel((const void*)fwd, dim3(grid), dim3(NTHREADS), kargs, LDS_BYTES, stream);
        if (le != hipSuccess) fprintf(stderr, "kernel_launch: cooperative launch failed: %s (grid %d)\n", hipGetErrorString(le), grid);
    }
}
```

```cpp
#include <hip/hip_runtime.h>
#include <hip/hip_bf16.h>
#include <hip/hip_cooperative_groups.h>
#include <cstdio>
#include <cstdint>
#include <cmath>
namespace pg8 {
#define PG8_LAS __attribute__((address_space(3)))
typedef unsigned short bf16_t;
typedef short bf16x8 __attribute__((ext_vector_type(8)));
typedef float f32x4 __attribute__((ext_vector_type(4)));
typedef unsigned u32x4 __attribute__((ext_vector_type(4)));
typedef int v4i_t __attribute__((ext_vector_type(4)));
typedef int v8i_t __attribute__((ext_vector_type(8)));
constexpr int EPI_OFF = 131072 + 16384;
constexpr int BM = 256, BK = 64, HALF = 128, HTB = HALF * BK * 2  , STAGE_BYTES = 8 * HTB, NXCD = 8, WGM = 8;

__host__ __device__ __forceinline__ int lds_byte(int r, int c) { const int st = (r >> 4) * 2 + (c >> 5), rr = r & 15, cc = c & 31, ob = rr * 64 + cc * 2; return st * 1024 + (ob ^ (((ob >> 9) & 1) << 5)); }
__host__ __device__ __forceinline__ void stage_rc(int b, int& R, int& C) { const int st = b / 1024, sb = b % 1024, swz = sb ^ (((sb >> 9) & 1) << 5); R = (st >> 1) * 16 + swz / 64; C = (st & 1) * 32 + (swz % 64) / 2; }
__host__ __device__ __forceinline__ int perm32(int rho) { const int n = rho >> 4, i = rho & 15; return 8 * (i >> 2) + 4 * n + (i & 3); }

struct Unit { int pm, pn, be, es; };
struct Gemm { const bf16_t* A; const bf16_t* Bt; int M, N, K; size_t bstride; };

struct StaticOrder {
    static constexpr bool GATHER = false;
    int nM, nN, nwg, G, c;
    __host__ __device__ __forceinline__ void init(int M, int N, int G_, int c_) { nM = M / BM; nN = N / BM; nwg = nM * nN; G = G_; c = c_; }
    __host__ __device__ __forceinline__ bool next(int i, Unit& u) const {
        const long L = (long)i * G + c; if (L >= nwg) return false;
        int wgid = (int)L; { const int q = nwg / NXCD, r = nwg % NXCD, xcd = wgid % NXCD, off = wgid / NXCD; wgid = (xcd < r ? xcd * (q + 1) : r * (q + 1) + (xcd - r) * q) + off; }
        const int nig = WGM * nN, gid = wgid / nig, fm = gid * WGM, gsz = (nM - fm) < WGM ? (nM - fm) : WGM;
        u.pm = fm + ((wgid % nig) % gsz); u.pn = (wgid % nig) / gsz; u.be = 0; u.es = 0; return true;
    }
    __device__ __forceinline__ void a_ready(const Unit&) const {}
    __device__ __forceinline__ void done(const Unit&) const {}
};

__device__ __forceinline__ unsigned cvt_pk_bf16(float lo, float hi) { unsigned r; asm volatile("v_cvt_pk_bf16_f32 %0, %1, %2" : "=v"(r) : "v"(lo), "v"(hi)); return r; }
typedef float f32x2 __attribute__((ext_vector_type(2)));
__device__ __forceinline__ f32x2 gelu_pk(f32x2 v) {
    const f32x2 av = __builtin_elementwise_abs(v), d = av * 0.2316418882f + 1.0f;
    f32x2 t; t.x = __builtin_amdgcn_rcpf(d.x); t.y = __builtin_amdgcn_rcpf(d.y);
    f32x2 q = t * 0.5307027145f + (-0.7265760135f); q = q * t + 0.7107068705f; q = q * t + (-0.142248368f); q = q * t + 0.127414796f; q = q * t;
    const f32x2 s = (v * v) * (-0.72134752044f);
    f32x2 e; e.x = __builtin_amdgcn_exp2f(s.x); e.y = __builtin_amdgcn_exp2f(s.y);
    const f32x2 m = v * (q * e), r = v - m;
    f32x2 o; o.x = v.x < 0.f ? m.x : r.x; o.y = v.y < 0.f ? m.y : r.y; return o;
}

template <int ACT  > struct EpiBf16 {
    static constexpr bool PERM = true, AFTER_DRAIN = false, HAS_MID = false, F8 = false, PREFETCH = false; static constexpr int WSCALE = 0x7F7F7F7F; static_assert(ACT == 0 || ACT == 1, "EpiBf16: ACT is 0 (none) or 1 (gelu_pk)");
    bf16_t* O; int ldc; const float* bias; int split_cols; size_t split_stride; float scale0;
    __device__ __forceinline__ void operator()(const f32x4 (&acc)[2][2][4][2], const Unit& u, int wr, int wc, int fr, int fq) const {
        const int row0 = u.pm * BM + wr * 64 + fr; int colt = u.pn * BM; bf16_t* base = O;
        float sc = 1.f; if (split_cols) { const int t = colt / split_cols; base += (size_t)t * split_stride; colt -= t * split_cols; if (t == 0) sc = scale0; }
        const int col0 = colt + wc * 32 + 8 * fq, bcol0 = u.pn * BM + wc * 32 + 8 * fq;
        f32x4 bv[2][2];
#pragma unroll
        for (int bj = 0; bj < 2; ++bj)
#pragma unroll
            for (int n = 0; n < 2; ++n) bv[bj][n] = bias ? *(const f32x4*)(bias + bcol0 + bj * HALF + 4 * n) : (f32x4){0.f, 0.f, 0.f, 0.f};
#pragma unroll
        for (int ai = 0; ai < 2; ++ai)
#pragma unroll
            for (int m = 0; m < 4; ++m) { bf16_t* rowp = base + (size_t)(row0 + ai * HALF + m * 16) * ldc + col0;
#pragma unroll
                for (int bj = 0; bj < 2; ++bj) { f32x4 v0 = acc[ai][bj][m][0] + bv[bj][0], v1 = acc[ai][bj][m][1] + bv[bj][1];
                    if (ACT == 1) { f32x2 a = gelu_pk((f32x2){v0[0], v0[1]}), b = gelu_pk((f32x2){v0[2], v0[3]}), c = gelu_pk((f32x2){v1[0], v1[1]}), d = gelu_pk((f32x2){v1[2], v1[3]});
                        v0 = (f32x4){a.x, a.y, b.x, b.y}; v1 = (f32x4){c.x, c.y, d.x, d.y}; }
                    v0 = v0 * sc; v1 = v1 * sc; u32x4 w; w.x = cvt_pk_bf16(v0[0], v0[1]); w.y = cvt_pk_bf16(v0[2], v0[3]); w.z = cvt_pk_bf16(v1[0], v1[1]); w.w = cvt_pk_bf16(v1[2], v1[3]);
                    *(u32x4*)(rowp + bj * HALF) = w; } }
    }
};
struct EpiF32 {
    static constexpr bool PERM = false, AFTER_DRAIN = false, HAS_MID = false, F8 = false, PREFETCH = false; static constexpr int WSCALE = 0x7F7F7F7F;
    float* C; int ldc; const float* bias;
    __device__ __forceinline__ void operator()(const f32x4 (&acc)[2][2][4][2], const Unit& u, int wr, int wc, int fr, int fq) const {
        const int row0 = u.pm * BM + wr * 64 + fr, col0 = u.pn * BM + wc * 32 + 4 * fq;
        f32x4 bv[2][2];
#pragma unroll
        for (int bj = 0; bj < 2; ++bj)
#pragma unroll
            for (int n = 0; n < 2; ++n) bv[bj][n] = bias ? *(const f32x4*)(bias + col0 + bj * HALF + n * 16) : (f32x4){0.f, 0.f, 0.f, 0.f};
#pragma unroll
        for (int ai = 0; ai < 2; ++ai)
#pragma unroll
            for (int m = 0; m < 4; ++m) { float* rowp = C + (size_t)(row0 + ai * HALF + m * 16) * ldc + col0;
#pragma unroll
                for (int bj = 0; bj < 2; ++bj)
#pragma unroll
                    for (int n = 0; n < 2; ++n) *(f32x4*)(rowp + bj * HALF + n * 16) = acc[ai][bj][m][n] + bv[bj][n]; }
    }
};
__device__ __forceinline__ void epi_dma(const void* src, PG8_LAS unsigned char* dst) { __builtin_amdgcn_global_load_lds((const unsigned*)src, (PG8_LAS unsigned*)dst, 16, 0, 0); }
__device__ __forceinline__ unsigned pk4_fp8(float a, float b, float c, float d) {
    a = __builtin_fminf(__builtin_fmaxf(a, -448.f), 448.f); b = __builtin_fminf(__builtin_fmaxf(b, -448.f), 448.f); c = __builtin_fminf(__builtin_fmaxf(c, -448.f), 448.f); d = __builtin_fminf(__builtin_fmaxf(d, -448.f), 448.f);
    int w = 0; w = __builtin_amdgcn_cvt_pk_fp8_f32(a, b, w, false); w = __builtin_amdgcn_cvt_pk_fp8_f32(c, d, w, true); return (unsigned)w; }
struct EpiSwiglu {
    static constexpr bool PERM = true, AFTER_DRAIN = false, HAS_MID = false, F8 = true, PREFETCH = true; static constexpr int WSCALE = 0x7A7A7A7A;
    unsigned char* O; const float* b1; PG8_LAS unsigned char* el;
    __device__ __forceinline__ void prefetch(const Unit& u, int slot, int wid, int lane) const {
        if (wid == 0) epi_dma(b1 + (size_t)u.be * 2048 + (lane >> 5) * 1024 + u.pn * HALF + (lane & 31) * 4, el + EPI_OFF + slot * 2048); }
    __device__ __forceinline__ void operator()(const f32x4 (&acc)[2][2][4][2], const Unit& u, int wr, int wc, int fr, int fq) const {
        const int row0 = u.pm * BM + wr * 64 + fr; const int ch0 = u.pn * HALF + wc * 32 + 8 * fq;
        const PG8_LAS float* bb = (const PG8_LAS float*)(el + EPI_OFF + u.es * 2048) + wc * 32 + 8 * fq;
        f32x4 bg[2], bu[2];
#pragma unroll
        for (int n = 0; n < 2; ++n) { bg[n] = *(const PG8_LAS f32x4*)(bb + 4 * n); bu[n] = *(const PG8_LAS f32x4*)(bb + 128 + 4 * n); }
#pragma unroll
        for (int ai = 0; ai < 2; ++ai)
#pragma unroll
            for (int m = 0; m < 4; ++m) { unsigned char* rowp = O + (size_t)(row0 + ai * HALF + m * 16) * 1024 + ch0;
                f32x4 a[2];
#pragma unroll
                for (int n = 0; n < 2; ++n) { const f32x4 g = acc[ai][0][m][n] + bg[n], up = acc[ai][1][m][n] + bu[n];
#pragma unroll
                    for (int e = 0; e < 4; ++e) { const float gg = fminf(g[e], 7.0f), uu = fminf(fmaxf(up[e], -7.0f), 7.0f);
                        const float sg = __builtin_amdgcn_rcpf(1.0f + __builtin_amdgcn_exp2f(-1.702f * 1.4426950408889634f * gg));
                        a[n][e] = (uu + 1.0f) * gg * sg; } }
                *(unsigned long long*)rowp = (unsigned long long)pk4_fp8(a[0][0], a[0][1], a[0][2], a[0][3]) | ((unsigned long long)pk4_fp8(a[1][0], a[1][1], a[1][2], a[1][3]) << 32); }
    }
};
struct EpiY {
    static constexpr bool PERM = true, AFTER_DRAIN = false, HAS_MID = false, F8 = true; static constexpr int WSCALE = 0x7A7A7A7A;
    unsigned char* O; const float* b2; const float* roww; PG8_LAS unsigned char* el;
    static constexpr bool PREFETCH = true;
    __device__ __forceinline__ void prefetch(const Unit& u, int slot, int wid, int lane) const {
        if (wid == 0) epi_dma(b2 + (size_t)u.be * 1024 + u.pn * BM + lane * 4, el + EPI_OFF + slot * 2048);
        if (wid == 1) epi_dma(roww + (size_t)u.pm * BM + lane * 4, el + EPI_OFF + slot * 2048 + 1024); }
    __device__ __forceinline__ void operator()(const f32x4 (&acc)[2][2][4][2], const Unit& u, int wr, int wc, int fr, int fq) const {
        const int row0 = u.pm * BM + wr * 64 + fr; const int col0 = u.pn * BM + wc * 32 + 8 * fq;
        const PG8_LAS float* sl = (const PG8_LAS float*)(el + EPI_OFF + u.es * 2048); const PG8_LAS float* bb = sl + wc * 32 + 8 * fq;
        f32x4 bv[2][2];
#pragma unroll
        for (int bj = 0; bj < 2; ++bj)
#pragma unroll
            for (int n = 0; n < 2; ++n) bv[bj][n] = *(const PG8_LAS f32x4*)(bb + bj * HALF + 4 * n);
#pragma unroll
        for (int ai = 0; ai < 2; ++ai)
#pragma unroll
            for (int m = 0; m < 4; ++m) { const int row = row0 + ai * HALF + m * 16; const float rw = sl[256 + ai * HALF + wr * 64 + m * 16 + fr] * 16.0f; unsigned char* rowp = O + (size_t)row * 1024 + col0;
#pragma unroll
                for (int bj = 0; bj < 2; ++bj) { const f32x4 v0 = (acc[ai][bj][m][0] + bv[bj][0]) * rw, v1 = (acc[ai][bj][m][1] + bv[bj][1]) * rw;
                    *(unsigned long long*)(rowp + bj * HALF) = (unsigned long long)pk4_fp8(v0[0], v0[1], v0[2], v0[3]) | ((unsigned long long)pk4_fp8(v1[0], v1[1], v1[2], v1[3]) << 32); } }
    }
};
struct MoeOrder {
    static constexpr bool GATHER = false;
    StaticOrder so; const int* blke;
    __device__ __forceinline__ bool next(int i, Unit& u) const { if (!so.next(i, u)) return false; u.be = blke[u.pm]; return true; }
    __device__ __forceinline__ void a_ready(const Unit&) const {}
    __device__ __forceinline__ void done(const Unit&) const {}
};
__device__ __forceinline__ void st_bf16x4(bf16_t* p, const f32x4& v) { *(unsigned long long*)p = (unsigned long long)cvt_pk_bf16(v[0], v[1]) | ((unsigned long long)cvt_pk_bf16(v[2], v[3]) << 32); }
template <bool F8_> struct EpiInProjT {
    static constexpr bool PERM = false, AFTER_DRAIN = false, HAS_MID = false, F8 = F8_, PREFETCH = true; static constexpr int WSCALE = F8_ ? 0x7A7A7A7A : 0x7F7F7F7F;
    bf16_t *QP, *KA, *VA, *HY, *GT; const float* bias; PG8_LAS unsigned char* el; int T_, SKV_, CTX_; unsigned* nmax;
    static constexpr int TAB_OFF = 131072 + 20480;
    __device__ __forceinline__ void prefetch(const Unit& u, int slot, int wid, int lane) const { if (wid == 0) epi_dma(bias + 256 * u.pn + lane * 4, el + EPI_OFF + slot * 2048); }
    __device__ __forceinline__ void operator()(const f32x4 (&acc)[2][2][4][2], const Unit& u, int wr, int wc, int fr_, int fq_) const {
        int fr = fr_, fq = fq_; asm volatile("" : "+v"(fr), "+v"(fq));
        const int pn = u.pn;
        if (pn < 4) {
            const bool isk = pn >= 2; const PG8_LAS float* g = (const PG8_LAS float*)(el + TAB_OFF + 8192 + (isk ? 256 : 0)); const PG8_LAS float* bsl = (const PG8_LAS float*)(el + EPI_OFF + u.es * 2048);
            const PG8_LAS float* rc = (const PG8_LAS float*)(el + TAB_OFF); const PG8_LAS float* rs = rc + 1024;
            f32x4 bv[2][2], gv[2][2];
#pragma unroll
            for (int bj = 0; bj < 2; ++bj)
#pragma unroll
                for (int n = 0; n < 2; ++n) { bv[bj][n] = *(const PG8_LAS f32x4*)(bsl + 64 * wc + 32 * bj + 16 * n + 4 * fq); gv[bj][n] = *(const PG8_LAS f32x4*)(g + 32 * bj + 16 * n + 4 * fq); }
            float nrm2 = 0.f;
#pragma unroll
            for (int ai = 0; ai < 2; ++ai)
#pragma unroll
                for (int m = 0; m < 4; ++m) { const int r = u.pm * BM + ai * HALF + wr * 64 + m * 16 + fr;
                    f32x4 x[2][2]; float ss = 0.f;
#pragma unroll
                    for (int bj = 0; bj < 2; ++bj)
#pragma unroll
                        for (int n = 0; n < 2; ++n) { x[bj][n] = acc[ai][bj][m][n] + bv[bj][n]; ss += (x[bj][n][0] * x[bj][n][0] + x[bj][n][1] * x[bj][n][1]) + (x[bj][n][2] * x[bj][n][2] + x[bj][n][3] * x[bj][n][3]); }
                    ss += __shfl_xor(ss, 16); ss += __shfl_xor(ss, 32);
                    const float rstd = rsqrtf(ss * (1.0f / 64.0f) + 1e-6f);
#pragma unroll
                    for (int bj = 0; bj < 2; ++bj)
#pragma unroll
                        for (int n = 0; n < 2; ++n) x[bj][n] = x[bj][n] * rstd * gv[bj][n];
                    { float s2 = 0.f;
#pragma unroll
                      for (int bj = 0; bj < 2; ++bj)
#pragma unroll
                        for (int n = 0; n < 2; ++n) s2 += (x[bj][n][0] * x[bj][n][0] + x[bj][n][1] * x[bj][n][1]) + (x[bj][n][2] * x[bj][n][2] + x[bj][n][3] * x[bj][n][3]);
                      s2 += __shfl_xor(s2, 16); s2 += __shfl_xor(s2, 32); nrm2 = fmaxf(nrm2, s2); }
                    const bool latent = r < T_; const int t = r & 4095;
                    if (latent) {
#pragma unroll
                        for (int bj = 0; bj < 2; ++bj) { const int pos = bj ? (t & 63) : (t >> 6); const f32x4 cs = *(const PG8_LAS f32x4*)(rc + pos * 16 + 4 * fq), sn = *(const PG8_LAS f32x4*)(rs + pos * 16 + 4 * fq);
                            const f32x4 x1 = x[bj][0], x2 = x[bj][1]; x[bj][0] = x1 * cs - x2 * sn; x[bj][1] = x2 * cs + x1 * sn; } }
                    if (!isk) { unsigned char* base = (unsigned char*)QP + (size_t)r * 512 + 256 * (pn & 1) + 64 * wc;
#pragma unroll
                        for (int bj = 0; bj < 2; ++bj)
#pragma unroll
                            for (int n = 0; n < 2; ++n) { const f32x4 v = x[bj][n] * 0.72134752044448170f; *(unsigned*)(base + 32 * bj + 16 * n + 4 * fq) = pk4_fp8(v[0], v[1], v[2], v[3]); } }
                    else { const size_t krow = latent ? (size_t)(r >> 12) * SKV_ + CTX_ + t : (size_t)((r - T_) >> 8) * SKV_ + ((r - T_) & 255); unsigned char* base = (unsigned char*)KA + krow * 512 + 256 * (pn & 1) + 64 * wc;
#pragma unroll
                        for (int bj = 0; bj < 2; ++bj)
#pragma unroll
                            for (int n = 0; n < 2; ++n) { const f32x4 v = x[bj][n]; *(unsigned*)(base + 32 * bj + 16 * n + 4 * fq) = pk4_fp8(v[0], v[1], v[2], v[3]); } }
                }
            nrm2 = fmaxf(nrm2, __shfl_xor(nrm2, 1)); nrm2 = fmaxf(nrm2, __shfl_xor(nrm2, 2)); nrm2 = fmaxf(nrm2, __shfl_xor(nrm2, 4)); nrm2 = fmaxf(nrm2, __shfl_xor(nrm2, 8));
            if (fr == 0 && fq == 0) (void)__hip_atomic_fetch_max(nmax + (isk ? 64 : 0), __float_as_uint(nrm2), __ATOMIC_RELAXED, __HIP_MEMORY_SCOPE_AGENT);
        } else {
            const int kind = pn < 6 ? 0 : (pn < 12 ? 1 : 2);
            const int lc0 = 32 * wc + 8 * fq;
            f32x4 bv[2][2];
#pragma unroll
            for (int bj = 0; bj < 2; ++bj)
#pragma unroll
                for (int n = 0; n < 2; ++n) bv[bj][n] = *(const PG8_LAS f32x4*)((const PG8_LAS float*)(el + EPI_OFF + u.es * 2048) + 128 * bj + lc0 + 4 * n);
#pragma unroll
            for (int ai = 0; ai < 2; ++ai)
#pragma unroll
                for (int m = 0; m < 4; ++m) { const int r = u.pm * BM + ai * HALF + wr * 64 + m * 16 + fr;
                    bf16_t* rowp;
                    if (kind == 0) { const size_t vrow = r < T_ ? (size_t)(r >> 12) * SKV_ + CTX_ + (r & 4095) : (size_t)((r - T_) >> 8) * SKV_ + ((r - T_) & 255); rowp = VA + vrow * 512 + 256 * (pn - 4) + lc0; }
                    else if (kind == 1) rowp = HY + (size_t)r * 1536 + 256 * (pn - 6) + lc0;
                    else rowp = GT + (size_t)r * 2048 + 256 * (pn - 12) + lc0;
#pragma unroll
                    for (int bj = 0; bj < 2; ++bj) { f32x4 v0 = acc[ai][bj][m][0] + bv[bj][0], v1 = acc[ai][bj][m][1] + bv[bj][1];
                        if (kind == 2) {
#pragma unroll
                            for (int e = 0; e < 4; ++e) { v0[e] = __builtin_amdgcn_rcpf(1.0f + __builtin_amdgcn_exp2f(-1.4426950408889634f * v0[e])); v1[e] = __builtin_amdgcn_rcpf(1.0f + __builtin_amdgcn_exp2f(-1.4426950408889634f * v1[e])); } }
                        u32x4 w; w.x = cvt_pk_bf16(v0[0], v0[1]); w.y = cvt_pk_bf16(v0[2], v0[3]); w.z = cvt_pk_bf16(v1[0], v1[1]); w.w = cvt_pk_bf16(v1[2], v1[3]);
                        *(u32x4*)(rowp + bj * HALF) = w; } }
        }
    }
};
typedef EpiInProjT<false> EpiInProj;
struct WinOrder {
    static constexpr bool GATHER = false;
    StaticOrder so; int pn0;
    __device__ __forceinline__ bool next(int i, Unit& u) const { if (!so.next(i, u)) return false; u.pn += pn0; return true; }
    __device__ __forceinline__ void a_ready(const Unit&) const {}
    __device__ __forceinline__ void done(const Unit&) const {}
};
struct CtxOrder {
    static constexpr bool GATHER = false;
    int G, c;
    __device__ __forceinline__ bool next(int i, Unit& u) const { const int L = i * G + c; if (L >= 32) return false; u.pm = 128 + (L & 7); u.pn = 2 + (L >> 3); u.be = 0; u.es = 0; return true; }
    __device__ __forceinline__ void a_ready(const Unit&) const {}
    __device__ __forceinline__ void done(const Unit&) const {}
};

__device__ __forceinline__ float bf_lo(unsigned d) { return __builtin_bit_cast(float, d << 16); }
__device__ __forceinline__ float bf_hi(unsigned d) { return __builtin_bit_cast(float, d & 0xffff0000u); }
struct EpiMerge {
    static constexpr bool PERM = true, AFTER_DRAIN = false, HAS_MID = true, F8 = false, PREFETCH = false; static constexpr int WSCALE = 0x7F7F7F7F;
    bf16_t* O; const bf16_t* GT;
    __device__ __forceinline__ void mid(f32x4 (&acc)[2][2][4][2], const Unit& u, int wr, int wc, int fr_, int fq_) const {
        int fr = fr_, fq = fq_; asm volatile("" : "+v"(fr), "+v"(fq));
        const bf16_t* __restrict__ G = GT;
        const int row0 = u.pm * BM + wr * 64 + fr, col0 = u.pn * BM + wc * 32 + 8 * fq;
#pragma unroll
        for (int ai = 0; ai < 2; ++ai)
#pragma unroll
            for (int mp = 0; mp < 2; ++mp) { u32x4 ga[2][2], gb[2][2];
#pragma unroll
                for (int q = 0; q < 2; ++q) { const bf16_t* gp = G + (size_t)(row0 + ai * HALF + (2 * mp + q) * 16) * 2048 + col0;
#pragma unroll
                    for (int bj = 0; bj < 2; ++bj) { ga[q][bj] = *(const u32x4*)(gp + bj * HALF); gb[q][bj] = *(const u32x4*)(gp + 1024 + bj * HALF); } }
#pragma unroll
                for (int q = 0; q < 2; ++q) { const int m = 2 * mp + q;
#pragma unroll
                    for (int bj = 0; bj < 2; ++bj) { const u32x4 a = ga[q][bj], b = gb[q][bj]; f32x4 r0, r1;
                        r0[0] = bf_lo(a.x) * __builtin_amdgcn_rcpf(bf_lo(b.x)); r0[1] = bf_hi(a.x) * __builtin_amdgcn_rcpf(bf_hi(b.x)); r0[2] = bf_lo(a.y) * __builtin_amdgcn_rcpf(bf_lo(b.y)); r0[3] = bf_hi(a.y) * __builtin_amdgcn_rcpf(bf_hi(b.y));
                        r1[0] = bf_lo(a.z) * __builtin_amdgcn_rcpf(bf_lo(b.z)); r1[1] = bf_hi(a.z) * __builtin_amdgcn_rcpf(bf_hi(b.z)); r1[2] = bf_lo(a.w) * __builtin_amdgcn_rcpf(bf_lo(b.w)); r1[3] = bf_hi(a.w) * __builtin_amdgcn_rcpf(bf_hi(b.w));
                        acc[ai][bj][m][0] = acc[ai][bj][m][0] * r0; acc[ai][bj][m][1] = acc[ai][bj][m][1] * r1; } }
                asm volatile("" ::: "memory"); }
    }
    __device__ __forceinline__ void operator()(const f32x4 (&acc)[2][2][4][2], const Unit& u, int wr, int wc, int fr, int fq) const {
        const bf16_t* __restrict__ G = GT; bf16_t* __restrict__ Or = O;
        const int row0 = u.pm * BM + wr * 64 + fr, col0 = u.pn * BM + wc * 32 + 8 * fq;
#pragma unroll
        for (int ai = 0; ai < 2; ++ai) { u32x4 gb[4][2];
#pragma unroll
            for (int m = 0; m < 4; ++m)
#pragma unroll
                for (int bj = 0; bj < 2; ++bj) gb[m][bj] = *(const u32x4*)(G + (size_t)(row0 + ai * HALF + m * 16) * 2048 + 1024 + col0 + bj * HALF);
#pragma unroll
            for (int m = 0; m < 4; ++m) { bf16_t* rowp = Or + (size_t)(row0 + ai * HALF + m * 16) * 1024 + col0;
#pragma unroll
                for (int bj = 0; bj < 2; ++bj) { const u32x4 b = gb[m][bj]; const f32x4 v0 = acc[ai][bj][m][0], v1 = acc[ai][bj][m][1];
                    u32x4 w; w.x = cvt_pk_bf16(v0[0] * bf_lo(b.x), v0[1] * bf_hi(b.x)); w.y = cvt_pk_bf16(v0[2] * bf_lo(b.y), v0[3] * bf_hi(b.y));
                    w.z = cvt_pk_bf16(v1[0] * bf_lo(b.z), v1[1] * bf_hi(b.z)); w.w = cvt_pk_bf16(v1[2] * bf_lo(b.w), v1[3] * bf_hi(b.w));
                    *(u32x4*)(rowp + bj * HALF) = w; } } }
    }
};
struct EpiWout {
    static constexpr bool PERM = false, AFTER_DRAIN = false, HAS_MID = false, F8 = false, PREFETCH = false; static constexpr int WSCALE = 0x7F7F7F7F;
    const float* X; float* O; const float* MOD; float* SSQ;
    __device__ __forceinline__ void operator()(const f32x4 (&acc)[2][2][4][2], const Unit& u, int wr, int wc, int fr, int fq) const {
        const float* __restrict__ Xr = X; float* __restrict__ Or = O; float* __restrict__ Sr = SSQ;
        const int row0 = u.pm * BM + wr * 64 + fr, col0 = u.pn * BM + wc * 32 + 4 * fq;
        const float* g1p = MOD + (row0 >> 12) * 6144 + 2048 + col0;
        f32x4 g1[2][2];
#pragma unroll
        for (int bj = 0; bj < 2; ++bj)
#pragma unroll
            for (int n = 0; n < 2; ++n) g1[bj][n] = *(const f32x4*)(g1p + bj * HALF + n * 16);
#pragma unroll
        for (int ai = 0; ai < 2; ++ai)
#pragma unroll
            for (int mp = 0; mp < 2; ++mp) { f32x4 xv[2][2][2];
#pragma unroll
                for (int q = 0; q < 2; ++q) { const size_t off = (size_t)(row0 + ai * HALF + (2 * mp + q) * 16) * 1024 + col0;
#pragma unroll
                    for (int bj = 0; bj < 2; ++bj)
#pragma unroll
                        for (int n = 0; n < 2; ++n) xv[q][bj][n] = *(const f32x4*)(Xr + off + bj * HALF + n * 16); }
#pragma unroll
                for (int q = 0; q < 2; ++q) { const int m = 2 * mp + q; const int row = row0 + ai * HALF + m * 16; const size_t off = (size_t)row * 1024 + col0; float ss = 0.f;
#pragma unroll
                    for (int bj = 0; bj < 2; ++bj)
#pragma unroll
                        for (int n = 0; n < 2; ++n) { const f32x4 v = xv[q][bj][n] + g1[bj][n] * acc[ai][bj][m][n];
                            *(f32x4*)(Or + off + bj * HALF + n * 16) = v; ss += (v[0] * v[0] + v[1] * v[1]) + (v[2] * v[2] + v[3] * v[3]); }
                    ss += __shfl_xor(ss, 16); ss += __shfl_xor(ss, 32);
                    if (fq == 0) Sr[(size_t)row * 16 + u.pn * 4 + wc] = ss; } }
    }
};

struct MoeGatherOrder {
    static constexpr bool GATHER = true;
    StaticOrder so; const int* blke; const PG8_LAS unsigned short* tokl;
    __device__ __forceinline__ bool next(int i, Unit& u) const { if (!so.next(i, u)) return false; u.be = blke[u.pm]; return true; }
    __device__ __forceinline__ int gather_tok(int ui, int row) const { return (int)tokl[ui * 256 + row]; }
    __device__ __forceinline__ void a_ready(const Unit&) const {}
    __device__ __forceinline__ void done(const Unit&) const {}
};
template <bool F8> struct FragT { typedef bf16x8 A[4][2]; typedef bf16x8 B[2][2]; };
template <> struct FragT<true> { typedef v8i_t A[4]; typedef v8i_t B[2]; };
template <class Epi, class Sched, bool ALIGN_EPI = false, bool SP2 = false>
__device__ __forceinline__ void gemm_phase(PG8_LAS unsigned char* lds, const Gemm g, const Sched& S, const Epi& E) {
    const int tid = threadIdx.x, wid = __builtin_amdgcn_readfirstlane(tid >> 6), lane = tid & 63, wr = wid >> 2, wc = wid & 3, fr = lane & 15, fq = lane >> 4;
    const int K = g.K, nt = K / BK;
    unsigned voffA[2], voffB[2];
#pragma unroll
    for (int i = 0; i < 2; ++i) { int R, C; stage_rc(tid * 16 + i * 8192, R, C); const int Rb = Epi::PERM ? ((R & ~31) + perm32(R & 31)) : R;
        voffA[i] = (unsigned)(R * K + C) * 2u; voffB[i] = (unsigned)(Rb * K + C) * 2u; }
    const size_t kstep = (size_t)(BK * 2);
    const size_t hstep = (size_t)HALF * K * 2;
    const size_t tstep = 2 * hstep;
    const unsigned ldsw = (unsigned)wid * 1024u;
    const int aoff = lds_byte(wr * 64 + fr, fq * 8), boff = lds_byte(wc * 32 + fr, fq * 8);
    const int aoff8 = aoff, boff8 = boff;
#define PG8_SA(b, h) (((b) * 2 + (h)) * HTB)
#define PG8_SB(b, h) ((4 + (b) * 2 + (h)) * HTB)
#define PG8_STAGE(bufoff, gbase, voff) do { _Pragma("unroll") for (int _i = 0; _i < 2; ++_i) \
        __builtin_amdgcn_global_load_lds((const unsigned*)((const char*)(gbase) + (voff)[_i]), (PG8_LAS unsigned*)(lds + (bufoff) + ldsw + _i * 8192), 16, 0, 0); } while (0)
#define PG8_STAGE_A(bufoff, gbase, h, nx) do { if constexpr (Sched::GATHER) { unsigned gv_[2]; \
        if (nx) { _Pragma("unroll") for (int i_ = 0; i_ < 2; ++i_) { int R_, C_; stage_rc(tid * 16 + i_ * 8192, R_, C_); gv_[i_] = (unsigned)(S.gather_tok(ui + 1, 128 * (h) + R_) * K + C_) * 2u; } } \
        else { gv_[0] = cvA[h][0]; gv_[1] = cvA[h][1]; } \
        PG8_STAGE(bufoff, gbase, gv_); } \
        else { PG8_STAGE(bufoff, (gbase) + (h) * hstep, voffA); } } while (0)
#define PG8_LD32(off_) __builtin_shufflevector(__builtin_bit_cast(v4i_t, *(const PG8_LAS bf16x8*)(lds + (off_))), __builtin_bit_cast(v4i_t, *(const PG8_LAS bf16x8*)(lds + (off_) + 1024)), 0, 1, 2, 3, 4, 5, 6, 7)
#define PG8_LDA(dst, b, h) do { if constexpr (Epi::F8) { _Pragma("unroll") for (int m = 0; m < 4; ++m) dst[m] = PG8_LD32(PG8_SA(b, h) + aoff8 + m * 2048); } else { \
        _Pragma("unroll") for (int m = 0; m < 4; ++m) _Pragma("unroll") for (int k = 0; k < 2; ++k) dst[m][k] = *(const PG8_LAS bf16x8*)(lds + PG8_SA(b, h) + aoff + m * 2048 + k * 1024); } } while (0)
#define PG8_LDB(dst, b, h) do { if constexpr (Epi::F8) { _Pragma("unroll") for (int n = 0; n < 2; ++n) dst[n] = PG8_LD32(PG8_SB(b, h) + boff8 + n * 2048); } else { \
        _Pragma("unroll") for (int n = 0; n < 2; ++n) _Pragma("unroll") for (int k = 0; k < 2; ++k) dst[n][k] = *(const PG8_LAS bf16x8*)(lds + PG8_SB(b, h) + boff + n * 2048 + k * 1024); } } while (0)
#define PG8_MMA(ai, bj, At, Bt) do { __builtin_amdgcn_s_setprio(1); if constexpr (Epi::F8) { \
        _Pragma("unroll") for (int m = 0; m < 4; ++m) _Pragma("unroll") for (int n = 0; n < 2; ++n) \
            acc[ai][bj][m][n] = __builtin_amdgcn_mfma_scale_f32_16x16x128_f8f6f4(Bt[n], At[m], acc[ai][bj][m][n], 0, 0, 0, Epi::WSCALE, 0, 0x7F7F7F7F); \
        _Pragma("unroll") for (int m = 0; m < 4; ++m) _Pragma("unroll") for (int n = 0; n < 2; ++n) asm volatile("" : "+v"(acc[ai][bj][m][n])); } else { \
        _Pragma("unroll") for (int m = 0; m < 4; ++m) _Pragma("unroll") for (int n = 0; n < 2; ++n) _Pragma("unroll") for (int k = 0; k < 2; ++k) \
        acc[ai][bj][m][n] = __builtin_amdgcn_mfma_f32_16x16x32_bf16(Bt[n][k], At[m][k], acc[ai][bj][m][n], 0, 0, 0); } __builtin_amdgcn_s_setprio(0); } while (0)
#define PG8_WAIT_V(n) asm volatile("s_waitcnt vmcnt(" #n ")" ::: "memory")
#define PG8_WAIT_L(n) asm volatile("s_waitcnt lgkmcnt(" #n ")" ::: "memory")
#define PG8_BAR __builtin_amdgcn_s_barrier()
#define PG8_SCHED __builtin_amdgcn_sched_barrier(0)
    Unit cur, nxt; int ui = 0;
    if (!S.next(0, cur)) return;
    f32x4 acc[2][2][4][2];
#pragma unroll
    for (int a = 0; a < 2; ++a)
#pragma unroll
        for (int b = 0; b < 2; ++b)
#pragma unroll
            for (int m = 0; m < 4; ++m)
#pragma unroll
                for (int n = 0; n < 2; ++n) acc[a][b][m][n] = (f32x4){0.f, 0.f, 0.f, 0.f};
    typename FragT<Epi::F8>::A At; typename FragT<Epi::F8>::B B0, B1;
    const char* cA = (const char*)g.A + (Sched::GATHER ? (size_t)0 : (size_t)cur.pm * tstep);
    unsigned cvA[2][2];
    if constexpr (Sched::GATHER) {
#pragma unroll
        for (int h = 0; h < 2; ++h)
#pragma unroll
            for (int i = 0; i < 2; ++i) { int R, Cc; stage_rc(tid * 16 + i * 8192, R, Cc); cvA[h][i] = (unsigned)(S.gather_tok(0, 128 * h + R) * K + Cc) * 2u; } } const char* cB = (const char*)g.Bt + (size_t)cur.be * g.bstride + (size_t)cur.pn * tstep;
    S.a_ready(cur);
    if constexpr (Epi::PREFETCH) E.prefetch(cur, 0, wid, lane);
    if constexpr (SP2) {
        PG8_STAGE(PG8_SB(0, 0), cB, voffB); PG8_STAGE(PG8_SB(0, 1), cB + hstep, voffB); PG8_STAGE_A(PG8_SA(0, 0), cA, 0, false); PG8_STAGE_A(PG8_SA(0, 1), cA, 1, false);
        if (wr == 1) PG8_BAR;
        PG8_WAIT_V(2); PG8_BAR;
        PG8_STAGE(PG8_SB(1, 0), cB + kstep, voffB); PG8_STAGE_A(PG8_SA(1, 0), cA + kstep, 0, false); PG8_STAGE(PG8_SB(1, 1), cB + hstep + kstep, voffB);
        PG8_WAIT_V(6); PG8_BAR;
    } else {
        PG8_STAGE(PG8_SB(0, 0), cB, voffB); PG8_STAGE_A(PG8_SA(0, 0), cA, 0, false); PG8_STAGE(PG8_SB(0, 1), cB + hstep, voffB); PG8_STAGE_A(PG8_SA(0, 1), cA, 1, false);
        if (wr == 1) PG8_BAR;
        PG8_WAIT_V(4); PG8_BAR;
        PG8_STAGE(PG8_SB(1, 0), cB + kstep, voffB); PG8_STAGE_A(PG8_SA(1, 0), cA + kstep, 0, false); PG8_STAGE(PG8_SB(1, 1), cB + hstep + kstep, voffB);
        PG8_WAIT_V(6); PG8_BAR;
    }
    for (;;) {
        const bool has_next = S.next(ui + 1, nxt);
        const char* nA = (has_next && !Sched::GATHER) ? (const char*)g.A + (size_t)nxt.pm * tstep : cA;
 const char* nB = has_next ? (const char*)g.Bt + (size_t)nxt.be * g.bstride + (size_t)nxt.pn * tstep : cB;
        for (int t = 0; t < nt; t += 2) {
            const bool last = (t == nt - 2);
            const char* a1 = cA + (size_t)(t + 1) * kstep;
            const char* a2 = last ? nA : cA + (size_t)(t + 2) * kstep; const char* b2 = last ? nB : cB + (size_t)(t + 2) * kstep;
            const char* a3 = a2 + kstep; const char* b3 = b2 + kstep;
            if (last && has_next) S.a_ready(nxt);
            if constexpr (Epi::HAS_MID) { if (t == nt / 2) E.mid(acc, cur, wr, wc, fr, fq); }
            if constexpr (SP2) {
            PG8_LDB(B0, 0, 0); PG8_LDB(B1, 0, 1); PG8_SCHED; PG8_LDA(At, 0, 0); PG8_STAGE_A(PG8_SA(1, 1), a1, 1, false);
            PG8_WAIT_V(8); PG8_WAIT_L(0); PG8_BAR; PG8_MMA(0, 0, At, B0); PG8_MMA(0, 1, At, B1); PG8_BAR; PG8_SCHED;
            PG8_LDA(At, 0, 1); PG8_STAGE(PG8_SB(0, 0), b2, voffB); PG8_STAGE(PG8_SB(0, 1), b2 + hstep, voffB); PG8_STAGE_A(PG8_SA(0, 0), a2, 0, last && has_next);
            PG8_WAIT_V(8); PG8_WAIT_L(0); PG8_BAR; PG8_MMA(1, 0, At, B0); PG8_MMA(1, 1, At, B1); PG8_BAR; PG8_SCHED;
            PG8_LDB(B0, 1, 0); PG8_LDB(B1, 1, 1); PG8_SCHED; PG8_LDA(At, 1, 0); PG8_STAGE_A(PG8_SA(0, 1), a2, 1, last && has_next);
            PG8_WAIT_V(8); PG8_WAIT_L(0); PG8_BAR; PG8_MMA(0, 0, At, B0); PG8_MMA(0, 1, At, B1); PG8_BAR; PG8_SCHED;
            PG8_LDA(At, 1, 1); PG8_STAGE(PG8_SB(1, 0), b3, voffB); PG8_STAGE(PG8_SB(1, 1), b3 + hstep, voffB); PG8_STAGE_A(PG8_SA(1, 0), a3, 0, last && has_next);
            PG8_WAIT_V(8); PG8_WAIT_L(0); PG8_BAR; PG8_MMA(1, 0, At, B0); PG8_MMA(1, 1, At, B1); PG8_BAR; PG8_SCHED;
            } else {
            PG8_LDB(B0, 0, 0); PG8_SCHED; PG8_LDA(At, 0, 0); PG8_STAGE_A(PG8_SA(1, 1), a1, 1, false);
            PG8_WAIT_L(8); PG8_BAR; PG8_WAIT_L(0); PG8_MMA(0, 0, At, B0); PG8_BAR; PG8_SCHED;
            PG8_LDB(B1, 0, 1); PG8_STAGE(PG8_SB(0, 0), b2, voffB);
            PG8_BAR; PG8_WAIT_L(0); PG8_MMA(0, 1, At, B1); PG8_BAR;
            PG8_LDA(At, 0, 1); PG8_STAGE_A(PG8_SA(0, 0), a2, 0, last && has_next);
            PG8_BAR; PG8_WAIT_L(0); PG8_MMA(1, 0, At, B0); PG8_BAR; PG8_SCHED;
            PG8_STAGE(PG8_SB(0, 1), b2 + hstep, voffB);
            PG8_WAIT_V(6); PG8_BAR; PG8_MMA(1, 1, At, B1); PG8_BAR;
            PG8_LDB(B0, 1, 0); PG8_SCHED; PG8_LDA(At, 1, 0); PG8_STAGE_A(PG8_SA(0, 1), a2, 1, last && has_next);
            PG8_WAIT_L(8); PG8_BAR; PG8_WAIT_L(0); PG8_MMA(0, 0, At, B0); PG8_BAR; PG8_SCHED;
            PG8_LDB(B1, 1, 1); PG8_STAGE(PG8_SB(1, 0), b3, voffB);
            PG8_BAR; PG8_WAIT_L(0); PG8_MMA(0, 1, At, B1); PG8_BAR;
            PG8_LDA(At, 1, 1); PG8_STAGE_A(PG8_SA(1, 0), a3, 0, last && has_next);
            PG8_BAR; PG8_WAIT_L(0); PG8_MMA(1, 0, At, B0); PG8_BAR; PG8_SCHED;
            PG8_STAGE(PG8_SB(1, 1), b3 + hstep, voffB);
            PG8_WAIT_V(6); PG8_BAR; PG8_MMA(1, 1, At, B1); PG8_BAR;
            }
        }
        if constexpr (ALIGN_EPI) { if (wr == 0) PG8_BAR; }
        if constexpr (!Epi::AFTER_DRAIN) { cur.es = ui & 1; E(acc, cur, wr, wc, fr, fq); S.done(cur); }
        if (!has_next) break;
        if constexpr (Epi::PREFETCH) E.prefetch(nxt, (ui + 1) & 1, wid, lane);
#pragma unroll
        for (int a = 0; a < 2; ++a)
#pragma unroll
            for (int b = 0; b < 2; ++b)
#pragma unroll
                for (int m = 0; m < 4; ++m)
#pragma unroll
                    for (int n = 0; n < 2; ++n) acc[a][b][m][n] = (f32x4){0.f, 0.f, 0.f, 0.f};
        cur = nxt; cA = nA; cB = nB; ++ui;
        if constexpr (Sched::GATHER) {
#pragma unroll
            for (int h = 0; h < 2; ++h)
#pragma unroll
                for (int i = 0; i < 2; ++i) { int R, Cc; stage_rc(tid * 16 + i * 8192, R, Cc); cvA[h][i] = (unsigned)(S.gather_tok(ui, 128 * h + R) * K + Cc) * 2u; } }
        if constexpr (ALIGN_EPI) { if (wr == 1) PG8_BAR; }
    }
    PG8_WAIT_V(0);
    if constexpr (!ALIGN_EPI) { if (wr == 0) PG8_BAR; }
    PG8_BAR;
    if constexpr (Epi::AFTER_DRAIN) { E.fused(acc, cur, wr, wc, fr, fq, lds, wid, lane); S.done(cur); }
#undef PG8_SA
#undef PG8_SB
#undef PG8_STAGE
#undef PG8_STAGE_A
#undef PG8_LD32
#undef PG8_LDA
#undef PG8_LDB
#undef PG8_MMA
#undef PG8_WAIT_V
#undef PG8_WAIT_L
#undef PG8_BAR
#undef PG8_SCHED
}
}
namespace att {
using bf16 = __hip_bfloat16;
constexpr int   D = 128, NW = 8, QBLK = 32, KVBLK = 64;
constexpr float SCALE = 0.125f;
constexpr float THR = 8.f;
constexpr int SDEPTH = 2;
constexpr int LDQ = 8 * D, LDK = 4 * D, LDO = LDQ;
constexpr size_t SHM_V = KVBLK * D * 2, SHM_K = KVBLK * D * 2, SHM_ATTN = 2 * SHM_V + 2 * SHM_K + NW * 64 * 4;
using bf16x8 = __attribute__((ext_vector_type(8))) short;
using s16x4  = __attribute__((ext_vector_type(4))) short;
using f32x16 = __attribute__((ext_vector_type(16))) float;
using f32x8  = __attribute__((ext_vector_type(8))) float;
using u32x4  = __attribute__((ext_vector_type(4))) unsigned;
#define KSWZ(row, colB) ((row) * 256 + ((colB) ^ (((row) & 7) << 4)))
#define SBAR() __builtin_amdgcn_sched_barrier(0)
__device__ __forceinline__ int crow(int r, int hi) { return (r & 3) + 8 * (r >> 2) + 4 * hi; }
__device__ __forceinline__ unsigned cvtpk(float lo, float hi) {
  unsigned r; asm volatile("v_cvt_pk_bf16_f32 %0, %1, %2" : "=v"(r) : "v"(lo), "v"(hi)); return r;
}
template <typename TIn> struct Stage;
template <> struct Stage<bf16>  { using T = bf16x8;
  __device__ static __forceinline__ T ld8(const bf16* p) { return *reinterpret_cast<const bf16x8*>(p); }
  __device__ static __forceinline__ bf16x8 tobf(T x) { return x; } };
template <> struct Stage<float> { using T = f32x8;
  __device__ static __forceinline__ T ld8(const float* p) { return *reinterpret_cast<const f32x8*>(p); }
  __device__ static __forceinline__ bf16x8 tobf(T x) {
    u32x4 w = {cvtpk(x[0], x[1]), cvtpk(x[2], x[3]), cvtpk(x[4], x[5]), cvtpk(x[6], x[7])}; return *reinterpret_cast<bf16x8*>(&w); } };

__device__ __forceinline__ void partialSM(f32x16& p0, f32x16& p1, float& m_reg, float& mn, float& alpha) {
  constexpr float C = SCALE * 1.4426950408889634f;
  float pmax = p0[0]; for (int r = 1; r < 16; ++r) pmax = fmaxf(pmax, p0[r]); for (int r = 0; r < 16; ++r) pmax = fmaxf(pmax, p1[r]);
  { auto rr = __builtin_amdgcn_permlane32_swap(__float_as_uint(pmax), __float_as_uint(pmax), false, false);
    pmax = fmaxf(__uint_as_float(rr[0]), __uint_as_float(rr[1])); }
  if (__builtin_expect(__all(pmax - m_reg <= THR / SCALE), 1)) { mn = m_reg; alpha = 1.f; }
  else { mn = fmaxf(m_reg, pmax); alpha = __builtin_amdgcn_exp2f((m_reg - mn) * C); m_reg = mn; }
  float mnC = -mn * C;
  for (int r = 0; r < 16; ++r) p0[r] = fmaf(p0[r], C, mnC); for (int r = 0; r < 16; ++r) p1[r] = fmaf(p1[r], C, mnC);
  for (int r = 0; r < 16; ++r) p0[r] = __builtin_amdgcn_exp2f(p0[r]);
}
__device__ __forceinline__ void finishSM(f32x16& p0, f32x16& p1, float alpha, float& l_reg, bf16x8& pa0, bf16x8& pa1, bf16x8& pa2, bf16x8& pa3) {
  for (int r = 0; r < 16; ++r) p1[r] = __builtin_amdgcn_exp2f(p1[r]);
  float ps = 0; for (int r = 0; r < 16; ++r) ps += p0[r]; for (int r = 0; r < 16; ++r) ps += p1[r];
  { auto rr = __builtin_amdgcn_permlane32_swap(__float_as_uint(ps), __float_as_uint(ps), false, false);
    ps = __uint_as_float(rr[0]) + __uint_as_float(rr[1]); }
  l_reg = l_reg * alpha + ps;
#define PK4(P, BASE, OUT) do { unsigned a0 = cvtpk(P[BASE + 0], P[BASE + 1]), a1 = cvtpk(P[BASE + 2], P[BASE + 3]);   \
    unsigned b0 = cvtpk(P[BASE + 4], P[BASE + 5]), b1 = cvtpk(P[BASE + 6], P[BASE + 7]);                              \
    auto r0 = __builtin_amdgcn_permlane32_swap(a0, b0, false, false); auto r1 = __builtin_amdgcn_permlane32_swap(a1, b1, false, false); \
    u32x4 w = {r0[0], r1[0], r0[1], r1[1]}; OUT = *reinterpret_cast<bf16x8*>(&w); } while (0)
  PK4(p0, 0, pa0); PK4(p0, 8, pa1); PK4(p1, 0, pa2); PK4(p1, 8, pa3);
#undef PK4
}
__device__ __forceinline__ void qkt(f32x16& p0, f32x16& p1, const bf16* Ks, const bf16x8* qr, int r32, int hi) {
  p0 = f32x16{}; p1 = f32x16{};
  for (int d0 = 0; d0 < 8; ++d0) { int cb = (d0 * 16 + hi * 8) * 2;
    bf16x8 b0 = *reinterpret_cast<const bf16x8*>((const char*)Ks + KSWZ(r32, cb));
    bf16x8 b1 = *reinterpret_cast<const bf16x8*>((const char*)Ks + KSWZ(32 + r32, cb));
    p0 = __builtin_amdgcn_mfma_f32_32x32x16_bf16(b0, qr[d0], p0, 0, 0, 0);
    p1 = __builtin_amdgcn_mfma_f32_32x32x16_bf16(b1, qr[d0], p1, 0, 0, 0); }
}
__device__ __forceinline__ int v_st(int k, int c) { const int kk = (k & ~0xC) | ((k & 4) << 1) | ((k & 8) >> 1); return ((kk >> 3) * 4 + (c >> 5)) * 512 + ((kk & 7) * 32 + (c & 31)) * 2; }
__device__ __forceinline__ int v_rd_base(int lane) { return ((lane & 3) << 3) | (((lane >> 2) & 3) << 6) | (((lane >> 4) & 1) << 5) | (((lane >> 5) & 1) << 8); }
constexpr int v_rd_off(int d0, int ks, int half) { return d0 * 512 + ks * 4096 + half * 2048; }
template <int OFF> __device__ __forceinline__ s16x4 tr_read(int vb) {
  s16x4 r; asm volatile("ds_read_b64_tr_b16 %0, %1 offset:%2" : "=&v"(r) : "v"(vb), "i"(OFF) : "memory"); return r;
}
template <int D0> __device__ __forceinline__ void pv_one(f32x16& od, int vb, bf16x8 pa0, bf16x8 pa1, bf16x8 pa2, bf16x8 pa3) {
  const s16x4 l0 = tr_read<v_rd_off(D0, 0, 0)>(vb), h0 = tr_read<v_rd_off(D0, 0, 1)>(vb), l1 = tr_read<v_rd_off(D0, 1, 0)>(vb), h1 = tr_read<v_rd_off(D0, 1, 1)>(vb);
  const s16x4 l2 = tr_read<v_rd_off(D0, 2, 0)>(vb), h2 = tr_read<v_rd_off(D0, 2, 1)>(vb), l3 = tr_read<v_rd_off(D0, 3, 0)>(vb), h3 = tr_read<v_rd_off(D0, 3, 1)>(vb);
  asm volatile("s_waitcnt lgkmcnt(0)" ::: "memory"); SBAR();
#define PK(L, H) (bf16x8){L[0], L[1], L[2], L[3], H[0], H[1], H[2], H[3]}
  od = __builtin_amdgcn_mfma_f32_32x32x16_bf16(pa0, PK(l0, h0), od, 0, 0, 0);
  od = __builtin_amdgcn_mfma_f32_32x32x16_bf16(pa1, PK(l1, h1), od, 0, 0, 0);
  od = __builtin_amdgcn_mfma_f32_32x32x16_bf16(pa2, PK(l2, h2), od, 0, 0, 0);
  od = __builtin_amdgcn_mfma_f32_32x32x16_bf16(pa3, PK(l3, h3), od, 0, 0, 0);
#undef PK
}
__device__ __forceinline__ void pv_d0(f32x16* o, int vb, bf16x8 pa0, bf16x8 pa1, bf16x8 pa2, bf16x8 pa3) {
  pv_one<0>(o[0], vb, pa0, pa1, pa2, pa3); pv_one<1>(o[1], vb, pa0, pa1, pa2, pa3); pv_one<2>(o[2], vb, pa0, pa1, pa2, pa3); pv_one<3>(o[3], vb, pa0, pa1, pa2, pa3);
}

template <typename TQ>
__device__ __forceinline__ void attn_dense_body(const TQ* __restrict__ Qb, const bf16* __restrict__ Kh, const bf16* __restrict__ Vh,
                                                float* __restrict__ Ob, int seq, char* lds) {
  using St = Stage<bf16>; using SQ = Stage<TQ>;
  const int tid = threadIdx.x, wid = tid >> 6, lane = tid & 63, r32 = lane & 31, hi = lane >> 5;
  bf16* V_lds = (bf16*)lds; bf16* K_lds = (bf16*)(lds + 2 * SHM_V);
  float* ws = (float*)(lds + 2 * SHM_V + 2 * SHM_K) + wid * 64; float* li_l = ws; float* al_l = ws + 32;
  float m_reg = -1e30f, l_reg = 0; f32x16 o[4] = {}; bf16x8 qr[8];
  const TQ* Qw = Qb + (long)(wid * QBLK + r32) * LDQ + hi * 8;
#pragma unroll
  for (int d0 = 0; d0 < 8; ++d0) qr[d0] = SQ::tobf(SQ::ld8(Qw + d0 * 16));
  const int sr = tid >> 4, sc = (tid & 15) * 8, vst0 = v_st(sr, sc), vst1 = v_st(32 + sr, sc);
  const int vb0 = (int)(uintptr_t)V_lds + v_rd_base(lane);
  struct { typename St::T vs0, vs1, ks0, ks1; } sr_[SDEPTH];
#define SLOAD(i, k0) do { sr_[i].vs0 = St::ld8(&Vh[(long)((k0) + sr) * LDK + sc]); sr_[i].vs1 = St::ld8(&Vh[(long)((k0) + 32 + sr) * LDK + sc]); \
    sr_[i].ks0 = St::ld8(&Kh[(long)((k0) + sr) * LDK + sc]); sr_[i].ks1 = St::ld8(&Kh[(long)((k0) + 32 + sr) * LDK + sc]); } while (0)
#define SWRITE(b, i) do { *(bf16x8*)((char*)V_lds + (b) * SHM_V + vst0) = St::tobf(sr_[i].vs0);          \
    *(bf16x8*)((char*)V_lds + (b) * SHM_V + vst1) = St::tobf(sr_[i].vs1); int kc = sc * 2;               \
    *(bf16x8*)((char*)K_lds + (b) * SHM_K + KSWZ(sr, kc)) = St::tobf(sr_[i].ks0);                       \
    *(bf16x8*)((char*)K_lds + (b) * SHM_K + KSWZ(32 + sr, kc)) = St::tobf(sr_[i].ks1); } while (0)
#define SWAIT() do { if constexpr (SDEPTH == 2) asm volatile("s_waitcnt vmcnt(4)" ::: "memory"); else asm volatile("s_waitcnt vmcnt(0)" ::: "memory"); } while (0)
#define RESC(a) do { if (__any((a) < 1.f)) { if (hi == 0) al_l[r32] = (a); asm volatile("s_waitcnt lgkmcnt(0)" ::: "memory"); \
    for (int d = 0; d < 4; ++d) for (int r = 0; r < 16; ++r) o[d][r] *= al_l[crow(r, hi)]; } } while (0)
  f32x16 pA0, pA1, pB0, pB1; float mnA, mnB, alA, alB; bf16x8 pa0, pa1, pa2, pa3; const int NT = seq / KVBLK;
  constexpr int SE = 0, SO = SDEPTH - 1;
  SLOAD(SE, 0); asm volatile("s_waitcnt vmcnt(0)" ::: "memory"); SWRITE(0, SE); __syncthreads();
  qkt(pA0, pA1, K_lds, qr, r32, hi); partialSM(pA0, pA1, m_reg, mnA, alA);
  SLOAD(SO, KVBLK); if constexpr (SDEPTH == 2) { if (2 < NT) SLOAD(SE, 2 * KVBLK); }
  SWAIT(); SWRITE(1, SO); __syncthreads();
  for (int j = 1; j + 1 < NT; j += 2) {
    SBAR(); qkt(pB0, pB1, (bf16*)((char*)K_lds + SHM_K), qr, r32, hi);
    finishSM(pA0, pA1, alA, l_reg, pa0, pa1, pa2, pa3); SBAR();
    SLOAD(SO, (j + SDEPTH) * KVBLK); SBAR();
    pv_d0(o, vb0, pa0, pa1, pa2, pa3); partialSM(pB0, pB1, m_reg, mnB, alB);
    __syncthreads(); SWAIT(); SWRITE(0, SE);
    RESC(alB); __syncthreads();
    SBAR(); qkt(pA0, pA1, K_lds, qr, r32, hi);
    finishSM(pB0, pB1, alB, l_reg, pa0, pa1, pa2, pa3); SBAR();
    if (SDEPTH == 1 || j + 3 < NT) SLOAD(SE, (j + 1 + SDEPTH) * KVBLK); SBAR();
    pv_d0(o, vb0 + (int)SHM_V, pa0, pa1, pa2, pa3); partialSM(pA0, pA1, m_reg, mnA, alA);
    __syncthreads(); SWAIT(); SWRITE(1, SO);
    RESC(alA); __syncthreads();
  }
  SBAR(); qkt(pB0, pB1, (bf16*)((char*)K_lds + SHM_K), qr, r32, hi);
  finishSM(pA0, pA1, alA, l_reg, pa0, pa1, pa2, pa3); SBAR();
  pv_d0(o, vb0, pa0, pa1, pa2, pa3); partialSM(pB0, pB1, m_reg, mnB, alB);
  __syncthreads(); RESC(alB);
  finishSM(pB0, pB1, alB, l_reg, pa0, pa1, pa2, pa3); SBAR();
  pv_d0(o, vb0 + (int)SHM_V, pa0, pa1, pa2, pa3);
  if (hi == 0) li_l[r32] = l_reg; asm volatile("s_waitcnt lgkmcnt(0)" ::: "memory");
  float rli[16];
#pragma unroll
  for (int r = 0; r < 16; ++r) rli[r] = __builtin_amdgcn_rcpf(li_l[crow(r, hi)]);
  float* Ow = Ob + (long)(wid * QBLK) * LDO;
#pragma unroll
  for (int r = 0; r < 16; ++r) { int orow = crow(r, hi);
    for (int d0 = 0; d0 < 4; ++d0) Ow[(long)orow * LDO + d0 * 32 + r32] = o[d0][r] * rli[r]; }
#undef SLOAD
#undef SWRITE
#undef SWAIT
#undef RESC
}
__device__ __forceinline__ void qkt2(f32x16& p0, f32x16& p1, const bf16* Ks, const bf16x8* qr, int r32, int hi, int mp) {
  p0 = f32x16{}; p1 = f32x16{};
  __builtin_amdgcn_s_setprio(1);
#pragma unroll
  for (int d0 = 0; d0 < 4; ++d0) { int cb = (mp * 64 + d0 * 16 + hi * 8) * 2;
    bf16x8 b0 = *reinterpret_cast<const bf16x8*>((const char*)Ks + KSWZ(r32, cb));
    bf16x8 b1 = *reinterpret_cast<const bf16x8*>((const char*)Ks + KSWZ(32 + r32, cb));
    p0 = __builtin_amdgcn_mfma_f32_32x32x16_bf16(b0, qr[d0], p0, 0, 0, 0);
    p1 = __builtin_amdgcn_mfma_f32_32x32x16_bf16(b1, qr[d0], p1, 0, 0, 0); }
  __builtin_amdgcn_s_setprio(0);
}
constexpr int LDQ2 = 512, LDOB = 1024;
__device__ __forceinline__ void attn_diff_body(const bf16* __restrict__ Qb, const bf16* __restrict__ Kh, const bf16* __restrict__ Vh,
                                               unsigned short* __restrict__ Ob, int seq, char* lds, float lam, const float* __restrict__ subg, float osc) {
  using St = Stage<bf16>; using SQ = Stage<bf16>;
  const int tid = threadIdx.x, wid = tid >> 6, lane = tid & 63, r32 = lane & 31, hi = lane >> 5, mp = wid >> 2, wq = wid & 3;
  bf16* V_lds = (bf16*)lds; bf16* K_lds = (bf16*)(lds + 2 * SHM_V);
  float* ws = (float*)(lds + 2 * SHM_V + 2 * SHM_K) + wid * 64; float* li_l = ws; float* al_l = ws + 32;
  float m_reg = -1e30f, l_reg = 0; f32x16 o[4] = {}; bf16x8 qr[4];
  const bf16* Qw = Qb + (long)(wq * QBLK + r32) * LDQ2 + mp * 64 + hi * 8;
#pragma unroll
  for (int d0 = 0; d0 < 4; ++d0) qr[d0] = SQ::tobf(SQ::ld8(Qw + d0 * 16));
  const int sr = tid >> 4, sc = (tid & 15) * 8, vst0 = v_st(sr, sc), vst1 = v_st(32 + sr, sc);
  const int vb0 = (int)(uintptr_t)V_lds + v_rd_base(lane);
  struct { typename St::T vs0, vs1, ks0, ks1; } sr_[SDEPTH];
#define SLOAD(i, k0) do { sr_[i].vs0 = St::ld8(&Vh[(long)((k0) + sr) * LDK + sc]); sr_[i].vs1 = St::ld8(&Vh[(long)((k0) + 32 + sr) * LDK + sc]); \
    sr_[i].ks0 = St::ld8(&Kh[(long)((k0) + sr) * LDK + sc]); sr_[i].ks1 = St::ld8(&Kh[(long)((k0) + 32 + sr) * LDK + sc]); } while (0)
#define SWRITE(b, i) do { *(bf16x8*)((char*)V_lds + (b) * SHM_V + vst0) = St::tobf(sr_[i].vs0);          \
    *(bf16x8*)((char*)V_lds + (b) * SHM_V + vst1) = St::tobf(sr_[i].vs1); int kc = sc * 2;               \
    *(bf16x8*)((char*)K_lds + (b) * SHM_K + KSWZ(sr, kc)) = St::tobf(sr_[i].ks0);                       \
    *(bf16x8*)((char*)K_lds + (b) * SHM_K + KSWZ(32 + sr, kc)) = St::tobf(sr_[i].ks1); } while (0)
#define SWAIT() do { if constexpr (SDEPTH == 2) asm volatile("s_waitcnt vmcnt(4)" ::: "memory"); else asm volatile("s_waitcnt vmcnt(0)" ::: "memory"); } while (0)
#define RESC(a) do { if (__any((a) < 1.f)) { if (hi == 0) al_l[r32] = (a); asm volatile("s_waitcnt lgkmcnt(0)" ::: "memory"); \
    for (int d = 0; d < 4; ++d) for (int r = 0; r < 16; ++r) o[d][r] *= al_l[crow(r, hi)]; } } while (0)
  f32x16 pA0, pA1, pB0, pB1; float mnA, mnB, alA, alB; bf16x8 pa0, pa1, pa2, pa3; const int NT = seq / KVBLK;
  constexpr int SE = 0, SO = SDEPTH - 1;
  SLOAD(SE, 0); asm volatile("s_waitcnt vmcnt(0)" ::: "memory"); SWRITE(0, SE); __syncthreads();
  qkt2(pA0, pA1, K_lds, qr, r32, hi, mp); partialSM(pA0, pA1, m_reg, mnA, alA);
  SLOAD(SO, KVBLK); if constexpr (SDEPTH == 2) { if (2 < NT) SLOAD(SE, 2 * KVBLK); }
  SWAIT(); SWRITE(1, SO); __syncthreads();
  for (int j = 1; j + 1 < NT; j += 2) {
    SBAR(); qkt2(pB0, pB1, (bf16*)((char*)K_lds + SHM_K), qr, r32, hi, mp);
    finishSM(pA0, pA1, alA, l_reg, pa0, pa1, pa2, pa3); SBAR();
    SLOAD(SO, (j + SDEPTH) * KVBLK); SBAR();
    pv_d0(o, vb0, pa0, pa1, pa2, pa3); partialSM(pB0, pB1, m_reg, mnB, alB);
    __syncthreads(); SWAIT(); SWRITE(0, SE);
    RESC(alB); __syncthreads();
    SBAR(); qkt2(pA0, pA1, K_lds, qr, r32, hi, mp);
    finishSM(pB0, pB1, alB, l_reg, pa0, pa1, pa2, pa3); SBAR();
    if (SDEPTH == 1 || j + 3 < NT) SLOAD(SE, (j + 1 + SDEPTH) * KVBLK); SBAR();
    pv_d0(o, vb0 + (int)SHM_V, pa0, pa1, pa2, pa3); partialSM(pA0, pA1, m_reg, mnA, alA);
    __syncthreads(); SWAIT(); SWRITE(1, SO);
    RESC(alA); __syncthreads();
  }
  SBAR(); qkt2(pB0, pB1, (bf16*)((char*)K_lds + SHM_K), qr, r32, hi, mp);
  finishSM(pA0, pA1, alA, l_reg, pa0, pa1, pa2, pa3); SBAR();
  pv_d0(o, vb0, pa0, pa1, pa2, pa3); partialSM(pB0, pB1, m_reg, mnB, alB);
  __syncthreads(); RESC(alB);
  finishSM(pB0, pB1, alB, l_reg, pa0, pa1, pa2, pa3); SBAR();
  pv_d0(o, vb0 + (int)SHM_V, pa0, pa1, pa2, pa3);
  if (hi == 0) li_l[r32] = l_reg; asm volatile("s_waitcnt lgkmcnt(0)" ::: "memory");
  float rli[16];
#pragma unroll
  for (int r = 0; r < 16; ++r) rli[r] = __builtin_amdgcn_rcpf(li_l[crow(r, hi)]);
#pragma unroll
  for (int d0 = 0; d0 < 4; ++d0)
#pragma unroll
    for (int r = 0; r < 16; ++r) o[d0][r] *= rli[r];
  __syncthreads();
  float* xch = (float*)lds + wq * 4096 + lane;
  if (mp == 1) {
#pragma unroll
    for (int d0 = 0; d0 < 4; ++d0)
#pragma unroll
      for (int r = 0; r < 16; ++r) xch[(d0 * 16 + r) * 64] = o[d0][r]; }
  __syncthreads();
  if (mp == 0) {
    int lane_e = lane; asm volatile("" : "+v"(lane_e));
    const int r32e = lane_e & 31, hie = lane_e >> 5;
    float ssq[16];
#pragma unroll
    for (int r = 0; r < 16; ++r) ssq[r] = 0.f;
#pragma unroll
    for (int d0 = 0; d0 < 4; ++d0)
#pragma unroll
      for (int r = 0; r < 16; ++r) { const float v = o[d0][r] - lam * xch[(d0 * 16 + r) * 64]; o[d0][r] = v; ssq[r] += v * v; }
#pragma unroll
    for (int r = 0; r < 16; ++r) { float s = ssq[r]; s += __shfl_xor(s, 1); s += __shfl_xor(s, 2); s += __shfl_xor(s, 4); s += __shfl_xor(s, 8); s += __shfl_xor(s, 16); ssq[r] = rsqrtf(s * (1.0f / 128.0f) + 1e-6f) * osc; }
    unsigned short* Ow = Ob + (long)(wq * QBLK) * LDOB;
#pragma unroll
    for (int d0 = 0; d0 < 4; ++d0) { const float gsc = subg[d0 * 32 + r32e];
#pragma unroll
      for (int r = 0; r < 16; ++r) { const float v = o[d0][r] * ssq[r] * gsc; const unsigned u = __float_as_uint(v); Ow[(long)crow(r, hie) * LDOB + d0 * 32 + r32e] = (unsigned short)((u + 0x7fffu + ((u >> 16) & 1u)) >> 16); } } }
  __syncthreads();
#undef SLOAD
#undef SWRITE
#undef SWAIT
#undef RESC
}
__device__ __forceinline__ void qkt3(f32x16& p0, f32x16& p1, const bf16* Ks, const bf16x8* qr, const f32x16& negm, int r32, int hi, int mp) {
#pragma unroll
  for (int d0 = 0; d0 < 4; ++d0) { int cb = (mp * 64 + d0 * 16 + hi * 8) * 2;
    bf16x8 b0 = *reinterpret_cast<const bf16x8*>((const char*)Ks + KSWZ(r32, cb));
    bf16x8 b1 = *reinterpret_cast<const bf16x8*>((const char*)Ks + KSWZ(32 + r32, cb));
    if (d0 == 0) { p0 = __builtin_amdgcn_mfma_f32_32x32x16_bf16(b0, qr[0], negm, 0, 0, 0); p1 = __builtin_amdgcn_mfma_f32_32x32x16_bf16(b1, qr[0], negm, 0, 0, 0); }
    else { p0 = __builtin_amdgcn_mfma_f32_32x32x16_bf16(b0, qr[d0], p0, 0, 0, 0); p1 = __builtin_amdgcn_mfma_f32_32x32x16_bf16(b1, qr[d0], p1, 0, 0, 0); } }
}
constexpr float THR2 = THR * 1.4426950408889634f;
__device__ __forceinline__ void partialSM2(f32x16& p0, f32x16& p1, float& m_reg, f32x16& negm, float& alpha, bool nomax) {
  if (nomax) { alpha = 1.f; for (int r = 0; r < 16; ++r) p0[r] = __builtin_amdgcn_exp2f(p0[r]); return; }
  float pmax = p0[0]; for (int r = 1; r < 16; ++r) pmax = fmaxf(pmax, p0[r]); for (int r = 0; r < 16; ++r) pmax = fmaxf(pmax, p1[r]);
  { auto rr = __builtin_amdgcn_permlane32_swap(__float_as_uint(pmax), __float_as_uint(pmax), false, false);
    pmax = fmaxf(__uint_as_float(rr[0]), __uint_as_float(rr[1])); }
  if (__builtin_expect(__all(pmax <= THR2), 1)) { alpha = 1.f; }
  else { const float dl = fmaxf(pmax, 0.f); m_reg += dl; alpha = __builtin_amdgcn_exp2f(-dl);
    for (int r = 0; r < 16; ++r) { p0[r] -= dl; p1[r] -= dl; }
    for (int r = 0; r < 16; ++r) negm[r] = -m_reg; }
  for (int r = 0; r < 16; ++r) p0[r] = __builtin_amdgcn_exp2f(p0[r]);
}
__device__ __forceinline__ void finishSM2(f32x16& p0, f32x16& p1, float alpha, float& l_reg, bf16x8& pa0, bf16x8& pa1, bf16x8& pa2, bf16x8& pa3) {
  for (int r = 0; r < 16; ++r) p1[r] = __builtin_amdgcn_exp2f(p1[r]);
  float ps = 0; for (int r = 0; r < 16; ++r) ps += p0[r]; for (int r = 0; r < 16; ++r) ps += p1[r];
  { auto rr = __builtin_amdgcn_permlane32_swap(__float_as_uint(ps), __float_as_uint(ps), false, false);
    ps = __uint_as_float(rr[0]) + __uint_as_float(rr[1]); }
  l_reg = l_reg * alpha + ps;
#define PK8(P, BASE, OUT) do { u32x4 w = {cvtpk(P[BASE + 0], P[BASE + 1]), cvtpk(P[BASE + 2], P[BASE + 3]), cvtpk(P[BASE + 4], P[BASE + 5]), cvtpk(P[BASE + 6], P[BASE + 7])}; OUT = *reinterpret_cast<bf16x8*>(&w); } while (0)
  PK8(p0, 0, pa0); PK8(p0, 8, pa1); PK8(p1, 0, pa2); PK8(p1, 8, pa3);
#undef PK8
}
typedef short v4i16b_t __attribute__((ext_vector_type(4)));
__device__ __forceinline__ v4i16b_t vtrb(int vb, int off) { return __builtin_amdgcn_ds_read_tr16_b64_v4i16((__attribute__((address_space(3))) v4i16b_t*)(unsigned)(vb + off)); }
#define PVB_F(L, H) __builtin_bit_cast(bf16x8, __builtin_shufflevector(L, H, 0, 1, 2, 3, 4, 5, 6, 7))
template <int D0> __device__ __forceinline__ void pv_oneb(f32x16& od, int vb, bf16x8 pa0, bf16x8 pa1, bf16x8 pa2, bf16x8 pa3) {
  const v4i16b_t l0 = vtrb(vb, v_rd_off(D0, 0, 0)), h0 = vtrb(vb, v_rd_off(D0, 0, 1)), l1 = vtrb(vb, v_rd_off(D0, 1, 0)), h1 = vtrb(vb, v_rd_off(D0, 1, 1));
  const v4i16b_t l2 = vtrb(vb, v_rd_off(D0, 2, 0)), h2 = vtrb(vb, v_rd_off(D0, 2, 1)), l3 = vtrb(vb, v_rd_off(D0, 3, 0)), h3 = vtrb(vb, v_rd_off(D0, 3, 1));
  __builtin_amdgcn_s_setprio(1);
  od = __builtin_amdgcn_mfma_f32_32x32x16_bf16(pa0, PVB_F(l0, h0), od, 0, 0, 0);
  od = __builtin_amdgcn_mfma_f32_32x32x16_bf16(pa1, PVB_F(l1, h1), od, 0, 0, 0);
  od = __builtin_amdgcn_mfma_f32_32x32x16_bf16(pa2, PVB_F(l2, h2), od, 0, 0, 0);
  od = __builtin_amdgcn_mfma_f32_32x32x16_bf16(pa3, PVB_F(l3, h3), od, 0, 0, 0);
  __builtin_amdgcn_s_setprio(0);
}
__device__ __forceinline__ void pv_d0b(f32x16* o, int vb, bf16x8 pa0, bf16x8 pa1, bf16x8 pa2, bf16x8 pa3) {
  pv_oneb<0>(o[0], vb, pa0, pa1, pa2, pa3); SBAR(); pv_oneb<1>(o[1], vb, pa0, pa1, pa2, pa3); SBAR(); pv_oneb<2>(o[2], vb, pa0, pa1, pa2, pa3); SBAR(); pv_oneb<3>(o[3], vb, pa0, pa1, pa2, pa3);
}
#define PVP_RD(A, D0) do { A[0] = tr_read<v_rd_off(D0, 0, 0)>(vb); A[1] = tr_read<v_rd_off(D0, 0, 1)>(vb); A[2] = tr_read<v_rd_off(D0, 1, 0)>(vb); A[3] = tr_read<v_rd_off(D0, 1, 1)>(vb); \
    A[4] = tr_read<v_rd_off(D0, 2, 0)>(vb); A[5] = tr_read<v_rd_off(D0, 2, 1)>(vb); A[6] = tr_read<v_rd_off(D0, 3, 0)>(vb); A[7] = tr_read<v_rd_off(D0, 3, 1)>(vb); } while (0)
#define PVP_PK(L, H) (bf16x8){L[0], L[1], L[2], L[3], H[0], H[1], H[2], H[3]}
#define PVP_MM(OD, A) do { OD = __builtin_amdgcn_mfma_f32_32x32x16_bf16(pa0, PVP_PK(A[0], A[1]), OD, 0, 0, 0); OD = __builtin_amdgcn_mfma_f32_32x32x16_bf16(pa1, PVP_PK(A[2], A[3]), OD, 0, 0, 0); \
    OD = __builtin_amdgcn_mfma_f32_32x32x16_bf16(pa2, PVP_PK(A[4], A[5]), OD, 0, 0, 0); OD = __builtin_amdgcn_mfma_f32_32x32x16_bf16(pa3, PVP_PK(A[6], A[7]), OD, 0, 0, 0); } while (0)
__device__ __forceinline__ void pv_pipe(f32x16* o, int vb, bf16x8 pa0, bf16x8 pa1, bf16x8 pa2, bf16x8 pa3) {
  s16x4 A0[8], A1[8];
  PVP_RD(A0, 0); PVP_RD(A1, 1);
  asm volatile("s_waitcnt lgkmcnt(8)" ::: "memory"); SBAR(); PVP_MM(o[0], A0); SBAR();
  PVP_RD(A0, 2);
  asm volatile("s_waitcnt lgkmcnt(8)" ::: "memory"); SBAR(); PVP_MM(o[1], A1); SBAR();
  PVP_RD(A1, 3);
  asm volatile("s_waitcnt lgkmcnt(8)" ::: "memory"); SBAR(); PVP_MM(o[2], A0); SBAR();
  asm volatile("s_waitcnt lgkmcnt(0)" ::: "memory"); SBAR(); PVP_MM(o[3], A1);
}
#undef PVP_RD
#undef PVP_PK
#undef PVP_MM
__device__ __forceinline__ void attn_diff_body3(const bf16* __restrict__ Qb, const bf16* __restrict__ Kh, const bf16* __restrict__ Vh,
                                               unsigned short* __restrict__ Ob, int seq, char* lds, __attribute__((address_space(3))) unsigned char* ldsl, float lam, const float* __restrict__ subg, float osc, bool nomax) {
  using St = Stage<bf16>; using SQ = Stage<bf16>;
  const int tid = threadIdx.x, wid = tid >> 6, lane = tid & 63, r32 = lane & 31, hi = lane >> 5, mp = wid >> 2, wq = wid & 3;
  constexpr int VR = 0, KR = 3 * 16384, WSO = 6 * 16384;
  bf16* V_lds = (bf16*)(lds + VR); bf16* K_lds = (bf16*)(lds + KR);
  float* ws = (float*)(lds + WSO) + wid * 64; float* li_l = ws; float* al_l = ws + 32;
  float m_reg = 0.f, l_reg = 0; f32x16 o[4] = {}; bf16x8 qr[4]; f32x16 negm = {}; asm volatile("" : "+v"(negm));
  const bf16* Qw = Qb + (long)(wq * QBLK + r32) * LDQ2 + mp * 64 + hi * 8;
#pragma unroll
  for (int d0 = 0; d0 < 4; ++d0) qr[d0] = SQ::tobf(SQ::ld8(Qw + d0 * 16));
  const int vb0 = (int)(uintptr_t)V_lds + v_rd_base(lane);
  int kso[2], vso[2];
#pragma unroll
  for (int i = 0; i < 2; ++i) { const int ob = (i * 8 + wid) * 1024 + 16 * lane; const int row = ob >> 8, cb = (ob & 255) ^ ((row & 7) << 4); kso[i] = row * LDK + (cb >> 1);
    const int st = ob >> 9, e = (ob & 511) >> 1, kk = (st >> 2) * 8 + (e >> 5); vso[i] = kk * LDK + (st & 3) * 32 + (e & 31); }
  const int wu = __builtin_amdgcn_readfirstlane(wid);
  typedef __attribute__((address_space(3))) unsigned las_u32;
  const int NT = seq / KVBLK;
#define DMA_K(t, slot) do { const int tt_ = (t) < NT ? (t) : NT - 1; const bf16* g_ = Kh + (long)tt_ * KVBLK * LDK; _Pragma("unroll") for (int i_ = 0; i_ < 2; ++i_) \
    __builtin_amdgcn_global_load_lds((const unsigned*)(g_ + kso[i_]), (las_u32*)(ldsl + KR + (slot) * 16384 + (i_ * 8 + wu) * 1024), 16, 0, 0); } while (0)
#define DMA_V(t, slot) do { const int tt_ = (t) < NT ? (t) : NT - 1; const bf16* g_ = Vh + (long)tt_ * KVBLK * LDK; _Pragma("unroll") for (int i_ = 0; i_ < 2; ++i_) \
    __builtin_amdgcn_global_load_lds((const unsigned*)(g_ + vso[i_]), (las_u32*)(ldsl + VR + (slot) * 16384 + (i_ * 8 + wu) * 1024), 16, 0, 0); } while (0)
#define CLOSE() do { asm volatile("s_waitcnt vmcnt(4) lgkmcnt(0)" ::: "memory"); __builtin_amdgcn_s_barrier(); asm volatile("" ::: "memory"); } while (0)
#define RESC(a) do { if (__any((a) < 1.f)) { if (hi == 0) al_l[r32] = (a); asm volatile("s_waitcnt lgkmcnt(0)" ::: "memory"); \
    for (int d = 0; d < 4; ++d) for (int r = 0; r < 16; ++r) o[d][r] *= al_l[crow(r, hi)]; } } while (0)
  f32x16 pA0, pA1, pB0, pB1; float mnA, mnB, alA, alB; bf16x8 pa0, pa1, pa2, pa3;
  DMA_K(0, 0); DMA_K(1, 1); DMA_V(0, 0);
  asm volatile("s_waitcnt vmcnt(4)" ::: "memory"); __builtin_amdgcn_s_barrier(); asm volatile("" ::: "memory");
  DMA_K(2, 2); DMA_V(1, 1);
  qkt2(pA0, pA1, K_lds, qr, r32, hi, mp); partialSM2(pA0, pA1, m_reg, negm, alA, nomax);
  CLOSE();
  int kcur = 1, vcur = 0;
#define ROT3(x) ((x) == 2 ? 0 : (x) + 1)
#define PRV3(x) ((x) == 0 ? 2 : (x) - 1)
#define ITER(PC0, PC1, MNC, ALC, PP0, PP1, ALP, j_) do { \
    DMA_K((j_) + 2, PRV3(kcur)); DMA_V((j_) + 1, PRV3(vcur)); \
    SBAR(); if (__builtin_expect(__all(m_reg == 0.f), 1)) { qkt2(PC0, PC1, (bf16*)((char*)K_lds + kcur * 16384), qr, r32, hi, mp); } else { qkt3(PC0, PC1, (bf16*)((char*)K_lds + kcur * 16384), qr, negm, r32, hi, mp); } \
    finishSM2(PP0, PP1, ALP, l_reg, pa0, pa1, pa2, pa3); SBAR(); \
    pv_d0b(o, vb0 + vcur * 16384, pa0, pa1, pa2, pa3); partialSM2(PC0, PC1, m_reg, negm, ALC, nomax); \
    if (!nomax) { RESC(ALC); } CLOSE(); kcur = ROT3(kcur); vcur = ROT3(vcur); } while (0)
  for (int j = 1; j + 1 < NT; j += 2) {
    ITER(pB0, pB1, mnB, alB, pA0, pA1, alA, j);
    ITER(pA0, pA1, mnA, alA, pB0, pB1, alB, j + 1);
  }
  ITER(pB0, pB1, mnB, alB, pA0, pA1, alA, NT - 1);
  finishSM2(pB0, pB1, alB, l_reg, pa0, pa1, pa2, pa3); SBAR();
  pv_d0b(o, vb0 + vcur * 16384, pa0, pa1, pa2, pa3);
  asm volatile("s_waitcnt vmcnt(0)" ::: "memory");
#undef ITER
#undef ROT3
#undef PRV3
#undef DMA_K
#undef DMA_V
#undef CLOSE
  if (hi == 0) li_l[r32] = l_reg; asm volatile("s_waitcnt lgkmcnt(0)" ::: "memory");
  float rli[16];
#pragma unroll
  for (int r = 0; r < 16; ++r) rli[r] = __builtin_amdgcn_rcpf(li_l[crow(r, hi)]);
#pragma unroll
  for (int d0 = 0; d0 < 4; ++d0)
#pragma unroll
    for (int r = 0; r < 16; ++r) o[d0][r] *= rli[r];
  __syncthreads();
  float* xch = (float*)lds + wq * 4096 + lane;
  if (mp == 1) {
#pragma unroll
    for (int d0 = 0; d0 < 4; ++d0)
#pragma unroll
      for (int r = 0; r < 16; ++r) xch[(d0 * 16 + r) * 64] = o[d0][r]; }
  __syncthreads();
  if (mp == 0) {
    int lane_e = lane; asm volatile("" : "+v"(lane_e));
    const int r32e = lane_e & 31, hie = lane_e >> 5;
    float ssq[16];
#pragma unroll
    for (int r = 0; r < 16; ++r) ssq[r] = 0.f;
#pragma unroll
    for (int d0 = 0; d0 < 4; ++d0)
#pragma unroll
      for (int r = 0; r < 16; ++r) { const float v = o[d0][r] - lam * xch[(d0 * 16 + r) * 64]; o[d0][r] = v; ssq[r] += v * v; }
#pragma unroll
    for (int r = 0; r < 16; ++r) { float s = ssq[r]; s += __shfl_xor(s, 1); s += __shfl_xor(s, 2); s += __shfl_xor(s, 4); s += __shfl_xor(s, 8); s += __shfl_xor(s, 16); ssq[r] = rsqrtf(s * (1.0f / 128.0f) + 1e-6f) * osc; }
    unsigned short* Ow = Ob + (long)(wq * QBLK) * LDOB;
#pragma unroll
    for (int d0 = 0; d0 < 4; ++d0) { const float gsc = subg[d0 * 32 + r32e];
#pragma unroll
      for (int r = 0; r < 16; ++r) { const float v = o[d0][r] * ssq[r] * gsc; const unsigned u = __float_as_uint(v); Ow[(long)crow(r, hie) * LDOB + d0 * 32 + r32e] = (unsigned short)((u + 0x7fffu + ((u >> 16) & 1u)) >> 16); } } }
  __syncthreads();
#undef RESC
}
typedef int v8i_a8 __attribute__((ext_vector_type(8)));
typedef int v4i_a8 __attribute__((ext_vector_type(4)));
constexpr float THR8 = 8.5f;
__device__ __forceinline__ unsigned pk4f8(float a, float b, float c, float d) { int w = 0; w = __builtin_amdgcn_cvt_pk_fp8_f32(a, b, w, false); w = __builtin_amdgcn_cvt_pk_fp8_f32(c, d, w, true); return (unsigned)w; }
__device__ __forceinline__ void partialSM8(f32x16& p0, f32x16& p1, float& m_reg, float& alpha) {
  float pmax = p0[0]; for (int r = 1; r < 16; ++r) pmax = fmaxf(pmax, p0[r]); for (int r = 0; r < 16; ++r) pmax = fmaxf(pmax, p1[r]);
  { auto rr = __builtin_amdgcn_permlane32_swap(__float_as_uint(pmax), __float_as_uint(pmax), false, false);
    pmax = fmaxf(__uint_as_float(rr[0]), __uint_as_float(rr[1])); }
  if (__builtin_expect(__all(pmax <= THR8), 1)) { alpha = 1.f; }
  else { const float dl = fmaxf(pmax, 0.f); m_reg += dl; alpha = __builtin_amdgcn_exp2f(-dl);
    for (int r = 0; r < 16; ++r) { p0[r] -= dl; p1[r] -= dl; } }
  for (int r = 0; r < 16; ++r) p0[r] = __builtin_amdgcn_exp2f(p0[r]);
}
__device__ __forceinline__ void finishSM8(f32x16& p0, f32x16& p1, float alpha, float& l_reg, v8i_a8& pa) {
  for (int r = 0; r < 16; ++r) p1[r] = __builtin_amdgcn_exp2f(p1[r]);
  float ps = 0; for (int r = 0; r < 16; ++r) ps += p0[r]; for (int r = 0; r < 16; ++r) ps += p1[r];
  { auto rr = __builtin_amdgcn_permlane32_swap(__float_as_uint(ps), __float_as_uint(ps), false, false);
    ps = __uint_as_float(rr[0]) + __uint_as_float(rr[1]); }
  l_reg = l_reg * alpha + ps;
  pa[0] = (int)pk4f8(p0[0], p0[1], p0[2], p0[3]); pa[1] = (int)pk4f8(p0[4], p0[5], p0[6], p0[7]); pa[2] = (int)pk4f8(p0[8], p0[9], p0[10], p0[11]); pa[3] = (int)pk4f8(p0[12], p0[13], p0[14], p0[15]);
  pa[4] = (int)pk4f8(p1[0], p1[1], p1[2], p1[3]); pa[5] = (int)pk4f8(p1[4], p1[5], p1[6], p1[7]); pa[6] = (int)pk4f8(p1[8], p1[9], p1[10], p1[11]); pa[7] = (int)pk4f8(p1[12], p1[13], p1[14], p1[15]);
}
typedef __attribute__((address_space(3))) unsigned char las_u8;
__device__ __forceinline__ v8i_a8 kfrag8(const las_u8* kt, int row, int mp, int hi) {
  const int sw = (row >> 1) & 7, c0 = 4 * mp + 2 * hi;
  const v4i_a8 lo = *(const __attribute__((address_space(3))) v4i_a8*)(kt + row * 128 + ((c0 ^ sw) << 4)), hi4 = *(const __attribute__((address_space(3))) v4i_a8*)(kt + row * 128 + (((c0 + 1) ^ sw) << 4));
  return __builtin_shufflevector(lo, hi4, 0, 1, 2, 3, 4, 5, 6, 7);
}
#define QS8 0x7D7D7D7D
#define US8 0x7F7F7F7F
__device__ __forceinline__ void qkt8(f32x16& p0, f32x16& p1, const las_u8* kt, const v8i_a8& qf, const f32x16& c0, int r32, int hi, int mp) {
  const v8i_a8 k0 = kfrag8(kt, r32, mp, hi), k1 = kfrag8(kt, 32 + r32, mp, hi);
  p0 = __builtin_amdgcn_mfma_scale_f32_32x32x64_f8f6f4(k0, qf, c0, 0, 0, 0, US8, 0, QS8);
  p1 = __builtin_amdgcn_mfma_scale_f32_32x32x64_f8f6f4(k1, qf, c0, 0, 0, 0, US8, 0, QS8);
}
__device__ __forceinline__ void pv8(f32x16* o, const las_u8* vt, int lane, const v8i_a8& pa) {
#pragma unroll
  for (int d0 = 0; d0 < 4; ++d0) {
    const v4i_a8 lo = *(const __attribute__((address_space(3))) v4i_a8*)(vt + ((d0 * 2 + 0) * 64 + lane) * 16), hi4 = *(const __attribute__((address_space(3))) v4i_a8*)(vt + ((d0 * 2 + 1) * 64 + lane) * 16);
    const v8i_a8 vf = __builtin_shufflevector(lo, hi4, 0, 1, 2, 3, 4, 5, 6, 7);
    o[d0] = __builtin_amdgcn_mfma_scale_f32_32x32x64_f8f6f4(pa, vf, o[d0], 0, 0, 0, US8, 0, US8); }
}
__device__ __forceinline__ unsigned pk4b8(float a, float b, float c, float d) { int w = 0; w = __builtin_amdgcn_cvt_pk_bf8_f32(a, b, w, false); w = __builtin_amdgcn_cvt_pk_bf8_f32(c, d, w, true); return (unsigned)w; }
__device__ __forceinline__ void finishSM8b(f32x16& p0, f32x16& p1, v8i_a8& pa) {
  for (int r = 0; r < 16; ++r) p1[r] = __builtin_amdgcn_exp2f(p1[r]);
  pa[0] = (int)pk4b8(p0[0], p0[1], p0[2], p0[3]); pa[1] = (int)pk4b8(p0[4], p0[5], p0[6], p0[7]); pa[2] = (int)pk4b8(p0[8], p0[9], p0[10], p0[11]); pa[3] = (int)pk4b8(p0[12], p0[13], p0[14], p0[15]);
  pa[4] = (int)pk4b8(p1[0], p1[1], p1[2], p1[3]); pa[5] = (int)pk4b8(p1[4], p1[5], p1[6], p1[7]); pa[6] = (int)pk4b8(p1[8], p1[9], p1[10], p1[11]); pa[7] = (int)pk4b8(p1[12], p1[13], p1[14], p1[15]);
}
__device__ __forceinline__ void pv8b(f32x16* o, f32x16& osum, const v8i_a8& ones, const las_u8* vt, int lane, const v8i_a8& pa) {
  osum = __builtin_amdgcn_mfma_scale_f32_32x32x64_f8f6f4(pa, ones, osum, 1, 0, 0, US8, 0, US8);
#pragma unroll
  for (int d0 = 0; d0 < 4; ++d0) {
    const v4i_a8 lo = *(const __attribute__((address_space(3))) v4i_a8*)(vt + ((d0 * 2 + 0) * 64 + lane) * 16), hi4 = *(const __attribute__((address_space(3))) v4i_a8*)(vt + ((d0 * 2 + 1) * 64 + lane) * 16);
    const v8i_a8 vf = __builtin_shufflevector(lo, hi4, 0, 1, 2, 3, 4, 5, 6, 7);
    o[d0] = __builtin_amdgcn_mfma_scale_f32_32x32x64_f8f6f4(pa, vf, o[d0], 1, 0, 0, US8, 0, US8); }
}
template <bool NOMAX> __device__ __forceinline__ void attn_diff_body8(const unsigned char* __restrict__ Q8b, const unsigned char* __restrict__ K8h, const unsigned char* __restrict__ V8h,
                                               unsigned short* __restrict__ Ob, int seq, char* lds, las_u8* ldsl, float lam, const float* __restrict__ subg, float osc) {
  constexpr bool nomax = NOMAX;
  const int tid = threadIdx.x, wid = tid >> 6, lane = tid & 63, r32 = lane & 31, hi = lane >> 5, mp = wid >> 2, wq = wid & 3;
  constexpr int VR = 0, KR = 3 * 8192, WSO = 65536;
  typedef __attribute__((address_space(3))) float las_f32;
  las_f32* li_l = (las_f32*)(ldsl + WSO) + wid * 64; las_f32* al_l = li_l + 32;
  float m_reg = 0.f, l_reg = 0; f32x16 o[4] = {};
  v8i_a8 qf;
  { const unsigned char* qp = Q8b + (long)(wq * QBLK + r32) * 512 + mp * 64 + hi * 32; const v4i_a8 lo = *(const v4i_a8*)qp, h4 = *(const v4i_a8*)(qp + 16); qf = __builtin_shufflevector(lo, h4, 0, 1, 2, 3, 4, 5, 6, 7); }
  const int wu = __builtin_amdgcn_readfirstlane(wid);
  const int krow = 8 * wid + (lane >> 3), kso = krow * 512 + (((lane & 7) ^ ((krow >> 1) & 7)) << 4), vso = wid * 1024 + 16 * lane;
  typedef __attribute__((address_space(3))) unsigned las_u32;
  const int NT = seq / KVBLK;
#define DMA_K(t, slot) do { const int tt_ = (t) < NT ? (t) : NT - 1; __builtin_amdgcn_global_load_lds((const unsigned*)(K8h + (long)tt_ * KVBLK * 512 + kso), (las_u32*)(ldsl + KR + (slot) * 8192 + wu * 1024), 16, 0, 0); } while (0)
#define DMA_V(t, slot) do { const int tt_ = (t) < NT ? (t) : NT - 1; __builtin_amdgcn_global_load_lds((const unsigned*)(V8h + (long)tt_ * 8192 + vso), (las_u32*)(ldsl + VR + (slot) * 8192 + wu * 1024), 16, 0, 0); } while (0)
#define CLOSE() do { asm volatile("s_waitcnt vmcnt(2) lgkmcnt(0)" ::: "memory"); __builtin_amdgcn_s_barrier(); asm volatile("" ::: "memory"); } while (0)
#define RESC(a) do { if (__any((a) < 1.f)) { if (hi == 0) al_l[r32] = (a); asm volatile("s_waitcnt lgkmcnt(0)" ::: "memory"); \
    for (int d = 0; d < 4; ++d) for (int r = 0; r < 16; ++r) o[d][r] *= al_l[crow(r, hi)]; } } while (0)
  f32x16 pA0, pA1, pB0, pB1; float alA, alB; v8i_a8 pa;
  f32x16 osum = {}; v8i_a8 ones8;
  { const int ob = r32 == 0 ? 0x38383838 : 0; ones8 = (v8i_a8){ob, ob, ob, ob, ob, ob, ob, ob}; }
  int kcur = 1, vcur = 0;
  if constexpr (!nomax) {
  DMA_K(0, 0); DMA_K(1, 1); DMA_V(0, 0);
  asm volatile("s_waitcnt vmcnt(2)" ::: "memory"); __builtin_amdgcn_s_barrier(); asm volatile("" ::: "memory");
  DMA_K(2, 2); DMA_V(1, 1);
  { const f32x16 z0 = {}; qkt8(pA0, pA1, ldsl + KR, qf, z0, r32, hi, mp); }
  partialSM8(pA0, pA1, m_reg, alA);
  CLOSE();
  }
#define ROT3(x) ((x) == 2 ? 0 : (x) + 1)
#define PRV3(x) ((x) == 0 ? 2 : (x) - 1)
#define ITER(PC0, PC1, ALC, PP0, PP1, ALP, j_) do { \
    DMA_K((j_) + 2, PRV3(kcur)); DMA_V((j_) + 1, PRV3(vcur)); \
    SBAR(); if (__builtin_expect(__all(m_reg == 0.f), 1)) { const f32x16 z0_ = {}; qkt8(PC0, PC1, ldsl + KR + kcur * 8192, qf, z0_, r32, hi, mp); } \
    else { f32x16 nm_; _Pragma("unroll") for (int r_ = 0; r_ < 16; ++r_) nm_[r_] = -m_reg; qkt8(PC0, PC1, ldsl + KR + kcur * 8192, qf, nm_, r32, hi, mp); } \
    finishSM8(PP0, PP1, ALP, l_reg, pa); SBAR(); \
    pv8(o, ldsl + VR + vcur * 8192, lane, pa); partialSM8(PC0, PC1, m_reg, ALC); \
    RESC(ALC); CLOSE(); kcur = ROT3(kcur); vcur = ROT3(vcur); } while (0)
  if constexpr (nomax) {
    v8i_a8 kf0, kf1, vf0, vf1, vf2, vf3;
#define LDV8(d0_, vt_) ({ const v4i_a8 lo_ = *(const __attribute__((address_space(3))) v4i_a8*)((vt_) + (((d0_) * 2 + 0) * 64 + lane) * 16), hi_ = *(const __attribute__((address_space(3))) v4i_a8*)((vt_) + (((d0_) * 2 + 1) * 64 + lane) * 16); \
      (v8i_a8)__builtin_shufflevector(lo_, hi_, 0, 1, 2, 3, 4, 5, 6, 7); })
#define PVB() do { \
      osum = __builtin_amdgcn_mfma_scale_f32_32x32x64_f8f6f4(pa, ones8, osum, 1, 0, 0, US8, 0, US8); \
      o[0] = __builtin_amdgcn_mfma_scale_f32_32x32x64_f8f6f4(pa, vf0, o[0], 1, 0, 0, US8, 0, US8); o[1] = __builtin_amdgcn_mfma_scale_f32_32x32x64_f8f6f4(pa, vf1, o[1], 1, 0, 0, US8, 0, US8); \
      o[2] = __builtin_amdgcn_mfma_scale_f32_32x32x64_f8f6f4(pa, vf2, o[2], 1, 0, 0, US8, 0, US8); o[3] = __builtin_amdgcn_mfma_scale_f32_32x32x64_f8f6f4(pa, vf3, o[3], 1, 0, 0, US8, 0, US8); \
      asm volatile("" : "+v"(o[0]), "+v"(o[1]), "+v"(o[2]), "+v"(o[3]), "+v"(osum)); } while (0)
#define QKB(PC0, PC1) do { const f32x16 z0_ = {}; PC0 = __builtin_amdgcn_mfma_scale_f32_32x32x64_f8f6f4(kf0, qf, z0_, 0, 0, 0, US8, 0, QS8); PC1 = __builtin_amdgcn_mfma_scale_f32_32x32x64_f8f6f4(kf1, qf, z0_, 0, 0, 0, US8, 0, QS8); asm volatile("" : "+v"(PC0), "+v"(PC1)); } while (0)
#define LDK8(t_) do { const las_u8* kt_ = ldsl + KR + ((t_) & 3) * 8192; kf0 = kfrag8(kt_, r32, mp, hi); kf1 = kfrag8(kt_, 32 + r32, mp, hi); } while (0)
#define LDV01() do { const las_u8* vt_ = ldsl + VR + vcur * 8192; vf0 = LDV8(0, vt_); vf1 = LDV8(1, vt_); } while (0)
#define LDV23() do { const las_u8* vt_ = ldsl + VR + vcur * 8192; vf2 = LDV8(2, vt_); vf3 = LDV8(3, vt_); } while (0)
#define ITERC(PC0, PC1, PP0, PP1, j_) do { \
    DMA_K((j_) + 3, ((j_) + 3) & 3); DMA_V((j_) + 1, PRV3(vcur)); \
    SBAR(); QKB(PC0, PC1); SBAR(); \
    LDV01(); LDK8((j_) + 1); SBAR(); \
    finishSM8b(PP0, PP1, pa); SBAR(); LDV23(); SBAR(); \
    PVB(); \
    _Pragma("unroll") for (int r_ = 0; r_ < 16; ++r_) PC0[r_] = __builtin_amdgcn_exp2f(PC0[r_]); \
    CLOSE(); vcur = ROT3(vcur); } while (0)
    DMA_K(0, 0); DMA_V(0, 0); DMA_K(1, 1); DMA_K(2, 2);
    asm volatile("s_waitcnt vmcnt(1)" ::: "memory"); __builtin_amdgcn_s_barrier(); asm volatile("" ::: "memory");
    LDK8(0); QKB(pA0, pA1); SBAR(); LDK8(1); SBAR();
    DMA_K(3, 3); DMA_V(1, 1);
    for (int r = 0; r < 16; ++r) pA0[r] = __builtin_amdgcn_exp2f(pA0[r]);
    CLOSE();
    for (int j = 1; j + 1 < NT; j += 2) { ITERC(pB0, pB1, pA0, pA1, j); ITERC(pA0, pA1, pB0, pB1, j + 1); }
    ITERC(pB0, pB1, pA0, pA1, NT - 1);
    LDV01(); LDV23(); finishSM8b(pB0, pB1, pa); SBAR(); PVB();
#undef ITERC
#undef LDV01
#undef LDV23
#undef LDK8
#undef QKB
#undef PVB
#undef LDV8
  } else {
    for (int j = 1; j + 1 < NT; j += 2) { ITER(pB0, pB1, alB, pA0, pA1, alA, j); ITER(pA0, pA1, alA, pB0, pB1, alB, j + 1); }
    ITER(pB0, pB1, alB, pA0, pA1, alA, NT - 1);
    finishSM8(pB0, pB1, alB, l_reg, pa); SBAR(); pv8(o, ldsl + VR + vcur * 8192, lane, pa);
  }
  asm volatile("s_waitcnt vmcnt(0)" ::: "memory");
#undef ITER
#undef ROT3
#undef PRV3
#undef DMA_K
#undef DMA_V
#undef CLOSE
  if constexpr (nomax) { if (r32 == 0) {
#pragma unroll
      for (int r = 0; r < 16; ++r) li_l[crow(r, hi)] = osum[r]; } }
  else { if (hi == 0) li_l[r32] = l_reg; }
  asm volatile("s_waitcnt lgkmcnt(0)" ::: "memory");
  float rli[16];
#pragma unroll
  for (int r = 0; r < 16; ++r) rli[r] = __builtin_amdgcn_rcpf(li_l[crow(r, hi)]);
#pragma unroll
  for (int d0 = 0; d0 < 4; ++d0)
#pragma unroll
    for (int r = 0; r < 16; ++r) o[d0][r] *= rli[r];
  __syncthreads();
  las_f32* xch = (las_f32*)ldsl + wq * 4096 + lane;
  if (mp == 1) {
#pragma unroll
    for (int d0 = 0; d0 < 4; ++d0)
#pragma unroll
      for (int r = 0; r < 16; ++r) xch[(d0 * 16 + r) * 64] = o[d0][r]; }
  __syncthreads();
  if (mp == 0) {
    int lane_e = lane; asm volatile("" : "+v"(lane_e));
    const int r32e = lane_e & 31, hie = lane_e >> 5;
    float ssq[16];
#pragma unroll
    for (int r = 0; r < 16; ++r) ssq[r] = 0.f;
#pragma unroll
    for (int d0 = 0; d0 < 4; ++d0)
#pragma unroll
      for (int r = 0; r < 16; ++r) { const float v = o[d0][r] - lam * xch[(d0 * 16 + r) * 64]; o[d0][r] = v; ssq[r] += v * v; }
#pragma unroll
    for (int r = 0; r < 16; ++r) { float s = ssq[r]; s += __shfl_xor(s, 1); s += __shfl_xor(s, 2); s += __shfl_xor(s, 4); s += __shfl_xor(s, 8); s += __shfl_xor(s, 16); ssq[r] = rsqrtf(s * (1.0f / 128.0f) + 1e-6f) * osc; }
    unsigned short* Ow = Ob + (long)(wq * QBLK) * LDOB;
#pragma unroll
    for (int d0 = 0; d0 < 4; ++d0) { const float gsc = subg[d0 * 32 + r32e];
#pragma unroll
      for (int r = 0; r < 16; ++r) { const float v = o[d0][r] * ssq[r] * gsc; const unsigned u = __float_as_uint(v); Ow[(long)crow(r, hie) * LDOB + d0 * 32 + r32e] = (unsigned short)((u + 0x7fffu + ((u >> 16) & 1u)) >> 16); } } }
  __syncthreads();
#undef RESC
}
}
#define GAS __attribute__((address_space(1)))
#define LAS __attribute__((address_space(3)))
typedef unsigned short bf16;
typedef unsigned v4u __attribute__((ext_vector_type(4)));
typedef float f32x4 __attribute__((ext_vector_type(4)));
typedef short bf16x8 __attribute__((ext_vector_type(8)));
typedef GAS unsigned gu32;
typedef GAS unsigned long long gu64;
#define RLX_AGENT __ATOMIC_RELAXED, __HIP_MEMORY_SCOPE_AGENT
#define LDS_WAIT() asm volatile("s_waitcnt lgkmcnt(0)" ::: "memory")
#define VM_WAIT() asm volatile("s_waitcnt vmcnt(0)" ::: "memory")
__device__ __forceinline__ unsigned long long rt() { return __builtin_amdgcn_s_memrealtime(); }
__device__ __forceinline__ unsigned f2bf(float f) { unsigned u = __builtin_bit_cast(unsigned, f); return (u + 0x7fffu + ((u >> 16) & 1u)) >> 16; }
__device__ __forceinline__ unsigned pk2(float lo, float hi) { return f2bf(lo) | (f2bf(hi) << 16); }

#define XB_TMO      128
#define XB_XCNT(j)  (256  + 64 * (j))
#define XB_XSUB(j)  (1280 + 64 * (j))
#define XB_XGEN(j)  (2304 + 64 * (j))
#define XB_TOP      3328
#define XB_TOPGEN   3392
#define XCD_BAR_WORDS 3456
#define XB_SPIN_CAP (1u << 23)

__device__ __forceinline__ unsigned xb_ld(unsigned* p)              { return __hip_atomic_load(p, __ATOMIC_RELAXED, __HIP_MEMORY_SCOPE_AGENT); }
__device__ __forceinline__ unsigned xb_add(unsigned* p, unsigned v) { return __hip_atomic_fetch_add(p, v, __ATOMIC_RELAXED, __HIP_MEMORY_SCOPE_AGENT); }
__device__ __forceinline__ unsigned xb_xcc_id() { return (unsigned)__builtin_amdgcn_s_getreg((3 << 11) | 20) & 0xFu; }
#define XB_SPIN(cond, bar) do { unsigned _sp = 0; while (cond) { __builtin_amdgcn_s_sleep(1); \
    if ((++_sp & 255u) == 0u) { if (xb_ld(&(bar)[XB_TMO])) break; if (_sp > XB_SPIN_CAP) { atomicAdd(&(bar)[XB_TMO], 1u); break; } } } } while (0)

struct XcdBarrier {
    unsigned* bar; unsigned x;
    volatile LAS unsigned* st;
};

__device__ __forceinline__ XcdBarrier xcd_barrier_post(unsigned* bar, volatile LAS unsigned* st) {
    XcdBarrier b; b.bar = bar; b.x = xb_xcc_id(); b.st = st;
    if (threadIdx.x == 0) (void)xb_add(&bar[XB_XCNT(b.x)], 1u);
    return b;
}
__device__ __forceinline__ void xcd_barrier_complete(unsigned* bar, unsigned x, unsigned& nloc, unsigned& nx) {
    const unsigned G = gridDim.x * gridDim.y * gridDim.z;
    unsigned sum, cnt, mine, sp = 0u;
    for (;;) {
        sum = 0u; cnt = 0u; mine = 0u;
#pragma unroll
        for (unsigned j = 0; j < 16; ++j) { const unsigned c = xb_ld(&bar[XB_XCNT(j)]); sum += c; cnt += (c > 0u) ? 1u : 0u; mine = (j == x) ? c : mine; }
        if (sum == G) break;
        __builtin_amdgcn_s_sleep(1);
        if ((++sp & 255u) == 0u) { if (xb_ld(&bar[XB_TMO])) break; if (sp > XB_SPIN_CAP) { atomicAdd(&bar[XB_TMO], 1u); break; } }
    }
    nloc = mine > 0u ? mine : 1u; nx = cnt > 0u ? cnt : 1u;
}

__device__ __forceinline__ void xcd_barrier(const XcdBarrier& b) {
    asm volatile("s_waitcnt vmcnt(0)" ::: "memory");
    __syncthreads();
    if (threadIdx.x == 0) {
        unsigned* bar = b.bar;
        __builtin_amdgcn_s_waitcnt(0);
        unsigned nloc = b.st[0], nx = b.st[1];
        if (nloc == 0u) { xcd_barrier_complete(bar, b.x, nloc, nx); b.st[0] = nloc; b.st[1] = nx; }
        const unsigned old = xb_add(&bar[XB_XSUB(b.x)], 1u);
        const unsigned gen = old / nloc;
        if (old + 1u == (gen + 1u) * nloc) {
            __builtin_amdgcn_fence(__ATOMIC_RELEASE, "agent");
            asm volatile("s_waitcnt vmcnt(0)" ::: "memory");
            const unsigned og = xb_add(&bar[XB_TOP], 1u);
            const unsigned tg = og / nx;
            if (og + 1u == (tg + 1u) * nx) xb_add(&bar[XB_TOPGEN], 1u);
            else XB_SPIN(xb_ld(&bar[XB_TOPGEN]) == tg, bar);
            __builtin_amdgcn_fence(__ATOMIC_ACQUIRE, "agent");
            xb_add(&bar[XB_XGEN(b.x)], 1u);
            asm volatile("s_waitcnt vmcnt(0)" ::: "memory");
        } else {
            XB_SPIN(xb_ld(&bar[XB_XGEN(b.x)]) == gen, bar);
            __builtin_amdgcn_fence(__ATOMIC_ACQUIRE, "agent");
            asm volatile("s_waitcnt vmcnt(0)" ::: "memory");
        }
    }
    __syncthreads();
}
constexpr int DM = 1024, NB = 8, SEQ = 4096, CTX = 256, T = NB * SEQ, TC = NB * CTX, SKV = CTX + SEQ, MROWS = T + TC;
constexpr int NIN = 5120;
constexpr int C_Q = 0, C_K = 512, C_V = 1024, C_HY = 1536, C_G = 3072;
constexpr int NE = 32, TOPK = 4, NA = T * TOPK, NROWS = NA + NE * 256, NBLK = NROWS / 256;
constexpr float EPS = 1e-6f;
enum { IX_X = 0, IX_C, IX_CTX, IX_CCTX, IX_ADAW, IX_ADAB, IX_N1G, IX_N2G, IX_WIN, IX_BIN, IX_QNG, IX_KNG, IX_LQ1, IX_LK1, IX_LQ2, IX_LK2, IX_SUBG,
       IX_CONVW, IX_CONVB, IX_FW1, IX_FB1, IX_FW2, IX_FB2, IX_FW3, IX_FB3, IX_FW4, IX_FFREQ, IX_HBIAS, IX_WUA, IX_WUB, IX_WOUT, IX_RW, IX_RB,
       IX_EW1, IX_EB1, IX_EW2, IX_EB2, N_INPUTS };
constexpr size_t MiB = 1u << 20;
constexpr size_t WS_CTL = 0, CTL_BYTES = 1 * MiB;
constexpr size_t WS_MOD = 1 * MiB;
constexpr size_t WS_LAM = WS_MOD + 256 * 1024;
constexpr size_t WS_ROPEC = WS_LAM + 1024, WS_ROPES = WS_ROPEC + 4096;
constexpr size_t WS_BLKE = WS_ROPES + 4096;
constexpr size_t WS_CNTB = WS_BLKE + 4096;
constexpr size_t WS_TOPE = 2 * MiB, WS_TOPW = WS_TOPE + 512 * 1024, WS_TOKPOS = WS_TOPW + 512 * 1024;
constexpr size_t WS_ROWTOK = WS_TOKPOS + 512 * 1024, WS_ROWW = WS_ROWTOK + 576 * 1024;
static_assert(WS_CNTB + 32768 <= 2 * MiB && WS_ROWW + 576 * 1024 <= 5 * MiB && (size_t)NROWS * 4 <= 576 * 1024, "small tables");
constexpr size_t WS_HF = 6 * MiB;
constexpr size_t WS_WIN = 22 * MiB;
constexpr size_t WS_WIN8 = 5 * MiB + 512 * 1024;
constexpr size_t WS_WA = 32 * MiB, WS_WB = 33 * MiB, WS_WO = 34 * MiB;
constexpr size_t WS_W1 = 36 * MiB;
constexpr size_t WS_W2 = 164 * MiB;
constexpr size_t WS_ACT0 = 228 * MiB;
constexpr size_t WS_HY = 228 * MiB;
constexpr size_t WS_GT = 324 * MiB;
constexpr size_t WS_PX = WS_ACT0;
constexpr size_t WS_XM = 568 * MiB;
constexpr size_t WS_XM8 = 636 * MiB;
constexpr size_t WS_WG8 = 668 * MiB;
constexpr size_t WS_OATT = 568 * MiB;
constexpr size_t WS_QP = 696 * MiB;
constexpr size_t WS_V8T = 728 * MiB;
constexpr size_t WS_KA = 760 * MiB, WS_VA = 794 * MiB;
constexpr size_t WS_U = 828 * MiB;
constexpr size_t WS_UT = 828 * MiB, WS_YT = 860 * MiB;
constexpr size_t WS_CP = 956 * MiB;
constexpr size_t WS_OAB = 892 * MiB;
constexpr size_t WS_SSQ = 228 * MiB;
constexpr size_t WS_OB = 892 * MiB, WS_OA = 924 * MiB;
constexpr size_t WS_TA = 696 * MiB;
constexpr size_t WS_TB = 568 * MiB;
constexpr size_t WS_MB = 828 * MiB;
constexpr size_t WS_TM = 696 * MiB;
constexpr size_t WS_H = 568 * MiB;
constexpr size_t WS_HS = 228 * MiB;
constexpr size_t WS_ACT = 860 * MiB;
constexpr size_t WS_Y = 568 * MiB;
constexpr size_t WS_END = 1020 * MiB;
constexpr int CW_CNT = 0;
constexpr int CW_BAR = 4096;
constexpr int CW_NMAX = 1024;
constexpr int RING_BYTES = 131072, MISC_OFF = RING_BYTES + 320, LDS_BYTES = 163840;
constexpr int NWAVES = 8, NTHREADS = 512;

typedef __attribute__((address_space(3))) float lds_f32;
__device__ __forceinline__ float bf2f(bf16 v) { return __builtin_bit_cast(float, (unsigned)v << 16); }
__device__ __forceinline__ float wave_sum(float v) {
#pragma unroll
    for (int o = 1; o < 64; o <<= 1) v += __shfl_xor(v, o);
    return v;
}
__device__ __forceinline__ float sigmoidf_(float x) { return 1.0f / (1.0f + __expf(-x)); }

struct Ctx {
    float* out; unsigned char* ws;
    LAS unsigned char* lds; char* ldsg;
    int tid, lane, wave, gwave, nwaves, gtid, gthreads;
};
#define WSP(T_, off) ((T_*)(C.ws + (off)))
#define INP(i) (((const float* const __attribute__((address_space(4)))*)__builtin_amdgcn_kernarg_segment_ptr())[i])

__device__ __forceinline__ void tr_item(const float* W, int N, bf16* WT, int Kout, int k0, int n0, int orow0, LAS float* scr, int lane, bool perm = false) {
    { const int kr = lane >> 3, c4 = (lane & 7) * 4; f32x4 v[8];
#pragma unroll
      for (int i = 0; i < 8; ++i) v[i] = *(const f32x4*)(W + (size_t)(k0 + 8 * i + kr) * N + n0 + c4);
#pragma unroll
      for (int i = 0; i < 8; ++i) { LAS float* d = scr + (8 * i + kr) * 33 + c4; d[0] = v[i].x; d[1] = v[i].y; d[2] = v[i].z; d[3] = v[i].w; } }
    LDS_WAIT(); asm volatile("" ::: "memory");
    const int c = lane & 7;
#pragma unroll
    for (int j = 0; j < 4; ++j) { const int n = (lane >> 3) + 8 * j; const LAS float* s = scr + (8 * c) * 33 + n;
        v4u o; o.x = pk2(s[0 * 33], s[1 * 33]); o.y = pk2(s[2 * 33], s[3 * 33]); o.z = pk2(s[4 * 33], s[5 * 33]); o.w = pk2(s[6 * 33], s[7 * 33]);
        const int nr = perm ? (16 * ((n >> 2) & 1) + 4 * (n >> 3) + (n & 3)) : n;
        *(v4u*)(WT + (size_t)(orow0 + nr) * Kout + k0 + 8 * c) = o; }
    LDS_WAIT(); asm volatile("" ::: "memory");
}
__device__ __forceinline__ void tr_item8(const float* W, int N, unsigned char* WT, int Kout, int k0, int n0, int orow0, LAS float* scr, int lane, float mul, bool perm = false) {
    { const int kr = lane >> 3, c4 = (lane & 7) * 4; f32x4 v[8];
#pragma unroll
      for (int i = 0; i < 8; ++i) v[i] = *(const f32x4*)(W + (size_t)(k0 + 8 * i + kr) * N + n0 + c4);
#pragma unroll
      for (int i = 0; i < 8; ++i) { LAS float* d = scr + (8 * i + kr) * 33 + c4; d[0] = v[i].x; d[1] = v[i].y; d[2] = v[i].z; d[3] = v[i].w; } }
    LDS_WAIT(); asm volatile("" ::: "memory");
    const int c = lane & 7;
#pragma unroll
    for (int j = 0; j < 4; ++j) { const int n = (lane >> 3) + 8 * j; const LAS float* s = scr + (8 * c) * 33 + n;
        const unsigned lo = pg8::pk4_fp8(s[0 * 33] * mul, s[1 * 33] * mul, s[2 * 33] * mul, s[3 * 33] * mul), hi = pg8::pk4_fp8(s[4 * 33] * mul, s[5 * 33] * mul, s[6 * 33] * mul, s[7 * 33] * mul);
        const int nr = perm ? (16 * ((n >> 2) & 1) + 4 * (n >> 3) + (n & 3)) : n;
        *(unsigned long long*)(WT + (size_t)(orow0 + nr) * Kout + k0 + 8 * c) = (unsigned long long)lo | ((unsigned long long)hi << 32); }
    LDS_WAIT(); asm volatile("" ::: "memory");
}
struct PrepItem { const float* src; unsigned char* dst; int N, k0, n0, orow0, fl; };
__device__ __forceinline__ void prep_decode(const Ctx& C, int r, PrepItem& p) {
    constexpr int I_INB = 16 * 96, I_ING = 8 * 32, I_A = 8 * 32, I_O = 16 * 32, I_E1 = 8 * 32, I_E2 = 8 * 16;
    if (r < I_INB) { const int kb = r / 96, nb = r % 96; const int L0 = 32 * nb, pn = L0 >> 8;
        p.src = INP(IX_WIN); p.N = NIN; p.k0 = 64 * kb; p.n0 = L0; p.dst = WSP(unsigned char, WS_WIN);
        p.orow0 = pn < 4 ? (256 * pn + 128 * ((L0 >> 5) & 1) + 32 * ((L0 >> 6) & 3)) : L0; p.fl = pn >= 4 ? 2 : 0; return; } r -= I_INB;
    if (r < I_ING) { const int kb = r / 32, nb = r % 32; p.src = INP(IX_WIN); p.N = NIN; p.k0 = 128 * kb; p.n0 = 3072 + 64 * nb; p.dst = WSP(unsigned char, WS_WG8); p.orow0 = 64 * nb; p.fl = 3; return; } r -= I_ING;
    if (r < 2 * I_A) { const int hb = r >= I_A; if (hb) r -= I_A; const int kb = r / 32, nb = r % 32;
        p.src = hb ? INP(IX_WUB) : INP(IX_WUA); p.N = 1024; p.k0 = 64 * kb; p.n0 = 32 * nb; p.dst = WSP(unsigned char, WS_WA) + (hb ? 1024 : 0); p.orow0 = 32 * nb; p.fl = 0; return; } r -= 2 * I_A;
    if (r < I_O) { const int kb = r / 32, nb = r % 32; p.src = INP(IX_WOUT); p.N = 1024; p.k0 = 64 * kb; p.n0 = 32 * nb; p.dst = WSP(unsigned char, WS_WO); p.orow0 = 32 * nb; p.fl = 0; return; } r -= I_O;
    if (r < NE * I_E1) { const int e = r / I_E1, q = r % I_E1, kb = q / 32, nb = q % 32; const int L0 = 64 * nb, half = L0 >> 10, ch = L0 & 1023;
        p.src = INP(IX_EW1) + (size_t)e * 1024 * 2048; p.N = 2048; p.k0 = 128 * kb; p.n0 = L0; p.dst = WSP(unsigned char, WS_W1) + (size_t)e * 2048 * 1024; p.orow0 = (ch >> 7) * 256 + half * 128 + (ch & 127); p.fl = 1; return; }
    r -= NE * I_E1;
    { const int e = r / I_E2, q = r % I_E2, kb = q / 16, nb = q % 16;
      p.src = INP(IX_EW2) + (size_t)e * 1024 * 1024; p.N = 1024; p.k0 = 128 * kb; p.n0 = 64 * nb; p.dst = WSP(unsigned char, WS_W2) + (size_t)e * 1024 * 1024; p.orow0 = 64 * nb; p.fl = 1; }
}
__device__ __forceinline__ void ph_prep_weights(const Ctx& C) {
    LAS float* scr = (LAS float*)(C.lds + C.wave * 16384);
    constexpr int NIT = 16 * 96 + 8 * 32 + 2 * 8 * 32 + 16 * 32 + NE * (8 * 32 + 8 * 16);
    const int lane = C.lane;
    for (int it = C.gwave; it < NIT; it += C.nwaves) {
        PrepItem p; prep_decode(C, it, p);
        if (p.fl & 1) {
            const int kq = lane >> 4, c = lane & 15;
            const float* src = p.src + (size_t)(p.k0 + 32 * kq) * p.N + p.n0 + 4 * c;
            LAS unsigned char* sb = (LAS unsigned char*)scr;
#pragma unroll
            for (int h = 0; h < 2; ++h) { f32x4 v[16];
#pragma unroll
                for (int i = 0; i < 16; ++i) v[i] = *(const f32x4*)(src + (size_t)(16 * h + i) * p.N);
#pragma unroll
                for (int e = 0; e < 4; ++e) { v4u o;
                    o.x = pg8::pk4_fp8(v[0][e] * 32.0f, v[1][e] * 32.0f, v[2][e] * 32.0f, v[3][e] * 32.0f); o.y = pg8::pk4_fp8(v[4][e] * 32.0f, v[5][e] * 32.0f, v[6][e] * 32.0f, v[7][e] * 32.0f);
                    o.z = pg8::pk4_fp8(v[8][e] * 32.0f, v[9][e] * 32.0f, v[10][e] * 32.0f, v[11][e] * 32.0f); o.w = pg8::pk4_fp8(v[12][e] * 32.0f, v[13][e] * 32.0f, v[14][e] * 32.0f, v[15][e] * 32.0f);
                    *(LAS v4u*)(sb + (4 * c + e) * 144 + 32 * kq + 16 * h) = o; } }
            LDS_WAIT(); asm volatile("" ::: "memory");
#pragma unroll
            for (int j = 0; j < 8; ++j) { const int n = (lane >> 3) + 8 * j, ch = lane & 7; const v4u o = *(const LAS v4u*)(sb + n * 144 + 16 * ch);
                const int n32 = n & 31, nr = (p.fl & 2) ? (16 * ((n32 >> 2) & 1) + 4 * (n32 >> 3) + (n32 & 3)) : n32;
                *(v4u*)(p.dst + (size_t)(p.orow0 + (n & 32) + nr) * 1024 + p.k0 + 16 * ch) = o; }
        } else {
            const int kr = lane >> 3, c4 = (lane & 7) * 4;
            f32x4 v[8];
#pragma unroll
            for (int i = 0; i < 8; ++i) v[i] = *(const f32x4*)(p.src + (size_t)(p.k0 + 8 * i + kr) * p.N + p.n0 + c4);
#pragma unroll
            for (int i = 0; i < 8; ++i) { LAS float* d = scr + (8 * i + kr) * 33 + c4; d[0] = v[i].x; d[1] = v[i].y; d[2] = v[i].z; d[3] = v[i].w; }
            LDS_WAIT(); asm volatile("" ::: "memory");
            const int c = lane & 7;
#pragma unroll
            for (int j = 0; j < 4; ++j) { const int n = (lane >> 3) + 8 * j; const LAS float* s = scr + (8 * c) * 33 + n;
                v4u o; o.x = pk2(s[0 * 33], s[1 * 33]); o.y = pk2(s[2 * 33], s[3 * 33]); o.z = pk2(s[4 * 33], s[5 * 33]); o.w = pk2(s[6 * 33], s[7 * 33]);
                const int nr = (p.fl & 2) ? (16 * ((n >> 2) & 1) + 4 * (n >> 3) + (n & 3)) : n;
                *(v4u*)((bf16*)p.dst + (size_t)(p.orow0 + nr) * 1024 + p.k0 + 8 * c) = o; }
        }
        LDS_WAIT(); asm volatile("" ::: "memory");
    }
}
__device__ __forceinline__ void ph_prep_ada(const Ctx& C) {
    LAS float* s = (LAS float*)C.lds;
    LAS float* red = s + 9 * 1024;
    const float* W = INP(IX_ADAW); float* MOD = WSP(float, WS_MOD);
    for (int g = blockIdx.x; g < 192; g += gridDim.x) {
        __syncthreads();
        for (int i = C.tid; i < 9 * 1024; i += NTHREADS) { const int r = i >> 10, k = i & 1023; const float v = r < 8 ? INP(IX_C)[r * 1024 + k] : INP(IX_CCTX)[k]; s[i] = v / (1.0f + __expf(-v)); }
        __syncthreads();
        float acc[9];
#pragma unroll
        for (int r = 0; r < 9; ++r) acc[r] = 0.f;
        const int col = 32 * g + (C.lane & 31), kp = C.wave * 2 + (C.lane >> 5);
#pragma unroll 8
        for (int k = 64 * kp; k < 64 * kp + 64; ++k) { const float wv = W[(size_t)k * 6144 + col];
#pragma unroll
            for (int r = 0; r < 9; ++r) acc[r] += s[r * 1024 + k] * wv; }
#pragma unroll
        for (int r = 0; r < 9; ++r) red[(kp * 9 + r) * 32 + (C.lane & 31)] = acc[r];
        __syncthreads();
        for (int i = C.tid; i < 9 * 32; i += NTHREADS) { const int r = i >> 5, l = i & 31; float a = 0.f;
#pragma unroll
            for (int w = 0; w < 16; ++w) a += red[(w * 9 + r) * 32 + l];
            MOD[r * 6144 + 32 * g + l] = a + INP(IX_ADAB)[32 * g + l]; }
    }
    __syncthreads();
}
__device__ __forceinline__ void ph_prep_misc(const Ctx& C) {
    if (blockIdx.x == gridDim.x - 1) {
        if (C.wave == 0) { const float a = wave_sum(INP(IX_LQ1)[C.lane] * INP(IX_LK1)[C.lane]), b = wave_sum(INP(IX_LQ2)[C.lane] * INP(IX_LK2)[C.lane]);
            if (C.lane == 0) *WSP(float, WS_LAM) = expf(a) - expf(b) + 0.2f;
            float gq = fabsf(INP(IX_QNG)[C.lane]), gk = fabsf(INP(IX_KNG)[C.lane]);
#pragma unroll
            for (int o = 1; o < 64; o <<= 1) { gq = fmaxf(gq, __shfl_xor(gq, o)); gk = fmaxf(gk, __shfl_xor(gk, o)); }
            if (C.lane == 0) WSP(float, WS_LAM)[1] = 11.541560327111707f * gq * gk + 0.5f; }
        for (int i = C.tid; i < 64 * 16; i += NTHREADS) { const int p = i >> 4, f = i & 15; const double fr = pow(10000.0, -(double)f / 16.0), ang = (double)p * fr;
            WSP(float, WS_ROPEC)[i] = (float)cos(ang); WSP(float, WS_ROPES)[i] = (float)sin(ang); }
    }
}
__device__ __forceinline__ void ph_prep_filter(const Ctx& C) {
    LAS float* sc = (LAS float*)(C.lds + C.wave * 4096);
    LAS float* wl = (LAS float*)(C.lds + 32768);
    float* HF = WSP(float, WS_HF);
    const float* w4 = INP(IX_FW4);
    const int lane = C.lane; const float fq = INP(IX_FFREQ)[lane];
    for (int i = C.gtid; i < 512; i += C.gthreads) HF[i] = 0.f;
    __syncthreads();
    { const float* w1 = INP(IX_FW1); const float* w2 = INP(IX_FW2); const float* w3 = INP(IX_FW3);
      for (int i = C.tid; i < (33 + 64 + 64) * 16; i += NTHREADS) { const int e = 4 * i; const float* src = e < 33 * 64 ? w1 + e : (e < 97 * 64 ? w2 + (e - 33 * 64) : w3 + (e - 97 * 64));
          const f32x4 v = *(const f32x4*)src; LAS float* d = wl + e; d[0] = v.x; d[1] = v.y; d[2] = v.z; d[3] = v.w; } }
    __syncthreads();
    const float lo = logf(0.01f) / 1.5f, hi = logf(0.01f) / 0.3f;
    for (int pb = blockIdx.x; pb < SEQ / 16; pb += gridDim.x) {
        const int n0 = 16 * pb + 2 * C.wave;
#pragma unroll
        for (int p = 0; p < 2; ++p) { const int n = n0 + p; float zv = 0.f;
            if (lane == 0) zv = (float)n / 4095.0f;
            else if (lane <= 32) { const int i = (lane - 1) & 15; const double f = 1e-4 + (double)i * ((15.0 - 1e-4) / 15.0); const double ang = f * (6.283185307179586 * (double)n / 4096.0);
                zv = lane <= 16 ? (float)cos(ang) : -(float)sin(ang); }
            sc[p * 256 + lane] = zv; }
        LDS_WAIT();
        float a0, a1;
        a0 = a1 = INP(IX_FB1)[lane];
#pragma unroll 11
        for (int i = 0; i < 33; ++i) { const float wv = wl[i * 64 + lane]; a0 += sc[i] * wv; a1 += sc[256 + i] * wv; }
        sc[64 + lane] = sinf(fq * a0); sc[256 + 64 + lane] = sinf(fq * a1); LDS_WAIT();
        a0 = a1 = INP(IX_FB2)[lane];
#pragma unroll 16
        for (int i = 0; i < 64; ++i) { const float wv = wl[(33 + i) * 64 + lane]; a0 += sc[64 + i] * wv; a1 += sc[256 + 64 + i] * wv; }
        sc[128 + lane] = sinf(fq * a0); sc[256 + 128 + lane] = sinf(fq * a1); LDS_WAIT();
        a0 = a1 = INP(IX_FB3)[lane];
#pragma unroll 16
        for (int i = 0; i < 64; ++i) { const float wv = wl[(97 + i) * 64 + lane]; a0 += sc[128 + i] * wv; a1 += sc[256 + 128 + i] * wv; }
        sc[192 + lane] = sinf(fq * a0); sc[256 + 192 + lane] = sinf(fq * a1);
        __syncthreads();
        float acc0[16], acc1[16];
#pragma unroll
        for (int q = 0; q < 16; ++q) { acc0[q] = 0.f; acc1[q] = 0.f; }
        const int o0 = 128 * C.wave + lane;
#pragma unroll 1
        for (int j0 = 0; j0 < 64; j0 += 16) { float wa[16], wb[16];
#pragma unroll
            for (int j = 0; j < 16; ++j) { wa[j] = w4[(j0 + j) * 1024 + o0]; wb[j] = w4[(j0 + j) * 1024 + o0 + 64]; }
#pragma unroll
            for (int q = 0; q < 16; ++q) { const LAS float* hq = (const LAS float*)(C.lds + (q >> 1) * 4096 + (q & 1) * 1024) + 192 + j0;
#pragma unroll
                for (int j4 = 0; j4 < 16; j4 += 4) { const f32x4 h = *(const LAS f32x4*)(hq + j4);
                    acc0[q] += h.x * wa[j4] + h.y * wa[j4 + 1] + h.z * wa[j4 + 2] + h.w * wa[j4 + 3]; acc1[q] += h.x * wb[j4] + h.y * wb[j4 + 1] + h.z * wb[j4 + 2] + h.w * wb[j4 + 3]; } } }
#pragma unroll
        for (int cc = 0; cc < 2; ++cc) { const int o = o0 + 64 * cc, dir = o >> 9, c = o & 511; const float dl = fabsf(lo + (hi - lo) * ((float)c / 511.0f)); const float hb = INP(IX_HBIAS)[c];
#pragma unroll
            for (int q = 0; q < 16; ++q) { const int n = 16 * pb + q; const float tn = (float)n / 4095.0f;
                float v = (cc ? acc1[q] : acc0[q]) * expf(-tn * dl);
                if (dir == 0) { if (n == 0) v += hb; HF[(size_t)(4096 + n) * 512 + c] = v; }
                else if (n > 0) HF[(size_t)(4096 - n) * 512 + c] = v; } }
        __syncthreads();
    }
}
__device__ __forceinline__ void ph_modulate1(const Ctx& C) {
    const float* MOD = WSP(float, WS_MOD); bf16* XM = WSP(bf16, WS_XM); unsigned char* XM8 = WSP(unsigned char, WS_XM8); const float* g = INP(IX_N1G);
    for (int r0 = C.gwave; r0 < MROWS; r0 += 2 * C.nwaves) {
        f32x4 v[2][4];
#pragma unroll
        for (int q = 0; q < 2; ++q) { const int r = r0 + q * C.nwaves; if (r < MROWS) { const float* xr = r < T ? INP(IX_X) + (size_t)r * DM : INP(IX_CTX) + (size_t)(r - T) * DM;
#pragma unroll
            for (int j = 0; j < 4; ++j) v[q][j] = *(const f32x4*)(xr + 4 * C.lane + 256 * j); } }
#pragma unroll
        for (int q = 0; q < 2; ++q) { const int r = r0 + q * C.nwaves; if (r < MROWS) {
            const float* mrow = MOD + (r < T ? (r >> 12) : 8) * 6144;
            float ss = 0.f;
#pragma unroll
            for (int j = 0; j < 4; ++j) ss += (v[q][j].x * v[q][j].x + v[q][j].y * v[q][j].y) + (v[q][j].z * v[q][j].z + v[q][j].w * v[q][j].w);
            const float rstd = rsqrtf(wave_sum(ss) * (1.0f / DM) + EPS);
#pragma unroll
            for (int j = 0; j < 4; ++j) { const int col = 4 * C.lane + 256 * j; const f32x4 gg = *(const f32x4*)(g + col), sh = *(const f32x4*)(mrow + col), sc = *(const f32x4*)(mrow + 1024 + col);
                const f32x4 y = v[q][j] * rstd * gg * (sc + 1.0f) + sh;
                *(unsigned long long*)(XM + (size_t)r * DM + col) = (unsigned long long)pk2(y.x, y.y) | ((unsigned long long)pk2(y.z, y.w) << 32);
                if (r < T) *(unsigned*)(XM8 + (size_t)r * DM + col) = pg8::pk4_fp8(y.x, y.y, y.z, y.w); } } }
    }
}
__device__ __forceinline__ void ph_post_proj(const Ctx& C) {
    const bf16* PX = WSP(bf16, WS_PX); bf16* QP = WSP(bf16, WS_QP); bf16* KA = WSP(bf16, WS_KA); bf16* VA = WSP(bf16, WS_VA); float* U = WSP(float, WS_U);
    const float* RC = WSP(float, WS_ROPEC); const float* RS = WSP(float, WS_ROPES);
    const int lane = C.lane;
    for (int it = C.gwave; it < T * 16 + TC * 8; it += C.nwaves) {
        int r, which, h, m, rc = 0; bool latent;
        if (it < T * 16) { r = it >> 4; const int v = it & 15; which = v >> 3; h = (v >> 1) & 3; m = v & 1; latent = true; }
        else { const int j = it - T * 16; rc = j >> 3; const int v = j & 7; which = 1; h = v >> 1; m = v & 1; r = T + rc; latent = false; }
        const float x = bf2f(PX[(size_t)r * NIN + which * 512 + h * 128 + m * 64 + lane]);
        const float rstd = rsqrtf(wave_sum(x * x) * (1.0f / 64.0f) + EPS);
        float y = x * rstd * (which ? INP(IX_KNG)[lane] : INP(IX_QNG)[lane]);
        const int t = r & 4095;
        if (latent) { const int axis = lane >> 5, half = (lane >> 4) & 1, f = lane & 15, pos = axis ? (t & 63) : (t >> 6);
            const float cs = RC[pos * 16 + f], sn = RS[pos * 16 + f]; const float pr = __shfl_xor(y, 16);
            y = half == 0 ? y * cs - pr * sn : y * cs + pr * sn; }
        if (which == 0) { const size_t base = ((size_t)r * 8 + (h * 2 + m)) * 128; QP[base + m * 64 + lane] = (bf16)f2bf(y); QP[base + (1 - m) * 64 + lane] = 0; }
        else { const size_t krow = latent ? (size_t)(r >> 12) * SKV + CTX + t : (size_t)(rc >> 8) * SKV + (rc & 255); KA[krow * 512 + h * 128 + m * 64 + lane] = (bf16)f2bf(y); }
    }
    for (int i = C.gtid; i < MROWS * 64; i += C.gthreads) { const int r = i >> 6, ch = i & 63;
        const size_t vrow = r < T ? (size_t)(r >> 12) * SKV + CTX + (r & 4095) : (size_t)((r - T) >> 8) * SKV + ((r - T) & 255);
        *(v4u*)(VA + vrow * 512 + ch * 8) = *(const v4u*)(PX + (size_t)r * NIN + C_V + ch * 8); }
    const float* cw = INP(IX_CONVW); const float* cb = INP(IX_CONVB);
    for (int i = C.gtid; i < T * 512; i += C.gthreads) { const int r = i >> 9, c = i & 511, t = r & 4095; float z[2];
#pragma unroll
        for (int gsel = 0; gsel < 2; ++gsel) { const int chn = 512 * (gsel + 1) + c; const bf16* p = PX + (size_t)r * NIN + C_HY + chn;
            const float xm = t > 0 ? bf2f(p[-NIN]) : 0.f, x0 = bf2f(p[0]), xp = t < 4095 ? bf2f(p[NIN]) : 0.f;
            z[gsel] = xm * cw[chn] + x0 * cw[1536 + chn] + xp * cw[3072 + chn] + cb[chn]; }
        U[i] = z[0] * z[1]; }
}
__device__ __forceinline__ void ph_hyena_naive(const Ctx& C) {
    const float* U = WSP(float, WS_U); const float* HF = WSP(float, WS_HF); const bf16* PX = WSP(bf16, WS_PX); bf16* OB = WSP(bf16, WS_OB);
    const float* cw = INP(IX_CONVW); const float* cb = INP(IX_CONVB);
    for (int i = C.gtid; i < T * 512 / 8; i += C.gthreads) {
        const int c = i & 511, tg = i >> 9, b = tg >> 9, t0 = (tg & 511) * 8;
        float acc[8], tap[8];
#pragma unroll
        for (int j = 0; j < 8; ++j) { acc[j] = 0.f; tap[j] = HF[(size_t)(t0 + j + 4096) * 512 + c]; }
        const float* up = U + (size_t)b * SEQ * 512 + c; const float* hp = HF + (size_t)(t0 + 4095) * 512 + c;
        for (int s = 0; s < SEQ; ++s) { const float uv = up[(size_t)s * 512]; const float nt = hp[-(long)s * 512];
#pragma unroll
            for (int j = 0; j < 8; ++j) acc[j] += uv * tap[j];
#pragma unroll
            for (int j = 7; j > 0; --j) tap[j] = tap[j - 1];
            tap[0] = nt; }
#pragma unroll
        for (int j = 0; j < 8; ++j) { const int t = t0 + j; const size_t r = (size_t)b * SEQ + t; const bf16* p = PX + r * NIN + C_HY + c;
            const float xm = t > 0 ? bf2f(p[-NIN]) : 0.f, x0 = bf2f(p[0]), xp = t < 4095 ? bf2f(p[NIN]) : 0.f;
            const float z0 = xm * cw[c] + x0 * cw[1536 + c] + xp * cw[3072 + c] + cb[c];
            OB[r * 512 + c] = (bf16)f2bf(z0 * acc[j]); }
    }
}
__device__ __forceinline__ void ph_attn_post(const Ctx& C) {
    const float* O = WSP(float, WS_OATT); bf16* OA = WSP(bf16, WS_OA); const float lam = *WSP(float, WS_LAM); const float* sg = INP(IX_SUBG);
    for (int it = C.gwave; it < T * 4; it += C.nwaves) { const int r = it >> 2, h = it & 3; const float* p = O + (size_t)r * 1024 + h * 256 + C.lane;
        const float o0 = p[0] - lam * p[128], o1 = p[64] - lam * p[192];
        const float rstd = rsqrtf(wave_sum(o0 * o0 + o1 * o1) * (1.0f / 128.0f) + EPS);
        OA[(size_t)r * 512 + h * 128 + C.lane] = (bf16)f2bf(o0 * rstd * sg[C.lane] * 0.8f); OA[(size_t)r * 512 + h * 128 + 64 + C.lane] = (bf16)f2bf(o1 * rstd * sg[64 + C.lane] * 0.8f); }
}
__device__ __forceinline__ void ph_gate(const Ctx& C) {
    const float* TA = WSP(float, WS_TA); const float* TB = WSP(float, WS_TB); const bf16* GT = WSP(bf16, WS_GT); bf16* MB = WSP(bf16, WS_MB);
    for (int i = C.gtid; i < T * 256; i += C.gthreads) { const int r = i >> 8, c = (i & 255) * 4; const f32x4 a = *(const f32x4*)(TA + (size_t)r * 1024 + c), b = *(const f32x4*)(TB + (size_t)r * 1024 + c);
        const bf16* g = GT + (size_t)r * 2048 + c; float o[4];
#pragma unroll
        for (int e = 0; e < 4; ++e) o[e] = bf2f(g[e]) * a[e] + bf2f(g[1024 + e]) * b[e];
        *(unsigned long long*)(MB + (size_t)r * 1024 + c) = (unsigned long long)pk2(o[0], o[1]) | ((unsigned long long)pk2(o[2], o[3]) << 32); }
}
__device__ __forceinline__ void ph_router(const Ctx& C) {
    const float* MOD = WSP(float, WS_MOD); const float* TM = WSP(float, WS_TM); bf16* H = WSP(bf16, WS_H); const float* g2n = INP(IX_N2G); const float* RW = INP(IX_RW);
    int* TOPE = WSP(int, WS_TOPE); float* TOPW = WSP(float, WS_TOPW); unsigned* CNT = WSP(unsigned, WS_CTL) + CW_CNT;
    LAS unsigned* hist = (LAS unsigned*)C.lds;
    if (C.tid < 32) hist[C.tid] = 0u;
    __syncthreads();
    for (int r = C.gwave; r < T; r += C.nwaves) {
        const float* mrow = MOD + (r >> 12) * 6144;
        f32x4 v[4]; float ss = 0.f;
#pragma unroll
        for (int j = 0; j < 4; ++j) { const int col = 4 * C.lane + 256 * j; const f32x4 x = *(const f32x4*)(INP(IX_X) + (size_t)r * DM + col), tm = *(const f32x4*)(TM + (size_t)r * DM + col), g1 = *(const f32x4*)(mrow + 2048 + col);
            v[j] = x + g1 * tm; *(f32x4*)(C.out + (size_t)r * DM + col) = v[j]; ss += (v[j].x * v[j].x + v[j].y * v[j].y) + (v[j].z * v[j].z + v[j].w * v[j].w); }
        const float rstd = rsqrtf(wave_sum(ss) * (1.0f / DM) + EPS);
        f32x4 y[4];
#pragma unroll
        for (int j = 0; j < 4; ++j) { const int col = 4 * C.lane + 256 * j; const f32x4 gg = *(const f32x4*)(g2n + col), sh = *(const f32x4*)(mrow + 3072 + col), sc = *(const f32x4*)(mrow + 4096 + col);
            y[j] = v[j] * rstd * gg * (sc + 1.0f) + sh;
            *(unsigned long long*)(H + (size_t)r * DM + col) = (unsigned long long)pk2(y[j].x, y[j].y) | ((unsigned long long)pk2(y[j].z, y[j].w) << 32); }
        LAS float* lg = (LAS float*)(C.lds + 1024) + C.wave * 32;
#pragma unroll 1
        for (int e = 0; e < 32; ++e) { float a = 0.f;
#pragma unroll
            for (int j = 0; j < 4; ++j) { const float* wr = RW + (size_t)(4 * C.lane + 256 * j) * 32 + e; a += y[j].x * wr[0] + y[j].y * wr[32] + y[j].z * wr[64] + y[j].w * wr[96]; }
            a = wave_sum(a) + INP(IX_RB)[e];
            if (C.lane == 0) lg[e] = a; }
        LDS_WAIT();
        float p[32];
#pragma unroll
        for (int e = 0; e < 32; ++e) p[e] = lg[e];
        unsigned taken = 0u; float tv[4]; int ti[4];
#pragma unroll
        for (int k = 0; k < 4; ++k) { float best = -INFINITY; int bi = 0;
#pragma unroll
            for (int e = 0; e < 32; ++e) { const bool ok = !((taken >> e) & 1u) && p[e] > best; best = ok ? p[e] : best; bi = ok ? e : bi; }
            taken |= 1u << bi; tv[k] = best; ti[k] = bi; }
        const float e1 = __expf(tv[1] - tv[0]), e2 = __expf(tv[2] - tv[0]), e3 = __expf(tv[3] - tv[0]); const float inv = 1.0f / (1.0f + e1 + e2 + e3);
        if (C.lane == 0) { *(int4*)(TOPE + (size_t)r * 4) = make_int4(ti[0], ti[1], ti[2], ti[3]); *(f32x4*)(TOPW + (size_t)r * 4) = (f32x4){inv, e1 * inv, e2 * inv, e3 * inv};
            atomicAdd((unsigned*)&hist[ti[0]], 1u); atomicAdd((unsigned*)&hist[ti[1]], 1u); atomicAdd((unsigned*)&hist[ti[2]], 1u); atomicAdd((unsigned*)&hist[ti[3]], 1u); }
    }
    __syncthreads();
    if (C.tid < 32) atomicAdd(CNT + C.tid, hist[C.tid]);
}
__device__ __forceinline__ void ph_sort(const Ctx& C) {
    const unsigned* CNT = WSP(unsigned, WS_CTL) + CW_CNT; const int* TOPE = WSP(int, WS_TOPE); const float* TOPW = WSP(float, WS_TOPW);
    int* TOKPOS = WSP(int, WS_TOKPOS); int* ROWTOK = WSP(int, WS_ROWTOK); float* ROWW = WSP(float, WS_ROWW); int* BLKE = WSP(int, WS_BLKE);
    LAS int* wtot = (LAS int*)C.lds;
    for (int e = blockIdx.x; e < NE; e += gridDim.x) {
        int pstart = 0, cnt = 0, padded = 0;
        for (int i = 0; i <= e; ++i) { pstart += padded; cnt = (int)__hip_atomic_load(CNT + i, __ATOMIC_RELAXED, __HIP_MEMORY_SCOPE_AGENT); padded = (cnt + 255) / 256 * 256; }
        int running = 0;
        for (int a0 = 0; a0 < NA; a0 += NTHREADS) { const int a = a0 + C.tid; const bool flag = TOPE[a] == e;
            const unsigned long long bal = __ballot(flag); const int pre = __popcll(bal & ((1ull << C.lane) - 1ull)), tot = __popcll(bal);
            __syncthreads();
            if (C.lane == 0) wtot[C.wave] = tot;
            __syncthreads();
            int woff = 0, all = 0;
#pragma unroll
            for (int w = 0; w < 8; ++w) { const int x = wtot[w]; woff += (w < C.wave) ? x : 0; all += x; }
            if (flag) { const int pos = pstart + running + woff + pre; ROWTOK[pos] = a >> 2; ROWW[pos] = TOPW[a]; TOKPOS[a] = pos; }
            running += all; }
        for (int i = cnt + C.tid; i < padded; i += NTHREADS) { ROWTOK[pstart + i] = T; ROWW[pstart + i] = 0.f; }
        __syncthreads();
    }
    if (blockIdx.x == gridDim.x - 1) {
        for (int blk = C.tid; blk <= NBLK; blk += NTHREADS) { int pend = 0, e = 0; bool found = false;
            for (int i = 0; i < NE; ++i) { const int cnt = (int)__hip_atomic_load(CNT + i, __ATOMIC_RELAXED, __HIP_MEMORY_SCOPE_AGENT); pend += (cnt + 255) / 256 * 256; if (!found && blk * 256 < pend) { e = i; found = true; } }
            if (blk < NBLK) BLKE[blk] = found ? e : NE - 1; else BLKE[NBLK] = pend / 256; }
    }
}
__device__ __forceinline__ void ph_gather(const Ctx& C) {
    const int nrows = WSP(int, WS_BLKE)[NBLK] * 256; const int* ROWTOK = WSP(int, WS_ROWTOK); const bf16* H = WSP(bf16, WS_H); bf16* HS = WSP(bf16, WS_HS);
    for (int r = C.gwave; r < nrows; r += C.nwaves) { const int tok = ROWTOK[r]; v4u a = {0u, 0u, 0u, 0u}, b = {0u, 0u, 0u, 0u};
        if (tok < T) { a = *(const v4u*)(H + (size_t)tok * DM + C.lane * 16); b = *(const v4u*)(H + (size_t)tok * DM + C.lane * 16 + 8); }
        *(v4u*)(HS + (size_t)r * DM + C.lane * 16) = a; *(v4u*)(HS + (size_t)r * DM + C.lane * 16 + 8) = b; }
}
__device__ __forceinline__ void ph_combine(const Ctx& C) {
    const float* MOD = WSP(float, WS_MOD); const int* TOKPOS = WSP(int, WS_TOKPOS); const unsigned char* Y = WSP(unsigned char, WS_Y);
    typedef float f32x2_t __attribute__((ext_vector_type(2)));
    for (int i0 = C.gtid; i0 < T * 256; i0 += 4 * C.gthreads) {
        int4 ps[4]; f32x4 xo[4], g2[4]; unsigned w[4][4];
#pragma unroll
        for (int q = 0; q < 4; ++q) { const int i = i0 + q * C.gthreads; if (i < T * 256) ps[q] = *(const int4*)(TOKPOS + (size_t)(i >> 8) * 4); }
#pragma unroll
        for (int q = 0; q < 4; ++q) { const int i = i0 + q * C.gthreads; if (i < T * 256) { const int r = i >> 8, c = (i & 255) * 4;
            w[q][0] = *(const unsigned*)(Y + (size_t)ps[q].x * DM + c); w[q][1] = *(const unsigned*)(Y + (size_t)ps[q].y * DM + c); w[q][2] = *(const unsigned*)(Y + (size_t)ps[q].z * DM + c); w[q][3] = *(const unsigned*)(Y + (size_t)ps[q].w * DM + c);
            xo[q] = *(const f32x4*)(C.out + (size_t)r * DM + c); g2[q] = *(const f32x4*)(MOD + (r >> 12) * 6144 + 5120 + c); } }
#pragma unroll
        for (int q = 0; q < 4; ++q) { const int i = i0 + q * C.gthreads; if (i < T * 256) { const int r = i >> 8, c = (i & 255) * 4; f32x4 acc = {0.f, 0.f, 0.f, 0.f};
#pragma unroll
            for (int k = 0; k < 4; ++k) { const f32x2_t lo = __builtin_amdgcn_cvt_pk_f32_fp8((int)w[q][k], false), hi = __builtin_amdgcn_cvt_pk_f32_fp8((int)w[q][k], true); acc.x += lo.x; acc.y += lo.y; acc.z += hi.x; acc.w += hi.y; }
            *(f32x4*)(C.out + (size_t)r * DM + c) = xo[q] + g2[q] * acc * 0.0625f; } }
    }
}
__device__ __forceinline__ unsigned bfx(const v4u& w, int e) { const unsigned d = e < 2 ? w.x : e < 4 ? w.y : e < 6 ? w.z : w.w; return (e & 1) ? (d & 0xffff0000u) : (d << 16); }
__device__ __forceinline__ float bfe(const v4u& w, int e) { return __builtin_bit_cast(float, bfx(w, e)); }
__device__ __forceinline__ void ph_hyena_pre(const Ctx& C) {
    const bf16* HY = WSP(bf16, WS_HY); bf16* UT = WSP(bf16, WS_UT); bf16* CP = WSP(bf16, WS_CP); const float* HF = WSP(float, WS_HF);
    const float* cw = INP(IX_CONVW); const float* cb_ = INP(IX_CONVB);
    LAS bf16* tile = (LAS bf16*)C.lds;
    const int tid = C.tid;
    const bool skew = gridDim.x >= 64 && (gridDim.x & 7) == 0; const int vb0 = skew ? (int)blockIdx.x - 32 : (int)blockIdx.x, vnb = skew ? (int)gridDim.x - 32 : (int)gridDim.x;
    const bool fixc = (vnb & 7) == 0;
    const int tl = tid >> 3, c8 = (tid & 7) * 8;
    float w0[2][8], w1[2][8], w2[2][8], wb[2][8];
    if (fixc) {
#pragma unroll
        for (int gsel = 0; gsel < 2; ++gsel) { const int chn = 512 * (gsel + 1) + ((int)blockIdx.x & 7) * 64 + c8;
#pragma unroll
            for (int e = 0; e < 8; ++e) { w0[gsel][e] = cw[chn + e]; w1[gsel][e] = cw[1536 + chn + e]; w2[gsel][e] = cw[3072 + chn + e]; wb[gsel][e] = cb_[chn + e]; } } }
    const v4u zero4 = {0u, 0u, 0u, 0u};
#define HP_LOAD(IT, M, X, Q) do { const int cb_i = (IT) & 7, tb_i = ((IT) >> 3) & 63, b_i = (IT) >> 9; const int t_i = tb_i * 64 + tl; const size_t r_i = (size_t)b_i * SEQ + t_i; \
        _Pragma("unroll") for (int gsel = 0; gsel < 2; ++gsel) { const bf16* p_ = HY + r_i * 1536 + 512 * (gsel + 1) + cb_i * 64 + c8; \
            M[gsel] = t_i > 0 ? *(const v4u*)(p_ - 1536) : zero4; X[gsel] = *(const v4u*)p_; Q[gsel] = t_i < SEQ - 1 ? *(const v4u*)(p_ + 1536) : zero4; } } while (0)
    v4u cm[2], cx[2], cq[2], nm[2], nx[2], nq[2];
    int it = vb0 < 0 ? 8 * 64 * 8 : vb0;
    if (it < 8 * 64 * 8) HP_LOAD(it, cm, cx, cq);
    for (; it < 8 * 64 * 8; it += vnb) {
        const int cb = it & 7, tb = (it >> 3) & 63, b = it >> 9, c0 = cb * 64, t0 = tb * 64;
        const bool has_n = it + vnb < 8 * 64 * 8;
        if (has_n) HP_LOAD(it + vnb, nm, nx, nq);
        if (!fixc) {
#pragma unroll
            for (int gsel = 0; gsel < 2; ++gsel) { const int chn = 512 * (gsel + 1) + c0 + c8;
#pragma unroll
                for (int e = 0; e < 8; ++e) { w0[gsel][e] = cw[chn + e]; w1[gsel][e] = cw[1536 + chn + e]; w2[gsel][e] = cw[3072 + chn + e]; wb[gsel][e] = cb_[chn + e]; } } }
        float z[2][8];
#pragma unroll
        for (int gsel = 0; gsel < 2; ++gsel)
#pragma unroll
            for (int e = 0; e < 8; ++e) z[gsel][e] = bfe(cm[gsel], e) * w0[gsel][e] + bfe(cx[gsel], e) * w1[gsel][e] + bfe(cq[gsel], e) * w2[gsel][e] + wb[gsel][e];
        __syncthreads();
#pragma unroll
        for (int e = 0; e < 8; ++e) tile[(c8 + e) * 72 + tl] = (bf16)f2bf(z[0][e] * z[1][e]);
        __syncthreads();
        const v4u o = *(const LAS v4u*)(tile + (tid >> 3) * 72 + (tid & 7) * 8);
        *(v4u*)(UT + ((size_t)(c0 + (tid >> 3)) * 8 + b) * SEQ + t0 + (tid & 7) * 8) = o;
        if (has_n) {
#pragma unroll
            for (int gsel = 0; gsel < 2; ++gsel) { cm[gsel] = nm[gsel]; cx[gsel] = nx[gsel]; cq[gsel] = nq[gsel]; } }
    }
#undef HP_LOAD
    __syncthreads();
    LAS float* hfl = (LAS float*)(C.lds + 16384);
    for (int it = vb0 < 0 ? 8 * 128 : vb0; it < 8 * 128; it += vnb) {
        const int cb = it & 7, xb = it >> 3, c0 = cb * 64, x0 = xb * 64, mbase = 8192 - x0 - 70;
        __syncthreads();
        for (int idx = tid; idx < 71 * 64; idx += NTHREADS) { const int lr = idx >> 6, cc = idx & 63, mp = mbase + lr; hfl[lr * 65 + cc] = (mp >= 1 && mp <= 8191) ? HF[(size_t)mp * 512 + c0 + cc] : 0.f; }
        __syncthreads();
        const int c = tid >> 3, x8 = (tid & 7) * 8;
#pragma unroll
        for (int rho = 0; rho < 8; ++rho) { float v[8];
#pragma unroll
            for (int e = 0; e < 8; ++e) v[e] = hfl[(70 - (x8 + e) - rho) * 65 + c];
            v4u o; o.x = pk2(v[0], v[1]); o.y = pk2(v[2], v[3]); o.z = pk2(v[4], v[5]); o.w = pk2(v[6], v[7]);
            *(v4u*)(CP + ((size_t)(c0 + c) * 8 + rho) * 8192 + x0 + x8) = o; }
    }
    __syncthreads();
}
typedef float f32x16_t __attribute__((ext_vector_type(16)));
constexpr int HY_RING = 8, HY_TB = 65536;
__device__ __forceinline__ void ph_hyena_mfma(const Ctx& C) {
    const bf16* UT = WSP(bf16, WS_UT); const bf16* CP = WSP(bf16, WS_CP); bf16* YT = WSP(bf16, WS_YT);
    const int lane = C.lane, n = lane & 31, hh = lane >> 5, b = C.wave;
    LAS unsigned char* ub = C.lds + b * 8192;
    const unsigned ubo = (unsigned)b * 8192u, zrow = (unsigned)(HY_TB + HY_RING * 8192);
    const int rho = (-n) & 7, cn = (n + rho) >> 3;
    if (C.tid < 32) ((LAS unsigned*)(C.lds + HY_TB + HY_RING * 8192))[C.tid] = 0u;
    __syncthreads();
    const int fnb = b >> 2, fks = b & 3;
    const int wfix = 512 - 4 * fnb + 2 * fks + hh - cn;
    for (int c = blockIdx.x; c < 512; c += gridDim.x) {
        const bf16* src = UT + ((size_t)c * 8 + b) * SEQ;
#pragma unroll
        for (int it = 0; it < 8; ++it) { const int g = it * 64 + lane, p = g >> 3, ch = g & 7; const v4u v = *(const v4u*)(src + g * 8);
            *(LAS v4u*)(ub + p * 128 + ((ch ^ ((p >> 1) & 7)) << 4)) = v; }
        asm volatile("s_waitcnt vmcnt(0) lgkmcnt(0)" ::: "memory");
        f32x16_t acc[2][2];
#pragma unroll
        for (int i = 0; i < 2; ++i)
#pragma unroll
            for (int j = 0; j < 2; ++j)
#pragma unroll
                for (int r = 0; r < 16; ++r) acc[i][j][r] = 0.f;
        const bf16* cpl = CP + ((size_t)c * 8 + rho) * 8192;
#define HY_ISSUE2(D_, slot_) do { _Pragma("unroll") for (int h_ = 0; h_ < 2; ++h_) { const int sc_ = (2 * (D_) + h_) > 126 ? 126 : (2 * (D_) + h_); const int W_ = wfix - 8 * (sc_ - 63); \
        __builtin_amdgcn_global_load_lds((const unsigned*)(cpl + 8 * W_), (LAS unsigned*)(C.lds + HY_TB + (slot_) * 16384 + h_ * 8192 + b * 1024), 16, 0, 0); } } while (0)
#define HY_READ(TF, AF, s_, off_) do { const int d_ = (s_) - 63; const LAS unsigned char* tb_ = C.lds + HY_TB + (off_) + lane * 16; \
        _Pragma("unroll") for (int nb = 0; nb < 2; ++nb) _Pragma("unroll") for (int ks = 0; ks < 4; ++ks) TF[nb][ks] = *(const LAS bf16x8*)(tb_ + (nb * 4 + ks) * 1024); \
        _Pragma("unroll") for (int ib = 0; ib < 2; ++ib) { if (ib == 0 ? (d_ <= 31) : (d_ >= -31)) { const int p_ = 32 * ib - d_ + n; const bool v_ = (unsigned)p_ < 64u; \
            const unsigned a0_ = v_ ? (ubo + (unsigned)(p_ * 128 + (((p_ >> 1) & 7) << 4))) : zrow; \
            _Pragma("unroll") for (int ks = 0; ks < 4; ++ks) AF[ib][ks] = *(const LAS bf16x8*)(C.lds + (a0_ ^ (unsigned)((2 * ks + hh) << 4))); } } } while (0)
#define HY_MMA(TF, AF, s_) do { const int d_ = (s_) - 63; if ((s_) <= 126) { _Pragma("unroll") for (int ib = 0; ib < 2; ++ib) { if (ib == 0 ? (d_ <= 31) : (d_ >= -31)) { \
        _Pragma("unroll") for (int ks = 0; ks < 4; ++ks) _Pragma("unroll") for (int nb = 0; nb < 2; ++nb) acc[ib][nb] = __builtin_amdgcn_mfma_f32_32x32x16_bf16(AF[ib][ks], TF[nb][ks], acc[ib][nb], 0, 0, 0); } } } } while (0)
        HY_ISSUE2(0, 0); HY_ISSUE2(1, 1); HY_ISSUE2(2, 2);
        asm volatile("s_waitcnt vmcnt(2)" ::: "memory"); __builtin_amdgcn_s_barrier(); asm volatile("" ::: "memory");
        bf16x8 tfA[2][4], afA[2][4], tfB[2][4], afB[2][4];
        HY_READ(tfA, afA, 0, 0);
#pragma unroll 1
        for (int D = 0; D < 64; ++D) {
            const int slot = D & 3;
            HY_ISSUE2(D + 3, (D + 3) & 3);
            HY_READ(tfB, afB, 2 * D + 1, slot * 16384 + 8192);
            HY_MMA(tfA, afA, 2 * D);
            if (D < 63) HY_READ(tfA, afA, 2 * D + 2, ((D + 1) & 3) * 16384);
            HY_MMA(tfB, afB, 2 * D + 1);
            asm volatile("s_waitcnt vmcnt(2) lgkmcnt(0)" ::: "memory"); __builtin_amdgcn_s_barrier(); asm volatile("" ::: "memory");
        }
#undef HY_ISSUE2
#undef HY_READ
#undef HY_MMA
        asm volatile("s_waitcnt vmcnt(0)" ::: "memory");
        bf16* dst = YT + ((size_t)c * 8 + b) * SEQ;
#pragma unroll
        for (int ib = 0; ib < 2; ++ib)
#pragma unroll
            for (int nb = 0; nb < 2; ++nb)
#pragma unroll
                for (int r = 0; r < 16; ++r) { const int i = 32 * ib + (r & 3) + 8 * (r >> 2) + 4 * hh; dst[64 * i + 32 * nb + n] = (bf16)f2bf(acc[ib][nb][r]); }
        asm volatile("s_waitcnt vmcnt(0) lgkmcnt(0)" ::: "memory"); __builtin_amdgcn_s_barrier(); asm volatile("" ::: "memory");
    }
    __syncthreads();
}
__device__ __forceinline__ void ph_hyena_post(const Ctx& C) {
    const bf16* HY = WSP(bf16, WS_HY); const bf16* YT = WSP(bf16, WS_YT); bf16* OAB = WSP(bf16, WS_OAB);
    const float* cw = INP(IX_CONVW); const float* cb_ = INP(IX_CONVB);
    LAS bf16* tile = (LAS bf16*)C.lds; const int tid = C.tid;
    const int vb0 = (int)blockIdx.x, vnb = (int)gridDim.x; const bool fixc = (vnb & 7) == 0;
    const int tl = tid >> 3, c8 = (tid & 7) * 8;
    float w0[8], w1[8], w2[8], wb[8];
    if (fixc) { const int chn = (vb0 & 7) * 64 + c8;
#pragma unroll
        for (int e = 0; e < 8; ++e) { w0[e] = cw[chn + e]; w1[e] = cw[1536 + chn + e]; w2[e] = cw[3072 + chn + e]; wb[e] = cb_[chn + e]; } }
    const v4u zero4 = {0u, 0u, 0u, 0u};
#define HQ_LOAD(IT, YV, M, X, Q) do { const int cb_i = (IT) & 7, tb_i = ((IT) >> 3) & 63, b_i = (IT) >> 9; const int t_i = tb_i * 64 + tl; \
        YV = *(const v4u*)(YT + ((size_t)(cb_i * 64 + (tid >> 3)) * 8 + b_i) * SEQ + tb_i * 64 + (tid & 7) * 8); \
        const bf16* p_ = HY + ((size_t)b_i * SEQ + t_i) * 1536 + cb_i * 64 + c8; \
        M = t_i > 0 ? *(const v4u*)(p_ - 1536) : zero4; X = *(const v4u*)p_; Q = t_i < SEQ - 1 ? *(const v4u*)(p_ + 1536) : zero4; } while (0)
    v4u cy, cm, cx, cq, ny, nm, nx, nq;
    int it = vb0;
    if (it < 8 * 64 * 8) HQ_LOAD(it, cy, cm, cx, cq);
    for (; it < 8 * 64 * 8; it += vnb) {
        const int cb = it & 7, tb = (it >> 3) & 63, b = it >> 9, c0 = cb * 64, t0 = tb * 64;
        const bool has_n = it + vnb < 8 * 64 * 8;
        if (has_n) HQ_LOAD(it + vnb, ny, nm, nx, nq);
        if (!fixc) { const int chn = c0 + c8;
#pragma unroll
            for (int e = 0; e < 8; ++e) { w0[e] = cw[chn + e]; w1[e] = cw[1536 + chn + e]; w2[e] = cw[3072 + chn + e]; wb[e] = cb_[chn + e]; } }
        __syncthreads();
        *(LAS v4u*)(tile + (tid >> 3) * 72 + (tid & 7) * 8) = cy;
        __syncthreads();
        const int t = t0 + tl, chn = c0 + c8; const size_t r = (size_t)b * SEQ + t;
        float o[8];
#pragma unroll
        for (int e = 0; e < 8; ++e) { const float z0 = bfe(cm, e) * w0[e] + bfe(cx, e) * w1[e] + bfe(cq, e) * w2[e] + wb[e]; o[e] = z0 * bf2f(tile[(c8 + e) * 72 + tl]); }
        v4u w; w.x = pk2(o[0], o[1]); w.y = pk2(o[2], o[3]); w.z = pk2(o[4], o[5]); w.w = pk2(o[6], o[7]);
        *(v4u*)(OAB + r * 1024 + 512 + chn) = w;
        if (has_n) { cy = ny; cm = nm; cx = nx; cq = nq; }
    }
#undef HQ_LOAD
    __syncthreads();
}

__device__ __forceinline__ void v8t_chunk(const bf16* VA, unsigned char* V8T, int b, int h, int tk, int ci) {
    const int d0 = ci >> 7, half = (ci >> 6) & 1, ln = ci & 63, n = ln & 31, kg = ln >> 5;
    const bf16* src = VA + ((size_t)b * SKV + 64 * tk + 32 * half + 4 * kg) * 512 + h * 128 + 32 * d0 + n;
    float v[16];
#pragma unroll
    for (int e = 0; e < 16; ++e) v[e] = bf2f(src[(size_t)((e & 3) + 8 * (e >> 2)) * 512]);
    v4u o; o.x = pg8::pk4_fp8(v[0], v[1], v[2], v[3]); o.y = pg8::pk4_fp8(v[4], v[5], v[6], v[7]); o.z = pg8::pk4_fp8(v[8], v[9], v[10], v[11]); o.w = pg8::pk4_fp8(v[12], v[13], v[14], v[15]);
    *(v4u*)(V8T + ((size_t)((b * 4 + h) * (SKV / 64) + tk) * 512 + ci) * 16) = o;
}
__device__ __forceinline__ void ph_v8t(const Ctx& C) {
    const bf16* VA = WSP(bf16, WS_VA); unsigned char* V8T = WSP(unsigned char, WS_V8T);
    constexpr int NTL = SKV / 64 - 4;
    const bool skew = gridDim.x >= 64; const int t0 = skew ? C.gtid - 32 * NTHREADS : C.gtid, tn = skew ? C.gthreads - 32 * NTHREADS : C.gthreads;
    for (int i = t0 < 0 ? NB * 4 * NTL * 512 : t0; i < NB * 4 * NTL * 512; i += tn) { const int ci = i & 511, tk = 4 + (i >> 9) % NTL, bh = (i >> 9) / NTL; v8t_chunk(VA, V8T, bh >> 2, bh & 3, tk, ci); }
}
__device__ __forceinline__ void ph_v8t_ctx(const Ctx& C, int b, int h0) {
    const bf16* VA = WSP(bf16, WS_VA); unsigned char* V8T = WSP(unsigned char, WS_V8T);
    for (int i = C.tid; i < 2 * 4 * 512; i += NTHREADS) v8t_chunk(VA, V8T, b, h0 + (i >> 11), (i >> 9) & 3, i & 511);
}
__device__ __forceinline__ unsigned char f8b(float v) { return (unsigned char)(pg8::pk4_fp8(v, 0.f, 0.f, 0.f) & 0xffu); }
__device__ __forceinline__ void ph_hyena_pre8(const Ctx& C) {
    const bf16* HY = WSP(bf16, WS_HY); unsigned char* UT = WSP(unsigned char, WS_UT); unsigned char* CP = WSP(unsigned char, WS_CP); const float* HF = WSP(float, WS_HF);
    const float* cw = INP(IX_CONVW); const float* cb_ = INP(IX_CONVB);
    LAS unsigned char* tile = C.lds;
    const int tid = C.tid;
    const bool skew = gridDim.x >= 64 && (gridDim.x & 7) == 0; const int vb0 = skew ? (int)blockIdx.x - 32 : (int)blockIdx.x, vnb = skew ? (int)gridDim.x - 32 : (int)gridDim.x;
    const bool fixc = (vnb & 7) == 0;
    const int tl = tid >> 3, c8 = (tid & 7) * 8;
    float w0[2][8], w1[2][8], w2[2][8], wb[2][8];
    if (fixc) {
#pragma unroll
        for (int gsel = 0; gsel < 2; ++gsel) { const int chn = 512 * (gsel + 1) + ((int)blockIdx.x & 7) * 64 + c8;
#pragma unroll
            for (int e = 0; e < 8; ++e) { w0[gsel][e] = cw[chn + e]; w1[gsel][e] = cw[1536 + chn + e]; w2[gsel][e] = cw[3072 + chn + e]; wb[gsel][e] = cb_[chn + e]; } } }
    const v4u zero4 = {0u, 0u, 0u, 0u};
#define HP_LOAD(IT, M, X, Q) do { const int cb_i = (IT) & 7, tb_i = ((IT) >> 3) & 63, b_i = (IT) >> 9; const int t_i = tb_i * 64 + tl; const size_t r_i = (size_t)b_i * SEQ + t_i; \
        _Pragma("unroll") for (int gsel = 0; gsel < 2; ++gsel) { const bf16* p_ = HY + r_i * 1536 + 512 * (gsel + 1) + cb_i * 64 + c8; \
            M[gsel] = t_i > 0 ? *(const v4u*)(p_ - 1536) : zero4; X[gsel] = *(const v4u*)p_; Q[gsel] = t_i < SEQ - 1 ? *(const v4u*)(p_ + 1536) : zero4; } } while (0)
    v4u cm[2], cx[2], cq[2], nm[2], nx[2], nq[2];
    int it = vb0 < 0 ? 8 * 64 * 8 : vb0;
    if (it < 8 * 64 * 8) HP_LOAD(it, cm, cx, cq);
    for (; it < 8 * 64 * 8; it += vnb) {
        const int cb = it & 7, tb = (it >> 3) & 63, b = it >> 9, c0 = cb * 64, t0 = tb * 64;
        const bool has_n = it + vnb < 8 * 64 * 8;
        if (has_n) HP_LOAD(it + vnb, nm, nx, nq);
        if (!fixc) {
#pragma unroll
            for (int gsel = 0; gsel < 2; ++gsel) { const int chn = 512 * (gsel + 1) + c0 + c8;
#pragma unroll
                for (int e = 0; e < 8; ++e) { w0[gsel][e] = cw[chn + e]; w1[gsel][e] = cw[1536 + chn + e]; w2[gsel][e] = cw[3072 + chn + e]; wb[gsel][e] = cb_[chn + e]; } } }
        float z[2][8];
#pragma unroll
        for (int gsel = 0; gsel < 2; ++gsel)
#pragma unroll
            for (int e = 0; e < 8; ++e) z[gsel][e] = bfe(cm[gsel], e) * w0[gsel][e] + bfe(cx[gsel], e) * w1[gsel][e] + bfe(cq[gsel], e) * w2[gsel][e] + wb[gsel][e];
        __syncthreads();
#pragma unroll
        for (int e = 0; e < 8; ++e) tile[(c8 + e) * 80 + tl] = f8b(z[0][e] * z[1][e]);
        __syncthreads();
        const unsigned long long o = *(const LAS unsigned long long*)(tile + (tid >> 3) * 80 + (tid & 7) * 8);
        *(unsigned long long*)(UT + ((size_t)(c0 + (tid >> 3)) * 8 + b) * SEQ + t0 + (tid & 7) * 8) = o;
        if (has_n) {
#pragma unroll
            for (int gsel = 0; gsel < 2; ++gsel) { cm[gsel] = nm[gsel]; cx[gsel] = nx[gsel]; cq[gsel] = nq[gsel]; } }
    }
#undef HP_LOAD
    __syncthreads();
    LAS float* hfl = (LAS float*)(C.lds + 16384);
    for (int it2 = vb0 < 0 ? 8 * 128 : vb0; it2 < 8 * 128; it2 += vnb) {
        const int cb = it2 & 7, xb = it2 >> 3, c0 = cb * 64, x0 = xb * 64, mbase = 8192 - x0 - 78;
        __syncthreads();
        for (int idx = tid; idx < 79 * 64; idx += NTHREADS) { const int lr = idx >> 6, cc = idx & 63, mp = mbase + lr; hfl[lr * 65 + cc] = (mp >= 1 && mp <= 8191) ? HF[(size_t)mp * 512 + c0 + cc] * 64.0f : 0.f; }
        __syncthreads();
        const int c = tid >> 3, x8 = (tid & 7) * 8;
#pragma unroll 4
        for (int rho = 0; rho < 16; ++rho) { float v[8];
#pragma unroll
            for (int e = 0; e < 8; ++e) v[e] = hfl[(78 - (x8 + e) - rho) * 65 + c];
            *(unsigned long long*)(CP + ((size_t)(c0 + c) * 16 + rho) * 8192 + x0 + x8) = (unsigned long long)pg8::pk4_fp8(v[0], v[1], v[2], v[3]) | ((unsigned long long)pg8::pk4_fp8(v[4], v[5], v[6], v[7]) << 32); }
    }
    __syncthreads();
}
typedef int v8i_h8 __attribute__((ext_vector_type(8)));
typedef int v4i_h8 __attribute__((ext_vector_type(4)));
constexpr int H8_TB = 32768, H8_Z = 65536;
__device__ __forceinline__ void ph_hyena_mfma8(const Ctx& C) {
    const unsigned char* UT = WSP(unsigned char, WS_UT); const unsigned char* CP = WSP(unsigned char, WS_CP); bf16* YT = WSP(bf16, WS_YT);
    const int lane = C.lane, n = lane & 31, hh = lane >> 5, b = C.wave;
    const unsigned ubo = (unsigned)b * 4096u, zrow = (unsigned)H8_Z;
    const int rho = (-n) & 15, cn = (n + rho) >> 4;
    if (C.tid < 16) ((LAS unsigned*)(C.lds + H8_Z))[C.tid] = 0u;
    __syncthreads();
    const int fh = b >> 2, fnb = (b >> 1) & 1, fhalf = b & 1;
    const int wfix = 256 - 2 * fnb + 2 * hh - cn;
    for (int c = blockIdx.x; c < 512; c += gridDim.x) {
        const unsigned char* src = UT + ((size_t)c * 8 + b) * SEQ;
#pragma unroll
        for (int it = 0; it < 4; ++it) { const int g = it * 64 + lane, p = g >> 2, c4 = g & 3; const v4u v = *(const v4u*)(src + g * 16);
            *(LAS v4u*)(C.lds + ubo + p * 64 + ((c4 ^ ((p >> 2) & 3)) << 4)) = v; }
        asm volatile("s_waitcnt vmcnt(0) lgkmcnt(0)" ::: "memory");
        f32x16_t acc[2][2];
#pragma unroll
        for (int i = 0; i < 2; ++i)
#pragma unroll
            for (int j = 0; j < 2; ++j)
#pragma unroll
                for (int r = 0; r < 16; ++r) acc[i][j][r] = 0.f;
        const unsigned char* cpl = CP + ((size_t)c * 16 + rho) * 8192 + 16 * fhalf;
#define H8_ISSUE(D_, slot_) do { const int sc_ = (2 * (D_) + fh) > 126 ? 126 : (2 * (D_) + fh); const int W_ = wfix - 4 * (sc_ - 63); \
        __builtin_amdgcn_global_load_lds((const unsigned*)(cpl + 16 * W_), (LAS unsigned*)(C.lds + H8_TB + (slot_) * 8192 + b * 1024), 16, 0, 0); } while (0)
#define H8_READ(TF, AF, s_, off_) do { const int d_ = (s_) - 63; const LAS unsigned char* tb_ = C.lds + H8_TB + (off_) + lane * 16; \
        _Pragma("unroll") for (int nb = 0; nb < 2; ++nb) { const v4i_h8 lo_ = *(const LAS v4i_h8*)(tb_ + (nb * 2 + 0) * 1024), hi_ = *(const LAS v4i_h8*)(tb_ + (nb * 2 + 1) * 1024); TF[nb] = __builtin_shufflevector(lo_, hi_, 0, 1, 2, 3, 4, 5, 6, 7); } \
        _Pragma("unroll") for (int ib = 0; ib < 2; ++ib) { if (ib == 0 ? (d_ <= 31) : (d_ >= -31)) { const int p_ = 32 * ib - d_ + n; const bool v_ = (unsigned)p_ < 64u; \
            const unsigned a0_ = v_ ? (ubo + (unsigned)(p_ * 64 + (((p_ >> 2) & 3) << 4))) : zrow; \
            const v4i_h8 lo_ = *(const LAS v4i_h8*)(C.lds + (a0_ ^ (unsigned)((2 * hh) << 4))), hi_ = *(const LAS v4i_h8*)(C.lds + (a0_ ^ (unsigned)((2 * hh + 1) << 4))); AF[ib] = __builtin_shufflevector(lo_, hi_, 0, 1, 2, 3, 4, 5, 6, 7); } } } while (0)
#define H8_MMA(TF, AF, s_) do { const int d_ = (s_) - 63; if ((s_) <= 126) { _Pragma("unroll") for (int ib = 0; ib < 2; ++ib) { if (ib == 0 ? (d_ <= 31) : (d_ >= -31)) { \
        _Pragma("unroll") for (int nb = 0; nb < 2; ++nb) acc[ib][nb] = __builtin_amdgcn_mfma_scale_f32_32x32x64_f8f6f4(AF[ib], TF[nb], acc[ib][nb], 0, 0, 0, 0x7F7F7F7F, 0, 0x79797979); } } } } while (0)
        H8_ISSUE(0, 0); H8_ISSUE(1, 1); H8_ISSUE(2, 2);
        asm volatile("s_waitcnt vmcnt(1)" ::: "memory"); __builtin_amdgcn_s_barrier(); asm volatile("" ::: "memory");
        v8i_h8 tfA[2], afA[2], tfB[2], afB[2];
#pragma unroll
        for (int i = 0; i < 2; ++i) { afA[i] = (v8i_h8){0, 0, 0, 0, 0, 0, 0, 0}; afB[i] = (v8i_h8){0, 0, 0, 0, 0, 0, 0, 0}; }
        H8_READ(tfA, afA, 0, 0);
#pragma unroll 1
        for (int D = 0; D < 64; ++D) {
            const int slot = D & 3;
            H8_ISSUE(D + 3, (D + 3) & 3);
            H8_READ(tfB, afB, 2 * D + 1, slot * 8192 + 4096);
            H8_MMA(tfA, afA, 2 * D);
            if (D < 63) H8_READ(tfA, afA, 2 * D + 2, ((D + 1) & 3) * 8192);
            H8_MMA(tfB, afB, 2 * D + 1);
            asm volatile("s_waitcnt vmcnt(1) lgkmcnt(0)" ::: "memory"); __builtin_amdgcn_s_barrier(); asm volatile("" ::: "memory");
        }
#undef H8_ISSUE
#undef H8_READ
#undef H8_MMA
        asm volatile("s_waitcnt vmcnt(0)" ::: "memory");
        bf16* dst = YT + ((size_t)c * 8 + b) * SEQ;
#pragma unroll
        for (int ib = 0; ib < 2; ++ib)
#pragma unroll
            for (int nb = 0; nb < 2; ++nb)
#pragma unroll
                for (int r = 0; r < 16; ++r) { const int i = 32 * ib + (r & 3) + 8 * (r >> 2) + 4 * hh; dst[64 * i + 32 * nb + n] = (bf16)f2bf(acc[ib][nb][r]); }
        asm volatile("s_waitcnt vmcnt(0) lgkmcnt(0)" ::: "memory"); __builtin_amdgcn_s_barrier(); asm volatile("" ::: "memory");
    }
    __syncthreads();
}
constexpr int LDS_HIST = RING_BYTES + 1024, LDS_LG = RING_BYTES + 2048;
__device__ __forceinline__ void ph_router2(const Ctx& C) {
    const float* MOD = WSP(float, WS_MOD); const float* SSQ = WSP(float, WS_SSQ); bf16* H = WSP(bf16, WS_H); const float* g2n = INP(IX_N2G); const float* RW = INP(IX_RW);
    int* TOPE = WSP(int, WS_TOPE); float* TOPW = WSP(float, WS_TOPW); unsigned* CNTB = WSP(unsigned, WS_CNTB);
    LAS unsigned* hist = (LAS unsigned*)(C.lds + LDS_HIST);
    const int lane = C.lane, tid = C.tid;
    for (int i = tid; i < 1024 * 8; i += NTHREADS) { const int k = i >> 3, ch = i & 7; const f32x4 w = *(const f32x4*)(RW + (size_t)k * 32 + ch * 4);
        *(LAS f32x4*)(C.lds + k * 128 + ((ch ^ ((k >> 1) & 7)) << 4)) = w; }
    const float rb = INP(IX_RB)[lane >> 1];
    for (int chk = blockIdx.x; chk < T / 128; chk += gridDim.x) {
        __syncthreads();
        if (tid < 32) hist[tid] = 0u;
        __syncthreads();
#pragma unroll 1
        for (int ri = 0; ri < 16; ++ri) {
            const int r = chk * 128 + C.wave * 16 + ri; const float* mrow = MOD + (r >> 12) * 6144;
            float v[16]; float ss = 0.f;
#pragma unroll
            for (int m = 0; m < 16; ++m) { const int col = lane + 64 * m; v[m] = C.out[(size_t)r * DM + col]; }
            ss = lane < 16 ? SSQ[(size_t)r * 16 + lane] : 0.f;
            const float rstd = rsqrtf(wave_sum(ss) * (1.0f / DM) + EPS);
            float p[32];
#pragma unroll
            for (int e = 0; e < 32; ++e) p[e] = 0.f;
#pragma unroll
            for (int m = 0; m < 16; ++m) { const int col = lane + 64 * m; const float y = v[m] * rstd * g2n[col] * (mrow[4096 + col] + 1.0f) + mrow[3072 + col];
                H[(size_t)r * DM + col] = (bf16)f2bf(y);
                const LAS unsigned char* wrow = C.lds + col * 128; const int sw = (col >> 1) & 7; asm volatile("" ::: "memory");
#pragma unroll
                for (int q = 0; q < 8; ++q) { const f32x4 w = *(const LAS f32x4*)(wrow + ((q ^ sw) << 4)); p[4 * q] += y * w.x; p[4 * q + 1] += y * w.y; p[4 * q + 2] += y * w.z; p[4 * q + 3] += y * w.w; } }
#define HALVE(N_, MASK_) _Pragma("unroll") for (int e = 0; e < (N_); ++e) { const float a = p[e], b2 = p[e + (N_)]; const bool up = (lane & (MASK_)) != 0; const float send = up ? a : b2, keep = up ? b2 : a; p[e] = keep + __shfl_xor(send, (MASK_)); }
            HALVE(16, 32) HALVE(8, 16) HALVE(4, 8) HALVE(2, 4) HALVE(1, 2)
#undef HALVE
            float lg = p[0] + __shfl_xor(p[0], 1) + rb;
            const int myid = lane >> 1;
            float tv[4]; int ti[4];
#pragma unroll
            for (int k = 0; k < 4; ++k) { float bv = lg; int bi = myid;
#pragma unroll
                for (int mask = 2; mask < 64; mask <<= 1) { const float ov = __shfl_xor(bv, mask); const int oi = __shfl_xor(bi, mask); const bool take = ov > bv || (ov == bv && oi < bi); bv = take ? ov : bv; bi = take ? oi : bi; }
                tv[k] = bv; ti[k] = bi; if (myid == bi) lg = -INFINITY; }
            const float e1 = __expf(tv[1] - tv[0]), e2 = __expf(tv[2] - tv[0]), e3 = __expf(tv[3] - tv[0]); const float inv = 1.0f / (1.0f + e1 + e2 + e3);
            if (lane == 0) { *(int4*)(TOPE + (size_t)r * 4) = make_int4(ti[0], ti[1], ti[2], ti[3]); *(f32x4*)(TOPW + (size_t)r * 4) = (f32x4){inv, e1 * inv, e2 * inv, e3 * inv};
                __hip_atomic_fetch_add(&hist[ti[0]], 1u, __ATOMIC_RELAXED, __HIP_MEMORY_SCOPE_WORKGROUP); __hip_atomic_fetch_add(&hist[ti[1]], 1u, __ATOMIC_RELAXED, __HIP_MEMORY_SCOPE_WORKGROUP);
                __hip_atomic_fetch_add(&hist[ti[2]], 1u, __ATOMIC_RELAXED, __HIP_MEMORY_SCOPE_WORKGROUP); __hip_atomic_fetch_add(&hist[ti[3]], 1u, __ATOMIC_RELAXED, __HIP_MEMORY_SCOPE_WORKGROUP); }
        }
        __syncthreads();
        if (tid < 32) CNTB[chk * 32 + tid] = hist[tid];
    }
    __syncthreads();
}
__device__ __forceinline__ void ph_sort2(const Ctx& C) {
    const unsigned* CNTB = WSP(unsigned, WS_CNTB); const int* TOPE = WSP(int, WS_TOPE); const float* TOPW = WSP(float, WS_TOPW);
    int* TOKPOS = WSP(int, WS_TOKPOS); int* ROWTOK = WSP(int, WS_ROWTOK); float* ROWW = WSP(float, WS_ROWW); int* BLKE = WSP(int, WS_BLKE);
    LAS int* ptot = (LAS int*)C.lds;
    LAS int* pbef = ptot + 512;
    LAS int* tot = pbef + 512;
    LAS int* base = tot + 32;
    LAS int* pst = base + 32;
    LAS int* wt = pst + 64;
    const int tid = C.tid, lane = C.lane;
    for (int chk = blockIdx.x; chk < T / 128; chk += gridDim.x) {
        __syncthreads();
        { const int e = tid & 31, part = tid >> 5; int s = 0, sb = 0;
          for (int c2 = part * 16; c2 < part * 16 + 16; ++c2) { const int v = (int)CNTB[c2 * 32 + e]; s += v; sb += (c2 < chk) ? v : 0; }
          ptot[part * 32 + e] = s; pbef[part * 32 + e] = sb; }
        __syncthreads();
        if (tid < 32) { int s = 0, sb = 0;
#pragma unroll
            for (int pp = 0; pp < 16; ++pp) { s += ptot[pp * 32 + tid]; sb += pbef[pp * 32 + tid]; }
            tot[tid] = s; base[tid] = sb; }
        __syncthreads();
        if (tid < 33) { int ps = 0; for (int i = 0; i < tid; ++i) ps += (tot[i] + 255) / 256 * 256; pst[tid] = ps; }
        __syncthreads();
        const int a = chk * 512 + tid; const int ea = TOPE[a]; int pre = 0;
#pragma unroll 4
        for (int e = 0; e < 32; ++e) { const unsigned long long bal = __ballot(ea == e); if (lane == 0) wt[C.wave * 32 + e] = __popcll(bal); if (ea == e) pre = __popcll(bal & ((1ull << lane) - 1ull)); }
        __syncthreads();
        int woff = 0;
#pragma unroll
        for (int w = 0; w < 8; ++w) woff += (w < C.wave) ? wt[w * 32 + ea] : 0;
        const int pos = pst[ea] + base[ea] + woff + pre;
        ROWTOK[pos] = a >> 2; ROWW[pos] = TOPW[a]; TOKPOS[a] = pos;
        if (chk < NE) { const int e = chk, st = pst[e] + tot[e], en = pst[e + 1]; for (int i = st + tid; i < en; i += NTHREADS) { ROWTOK[i] = T; ROWW[i] = 0.f; } }
        if (chk == 0 && tid < DM / 16) ((v4u*)(WSP(unsigned char, WS_H) + (size_t)T * DM))[tid] = (v4u){0u, 0u, 0u, 0u};
        if (chk == T / 128 - 1) { for (int blk = tid; blk <= NBLK; blk += NTHREADS) { int e = NE - 1;
#pragma unroll 1
                for (int i = NE - 1; i >= 0; --i) if (blk * 256 < pst[i + 1]) e = i;
                if (blk < NBLK) BLKE[blk] = e; else BLKE[NBLK] = pst[NE] / 256; } }
    }
    __syncthreads();
}
constexpr int LDS_GS = RING_BYTES + 4096;
__device__ __forceinline__ void ph_router3(const Ctx& C) {
    const float* MOD = WSP(float, WS_MOD); const float* SSQ = WSP(float, WS_SSQ); unsigned char* H = WSP(unsigned char, WS_H); const float* g2n = INP(IX_N2G); const float* RW = INP(IX_RW);
    int* TOPE = WSP(int, WS_TOPE); float* TOPW = WSP(float, WS_TOPW); unsigned* CNTB = WSP(unsigned, WS_CNTB);
    LAS float* Wl = (LAS float*)C.lds; LAS float* gsl = (LAS float*)(C.lds + LDS_GS); LAS float* shl = gsl + 1024;
    LAS unsigned* hist = (LAS unsigned*)(C.lds + LDS_HIST);
    const int lane = C.lane, tid = C.tid, i = lane & 15, kk = lane >> 4;
    for (int i0 = tid; i0 < 1024 * 32; i0 += 8 * NTHREADS) { float wv[8];
#pragma unroll
        for (int u = 0; u < 8; ++u) wv[u] = RW[i0 + u * NTHREADS];
#pragma unroll
        for (int u = 0; u < 8; ++u) { const int idx = i0 + u * NTHREADS, k = idx >> 5, ex = idx & 31, q = k >> 4, k2 = (k >> 2) & 3, e = k & 3, nb = ex >> 4, j = ex & 15;
            Wl[((q * 4 + e) * 2 + nb) * 64 + k2 * 16 + j] = wv[u]; } }
    const float rb0 = INP(IX_RB)[i], rb1 = INP(IX_RB)[16 + i];
    for (int chk = blockIdx.x; chk < T / 128; chk += gridDim.x) {
        __syncthreads();
        const float* mrow = MOD + (chk >> 5) * 6144;
        for (int k = tid; k < 1024; k += NTHREADS) { gsl[k] = g2n[k] * (1.0f + mrow[4096 + k]); shl[k] = mrow[3072 + k]; }
        if (tid < 32) hist[tid] = 0u;
        __syncthreads();
        const int r0 = chk * 128 + C.wave * 16, r = r0 + i;
        float ss; { const f32x4 s4 = *(const f32x4*)(SSQ + (size_t)r * 16 + 4 * kk); ss = (s4[0] + s4[1]) + (s4[2] + s4[3]); ss += __shfl_xor(ss, 16); ss += __shfl_xor(ss, 32); }
        const float rstd = rsqrtf(ss * (1.0f / DM) + EPS);
        f32x4 acc0 = {0.f, 0.f, 0.f, 0.f}, acc1 = {0.f, 0.f, 0.f, 0.f};
        const float* xr = C.out + (size_t)r * DM + 4 * kk; unsigned char* hr = H + (size_t)r * DM + 4 * kk;
#pragma unroll 8
        for (int q = 0; q < 64; ++q) {
            const f32x4 x = *(const f32x4*)(xr + 16 * q); const f32x4 gs = *(const LAS f32x4*)(gsl + 16 * q + 4 * kk), sh = *(const LAS f32x4*)(shl + 16 * q + 4 * kk);
            const f32x4 h = x * rstd * gs + sh;
            *(unsigned*)(hr + 16 * q) = pg8::pk4_fp8(h[0], h[1], h[2], h[3]);
#pragma unroll
            for (int e = 0; e < 4; ++e) { const float b0 = Wl[((q * 4 + e) * 2 + 0) * 64 + lane], b1 = Wl[((q * 4 + e) * 2 + 1) * 64 + lane];
                acc0 = __builtin_amdgcn_mfma_f32_16x16x4f32(h[e], b0, acc0, 0, 0, 0); acc1 = __builtin_amdgcn_mfma_f32_16x16x4f32(h[e], b1, acc1, 0, 0, 0); }
        }
#pragma unroll
        for (int reg = 0; reg < 4; ++reg) {
            float v0 = acc0[reg] + rb0, v1 = acc1[reg] + rb1; float tv[4]; int ti[4];
#pragma unroll
            for (int k = 0; k < 4; ++k) { const bool f0 = v0 >= v1; float bv = f0 ? v0 : v1; int bi = f0 ? i : 16 + i;
#pragma unroll
                for (int mask = 1; mask < 16; mask <<= 1) { const float ov = __shfl_xor(bv, mask); const int oi = __shfl_xor(bi, mask); const bool take = ov > bv || (ov == bv && oi < bi); bv = take ? ov : bv; bi = take ? oi : bi; }
                tv[k] = bv; ti[k] = bi; if (bi == i) v0 = -INFINITY; if (bi == 16 + i) v1 = -INFINITY; }
            const float e1 = __expf(tv[1] - tv[0]), e2 = __expf(tv[2] - tv[0]), e3 = __expf(tv[3] - tv[0]); const float inv = 1.0f / (1.0f + e1 + e2 + e3);
            if (i == 0) { const size_t row = (size_t)(r0 + 4 * kk + reg); *(int4*)(TOPE + row * 4) = make_int4(ti[0], ti[1], ti[2], ti[3]); *(f32x4*)(TOPW + row * 4) = (f32x4){inv, e1 * inv, e2 * inv, e3 * inv};
                __hip_atomic_fetch_add(&hist[ti[0]], 1u, __ATOMIC_RELAXED, __HIP_MEMORY_SCOPE_WORKGROUP); __hip_atomic_fetch_add(&hist[ti[1]], 1u, __ATOMIC_RELAXED, __HIP_MEMORY_SCOPE_WORKGROUP);
                __hip_atomic_fetch_add(&hist[ti[2]], 1u, __ATOMIC_RELAXED, __HIP_MEMORY_SCOPE_WORKGROUP); __hip_atomic_fetch_add(&hist[ti[3]], 1u, __ATOMIC_RELAXED, __HIP_MEMORY_SCOPE_WORKGROUP); }
        }
        __syncthreads();
        if (tid < 32) CNTB[chk * 32 + tid] = hist[tid];
    }
    __syncthreads();
}
__device__ __forceinline__ void ph_attention(const Ctx& C) {
    const unsigned char* Q8 = WSP(unsigned char, WS_QP); const unsigned char* K8 = WSP(unsigned char, WS_KA); const unsigned char* V8T = WSP(unsigned char, WS_V8T); bf16* OA = WSP(bf16, WS_OAB);
    const float lam = *WSP(float, WS_LAM); const float* sg = INP(IX_SUBG);
    const float sbound = 0.20358f * sqrtf(__uint_as_float(WSP(unsigned, WS_CTL)[CW_NMAX]) * __uint_as_float(WSP(unsigned, WS_CTL)[CW_NMAX + 64]));
    const bool nomax = __builtin_amdgcn_readfirstlane((int)(sbound > 0.f && sbound <= 15.6f)) != 0;
    const bool xl = gridDim.x == 256;
#define ATT_UNITS(NM) for (int it = 0; it < (xl ? 4 : (NB * 4 * (SEQ / 128) + (int)gridDim.x - 1) / (int)gridDim.x); ++it) { \
        int u; \
        if (xl) { const int x = blockIdx.x & 7, j = blockIdx.x >> 3; u = ((4 * x + it) << 5) | j; } else { u = blockIdx.x + it * gridDim.x; if (u >= NB * 4 * (SEQ / 128)) break; } \
        const int qb = u & 31, h = (u >> 5) & 3, b = u >> 7; \
        const long q0 = ((long)b * SEQ + qb * 128) * 512 + h * 128, k0 = (long)b * SKV * 512 + h * 128, o0 = ((long)b * SEQ + qb * 128) * 1024 + h * 128, v0 = (long)(b * 4 + h) * (SKV / 64) * 8192; \
        __syncthreads(); \
        att::attn_diff_body8<NM>(Q8 + q0, K8 + k0, V8T + v0, OA + o0, SKV, C.ldsg, C.lds, lam, sg, 0.8f); }
    if (nomax) { ATT_UNITS(true) } else { ATT_UNITS(false) }
#undef ATT_UNITS
    __syncthreads();
}
enum { PH_PREP = 0, PH_MOD1, PH_INPROJ, PH_POST, PH_ATTN, PH_HYENA, PH_ATTNPOST, PH_MERGEUP, PH_WOUT, PH_ROUTER, PH_SORT, PH_MOE1, PH_MOE2, PH_COMBINE, N_PHASES };
struct Args { const float* in[N_INPUTS]; float* out; unsigned char* ws; int ph_lo, ph_hi, li, pad; };
static_assert(sizeof(Args) == N_INPUTS * 8 + 8 + 8 + 16, "Args has no padding");

#ifndef PG8_ALIGN
#define PG8_ALIGN true
#endif
namespace cg = cooperative_groups;
__global__ void __launch_bounds__(NTHREADS, 2) fwd(Args args) {
    cg::grid_group grid_g = cg::this_grid();
    extern __shared__ __attribute__((aligned(16))) unsigned char lds_raw[];
    Ctx C;
    C.out = args.out; C.ws = args.ws; C.lds = (LAS unsigned char*)lds_raw; C.ldsg = (char*)lds_raw;
    C.tid = threadIdx.x; C.lane = C.tid & 63; C.wave = __builtin_amdgcn_readfirstlane(C.tid >> 6);
    C.gwave = blockIdx.x * NWAVES + C.wave; C.nwaves = gridDim.x * NWAVES; C.gtid = blockIdx.x * NTHREADS + C.tid; C.gthreads = gridDim.x * NTHREADS;
    const int lo = args.ph_lo, hi = args.ph_hi;
    volatile LAS unsigned* MISC = (volatile LAS unsigned*)(C.lds + MISC_OFF);
    if (C.tid < 32) MISC[C.tid] = 0u;
    __syncthreads();
    unsigned* barw = (unsigned*)(C.ws + WS_CTL) + CW_BAR + args.li * XCD_BAR_WORDS;
    XcdBarrier xbar; xbar.bar = barw; xbar.x = 0; xbar.st = nullptr;
    if (hi - lo > 1) xbar = xcd_barrier_post(barw, MISC + 8);
#define IN(k) (lo <= (k) && (k) < hi)
#define SEAM(k) do { if (IN(k) && IN((k) + 1)) { if (args.li < 0) grid_g.sync(); else xcd_barrier(xbar); } } while (0)
    if (IN(PH_PREP)) { ph_prep_weights(C); __syncthreads(); ph_prep_ada(C); __syncthreads(); ph_prep_misc(C); ph_prep_filter(C); }
    SEAM(PH_PREP);
    if (IN(PH_MOD1)) { ph_modulate1(C); }
    SEAM(PH_MOD1);
    if (IN(PH_INPROJ)) {
        {
            LAS float* tb = (LAS float*)(C.lds + RING_BYTES + 20480);
            for (int i = C.tid; i < 1024; i += NTHREADS) { tb[i] = WSP(float, WS_ROPEC)[i]; tb[1024 + i] = WSP(float, WS_ROPES)[i]; }
            if (C.tid < 64) { tb[2048 + C.tid] = INP(IX_QNG)[C.tid]; tb[2048 + 64 + C.tid] = INP(IX_KNG)[C.tid]; }
            __syncthreads(); }
        {
            pg8::Gemm g{WSP(bf16, WS_XM), WSP(bf16, WS_WIN), T, 3072, DM, 0}; pg8::WinOrder S; S.so.init(T, 3072, gridDim.x, (int)blockIdx.x); S.pn0 = 0;
            pg8::EpiInProj E{WSP(bf16, WS_QP), WSP(bf16, WS_KA), WSP(bf16, WS_VA), WSP(bf16, WS_HY), WSP(bf16, WS_GT), INP(IX_BIN), C.lds, T, SKV, CTX, WSP(unsigned, WS_CTL) + CW_NMAX};
            pg8::gemm_phase<pg8::EpiInProj, pg8::WinOrder, PG8_ALIGN, true>(C.lds, g, S, E); }
        {
            pg8::Gemm g{WSP(bf16, WS_XM8), (const bf16*)(WSP(unsigned char, WS_WG8) - (size_t)12 * 256 * 1024), T, 2048, DM / 2, 0}; pg8::WinOrder S; S.so.init(T, 2048, gridDim.x, (int)blockIdx.x); S.pn0 = 12;
            pg8::EpiInProjT<true> E{WSP(bf16, WS_QP), WSP(bf16, WS_KA), WSP(bf16, WS_VA), WSP(bf16, WS_HY), WSP(bf16, WS_GT), INP(IX_BIN), C.lds, T, SKV, CTX, WSP(unsigned, WS_CTL) + CW_NMAX};
            pg8::gemm_phase<pg8::EpiInProjT<true>, pg8::WinOrder, PG8_ALIGN, true>(C.lds, g, S, E); }
    }
    SEAM(PH_INPROJ);
    if (IN(PH_POST)) {
        {
            LAS float* tb = (LAS float*)(C.lds + RING_BYTES + 20480);
            for (int i = C.tid; i < 1024; i += NTHREADS) { tb[i] = WSP(float, WS_ROPEC)[i]; tb[1024 + i] = WSP(float, WS_ROPES)[i]; }
            if (C.tid < 64) { tb[2048 + C.tid] = INP(IX_QNG)[C.tid]; tb[2048 + 64 + C.tid] = INP(IX_KNG)[C.tid]; }
            __syncthreads(); }
        { pg8::Gemm g{WSP(bf16, WS_XM), WSP(bf16, WS_WIN), MROWS, NIN, DM, 0}; pg8::CtxOrder S{(int)gridDim.x, (int)blockIdx.x};
          pg8::EpiInProj E{WSP(bf16, WS_QP), WSP(bf16, WS_KA), WSP(bf16, WS_VA), WSP(bf16, WS_HY), WSP(bf16, WS_GT), INP(IX_BIN), C.lds, T, SKV, CTX, WSP(unsigned, WS_CTL) + CW_NMAX};
          pg8::gemm_phase<pg8::EpiInProj, pg8::CtxOrder, true, true>(C.lds, g, S, E); }
        asm volatile("s_waitcnt vmcnt(0)" ::: "memory"); __syncthreads();
        if (gridDim.x >= 32 && blockIdx.x >= 16 && blockIdx.x < 32) ph_v8t_ctx(C, (int)blockIdx.x & 7, 2 * (((int)blockIdx.x >> 3) - 2));
        __syncthreads(); ph_hyena_pre8(C); ph_v8t(C); }
    SEAM(PH_POST);
    if (IN(PH_ATTN)) { ph_attention(C); }
    if (IN(PH_HYENA)) { ph_hyena_mfma8(C); }
    SEAM(PH_HYENA);
    if (IN(PH_ATTNPOST)) { ph_hyena_post(C); }
    SEAM(PH_ATTNPOST);
    if (IN(PH_MERGEUP)) {
        pg8::Gemm g{WSP(bf16, WS_OAB), WSP(bf16, WS_WA), T, DM, DM, 0}; pg8::StaticOrder S; S.init(T, DM, gridDim.x, (int)blockIdx.x);
        pg8::EpiMerge E{WSP(bf16, WS_MB), WSP(bf16, WS_GT)}; pg8::gemm_phase<pg8::EpiMerge, pg8::StaticOrder, PG8_ALIGN, true>(C.lds, g, S, E);
    }
    SEAM(PH_MERGEUP);
    if (IN(PH_WOUT)) {
        pg8::Gemm g{WSP(bf16, WS_MB), WSP(bf16, WS_WO), T, DM, DM, 0}; pg8::StaticOrder S; S.init(T, DM, gridDim.x, (int)blockIdx.x);
        pg8::EpiWout E{INP(IX_X), C.out, WSP(float, WS_MOD), WSP(float, WS_SSQ)}; pg8::gemm_phase<pg8::EpiWout, pg8::StaticOrder, PG8_ALIGN, true>(C.lds, g, S, E);
    }
    SEAM(PH_WOUT);
    if (IN(PH_ROUTER)) { ph_router3(C); }
    SEAM(PH_ROUTER);
    if (IN(PH_SORT)) { ph_sort2(C); }
    SEAM(PH_SORT);
    if (IN(PH_MOE1)) {
        const int nblk = WSP(int, WS_BLKE)[NBLK];
        pg8::MoeGatherOrder S; S.so.init(nblk * 256, 2048, gridDim.x, (int)blockIdx.x); S.blke = WSP(int, WS_BLKE); S.tokl = (const LAS unsigned short*)(C.lds + LDS_GS);
        {
            LAS unsigned short* tl = (LAS unsigned short*)(C.lds + LDS_GS); const int* ROWTOK = WSP(int, WS_ROWTOK); pg8::Unit uu;
            LAS int* pml = (LAS int*)(C.lds + LDS_GS + 10240);
            if (C.tid == 0) { for (int ui = 0; ui < 20; ++ui) pml[ui] = S.so.next(ui, uu) ? uu.pm : -1; }
            __syncthreads();
#define TL_LD(u) const int pm##u = pml[u]; int tv##u = 0; if (pm##u >= 0 && C.tid < 256) tv##u = ROWTOK[pm##u * 256 + C.tid];
#define TL_ST(u) if (C.tid < 256) tl[(u) * 256 + C.tid] = (unsigned short)tv##u;
            TL_LD(0) TL_LD(1) TL_LD(2) TL_LD(3) TL_LD(4) TL_LD(5) TL_LD(6) TL_LD(7) TL_LD(8) TL_LD(9) TL_LD(10) TL_LD(11) TL_LD(12) TL_LD(13) TL_LD(14) TL_LD(15) TL_LD(16) TL_LD(17) TL_LD(18) TL_LD(19)
            TL_ST(0) TL_ST(1) TL_ST(2) TL_ST(3) TL_ST(4) TL_ST(5) TL_ST(6) TL_ST(7) TL_ST(8) TL_ST(9) TL_ST(10) TL_ST(11) TL_ST(12) TL_ST(13) TL_ST(14) TL_ST(15) TL_ST(16) TL_ST(17) TL_ST(18) TL_ST(19)
#undef TL_LD
#undef TL_ST
        }
        __syncthreads();
        pg8::Gemm g{WSP(bf16, WS_H), WSP(bf16, WS_W1), nblk * 256, 2048, DM / 2, (size_t)2048 * 1024};
        pg8::EpiSwiglu E{WSP(unsigned char, WS_ACT), INP(IX_EB1), C.lds}; pg8::gemm_phase<pg8::EpiSwiglu, pg8::MoeGatherOrder, PG8_ALIGN, true>(C.lds, g, S, E);
    }
    SEAM(PH_MOE1);
    if (IN(PH_MOE2)) {
        const int nblk = WSP(int, WS_BLKE)[NBLK];
        pg8::Gemm g{WSP(bf16, WS_ACT), WSP(bf16, WS_W2), nblk * 256, DM, DM / 2, (size_t)1024 * 1024}; pg8::MoeOrder S; S.so.init(nblk * 256, DM, gridDim.x, (int)blockIdx.x); S.blke = WSP(int, WS_BLKE);
        pg8::EpiY E{WSP(unsigned char, WS_Y), INP(IX_EB2), WSP(float, WS_ROWW), C.lds}; pg8::gemm_phase<pg8::EpiY, pg8::MoeOrder, PG8_ALIGN, true>(C.lds, g, S, E);
    }
    SEAM(PH_MOE2);
    if (IN(PH_COMBINE)) { ph_combine(C); }
#undef IN
#undef SEAM
}

extern "C" void kernel_launch(void* const* d_in, const int* in_sizes, int n_in, void* d_out, int out_size, void* d_ws, size_t ws_size, hipStream_t stream) {
    static int grid = 0;
    if (grid == 0) {
        if (n_in != N_INPUTS || in_sizes[0] != T * DM || out_size != T * DM || ws_size < WS_END) { fprintf(stderr, "kernel_launch: unexpected shapes n_in %d in0 %d out %d ws %zu (need %zu)\n", n_in, n_in > 0 ? in_sizes[0] : -1, out_size, ws_size, (size_t)WS_END); grid = -1; return; }
        int dev = 0, cus = 0;
        if (hipGetDevice(&dev) != hipSuccess || hipDeviceGetAttribute(&cus, hipDeviceAttributeMultiprocessorCount, dev) != hipSuccess) { grid = -1; return; }
        if (hipFuncSetAttribute((const void*)fwd, hipFuncAttributeMaxDynamicSharedMemorySize, LDS_BYTES) != hipSuccess) { fprintf(stderr, "kernel_launch: hipFuncSetAttribute failed\n"); grid = -1; return; }
        int per_cu = 0;
        if (hipOccupancyMaxActiveBlocksPerMultiprocessor(&per_cu, (const void*)fwd, NTHREADS, LDS_BYTES) != hipSuccess || per_cu < 1) { fprintf(stderr, "kernel_launch: occupancy query says %d blocks per CU\n", per_cu); grid = -1; return; }
        grid = cus;
    }
    if (grid < 0) return;
    (void)hipMemsetAsync((char*)d_ws + WS_CTL, 0, CTL_BYTES, stream);
    Args a{};
    for (int i = 0; i < N_INPUTS; ++i) a.in[i] = (const float*)d_in[i];
    a.out = (float*)d_out; a.ws = (unsigned char*)d_ws;
#ifndef PROBE_DUP
#define PROBE_DUP -1
#endif
    int cuts[5] = {0, N_PHASES, N_PHASES, N_PHASES, N_PHASES}, nl = 1;
    if (PROBE_DUP >= 0) { cuts[1] = PROBE_DUP + 1; cuts[2] = PROBE_DUP; cuts[3] = PROBE_DUP + 1; nl = 4; }
    for (int li = 0; li < (PROBE_DUP >= 0 ? 3 : 1); ++li) {
        if (PROBE_DUP >= 0) { a.ph_lo = li == 0 ? 0 : (li == 1 ? PROBE_DUP : PROBE_DUP + 1); a.ph_hi = li == 2 ? N_PHASES : PROBE_DUP + 1; } else { a.ph_lo = 0; a.ph_hi = N_PHASES; }
        a.li = li; (void)cuts; (void)nl;
        if (a.ph_lo >= a.ph_hi) continue;
        void* kargs[] = {&a};
        const hipError_t le = hipLaunchCooperativeKernel((const void*)fwd, dim3(grid), dim3(NTHREADS), kargs, LDS_BYTES, stream);
        if (le != hipSuccess) fprintf(stderr, "kernel_launch: cooperative launch failed: %s (grid %d)\n", hipGetErrorString(le), grid);
    }
}
```

```cpp
#include <hip/hip_runtime.h>
#include <hip/hip_bf16.h>
#include <hip/hip_cooperative_groups.h>
#include <cstdio>
#include <cstdint>
#include <cmath>
namespace pg8 {
#define PG8_LAS __attribute__((address_space(3)))
typedef unsigned short bf16_t;
typedef short bf16x8 __attribute__((ext_vector_type(8)));
typedef float f32x4 __attribute__((ext_vector_type(4)));
typedef unsigned u32x4 __attribute__((ext_vector_type(4)));
typedef int v4i_t __attribute__((ext_vector_type(4)));
typedef int v8i_t __attribute__((ext_vector_type(8)));
constexpr int EPI_OFF = 131072 + 16384;
constexpr int BM = 256, BK = 64, HALF = 128, HTB = HALF * BK * 2  , STAGE_BYTES = 8 * HTB, NXCD = 8, WGM = 8;

__host__ __device__ __forceinline__ int lds_byte(int r, int c) { const int st = (r >> 4) * 2 + (c >> 5), rr = r & 15, cc = c & 31, ob = rr * 64 + cc * 2; return st * 1024 + (ob ^ (((ob >> 9) & 1) << 5)); }
__host__ __device__ __forceinline__ void stage_rc(int b, int& R, int& C) { const int st = b / 1024, sb = b % 1024, swz = sb ^ (((sb >> 9) & 1) << 5); R = (st >> 1) * 16 + swz / 64; C = (st & 1) * 32 + (swz % 64) / 2; }
__host__ __device__ __forceinline__ int perm32(int rho) { const int n = rho >> 4, i = rho & 15; return 8 * (i >> 2) + 4 * n + (i & 3); }

struct Unit { int pm, pn, be, es; };
struct Gemm { const bf16_t* A; const bf16_t* Bt; int M, N, K; size_t bstride; };

struct StaticOrder {
    static constexpr bool GATHER = false;
    int nM, nN, nwg, G, c;
    __host__ __device__ __forceinline__ void init(int M, int N, int G_, int c_) { nM = M / BM; nN = N / BM; nwg = nM * nN; G = G_; c = c_; }
    __host__ __device__ __forceinline__ bool next(int i, Unit& u) const {
        const long L = (long)i * G + c; if (L >= nwg) return false;
        int wgid = (int)L; { const int q = nwg / NXCD, r = nwg % NXCD, xcd = wgid % NXCD, off = wgid / NXCD; wgid = (xcd < r ? xcd * (q + 1) : r * (q + 1) + (xcd - r) * q) + off; }
        const int nig = WGM * nN, gid = wgid / nig, fm = gid * WGM, gsz = (nM - fm) < WGM ? (nM - fm) : WGM;
        u.pm = fm + ((wgid % nig) % gsz); u.pn = (wgid % nig) / gsz; u.be = 0; u.es = 0; return true;
    }
    __device__ __forceinline__ void a_ready(const Unit&) const {}
    __device__ __forceinline__ void done(const Unit&) const {}
};

__device__ __forceinline__ unsigned cvt_pk_bf16(float lo, float hi) { unsigned r; asm volatile("v_cvt_pk_bf16_f32 %0, %1, %2" : "=v"(r) : "v"(lo), "v"(hi)); return r; }
typedef float f32x2 __attribute__((ext_vector_type(2)));
__device__ __forceinline__ f32x2 gelu_pk(f32x2 v) {
    const f32x2 av = __builtin_elementwise_abs(v), d = av * 0.2316418882f + 1.0f;
    f32x2 t; t.x = __builtin_amdgcn_rcpf(d.x); t.y = __builtin_amdgcn_rcpf(d.y);
    f32x2 q = t * 0.5307027145f + (-0.7265760135f); q = q * t + 0.7107068705f; q = q * t + (-0.142248368f); q = q * t + 0.127414796f; q = q * t;
    const f32x2 s = (v * v) * (-0.72134752044f);
    f32x2 e; e.x = __builtin_amdgcn_exp2f(s.x); e.y = __builtin_amdgcn_exp2f(s.y);
    const f32x2 m = v * (q * e), r = v - m;
    f32x2 o; o.x = v.x < 0.f ? m.x : r.x; o.y = v.y < 0.f ? m.y : r.y; return o;
}

template <int ACT  > struct EpiBf16 {
    static constexpr bool PERM = true, AFTER_DRAIN = false, HAS_MID = false, F8 = false, PREFETCH = false; static constexpr int WSCALE = 0x7F7F7F7F; static_assert(ACT == 0 || ACT == 1, "EpiBf16: ACT is 0 (none) or 1 (gelu_pk)");
    bf16_t* O; int ldc; const float* bias; int split_cols; size_t split_stride; float scale0;
    __device__ __forceinline__ void operator()(const f32x4 (&acc)[2][2][4][2], const Unit& u, int wr, int wc, int fr, int fq) const {
        const int row0 = u.pm * BM + wr * 64 + fr; int colt = u.pn * BM; bf16_t* base = O;
        float sc = 1.f; if (split_cols) { const int t = colt / split_cols; base += (size_t)t * split_stride; colt -= t * split_cols; if (t == 0) sc = scale0; }
        const int col0 = colt + wc * 32 + 8 * fq, bcol0 = u.pn * BM + wc * 32 + 8 * fq;
        f32x4 bv[2][2];
#pragma unroll
        for (int bj = 0; bj < 2; ++bj)
#pragma unroll
            for (int n = 0; n < 2; ++n) bv[bj][n] = bias ? *(const f32x4*)(bias + bcol0 + bj * HALF + 4 * n) : (f32x4){0.f, 0.f, 0.f, 0.f};
#pragma unroll
        for (int ai = 0; ai < 2; ++ai)
#pragma unroll
            for (int m = 0; m < 4; ++m) { bf16_t* rowp = base + (size_t)(row0 + ai * HALF + m * 16) * ldc + col0;
#pragma unroll
                for (int bj = 0; bj < 2; ++bj) { f32x4 v0 = acc[ai][bj][m][0] + bv[bj][0], v1 = acc[ai][bj][m][1] + bv[bj][1];
                    if (ACT == 1) { f32x2 a = gelu_pk((f32x2){v0[0], v0[1]}), b = gelu_pk((f32x2){v0[2], v0[3]}), c = gelu_pk((f32x2){v1[0], v1[1]}), d = gelu_pk((f32x2){v1[2], v1[3]});
                        v0 = (f32x4){a.x, a.y, b.x, b.y}; v1 = (f32x4){c.x, c.y, d.x, d.y}; }
                    v0 = v0 * sc; v1 = v1 * sc; u32x4 w; w.x = cvt_pk_bf16(v0[0], v0[1]); w.y = cvt_pk_bf16(v0[2], v0[3]); w.z = cvt_pk_bf16(v1[0], v1[1]); w.w = cvt_pk_bf16(v1[2], v1[3]);
                    *(u32x4*)(rowp + bj * HALF) = w; } }
    }
};
struct EpiF32 {
    static constexpr bool PERM = false, AFTER_DRAIN = false, HAS_MID = false, F8 = false, PREFETCH = false; static constexpr int WSCALE = 0x7F7F7F7F;
    float* C; int ldc; const float* bias;
    __device__ __forceinline__ void operator()(const f32x4 (&acc)[2][2][4][2], const Unit& u, int wr, int wc, int fr, int fq) const {
        const int row0 = u.pm * BM + wr * 64 + fr, col0 = u.pn * BM + wc * 32 + 4 * fq;
        f32x4 bv[2][2];
#pragma unroll
        for (int bj = 0; bj < 2; ++bj)
#pragma unroll
            for (int n = 0; n < 2; ++n) bv[bj][n] = bias ? *(const f32x4*)(bias + col0 + bj * HALF + n * 16) : (f32x4){0.f, 0.f, 0.f, 0.f};
#pragma unroll
        for (int ai = 0; ai < 2; ++ai)
#pragma unroll
            for (int m = 0; m < 4; ++m) { float* rowp = C + (size_t)(row0 + ai * HALF + m * 16) * ldc + col0;
#pragma unroll
                for (int bj = 0; bj < 2; ++bj)
#pragma unroll
                    for (int n = 0; n < 2; ++n) *(f32x4*)(rowp + bj * HALF + n * 16) = acc[ai][bj][m][n] + bv[bj][n]; }
    }
};
__device__ __forceinline__ void epi_dma(const void* src, PG8_LAS unsigned char* dst) { __builtin_amdgcn_global_load_lds((const unsigned*)src, (PG8_LAS unsigned*)dst, 16, 0, 0); }
__device__ __forceinline__ unsigned pk4_fp8(float a, float b, float c, float d) {
    a = __builtin_fminf(__builtin_fmaxf(a, -448.f), 448.f); b = __builtin_fminf(__builtin_fmaxf(b, -448.f), 448.f); c = __builtin_fminf(__builtin_fmaxf(c, -448.f), 448.f); d = __builtin_fminf(__builtin_fmaxf(d, -448.f), 448.f);
    int w = 0; w = __builtin_amdgcn_cvt_pk_fp8_f32(a, b, w, false); w = __builtin_amdgcn_cvt_pk_fp8_f32(c, d, w, true); return (unsigned)w; }
struct EpiSwiglu {
    static constexpr bool PERM = true, AFTER_DRAIN = false, HAS_MID = false, F8 = true, PREFETCH = true; static constexpr int WSCALE = 0x7A7A7A7A;
    unsigned char* O; const float* b1; PG8_LAS unsigned char* el;
    __device__ __forceinline__ void prefetch(const Unit& u, int slot, int wid, int lane) const {
        if (wid == 0) epi_dma(b1 + (size_t)u.be * 2048 + (lane >> 5) * 1024 + u.pn * HALF + (lane & 31) * 4, el + EPI_OFF + slot * 2048); }
    __device__ __forceinline__ void operator()(const f32x4 (&acc)[2][2][4][2], const Unit& u, int wr, int wc, int fr, int fq) const {
        const int row0 = u.pm * BM + wr * 64 + fr; const int ch0 = u.pn * HALF + wc * 32 + 8 * fq;
        const PG8_LAS float* bb = (const PG8_LAS float*)(el + EPI_OFF + u.es * 2048) + wc * 32 + 8 * fq;
        f32x4 bg[2], bu[2];
#pragma unroll
        for (int n = 0; n < 2; ++n) { bg[n] = *(const PG8_LAS f32x4*)(bb + 4 * n); bu[n] = *(const PG8_LAS f32x4*)(bb + 128 + 4 * n); }
#pragma unroll
        for (int ai = 0; ai < 2; ++ai)
#pragma unroll
            for (int m = 0; m < 4; ++m) { unsigned char* rowp = O + (size_t)(row0 + ai * HALF + m * 16) * 1024 + ch0;
                f32x4 a[2];
#pragma unroll
                for (int n = 0; n < 2; ++n) { const f32x4 g = acc[ai][0][m][n] + bg[n], up = acc[ai][1][m][n] + bu[n];
#pragma unroll
                    for (int e = 0; e < 4; ++e) { const float gg = fminf(g[e], 7.0f), uu = fminf(fmaxf(up[e], -7.0f), 7.0f);
                        const float sg = __builtin_amdgcn_rcpf(1.0f + __builtin_amdgcn_exp2f(-1.702f * 1.4426950408889634f * gg));
                        a[n][e] = (uu + 1.0f) * gg * sg; } }
                *(unsigned long long*)rowp = (unsigned long long)pk4_fp8(a[0][0], a[0][1], a[0][2], a[0][3]) | ((unsigned long long)pk4_fp8(a[1][0], a[1][1], a[1][2], a[1][3]) << 32); }
    }
};
struct EpiY {
    static constexpr bool PERM = true, AFTER_DRAIN = false, HAS_MID = false, F8 = true; static constexpr int WSCALE = 0x7A7A7A7A;
    unsigned char* O; const float* b2; const float* roww; PG8_LAS unsigned char* el;
    static constexpr bool PREFETCH = true;
    __device__ __forceinline__ void prefetch(const Unit& u, int slot, int wid, int lane) const {
        if (wid == 0) epi_dma(b2 + (size_t)u.be * 1024 + u.pn * BM + lane * 4, el + EPI_OFF + slot * 2048);
        if (wid == 1) epi_dma(roww + (size_t)u.pm * BM + lane * 4, el + EPI_OFF + slot * 2048 + 1024); }
    __device__ __forceinline__ void operator()(const f32x4 (&acc)[2][2][4][2], const Unit& u, int wr, int wc, int fr, int fq) const {
        const int row0 = u.pm * BM + wr * 64 + fr; const int col0 = u.pn * BM + wc * 32 + 8 * fq;
        const PG8_LAS float* sl = (const PG8_LAS float*)(el + EPI_OFF + u.es * 2048); const PG8_LAS float* bb = sl + wc * 32 + 8 * fq;
        f32x4 bv[2][2];
#pragma unroll
        for (int bj = 0; bj < 2; ++bj)
#pragma unroll
            for (int n = 0; n < 2; ++n) bv[bj][n] = *(const PG8_LAS f32x4*)(bb + bj * HALF + 4 * n);
#pragma unroll
        for (int ai = 0; ai < 2; ++ai)
#pragma unroll
            for (int m = 0; m < 4; ++m) { const int row = row0 + ai * HALF + m * 16; const float rw = sl[256 + ai * HALF + wr * 64 + m * 16 + fr] * 16.0f; unsigned char* rowp = O + (size_t)row * 1024 + col0;
#pragma unroll
                for (int bj = 0; bj < 2; ++bj) { const f32x4 v0 = (acc[ai][bj][m][0] + bv[bj][0]) * rw, v1 = (acc[ai][bj][m][1] + bv[bj][1]) * rw;
                    *(unsigned long long*)(rowp + bj * HALF) = (unsigned long long)pk4_fp8(v0[0], v0[1], v0[2], v0[3]) | ((unsigned long long)pk4_fp8(v1[0], v1[1], v1[2], v1[3]) << 32); } }
    }
};
struct MoeOrder {
    static constexpr bool GATHER = false;
    StaticOrder so; const int* blke;
    __device__ __forceinline__ bool next(int i, Unit& u) const { if (!so.next(i, u)) return false; u.be = blke[u.pm]; return true; }
    __device__ __forceinline__ void a_ready(const Unit&) const {}
    __device__ __forceinline__ void done(const Unit&) const {}
};
__device__ __forceinline__ void st_bf16x4(bf16_t* p, const f32x4& v) { *(unsigned long long*)p = (unsigned long long)cvt_pk_bf16(v[0], v[1]) | ((unsigned long long)cvt_pk_bf16(v[2], v[3]) << 32); }
template <bool F8_> struct EpiInProjT {
    static constexpr bool PERM = false, AFTER_DRAIN = false, HAS_MID = false, F8 = F8_, PREFETCH = true; static constexpr int WSCALE = F8_ ? 0x7A7A7A7A : 0x7F7F7F7F;
    bf16_t *QP, *KA, *VA, *HY, *GT; const float* bias; PG8_LAS unsigned char* el; int T_, SKV_, CTX_; unsigned* nmax;
    static constexpr int TAB_OFF = 131072 + 20480;
    __device__ __forceinline__ void prefetch(const Unit& u, int slot, int wid, int lane) const { if (wid == 0) epi_dma(bias + 256 * u.pn + lane * 4, el + EPI_OFF + slot * 2048); }
    __device__ __forceinline__ void operator()(const f32x4 (&acc)[2][2][4][2], const Unit& u, int wr, int wc, int fr_, int fq_) const {
        int fr = fr_, fq = fq_; asm volatile("" : "+v"(fr), "+v"(fq));
        const int pn = u.pn;
        if (pn < 4) {
            const bool isk = pn >= 2; const PG8_LAS float* g = (const PG8_LAS float*)(el + TAB_OFF + 8192 + (isk ? 256 : 0)); const PG8_LAS float* bsl = (const PG8_LAS float*)(el + EPI_OFF + u.es * 2048);
            const PG8_LAS float* rc = (const PG8_LAS float*)(el + TAB_OFF); const PG8_LAS float* rs = rc + 1024;
            f32x4 bv[2][2], gv[2][2];
#pragma unroll
            for (int bj = 0; bj < 2; ++bj)
#pragma unroll
                for (int n = 0; n < 2; ++n) { bv[bj][n] = *(const PG8_LAS f32x4*)(bsl + 64 * wc + 32 * bj + 16 * n + 4 * fq); gv[bj][n] = *(const PG8_LAS f32x4*)(g + 32 * bj + 16 * n + 4 * fq); }
            float nrm2 = 0.f;
#pragma unroll
            for (int ai = 0; ai < 2; ++ai)
#pragma unroll
                for (int m = 0; m < 4; ++m) { const int r = u.pm * BM + ai * HALF + wr * 64 + m * 16 + fr;
                    f32x4 x[2][2]; float ss = 0.f;
#pragma unroll
                    for (int bj = 0; bj < 2; ++bj)
#pragma unroll
                        for (int n = 0; n < 2; ++n) { x[bj][n] = acc[ai][bj][m][n] + bv[bj][n]; ss += (x[bj][n][0] * x[bj][n][0] + x[bj][n][1] * x[bj][n][1]) + (x[bj][n][2] * x[bj][n][2] + x[bj][n][3] * x[bj][n][3]); }
                    ss += __shfl_xor(ss, 16); ss += __shfl_xor(ss, 32);
                    const float rstd = rsqrtf(ss * (1.0f / 64.0f) + 1e-6f);
#pragma unroll
                    for (int bj = 0; bj < 2; ++bj)
#pragma unroll
                        for (int n = 0; n < 2; ++n) x[bj][n] = x[bj][n] * rstd * gv[bj][n];
                    { float s2 = 0.f;
#pragma unroll
                      for (int bj = 0; bj < 2; ++bj)
#pragma unroll
                        for (int n = 0; n < 2; ++n) s2 += (x[bj][n][0] * x[bj][n][0] + x[bj][n][1] * x[bj][n][1]) + (x[bj][n][2] * x[bj][n][2] + x[bj][n][3] * x[bj][n][3]);
                      s2 += __shfl_xor(s2, 16); s2 += __shfl_xor(s2, 32); nrm2 = fmaxf(nrm2, s2); }
                    const bool latent = r < T_; const int t = r & 4095;
                    if (latent) {
#pragma unroll
                        for (int bj = 0; bj < 2; ++bj) { const int pos = bj ? (t & 63) : (t >> 6); const f32x4 cs = *(const PG8_LAS f32x4*)(rc + pos * 16 + 4 * fq), sn = *(const PG8_LAS f32x4*)(rs + pos * 16 + 4 * fq);
                            const f32x4 x1 = x[bj][0], x2 = x[bj][1]; x[bj][0] = x1 * cs - x2 * sn; x[bj][1] = x2 * cs + x1 * sn; } }
                    if (!isk) { unsigned char* base = (unsigned char*)QP + (size_t)r * 512 + 256 * (pn & 1) + 64 * wc;
#pragma unroll
                        for (int bj = 0; bj < 2; ++bj)
#pragma unroll
                            for (int n = 0; n < 2; ++n) { const f32x4 v = x[bj][n] * 0.72134752044448170f; *(unsigned*)(base + 32 * bj + 16 * n + 4 * fq) = pk4_fp8(v[0], v[1], v[2], v[3]); } }
                    else { const size_t krow = latent ? (size_t)(r >> 12) * SKV_ + CTX_ + t : (size_t)((r - T_) >> 8) * SKV_ + ((r - T_) & 255); unsigned char* base = (unsigned char*)KA + krow * 512 + 256 * (pn & 1) + 64 * wc;
#pragma unroll
                        for (int bj = 0; bj < 2; ++bj)
#pragma unroll
                            for (int n = 0; n < 2; ++n) { const f32x4 v = x[bj][n]; *(unsigned*)(base + 32 * bj + 16 * n + 4 * fq) = pk4_fp8(v[0], v[1], v[2], v[3]); } }
                }
            nrm2 = fmaxf(nrm2, __shfl_xor(nrm2, 1)); nrm2 = fmaxf(nrm2, __shfl_xor(nrm2, 2)); nrm2 = fmaxf(nrm2, __shfl_xor(nrm2, 4)); nrm2 = fmaxf(nrm2, __shfl_xor(nrm2, 8));
            if (fr == 0 && fq == 0) (void)__hip_atomic_fetch_max(nmax + (isk ? 64 : 0), __float_as_uint(nrm2), __ATOMIC_RELAXED, __HIP_MEMORY_SCOPE_AGENT);
        } else {
            const int kind = pn < 6 ? 0 : (pn < 12 ? 1 : 2);
            const int lc0 = 32 * wc + 8 * fq;
            f32x4 bv[2][2];
#pragma unroll
            for (int bj = 0; bj < 2; ++bj)
#pragma unroll
                for (int n = 0; n < 2; ++n) bv[bj][n] = *(const PG8_LAS f32x4*)((const PG8_LAS float*)(el + EPI_OFF + u.es * 2048) + 128 * bj + lc0 + 4 * n);
#pragma unroll
            for (int ai = 0; ai < 2; ++ai)
#pragma unroll
                for (int m = 0; m < 4; ++m) { const int r = u.pm * BM + ai * HALF + wr * 64 + m * 16 + fr;
                    bf16_t* rowp;
                    if (kind == 0) { const size_t vrow = r < T_ ? (size_t)(r >> 12) * SKV_ + CTX_ + (r & 4095) : (size_t)((r - T_) >> 8) * SKV_ + ((r - T_) & 255); rowp = VA + vrow * 512 + 256 * (pn - 4) + lc0; }
                    else if (kind == 1) rowp = HY + (size_t)r * 1536 + 256 * (pn - 6) + lc0;
                    else rowp = GT + (size_t)r * 2048 + 256 * (pn - 12) + lc0;
#pragma unroll
                    for (int bj = 0; bj < 2; ++bj) { f32x4 v0 = acc[ai][bj][m][0] + bv[bj][0], v1 = acc[ai][bj][m][1] + bv[bj][1];
                        if (kind == 2) {
#pragma unroll
                            for (int e = 0; e < 4; ++e) { v0[e] = __builtin_amdgcn_rcpf(1.0f + __builtin_amdgcn_exp2f(-1.4426950408889634f * v0[e])); v1[e] = __builtin_amdgcn_rcpf(1.0f + __builtin_amdgcn_exp2f(-1.4426950408889634f * v1[e])); } }
                        u32x4 w; w.x = cvt_pk_bf16(v0[0], v0[1]); w.y = cvt_pk_bf16(v0[2], v0[3]); w.z = cvt_pk_bf16(v1[0], v1[1]); w.w = cvt_pk_bf16(v1[2], v1[3]);
                        *(u32x4*)(rowp + bj * HALF) = w; } }
        }
    }
};
typedef EpiInProjT<false> EpiInProj;
struct WinOrder {
    static constexpr bool GATHER = false;
    StaticOrder so; int pn0;
    __device__ __forceinline__ bool next(int i, Unit& u) const { if (!so.next(i, u)) return false; u.pn += pn0; return true; }
    __device__ __forceinline__ void a_ready(const Unit&) const {}
    __device__ __forceinline__ void done(const Unit&) const {}
};
struct CtxOrder {
    static constexpr bool GATHER = false;
    int G, c;
    __device__ __forceinline__ bool next(int i, Unit& u) const { const int L = i * G + c; if (L >= 32) return false; u.pm = 128 + (L & 7); u.pn = 2 + (L >> 3); u.be = 0; u.es = 0; return true; }
    __device__ __forceinline__ void a_ready(const Unit&) const {}
    __device__ __forceinline__ void done(const Unit&) const {}
};

__device__ __forceinline__ float bf_lo(unsigned d) { return __builtin_bit_cast(float, d << 16); }
__device__ __forceinline__ float bf_hi(unsigned d) { return __builtin_bit_cast(float, d & 0xffff0000u); }
struct EpiMerge {
    static constexpr bool PERM = true, AFTER_DRAIN = false, HAS_MID = true, F8 = false, PREFETCH = false; static constexpr int WSCALE = 0x7F7F7F7F;
    bf16_t* O; const bf16_t* GT;
    __device__ __forceinline__ void mid(f32x4 (&acc)[2][2][4][2], const Unit& u, int wr, int wc, int fr_, int fq_) const {
        int fr = fr_, fq = fq_; asm volatile("" : "+v"(fr), "+v"(fq));
        const bf16_t* __restrict__ G = GT;
        const int row0 = u.pm * BM + wr * 64 + fr, col0 = u.pn * BM + wc * 32 + 8 * fq;
#pragma unroll
        for (int ai = 0; ai < 2; ++ai)
#pragma unroll
            for (int mp = 0; mp < 2; ++mp) { u32x4 ga[2][2], gb[2][2];
#pragma unroll
                for (int q = 0; q < 2; ++q) { const bf16_t* gp = G + (size_t)(row0 + ai * HALF + (2 * mp + q) * 16) * 2048 + col0;
#pragma unroll
                    for (int bj = 0; bj < 2; ++bj) { ga[q][bj] = *(const u32x4*)(gp + bj * HALF); gb[q][bj] = *(const u32x4*)(gp + 1024 + bj * HALF); } }
#pragma unroll
                for (int q = 0; q < 2; ++q) { const int m = 2 * mp + q;
#pragma unroll
                    for (int bj = 0; bj < 2; ++bj) { const u32x4 a = ga[q][bj], b = gb[q][bj]; f32x4 r0, r1;
                        r0[0] = bf_lo(a.x) * __builtin_amdgcn_rcpf(bf_lo(b.x)); r0[1] = bf_hi(a.x) * __builtin_amdgcn_rcpf(bf_hi(b.x)); r0[2] = bf_lo(a.y) * __builtin_amdgcn_rcpf(bf_lo(b.y)); r0[3] = bf_hi(a.y) * __builtin_amdgcn_rcpf(bf_hi(b.y));
                        r1[0] = bf_lo(a.z) * __builtin_amdgcn_rcpf(bf_lo(b.z)); r1[1] = bf_hi(a.z) * __builtin_amdgcn_rcpf(bf_hi(b.z)); r1[2] = bf_lo(a.w) * __builtin_amdgcn_rcpf(bf_lo(b.w)); r1[3] = bf_hi(a.w) * __builtin_amdgcn_rcpf(bf_hi(b.w));
                        acc[ai][bj][m][0] = acc[ai][bj][m][0] * r0; acc[ai][bj][m][1] = acc[ai][bj][m][1] * r1; } }
                asm volatile("" ::: "memory"); }
    }
    __device__ __forceinline__ void operator()(const f32x4 (&acc)[2][2][4][2], const Unit& u, int wr, int wc, int fr, int fq) const {
        const bf16_t* __restrict__ G = GT; bf16_t* __restrict__ Or = O;
        const int row0 = u.pm * BM + wr * 64 + fr, col0 = u.pn * BM + wc * 32 + 8 * fq;
#pragma unroll
        for (int ai = 0; ai < 2; ++ai) { u32x4 gb[4][2];
#pragma unroll
            for (int m = 0; m < 4; ++m)
#pragma unroll
                for (int bj = 0; bj < 2; ++bj) gb[m][bj] = *(const u32x4*)(G + (size_t)(row0 + ai * HALF + m * 16) * 2048 + 1024 + col0 + bj * HALF);
#pragma unroll
            for (int m = 0; m < 4; ++m) { bf16_t* rowp = Or + (size_t)(row0 + ai * HALF + m * 16) * 1024 + col0;
#pragma unroll
                for (int bj = 0; bj < 2; ++bj) { const u32x4 b = gb[m][bj]; const f32x4 v0 = acc[ai][bj][m][0], v1 = acc[ai][bj][m][1];
                    u32x4 w; w.x = cvt_pk_bf16(v0[0] * bf_lo(b.x), v0[1] * bf_hi(b.x)); w.y = cvt_pk_bf16(v0[2] * bf_lo(b.y), v0[3] * bf_hi(b.y));
                    w.z = cvt_pk_bf16(v1[0] * bf_lo(b.z), v1[1] * bf_hi(b.z)); w.w = cvt_pk_bf16(v1[2] * bf_lo(b.w), v1[3] * bf_hi(b.w));
                    *(u32x4*)(rowp + bj * HALF) = w; } } }
    }
};
struct EpiWout {
    static constexpr bool PERM = false, AFTER_DRAIN = false, HAS_MID = false, F8 = false, PREFETCH = false; static constexpr int WSCALE = 0x7F7F7F7F;
    const float* X; float* O; const float* MOD; float* SSQ;
    __device__ __forceinline__ void operator()(const f32x4 (&acc)[2][2][4][2], const Unit& u, int wr, int wc, int fr, int fq) const {
        const float* __restrict__ Xr = X; float* __restrict__ Or = O; float* __restrict__ Sr = SSQ;
        const int row0 = u.pm * BM + wr * 64 + fr, col0 = u.pn * BM + wc * 32 + 4 * fq;
        const float* g1p = MOD + (row0 >> 12) * 6144 + 2048 + col0;
        f32x4 g1[2][2];
#pragma unroll
        for (int bj = 0; bj < 2; ++bj)
#pragma unroll
            for (int n = 0; n < 2; ++n) g1[bj][n] = *(const f32x4*)(g1p + bj * HALF + n * 16);
#pragma unroll
        for (int ai = 0; ai < 2; ++ai)
#pragma unroll
            for (int mp = 0; mp < 2; ++mp) { f32x4 xv[2][2][2];
#pragma unroll
                for (int q = 0; q < 2; ++q) { const size_t off = (size_t)(row0 + ai * HALF + (2 * mp + q) * 16) * 1024 + col0;
#pragma unroll
                    for (int bj = 0; bj < 2; ++bj)
#pragma unroll
                        for (int n = 0; n < 2; ++n) xv[q][bj][n] = *(const f32x4*)(Xr + off + bj * HALF + n * 16); }
#pragma unroll
                for (int q = 0; q < 2; ++q) { const int m = 2 * mp + q; const int row = row0 + ai * HALF + m * 16; const size_t off = (size_t)row * 1024 + col0; float ss = 0.f;
#pragma unroll
                    for (int bj = 0; bj < 2; ++bj)
#pragma unroll
                        for (int n = 0; n < 2; ++n) { const f32x4 v = xv[q][bj][n] + g1[bj][n] * acc[ai][bj][m][n];
                            *(f32x4*)(Or + off + bj * HALF + n * 16) = v; ss += (v[0] * v[0] + v[1] * v[1]) + (v[2] * v[2] + v[3] * v[3]); }
                    ss += __shfl_xor(ss, 16); ss += __shfl_xor(ss, 32);
                    if (fq == 0) Sr[(size_t)row * 16 + u.pn * 4 + wc] = ss; } }
    }
};

struct MoeGatherOrder {
    static constexpr bool GATHER = true;
    StaticOrder so; const int* blke; const PG8_LAS unsigned short* tokl;
    __device__ __forceinline__ bool next(int i, Unit& u) const { if (!so.next(i, u)) return false; u.be = blke[u.pm]; return true; }
    __device__ __forceinline__ int gather_tok(int ui, int row) const { return (int)tokl[ui * 256 + row]; }
    __device__ __forceinline__ void a_ready(const Unit&) const {}
    __device__ __forceinline__ void done(const Unit&) const {}
};
template <bool F8> struct FragT { typedef bf16x8 A[4][2]; typedef bf16x8 B[2][2]; };
template <> struct FragT<true> { typedef v8i_t A[4]; typedef v8i_t B[2]; };
template <class Epi, class Sched, bool ALIGN_EPI = false, bool SP2 = false>
__device__ __forceinline__ void gemm_phase(PG8_LAS unsigned char* lds, const Gemm g, const Sched& S, const Epi& E) {
    const int tid = threadIdx.x, wid = __builtin_amdgcn_readfirstlane(tid >> 6), lane = tid & 63, wr = wid >> 2, wc = wid & 3, fr = lane & 15, fq = lane >> 4;
    const int K = g.K, nt = K / BK;
    unsigned voffA[2], voffB[2];
#pragma unroll
    for (int i = 0; i < 2; ++i) { int R, C; stage_rc(tid * 16 + i * 8192, R, C); const int Rb = Epi::PERM ? ((R & ~31) + perm32(R & 31)) : R;
        voffA[i] = (unsigned)(R * K + C) * 2u; voffB[i] = (unsigned)(Rb * K + C) * 2u; }
    const size_t kstep = (size_t)(BK * 2);
    const size_t hstep = (size_t)HALF * K * 2;
    const size_t tstep = 2 * hstep;
    const unsigned ldsw = (unsigned)wid * 1024u;
    const int aoff = lds_byte(wr * 64 + fr, fq * 8), boff = lds_byte(wc * 32 + fr, fq * 8);
    const int aoff8 = aoff, boff8 = boff;
#define PG8_SA(b, h) (((b) * 2 + (h)) * HTB)
#define PG8_SB(b, h) ((4 + (b) * 2 + (h)) * HTB)
#define PG8_STAGE(bufoff, gbase, voff) do { _Pragma("unroll") for (int _i = 0; _i < 2; ++_i) \
        __builtin_amdgcn_global_load_lds((const unsigned*)((const char*)(gbase) + (voff)[_i]), (PG8_LAS unsigned*)(lds + (bufoff) + ldsw + _i * 8192), 16, 0, 0); } while (0)
#define PG8_STAGE_A(bufoff, gbase, h, nx) do { if constexpr (Sched::GATHER) { unsigned gv_[2]; \
        if (nx) { _Pragma("unroll") for (int i_ = 0; i_ < 2; ++i_) { int R_, C_; stage_rc(tid * 16 + i_ * 8192, R_, C_); gv_[i_] = (unsigned)(S.gather_tok(ui + 1, 128 * (h) + R_) * K + C_) * 2u; } } \
        else { gv_[0] = cvA[h][0]; gv_[1] = cvA[h][1]; } \
        PG8_STAGE(bufoff, gbase, gv_); } \
        else { PG8_STAGE(bufoff, (gbase) + (h) * hstep, voffA); } } while (0)
#define PG8_LD32(off_) __builtin_shufflevector(__builtin_bit_cast(v4i_t, *(const PG8_LAS bf16x8*)(lds + (off_))), __builtin_bit_cast(v4i_t, *(const PG8_LAS bf16x8*)(lds + (off_) + 1024)), 0, 1, 2, 3, 4, 5, 6, 7)
#define PG8_LDA(dst, b, h) do { if constexpr (Epi::F8) { _Pragma("unroll") for (int m = 0; m < 4; ++m) dst[m] = PG8_LD32(PG8_SA(b, h) + aoff8 + m * 2048); } else { \
        _Pragma("unroll") for (int m = 0; m < 4; ++m) _Pragma("unroll") for (int k = 0; k < 2; ++k) dst[m][k] = *(const PG8_LAS bf16x8*)(lds + PG8_SA(b, h) + aoff + m * 2048 + k * 1024); } } while (0)
#define PG8_LDB(dst, b, h) do { if constexpr (Epi::F8) { _Pragma("unroll") for (int n = 0; n < 2; ++n) dst[n] = PG8_LD32(PG8_SB(b, h) + boff8 + n * 2048); } else { \
        _Pragma("unroll") for (int n = 0; n < 2; ++n) _Pragma("unroll") for (int k = 0; k < 2; ++k) dst[n][k] = *(const PG8_LAS bf16x8*)(lds + PG8_SB(b, h) + boff + n * 2048 + k * 1024); } } while (0)
#define PG8_MMA(ai, bj, At, Bt) do { __builtin_amdgcn_s_setprio(1); if constexpr (Epi::F8) { \
        _Pragma("unroll") for (int m = 0; m < 4; ++m) _Pragma("unroll") for (int n = 0; n < 2; ++n) \
            acc[ai][bj][m][n] = __builtin_amdgcn_mfma_scale_f32_16x16x128_f8f6f4(Bt[n], At[m], acc[ai][bj][m][n], 0, 0, 0, Epi::WSCALE, 0, 0x7F7F7F7F); \
        _Pragma("unroll") for (int m = 0; m < 4; ++m) _Pragma("unroll") for (int n = 0; n < 2; ++n) asm volatile("" : "+v"(acc[ai][bj][m][n])); } else { \
        _Pragma("unroll") for (int m = 0; m < 4; ++m) _Pragma("unroll") for (int n = 0; n < 2; ++n) _Pragma("unroll") for (int k = 0; k < 2; ++k) \
        acc[ai][bj][m][n] = __builtin_amdgcn_mfma_f32_16x16x32_bf16(Bt[n][k], At[m][k], acc[ai][bj][m][n], 0, 0, 0); } __builtin_amdgcn_s_setprio(0); } while (0)
#define PG8_WAIT_V(n) asm volatile("s_waitcnt vmcnt(" #n ")" ::: "memory")
#define PG8_WAIT_L(n) asm volatile("s_waitcnt lgkmcnt(" #n ")" ::: "memory")
#define PG8_BAR __builtin_amdgcn_s_barrier()
#define PG8_SCHED __builtin_amdgcn_sched_barrier(0)
    Unit cur, nxt; int ui = 0;
    if (!S.next(0, cur)) return;
    f32x4 acc[2][2][4][2];
#pragma unroll
    for (int a = 0; a < 2; ++a)
#pragma unroll
        for (int b = 0; b < 2; ++b)
#pragma unroll
            for (int m = 0; m < 4; ++m)
#pragma unroll
                for (int n = 0; n < 2; ++n) acc[a][b][m][n] = (f32x4){0.f, 0.f, 0.f, 0.f};
    typename FragT<Epi::F8>::A At; typename FragT<Epi::F8>::B B0, B1;
    const char* cA = (const char*)g.A + (Sched::GATHER ? (size_t)0 : (size_t)cur.pm * tstep);
    unsigned cvA[2][2];
    if constexpr (Sched::GATHER) {
#pragma unroll
        for (int h = 0; h < 2; ++h)
#pragma unroll
            for (int i = 0; i < 2; ++i) { int R, Cc; stage_rc(tid * 16 + i * 8192, R, Cc); cvA[h][i] = (unsigned)(S.gather_tok(0, 128 * h + R) * K + Cc) * 2u; } } const char* cB = (const char*)g.Bt + (size_t)cur.be * g.bstride + (size_t)cur.pn * tstep;
    S.a_ready(cur);
    if constexpr (Epi::PREFETCH) E.prefetch(cur, 0, wid, lane);
    if constexpr (SP2) {
        PG8_STAGE(PG8_SB(0, 0), cB, voffB); PG8_STAGE(PG8_SB(0, 1), cB + hstep, voffB); PG8_STAGE_A(PG8_SA(0, 0), cA, 0, false); PG8_STAGE_A(PG8_SA(0, 1), cA, 1, false);
        if (wr == 1) PG8_BAR;
        PG8_WAIT_V(2); PG8_BAR;
        PG8_STAGE(PG8_SB(1, 0), cB + kstep, voffB); PG8_STAGE_A(PG8_SA(1, 0), cA + kstep, 0, false); PG8_STAGE(PG8_SB(1, 1), cB + hstep + kstep, voffB);
        PG8_WAIT_V(6); PG8_BAR;
    } else {
        PG8_STAGE(PG8_SB(0, 0), cB, voffB); PG8_STAGE_A(PG8_SA(0, 0), cA, 0, false); PG8_STAGE(PG8_SB(0, 1), cB + hstep, voffB); PG8_STAGE_A(PG8_SA(0, 1), cA, 1, false);
        if (wr == 1) PG8_BAR;
        PG8_WAIT_V(4); PG8_BAR;
        PG8_STAGE(PG8_SB(1, 0), cB + kstep, voffB); PG8_STAGE_A(PG8_SA(1, 0), cA + kstep, 0, false); PG8_STAGE(PG8_SB(1, 1), cB + hstep + kstep, voffB);
        PG8_WAIT_V(6); PG8_BAR;
    }
    for (;;) {
        const bool has_next = S.next(ui + 1, nxt);
        const char* nA = (has_next && !Sched::GATHER) ? (const char*)g.A + (size_t)nxt.pm * tstep : cA;
 const char* nB = has_next ? (const char*)g.Bt + (size_t)nxt.be * g.bstride + (size_t)nxt.pn * tstep : cB;
        for (int t = 0; t < nt; t += 2) {
            const bool last = (t == nt - 2);
            const char* a1 = cA + (size_t)(t + 1) * kstep;
            const char* a2 = last ? nA : cA + (size_t)(t + 2) * kstep; const char* b2 = last ? nB : cB + (size_t)(t + 2) * kstep;
            const char* a3 = a2 + kstep; const char* b3 = b2 + kstep;
            if (last && has_next) S.a_ready(nxt);
            if constexpr (Epi::HAS_MID) { if (t == nt / 2) E.mid(acc, cur, wr, wc, fr, fq); }
            if constexpr (SP2) {
            PG8_LDB(B0, 0, 0); PG8_LDB(B1, 0, 1); PG8_SCHED; PG8_LDA(At, 0, 0); PG8_STAGE_A(PG8_SA(1, 1), a1, 1, false);
            PG8_WAIT_V(8); PG8_WAIT_L(0); PG8_BAR; PG8_MMA(0, 0, At, B0); PG8_MMA(0, 1, At, B1); PG8_BAR; PG8_SCHED;
            PG8_LDA(At, 0, 1); PG8_STAGE(PG8_SB(0, 0), b2, voffB); PG8_STAGE(PG8_SB(0, 1), b2 + hstep, voffB); PG8_STAGE_A(PG8_SA(0, 0), a2, 0, last && has_next);
            PG8_WAIT_V(8); PG8_WAIT_L(0); PG8_BAR; PG8_MMA(1, 0, At, B0); PG8_MMA(1, 1, At, B1); PG8_BAR; PG8_SCHED;
            PG8_LDB(B0, 1, 0); PG8_LDB(B1, 1, 1); PG8_SCHED; PG8_LDA(At, 1, 0); PG8_STAGE_A(PG8_SA(0, 1), a2, 1, last && has_next);
            PG8_WAIT_V(8); PG8_WAIT_L(0); PG8_BAR; PG8_MMA(0, 0, At, B0); PG8_MMA(0, 1, At, B1); PG8_BAR; PG8_SCHED;
            PG8_LDA(At, 1, 1); PG8_STAGE(PG8_SB(1, 0), b3, voffB); PG8_STAGE(PG8_SB(1, 1), b3 + hstep, voffB); PG8_STAGE_A(PG8_SA(1, 0), a3, 0, last && has_next);
            PG8_WAIT_V(8); PG8_WAIT_L(0); PG8_BAR; PG8_MMA(1, 0, At, B0); PG8_MMA(1, 1, At, B1); PG8_BAR; PG8_SCHED;
            } else {
            PG8_LDB(B0, 0, 0); PG8_SCHED; PG8_LDA(At, 0, 0); PG8_STAGE_A(PG8_SA(1, 1), a1, 1, false);
            PG8_WAIT_L(8); PG8_BAR; PG8_WAIT_L(0); PG8_MMA(0, 0, At, B0); PG8_BAR; PG8_SCHED;
            PG8_LDB(B1, 0, 1); PG8_STAGE(PG8_SB(0, 0), b2, voffB);
            PG8_BAR; PG8_WAIT_L(0); PG8_MMA(0, 1, At, B1); PG8_BAR;
            PG8_LDA(At, 0, 1); PG8_STAGE_A(PG8_SA(0, 0), a2, 0, last && has_next);
            PG8_BAR; PG8_WAIT_L(0); PG8_MMA(1, 0, At, B0); PG8_BAR; PG8_SCHED;
            PG8_STAGE(PG8_SB(0, 1), b2 + hstep, voffB);
            PG8_WAIT_V(6); PG8_BAR; PG8_MMA(1, 1, At, B1); PG8_BAR;
            PG8_LDB(B0, 1, 0); PG8_SCHED; PG8_LDA(At, 1, 0); PG8_STAGE_A(PG8_SA(0, 1), a2, 1, last && has_next);
            PG8_WAIT_L(8); PG8_BAR; PG8_WAIT_L(0); PG8_MMA(0, 0, At, B0); PG8_BAR; PG8_SCHED;
            PG8_LDB(B1, 1, 1); PG8_STAGE(PG8_SB(1, 0), b3, voffB);
            PG8_BAR; PG8_WAIT_L(0); PG8_MMA(0, 1, At, B1); PG8_BAR;
            PG8_LDA(At, 1, 1); PG8_STAGE_A(PG8_SA(1, 0), a3, 0, last && has_next);
            PG8_BAR; PG8_WAIT_L(0); PG8_MMA(1, 0, At, B0); PG8_BAR; PG8_SCHED;
            PG8_STAGE(PG8_SB(1, 1), b3 + hstep, voffB);
            PG8_WAIT_V(6); PG8_BAR; PG8_MMA(1, 1, At, B1); PG8_BAR;
            }
        }
        if constexpr (ALIGN_EPI) { if (wr == 0) PG8_BAR; }
        if constexpr (!Epi::AFTER_DRAIN) { cur.es = ui & 1; E(acc, cur, wr, wc, fr, fq); S.done(cur); }
        if (!has_next) break;
        if constexpr (Epi::PREFETCH) E.prefetch(nxt, (ui + 1) & 1, wid, lane);
#pragma unroll
        for (int a = 0; a < 2; ++a)
#pragma unroll
            for (int b = 0; b < 2; ++b)
#pragma unroll
                for (int m = 0; m < 4; ++m)
#pragma unroll
                    for (int n = 0; n < 2; ++n) acc[a][b][m][n] = (f32x4){0.f, 0.f, 0.f, 0.f};
        cur = nxt; cA = nA; cB = nB; ++ui;
        if constexpr (Sched::GATHER) {
#pragma unroll
            for (int h = 0; h < 2; ++h)
#pragma unroll
                for (int i = 0; i < 2; ++i) { int R, Cc; stage_rc(tid * 16 + i * 8192, R, Cc); cvA[h][i] = (unsigned)(S.gather_tok(ui, 128 * h + R) * K + Cc) * 2u; } }
        if constexpr (ALIGN_EPI) { if (wr == 1) PG8_BAR; }
    }
    PG8_WAIT_V(0);
    if constexpr (!ALIGN_EPI) { if (wr == 0) PG8_BAR; }
    PG8_BAR;
    if constexpr (Epi::AFTER_DRAIN) { E.fused(acc, cur, wr, wc, fr, fq, lds, wid, lane); S.done(cur); }
#undef PG8_SA
#undef PG8_SB
#undef PG8_STAGE
#undef PG8_STAGE_A
#undef PG8_LD32
#undef PG8_LDA
#undef PG8_LDB
#undef PG8_MMA
#undef PG8_WAIT_V
#undef PG8_WAIT_L
#undef PG8_BAR
#undef PG8_SCHED
}
}
namespace att {
using bf16 = __hip_bfloat16;
constexpr int   D = 128, NW = 8, QBLK = 32, KVBLK = 64;
constexpr float SCALE = 0.125f;
constexpr float THR = 8.f;
constexpr int SDEPTH = 2;
constexpr int LDQ = 8 * D, LDK = 4 * D, LDO = LDQ;
constexpr size_t SHM_V = KVBLK * D * 2, SHM_K = KVBLK * D * 2, SHM_ATTN = 2 * SHM_V + 2 * SHM_K + NW * 64 * 4;
using bf16x8 = __attribute__((ext_vector_type(8))) short;
using s16x4  = __attribute__((ext_vector_type(4))) short;
using f32x16 = __attribute__((ext_vector_type(16))) float;
using f32x8  = __attribute__((ext_vector_type(8))) float;
using u32x4  = __attribute__((ext_vector_type(4))) unsigned;
#define KSWZ(row, colB) ((row) * 256 + ((colB) ^ (((row) & 7) << 4)))
#define SBAR() __builtin_amdgcn_sched_barrier(0)
__device__ __forceinline__ int crow(int r, int hi) { return (r & 3) + 8 * (r >> 2) + 4 * hi; }
__device__ __forceinline__ unsigned cvtpk(float lo, float hi) {
  unsigned r; asm volatile("v_cvt_pk_bf16_f32 %0, %1, %2" : "=v"(r) : "v"(lo), "v"(hi)); return r;
}
template <typename TIn> struct Stage;
template <> struct Stage<bf16>  { using T = bf16x8;
  __device__ static __forceinline__ T ld8(const bf16* p) { return *reinterpret_cast<const bf16x8*>(p); }
  __device__ static __forceinline__ bf16x8 tobf(T x) { return x; } };
template <> struct Stage<float> { using T = f32x8;
  __device__ static __forceinline__ T ld8(const float* p) { return *reinterpret_cast<const f32x8*>(p); }
  __device__ static __forceinline__ bf16x8 tobf(T x) {
    u32x4 w = {cvtpk(x[0], x[1]), cvtpk(x[2], x[3]), cvtpk(x[4], x[5]), cvtpk(x[6], x[7])}; return *reinterpret_cast<bf16x8*>(&w); } };

__device__ __forceinline__ void partialSM(f32x16& p0, f32x16& p1, float& m_reg, float& mn, float& alpha) {
  constexpr float C = SCALE * 1.4426950408889634f;
  float pmax = p0[0]; for (int r = 1; r < 16; ++r) pmax = fmaxf(pmax, p0[r]); for (int r = 0; r < 16; ++r) pmax = fmaxf(pmax, p1[r]);
  { auto rr = __builtin_amdgcn_permlane32_swap(__float_as_uint(pmax), __float_as_uint(pmax), false, false);
    pmax = fmaxf(__uint_as_float(rr[0]), __uint_as_float(rr[1])); }
  if (__builtin_expect(__all(pmax - m_reg <= THR / SCALE), 1)) { mn = m_reg; alpha = 1.f; }
  else { mn = fmaxf(m_reg, pmax); alpha = __builtin_amdgcn_exp2f((m_reg - mn) * C); m_reg = mn; }
  float mnC = -mn * C;
  for (int r = 0; r < 16; ++r) p0[r] = fmaf(p0[r], C, mnC); for (int r = 0; r < 16; ++r) p1[r] = fmaf(p1[r], C, mnC);
  for (int r = 0; r < 16; ++r) p0[r] = __builtin_amdgcn_exp2f(p0[r]);
}
__device__ __forceinline__ void finishSM(f32x16& p0, f32x16& p1, float alpha, float& l_reg, bf16x8& pa0, bf16x8& pa1, bf16x8& pa2, bf16x8& pa3) {
  for (int r = 0; r < 16; ++r) p1[r] = __builtin_amdgcn_exp2f(p1[r]);
  float ps = 0; for (int r = 0; r < 16; ++r) ps += p0[r]; for (int r = 0; r < 16; ++r) ps += p1[r];
  { auto rr = __builtin_amdgcn_permlane32_swap(__float_as_uint(ps), __float_as_uint(ps), false, false);
    ps = __uint_as_float(rr[0]) + __uint_as_float(rr[1]); }
  l_reg = l_reg * alpha + ps;
#define PK4(P, BASE, OUT) do { unsigned a0 = cvtpk(P[BASE + 0], P[BASE + 1]), a1 = cvtpk(P[BASE + 2], P[BASE + 3]);   \
    unsigned b0 = cvtpk(P[BASE + 4], P[BASE + 5]), b1 = cvtpk(P[BASE + 6], P[BASE + 7]);                              \
    auto r0 = __builtin_amdgcn_permlane32_swap(a0, b0, false, false); auto r1 = __builtin_amdgcn_permlane32_swap(a1, b1, false, false); \
    u32x4 w = {r0[0], r1[0], r0[1], r1[1]}; OUT = *reinterpret_cast<bf16x8*>(&w); } while (0)
  PK4(p0, 0, pa0); PK4(p0, 8, pa1); PK4(p1, 0, pa2); PK4(p1, 8, pa3);
#undef PK4
}
__device__ __forceinline__ void qkt(f32x16& p0, f32x16& p1, const bf16* Ks, const bf16x8* qr, int r32, int hi) {
  p0 = f32x16{}; p1 = f32x16{};
  for (int d0 = 0; d0 < 8; ++d0) { int cb = (d0 * 16 + hi * 8) * 2;
    bf16x8 b0 = *reinterpret_cast<const bf16x8*>((const char*)Ks + KSWZ(r32, cb));
    bf16x8 b1 = *reinterpret_cast<const bf16x8*>((const char*)Ks + KSWZ(32 + r32, cb));
    p0 = __builtin_amdgcn_mfma_f32_32x32x16_bf16(b0, qr[d0], p0, 0, 0, 0);
    p1 = __builtin_amdgcn_mfma_f32_32x32x16_bf16(b1, qr[d0], p1, 0, 0, 0); }
}
__device__ __forceinline__ int v_st(int k, int c) { const int kk = (k & ~0xC) | ((k & 4) << 1) | ((k & 8) >> 1); return ((kk >> 3) * 4 + (c >> 5)) * 512 + ((kk & 7) * 32 + (c & 31)) * 2; }
__device__ __forceinline__ int v_rd_base(int lane) { return ((lane & 3) << 3) | (((lane >> 2) & 3) << 6) | (((lane >> 4) & 1) << 5) | (((lane >> 5) & 1) << 8); }
constexpr int v_rd_off(int d0, int ks, int half) { return d0 * 512 + ks * 4096 + half * 2048; }
template <int OFF> __device__ __forceinline__ s16x4 tr_read(int vb) {
  s16x4 r; asm volatile("ds_read_b64_tr_b16 %0, %1 offset:%2" : "=&v"(r) : "v"(vb), "i"(OFF) : "memory"); return r;
}
template <int D0> __device__ __forceinline__ void pv_one(f32x16& od, int vb, bf16x8 pa0, bf16x8 pa1, bf16x8 pa2, bf16x8 pa3) {
  const s16x4 l0 = tr_read<v_rd_off(D0, 0, 0)>(vb), h0 = tr_read<v_rd_off(D0, 0, 1)>(vb), l1 = tr_read<v_rd_off(D0, 1, 0)>(vb), h1 = tr_read<v_rd_off(D0, 1, 1)>(vb);
  const s16x4 l2 = tr_read<v_rd_off(D0, 2, 0)>(vb), h2 = tr_read<v_rd_off(D0, 2, 1)>(vb), l3 = tr_read<v_rd_off(D0, 3, 0)>(vb), h3 = tr_read<v_rd_off(D0, 3, 1)>(vb);
  asm volatile("s_waitcnt lgkmcnt(0)" ::: "memory"); SBAR();
#define PK(L, H) (bf16x8){L[0], L[1], L[2], L[3], H[0], H[1], H[2], H[3]}
  od = __builtin_amdgcn_mfma_f32_32x32x16_bf16(pa0, PK(l0, h0), od, 0, 0, 0);
  od = __builtin_amdgcn_mfma_f32_32x32x16_bf16(pa1, PK(l1, h1), od, 0, 0, 0);
  od = __builtin_amdgcn_mfma_f32_32x32x16_bf16(pa2, PK(l2, h2), od, 0, 0, 0);
  od = __builtin_amdgcn_mfma_f32_32x32x16_bf16(pa3, PK(l3, h3), od, 0, 0, 0);
#undef PK
}
__device__ __forceinline__ void pv_d0(f32x16* o, int vb, bf16x8 pa0, bf16x8 pa1, bf16x8 pa2, bf16x8 pa3) {
  pv_one<0>(o[0], vb, pa0, pa1, pa2, pa3); pv_one<1>(o[1], vb, pa0, pa1, pa2, pa3); pv_one<2>(o[2], vb, pa0, pa1, pa2, pa3); pv_one<3>(o[3], vb, pa0, pa1, pa2, pa3);
}

template <typename TQ>
__device__ __forceinline__ void attn_dense_body(const TQ* __restrict__ Qb, const bf16* __restrict__ Kh, const bf16* __restrict__ Vh,
                                                float* __restrict__ Ob, int seq, char* lds) {
  using St = Stage<bf16>; using SQ = Stage<TQ>;
  const int tid = threadIdx.x, wid = tid >> 6, lane = tid & 63, r32 = lane & 31, hi = lane >> 5;
  bf16* V_lds = (bf16*)lds; bf16* K_lds = (bf16*)(lds + 2 * SHM_V);
  float* ws = (float*)(lds + 2 * SHM_V + 2 * SHM_K) + wid * 64; float* li_l = ws; float* al_l = ws + 32;
  float m_reg = -1e30f, l_reg = 0; f32x16 o[4] = {}; bf16x8 qr[8];
  const TQ* Qw = Qb + (long)(wid * QBLK + r32) * LDQ + hi * 8;
#pragma unroll
  for (int d0 = 0; d0 < 8; ++d0) qr[d0] = SQ::tobf(SQ::ld8(Qw + d0 * 16));
  const int sr = tid >> 4, sc = (tid & 15) * 8, vst0 = v_st(sr, sc), vst1 = v_st(32 + sr, sc);
  const int vb0 = (int)(uintptr_t)V_lds + v_rd_base(lane);
  struct { typename St::T vs0, vs1, ks0, ks1; } sr_[SDEPTH];
#define SLOAD(i, k0) do { sr_[i].vs0 = St::ld8(&Vh[(long)((k0) + sr) * LDK + sc]); sr_[i].vs1 = St::ld8(&Vh[(long)((k0) + 32 + sr) * LDK + sc]); \
    sr_[i].ks0 = St::ld8(&Kh[(long)((k0) + sr) * LDK + sc]); sr_[i].ks1 = St::ld8(&Kh[(long)((k0) + 32 + sr) * LDK + sc]); } while (0)
#define SWRITE(b, i) do { *(bf16x8*)((char*)V_lds + (b) * SHM_V + vst0) = St::tobf(sr_[i].vs0);          \
    *(bf16x8*)((char*)V_lds + (b) * SHM_V + vst1) = St::tobf(sr_[i].vs1); int kc = sc * 2;               \
    *(bf16x8*)((char*)K_lds + (b) * SHM_K + KSWZ(sr, kc)) = St::tobf(sr_[i].ks0);                       \
    *(bf16x8*)((char*)K_lds + (b) * SHM_K + KSWZ(32 + sr, kc)) = St::tobf(sr_[i].ks1); } while (0)
#define SWAIT() do { if constexpr (SDEPTH == 2) asm volatile("s_waitcnt vmcnt(4)" ::: "memory"); else asm volatile("s_waitcnt vmcnt(0)" ::: "memory"); } while (0)
#define RESC(a) do { if (__any((a) < 1.f)) { if (hi == 0) al_l[r32] = (a); asm volatile("s_waitcnt lgkmcnt(0)" ::: "memory"); \
    for (int d = 0; d < 4; ++d) for (int r = 0; r < 16; ++r) o[d][r] *= al_l[crow(r, hi)]; } } while (0)
  f32x16 pA0, pA1, pB0, pB1; float mnA, mnB, alA, alB; bf16x8 pa0, pa1, pa2, pa3; const int NT = seq / KVBLK;
  constexpr int SE = 0, SO = SDEPTH - 1;
  SLOAD(SE, 0); asm volatile("s_waitcnt vmcnt(0)" ::: "memory"); SWRITE(0, SE); __syncthreads();
  qkt(pA0, pA1, K_lds, qr, r32, hi); partialSM(pA0, pA1, m_reg, mnA, alA);
  SLOAD(SO, KVBLK); if constexpr (SDEPTH == 2) { if (2 < NT) SLOAD(SE, 2 * KVBLK); }
  SWAIT(); SWRITE(1, SO); __syncthreads();
  for (int j = 1; j + 1 < NT; j += 2) {
    SBAR(); qkt(pB0, pB1, (bf16*)((char*)K_lds + SHM_K), qr, r32, hi);
    finishSM(pA0, pA1, alA, l_reg, pa0, pa1, pa2, pa3); SBAR();
    SLOAD(SO, (j + SDEPTH) * KVBLK); SBAR();
    pv_d0(o, vb0, pa0, pa1, pa2, pa3); partialSM(pB0, pB1, m_reg, mnB, alB);
    __syncthreads(); SWAIT(); SWRITE(0, SE);
    RESC(alB); __syncthreads();
    SBAR(); qkt(pA0, pA1, K_lds, qr, r32, hi);
    finishSM(pB0, pB1, alB, l_reg, pa0, pa1, pa2, pa3); SBAR();
    if (SDEPTH == 1 || j + 3 < NT) SLOAD(SE, (j + 1 + SDEPTH) * KVBLK); SBAR();
    pv_d0(o, vb0 + (int)SHM_V, pa0, pa1, pa2, pa3); partialSM(pA0, pA1, m_reg, mnA, alA);
    __syncthreads(); SWAIT(); SWRITE(1, SO);
    RESC(alA); __syncthreads();
  }
  SBAR(); qkt(pB0, pB1, (bf16*)((char*)K_lds + SHM_K), qr, r32, hi);
  finishSM(pA0, pA1, alA, l_reg, pa0, pa1, pa2, pa3); SBAR();
  pv_d0(o, vb0, pa0, pa1, pa2, pa3); partialSM(pB0, pB1, m_reg, mnB, alB);
  __syncthreads(); RESC(alB);
  finishSM(pB0, pB1, alB, l_reg, pa0, pa1, pa2, pa3); SBAR();
  pv_d0(o, vb0 + (int)SHM_V, pa0, pa1, pa2, pa3);
  if (hi == 0) li_l[r32] = l_reg; asm volatile("s_waitcnt lgkmcnt(0)" ::: "memory");
  float rli[16];
#pragma unroll
  for (int r = 0; r < 16; ++r) rli[r] = __builtin_amdgcn_rcpf(li_l[crow(r, hi)]);
  float* Ow = Ob + (long)(wid * QBLK) * LDO;
#pragma unroll
  for (int r = 0; r < 16; ++r) { int orow = crow(r, hi);
    for (int d0 = 0; d0 < 4; ++d0) Ow[(long)orow * LDO + d0 * 32 + r32] = o[d0][r] * rli[r]; }
#undef SLOAD
#undef SWRITE
#undef SWAIT
#undef RESC
}
__device__ __forceinline__ void qkt2(f32x16& p0, f32x16& p1, const bf16* Ks, const bf16x8* qr, int r32, int hi, int mp) {
  p0 = f32x16{}; p1 = f32x16{};
  __builtin_amdgcn_s_setprio(1);
#pragma unroll
  for (int d0 = 0; d0 < 4; ++d0) { int cb = (mp * 64 + d0 * 16 + hi * 8) * 2;
    bf16x8 b0 = *reinterpret_cast<const bf16x8*>((const char*)Ks + KSWZ(r32, cb));
    bf16x8 b1 = *reinterpret_cast<const bf16x8*>((const char*)Ks + KSWZ(32 + r32, cb));
    p0 = __builtin_amdgcn_mfma_f32_32x32x16_bf16(b0, qr[d0], p0, 0, 0, 0);
    p1 = __builtin_amdgcn_mfma_f32_32x32x16_bf16(b1, qr[d0], p1, 0, 0, 0); }
  __builtin_amdgcn_s_setprio(0);
}
constexpr int LDQ2 = 512, LDOB = 1024;
__device__ __forceinline__ void attn_diff_body(const bf16* __restrict__ Qb, const bf16* __restrict__ Kh, const bf16* __restrict__ Vh,
                                               unsigned short* __restrict__ Ob, int seq, char* lds, float lam, const float* __restrict__ subg, float osc) {
  using St = Stage<bf16>; using SQ = Stage<bf16>;
  const int tid = threadIdx.x, wid = tid >> 6, lane = tid & 63, r32 = lane & 31, hi = lane >> 5, mp = wid >> 2, wq = wid & 3;
  bf16* V_lds = (bf16*)lds; bf16* K_lds = (bf16*)(lds + 2 * SHM_V);
  float* ws = (float*)(lds + 2 * SHM_V + 2 * SHM_K) + wid * 64; float* li_l = ws; float* al_l = ws + 32;
  float m_reg = -1e30f, l_reg = 0; f32x16 o[4] = {}; bf16x8 qr[4];
  const bf16* Qw = Qb + (long)(wq * QBLK + r32) * LDQ2 + mp * 64 + hi * 8;
#pragma unroll
  for (int d0 = 0; d0 < 4; ++d0) qr[d0] = SQ::tobf(SQ::ld8(Qw + d0 * 16));
  const int sr = tid >> 4, sc = (tid & 15) * 8, vst0 = v_st(sr, sc), vst1 = v_st(32 + sr, sc);
  const int vb0 = (int)(uintptr_t)V_lds + v_rd_base(lane);
  struct { typename St::T vs0, vs1, ks0, ks1; } sr_[SDEPTH];
#define SLOAD(i, k0) do { sr_[i].vs0 = St::ld8(&Vh[(long)((k0) + sr) * LDK + sc]); sr_[i].vs1 = St::ld8(&Vh[(long)((k0) + 32 + sr) * LDK + sc]); \
    sr_[i].ks0 = St::ld8(&Kh[(long)((k0) + sr) * LDK + sc]); sr_[i].ks1 = St::ld8(&Kh[(long)((k0) + 32 + sr) * LDK + sc]); } while (0)
#define SWRITE(b, i) do { *(bf16x8*)((char*)V_lds + (b) * SHM_V + vst0) = St::tobf(sr_[i].vs0);          \
    *(bf16x8*)((char*)V_lds + (b) * SHM_V + vst1) = St::tobf(sr_[i].vs1); int kc = sc * 2;               \
    *(bf16x8*)((char*)K_lds + (b) * SHM_K + KSWZ(sr, kc)) = St::tobf(sr_[i].ks0);                       \
    *(bf16x8*)((char*)K_lds + (b) * SHM_K + KSWZ(32 + sr, kc)) = St::tobf(sr_[i].ks1); } while (0)
#define SWAIT() do { if constexpr (SDEPTH == 2) asm volatile("s_waitcnt vmcnt(4)" ::: "memory"); else asm volatile("s_waitcnt vmcnt(0)" ::: "memory"); } while (0)
#define RESC(a) do { if (__any((a) < 1.f)) { if (hi == 0) al_l[r32] = (a); asm volatile("s_waitcnt lgkmcnt(0)" ::: "memory"); \
    for (int d = 0; d < 4; ++d) for (int r = 0; r < 16; ++r) o[d][r] *= al_l[crow(r, hi)]; } } while (0)
  f32x16 pA0, pA1, pB0, pB1; float mnA, mnB, alA, alB; bf16x8 pa0, pa1, pa2, pa3; const int NT = seq / KVBLK;
  constexpr int SE = 0, SO = SDEPTH - 1;
  SLOAD(SE, 0); asm volatile("s_waitcnt vmcnt(0)" ::: "memory"); SWRITE(0, SE); __syncthreads();
  qkt2(pA0, pA1, K_lds, qr, r32, hi, mp); partialSM(pA0, pA1, m_reg, mnA, alA);
  SLOAD(SO, KVBLK); if constexpr (SDEPTH == 2) { if (2 < NT) SLOAD(SE, 2 * KVBLK); }
  SWAIT(); SWRITE(1, SO); __syncthreads();
  for (int j = 1; j + 1 < NT; j += 2) {
    SBAR(); qkt2(pB0, pB1, (bf16*)((char*)K_lds + SHM_K), qr, r32, hi, mp);
    finishSM(pA0, pA1, alA, l_reg, pa0, pa1, pa2, pa3); SBAR();
    SLOAD(SO, (j + SDEPTH) * KVBLK); SBAR();
    pv_d0(o, vb0, pa0, pa1, pa2, pa3); partialSM(pB0, pB1, m_reg, mnB, alB);
    __syncthreads(); SWAIT(); SWRITE(0, SE);
    RESC(alB); __syncthreads();
    SBAR(); qkt2(pA0, pA1, K_lds, qr, r32, hi, mp);
    finishSM(pB0, pB1, alB, l_reg, pa0, pa1, pa2, pa3); SBAR();
    if (SDEPTH == 1 || j + 3 < NT) SLOAD(SE, (j + 1 + SDEPTH) * KVBLK); SBAR();
    pv_d0(o, vb0 + (int)SHM_V, pa0, pa1, pa2, pa3); partialSM(pA0, pA1, m_reg, mnA, alA);
    __syncthreads(); SWAIT(); SWRITE(1, SO);
    RESC(alA); __syncthreads();
  }
  SBAR(); qkt2(pB0, pB1, (bf16*)((char*)K_lds + SHM_K), qr, r32, hi, mp);
  finishSM(pA0, pA1, alA, l_reg, pa0, pa1, pa2, pa3); SBAR();
  pv_d0(o, vb0, pa0, pa1, pa2, pa3); partialSM(pB0, pB1, m_reg, mnB, alB);
  __syncthreads(); RESC(alB);
  finishSM(pB0, pB1, alB, l_reg, pa0, pa1, pa2, pa3); SBAR();
  pv_d0(o, vb0 + (int)SHM_V, pa0, pa1, pa2, pa3);
  if (hi == 0) li_l[r32] = l_reg; asm volatile("s_waitcnt lgkmcnt(0)" ::: "memory");
  float rli[16];
#pragma unroll
  for (int r = 0; r < 16; ++r) rli[r] = __builtin_amdgcn_rcpf(li_l[crow(r, hi)]);
#pragma unroll
  for (int d0 = 0; d0 < 4; ++d0)
#pragma unroll
    for (int r = 0; r < 16; ++r) o[d0][r] *= rli[r];
  __syncthreads();
  float* xch = (float*)lds + wq * 4096 + lane;
  if (mp == 1) {
#pragma unroll
    for (int d0 = 0; d0 < 4; ++d0)
#pragma unroll
      for (int r = 0; r < 16; ++r) xch[(d0 * 16 + r) * 64] = o[d0][r]; }
  __syncthreads();
  if (mp == 0) {
    int lane_e = lane; asm volatile("" : "+v"(lane_e));
    const int r32e = lane_e & 31, hie = lane_e >> 5;
    float ssq[16];
#pragma unroll
    for (int r = 0; r < 16; ++r) ssq[r] = 0.f;
#pragma unroll
    for (int d0 = 0; d0 < 4; ++d0)
#pragma unroll
      for (int r = 0; r < 16; ++r) { const float v = o[d0][r] - lam * xch[(d0 * 16 + r) * 64]; o[d0][r] = v; ssq[r] += v * v; }
#pragma unroll
    for (int r = 0; r < 16; ++r) { float s = ssq[r]; s += __shfl_xor(s, 1); s += __shfl_xor(s, 2); s += __shfl_xor(s, 4); s += __shfl_xor(s, 8); s += __shfl_xor(s, 16); ssq[r] = rsqrtf(s * (1.0f / 128.0f) + 1e-6f) * osc; }
    unsigned short* Ow = Ob + (long)(wq * QBLK) * LDOB;
#pragma unroll
    for (int d0 = 0; d0 < 4; ++d0) { const float gsc = subg[d0 * 32 + r32e];
#pragma unroll
      for (int r = 0; r < 16; ++r) { const float v = o[d0][r] * ssq[r] * gsc; const unsigned u = __float_as_uint(v); Ow[(long)crow(r, hie) * LDOB + d0 * 32 + r32e] = (unsigned short)((u + 0x7fffu + ((u >> 16) & 1u)) >> 16); } } }
  __syncthreads();
#undef SLOAD
#undef SWRITE
#undef SWAIT
#undef RESC
}
__device__ __forceinline__ void qkt3(f32x16& p0, f32x16& p1, const bf16* Ks, const bf16x8* qr, const f32x16& negm, int r32, int hi, int mp) {
#pragma unroll
  for (int d0 = 0; d0 < 4; ++d0) { int cb = (mp * 64 + d0 * 16 + hi * 8) * 2;
    bf16x8 b0 = *reinterpret_cast<const bf16x8*>((const char*)Ks + KSWZ(r32, cb));
    bf16x8 b1 = *reinterpret_cast<const bf16x8*>((const char*)Ks + KSWZ(32 + r32, cb));
    if (d0 == 0) { p0 = __builtin_amdgcn_mfma_f32_32x32x16_bf16(b0, qr[0], negm, 0, 0, 0); p1 = __builtin_amdgcn_mfma_f32_32x32x16_bf16(b1, qr[0], negm, 0, 0, 0); }
    else { p0 = __builtin_amdgcn_mfma_f32_32x32x16_bf16(b0, qr[d0], p0, 0, 0, 0); p1 = __builtin_amdgcn_mfma_f32_32x32x16_bf16(b1, qr[d0], p1, 0, 0, 0); } }
}
constexpr float THR2 = THR * 1.4426950408889634f;
__device__ __forceinline__ void partialSM2(f32x16& p0, f32x16& p1, float& m_reg, f32x16& negm, float& alpha, bool nomax) {
  if (nomax) { alpha = 1.f; for (int r = 0; r < 16; ++r) p0[r] = __builtin_amdgcn_exp2f(p0[r]); return; }
  float pmax = p0[0]; for (int r = 1; r < 16; ++r) pmax = fmaxf(pmax, p0[r]); for (int r = 0; r < 16; ++r) pmax = fmaxf(pmax, p1[r]);
  { auto rr = __builtin_amdgcn_permlane32_swap(__float_as_uint(pmax), __float_as_uint(pmax), false, false);
    pmax = fmaxf(__uint_as_float(rr[0]), __uint_as_float(rr[1])); }
  if (__builtin_expect(__all(pmax <= THR2), 1)) { alpha = 1.f; }
  else { const float dl = fmaxf(pmax, 0.f); m_reg += dl; alpha = __builtin_amdgcn_exp2f(-dl);
    for (int r = 0; r < 16; ++r) { p0[r] -= dl; p1[r] -= dl; }
    for (int r = 0; r < 16; ++r) negm[r] = -m_reg; }
  for (int r = 0; r < 16; ++r) p0[r] = __builtin_amdgcn_exp2f(p0[r]);
}
__device__ __forceinline__ void finishSM2(f32x16& p0, f32x16& p1, float alpha, float& l_reg, bf16x8& pa0, bf16x8& pa1, bf16x8& pa2, bf16x8& pa3) {
  for (int r = 0; r < 16; ++r) p1[r] = __builtin_amdgcn_exp2f(p1[r]);
  float ps = 0; for (int r = 0; r < 16; ++r) ps += p0[r]; for (int r = 0; r < 16; ++r) ps += p1[r];
  { auto rr = __builtin_amdgcn_permlane32_swap(__float_as_uint(ps), __float_as_uint(ps), false, false);
    ps = __uint_as_float(rr[0]) + __uint_as_float(rr[1]); }
  l_reg = l_reg * alpha + ps;
#define PK8(P, BASE, OUT) do { u32x4 w = {cvtpk(P[BASE + 0], P[BASE + 1]), cvtpk(P[BASE + 2], P[BASE + 3]), cvtpk(P[BASE + 4], P[BASE + 5]), cvtpk(P[BASE + 6], P[BASE + 7])}; OUT = *reinterpret_cast<bf16x8*>(&w); } while (0)
  PK8(p0, 0, pa0); PK8(p0, 8, pa1); PK8(p1, 0, pa2); PK8(p1, 8, pa3);
#undef PK8
}
typedef short v4i16b_t __attribute__((ext_vector_type(4)));
__device__ __forceinline__ v4i16b_t vtrb(int vb, int off) { return __builtin_amdgcn_ds_read_tr16_b64_v4i16((__attribute__((address_space(3))) v4i16b_t*)(unsigned)(vb + off)); }
#define PVB_F(L, H) __builtin_bit_cast(bf16x8, __builtin_shufflevector(L, H, 0, 1, 2, 3, 4, 5, 6, 7))
template <int D0> __device__ __forceinline__ void pv_oneb(f32x16& od, int vb, bf16x8 pa0, bf16x8 pa1, bf16x8 pa2, bf16x8 pa3) {
  const v4i16b_t l0 = vtrb(vb, v_rd_off(D0, 0, 0)), h0 = vtrb(vb, v_rd_off(D0, 0, 1)), l1 = vtrb(vb, v_rd_off(D0, 1, 0)), h1 = vtrb(vb, v_rd_off(D0, 1, 1));
  const v4i16b_t l2 = vtrb(vb, v_rd_off(D0, 2, 0)), h2 = vtrb(vb, v_rd_off(D0, 2, 1)), l3 = vtrb(vb, v_rd_off(D0, 3, 0)), h3 = vtrb(vb, v_rd_off(D0, 3, 1));
  __builtin_amdgcn_s_setprio(1);
  od = __builtin_amdgcn_mfma_f32_32x32x16_bf16(pa0, PVB_F(l0, h0), od, 0, 0, 0);
  od = __builtin_amdgcn_mfma_f32_32x32x16_bf16(pa1, PVB_F(l1, h1), od, 0, 0, 0);
  od = __builtin_amdgcn_mfma_f32_32x32x16_bf16(pa2, PVB_F(l2, h2), od, 0, 0, 0);
  od = __builtin_amdgcn_mfma_f32_32x32x16_bf16(pa3, PVB_F(l3, h3), od, 0, 0, 0);
  __builtin_amdgcn_s_setprio(0);
}
__device__ __forceinline__ void pv_d0b(f32x16* o, int vb, bf16x8 pa0, bf16x8 pa1, bf16x8 pa2, bf16x8 pa3) {
  pv_oneb<0>(o[0], vb, pa0, pa1, pa2, pa3); SBAR(); pv_oneb<1>(o[1], vb, pa0, pa1, pa2, pa3); SBAR(); pv_oneb<2>(o[2], vb, pa0, pa1, pa2, pa3); SBAR(); pv_oneb<3>(o[3], vb, pa0, pa1, pa2, pa3);
}
#define PVP_RD(A, D0) do { A[0] = tr_read<v_rd_off(D0, 0, 0)>(vb); A[1] = tr_read<v_rd_off(D0, 0, 1)>(vb); A[2] = tr_read<v_rd_off(D0, 1, 0)>(vb); A[3] = tr_read<v_rd_off(D0, 1, 1)>(vb); \
    A[4] = tr_read<v_rd_off(D0, 2, 0)>(vb); A[5] = tr_read<v_rd_off(D0, 2, 1)>(vb); A[6] = tr_read<v_rd_off(D0, 3, 0)>(vb); A[7] = tr_read<v_rd_off(D0, 3, 1)>(vb); } while (0)
#define PVP_PK(L, H) (bf16x8){L[0], L[1], L[2], L[3], H[0], H[1], H[2], H[3]}
#define PVP_MM(OD, A) do { OD = __builtin_amdgcn_mfma_f32_32x32x16_bf16(pa0, PVP_PK(A[0], A[1]), OD, 0, 0, 0); OD = __builtin_amdgcn_mfma_f32_32x32x16_bf16(pa1, PVP_PK(A[2], A[3]), OD, 0, 0, 0); \
    OD = __builtin_amdgcn_mfma_f32_32x32x16_bf16(pa2, PVP_PK(A[4], A[5]), OD, 0, 0, 0); OD = __builtin_amdgcn_mfma_f32_32x32x16_bf16(pa3, PVP_PK(A[6], A[7]), OD, 0, 0, 0); } while (0)
__device__ __forceinline__ void pv_pipe(f32x16* o, int vb, bf16x8 pa0, bf16x8 pa1, bf16x8 pa2, bf16x8 pa3) {
  s16x4 A0[8], A1[8];
  PVP_RD(A0, 0); PVP_RD(A1, 1);
  asm volatile("s_waitcnt lgkmcnt(8)" ::: "memory"); SBAR(); PVP_MM(o[0], A0); SBAR();
  PVP_RD(A0, 2);
  asm volatile("s_waitcnt lgkmcnt(8)" ::: "memory"); SBAR(); PVP_MM(o[1], A1); SBAR();
  PVP_RD(A1, 3);
  asm volatile("s_waitcnt lgkmcnt(8)" ::: "memory"); SBAR(); PVP_MM(o[2], A0); SBAR();
  asm volatile("s_waitcnt lgkmcnt(0)" ::: "memory"); SBAR(); PVP_MM(o[3], A1);
}
#undef PVP_RD
#undef PVP_PK
#undef PVP_MM
__device__ __forceinline__ void attn_diff_body3(const bf16* __restrict__ Qb, const bf16* __restrict__ Kh, const bf16* __restrict__ Vh,
                                               unsigned short* __restrict__ Ob, int seq, char* lds, __attribute__((address_space(3))) unsigned char* ldsl, float lam, const float* __restrict__ subg, float osc, bool nomax) {
  using St = Stage<bf16>; using SQ = Stage<bf16>;
  const int tid = threadIdx.x, wid = tid >> 6, lane = tid & 63, r32 = lane & 31, hi = lane >> 5, mp = wid >> 2, wq = wid & 3;
  constexpr int VR = 0, KR = 3 * 16384, WSO = 6 * 16384;
  bf16* V_lds = (bf16*)(lds + VR); bf16* K_lds = (bf16*)(lds + KR);
  float* ws = (float*)(lds + WSO) + wid * 64; float* li_l = ws; float* al_l = ws + 32;
  float m_reg = 0.f, l_reg = 0; f32x16 o[4] = {}; bf16x8 qr[4]; f32x16 negm = {}; asm volatile("" : "+v"(negm));
  const bf16* Qw = Qb + (long)(wq * QBLK + r32) * LDQ2 + mp * 64 + hi * 8;
#pragma unroll
  for (int d0 = 0; d0 < 4; ++d0) qr[d0] = SQ::tobf(SQ::ld8(Qw + d0 * 16));
  const int vb0 = (int)(uintptr_t)V_lds + v_rd_base(lane);
  int kso[2], vso[2];
#pragma unroll
  for (int i = 0; i < 2; ++i) { const int ob = (i * 8 + wid) * 1024 + 16 * lane; const int row = ob >> 8, cb = (ob & 255) ^ ((row & 7) << 4); kso[i] = row * LDK + (cb >> 1);
    const int st = ob >> 9, e = (ob & 511) >> 1, kk = (st >> 2) * 8 + (e >> 5); vso[i] = kk * LDK + (st & 3) * 32 + (e & 31); }
  const int wu = __builtin_amdgcn_readfirstlane(wid);
  typedef __attribute__((address_space(3))) unsigned las_u32;
  const int NT = seq / KVBLK;
#define DMA_K(t, slot) do { const int tt_ = (t) < NT ? (t) : NT - 1; const bf16* g_ = Kh + (long)tt_ * KVBLK * LDK; _Pragma("unroll") for (int i_ = 0; i_ < 2; ++i_) \
    __builtin_amdgcn_global_load_lds((const unsigned*)(g_ + kso[i_]), (las_u32*)(ldsl + KR + (slot) * 16384 + (i_ * 8 + wu) * 1024), 16, 0, 0); } while (0)
#define DMA_V(t, slot) do { const int tt_ = (t) < NT ? (t) : NT - 1; const bf16* g_ = Vh + (long)tt_ * KVBLK * LDK; _Pragma("unroll") for (int i_ = 0; i_ < 2; ++i_) \
    __builtin_amdgcn_global_load_lds((const unsigned*)(g_ + vso[i_]), (las_u32*)(ldsl + VR + (slot) * 16384 + (i_ * 8 + wu) * 1024), 16, 0, 0); } while (0)
#define CLOSE() do { asm volatile("s_waitcnt vmcnt(4) lgkmcnt(0)" ::: "memory"); __builtin_amdgcn_s_barrier(); asm volatile("" ::: "memory"); } while (0)
#define RESC(a) do { if (__any((a) < 1.f)) { if (hi == 0) al_l[r32] = (a); asm volatile("s_waitcnt lgkmcnt(0)" ::: "memory"); \
    for (int d = 0; d < 4; ++d) for (int r = 0; r < 16; ++r) o[d][r] *= al_l[crow(r, hi)]; } } while (0)
  f32x16 pA0, pA1, pB0, pB1; float mnA, mnB, alA, alB; bf16x8 pa0, pa1, pa2, pa3;
  DMA_K(0, 0); DMA_K(1, 1); DMA_V(0, 0);
  asm volatile("s_waitcnt vmcnt(4)" ::: "memory"); __builtin_amdgcn_s_barrier(); asm volatile("" ::: "memory");
  DMA_K(2, 2); DMA_V(1, 1);
  qkt2(pA0, pA1, K_lds, qr, r32, hi, mp); partialSM2(pA0, pA1, m_reg, negm, alA, nomax);
  CLOSE();
  int kcur = 1, vcur = 0;
#define ROT3(x) ((x) == 2 ? 0 : (x) + 1)
#define PRV3(x) ((x) == 0 ? 2 : (x) - 1)
#define ITER(PC0, PC1, MNC, ALC, PP0, PP1, ALP, j_) do { \
    DMA_K((j_) + 2, PRV3(kcur)); DMA_V((j_) + 1, PRV3(vcur)); \
    SBAR(); if (__builtin_expect(__all(m_reg == 0.f), 1)) { qkt2(PC0, PC1, (bf16*)((char*)K_lds + kcur * 16384), qr, r32, hi, mp); } else { qkt3(PC0, PC1, (bf16*)((char*)K_lds + kcur * 16384), qr, negm, r32, hi, mp); } \
    finishSM2(PP0, PP1, ALP, l_reg, pa0, pa1, pa2, pa3); SBAR(); \
    pv_d0b(o, vb0 + vcur * 16384, pa0, pa1, pa2, pa3); partialSM2(PC0, PC1, m_reg, negm, ALC, nomax); \
    if (!nomax) { RESC(ALC); } CLOSE(); kcur = ROT3(kcur); vcur = ROT3(vcur); } while (0)
  for (int j = 1; j + 1 < NT; j += 2) {
    ITER(pB0, pB1, mnB, alB, pA0, pA1, alA, j);
    ITER(pA0, pA1, mnA, alA, pB0, pB1, alB, j + 1);
  }
  ITER(pB0, pB1, mnB, alB, pA0, pA1, alA, NT - 1);
  finishSM2(pB0, pB1, alB, l_reg, pa0, pa1, pa2, pa3); SBAR();
  pv_d0b(o, vb0 + vcur * 16384, pa0, pa1, pa2, pa3);
  asm volatile("s_waitcnt vmcnt(0)" ::: "memory");
#undef ITER
#undef ROT3
#undef PRV3
#undef DMA_K
#undef DMA_V
#undef CLOSE
  if (hi == 0) li_l[r32] = l_reg; asm volatile("s_waitcnt lgkmcnt(0)" ::: "memory");
  float rli[16];
#pragma unroll
  for (int r = 0; r < 16; ++r) rli[r] = __builtin_amdgcn_rcpf(li_l[crow(r, hi)]);
#pragma unroll
  for (int d0 = 0; d0 < 4; ++d0)
#pragma unroll
    for (int r = 0; r < 16; ++r) o[d0][r] *= rli[r];
  __syncthreads();
  float* xch = (float*)lds + wq * 4096 + lane;
  if (mp == 1) {
#pragma unroll
    for (int d0 = 0; d0 < 4; ++d0)
#pragma unroll
      for (int r = 0; r < 16; ++r) xch[(d0 * 16 + r) * 64] = o[d0][r]; }
  __syncthreads();
  if (mp == 0) {
    int lane_e = lane; asm volatile("" : "+v"(lane_e));
    const int r32e = lane_e & 31, hie = lane_e >> 5;
    float ssq[16];
#pragma unroll
    for (int r = 0; r < 16; ++r) ssq[r] = 0.f;
#pragma unroll
    for (int d0 = 0; d0 < 4; ++d0)
#pragma unroll
      for (int r = 0; r < 16; ++r) { const float v = o[d0][r] - lam * xch[(d0 * 16 + r) * 64]; o[d0][r] = v; ssq[r] += v * v; }
#pragma unroll
    for (int r = 0; r < 16; ++r) { float s = ssq[r]; s += __shfl_xor(s, 1); s += __shfl_xor(s, 2); s += __shfl_xor(s, 4); s += __shfl_xor(s, 8); s += __shfl_xor(s, 16); ssq[r] = rsqrtf(s * (1.0f / 128.0f) + 1e-6f) * osc; }
    unsigned short* Ow = Ob + (long)(wq * QBLK) * LDOB;
#pragma unroll
    for (int d0 = 0; d0 < 4; ++d0) { const float gsc = subg[d0 * 32 + r32e];
#pragma unroll
      for (int r = 0; r < 16; ++r) { const float v = o[d0][r] * ssq[r] * gsc; const unsigned u = __float_as_uint(v); Ow[(long)crow(r, hie) * LDOB + d0 * 32 + r32e] = (unsigned short)((u + 0x7fffu + ((u >> 16) & 1u)) >> 16); } } }
  __syncthreads();
#undef RESC
}
typedef int v8i_a8 __attribute__((ext_vector_type(8)));
typedef int v4i_a8 __attribute__((ext_vector_type(4)));
constexpr float THR8 = 8.5f;
__device__ __forceinline__ unsigned pk4f8(float a, float b, float c, float d) { int w = 0; w = __builtin_amdgcn_cvt_pk_fp8_f32(a, b, w, false); w = __builtin_amdgcn_cvt_pk_fp8_f32(c, d, w, true); return (unsigned)w; }
__device__ __forceinline__ void partialSM8(f32x16& p0, f32x16& p1, float& m_reg, float& alpha) {
  float pmax = p0[0]; for (int r = 1; r < 16; ++r) pmax = fmaxf(pmax, p0[r]); for (int r = 0; r < 16; ++r) pmax = fmaxf(pmax, p1[r]);
  { auto rr = __builtin_amdgcn_permlane32_swap(__float_as_uint(pmax), __float_as_uint(pmax), false, false);
    pmax = fmaxf(__uint_as_float(rr[0]), __uint_as_float(rr[1])); }
  if (__builtin_expect(__all(pmax <= THR8), 1)) { alpha = 1.f; }
  else { const float dl = fmaxf(pmax, 0.f); m_reg += dl; alpha = __builtin_amdgcn_exp2f(-dl);
    for (int r = 0; r < 16; ++r) { p0[r] -= dl; p1[r] -= dl; } }
  for (int r = 0; r < 16; ++r) p0[r] = __builtin_amdgcn_exp2f(p0[r]);
}
__device__ __forceinline__ void finishSM8(f32x16& p0, f32x16& p1, float alpha, float& l_reg, v8i_a8& pa) {
  for (int r = 0; r < 16; ++r) p1[r] = __builtin_amdgcn_exp2f(p1[r]);
  float ps = 0; for (int r = 0; r < 16; ++r) ps += p0[r]; for (int r = 0; r < 16; ++r) ps += p1[r];
  { auto rr = __builtin_amdgcn_permlane32_swap(__float_as_uint(ps), __float_as_uint(ps), false, false);
    ps = __uint_as_float(rr[0]) + __uint_as_float(rr[1]); }
  l_reg = l_reg * alpha + ps;
  pa[0] = (int)pk4f8(p0[0], p0[1], p0[2], p0[3]); pa[1] = (int)pk4f8(p0[4], p0[5], p0[6], p0[7]); pa[2] = (int)pk4f8(p0[8], p0[9], p0[10], p0[11]); pa[3] = (int)pk4f8(p0[12], p0[13], p0[14], p0[15]);
  pa[4] = (int)pk4f8(p1[0], p1[1], p1[2], p1[3]); pa[5] = (int)pk4f8(p1[4], p1[5], p1[6], p1[7]); pa[6] = (int)pk4f8(p1[8], p1[9], p1[10], p1[11]); pa[7] = (int)pk4f8(p1[12], p1[13], p1[14], p1[15]);
}
typedef __attribute__((address_space(3))) unsigned char las_u8;
__device__ __forceinline__ v8i_a8 kfrag8(const las_u8* kt, int row, int mp, int hi) {
  const int sw = (row >> 1) & 7, c0 = 4 * mp + 2 * hi;
  const v4i_a8 lo = *(const __attribute__((address_space(3))) v4i_a8*)(kt + row * 128 + ((c0 ^ sw) << 4)), hi4 = *(const __attribute__((address_space(3))) v4i_a8*)(kt + row * 128 + (((c0 + 1) ^ sw) << 4));
  return __builtin_shufflevector(lo, hi4, 0, 1, 2, 3, 4, 5, 6, 7);
}
#define QS8 0x7D7D7D7D
#define US8 0x7F7F7F7F
__device__ __forceinline__ void qkt8(f32x16& p0, f32x16& p1, const las_u8* kt, const v8i_a8& qf, const f32x16& c0, int r32, int hi, int mp) {
  const v8i_a8 k0 = kfrag8(kt, r32, mp, hi), k1 = kfrag8(kt, 32 + r32, mp, hi);
  p0 = __builtin_amdgcn_mfma_scale_f32_32x32x64_f8f6f4(k0, qf, c0, 0, 0, 0, US8, 0, QS8);
  p1 = __builtin_amdgcn_mfma_scale_f32_32x32x64_f8f6f4(k1, qf, c0, 0, 0, 0, US8, 0, QS8);
}
__device__ __forceinline__ void pv8(f32x16* o, const las_u8* vt, int lane, const v8i_a8& pa) {
#pragma unroll
  for (int d0 = 0; d0 < 4; ++d0) {
    const v4i_a8 lo = *(const __attribute__((address_space(3))) v4i_a8*)(vt + ((d0 * 2 + 0) * 64 + lane) * 16), hi4 = *(const __attribute__((address_space(3))) v4i_a8*)(vt + ((d0 * 2 + 1) * 64 + lane) * 16);
    const v8i_a8 vf = __builtin_shufflevector(lo, hi4, 0, 1, 2, 3, 4, 5, 6, 7);
    o[d0] = __builtin_amdgcn_mfma_scale_f32_32x32x64_f8f6f4(pa, vf, o[d0], 0, 0, 0, US8, 0, US8); }
}
__device__ __forceinline__ unsigned pk4b8(float a, float b, float c, float d) { int w = 0; w = __builtin_amdgcn_cvt_pk_bf8_f32(a, b, w, false); w = __builtin_amdgcn_cvt_pk_bf8_f32(c, d, w, true); return (unsigned)w; }
__device__ __forceinline__ void finishSM8b(f32x16& p0, f32x16& p1, v8i_a8& pa) {
  for (int r = 0; r < 16; ++r) p1[r] = __builtin_amdgcn_exp2f(p1[r]);
  pa[0] = (int)pk4b8(p0[0], p0[1], p0[2], p0[3]); pa[1] = (int)pk4b8(p0[4], p0[5], p0[6], p0[7]); pa[2] = (int)pk4b8(p0[8], p0[9], p0[10], p0[11]); pa[3] = (int)pk4b8(p0[12], p0[13], p0[14], p0[15]);
  pa[4] = (int)pk4b8(p1[0], p1[1], p1[2], p1[3]); pa[5] = (int)pk4b8(p1[4], p1[5], p1[6], p1[7]); pa[6] = (int)pk4b8(p1[8], p1[9], p1[10], p1[11]); pa[7] = (int)pk4b8(p1[12], p1[13], p1[14], p1[15]);
}
__device__ __forceinline__ void pv8b(f32x16* o, f32x16& osum, const v8i_a8& ones, const las_u8* vt, int lane, const v8i_a8& pa) {
  osum = __builtin_amdgcn_mfma_scale_f32_32x32x64_f8f6f4(pa, ones, osum, 1, 0, 0, US8, 0, US8);
#pragma unroll
  for (int d0 = 0; d0 < 4; ++d0) {
    const v4i_a8 lo = *(const __attribute__((address_space(3))) v4i_a8*)(vt + ((d0 * 2 + 0) * 64 + lane) * 16), hi4 = *(const __attribute__((address_space(3))) v4i_a8*)(vt + ((d0 * 2 + 1) * 64 + lane) * 16);
    const v8i_a8 vf = __builtin_shufflevector(lo, hi4, 0, 1, 2, 3, 4, 5, 6, 7);
    o[d0] = __builtin_amdgcn_mfma_scale_f32_32x32x64_f8f6f4(pa, vf, o[d0], 1, 0, 0, US8, 0, US8); }
}
template <bool NOMAX> __device__ __forceinline__ void attn_diff_body8(const unsigned char* __restrict__ Q8b, const unsigned char* __restrict__ K8h, const unsigned char* __restrict__ V8h,
                                               unsigned short* __restrict__ Ob, int seq, char* lds, las_u8* ldsl, float lam, const float* __restrict__ subg, float osc) {
  constexpr bool nomax = NOMAX;
  const int tid = threadIdx.x, wid = tid >> 6, lane = tid & 63, r32 = lane & 31, hi = lane >> 5, mp = wid >> 2, wq = wid & 3;
  constexpr int VR = 0, KR = 3 * 8192, WSO = 65536;
  typedef __attribute__((address_space(3))) float las_f32;
  las_f32* li_l = (las_f32*)(ldsl + WSO) + wid * 64; las_f32* al_l = li_l + 32;
  float m_reg = 0.f, l_reg = 0; f32x16 o[4] = {};
  v8i_a8 qf;
  { const unsigned char* qp = Q8b + (long)(wq * QBLK + r32) * 512 + mp * 64 + hi * 32; const v4i_a8 lo = *(const v4i_a8*)qp, h4 = *(const v4i_a8*)(qp + 16); qf = __builtin_shufflevector(lo, h4, 0, 1, 2, 3, 4, 5, 6, 7); }
  const int wu = __builtin_amdgcn_readfirstlane(wid);
  const int krow = 8 * wid + (lane >> 3), kso = krow * 512 + (((lane & 7) ^ ((krow >> 1) & 7)) << 4), vso = wid * 1024 + 16 * lane;
  typedef __attribute__((address_space(3))) unsigned las_u32;
  const int NT = seq / KVBLK;
#define DMA_K(t, slot) do { const int tt_ = (t) < NT ? (t) : NT - 1; __builtin_amdgcn_global_load_lds((const unsigned*)(K8h + (long)tt_ * KVBLK * 512 + kso), (las_u32*)(ldsl + KR + (slot) * 8192 + wu * 1024), 16, 0, 0); } while (0)
#define DMA_V(t, slot) do { const int tt_ = (t) < NT ? (t) : NT - 1; __builtin_amdgcn_global_load_lds((const unsigned*)(V8h + (long)tt_ * 8192 + vso), (las_u32*)(ldsl + VR + (slot) * 8192 + wu * 1024), 16, 0, 0); } while (0)
#define CLOSE() do { asm volatile("s_waitcnt vmcnt(2) lgkmcnt(0)" ::: "memory"); __builtin_amdgcn_s_barrier(); asm volatile("" ::: "memory"); } while (0)
#define RESC(a) do { if (__any((a) < 1.f)) { if (hi == 0) al_l[r32] = (a); asm volatile("s_waitcnt lgkmcnt(0)" ::: "memory"); \
    for (int d = 0; d < 4; ++d) for (int r = 0; r < 16; ++r) o[d][r] *= al_l[crow(r, hi)]; } } while (0)
  f32x16 pA0, pA1, pB0, pB1; float alA, alB; v8i_a8 pa;
  f32x16 osum = {}; v8i_a8 ones8;
  { const int ob = r32 == 0 ? 0x38383838 : 0; ones8 = (v8i_a8){ob, ob, ob, ob, ob, ob, ob, ob}; }
  int kcur = 1, vcur = 0;
  if constexpr (!nomax) {
  DMA_K(0, 0); DMA_K(1, 1); DMA_V(0, 0);
  asm volatile("s_waitcnt vmcnt(2)" ::: "memory"); __builtin_amdgcn_s_barrier(); asm volatile("" ::: "memory");
  DMA_K(2, 2); DMA_V(1, 1);
  { const f32x16 z0 = {}; qkt8(pA0, pA1, ldsl + KR, qf, z0, r32, hi, mp); }
  partialSM8(pA0, pA1, m_reg, alA);
  CLOSE();
  }
#define ROT3(x) ((x) == 2 ? 0 : (x) + 1)
#define PRV3(x) ((x) == 0 ? 2 : (x) - 1)
#define ITER(PC0, PC1, ALC, PP0, PP1, ALP, j_) do { \
    DMA_K((j_) + 2, PRV3(kcur)); DMA_V((j_) + 1, PRV3(vcur)); \
    SBAR(); if (__builtin_expect(__all(m_reg == 0.f), 1)) { const f32x16 z0_ = {}; qkt8(PC0, PC1, ldsl + KR + kcur * 8192, qf, z0_, r32, hi, mp); } \
    else { f32x16 nm_; _Pragma("unroll") for (int r_ = 0; r_ < 16; ++r_) nm_[r_] = -m_reg; qkt8(PC0, PC1, ldsl + KR + kcur * 8192, qf, nm_, r32, hi, mp); } \
    finishSM8(PP0, PP1, ALP, l_reg, pa); SBAR(); \
    pv8(o, ldsl + VR + vcur * 8192, lane, pa); partialSM8(PC0, PC1, m_reg, ALC); \
    RESC(ALC); CLOSE(); kcur = ROT3(kcur); vcur = ROT3(vcur); } while (0)
  if constexpr (nomax) {
    v8i_a8 kf0, kf1, vf0, vf1, vf2, vf3;
#define LDV8(d0_, vt_) ({ const v4i_a8 lo_ = *(const __attribute__((address_space(3))) v4i_a8*)((vt_) + (((d0_) * 2 + 0) * 64 + lane) * 16), hi_ = *(const __attribute__((address_space(3))) v4i_a8*)((vt_) + (((d0_) * 2 + 1) * 64 + lane) * 16); \
      (v8i_a8)__builtin_shufflevector(lo_, hi_, 0, 1, 2, 3, 4, 5, 6, 7); })
#define PVB() do { \
      osum = __builtin_amdgcn_mfma_scale_f32_32x32x64_f8f6f4(pa, ones8, osum, 1, 0, 0, US8, 0, US8); \
      o[0] = __builtin_amdgcn_mfma_scale_f32_32x32x64_f8f6f4(pa, vf0, o[0], 1, 0, 0, US8, 0, US8); o[1] = __builtin_amdgcn_mfma_scale_f32_32x32x64_f8f6f4(pa, vf1, o[1], 1, 0, 0, US8, 0, US8); \
      o[2] = __builtin_amdgcn_mfma_scale_f32_32x32x64_f8f6f4(pa, vf2, o[2], 1, 0, 0, US8, 0, US8); o[3] = __builtin_amdgcn_mfma_scale_f32_32x32x64_f8f6f4(pa, vf3, o[3], 1, 0, 0, US8, 0, US8); \
      asm volatile("" : "+v"(o[0]), "+v"(o[1]), "+v"(o[2]), "+v"(o[3]), "+v"(osum)); } while (0)
#define QKB(PC0, PC1) do { const f32x16 z0_ = {}; PC0 = __builtin_amdgcn_mfma_scale_f32_32x32x64_f8f6f4(kf0, qf, z0_, 0, 0, 0, US8, 0, QS8); PC1 = __builtin_amdgcn_mfma_scale_f32_32x32x64_f8f6f4(kf1, qf, z0_, 0, 0, 0, US8, 0, QS8); asm volatile("" : "+v"(PC0), "+v"(PC1)); } while (0)
#define LDK8(t_) do { const las_u8* kt_ = ldsl + KR + ((t_) & 3) * 8192; kf0 = kfrag8(kt_, r32, mp, hi); kf1 = kfrag8(kt_, 32 + r32, mp, hi); } while (0)
#define LDV01() do { const las_u8* vt_ = ldsl + VR + vcur * 8192; vf0 = LDV8(0, vt_); vf1 = LDV8(1, vt_); } while (0)
#define LDV23() do { const las_u8* vt_ = ldsl + VR + vcur * 8192; vf2 = LDV8(2, vt_); vf3 = LDV8(3, vt_); } while (0)
#define ITERC(PC0, PC1, PP0, PP1, j_) do { \
    DMA_K((j_) + 3, ((j_) + 3) & 3); DMA_V((j_) + 1, PRV3(vcur)); \
    SBAR(); QKB(PC0, PC1); SBAR(); \
    LDV01(); LDK8((j_) + 1); SBAR(); \
    finishSM8b(PP0, PP1, pa); SBAR(); LDV23(); SBAR(); \
    PVB(); \
    _Pragma("unroll") for (int r_ = 0; r_ < 16; ++r_) PC0[r_] = __builtin_amdgcn_exp2f(PC0[r_]); \
    CLOSE(); vcur = ROT3(vcur); } while (0)
    DMA_K(0, 0); DMA_V(0, 0); DMA_K(1, 1); DMA_K(2, 2);
    asm volatile("s_waitcnt vmcnt(1)" ::: "memory"); __builtin_amdgcn_s_barrier(); asm volatile("" ::: "memory");
    LDK8(0); QKB(pA0, pA1); SBAR(); LDK8(1); SBAR();
    DMA_K(3, 3); DMA_V(1, 1);
    for (int r = 0; r < 16; ++r) pA0[r] = __builtin_amdgcn_exp2f(pA0[r]);
    CLOSE();
    for (int j = 1; j + 1 < NT; j += 2) { ITERC(pB0, pB1, pA0, pA1, j); ITERC(pA0, pA1, pB0, pB1, j + 1); }
    ITERC(pB0, pB1, pA0, pA1, NT - 1);
    LDV01(); LDV23(); finishSM8b(pB0, pB1, pa); SBAR(); PVB();
#undef ITERC
#undef LDV01
#undef LDV23
#undef LDK8
#undef QKB
#undef PVB
#undef LDV8
  } else {
    for (int j = 1; j + 1 < NT; j += 2) { ITER(pB0, pB1, alB, pA0, pA1, alA, j); ITER(pA0, pA1, alA, pB0, pB1, alB, j + 1); }
    ITER(pB0, pB1, alB, pA0, pA1, alA, NT - 1);
    finishSM8(pB0, pB1, alB, l_reg, pa); SBAR(); pv8(o, ldsl + VR + vcur * 8192, lane, pa);
  }
  asm volatile("s_waitcnt vmcnt(0)" ::: "memory");
#undef ITER
#undef ROT3
#undef PRV3
#undef DMA_K
#undef DMA_V
#undef CLOSE
  if constexpr (nomax) { if (r32 == 0) {
#pragma unroll
      for (int r = 0; r < 16; ++r) li_l[crow(r, hi)] = osum[r]; } }
  else { if (hi == 0) li_l[r32] = l_reg; }
  asm volatile("s_waitcnt lgkmcnt(0)" ::: "memory");
  float rli[16];
#pragma unroll
  for (int r = 0; r < 16; ++r) rli[r] = __builtin_amdgcn_rcpf(li_l[crow(r, hi)]);
#pragma unroll
  for (int d0 = 0; d0 < 4; ++d0)
#pragma unroll
    for (int r = 0; r < 16; ++r) o[d0][r] *= rli[r];
  __syncthreads();
  las_f32* xch = (las_f32*)ldsl + wq * 4096 + lane;
  if (mp == 1) {
#pragma unroll
    for (int d0 = 0; d0 < 4; ++d0)
#pragma unroll
      for (int r = 0; r < 16; ++r) xch[(d0 * 16 + r) * 64] = o[d0][r]; }
  __syncthreads();
  if (mp == 0) {
    int lane_e = lane; asm volatile("" : "+v"(lane_e));
    const int r32e = lane_e & 31, hie = lane_e >> 5;
    float ssq[16];
#pragma unroll
    for (int r = 0; r < 16; ++r) ssq[r] = 0.f;
#pragma unroll
    for (int d0 = 0; d0 < 4; ++d0)
#pragma unroll
      for (int r = 0; r < 16; ++r) { const float v = o[d0][r] - lam * xch[(d0 * 16 + r) * 64]; o[d0][r] = v; ssq[r] += v * v; }
#pragma unroll
    for (int r = 0; r < 16; ++r) { float s = ssq[r]; s += __shfl_xor(s, 1); s += __shfl_xor(s, 2); s += __shfl_xor(s, 4); s += __shfl_xor(s, 8); s += __shfl_xor(s, 16); ssq[r] = rsqrtf(s * (1.0f / 128.0f) + 1e-6f) * osc; }
    unsigned short* Ow = Ob + (long)(wq * QBLK) * LDOB;
#pragma unroll
    for (int d0 = 0; d0 < 4; ++d0) { const float gsc = subg[d0 * 32 + r32e];
#pragma unroll
      for (int r = 0; r < 16; ++r) { const float v = o[d0][r] * ssq[r] * gsc; const unsigned u = __float_as_uint(v); Ow[(long)crow(r, hie) * LDOB + d0 * 32 + r32e] = (unsigned short)((u + 0x7fffu + ((u >> 16) & 1u)) >> 16); } } }
  __syncthreads();
#undef RESC
}
}
#define GAS __attribute__((address_space(1)))
#define LAS __attribute__((address_space(3)))
typedef unsigned short bf16;
typedef unsigned v4u __attribute__((ext_vector_type(4)));
typedef float f32x4 __attribute__((ext_vector_type(4)));
typedef short bf16x8 __attribute__((ext_vector_type(8)));
typedef GAS unsigned gu32;
typedef GAS unsigned long long gu64;
#define RLX_AGENT __ATOMIC_RELAXED, __HIP_MEMORY_SCOPE_AGENT
#define LDS_WAIT() asm volatile("s_waitcnt lgkmcnt(0)" ::: "memory")
#define VM_WAIT() asm volatile("s_waitcnt vmcnt(0)" ::: "memory")
__device__ __forceinline__ unsigned long long rt() { return __builtin_amdgcn_s_memrealtime(); }
__device__ __forceinline__ unsigned f2bf(float f) { unsigned u = __builtin_bit_cast(unsigned, f); return (u + 0x7fffu + ((u >> 16) & 1u)) >> 16; }
__device__ __forceinline__ unsigned pk2(float lo, float hi) { return f2bf(lo) | (f2bf(hi) << 16); }

#define XB_TMO      128
#define XB_XCNT(j)  (256  + 64 * (j))
#define XB_XSUB(j)  (1280 + 64 * (j))
#define XB_XGEN(j)  (2304 + 64 * (j))
#define XB_TOP      3328
#define XB_TOPGEN   3392
#define XCD_BAR_WORDS 3456
#define XB_SPIN_CAP (1u << 23)

__device__ __forceinline__ unsigned xb_ld(unsigned* p)              { return __hip_atomic_load(p, __ATOMIC_RELAXED, __HIP_MEMORY_SCOPE_AGENT); }
__device__ __forceinline__ unsigned xb_add(unsigned* p, unsigned v) { return __hip_atomic_fetch_add(p, v, __ATOMIC_RELAXED, __HIP_MEMORY_SCOPE_AGENT); }
__device__ __forceinline__ unsigned xb_xcc_id() { return (unsigned)__builtin_amdgcn_s_getreg((3 << 11) | 20) & 0xFu; }
#define XB_SPIN(cond, bar) do { unsigned _sp = 0; while (cond) { __builtin_amdgcn_s_sleep(1); \
    if ((++_sp & 255u) == 0u) { if (xb_ld(&(bar)[XB_TMO])) break; if (_sp > XB_SPIN_CAP) { atomicAdd(&(bar)[XB_TMO], 1u); break; } } } } while (0)

struct XcdBarrier {
    unsigned* bar; unsigned x;
    volatile LAS unsigned* st;
};

__device__ __forceinline__ XcdBarrier xcd_barrier_post(unsigned* bar, volatile LAS unsigned* st) {
    XcdBarrier b; b.bar = bar; b.x = xb_xcc_id(); b.st = st;
    if (threadIdx.x == 0) (void)xb_add(&bar[XB_XCNT(b.x)], 1u);
    return b;
}
__device__ __forceinline__ void xcd_barrier_complete(unsigned* bar, unsigned x, unsigned& nloc, unsigned& nx) {
    const unsigned G = gridDim.x * gridDim.y * gridDim.z;
    unsigned sum, cnt, mine, sp = 0u;
    for (;;) {
        sum = 0u; cnt = 0u; mine = 0u;
#pragma unroll
        for (unsigned j = 0; j < 16; ++j) { const unsigned c = xb_ld(&bar[XB_XCNT(j)]); sum += c; cnt += (c > 0u) ? 1u : 0u; mine = (j == x) ? c : mine; }
        if (sum == G) break;
        __builtin_amdgcn_s_sleep(1);
        if ((++sp & 255u) == 0u) { if (xb_ld(&bar[XB_TMO])) break; if (sp > XB_SPIN_CAP) { atomicAdd(&bar[XB_TMO], 1u); break; } }
    }
    nloc = mine > 0u ? mine : 1u; nx = cnt > 0u ? cnt : 1u;
}

__device__ __forceinline__ void xcd_barrier(const XcdBarrier& b) {
    asm volatile("s_waitcnt vmcnt(0)" ::: "memory");
    __syncthreads();
    if (threadIdx.x == 0) {
        unsigned* bar = b.bar;
        __builtin_amdgcn_s_waitcnt(0);
        unsigned nloc = b.st[0], nx = b.st[1];
        if (nloc == 0u) { xcd_barrier_complete(bar, b.x, nloc, nx); b.st[0] = nloc; b.st[1] = nx; }
        const unsigned old = xb_add(&bar[XB_XSUB(b.x)], 1u);
        const unsigned gen = old / nloc;
        if (old + 1u == (gen + 1u) * nloc) {
            __builtin_amdgcn_fence(__ATOMIC_RELEASE, "agent");
            asm volatile("s_waitcnt vmcnt(0)" ::: "memory");
            const unsigned og = xb_add(&bar[XB_TOP], 1u);
            const unsigned tg = og / nx;
            if (og + 1u == (tg + 1u) * nx) xb_add(&bar[XB_TOPGEN], 1u);
            else XB_SPIN(xb_ld(&bar[XB_TOPGEN]) == tg, bar);
            __builtin_amdgcn_fence(__ATOMIC_ACQUIRE, "agent");
            xb_add(&bar[XB_XGEN(b.x)], 1u);
            asm volatile("s_waitcnt vmcnt(0)" ::: "memory");
        } else {
            XB_SPIN(xb_ld(&bar[XB_XGEN(b.x)]) == gen, bar);
            __builtin_amdgcn_fence(__ATOMIC_ACQUIRE, "agent");
            asm volatile("s_waitcnt vmcnt(0)" ::: "memory");
        }
    }
    __syncthreads();
}
constexpr int DM = 1024, NB = 8, SEQ = 4096, CTX = 256, T = NB * SEQ, TC = NB * CTX, SKV = CTX + SEQ, MROWS = T + TC;
constexpr int NIN = 5120;
constexpr int C_Q = 0, C_K = 512, C_V = 1024, C_HY = 1536, C_G = 3072;
constexpr int NE = 32, TOPK = 4, NA = T * TOPK, NROWS = NA + NE * 256, NBLK = NROWS / 256;
constexpr float EPS = 1e-6f;
enum { IX_X = 0, IX_C, IX_CTX, IX_CCTX, IX_ADAW, IX_ADAB, IX_N1G, IX_N2G, IX_WIN, IX_BIN, IX_QNG, IX_KNG, IX_LQ1, IX_LK1, IX_LQ2, IX_LK2, IX_SUBG,
       IX_CONVW, IX_CONVB, IX_FW1, IX_FB1, IX_FW2, IX_FB2, IX_FW3, IX_FB3, IX_FW4, IX_FFREQ, IX_HBIAS, IX_WUA, IX_WUB, IX_WOUT, IX_RW, IX_RB,
       IX_EW1, IX_EB1, IX_EW2, IX_EB2, N_INPUTS };
constexpr size_t MiB = 1u << 20;
constexpr size_t WS_CTL = 0, CTL_BYTES = 1 * MiB;
constexpr size_t WS_MOD = 1 * MiB;
constexpr size_t WS_LAM = WS_MOD + 256 * 1024;
constexpr size_t WS_ROPEC = WS_LAM + 1024, WS_ROPES = WS_ROPEC + 4096;
constexpr size_t WS_BLKE = WS_ROPES + 4096;
constexpr size_t WS_CNTB = WS_BLKE + 4096;
constexpr size_t WS_TOPE = 2 * MiB, WS_TOPW = WS_TOPE + 512 * 1024, WS_TOKPOS = WS_TOPW + 512 * 1024;
constexpr size_t WS_ROWTOK = WS_TOKPOS + 512 * 1024, WS_ROWW = WS_ROWTOK + 576 * 1024;
static_assert(WS_CNTB + 32768 <= 2 * MiB && WS_ROWW + 576 * 1024 <= 5 * MiB && (size_t)NROWS * 4 <= 576 * 1024, "small tables");
constexpr size_t WS_HF = 6 * MiB;
constexpr size_t WS_WIN = 22 * MiB;
constexpr size_t WS_WIN8 = 5 * MiB + 512 * 1024;
constexpr size_t WS_WA = 32 * MiB, WS_WB = 33 * MiB, WS_WO = 34 * MiB;
constexpr size_t WS_W1 = 36 * MiB;
constexpr size_t WS_W2 = 164 * MiB;
constexpr size_t WS_ACT0 = 228 * MiB;
constexpr size_t WS_HY = 228 * MiB;
constexpr size_t WS_GT = 324 * MiB;
constexpr size_t WS_PX = WS_ACT0;
constexpr size_t WS_XM = 568 * MiB;
constexpr size_t WS_XM8 = 636 * MiB;
constexpr size_t WS_WG8 = 668 * MiB;
constexpr size_t WS_OATT = 568 * MiB;
constexpr size_t WS_QP = 696 * MiB;
constexpr size_t WS_V8T = 728 * MiB;
constexpr size_t WS_KA = 760 * MiB, WS_VA = 794 * MiB;
constexpr size_t WS_U = 828 * MiB;
constexpr size_t WS_UT = 828 * MiB, WS_YT = 860 * MiB;
constexpr size_t WS_CP = 956 * MiB;
constexpr size_t WS_OAB = 892 * MiB;
constexpr size_t WS_SSQ = 228 * MiB;
constexpr size_t WS_OB = 892 * MiB, WS_OA = 924 * MiB;
constexpr size_t WS_TA = 696 * MiB;
constexpr size_t WS_TB = 568 * MiB;
constexpr size_t WS_MB = 828 * MiB;
constexpr size_t WS_TM = 696 * MiB;
constexpr size_t WS_H = 568 * MiB;
constexpr size_t WS_HS = 228 * MiB;
constexpr size_t WS_ACT = 860 * MiB;
constexpr size_t WS_Y = 568 * MiB;
constexpr size_t WS_END = 1020 * MiB;
constexpr int CW_CNT = 0;
constexpr int CW_BAR = 4096;
constexpr int CW_NMAX = 1024;
constexpr int RING_BYTES = 131072, MISC_OFF = RING_BYTES + 320, LDS_BYTES = 163840;
constexpr int NWAVES = 8, NTHREADS = 512;

typedef __attribute__((address_space(3))) float lds_f32;
__device__ __forceinline__ float bf2f(bf16 v) { return __builtin_bit_cast(float, (unsigned)v << 16); }
__device__ __forceinline__ float wave_sum(float v) {
#pragma unroll
    for (int o = 1; o < 64; o <<= 1) v += __shfl_xor(v, o);
    return v;
}
__device__ __forceinline__ float sigmoidf_(float x) { return 1.0f / (1.0f + __expf(-x)); }

struct Ctx {
    float* out; unsigned char* ws;
    LAS unsigned char* lds; char* ldsg;
    int tid, lane, wave, gwave, nwaves, gtid, gthreads;
};
#define WSP(T_, off) ((T_*)(C.ws + (off)))
#define INP(i) (((const float* const __attribute__((address_space(4)))*)__builtin_amdgcn_kernarg_segment_ptr())[i])

__device__ __forceinline__ void tr_item(const float* W, int N, bf16* WT, int Kout, int k0, int n0, int orow0, LAS float* scr, int lane, bool perm = false) {
    { const int kr = lane >> 3, c4 = (lane & 7) * 4; f32x4 v[8];
#pragma unroll
      for (int i = 0; i < 8; ++i) v[i] = *(const f32x4*)(W + (size_t)(k0 + 8 * i + kr) * N + n0 + c4);
#pragma unroll
      for (int i = 0; i < 8; ++i) { LAS float* d = scr + (8 * i + kr) * 33 + c4; d[0] = v[i].x; d[1] = v[i].y; d[2] = v[i].z; d[3] = v[i].w; } }
    LDS_WAIT(); asm volatile("" ::: "memory");
    const int c = lane & 7;
#pragma unroll
    for (int j = 0; j < 4; ++j) { const int n = (lane >> 3) + 8 * j; const LAS float* s = scr + (8 * c) * 33 + n;
        v4u o; o.x = pk2(s[0 * 33], s[1 * 33]); o.y = pk2(s[2 * 33], s[3 * 33]); o.z = pk2(s[4 * 33], s[5 * 33]); o.w = pk2(s[6 * 33], s[7 * 33]);
        const int nr = perm ? (16 * ((n >> 2) & 1) + 4 * (n >> 3) + (n & 3)) : n;
        *(v4u*)(WT + (size_t)(orow0 + nr) * Kout + k0 + 8 * c) = o; }
    LDS_WAIT(); asm volatile("" ::: "memory");
}
__device__ __forceinline__ void tr_item8(const float* W, int N, unsigned char* WT, int Kout, int k0, int n0, int orow0, LAS float* scr, int lane, float mul, bool perm = false) {
    { const int kr = lane >> 3, c4 = (lane & 7) * 4; f32x4 v[8];
#pragma unroll
      for (int i = 0; i < 8; ++i) v[i] = *(const f32x4*)(W + (size_t)(k0 + 8 * i + kr) * N + n0 + c4);
#pragma unroll
      for (int i = 0; i < 8; ++i) { LAS float* d = scr + (8 * i + kr) * 33 + c4; d[0] = v[i].x; d[1] = v[i].y; d[2] = v[i].z; d[3] = v[i].w; } }
    LDS_WAIT(); asm volatile("" ::: "memory");
    const int c = lane & 7;
#pragma unroll
    for (int j = 0; j < 4; ++j) { const int n = (lane >> 3) + 8 * j; const LAS float* s = scr + (8 * c) * 33 + n;
        const unsigned lo = pg8::pk4_fp8(s[0 * 33] * mul, s[1 * 33] * mul, s[2 * 33] * mul, s[3 * 33] * mul), hi = pg8::pk4_fp8(s[4 * 33] * mul, s[5 * 33] * mul, s[6 * 33] * mul, s[7 * 33] * mul);
        const int nr = perm ? (16 * ((n >> 2) & 1) + 4 * (n >> 3) + (n & 3)) : n;
        *(unsigned long long*)(WT + (size_t)(orow0 + nr) * Kout + k0 + 8 * c) = (unsigned long long)lo | ((unsigned long long)hi << 32); }
    LDS_WAIT(); asm volatile("" ::: "memory");
}
struct PrepItem { const float* src; unsigned char* dst; int N, k0, n0, orow0, fl; };
__device__ __forceinline__ void prep_decode(const Ctx& C, int r, PrepItem& p) {
    constexpr int I_INB = 16 * 96, I_ING = 8 * 32, I_A = 8 * 32, I_O = 16 * 32, I_E1 = 8 * 32, I_E2 = 8 * 16;
    if (r < I_INB) { const int kb = r / 96, nb = r % 96; const int L0 = 32 * nb, pn = L0 >> 8;
        p.src = INP(IX_WIN); p.N = NIN; p.k0 = 64 * kb; p.n0 = L0; p.dst = WSP(unsigned char, WS_WIN);
        p.orow0 = pn < 4 ? (256 * pn + 128 * ((L0 >> 5) & 1) + 32 * ((L0 >> 6) & 3)) : L0; p.fl = pn >= 4 ? 2 : 0; return; } r -= I_INB;
    if (r < I_ING) { const int kb = r / 32, nb = r % 32; p.src = INP(IX_WIN); p.N = NIN; p.k0 = 128 * kb; p.n0 = 3072 + 64 * nb; p.dst = WSP(unsigned char, WS_WG8); p.orow0 = 64 * nb; p.fl = 3; return; } r -= I_ING;
    if (r < 2 * I_A) { const int hb = r >= I_A; if (hb) r -= I_A; const int kb = r / 32, nb = r % 32;
        p.src = hb ? INP(IX_WUB) : INP(IX_WUA); p.N = 1024; p.k0 = 64 * kb; p.n0 = 32 * nb; p.dst = WSP(unsigned char, WS_WA) + (hb ? 1024 : 0); p.orow0 = 32 * nb; p.fl = 0; return; } r -= 2 * I_A;
    if (r < I_O) { const int kb = r / 32, nb = r % 32; p.src = INP(IX_WOUT); p.N = 1024; p.k0 = 64 * kb; p.n0 = 32 * nb; p.dst = WSP(unsigned char, WS_WO); p.orow0 = 32 * nb; p.fl = 0; return; } r -= I_O;
    if (r < NE * I_E1) { const int e = r / I_E1, q = r % I_E1, kb = q / 32, nb = q % 32; const int L0 = 64 * nb, half = L0 >> 10, ch = L0 & 1023;
        p.src = INP(IX_EW1) + (size_t)e * 1024 * 2048; p.N = 2048; p.k0 = 128 * kb; p.n0 = L0; p.dst = WSP(unsigned char, WS_W1) + (size_t)e * 2048 * 1024; p.orow0 = (ch >> 7) * 256 + half * 128 + (ch & 127); p.fl = 1; return; }
    r -= NE * I_E1;
    { const int e = r / I_E2, q = r % I_E2, kb = q / 16, nb = q % 16;
      p.src = INP(IX_EW2) + (size_t)e * 1024 * 1024; p.N = 1024; p.k0 = 128 * kb; p.n0 = 64 * nb; p.dst = WSP(unsigned char, WS_W2) + (size_t)e * 1024 * 1024; p.orow0 = 64 * nb; p.fl = 1; }
}
__device__ __forceinline__ void ph_prep_weights(const Ctx& C) {
    LAS float* scr = (LAS float*)(C.lds + C.wave * 16384);
    constexpr int NIT = 16 * 96 + 8 * 32 + 2 * 8 * 32 + 16 * 32 + NE * (8 * 32 + 8 * 16);
    const int lane = C.lane;
    for (int it = C.gwave; it < NIT; it += C.nwaves) {
        PrepItem p; prep_decode(C, it, p);
        if (p.fl & 1) {
            const int kq = lane >> 4, c = lane & 15;
            const float* src = p.src + (size_t)(p.k0 + 32 * kq) * p.N + p.n0 + 4 * c;
            LAS unsigned char* sb = (LAS unsigned char*)scr;
#pragma unroll
            for (int h = 0; h < 2; ++h) { f32x4 v[16];
#pragma unroll
                for (int i = 0; i < 16; ++i) v[i] = *(const f32x4*)(src + (size_t)(16 * h + i) * p.N);
#pragma unroll
                for (int e = 0; e < 4; ++e) { v4u o;
                    o.x = pg8::pk4_fp8(v[0][e] * 32.0f, v[1][e] * 32.0f, v[2][e] * 32.0f, v[3][e] * 32.0f); o.y = pg8::pk4_fp8(v[4][e] * 32.0f, v[5][e] * 32.0f, v[6][e] * 32.0f, v[7][e] * 32.0f);
                    o.z = pg8::pk4_fp8(v[8][e] * 32.0f, v[9][e] * 32.0f, v[10][e] * 32.0f, v[11][e] * 32.0f); o.w = pg8::pk4_fp8(v[12][e] * 32.0f, v[13][e] * 32.0f, v[14][e] * 32.0f, v[15][e] * 32.0f);
                    *(LAS v4u*)(sb + (4 * c + e) * 144 + 32 * kq + 16 * h) = o; } }
            LDS_WAIT(); asm volatile("" ::: "memory");
#pragma unroll
            for (int j = 0; j < 8; ++j) { const int n = (lane >> 3) + 8 * j, ch = lane & 7; const v4u o = *(const LAS v4u*)(sb + n * 144 + 16 * ch);
                const int n32 = n & 31, nr = (p.fl & 2) ? (16 * ((n32 >> 2) & 1) + 4 * (n32 >> 3) + (n32 & 3)) : n32;
                *(v4u*)(p.dst + (size_t)(p.orow0 + (n & 32) + nr) * 1024 + p.k0 + 16 * ch) = o; }
        } else {
            const int kr = lane >> 3, c4 = (lane & 7) * 4;
            f32x4 v[8];
#pragma unroll
            for (int i = 0; i < 8; ++i) v[i] = *(const f32x4*)(p.src + (size_t)(p.k0 + 8 * i + kr) * p.N + p.n0 + c4);
#pragma unroll
            for (int i = 0; i < 8; ++i) { LAS float* d = scr + (8 * i + kr) * 33 + c4; d[0] = v[i].x; d[1] = v[i].y; d[2] = v[i].z; d[3] = v[i].w; }
            LDS_WAIT(); asm volatile("" ::: "memory");
            const int c = lane & 7;
#pragma unroll
            for (int j = 0; j < 4; ++j) { const int n = (lane >> 3) + 8 * j; const LAS float* s = scr + (8 * c) * 33 + n;
                v4u o; o.x = pk2(s[0 * 33], s[1 * 33]); o.y = pk2(s[2 * 33], s[3 * 33]); o.z = pk2(s[4 * 33], s[5 * 33]); o.w = pk2(s[6 * 33], s[7 * 33]);
                const int nr = (p.fl & 2) ? (16 * ((n >> 2) & 1) + 4 * (n >> 3) + (n & 3)) : n;
                *(v4u*)((bf16*)p.dst + (size_t)(p.orow0 + nr) * 1024 + p.k0 + 8 * c) = o; }
        }
        LDS_WAIT(); asm volatile("" ::: "memory");
    }
}
__device__ __forceinline__ void ph_prep_ada(const Ctx& C) {
    LAS float* s = (LAS float*)C.lds;
    LAS float* red = s + 9 * 1024;
    const float* W = INP(IX_ADAW); float* MOD = WSP(float, WS_MOD);
    for (int g = blockIdx.x; g < 192; g += gridDim.x) {
        __syncthreads();
        for (int i = C.tid; i < 9 * 1024; i += NTHREADS) { const int r = i >> 10, k = i & 1023; const float v = r < 8 ? INP(IX_C)[r * 1024 + k] : INP(IX_CCTX)[k]; s[i] = v / (1.0f + __expf(-v)); }
        __syncthreads();
        float acc[9];
#pragma unroll
        for (int r = 0; r < 9; ++r) acc[r] = 0.f;
        const int col = 32 * g + (C.lane & 31), kp = C.wave * 2 + (C.lane >> 5);
#pragma unroll 8
        for (int k = 64 * kp; k < 64 * kp + 64; ++k) { const float wv = W[(size_t)k * 6144 + col];
#pragma unroll
            for (int r = 0; r < 9; ++r) acc[r] += s[r * 1024 + k] * wv; }
#pragma unroll
        for (int r = 0; r < 9; ++r) red[(kp * 9 + r) * 32 + (C.lane & 31)] = acc[r];
        __syncthreads();
        for (int i = C.tid; i < 9 * 32; i += NTHREADS) { const int r = i >> 5, l = i & 31; float a = 0.f;
#pragma unroll
            for (int w = 0; w < 16; ++w) a += red[(w * 9 + r) * 32 + l];
            MOD[r * 6144 + 32 * g + l] = a + INP(IX_ADAB)[32 * g + l]; }
    }
    __syncthreads();
}
__device__ __forceinline__ void ph_prep_misc(const Ctx& C) {
    if (blockIdx.x == gridDim.x - 1) {
        if (C.wave == 0) { const float a = wave_sum(INP(IX_LQ1)[C.lane] * INP(IX_LK1)[C.lane]), b = wave_sum(INP(IX_LQ2)[C.lane] * INP(IX_LK2)[C.lane]);
            if (C.lane == 0) *WSP(float, WS_LAM) = expf(a) - expf(b) + 0.2f;
            float gq = fabsf(INP(IX_QNG)[C.lane]), gk = fabsf(INP(IX_KNG)[C.lane]);
#pragma unroll
            for (int o = 1; o < 64; o <<= 1) { gq = fmaxf(gq, __shfl_xor(gq, o)); gk = fmaxf(gk, __shfl_xor(gk, o)); }
            if (C.lane == 0) WSP(float, WS_LAM)[1] = 11.541560327111707f * gq * gk + 0.5f; }
        for (int i = C.tid; i < 64 * 16; i += NTHREADS) { const int p = i >> 4, f = i & 15; const double fr = pow(10000.0, -(double)f / 16.0), ang = (double)p * fr;
            WSP(float, WS_ROPEC)[i] = (float)cos(ang); WSP(float, WS_ROPES)[i] = (float)sin(ang); }
    }
}
__device__ __forceinline__ void ph_prep_filter(const Ctx& C) {
    LAS float* sc = (LAS float*)(C.lds + C.wave * 4096);
    LAS float* wl = (LAS float*)(C.lds + 32768);
    float* HF = WSP(float, WS_HF);
    const float* w4 = INP(IX_FW4);
    const int lane = C.lane; const float fq = INP(IX_FFREQ)[lane];
    for (int i = C.gtid; i < 512; i += C.gthreads) HF[i] = 0.f;
    __syncthreads();
    { const float* w1 = INP(IX_FW1); const float* w2 = INP(IX_FW2); const float* w3 = INP(IX_FW3);
      for (int i = C.tid; i < (33 + 64 + 64) * 16; i += NTHREADS) { const int e = 4 * i; const float* src = e < 33 * 64 ? w1 + e : (e < 97 * 64 ? w2 + (e - 33 * 64) : w3 + (e - 97 * 64));
          const f32x4 v = *(const f32x4*)src; LAS float* d = wl + e; d[0] = v.x; d[1] = v.y; d[2] = v.z; d[3] = v.w; } }
    __syncthreads();
    const float lo = logf(0.01f) / 1.5f, hi = logf(0.01f) / 0.3f;
    for (int pb = blockIdx.x; pb < SEQ / 16; pb += gridDim.x) {
        const int n0 = 16 * pb + 2 * C.wave;
#pragma unroll
        for (int p = 0; p < 2; ++p) { const int n = n0 + p; float zv = 0.f;
            if (lane == 0) zv = (float)n / 4095.0f;
            else if (lane <= 32) { const int i = (lane - 1) & 15; const double f = 1e-4 + (double)i * ((15.0 - 1e-4) / 15.0); const double ang = f * (6.283185307179586 * (double)n / 4096.0);
                zv = lane <= 16 ? (float)cos(ang) : -(float)sin(ang); }
            sc[p * 256 + lane] = zv; }
        LDS_WAIT();
        float a0, a1;
        a0 = a1 = INP(IX_FB1)[lane];
#pragma unroll 11
        for (int i = 0; i < 33; ++i) { const float wv = wl[i * 64 + lane]; a0 += sc[i] * wv; a1 += sc[256 + i] * wv; }
        sc[64 + lane] = sinf(fq * a0); sc[256 + 64 + lane] = sinf(fq * a1); LDS_WAIT();
        a0 = a1 = INP(IX_FB2)[lane];
#pragma unroll 16
        for (int i = 0; i < 64; ++i) { const float wv = wl[(33 + i) * 64 + lane]; a0 += sc[64 + i] * wv; a1 += sc[256 + 64 + i] * wv; }
        sc[128 + lane] = sinf(fq * a0); sc[256 + 128 + lane] = sinf(fq * a1); LDS_WAIT();
        a0 = a1 = INP(IX_FB3)[lane];
#pragma unroll 16
        for (int i = 0; i < 64; ++i) { const float wv = wl[(97 + i) * 64 + lane]; a0 += sc[128 + i] * wv; a1 += sc[256 + 128 + i] * wv; }
        sc[192 + lane] = sinf(fq * a0); sc[256 + 192 + lane] = sinf(fq * a1);
        __syncthreads();
        float acc0[16], acc1[16];
#pragma unroll
        for (int q = 0; q < 16; ++q) { acc0[q] = 0.f; acc1[q] = 0.f; }
        const int o0 = 128 * C.wave + lane;
#pragma unroll 1
        for (int j0 = 0; j0 < 64; j0 += 16) { float wa[16], wb[16];
#pragma unroll
            for (int j = 0; j < 16; ++j) { wa[j] = w4[(j0 + j) * 1024 + o0]; wb[j] = w4[(j0 + j) * 1024 + o0 + 64]; }
#pragma unroll
            for (int q = 0; q < 16; ++q) { const LAS float* hq = (const LAS float*)(C.lds + (q >> 1) * 4096 + (q & 1) * 1024) + 192 + j0;
#pragma unroll
                for (int j4 = 0; j4 < 16; j4 += 4) { const f32x4 h = *(const LAS f32x4*)(hq + j4);
                    acc0[q] += h.x * wa[j4] + h.y * wa[j4 + 1] + h.z * wa[j4 + 2] + h.w * wa[j4 + 3]; acc1[q] += h.x * wb[j4] + h.y * wb[j4 + 1] + h.z * wb[j4 + 2] + h.w * wb[j4 + 3]; } } }
#pragma unroll
        for (int cc = 0; cc < 2; ++cc) { const int o = o0 + 64 * cc, dir = o >> 9, c = o & 511; const float dl = fabsf(lo + (hi - lo) * ((float)c / 511.0f)); const float hb = INP(IX_HBIAS)[c];
#pragma unroll
            for (int q = 0; q < 16; ++q) { const int n = 16 * pb + q; const float tn = (float)n / 4095.0f;
                float v = (cc ? acc1[q] : acc0[q]) * expf(-tn * dl);
                if (dir == 0) { if (n == 0) v += hb; HF[(size_t)(4096 + n) * 512 + c] = v; }
                else if (n > 0) HF[(size_t)(4096 - n) * 512 + c] = v; } }
        __syncthreads();
    }
}
__device__ __forceinline__ void ph_modulate1(const Ctx& C) {
    const float* MOD = WSP(float, WS_MOD); bf16* XM = WSP(bf16, WS_XM); unsigned char* XM8 = WSP(unsigned char, WS_XM8); const float* g = INP(IX_N1G);
    for (int r0 = C.gwave; r0 < MROWS; r0 += 2 * C.nwaves) {
        f32x4 v[2][4];
#pragma unroll
        for (int q = 0; q < 2; ++q) { const int r = r0 + q * C.nwaves; if (r < MROWS) { const float* xr = r < T ? INP(IX_X) + (size_t)r * DM : INP(IX_CTX) + (size_t)(r - T) * DM;
#pragma unroll
            for (int j = 0; j < 4; ++j) v[q][j] = *(const f32x4*)(xr + 4 * C.lane + 256 * j); } }
#pragma unroll
        for (int q = 0; q < 2; ++q) { const int r = r0 + q * C.nwaves; if (r < MROWS) {
            const float* mrow = MOD + (r < T ? (r >> 12) : 8) * 6144;
            float ss = 0.f;
#pragma unroll
            for (int j = 0; j < 4; ++j) ss += (v[q][j].x * v[q][j].x + v[q][j].y * v[q][j].y) + (v[q][j].z * v[q][j].z + v[q][j].w * v[q][j].w);
            const float rstd = rsqrtf(wave_sum(ss) * (1.0f / DM) + EPS);
#pragma unroll
            for (int j = 0; j < 4; ++j) { const int col = 4 * C.lane + 256 * j; const f32x4 gg = *(const f32x4*)(g + col), sh = *(const f32x4*)(mrow + col), sc = *(const f32x4*)(mrow + 1024 + col);
                const f32x4 y = v[q][j] * rstd * gg * (sc + 1.0f) + sh;
                *(unsigned long long*)(XM + (size_t)r * DM + col) = (unsigned long long)pk2(y.x, y.y) | ((unsigned long long)pk2(y.z, y.w) << 32);
                if (r < T) *(unsigned*)(XM8 + (size_t)r * DM + col) = pg8::pk4_fp8(y.x, y.y, y.z, y.w); } } }
    }
}
__device__ __forceinline__ void ph_post_proj(const Ctx& C) {
    const bf16* PX = WSP(bf16, WS_PX); bf16* QP = WSP(bf16, WS_QP); bf16* KA = WSP(bf16, WS_KA); bf16* VA = WSP(bf16, WS_VA); float* U = WSP(float, WS_U);
    const float* RC = WSP(float, WS_ROPEC); const float* RS = WSP(float, WS_ROPES);
    const int lane = C.lane;
    for (int it = C.gwave; it < T * 16 + TC * 8; it += C.nwaves) {
        int r, which, h, m, rc = 0; bool latent;
        if (it < T * 16) { r = it >> 4; const int v = it & 15; which = v >> 3; h = (v >> 1) & 3; m = v & 1; latent = true; }
        else { const int j = it - T * 16; rc = j >> 3; const int v = j & 7; which = 1; h = v >> 1; m = v & 1; r = T + rc; latent = false; }
        const float x = bf2f(PX[(size_t)r * NIN + which * 512 + h * 128 + m * 64 + lane]);
        const float rstd = rsqrtf(wave_sum(x * x) * (1.0f / 64.0f) + EPS);
        float y = x * rstd * (which ? INP(IX_KNG)[lane] : INP(IX_QNG)[lane]);
        const int t = r & 4095;
        if (latent) { const int axis = lane >> 5, half = (lane >> 4) & 1, f = lane & 15, pos = axis ? (t & 63) : (t >> 6);
            const float cs = RC[pos * 16 + f], sn = RS[pos * 16 + f]; const float pr = __shfl_xor(y, 16);
            y = half == 0 ? y * cs - pr * sn : y * cs + pr * sn; }
        if (which == 0) { const size_t base = ((size_t)r * 8 + (h * 2 + m)) * 128; QP[base + m * 64 + lane] = (bf16)f2bf(y); QP[base + (1 - m) * 64 + lane] = 0; }
        else { const size_t krow = latent ? (size_t)(r >> 12) * SKV + CTX + t : (size_t)(rc >> 8) * SKV + (rc & 255); KA[krow * 512 + h * 128 + m * 64 + lane] = (bf16)f2bf(y); }
    }
    for (int i = C.gtid; i < MROWS * 64; i += C.gthreads) { const int r = i >> 6, ch = i & 63;
        const size_t vrow = r < T ? (size_t)(r >> 12) * SKV + CTX + (r & 4095) : (size_t)((r - T) >> 8) * SKV + ((r - T) & 255);
        *(v4u*)(VA + vrow * 512 + ch * 8) = *(const v4u*)(PX + (size_t)r * NIN + C_V + ch * 8); }
    const float* cw = INP(IX_CONVW); const float* cb = INP(IX_CONVB);
    for (int i = C.gtid; i < T * 512; i += C.gthreads) { const int r = i >> 9, c = i & 511, t = r & 4095; float z[2];
#pragma unroll
        for (int gsel = 0; gsel < 2; ++gsel) { const int chn = 512 * (gsel + 1) + c; const bf16* p = PX + (size_t)r * NIN + C_HY + chn;
            const float xm = t > 0 ? bf2f(p[-NIN]) : 0.f, x0 = bf2f(p[0]), xp = t < 4095 ? bf2f(p[NIN]) : 0.f;
            z[gsel] = xm * cw[chn] + x0 * cw[1536 + chn] + xp * cw[3072 + chn] + cb[chn]; }
        U[i] = z[0] * z[1]; }
}
__device__ __forceinline__ void ph_hyena_naive(const Ctx& C) {
    const float* U = WSP(float, WS_U); const float* HF = WSP(float, WS_HF); const bf16* PX = WSP(bf16, WS_PX); bf16* OB = WSP(bf16, WS_OB);
    const float* cw = INP(IX_CONVW); const float* cb = INP(IX_CONVB);
    for (int i = C.gtid; i < T * 512 / 8; i += C.gthreads) {
        const int c = i & 511, tg = i >> 9, b = tg >> 9, t0 = (tg & 511) * 8;
        float acc[8], tap[8];
#pragma unroll
        for (int j = 0; j < 8; ++j) { acc[j] = 0.f; tap[j] = HF[(size_t)(t0 + j + 4096) * 512 + c]; }
        const float* up = U + (size_t)b * SEQ * 512 + c; const float* hp = HF + (size_t)(t0 + 4095) * 512 + c;
        for (int s = 0; s < SEQ; ++s) { const float uv = up[(size_t)s * 512]; const float nt = hp[-(long)s * 512];
#pragma unroll
            for (int j = 0; j < 8; ++j) acc[j] += uv * tap[j];
#pragma unroll
            for (int j = 7; j > 0; --j) tap[j] = tap[j - 1];
            tap[0] = nt; }
#pragma unroll
        for (int j = 0; j < 8; ++j) { const int t = t0 + j; const size_t r = (size_t)b * SEQ + t; const bf16* p = PX + r * NIN + C_HY + c;
            const float xm = t > 0 ? bf2f(p[-NIN]) : 0.f, x0 = bf2f(p[0]), xp = t < 4095 ? bf2f(p[NIN]) : 0.f;
            const float z0 = xm * cw[c] + x0 * cw[1536 + c] + xp * cw[3072 + c] + cb[c];
            OB[r * 512 + c] = (bf16)f2bf(z0 * acc[j]); }
    }
}
__device__ __forceinline__ void ph_attn_post(const Ctx& C) {
    const float* O = WSP(float, WS_OATT); bf16* OA = WSP(bf16, WS_OA); const float lam = *WSP(float, WS_LAM); const float* sg = INP(IX_SUBG);
    for (int it = C.gwave; it < T * 4; it += C.nwaves) { const int r = it >> 2, h = it & 3; const float* p = O + (size_t)r * 1024 + h * 256 + C.lane;
        const float o0 = p[0] - lam * p[128], o1 = p[64] - lam * p[192];
        const float rstd = rsqrtf(wave_sum(o0 * o0 + o1 * o1) * (1.0f / 128.0f) + EPS);
        OA[(size_t)r * 512 + h * 128 + C.lane] = (bf16)f2bf(o0 * rstd * sg[C.lane] * 0.8f); OA[(size_t)r * 512 + h * 128 + 64 + C.lane] = (bf16)f2bf(o1 * rstd * sg[64 + C.lane] * 0.8f); }
}
__device__ __forceinline__ void ph_gate(const Ctx& C) {
    const float* TA = WSP(float, WS_TA); const float* TB = WSP(float, WS_TB); const bf16* GT = WSP(bf16, WS_GT); bf16* MB = WSP(bf16, WS_MB);
    for (int i = C.gtid; i < T * 256; i += C.gthreads) { const int r = i >> 8, c = (i & 255) * 4; const f32x4 a = *(const f32x4*)(TA + (size_t)r * 1024 + c), b = *(const f32x4*)(TB + (size_t)r * 1024 + c);
        const bf16* g = GT + (size_t)r * 2048 + c; float o[4];
#pragma unroll
        for (int e = 0; e < 4; ++e) o[e] = bf2f(g[e]) * a[e] + bf2f(g[1024 + e]) * b[e];
        *(unsigned long long*)(MB + (size_t)r * 1024 + c) = (unsigned long long)pk2(o[0], o[1]) | ((unsigned long long)pk2(o[2], o[3]) << 32); }
}
__device__ __forceinline__ void ph_router(const Ctx& C) {
    const float* MOD = WSP(float, WS_MOD); const float* TM = WSP(float, WS_TM); bf16* H = WSP(bf16, WS_H); const float* g2n = INP(IX_N2G); const float* RW = INP(IX_RW);
    int* TOPE = WSP(int, WS_TOPE); float* TOPW = WSP(float, WS_TOPW); unsigned* CNT = WSP(unsigned, WS_CTL) + CW_CNT;
    LAS unsigned* hist = (LAS unsigned*)C.lds;
    if (C.tid < 32) hist[C.tid] = 0u;
    __syncthreads();
    for (int r = C.gwave; r < T; r += C.nwaves) {
        const float* mrow = MOD + (r >> 12) * 6144;
        f32x4 v[4]; float ss = 0.f;
#pragma unroll
        for (int j = 0; j < 4; ++j) { const int col = 4 * C.lane + 256 * j; const f32x4 x = *(const f32x4*)(INP(IX_X) + (size_t)r * DM + col), tm = *(const f32x4*)(TM + (size_t)r * DM + col), g1 = *(const f32x4*)(mrow + 2048 + col);
            v[j] = x + g1 * tm; *(f32x4*)(C.out + (size_t)r * DM + col) = v[j]; ss += (v[j].x * v[j].x + v[j].y * v[j].y) + (v[j].z * v[j].z + v[j].w * v[j].w); }
        const float rstd = rsqrtf(wave_sum(ss) * (1.0f / DM) + EPS);
        f32x4 y[4];
#pragma unroll
        for (int j = 0; j < 4; ++j) { const int col = 4 * C.lane + 256 * j; const f32x4 gg = *(const f32x4*)(g2n + col), sh = *(const f32x4*)(mrow + 3072 + col), sc = *(const f32x4*)(mrow + 4096 + col);
            y[j] = v[j] * rstd * gg * (sc + 1.0f) + sh;
            *(unsigned long long*)(H + (size_t)r * DM + col) = (unsigned long long)pk2(y[j].x, y[j].y) | ((unsigned long long)pk2(y[j].z, y[j].w) << 32); }
        LAS float* lg = (LAS float*)(C.lds + 1024) + C.wave * 32;
#pragma unroll 1
        for (int e = 0; e < 32; ++e) { float a = 0.f;
#pragma unroll
            for (int j = 0; j < 4; ++j) { const float* wr = RW + (size_t)(4 * C.lane + 256 * j) * 32 + e; a += y[j].x * wr[0] + y[j].y * wr[32] + y[j].z * wr[64] + y[j].w * wr[96]; }
            a = wave_sum(a) + INP(IX_RB)[e];
            if (C.lane == 0) lg[e] = a; }
        LDS_WAIT();
        float p[32];
#pragma unroll
        for (int e = 0; e < 32; ++e) p[e] = lg[e];
        unsigned taken = 0u; float tv[4]; int ti[4];
#pragma unroll
        for (int k = 0; k < 4; ++k) { float best = -INFINITY; int bi = 0;
#pragma unroll
            for (int e = 0; e < 32; ++e) { const bool ok = !((taken >> e) & 1u) && p[e] > best; best = ok ? p[e] : best; bi = ok ? e : bi; }
            taken |= 1u << bi; tv[k] = best; ti[k] = bi; }
        const float e1 = __expf(tv[1] - tv[0]), e2 = __expf(tv[2] - tv[0]), e3 = __expf(tv[3] - tv[0]); const float inv = 1.0f / (1.0f + e1 + e2 + e3);
        if (C.lane == 0) { *(int4*)(TOPE + (size_t)r * 4) = make_int4(ti[0], ti[1], ti[2], ti[3]); *(f32x4*)(TOPW + (size_t)r * 4) = (f32x4){inv, e1 * inv, e2 * inv, e3 * inv};
            atomicAdd((unsigned*)&hist[ti[0]], 1u); atomicAdd((unsigned*)&hist[ti[1]], 1u); atomicAdd((unsigned*)&hist[ti[2]], 1u); atomicAdd((unsigned*)&hist[ti[3]], 1u); }
    }
    __syncthreads();
    if (C.tid < 32) atomicAdd(CNT + C.tid, hist[C.tid]);
}
__device__ __forceinline__ void ph_sort(const Ctx& C) {
    const unsigned* CNT = WSP(unsigned, WS_CTL) + CW_CNT; const int* TOPE = WSP(int, WS_TOPE); const float* TOPW = WSP(float, WS_TOPW);
    int* TOKPOS = WSP(int, WS_TOKPOS); int* ROWTOK = WSP(int, WS_ROWTOK); float* ROWW = WSP(float, WS_ROWW); int* BLKE = WSP(int, WS_BLKE);
    LAS int* wtot = (LAS int*)C.lds;
    for (int e = blockIdx.x; e < NE; e += gridDim.x) {
        int pstart = 0, cnt = 0, padded = 0;
        for (int i = 0; i <= e; ++i) { pstart += padded; cnt = (int)__hip_atomic_load(CNT + i, __ATOMIC_RELAXED, __HIP_MEMORY_SCOPE_AGENT); padded = (cnt + 255) / 256 * 256; }
        int running = 0;
        for (int a0 = 0; a0 < NA; a0 += NTHREADS) { const int a = a0 + C.tid; const bool flag = TOPE[a] == e;
            const unsigned long long bal = __ballot(flag); const int pre = __popcll(bal & ((1ull << C.lane) - 1ull)), tot = __popcll(bal);
            __syncthreads();
            if (C.lane == 0) wtot[C.wave] = tot;
            __syncthreads();
            int woff = 0, all = 0;
#pragma unroll
            for (int w = 0; w < 8; ++w) { const int x = wtot[w]; woff += (w < C.wave) ? x : 0; all += x; }
            if (flag) { const int pos = pstart + running + woff + pre; ROWTOK[pos] = a >> 2; ROWW[pos] = TOPW[a]; TOKPOS[a] = pos; }
            running += all; }
        for (int i = cnt + C.tid; i < padded; i += NTHREADS) { ROWTOK[pstart + i] = T; ROWW[pstart + i] = 0.f; }
        __syncthreads();
    }
    if (blockIdx.x == gridDim.x - 1) {
        for (int blk = C.tid; blk <= NBLK; blk += NTHREADS) { int pend = 0, e = 0; bool found = false;
            for (int i = 0; i < NE; ++i) { const int cnt = (int)__hip_atomic_load(CNT + i, __ATOMIC_RELAXED, __HIP_MEMORY_SCOPE_AGENT); pend += (cnt + 255) / 256 * 256; if (!found && blk * 256 < pend) { e = i; found = true; } }
            if (blk < NBLK) BLKE[blk] = found ? e : NE - 1; else BLKE[NBLK] = pend / 256; }
    }
}
__device__ __forceinline__ void ph_gather(const Ctx& C) {
    const int nrows = WSP(int, WS_BLKE)[NBLK] * 256; const int* ROWTOK = WSP(int, WS_ROWTOK); const bf16* H = WSP(bf16, WS_H); bf16* HS = WSP(bf16, WS_HS);
    for (int r = C.gwave; r < nrows; r += C.nwaves) { const int tok = ROWTOK[r]; v4u a = {0u, 0u, 0u, 0u}, b = {0u, 0u, 0u, 0u};
        if (tok < T) { a = *(const v4u*)(H + (size_t)tok * DM + C.lane * 16); b = *(const v4u*)(H + (size_t)tok * DM + C.lane * 16 + 8); }
        *(v4u*)(HS + (size_t)r * DM + C.lane * 16) = a; *(v4u*)(HS + (size_t)r * DM + C.lane * 16 + 8) = b; }
}
__device__ __forceinline__ void ph_combine(const Ctx& C) {
    const float* MOD = WSP(float, WS_MOD); const int* TOKPOS = WSP(int, WS_TOKPOS); const unsigned char* Y = WSP(unsigned char, WS_Y);
    typedef float f32x2_t __attribute__((ext_vector_type(2)));
    for (int i0 = C.gtid; i0 < T * 256; i0 += 4 * C.gthreads) {
        int4 ps[4]; f32x4 xo[4], g2[4]; unsigned w[4][4];
#pragma unroll
        for (int q = 0; q < 4; ++q) { const int i = i0 + q * C.gthreads; if (i < T * 256) ps[q] = *(const int4*)(TOKPOS + (size_t)(i >> 8) * 4); }
#pragma unroll
        for (int q = 0; q < 4; ++q) { const int i = i0 + q * C.gthreads; if (i < T * 256) { const int r = i >> 8, c = (i & 255) * 4;
            w[q][0] = *(const unsigned*)(Y + (size_t)ps[q].x * DM + c); w[q][1] = *(const unsigned*)(Y + (size_t)ps[q].y * DM + c); w[q][2] = *(const unsigned*)(Y + (size_t)ps[q].z * DM + c); w[q][3] = *(const unsigned*)(Y + (size_t)ps[q].w * DM + c);
            xo[q] = *(const f32x4*)(C.out + (size_t)r * DM + c); g2[q] = *(const f32x4*)(MOD + (r >> 12) * 6144 + 5120 + c); } }
#pragma unroll
        for (int q = 0; q < 4; ++q) { const int i = i0 + q * C.gthreads; if (i < T * 256) { const int r = i >> 8, c = (i & 255) * 4; f32x4 acc = {0.f, 0.f, 0.f, 0.f};
#pragma unroll
            for (int k = 0; k < 4; ++k) { const f32x2_t lo = __builtin_amdgcn_cvt_pk_f32_fp8((int)w[q][k], false), hi = __builtin_amdgcn_cvt_pk_f32_fp8((int)w[q][k], true); acc.x += lo.x; acc.y += lo.y; acc.z += hi.x; acc.w += hi.y; }
            *(f32x4*)(C.out + (size_t)r * DM + c) = xo[q] + g2[q] * acc * 0.0625f; } }
    }
}
__device__ __forceinline__ unsigned bfx(const v4u& w, int e) { const unsigned d = e < 2 ? w.x : e < 4 ? w.y : e < 6 ? w.z : w.w; return (e & 1) ? (d & 0xffff0000u) : (d << 16); }
__device__ __forceinline__ float bfe(const v4u& w, int e) { return __builtin_bit_cast(float, bfx(w, e)); }
__device__ __forceinline__ void ph_hyena_pre(const Ctx& C) {
    const bf16* HY = WSP(bf16, WS_HY); bf16* UT = WSP(bf16, WS_UT); bf16* CP = WSP(bf16, WS_CP); const float* HF = WSP(float, WS_HF);
    const float* cw = INP(IX_CONVW); const float* cb_ = INP(IX_CONVB);
    LAS bf16* tile = (LAS bf16*)C.lds;
    const int tid = C.tid;
    const bool skew = gridDim.x >= 64 && (gridDim.x & 7) == 0; const int vb0 = skew ? (int)blockIdx.x - 32 : (int)blockIdx.x, vnb = skew ? (int)gridDim.x - 32 : (int)gridDim.x;
    const bool fixc = (vnb & 7) == 0;
    const int tl = tid >> 3, c8 = (tid & 7) * 8;
    float w0[2][8], w1[2][8], w2[2][8], wb[2][8];
    if (fixc) {
#pragma unroll
        for (int gsel = 0; gsel < 2; ++gsel) { const int chn = 512 * (gsel + 1) + ((int)blockIdx.x & 7) * 64 + c8;
#pragma unroll
            for (int e = 0; e < 8; ++e) { w0[gsel][e] = cw[chn + e]; w1[gsel][e] = cw[1536 + chn + e]; w2[gsel][e] = cw[3072 + chn + e]; wb[gsel][e] = cb_[chn + e]; } } }
    const v4u zero4 = {0u, 0u, 0u, 0u};
#define HP_LOAD(IT, M, X, Q) do { const int cb_i = (IT) & 7, tb_i = ((IT) >> 3) & 63, b_i = (IT) >> 9; const int t_i = tb_i * 64 + tl; const size_t r_i = (size_t)b_i * SEQ + t_i; \
        _Pragma("unroll") for (int gsel = 0; gsel < 2; ++gsel) { const bf16* p_ = HY + r_i * 1536 + 512 * (gsel + 1) + cb_i * 64 + c8; \
            M[gsel] = t_i > 0 ? *(const v4u*)(p_ - 1536) : zero4; X[gsel] = *(const v4u*)p_; Q[gsel] = t_i < SEQ - 1 ? *(const v4u*)(p_ + 1536) : zero4; } } while (0)
    v4u cm[2], cx[2], cq[2], nm[2], nx[2], nq[2];
    int it = vb0 < 0 ? 8 * 64 * 8 : vb0;
    if (it < 8 * 64 * 8) HP_LOAD(it, cm, cx, cq);
    for (; it < 8 * 64 * 8; it += vnb) {
        const int cb = it & 7, tb = (it >> 3) & 63, b = it >> 9, c0 = cb * 64, t0 = tb * 64;
        const bool has_n = it + vnb < 8 * 64 * 8;
        if (has_n) HP_LOAD(it + vnb, nm, nx, nq);
        if (!fixc) {
#pragma unroll
            for (int gsel = 0; gsel < 2; ++gsel) { const int chn = 512 * (gsel + 1) + c0 + c8;
#pragma unroll
                for (int e = 0; e < 8; ++e) { w0[gsel][e] = cw[chn + e]; w1[gsel][e] = cw[1536 + chn + e]; w2[gsel][e] = cw[3072 + chn + e]; wb[gsel][e] = cb_[chn + e]; } } }
        float z[2][8];
#pragma unroll
        for (int gsel = 0; gsel < 2; ++gsel)
#pragma unroll
            for (int e = 0; e < 8; ++e) z[gsel][e] = bfe(cm[gsel], e) * w0[gsel][e] + bfe(cx[gsel], e) * w1[gsel][e] + bfe(cq[gsel], e) * w2[gsel][e] + wb[gsel][e];
        __syncthreads();
#pragma unroll
        for (int e = 0; e < 8; ++e) tile[(c8 + e) * 72 + tl] = (bf16)f2bf(z[0][e] * z[1][e]);
        __syncthreads();
        const v4u o = *(const LAS v4u*)(tile + (tid >> 3) * 72 + (tid & 7) * 8);
        *(v4u*)(UT + ((size_t)(c0 + (tid >> 3)) * 8 + b) * SEQ + t0 + (tid & 7) * 8) = o;
        if (has_n) {
#pragma unroll
            for (int gsel = 0; gsel < 2; ++gsel) { cm[gsel] = nm[gsel]; cx[gsel] = nx[gsel]; cq[gsel] = nq[gsel]; } }
    }
#undef HP_LOAD
    __syncthreads();
    LAS float* hfl = (LAS float*)(C.lds + 16384);
    for (int it = vb0 < 0 ? 8 * 128 : vb0; it < 8 * 128; it += vnb) {
        const int cb = it & 7, xb = it >> 3, c0 = cb * 64, x0 = xb * 64, mbase = 8192 - x0 - 70;
        __syncthreads();
        for (int idx = tid; idx < 71 * 64; idx += NTHREADS) { const int lr = idx >> 6, cc = idx & 63, mp = mbase + lr; hfl[lr * 65 + cc] = (mp >= 1 && mp <= 8191) ? HF[(size_t)mp * 512 + c0 + cc] : 0.f; }
        __syncthreads();
        const int c = tid >> 3, x8 = (tid & 7) * 8;
#pragma unroll
        for (int rho = 0; rho < 8; ++rho) { float v[8];
#pragma unroll
            for (int e = 0; e < 8; ++e) v[e] = hfl[(70 - (x8 + e) - rho) * 65 + c];
            v4u o; o.x = pk2(v[0], v[1]); o.y = pk2(v[2], v[3]); o.z = pk2(v[4], v[5]); o.w = pk2(v[6], v[7]);
            *(v4u*)(CP + ((size_t)(c0 + c) * 8 + rho) * 8192 + x0 + x8) = o; }
    }
    __syncthreads();
}
typedef float f32x16_t __attribute__((ext_vector_type(16)));
constexpr int HY_RING = 8, HY_TB = 65536;
__device__ __forceinline__ void ph_hyena_mfma(const Ctx& C) {
    const bf16* UT = WSP(bf16, WS_UT); const bf16* CP = WSP(bf16, WS_CP); bf16* YT = WSP(bf16, WS_YT);
    const int lane = C.lane, n = lane & 31, hh = lane >> 5, b = C.wave;
    LAS unsigned char* ub = C.lds + b * 8192;
    const unsigned ubo = (unsigned)b * 8192u, zrow = (unsigned)(HY_TB + HY_RING * 8192);
    const int rho = (-n) & 7, cn = (n + rho) >> 3;
    if (C.tid < 32) ((LAS unsigned*)(C.lds + HY_TB + HY_RING * 8192))[C.tid] = 0u;
    __syncthreads();
    const int fnb = b >> 2, fks = b & 3;
    const int wfix = 512 - 4 * fnb + 2 * fks + hh - cn;
    for (int c = blockIdx.x; c < 512; c += gridDim.x) {
        const bf16* src = UT + ((size_t)c * 8 + b) * SEQ;
#pragma unroll
        for (int it = 0; it < 8; ++it) { const int g = it * 64 + lane, p = g >> 3, ch = g & 7; const v4u v = *(const v4u*)(src + g * 8);
            *(LAS v4u*)(ub + p * 128 + ((ch ^ ((p >> 1) & 7)) << 4)) = v; }
        asm volatile("s_waitcnt vmcnt(0) lgkmcnt(0)" ::: "memory");
        f32x16_t acc[2][2];
#pragma unroll
        for (int i = 0; i < 2; ++i)
#pragma unroll
            for (int j = 0; j < 2; ++j)
#pragma unroll
                for (int r = 0; r < 16; ++r) acc[i][j][r] = 0.f;
        const bf16* cpl = CP + ((size_t)c * 8 + rho) * 8192;
#define HY_ISSUE2(D_, slot_) do { _Pragma("unroll") for (int h_ = 0; h_ < 2; ++h_) { const int sc_ = (2 * (D_) + h_) > 126 ? 126 : (2 * (D_) + h_); const int W_ = wfix - 8 * (sc_ - 63); \
        __builtin_amdgcn_global_load_lds((const unsigned*)(cpl + 8 * W_), (LAS unsigned*)(C.lds + HY_TB + (slot_) * 16384 + h_ * 8192 + b * 1024), 16, 0, 0); } } while (0)
#define HY_READ(TF, AF, s_, off_) do { const int d_ = (s_) - 63; const LAS unsigned char* tb_ = C.lds + HY_TB + (off_) + lane * 16; \
        _Pragma("unroll") for (int nb = 0; nb < 2; ++nb) _Pragma("unroll") for (int ks = 0; ks < 4; ++ks) TF[nb][ks] = *(const LAS bf16x8*)(tb_ + (nb * 4 + ks) * 1024); \
        _Pragma("unroll") for (int ib = 0; ib < 2; ++ib) { if (ib == 0 ? (d_ <= 31) : (d_ >= -31)) { const int p_ = 32 * ib - d_ + n; const bool v_ = (unsigned)p_ < 64u; \
            const unsigned a0_ = v_ ? (ubo + (unsigned)(p_ * 128 + (((p_ >> 1) & 7) << 4))) : zrow; \
            _Pragma("unroll") for (int ks = 0; ks < 4; ++ks) AF[ib][ks] = *(const LAS bf16x8*)(C.lds + (a0_ ^ (unsigned)((2 * ks + hh) << 4))); } } } while (0)
#define HY_MMA(TF, AF, s_) do { const int d_ = (s_) - 63; if ((s_) <= 126) { _Pragma("unroll") for (int ib = 0; ib < 2; ++ib) { if (ib == 0 ? (d_ <= 31) : (d_ >= -31)) { \
        _Pragma("unroll") for (int ks = 0; ks < 4; ++ks) _Pragma("unroll") for (int nb = 0; nb < 2; ++nb) acc[ib][nb] = __builtin_amdgcn_mfma_f32_32x32x16_bf16(AF[ib][ks], TF[nb][ks], acc[ib][nb], 0, 0, 0); } } } } while (0)
        HY_ISSUE2(0, 0); HY_ISSUE2(1, 1); HY_ISSUE2(2, 2);
        asm volatile("s_waitcnt vmcnt(2)" ::: "memory"); __builtin_amdgcn_s_barrier(); asm volatile("" ::: "memory");
        bf16x8 tfA[2][4], afA[2][4], tfB[2][4], afB[2][4];
        HY_READ(tfA, afA, 0, 0);
#pragma unroll 1
        for (int D = 0; D < 64; ++D) {
            const int slot = D & 3;
            HY_ISSUE2(D + 3, (D + 3) & 3);
            HY_READ(tfB, afB, 2 * D + 1, slot * 16384 + 8192);
            HY_MMA(tfA, afA, 2 * D);
            if (D < 63) HY_READ(tfA, afA, 2 * D + 2, ((D + 1) & 3) * 16384);
            HY_MMA(tfB, afB, 2 * D + 1);
            asm volatile("s_waitcnt vmcnt(2) lgkmcnt(0)" ::: "memory"); __builtin_amdgcn_s_barrier(); asm volatile("" ::: "memory");
        }
#undef HY_ISSUE2
#undef HY_READ
#undef HY_MMA
        asm volatile("s_waitcnt vmcnt(0)" ::: "memory");
        bf16* dst = YT + ((size_t)c * 8 + b) * SEQ;
#pragma unroll
        for (int ib = 0; ib < 2; ++ib)
#pragma unroll
            for (int nb = 0; nb < 2; ++nb)
#pragma unroll
                for (int r = 0; r < 16; ++r) { const int i = 32 * ib + (r & 3) + 8 * (r >> 2) + 4 * hh; dst[64 * i + 32 * nb + n] = (bf16)f2bf(acc[ib][nb][r]); }
        asm volatile("s_waitcnt vmcnt(0) lgkmcnt(0)" ::: "memory"); __builtin_amdgcn_s_barrier(); asm volatile("" ::: "memory");
    }
    __syncthreads();
}
__device__ __forceinline__ void ph_hyena_post(const Ctx& C) {
    const bf16* HY = WSP(bf16, WS_HY); const bf16* YT = WSP(bf16, WS_YT); bf16* OAB = WSP(bf16, WS_OAB);
    const float* cw = INP(IX_CONVW); const float* cb_ = INP(IX_CONVB);
    LAS bf16* tile = (LAS bf16*)C.lds; const int tid = C.tid;
    const int vb0 = (int)blockIdx.x, vnb = (int)gridDim.x; const bool fixc = (vnb & 7) == 0;
    const int tl = tid >> 3, c8 = (tid & 7) * 8;
    float w0[8], w1[8], w2[8], wb[8];
    if (fixc) { const int chn = (vb0 & 7) * 64 + c8;
#pragma unroll
        for (int e = 0; e < 8; ++e) { w0[e] = cw[chn + e]; w1[e] = cw[1536 + chn + e]; w2[e] = cw[3072 + chn + e]; wb[e] = cb_[chn + e]; } }
    const v4u zero4 = {0u, 0u, 0u, 0u};
#define HQ_LOAD(IT, YV, M, X, Q) do { const int cb_i = (IT) & 7, tb_i = ((IT) >> 3) & 63, b_i = (IT) >> 9; const int t_i = tb_i * 64 + tl; \
        YV = *(const v4u*)(YT + ((size_t)(cb_i * 64 + (tid >> 3)) * 8 + b_i) * SEQ + tb_i * 64 + (tid & 7) * 8); \
        const bf16* p_ = HY + ((size_t)b_i * SEQ + t_i) * 1536 + cb_i * 64 + c8; \
        M = t_i > 0 ? *(const v4u*)(p_ - 1536) : zero4; X = *(const v4u*)p_; Q = t_i < SEQ - 1 ? *(const v4u*)(p_ + 1536) : zero4; } while (0)
    v4u cy, cm, cx, cq, ny, nm, nx, nq;
    int it = vb0;
    if (it < 8 * 64 * 8) HQ_LOAD(it, cy, cm, cx, cq);
    for (; it < 8 * 64 * 8; it += vnb) {
        const int cb = it & 7, tb = (it >> 3) & 63, b = it >> 9, c0 = cb * 64, t0 = tb * 64;
        const bool has_n = it + vnb < 8 * 64 * 8;
        if (has_n) HQ_LOAD(it + vnb, ny, nm, nx, nq);
        if (!fixc) { const int chn = c0 + c8;
#pragma unroll
            for (int e = 0; e < 8; ++e) { w0[e] = cw[chn + e]; w1[e] = cw[1536 + chn + e]; w2[e] = cw[3072 + chn + e]; wb[e] = cb_[chn + e]; } }
        __syncthreads();
        *(LAS v4u*)(tile + (tid >> 3) * 72 + (tid & 7) * 8) = cy;
        __syncthreads();
        const int t = t0 + tl, chn = c0 + c8; const size_t r = (size_t)b * SEQ + t;
        float o[8];
#pragma unroll
        for (int e = 0; e < 8; ++e) { const float z0 = bfe(cm, e) * w0[e] + bfe(cx, e) * w1[e] + bfe(cq, e) * w2[e] + wb[e]; o[e] = z0 * bf2f(tile[(c8 + e) * 72 + tl]); }
        v4u w; w.x = pk2(o[0], o[1]); w.y = pk2(o[2], o[3]); w.z = pk2(o[4], o[5]); w.w = pk2(o[6], o[7]);
        *(v4u*)(OAB + r * 1024 + 512 + chn) = w;
        if (has_n) { cy = ny; cm = nm; cx = nx; cq = nq; }
    }
#undef HQ_LOAD
    __syncthreads();
}

__device__ __forceinline__ void v8t_chunk(const bf16* VA, unsigned char* V8T, int b, int h, int tk, int ci) {
    const int d0 = ci >> 7, half = (ci >> 6) & 1, ln = ci & 63, n = ln & 31, kg = ln >> 5;
    const bf16* src = VA + ((size_t)b * SKV + 64 * tk + 32 * half + 4 * kg) * 512 + h * 128 + 32 * d0 + n;
    float v[16];
#pragma unroll
    for (int e = 0; e < 16; ++e) v[e] = bf2f(src[(size_t)((e & 3) + 8 * (e >> 2)) * 512]);
    v4u o; o.x = pg8::pk4_fp8(v[0], v[1], v[2], v[3]); o.y = pg8::pk4_fp8(v[4], v[5], v[6], v[7]); o.z = pg8::pk4_fp8(v[8], v[9], v[10], v[11]); o.w = pg8::pk4_fp8(v[12], v[13], v[14], v[15]);
    *(v4u*)(V8T + ((size_t)((b * 4 + h) * (SKV / 64) + tk) * 512 + ci) * 16) = o;
}
__device__ __forceinline__ void ph_v8t(const Ctx& C) {
    const bf16* VA = WSP(bf16, WS_VA); unsigned char* V8T = WSP(unsigned char, WS_V8T);
    constexpr int NTL = SKV / 64 - 4;
    const bool skew = gridDim.x >= 64; const int t0 = skew ? C.gtid - 32 * NTHREADS : C.gtid, tn = skew ? C.gthreads - 32 * NTHREADS : C.gthreads;
    for (int i = t0 < 0 ? NB * 4 * NTL * 512 : t0; i < NB * 4 * NTL * 512; i += tn) { const int ci = i & 511, tk = 4 + (i >> 9) % NTL, bh = (i >> 9) / NTL; v8t_chunk(VA, V8T, bh >> 2, bh & 3, tk, ci); }
}
__device__ __forceinline__ void ph_v8t_ctx(const Ctx& C, int b, int h0) {
    const bf16* VA = WSP(bf16, WS_VA); unsigned char* V8T = WSP(unsigned char, WS_V8T);
    for (int i = C.tid; i < 2 * 4 * 512; i += NTHREADS) v8t_chunk(VA, V8T, b, h0 + (i >> 11), (i >> 9) & 3, i & 511);
}
__device__ __forceinline__ unsigned char f8b(float v) { return (unsigned char)(pg8::pk4_fp8(v, 0.f, 0.f, 0.f) & 0xffu); }
__device__ __forceinline__ void ph_hyena_pre8(const Ctx& C) {
    const bf16* HY = WSP(bf16, WS_HY); unsigned char* UT = WSP(unsigned char, WS_UT); unsigned char* CP = WSP(unsigned char, WS_CP); const float* HF = WSP(float, WS_HF);
    const float* cw = INP(IX_CONVW); const float* cb_ = INP(IX_CONVB);
    LAS unsigned char* tile = C.lds;
    const int tid = C.tid;
    const bool skew = gridDim.x >= 64 && (gridDim.x & 7) == 0; const int vb0 = skew ? (int)blockIdx.x - 32 : (int)blockIdx.x, vnb = skew ? (int)gridDim.x - 32 : (int)gridDim.x;
    const bool fixc = (vnb & 7) == 0;
    const int tl = tid >> 3, c8 = (tid & 7) * 8;
    float w0[2][8], w1[2][8], w2[2][8], wb[2][8];
    if (fixc) {
#pragma unroll
        for (int gsel = 0; gsel < 2; ++gsel) { const int chn = 512 * (gsel + 1) + ((int)blockIdx.x & 7) * 64 + c8;
#pragma unroll
            for (int e = 0; e < 8; ++e) { w0[gsel][e] = cw[chn + e]; w1[gsel][e] = cw[1536 + chn + e]; w2[gsel][e] = cw[3072 + chn + e]; wb[gsel][e] = cb_[chn + e]; } } }
    const v4u zero4 = {0u, 0u, 0u, 0u};
#define HP_LOAD(IT, M, X, Q) do { const int cb_i = (IT) & 7, tb_i = ((IT) >> 3) & 63, b_i = (IT) >> 9; const int t_i = tb_i * 64 + tl; const size_t r_i = (size_t)b_i * SEQ + t_i; \
        _Pragma("unroll") for (int gsel = 0; gsel < 2; ++gsel) { const bf16* p_ = HY + r_i * 1536 + 512 * (gsel + 1) + cb_i * 64 + c8; \
            M[gsel] = t_i > 0 ? *(const v4u*)(p_ - 1536) : zero4; X[gsel] = *(const v4u*)p_; Q[gsel] = t_i < SEQ - 1 ? *(const v4u*)(p_ + 1536) : zero4; } } while (0)
    v4u cm[2], cx[2], cq[2], nm[2], nx[2], nq[2];
    int it = vb0 < 0 ? 8 * 64 * 8 : vb0;
    if (it < 8 * 64 * 8) HP_LOAD(it, cm, cx, cq);
    for (; it < 8 * 64 * 8; it += vnb) {
        const int cb = it & 7, tb = (it >> 3) & 63, b = it >> 9, c0 = cb * 64, t0 = tb * 64;
        const bool has_n = it + vnb < 8 * 64 * 8;
        if (has_n) HP_LOAD(it + vnb, nm, nx, nq);
        if (!fixc) {
#pragma unroll
            for (int gsel = 0; gsel < 2; ++gsel) { const int chn = 512 * (gsel + 1) + c0 + c8;
#pragma unroll
                for (int e = 0; e < 8; ++e) { w0[gsel][e] = cw[chn + e]; w1[gsel][e] = cw[1536 + chn + e]; w2[gsel][e] = cw[3072 + chn + e]; wb[gsel][e] = cb_[chn + e]; } } }
        float z[2][8];
#pragma unroll
        for (int gsel = 0; gsel < 2; ++gsel)
#pragma unroll
            for (int e = 0; e < 8; ++e) z[gsel][e] = bfe(cm[gsel], e) * w0[gsel][e] + bfe(cx[gsel], e) * w1[gsel][e] + bfe(cq[gsel], e) * w2[gsel][e] + wb[gsel][e];
        __syncthreads();
#pragma unroll
        for (int e = 0; e < 8; ++e) tile[(c8 + e) * 80 + tl] = f8b(z[0][e] * z[1][e]);
        __syncthreads();
        const unsigned long long o = *(const LAS unsigned long long*)(tile + (tid >> 3) * 80 + (tid & 7) * 8);
        *(unsigned long long*)(UT + ((size_t)(c0 + (tid >> 3)) * 8 + b) * SEQ + t0 + (tid & 7) * 8) = o;
        if (has_n) {
#pragma unroll
            for (int gsel = 0; gsel < 2; ++gsel) { cm[gsel] = nm[gsel]; cx[gsel] = nx[gsel]; cq[gsel] = nq[gsel]; } }
    }
#undef HP_LOAD
    __syncthreads();
    LAS float* hfl = (LAS float*)(C.lds + 16384);
    for (int it2 = vb0 < 0 ? 8 * 128 : vb0; it2 < 8 * 128; it2 += vnb) {
        const int cb = it2 & 7, xb = it2 >> 3, c0 = cb * 64, x0 = xb * 64, mbase = 8192 - x0 - 78;
        __syncthreads();
        for (int idx = tid; idx < 79 * 64; idx += NTHREADS) { const int lr = idx >> 6, cc = idx & 63, mp = mbase + lr; hfl[lr * 65 + cc] = (mp >= 1 && mp <= 8191) ? HF[(size_t)mp * 512 + c0 + cc] * 64.0f : 0.f; }
        __syncthreads();
        const int c = tid >> 3, x8 = (tid & 7) * 8;
#pragma unroll 4
        for (int rho = 0; rho < 16; ++rho) { float v[8];
#pragma unroll
            for (int e = 0; e < 8; ++e) v[e] = hfl[(78 - (x8 + e) - rho) * 65 + c];
            *(unsigned long long*)(CP + ((size_t)(c0 + c) * 16 + rho) * 8192 + x0 + x8) = (unsigned long long)pg8::pk4_fp8(v[0], v[1], v[2], v[3]) | ((unsigned long long)pg8::pk4_fp8(v[4], v[5], v[6], v[7]) << 32); }
    }
    __syncthreads();
}
typedef int v8i_h8 __attribute__((ext_vector_type(8)));
typedef int v4i_h8 __attribute__((ext_vector_type(4)));
constexpr int H8_TB = 32768, H8_Z = 65536;
__device__ __forceinline__ void ph_hyena_mfma8(const Ctx& C) {
    const unsigned char* UT = WSP(unsigned char, WS_UT); const unsigned char* CP = WSP(unsigned char, WS_CP); bf16* YT = WSP(bf16, WS_YT);
    const int lane = C.lane, n = lane & 31, hh = lane >> 5, b = C.wave;
    const unsigned ubo = (unsigned)b * 4096u, zrow = (unsigned)H8_Z;
    const int rho = (-n) & 15, cn = (n + rho) >> 4;
    if (C.tid < 16) ((LAS unsigned*)(C.lds + H8_Z))[C.tid] = 0u;
    __syncthreads();
    const int fh = b >> 2, fnb = (b >> 1) & 1, fhalf = b & 1;
    const int wfix = 256 - 2 * fnb + 2 * hh - cn;
    for (int c = blockIdx.x; c < 512; c += gridDim.x) {
        const unsigned char* src = UT + ((size_t)c * 8 + b) * SEQ;
#pragma unroll
        for (int it = 0; it < 4; ++it) { const int g = it * 64 + lane, p = g >> 2, c4 = g & 3; const v4u v = *(const v4u*)(src + g * 16);
            *(LAS v4u*)(C.lds + ubo + p * 64 + ((c4 ^ ((p >> 2) & 3)) << 4)) = v; }
        asm volatile("s_waitcnt vmcnt(0) lgkmcnt(0)" ::: "memory");
        f32x16_t acc[2][2];
#pragma unroll
        for (int i = 0; i < 2; ++i)
#pragma unroll
            for (int j = 0; j < 2; ++j)
#pragma unroll
                for (int r = 0; r < 16; ++r) acc[i][j][r] = 0.f;
        const unsigned char* cpl = CP + ((size_t)c * 16 + rho) * 8192 + 16 * fhalf;
#define H8_ISSUE(D_, slot_) do { const int sc_ = (2 * (D_) + fh) > 126 ? 126 : (2 * (D_) + fh); const int W_ = wfix - 4 * (sc_ - 63); \
        __builtin_amdgcn_global_load_lds((const unsigned*)(cpl + 16 * W_), (LAS unsigned*)(C.lds + H8_TB + (slot_) * 8192 + b * 1024), 16, 0, 0); } while (0)
#define H8_READ(TF, AF, s_, off_) do { const int d_ = (s_) - 63; const LAS unsigned char* tb_ = C.lds + H8_TB + (off_) + lane * 16; \
        _Pragma("unroll") for (int nb = 0; nb < 2; ++nb) { const v4i_h8 lo_ = *(const LAS v4i_h8*)(tb_ + (nb * 2 + 0) * 1024), hi_ = *(const LAS v4i_h8*)(tb_ + (nb * 2 + 1) * 1024); TF[nb] = __builtin_shufflevector(lo_, hi_, 0, 1, 2, 3, 4, 5, 6, 7); } \
        _Pragma("unroll") for (int ib = 0; ib < 2; ++ib) { if (ib == 0 ? (d_ <= 31) : (d_ >= -31)) { const int p_ = 32 * ib - d_ + n; const bool v_ = (unsigned)p_ < 64u; \
            const unsigned a0_ = v_ ? (ubo + (unsigned)(p_ * 64 + (((p_ >> 2) & 3) << 4))) : zrow; \
            const v4i_h8 lo_ = *(const LAS v4i_h8*)(C.lds + (a0_ ^ (unsigned)((2 * hh) << 4))), hi_ = *(const LAS v4i_h8*)(C.lds + (a0_ ^ (unsigned)((2 * hh + 1) << 4))); AF[ib] = __builtin_shufflevector(lo_, hi_, 0, 1, 2, 3, 4, 5, 6, 7); } } } while (0)
#define H8_MMA(TF, AF, s_) do { const int d_ = (s_) - 63; if ((s_) <= 126) { _Pragma("unroll") for (int ib = 0; ib < 2; ++ib) { if (ib == 0 ? (d_ <= 31) : (d_ >= -31)) { \
        _Pragma("unroll") for (int nb = 0; nb < 2; ++nb) acc[ib][nb] = __builtin_amdgcn_mfma_scale_f32_32x32x64_f8f6f4(AF[ib], TF[nb], acc[ib][nb], 0, 0, 0, 0x7F7F7F7F, 0, 0x79797979); } } } } while (0)
        H8_ISSUE(0, 0); H8_ISSUE(1, 1); H8_ISSUE(2, 2);
        asm volatile("s_waitcnt vmcnt(1)" ::: "memory"); __builtin_amdgcn_s_barrier(); asm volatile("" ::: "memory");
        v8i_h8 tfA[2], afA[2], tfB[2], afB[2];
#pragma unroll
        for (int i = 0; i < 2; ++i) { afA[i] = (v8i_h8){0, 0, 0, 0, 0, 0, 0, 0}; afB[i] = (v8i_h8){0, 0, 0, 0, 0, 0, 0, 0}; }
        H8_READ(tfA, afA, 0, 0);
#pragma unroll 1
        for (int D = 0; D < 64; ++D) {
            const int slot = D & 3;
            H8_ISSUE(D + 3, (D + 3) & 3);
            H8_READ(tfB, afB, 2 * D + 1, slot * 8192 + 4096);
            H8_MMA(tfA, afA, 2 * D);
            if (D < 63) H8_READ(tfA, afA, 2 * D + 2, ((D + 1) & 3) * 8192);
            H8_MMA(tfB, afB, 2 * D + 1);
            asm volatile("s_waitcnt vmcnt(1) lgkmcnt(0)" ::: "memory"); __builtin_amdgcn_s_barrier(); asm volatile("" ::: "memory");
        }
#undef H8_ISSUE
#undef H8_READ
#undef H8_MMA
        asm volatile("s_waitcnt vmcnt(0)" ::: "memory");
        bf16* dst = YT + ((size_t)c * 8 + b) * SEQ;
#pragma unroll
        for (int ib = 0; ib < 2; ++ib)
#pragma unroll
            for (int nb = 0; nb < 2; ++nb)
#pragma unroll
                for (int r = 0; r < 16; ++r) { const int i = 32 * ib + (r & 3) + 8 * (r >> 2) + 4 * hh; dst[64 * i + 32 * nb + n] = (bf16)f2bf(acc[ib][nb][r]); }
        asm volatile("s_waitcnt vmcnt(0) lgkmcnt(0)" ::: "memory"); __builtin_amdgcn_s_barrier(); asm volatile("" ::: "memory");
    }
    __syncthreads();
}
constexpr int LDS_HIST = RING_BYTES + 1024, LDS_LG = RING_BYTES + 2048;
__device__ __forceinline__ void ph_router2(const Ctx& C) {
    const float* MOD = WSP(float, WS_MOD); const float* SSQ = WSP(float, WS_SSQ); bf16* H = WSP(bf16, WS_H); const float* g2n = INP(IX_N2G); const float* RW = INP(IX_RW);
    int* TOPE = WSP(int, WS_TOPE); float* TOPW = WSP(float, WS_TOPW); unsigned* CNTB = WSP(unsigned, WS_CNTB);
    LAS unsigned* hist = (LAS unsigned*)(C.lds + LDS_HIST);
    const int lane = C.lane, tid = C.tid;
    for (int i = tid; i < 1024 * 8; i += NTHREADS) { const int k = i >> 3, ch = i & 7; const f32x4 w = *(const f32x4*)(RW + (size_t)k * 32 + ch * 4);
        *(LAS f32x4*)(C.lds + k * 128 + ((ch ^ ((k >> 1) & 7)) << 4)) = w; }
    const float rb = INP(IX_RB)[lane >> 1];
    for (int chk = blockIdx.x; chk < T / 128; chk += gridDim.x) {
        __syncthreads();
        if (tid < 32) hist[tid] = 0u;
        __syncthreads();
#pragma unroll 1
        for (int ri = 0; ri < 16; ++ri) {
            const int r = chk * 128 + C.wave * 16 + ri; const float* mrow = MOD + (r >> 12) * 6144;
            float v[16]; float ss = 0.f;
#pragma unroll
            for (int m = 0; m < 16; ++m) { const int col = lane + 64 * m; v[m] = C.out[(size_t)r * DM + col]; }
            ss = lane < 16 ? SSQ[(size_t)r * 16 + lane] : 0.f;
            const float rstd = rsqrtf(wave_sum(ss) * (1.0f / DM) + EPS);
            float p[32];
#pragma unroll
            for (int e = 0; e < 32; ++e) p[e] = 0.f;
#pragma unroll
            for (int m = 0; m < 16; ++m) { const int col = lane + 64 * m; const float y = v[m] * rstd * g2n[col] * (mrow[4096 + col] + 1.0f) + mrow[3072 + col];
                H[(size_t)r * DM + col] = (bf16)f2bf(y);
                const LAS unsigned char* wrow = C.lds + col * 128; const int sw = (col >> 1) & 7; asm volatile("" ::: "memory");
#pragma unroll
                for (int q = 0; q < 8; ++q) { const f32x4 w = *(const LAS f32x4*)(wrow + ((q ^ sw) << 4)); p[4 * q] += y * w.x; p[4 * q + 1] += y * w.y; p[4 * q + 2] += y * w.z; p[4 * q + 3] += y * w.w; } }
#define HALVE(N_, MASK_) _Pragma("unroll") for (int e = 0; e < (N_); ++e) { const float a = p[e], b2 = p[e + (N_)]; const bool up = (lane & (MASK_)) != 0; const float send = up ? a : b2, keep = up ? b2 : a; p[e] = keep + __shfl_xor(send, (MASK_)); }
            HALVE(16, 32) HALVE(8, 16) HALVE(4, 8) HALVE(2, 4) HALVE(1, 2)
#undef HALVE
            float lg = p[0] + __shfl_xor(p[0], 1) + rb;
            const int myid = lane >> 1;
            float tv[4]; int ti[4];
#pragma unroll
            for (int k = 0; k < 4; ++k) { float bv = lg; int bi = myid;
#pragma unroll
                for (int mask = 2; mask < 64; mask <<= 1) { const float ov = __shfl_xor(bv, mask); const int oi = __shfl_xor(bi, mask); const bool take = ov > bv || (ov == bv && oi < bi); bv = take ? ov : bv; bi = take ? oi : bi; }
                tv[k] = bv; ti[k] = bi; if (myid == bi) lg = -INFINITY; }
            const float e1 = __expf(tv[1] - tv[0]), e2 = __expf(tv[2] - tv[0]), e3 = __expf(tv[3] - tv[0]); const float inv = 1.0f / (1.0f + e1 + e2 + e3);
            if (lane == 0) { *(int4*)(TOPE + (size_t)r * 4) = make_int4(ti[0], ti[1], ti[2], ti[3]); *(f32x4*)(TOPW + (size_t)r * 4) = (f32x4){inv, e1 * inv, e2 * inv, e3 * inv};
                __hip_atomic_fetch_add(&hist[ti[0]], 1u, __ATOMIC_RELAXED, __HIP_MEMORY_SCOPE_WORKGROUP); __hip_atomic_fetch_add(&hist[ti[1]], 1u, __ATOMIC_RELAXED, __HIP_MEMORY_SCOPE_WORKGROUP);
                __hip_atomic_fetch_add(&hist[ti[2]], 1u, __ATOMIC_RELAXED, __HIP_MEMORY_SCOPE_WORKGROUP); __hip_atomic_fetch_add(&hist[ti[3]], 1u, __ATOMIC_RELAXED, __HIP_MEMORY_SCOPE_WORKGROUP); }
        }
        __syncthreads();
        if (tid < 32) CNTB[chk * 32 + tid] = hist[tid];
    }
    __syncthreads();
}
__device__ __forceinline__ void ph_sort2(const Ctx& C) {
    const unsigned* CNTB = WSP(unsigned, WS_CNTB); const int* TOPE = WSP(int, WS_TOPE); const float* TOPW = WSP(float, WS_TOPW);
    int* TOKPOS = WSP(int, WS_TOKPOS); int* ROWTOK = WSP(int, WS_ROWTOK); float* ROWW = WSP(float, WS_ROWW); int* BLKE = WSP(int, WS_BLKE);
    LAS int* ptot = (LAS int*)C.lds;
    LAS int* pbef = ptot + 512;
    LAS int* tot = pbef + 512;
    LAS int* base = tot + 32;
    LAS int* pst = base + 32;
    LAS int* wt = pst + 64;
    const int tid = C.tid, lane = C.lane;
    for (int chk = blockIdx.x; chk < T / 128; chk += gridDim.x) {
        __syncthreads();
        { const int e = tid & 31, part = tid >> 5; int s = 0, sb = 0;
          for (int c2 = part * 16; c2 < part * 16 + 16; ++c2) { const int v = (int)CNTB[c2 * 32 + e]; s += v; sb += (c2 < chk) ? v : 0; }
          ptot[part * 32 + e] = s; pbef[part * 32 + e] = sb; }
        __syncthreads();
        if (tid < 32) { int s = 0, sb = 0;
#pragma unroll
            for (int pp = 0; pp < 16; ++pp) { s += ptot[pp * 32 + tid]; sb += pbef[pp * 32 + tid]; }
            tot[tid] = s; base[tid] = sb; }
        __syncthreads();
        if (tid < 33) { int ps = 0; for (int i = 0; i < tid; ++i) ps += (tot[i] + 255) / 256 * 256; pst[tid] = ps; }
        __syncthreads();
        const int a = chk * 512 + tid; const int ea = TOPE[a]; int pre = 0;
#pragma unroll 4
        for (int e = 0; e < 32; ++e) { const unsigned long long bal = __ballot(ea == e); if (lane == 0) wt[C.wave * 32 + e] = __popcll(bal); if (ea == e) pre = __popcll(bal & ((1ull << lane) - 1ull)); }
        __syncthreads();
        int woff = 0;
#pragma unroll
        for (int w = 0; w < 8; ++w) woff += (w < C.wave) ? wt[w * 32 + ea] : 0;
        const int pos = pst[ea] + base[ea] + woff + pre;
        ROWTOK[pos] = a >> 2; ROWW[pos] = TOPW[a]; TOKPOS[a] = pos;
        if (chk < NE) { const int e = chk, st = pst[e] + tot[e], en = pst[e + 1]; for (int i = st + tid; i < en; i += NTHREADS) { ROWTOK[i] = T; ROWW[i] = 0.f; } }
        if (chk == 0 && tid < DM / 16) ((v4u*)(WSP(unsigned char, WS_H) + (size_t)T * DM))[tid] = (v4u){0u, 0u, 0u, 0u};
        if (chk == T / 128 - 1) { for (int blk = tid; blk <= NBLK; blk += NTHREADS) { int e = NE - 1;
#pragma unroll 1
                for (int i = NE - 1; i >= 0; --i) if (blk * 256 < pst[i + 1]) e = i;
                if (blk < NBLK) BLKE[blk] = e; else BLKE[NBLK] = pst[NE] / 256; } }
    }
    __syncthreads();
}
constexpr int LDS_GS = RING_BYTES + 4096;
__device__ __forceinline__ void ph_router3(const Ctx& C) {
    const float* MOD = WSP(float, WS_MOD); const float* SSQ = WSP(float, WS_SSQ); unsigned char* H = WSP(unsigned char, WS_H); const float* g2n = INP(IX_N2G); const float* RW = INP(IX_RW);
    int* TOPE = WSP(int, WS_TOPE); float* TOPW = WSP(float, WS_TOPW); unsigned* CNTB = WSP(unsigned, WS_CNTB);
    LAS unsigned char* Wl = C.lds; LAS float* gsl = (LAS float*)(C.lds + LDS_GS); LAS float* shl = gsl + 1024;
    LAS unsigned* hist = (LAS unsigned*)(C.lds + LDS_HIST);
    const int lane = C.lane, tid = C.tid, i = lane & 15, kk = lane >> 4;
    for (int g = tid; g < 128 * 32; g += NTHREADS) { const int ex = g & 31, kg = g >> 5; float wv[8];
#pragma unroll
        for (int j = 0; j < 8; ++j) wv[j] = RW[(size_t)(8 * kg + j) * 32 + ex];
        unsigned hi[4], lo[4];
#pragma unroll
        for (int j = 0; j < 4; ++j) { hi[j] = pg8::cvt_pk_bf16(wv[2 * j], wv[2 * j + 1]);
            const float r0_ = wv[2 * j] - __uint_as_float(hi[j] << 16), r1_ = wv[2 * j + 1] - __uint_as_float(hi[j] & 0xffff0000u); lo[j] = pg8::cvt_pk_bf16(r0_, r1_); }
        const int Q = kg >> 2, k2 = kg & 3, nb = ex >> 4, n = ex & 15; LAS unsigned char* d = Wl + (((Q * 2 + nb) * 2) * 64 + k2 * 16 + n) * 16;
        *(LAS v4u*)d = (v4u){hi[0], hi[1], hi[2], hi[3]}; *(LAS v4u*)(d + 1024) = (v4u){lo[0], lo[1], lo[2], lo[3]}; }
    const float rb0 = INP(IX_RB)[i], rb1 = INP(IX_RB)[16 + i];
    for (int chk = blockIdx.x; chk < T / 128; chk += gridDim.x) {
        __syncthreads();
        const float* mrow = MOD + (chk >> 5) * 6144;
        for (int k = tid; k < 1024; k += NTHREADS) { gsl[k] = g2n[k] * (1.0f + mrow[4096 + k]); shl[k] = mrow[3072 + k]; }
        if (tid < 32) hist[tid] = 0u;
        __syncthreads();
        const int r0 = chk * 128 + C.wave * 16, r = r0 + i;
        float ss; { const f32x4 s4 = *(const f32x4*)(SSQ + (size_t)r * 16 + 4 * kk); ss = (s4[0] + s4[1]) + (s4[2] + s4[3]); ss += __shfl_xor(ss, 16); ss += __shfl_xor(ss, 32); }
        const float rstd = rsqrtf(ss * (1.0f / DM) + EPS);
        f32x4 acc0 = {0.f, 0.f, 0.f, 0.f}, acc1 = {0.f, 0.f, 0.f, 0.f};
        const float* xr = C.out + (size_t)r * DM + 8 * kk; unsigned char* hr = H + (size_t)r * DM + 8 * kk;
#pragma unroll 4
        for (int Q = 0; Q < 32; ++Q) {
            const f32x4 xa = *(const f32x4*)(xr + 32 * Q), xb = *(const f32x4*)(xr + 32 * Q + 4);
            const f32x4 ga = *(const LAS f32x4*)(gsl + 32 * Q + 8 * kk), gb = *(const LAS f32x4*)(gsl + 32 * Q + 8 * kk + 4), sa = *(const LAS f32x4*)(shl + 32 * Q + 8 * kk), sb = *(const LAS f32x4*)(shl + 32 * Q + 8 * kk + 4);
            const f32x4 ha = xa * rstd * ga + sa, hb = xb * rstd * gb + sb;
            *(unsigned long long*)(hr + 32 * Q) = (unsigned long long)pg8::pk4_fp8(ha[0], ha[1], ha[2], ha[3]) | ((unsigned long long)pg8::pk4_fp8(hb[0], hb[1], hb[2], hb[3]) << 32);
            unsigned hh[4], hl[4];
            hh[0] = pg8::cvt_pk_bf16(ha[0], ha[1]); hh[1] = pg8::cvt_pk_bf16(ha[2], ha[3]); hh[2] = pg8::cvt_pk_bf16(hb[0], hb[1]); hh[3] = pg8::cvt_pk_bf16(hb[2], hb[3]);
            hl[0] = pg8::cvt_pk_bf16(ha[0] - __uint_as_float(hh[0] << 16), ha[1] - __uint_as_float(hh[0] & 0xffff0000u)); hl[1] = pg8::cvt_pk_bf16(ha[2] - __uint_as_float(hh[1] << 16), ha[3] - __uint_as_float(hh[1] & 0xffff0000u));
            hl[2] = pg8::cvt_pk_bf16(hb[0] - __uint_as_float(hh[2] << 16), hb[1] - __uint_as_float(hh[2] & 0xffff0000u)); hl[3] = pg8::cvt_pk_bf16(hb[2] - __uint_as_float(hh[3] << 16), hb[3] - __uint_as_float(hh[3] & 0xffff0000u));
            const pg8::bf16x8 ah = __builtin_bit_cast(pg8::bf16x8, (v4u){hh[0], hh[1], hh[2], hh[3]}), al = __builtin_bit_cast(pg8::bf16x8, (v4u){hl[0], hl[1], hl[2], hl[3]});
            const LAS unsigned char* wq = Wl + (size_t)(Q * 4) * 1024 + lane * 16;
            const pg8::bf16x8 w0h = *(const LAS pg8::bf16x8*)(wq), w0l = *(const LAS pg8::bf16x8*)(wq + 1024), w1h = *(const LAS pg8::bf16x8*)(wq + 2048), w1l = *(const LAS pg8::bf16x8*)(wq + 3072);
            acc0 = __builtin_amdgcn_mfma_f32_16x16x32_bf16(ah, w0h, acc0, 0, 0, 0); acc1 = __builtin_amdgcn_mfma_f32_16x16x32_bf16(ah, w1h, acc1, 0, 0, 0);
            acc0 = __builtin_amdgcn_mfma_f32_16x16x32_bf16(ah, w0l, acc0, 0, 0, 0); acc1 = __builtin_amdgcn_mfma_f32_16x16x32_bf16(ah, w1l, acc1, 0, 0, 0);
            acc0 = __builtin_amdgcn_mfma_f32_16x16x32_bf16(al, w0h, acc0, 0, 0, 0); acc1 = __builtin_amdgcn_mfma_f32_16x16x32_bf16(al, w1h, acc1, 0, 0, 0);
        }
#pragma unroll
        for (int reg = 0; reg < 4; ++reg) {
            float v0 = acc0[reg] + rb0, v1 = acc1[reg] + rb1; float tv[4]; int ti[4];
#pragma unroll
            for (int k = 0; k < 4; ++k) { const bool f0 = v0 >= v1; float bv = f0 ? v0 : v1; int bi = f0 ? i : 16 + i;
#pragma unroll
                for (int mask = 1; mask < 16; mask <<= 1) { const float ov = __shfl_xor(bv, mask); const int oi = __shfl_xor(bi, mask); const bool take = ov > bv || (ov == bv && oi < bi); bv = take ? ov : bv; bi = take ? oi : bi; }
                tv[k] = bv; ti[k] = bi; if (bi == i) v0 = -INFINITY; if (bi == 16 + i) v1 = -INFINITY; }
            const float e1 = __expf(tv[1] - tv[0]), e2 = __expf(tv[2] - tv[0]), e3 = __expf(tv[3] - tv[0]); const float inv = 1.0f / (1.0f + e1 + e2 + e3);
            if (i == 0) { const size_t row = (size_t)(r0 + 4 * kk + reg); *(int4*)(TOPE + row * 4) = make_int4(ti[0], ti[1], ti[2], ti[3]); *(f32x4*)(TOPW + row * 4) = (f32x4){inv, e1 * inv, e2 * inv, e3 * inv};
                __hip_atomic_fetch_add(&hist[ti[0]], 1u, __ATOMIC_RELAXED, __HIP_MEMORY_SCOPE_WORKGROUP); __hip_atomic_fetch_add(&hist[ti[1]], 1u, __ATOMIC_RELAXED, __HIP_MEMORY_SCOPE_WORKGROUP);
                __hip_atomic_fetch_add(&hist[ti[2]], 1u, __ATOMIC_RELAXED, __HIP_MEMORY_SCOPE_WORKGROUP); __hip_atomic_fetch_add(&hist[ti[3]], 1u, __ATOMIC_RELAXED, __HIP_MEMORY_SCOPE_WORKGROUP); }
        }
        __syncthreads();
        if (tid < 32) CNTB[chk * 32 + tid] = hist[tid];
    }
    __syncthreads();
}
__device__ __forceinline__ void ph_attention(const Ctx& C) {
    const unsigned char* Q8 = WSP(unsigned char, WS_QP); const unsigned char* K8 = WSP(unsigned char, WS_KA); const unsigned char* V8T = WSP(unsigned char, WS_V8T); bf16* OA = WSP(bf16, WS_OAB);
    const float lam = *WSP(float, WS_LAM); const float* sg = INP(IX_SUBG);
    const float sbound = 0.20358f * sqrtf(__uint_as_float(WSP(unsigned, WS_CTL)[CW_NMAX]) * __uint_as_float(WSP(unsigned, WS_CTL)[CW_NMAX + 64]));
    const bool nomax = __builtin_amdgcn_readfirstlane((int)(sbound > 0.f && sbound <= 15.6f)) != 0;
    const bool xl = gridDim.x == 256;
#define ATT_UNITS(NM) for (int it = 0; it < (xl ? 4 : (NB * 4 * (SEQ / 128) + (int)gridDim.x - 1) / (int)gridDim.x); ++it) { \
        int u; \
        if (xl) { const int x = blockIdx.x & 7, j = blockIdx.x >> 3; u = ((4 * x + it) << 5) | j; } else { u = blockIdx.x + it * gridDim.x; if (u >= NB * 4 * (SEQ / 128)) break; } \
        const int qb = u & 31, h = (u >> 5) & 3, b = u >> 7; \
        const long q0 = ((long)b * SEQ + qb * 128) * 512 + h * 128, k0 = (long)b * SKV * 512 + h * 128, o0 = ((long)b * SEQ + qb * 128) * 1024 + h * 128, v0 = (long)(b * 4 + h) * (SKV / 64) * 8192; \
        __syncthreads(); \
        att::attn_diff_body8<NM>(Q8 + q0, K8 + k0, V8T + v0, OA + o0, SKV, C.ldsg, C.lds, lam, sg, 0.8f); }
    if (nomax) { ATT_UNITS(true) } else { ATT_UNITS(false) }
#undef ATT_UNITS
    __syncthreads();
}
enum { PH_PREP = 0, PH_MOD1, PH_INPROJ, PH_POST, PH_ATTN, PH_HYENA, PH_ATTNPOST, PH_MERGEUP, PH_WOUT, PH_ROUTER, PH_SORT, PH_MOE1, PH_MOE2, PH_COMBINE, N_PHASES };
struct Args { const float* in[N_INPUTS]; float* out; unsigned char* ws; int ph_lo, ph_hi, li, pad; };
static_assert(sizeof(Args) == N_INPUTS * 8 + 8 + 8 + 16, "Args has no padding");

#ifndef PG8_ALIGN
#define PG8_ALIGN true
#endif
namespace cg = cooperative_groups;
__global__ void __launch_bounds__(NTHREADS, 2) fwd(Args args) {
    cg::grid_group grid_g = cg::this_grid();
    extern __shared__ __attribute__((aligned(16))) unsigned char lds_raw[];
    Ctx C;
    C.out = args.out; C.ws = args.ws; C.lds = (LAS unsigned char*)lds_raw; C.ldsg = (char*)lds_raw;
    C.tid = threadIdx.x; C.lane = C.tid & 63; C.wave = __builtin_amdgcn_readfirstlane(C.tid >> 6);
    C.gwave = blockIdx.x * NWAVES + C.wave; C.nwaves = gridDim.x * NWAVES; C.gtid = blockIdx.x * NTHREADS + C.tid; C.gthreads = gridDim.x * NTHREADS;
    const int lo = args.ph_lo, hi = args.ph_hi;
    volatile LAS unsigned* MISC = (volatile LAS unsigned*)(C.lds + MISC_OFF);
    if (C.tid < 32) MISC[C.tid] = 0u;
    __syncthreads();
    unsigned* barw = (unsigned*)(C.ws + WS_CTL) + CW_BAR + args.li * XCD_BAR_WORDS;
    XcdBarrier xbar; xbar.bar = barw; xbar.x = 0; xbar.st = nullptr;
    if (hi - lo > 1) xbar = xcd_barrier_post(barw, MISC + 8);
#define IN(k) (lo <= (k) && (k) < hi)
#define SEAM(k) do { if (IN(k) && IN((k) + 1)) { if (args.li < 0) grid_g.sync(); else xcd_barrier(xbar); } } while (0)
    if (IN(PH_PREP)) { ph_prep_weights(C); __syncthreads(); ph_prep_ada(C); __syncthreads(); ph_prep_misc(C); ph_prep_filter(C); }
    SEAM(PH_PREP);
    if (IN(PH_MOD1)) { ph_modulate1(C); }
    SEAM(PH_MOD1);
    if (IN(PH_INPROJ)) {
        {
            LAS float* tb = (LAS float*)(C.lds + RING_BYTES + 20480);
            for (int i = C.tid; i < 1024; i += NTHREADS) { tb[i] = WSP(float, WS_ROPEC)[i]; tb[1024 + i] = WSP(float, WS_ROPES)[i]; }
            if (C.tid < 64) { tb[2048 + C.tid] = INP(IX_QNG)[C.tid]; tb[2048 + 64 + C.tid] = INP(IX_KNG)[C.tid]; }
            __syncthreads(); }
        {
            pg8::Gemm g{WSP(bf16, WS_XM), WSP(bf16, WS_WIN), T, 3072, DM, 0}; pg8::WinOrder S; S.so.init(T, 3072, gridDim.x, (int)blockIdx.x); S.pn0 = 0;
            pg8::EpiInProj E{WSP(bf16, WS_QP), WSP(bf16, WS_KA), WSP(bf16, WS_VA), WSP(bf16, WS_HY), WSP(bf16, WS_GT), INP(IX_BIN), C.lds, T, SKV, CTX, WSP(unsigned, WS_CTL) + CW_NMAX};
            pg8::gemm_phase<pg8::EpiInProj, pg8::WinOrder, PG8_ALIGN, true>(C.lds, g, S, E); }
        {
            pg8::Gemm g{WSP(bf16, WS_XM8), (const bf16*)(WSP(unsigned char, WS_WG8) - (size_t)12 * 256 * 1024), T, 2048, DM / 2, 0}; pg8::WinOrder S; S.so.init(T, 2048, gridDim.x, (int)blockIdx.x); S.pn0 = 12;
            pg8::EpiInProjT<true> E{WSP(bf16, WS_QP), WSP(bf16, WS_KA), WSP(bf16, WS_VA), WSP(bf16, WS_HY), WSP(bf16, WS_GT), INP(IX_BIN), C.lds, T, SKV, CTX, WSP(unsigned, WS_CTL) + CW_NMAX};
            pg8::gemm_phase<pg8::EpiInProjT<true>, pg8::WinOrder, PG8_ALIGN, true>(C.lds, g, S, E); }
    }
    SEAM(PH_INPROJ);
    if (IN(PH_POST)) {
        {
            LAS float* tb = (LAS float*)(C.lds + RING_BYTES + 20480);
            for (int i = C.tid; i < 1024; i += NTHREADS) { tb[i] = WSP(float, WS_ROPEC)[i]; tb[1024 + i] = WSP(float, WS_ROPES)[i]; }
            if (C.tid < 64) { tb[2048 + C.tid] = INP(IX_QNG)[C.tid]; tb[2048 + 64 + C.tid] = INP(IX_KNG)[C.tid]; }
            __syncthreads(); }
        { pg8::Gemm g{WSP(bf16, WS_XM), WSP(bf16, WS_WIN), MROWS, NIN, DM, 0}; pg8::CtxOrder S{(int)gridDim.x, (int)blockIdx.x};
          pg8::EpiInProj E{WSP(bf16, WS_QP), WSP(bf16, WS_KA), WSP(bf16, WS_VA), WSP(bf16, WS_HY), WSP(bf16, WS_GT), INP(IX_BIN), C.lds, T, SKV, CTX, WSP(unsigned, WS_CTL) + CW_NMAX};
          pg8::gemm_phase<pg8::EpiInProj, pg8::CtxOrder, true, true>(C.lds, g, S, E); }
        asm volatile("s_waitcnt vmcnt(0)" ::: "memory"); __syncthreads();
        if (gridDim.x >= 32 && blockIdx.x >= 16 && blockIdx.x < 32) ph_v8t_ctx(C, (int)blockIdx.x & 7, 2 * (((int)blockIdx.x >> 3) - 2));
        __syncthreads(); ph_hyena_pre8(C); ph_v8t(C); }
    SEAM(PH_POST);
    if (IN(PH_ATTN)) { ph_attention(C); }
    if (IN(PH_HYENA)) { ph_hyena_mfma8(C); }
    SEAM(PH_HYENA);
    if (IN(PH_ATTNPOST)) { ph_hyena_post(C); }
    SEAM(PH_ATTNPOST);
    if (IN(PH_MERGEUP)) {
        pg8::Gemm g{WSP(bf16, WS_OAB), WSP(bf16, WS_WA), T, DM, DM, 0}; pg8::StaticOrder S; S.init(T, DM, gridDim.x, (int)blockIdx.x);
        pg8::EpiMerge E{WSP(bf16, WS_MB), WSP(bf16, WS_GT)}; pg8::gemm_phase<pg8::EpiMerge, pg8::StaticOrder, PG8_ALIGN, true>(C.lds, g, S, E);
    }
    SEAM(PH_MERGEUP);
    if (IN(PH_WOUT)) {
        pg8::Gemm g{WSP(bf16, WS_MB), WSP(bf16, WS_WO), T, DM, DM, 0}; pg8::StaticOrder S; S.init(T, DM, gridDim.x, (int)blockIdx.x);
        pg8::EpiWout E{INP(IX_X), C.out, WSP(float, WS_MOD), WSP(float, WS_SSQ)}; pg8::gemm_phase<pg8::EpiWout, pg8::StaticOrder, PG8_ALIGN, true>(C.lds, g, S, E);
    }
    SEAM(PH_WOUT);
    if (IN(PH_ROUTER)) { ph_router3(C); }
    SEAM(PH_ROUTER);
    if (IN(PH_SORT)) { ph_sort2(C); }
    SEAM(PH_SORT);
    if (IN(PH_MOE1)) {
        const int nblk = WSP(int, WS_BLKE)[NBLK];
        pg8::MoeGatherOrder S; S.so.init(nblk * 256, 2048, gridDim.x, (int)blockIdx.x); S.blke = WSP(int, WS_BLKE); S.tokl = (const LAS unsigned short*)(C.lds + LDS_GS);
        {
            LAS unsigned short* tl = (LAS unsigned short*)(C.lds + LDS_GS); const int* ROWTOK = WSP(int, WS_ROWTOK); pg8::Unit uu;
            LAS int* pml = (LAS int*)(C.lds + LDS_GS + 10240);
            if (C.tid == 0) { for (int ui = 0; ui < 20; ++ui) pml[ui] = S.so.next(ui, uu) ? uu.pm : -1; }
            __syncthreads();
#define TL_LD(u) const int pm##u = pml[u]; int tv##u = 0; if (pm##u >= 0 && C.tid < 256) tv##u = ROWTOK[pm##u * 256 + C.tid];
#define TL_ST(u) if (C.tid < 256) tl[(u) * 256 + C.tid] = (unsigned short)tv##u;
            TL_LD(0) TL_LD(1) TL_LD(2) TL_LD(3) TL_LD(4) TL_LD(5) TL_LD(6) TL_LD(7) TL_LD(8) TL_LD(9) TL_LD(10) TL_LD(11) TL_LD(12) TL_LD(13) TL_LD(14) TL_LD(15) TL_LD(16) TL_LD(17) TL_LD(18) TL_LD(19)
            TL_ST(0) TL_ST(1) TL_ST(2) TL_ST(3) TL_ST(4) TL_ST(5) TL_ST(6) TL_ST(7) TL_ST(8) TL_ST(9) TL_ST(10) TL_ST(11) TL_ST(12) TL_ST(13) TL_ST(14) TL_ST(15) TL_ST(16) TL_ST(17) TL_ST(18) TL_ST(19)
#undef TL_LD
#undef TL_ST
        }
        __syncthreads();
        pg8::Gemm g{WSP(bf16, WS_H), WSP(bf16, WS_W1), nblk * 256, 2048, DM / 2, (size_t)2048 * 1024};
        pg8::EpiSwiglu E{WSP(unsigned char, WS_ACT), INP(IX_EB1), C.lds}; pg8::gemm_phase<pg8::EpiSwiglu, pg8::MoeGatherOrder, PG8_ALIGN, true>(C.lds, g, S, E);
    }
    SEAM(PH_MOE1);
    if (IN(PH_MOE2)) {
        const int nblk = WSP(int, WS_BLKE)[NBLK];
        pg8::Gemm g{WSP(bf16, WS_ACT), WSP(bf16, WS_W2), nblk * 256, DM, DM / 2, (size_t)1024 * 1024}; pg8::MoeOrder S; S.so.init(nblk * 256, DM, gridDim.x, (int)blockIdx.x); S.blke = WSP(int, WS_BLKE);
        pg8::EpiY E{WSP(unsigned char, WS_Y), INP(IX_EB2), WSP(float, WS_ROWW), C.lds}; pg8::gemm_phase<pg8::EpiY, pg8::MoeOrder, PG8_ALIGN, true>(C.lds, g, S, E);
    }
    SEAM(PH_MOE2);
    if (IN(PH_COMBINE)) { ph_combine(C); }
#undef IN
#undef SEAM
}

extern "C" void kernel_launch(void* const* d_in, const int* in_sizes, int n_in, void* d_out, int out_size, void* d_ws, size_t ws_size, hipStream_t stream) {
    static int grid = 0;
    if (grid == 0) {
        if (n_in != N_INPUTS || in_sizes[0] != T * DM || out_size != T * DM || ws_size < WS_END) { fprintf(stderr, "kernel_launch: unexpected shapes n_in %d in0 %d out %d ws %zu (need %zu)\n", n_in, n_in > 0 ? in_sizes[0] : -1, out_size, ws_size, (size_t)WS_END); grid = -1; return; }
        int dev = 0, cus = 0;
        if (hipGetDevice(&dev) != hipSuccess || hipDeviceGetAttribute(&cus, hipDeviceAttributeMultiprocessorCount, dev) != hipSuccess) { grid = -1; return; }
        if (hipFuncSetAttribute((const void*)fwd, hipFuncAttributeMaxDynamicSharedMemorySize, LDS_BYTES) != hipSuccess) { fprintf(stderr, "kernel_launch: hipFuncSetAttribute failed\n"); grid = -1; return; }
        int per_cu = 0;
        if (hipOccupancyMaxActiveBlocksPerMultiprocessor(&per_cu, (const void*)fwd, NTHREADS, LDS_BYTES) != hipSuccess || per_cu < 1) { fprintf(stderr, "kernel_launch: occupancy query says %d blocks per CU\n", per_cu); grid = -1; return; }
        grid = cus;
    }
    if (grid < 0) return;
    (void)hipMemsetAsync((char*)d_ws + WS_CTL, 0, CTL_BYTES, stream);
    Args a{};
    for (int i = 0; i < N_INPUTS; ++i) a.in[i] = (const float*)d_in[i];
    a.out = (float*)d_out; a.ws = (unsigned char*)d_ws;
#ifndef PROBE_DUP
#define PROBE_DUP -1
#endif
    int cuts[5] = {0, N_PHASES, N_PHASES, N_PHASES, N_PHASES}, nl = 1;
    if (PROBE_DUP >= 0) { cuts[1] = PROBE_DUP + 1; cuts[2] = PROBE_DUP; cuts[3] = PROBE_DUP + 1; nl = 4; }
    for (int li = 0; li < (PROBE_DUP >= 0 ? 3 : 1); ++li) {
        if (PROBE_DUP >= 0) { a.ph_lo = li == 0 ? 0 : (li == 1 ? PROBE_DUP : PROBE_DUP + 1); a.ph_hi = li == 2 ? N_PHASES : PROBE_DUP + 1; } else { a.ph_lo = 0; a.ph_hi = N_PHASES; }
        a.li = li; (void)cuts; (void)nl;
        if (a.ph_lo >= a.ph_hi) continue;
        void* kargs[] = {&a};
        const hipError_t le = hipLaunchCooperativeKernel((const void*)fwd, dim3(grid), dim3(NTHREADS), kargs, LDS_BYTES, stream);
        if (le != hipSuccess) fprintf(stderr, "kernel_launch: cooperative launch failed: %s (grid %d)\n", hipGetErrorString(le), grid);
    }
}
```

```cpp
#include <hip/hip_runtime.h>
#include <hip/hip_bf16.h>
#include <hip/hip_cooperative_groups.h>
#include <cstdio>
#include <cstdint>
#include <cmath>
namespace pg8 {
#define PG8_LAS __attribute__((address_space(3)))
typedef unsigned short bf16_t;
typedef short bf16x8 __attribute__((ext_vector_type(8)));
typedef float f32x4 __attribute__((ext_vector_type(4)));
typedef unsigned u32x4 __attribute__((ext_vector_type(4)));
typedef int v4i_t __attribute__((ext_vector_type(4)));
typedef int v8i_t __attribute__((ext_vector_type(8)));
constexpr int EPI_OFF = 131072 + 16384;
constexpr int BM = 256, BK = 64, HALF = 128, HTB = HALF * BK * 2  , STAGE_BYTES = 8 * HTB, NXCD = 8, WGM = 8;

__host__ __device__ __forceinline__ int lds_byte(int r, int c) { const int st = (r >> 4) * 2 + (c >> 5), rr = r & 15, cc = c & 31, ob = rr * 64 + cc * 2; return st * 1024 + (ob ^ (((ob >> 9) & 1) << 5)); }
__host__ __device__ __forceinline__ void stage_rc(int b, int& R, int& C) { const int st = b / 1024, sb = b % 1024, swz = sb ^ (((sb >> 9) & 1) << 5); R = (st >> 1) * 16 + swz / 64; C = (st & 1) * 32 + (swz % 64) / 2; }
__host__ __device__ __forceinline__ int perm32(int rho) { const int n = rho >> 4, i = rho & 15; return 8 * (i >> 2) + 4 * n + (i & 3); }

struct Unit { int pm, pn, be, es; };
struct Gemm { const bf16_t* A; const bf16_t* Bt; int M, N, K; size_t bstride; };

struct StaticOrder {
    static constexpr bool GATHER = false;
    int nM, nN, nwg, G, c;
    __host__ __device__ __forceinline__ void init(int M, int N, int G_, int c_) { nM = M / BM; nN = N / BM; nwg = nM * nN; G = G_; c = c_; }
    __host__ __device__ __forceinline__ bool next(int i, Unit& u) const {
        const long L = (long)i * G + c; if (L >= nwg) return false;
        int wgid = (int)L; { const int q = nwg / NXCD, r = nwg % NXCD, xcd = wgid % NXCD, off = wgid / NXCD; wgid = (xcd < r ? xcd * (q + 1) : r * (q + 1) + (xcd - r) * q) + off; }
        const int nig = WGM * nN, gid = wgid / nig, fm = gid * WGM, gsz = (nM - fm) < WGM ? (nM - fm) : WGM;
        u.pm = fm + ((wgid % nig) % gsz); u.pn = (wgid % nig) / gsz; u.be = 0; u.es = 0; return true;
    }
    __device__ __forceinline__ void a_ready(const Unit&) const {}
    __device__ __forceinline__ void done(const Unit&) const {}
};

__device__ __forceinline__ unsigned cvt_pk_bf16(float lo, float hi) { unsigned r; asm volatile("v_cvt_pk_bf16_f32 %0, %1, %2" : "=v"(r) : "v"(lo), "v"(hi)); return r; }
typedef float f32x2 __attribute__((ext_vector_type(2)));
__device__ __forceinline__ f32x2 gelu_pk(f32x2 v) {
    const f32x2 av = __builtin_elementwise_abs(v), d = av * 0.2316418882f + 1.0f;
    f32x2 t; t.x = __builtin_amdgcn_rcpf(d.x); t.y = __builtin_amdgcn_rcpf(d.y);
    f32x2 q = t * 0.5307027145f + (-0.7265760135f); q = q * t + 0.7107068705f; q = q * t + (-0.142248368f); q = q * t + 0.127414796f; q = q * t;
    const f32x2 s = (v * v) * (-0.72134752044f);
    f32x2 e; e.x = __builtin_amdgcn_exp2f(s.x); e.y = __builtin_amdgcn_exp2f(s.y);
    const f32x2 m = v * (q * e), r = v - m;
    f32x2 o; o.x = v.x < 0.f ? m.x : r.x; o.y = v.y < 0.f ? m.y : r.y; return o;
}

template <int ACT  > struct EpiBf16 {
    static constexpr bool PERM = true, AFTER_DRAIN = false, HAS_MID = false, F8 = false, PREFETCH = false; static constexpr int WSCALE = 0x7F7F7F7F; static_assert(ACT == 0 || ACT == 1, "EpiBf16: ACT is 0 (none) or 1 (gelu_pk)");
    bf16_t* O; int ldc; const float* bias; int split_cols; size_t split_stride; float scale0;
    __device__ __forceinline__ void operator()(const f32x4 (&acc)[2][2][4][2], const Unit& u, int wr, int wc, int fr, int fq) const {
        const int row0 = u.pm * BM + wr * 64 + fr; int colt = u.pn * BM; bf16_t* base = O;
        float sc = 1.f; if (split_cols) { const int t = colt / split_cols; base += (size_t)t * split_stride; colt -= t * split_cols; if (t == 0) sc = scale0; }
        const int col0 = colt + wc * 32 + 8 * fq, bcol0 = u.pn * BM + wc * 32 + 8 * fq;
        f32x4 bv[2][2];
#pragma unroll
        for (int bj = 0; bj < 2; ++bj)
#pragma unroll
            for (int n = 0; n < 2; ++n) bv[bj][n] = bias ? *(const f32x4*)(bias + bcol0 + bj * HALF + 4 * n) : (f32x4){0.f, 0.f, 0.f, 0.f};
#pragma unroll
        for (int ai = 0; ai < 2; ++ai)
#pragma unroll
            for (int m = 0; m < 4; ++m) { bf16_t* rowp = base + (size_t)(row0 + ai * HALF + m * 16) * ldc + col0;
#pragma unroll
                for (int bj = 0; bj < 2; ++bj) { f32x4 v0 = acc[ai][bj][m][0] + bv[bj][0], v1 = acc[ai][bj][m][1] + bv[bj][1];
                    if (ACT == 1) { f32x2 a = gelu_pk((f32x2){v0[0], v0[1]}), b = gelu_pk((f32x2){v0[2], v0[3]}), c = gelu_pk((f32x2){v1[0], v1[1]}), d = gelu_pk((f32x2){v1[2], v1[3]});
                        v0 = (f32x4){a.x, a.y, b.x, b.y}; v1 = (f32x4){c.x, c.y, d.x, d.y}; }
                    v0 = v0 * sc; v1 = v1 * sc; u32x4 w; w.x = cvt_pk_bf16(v0[0], v0[1]); w.y = cvt_pk_bf16(v0[2], v0[3]); w.z = cvt_pk_bf16(v1[0], v1[1]); w.w = cvt_pk_bf16(v1[2], v1[3]);
                    *(u32x4*)(rowp + bj * HALF) = w; } }
    }
};
struct EpiF32 {
    static constexpr bool PERM = false, AFTER_DRAIN = false, HAS_MID = false, F8 = false, PREFETCH = false; static constexpr int WSCALE = 0x7F7F7F7F;
    float* C; int ldc; const float* bias;
    __device__ __forceinline__ void operator()(const f32x4 (&acc)[2][2][4][2], const Unit& u, int wr, int wc, int fr, int fq) const {
        const int row0 = u.pm * BM + wr * 64 + fr, col0 = u.pn * BM + wc * 32 + 4 * fq;
        f32x4 bv[2][2];
#pragma unroll
        for (int bj = 0; bj < 2; ++bj)
#pragma unroll
            for (int n = 0; n < 2; ++n) bv[bj][n] = bias ? *(const f32x4*)(bias + col0 + bj * HALF + n * 16) : (f32x4){0.f, 0.f, 0.f, 0.f};
#pragma unroll
        for (int ai = 0; ai < 2; ++ai)
#pragma unroll
            for (int m = 0; m < 4; ++m) { float* rowp = C + (size_t)(row0 + ai * HALF + m * 16) * ldc + col0;
#pragma unroll
                for (int bj = 0; bj < 2; ++bj)
#pragma unroll
                    for (int n = 0; n < 2; ++n) *(f32x4*)(rowp + bj * HALF + n * 16) = acc[ai][bj][m][n] + bv[bj][n]; }
    }
};
__device__ __forceinline__ void epi_dma(const void* src, PG8_LAS unsigned char* dst) { __builtin_amdgcn_global_load_lds((const unsigned*)src, (PG8_LAS unsigned*)dst, 16, 0, 0); }
__device__ __forceinline__ unsigned pk4_fp8(float a, float b, float c, float d) {
    a = __builtin_fminf(__builtin_fmaxf(a, -448.f), 448.f); b = __builtin_fminf(__builtin_fmaxf(b, -448.f), 448.f); c = __builtin_fminf(__builtin_fmaxf(c, -448.f), 448.f); d = __builtin_fminf(__builtin_fmaxf(d, -448.f), 448.f);
    int w = 0; w = __builtin_amdgcn_cvt_pk_fp8_f32(a, b, w, false); w = __builtin_amdgcn_cvt_pk_fp8_f32(c, d, w, true); return (unsigned)w; }
struct EpiSwiglu {
    static constexpr bool PERM = true, AFTER_DRAIN = false, HAS_MID = false, F8 = true, PREFETCH = true; static constexpr int WSCALE = 0x7A7A7A7A;
    unsigned char* O; const float* b1; PG8_LAS unsigned char* el;
    __device__ __forceinline__ void prefetch(const Unit& u, int slot, int wid, int lane) const {
        if (wid == 0) epi_dma(b1 + (size_t)u.be * 2048 + (lane >> 5) * 1024 + u.pn * HALF + (lane & 31) * 4, el + EPI_OFF + slot * 2048); }
    __device__ __forceinline__ void operator()(const f32x4 (&acc)[2][2][4][2], const Unit& u, int wr, int wc, int fr, int fq) const {
        const int row0 = u.pm * BM + wr * 64 + fr; const int ch0 = u.pn * HALF + wc * 32 + 8 * fq;
        const PG8_LAS float* bb = (const PG8_LAS float*)(el + EPI_OFF + u.es * 2048) + wc * 32 + 8 * fq;
        f32x4 bg[2], bu[2];
#pragma unroll
        for (int n = 0; n < 2; ++n) { bg[n] = *(const PG8_LAS f32x4*)(bb + 4 * n); bu[n] = *(const PG8_LAS f32x4*)(bb + 128 + 4 * n); }
#pragma unroll
        for (int ai = 0; ai < 2; ++ai)
#pragma unroll
            for (int m = 0; m < 4; ++m) { unsigned char* rowp = O + (size_t)(row0 + ai * HALF + m * 16) * 1024 + ch0;
                f32x4 a[2];
#pragma unroll
                for (int n = 0; n < 2; ++n) { const f32x4 g = acc[ai][0][m][n] + bg[n], up = acc[ai][1][m][n] + bu[n];
#pragma unroll
                    for (int e = 0; e < 4; ++e) { const float gg = fminf(g[e], 7.0f), uu = fminf(fmaxf(up[e], -7.0f), 7.0f);
                        const float sg = __builtin_amdgcn_rcpf(1.0f + __builtin_amdgcn_exp2f(-1.702f * 1.4426950408889634f * gg));
                        a[n][e] = (uu + 1.0f) * gg * sg; } }
                *(unsigned long long*)rowp = (unsigned long long)pk4_fp8(a[0][0], a[0][1], a[0][2], a[0][3]) | ((unsigned long long)pk4_fp8(a[1][0], a[1][1], a[1][2], a[1][3]) << 32); }
    }
};
struct EpiY {
    static constexpr bool PERM = true, AFTER_DRAIN = false, HAS_MID = false, F8 = true; static constexpr int WSCALE = 0x7A7A7A7A;
    unsigned char* O; const float* b2; const float* roww; PG8_LAS unsigned char* el;
    static constexpr bool PREFETCH = true;
    __device__ __forceinline__ void prefetch(const Unit& u, int slot, int wid, int lane) const {
        if (wid == 0) epi_dma(b2 + (size_t)u.be * 1024 + u.pn * BM + lane * 4, el + EPI_OFF + slot * 2048);
        if (wid == 1) epi_dma(roww + (size_t)u.pm * BM + lane * 4, el + EPI_OFF + slot * 2048 + 1024); }
    __device__ __forceinline__ void operator()(const f32x4 (&acc)[2][2][4][2], const Unit& u, int wr, int wc, int fr, int fq) const {
        const int row0 = u.pm * BM + wr * 64 + fr; const int col0 = u.pn * BM + wc * 32 + 8 * fq;
        const PG8_LAS float* sl = (const PG8_LAS float*)(el + EPI_OFF + u.es * 2048); const PG8_LAS float* bb = sl + wc * 32 + 8 * fq;
        f32x4 bv[2][2];
#pragma unroll
        for (int bj = 0; bj < 2; ++bj)
#pragma unroll
            for (int n = 0; n < 2; ++n) bv[bj][n] = *(const PG8_LAS f32x4*)(bb + bj * HALF + 4 * n);
#pragma unroll
        for (int ai = 0; ai < 2; ++ai)
#pragma unroll
            for (int m = 0; m < 4; ++m) { const int row = row0 + ai * HALF + m * 16; const float rw = sl[256 + ai * HALF + wr * 64 + m * 16 + fr] * 16.0f; unsigned char* rowp = O + (size_t)row * 1024 + col0;
#pragma unroll
                for (int bj = 0; bj < 2; ++bj) { const f32x4 v0 = (acc[ai][bj][m][0] + bv[bj][0]) * rw, v1 = (acc[ai][bj][m][1] + bv[bj][1]) * rw;
                    *(unsigned long long*)(rowp + bj * HALF) = (unsigned long long)pk4_fp8(v0[0], v0[1], v0[2], v0[3]) | ((unsigned long long)pk4_fp8(v1[0], v1[1], v1[2], v1[3]) << 32); } }
    }
};
struct MoeOrder {
    static constexpr bool GATHER = false;
    StaticOrder so; const int* blke;
    __device__ __forceinline__ bool next(int i, Unit& u) const { if (!so.next(i, u)) return false; u.be = blke[u.pm]; return true; }
    __device__ __forceinline__ void a_ready(const Unit&) const {}
    __device__ __forceinline__ void done(const Unit&) const {}
};
__device__ __forceinline__ void st_bf16x4(bf16_t* p, const f32x4& v) { *(unsigned long long*)p = (unsigned long long)cvt_pk_bf16(v[0], v[1]) | ((unsigned long long)cvt_pk_bf16(v[2], v[3]) << 32); }
template <bool F8_> struct EpiInProjT {
    static constexpr bool PERM = false, AFTER_DRAIN = false, HAS_MID = false, F8 = F8_, PREFETCH = true; static constexpr int WSCALE = F8_ ? 0x7A7A7A7A : 0x7F7F7F7F;
    bf16_t *QP, *KA, *VA, *HY, *GT; const float* bias; PG8_LAS unsigned char* el; int T_, SKV_, CTX_; unsigned* nmax;
    static constexpr int TAB_OFF = 131072 + 20480;
    __device__ __forceinline__ void prefetch(const Unit& u, int slot, int wid, int lane) const { if (wid == 0) epi_dma(bias + 256 * u.pn + lane * 4, el + EPI_OFF + slot * 2048); }
    __device__ __forceinline__ void operator()(const f32x4 (&acc)[2][2][4][2], const Unit& u, int wr, int wc, int fr_, int fq_) const {
        int fr = fr_, fq = fq_; asm volatile("" : "+v"(fr), "+v"(fq));
        const int pn = u.pn;
        if (pn < 4) {
            const bool isk = pn >= 2; const PG8_LAS float* g = (const PG8_LAS float*)(el + TAB_OFF + 8192 + (isk ? 256 : 0)); const PG8_LAS float* bsl = (const PG8_LAS float*)(el + EPI_OFF + u.es * 2048);
            const PG8_LAS float* rc = (const PG8_LAS float*)(el + TAB_OFF); const PG8_LAS float* rs = rc + 1024;
            f32x4 bv[2][2], gv[2][2];
#pragma unroll
            for (int bj = 0; bj < 2; ++bj)
#pragma unroll
                for (int n = 0; n < 2; ++n) { bv[bj][n] = *(const PG8_LAS f32x4*)(bsl + 64 * wc + 32 * bj + 16 * n + 4 * fq); gv[bj][n] = *(const PG8_LAS f32x4*)(g + 32 * bj + 16 * n + 4 * fq); }
            float nrm2 = 0.f;
#pragma unroll
            for (int ai = 0; ai < 2; ++ai)
#pragma unroll
                for (int m = 0; m < 4; ++m) { const int r = u.pm * BM + ai * HALF + wr * 64 + m * 16 + fr;
                    f32x4 x[2][2]; float ss = 0.f;
#pragma unroll
                    for (int bj = 0; bj < 2; ++bj)
#pragma unroll
                        for (int n = 0; n < 2; ++n) { x[bj][n] = acc[ai][bj][m][n] + bv[bj][n]; ss += (x[bj][n][0] * x[bj][n][0] + x[bj][n][1] * x[bj][n][1]) + (x[bj][n][2] * x[bj][n][2] + x[bj][n][3] * x[bj][n][3]); }
                    ss += __shfl_xor(ss, 16); ss += __shfl_xor(ss, 32);
                    const float rstd = rsqrtf(ss * (1.0f / 64.0f) + 1e-6f);
#pragma unroll
                    for (int bj = 0; bj < 2; ++bj)
#pragma unroll
                        for (int n = 0; n < 2; ++n) x[bj][n] = x[bj][n] * rstd * gv[bj][n];
                    { float s2 = 0.f;
#pragma unroll
                      for (int bj = 0; bj < 2; ++bj)
#pragma unroll
                        for (int n = 0; n < 2; ++n) s2 += (x[bj][n][0] * x[bj][n][0] + x[bj][n][1] * x[bj][n][1]) + (x[bj][n][2] * x[bj][n][2] + x[bj][n][3] * x[bj][n][3]);
                      s2 += __shfl_xor(s2, 16); s2 += __shfl_xor(s2, 32); nrm2 = fmaxf(nrm2, s2); }
                    const bool latent = r < T_; const int t = r & 4095;
                    if (latent) {
#pragma unroll
                        for (int bj = 0; bj < 2; ++bj) { const int pos = bj ? (t & 63) : (t >> 6); const f32x4 cs = *(const PG8_LAS f32x4*)(rc + pos * 16 + 4 * fq), sn = *(const PG8_LAS f32x4*)(rs + pos * 16 + 4 * fq);
                            const f32x4 x1 = x[bj][0], x2 = x[bj][1]; x[bj][0] = x1 * cs - x2 * sn; x[bj][1] = x2 * cs + x1 * sn; } }
                    if (!isk) { unsigned char* base = (unsigned char*)QP + (size_t)r * 512 + 256 * (pn & 1) + 64 * wc;
#pragma unroll
                        for (int bj = 0; bj < 2; ++bj)
#pragma unroll
                            for (int n = 0; n < 2; ++n) { const f32x4 v = x[bj][n] * 0.72134752044448170f; *(unsigned*)(base + 32 * bj + 16 * n + 4 * fq) = pk4_fp8(v[0], v[1], v[2], v[3]); } }
                    else { const size_t krow = latent ? (size_t)(r >> 12) * SKV_ + CTX_ + t : (size_t)((r - T_) >> 8) * SKV_ + ((r - T_) & 255); unsigned char* base = (unsigned char*)KA + krow * 512 + 256 * (pn & 1) + 64 * wc;
#pragma unroll
                        for (int bj = 0; bj < 2; ++bj)
#pragma unroll
                            for (int n = 0; n < 2; ++n) { const f32x4 v = x[bj][n]; *(unsigned*)(base + 32 * bj + 16 * n + 4 * fq) = pk4_fp8(v[0], v[1], v[2], v[3]); } }
                }
            nrm2 = fmaxf(nrm2, __shfl_xor(nrm2, 1)); nrm2 = fmaxf(nrm2, __shfl_xor(nrm2, 2)); nrm2 = fmaxf(nrm2, __shfl_xor(nrm2, 4)); nrm2 = fmaxf(nrm2, __shfl_xor(nrm2, 8));
            if (fr == 0 && fq == 0) (void)__hip_atomic_fetch_max(nmax + (isk ? 64 : 0), __float_as_uint(nrm2), __ATOMIC_RELAXED, __HIP_MEMORY_SCOPE_AGENT);
        } else {
            const int kind = pn < 6 ? 0 : (pn < 12 ? 1 : 2);
            const int lc0 = 32 * wc + 8 * fq;
            f32x4 bv[2][2];
#pragma unroll
            for (int bj = 0; bj < 2; ++bj)
#pragma unroll
                for (int n = 0; n < 2; ++n) bv[bj][n] = *(const PG8_LAS f32x4*)((const PG8_LAS float*)(el + EPI_OFF + u.es * 2048) + 128 * bj + lc0 + 4 * n);
#pragma unroll
            for (int ai = 0; ai < 2; ++ai)
#pragma unroll
                for (int m = 0; m < 4; ++m) { const int r = u.pm * BM + ai * HALF + wr * 64 + m * 16 + fr;
                    bf16_t* rowp;
                    if (kind == 0) { const size_t vrow = r < T_ ? (size_t)(r >> 12) * SKV_ + CTX_ + (r & 4095) : (size_t)((r - T_) >> 8) * SKV_ + ((r - T_) & 255); rowp = VA + vrow * 512 + 256 * (pn - 4) + lc0; }
                    else if (kind == 1) rowp = HY + (size_t)r * 1536 + 256 * (pn - 6) + lc0;
                    else rowp = GT + (size_t)r * 2048 + 256 * (pn - 12) + lc0;
#pragma unroll
                    for (int bj = 0; bj < 2; ++bj) { f32x4 v0 = acc[ai][bj][m][0] + bv[bj][0], v1 = acc[ai][bj][m][1] + bv[bj][1];
                        if (kind == 2) {
#pragma unroll
                            for (int e = 0; e < 4; ++e) { v0[e] = __builtin_amdgcn_rcpf(1.0f + __builtin_amdgcn_exp2f(-1.4426950408889634f * v0[e])); v1[e] = __builtin_amdgcn_rcpf(1.0f + __builtin_amdgcn_exp2f(-1.4426950408889634f * v1[e])); } }
                        u32x4 w; w.x = cvt_pk_bf16(v0[0], v0[1]); w.y = cvt_pk_bf16(v0[2], v0[3]); w.z = cvt_pk_bf16(v1[0], v1[1]); w.w = cvt_pk_bf16(v1[2], v1[3]);
                        *(u32x4*)(rowp + bj * HALF) = w; } }
        }
    }
};
typedef EpiInProjT<false> EpiInProj;
struct WinOrder {
    static constexpr bool GATHER = false;
    StaticOrder so; int pn0;
    __device__ __forceinline__ bool next(int i, Unit& u) const { if (!so.next(i, u)) return false; u.pn += pn0; return true; }
    __device__ __forceinline__ void a_ready(const Unit&) const {}
    __device__ __forceinline__ void done(const Unit&) const {}
};
struct CtxOrder {
    static constexpr bool GATHER = false;
    int G, c;
    __device__ __forceinline__ bool next(int i, Unit& u) const { const int L = i * G + c; if (L >= 32) return false; u.pm = 128 + (L & 7); u.pn = 2 + (L >> 3); u.be = 0; u.es = 0; return true; }
    __device__ __forceinline__ void a_ready(const Unit&) const {}
    __device__ __forceinline__ void done(const Unit&) const {}
};

__device__ __forceinline__ float bf_lo(unsigned d) { return __builtin_bit_cast(float, d << 16); }
__device__ __forceinline__ float bf_hi(unsigned d) { return __builtin_bit_cast(float, d & 0xffff0000u); }
struct EpiMerge {
    static constexpr bool PERM = true, AFTER_DRAIN = false, HAS_MID = true, F8 = false, PREFETCH = false; static constexpr int WSCALE = 0x7F7F7F7F;
    bf16_t* O; const bf16_t* GT;
    __device__ __forceinline__ void mid(f32x4 (&acc)[2][2][4][2], const Unit& u, int wr, int wc, int fr_, int fq_) const {
        int fr = fr_, fq = fq_; asm volatile("" : "+v"(fr), "+v"(fq));
        const bf16_t* __restrict__ G = GT;
        const int row0 = u.pm * BM + wr * 64 + fr, col0 = u.pn * BM + wc * 32 + 8 * fq;
#pragma unroll
        for (int ai = 0; ai < 2; ++ai)
#pragma unroll
            for (int mp = 0; mp < 2; ++mp) { u32x4 ga[2][2], gb[2][2];
#pragma unroll
                for (int q = 0; q < 2; ++q) { const bf16_t* gp = G + (size_t)(row0 + ai * HALF + (2 * mp + q) * 16) * 2048 + col0;
#pragma unroll
                    for (int bj = 0; bj < 2; ++bj) { ga[q][bj] = *(const u32x4*)(gp + bj * HALF); gb[q][bj] = *(const u32x4*)(gp + 1024 + bj * HALF); } }
#pragma unroll
                for (int q = 0; q < 2; ++q) { const int m = 2 * mp + q;
#pragma unroll
                    for (int bj = 0; bj < 2; ++bj) { const u32x4 a = ga[q][bj], b = gb[q][bj]; f32x4 r0, r1;
                        r0[0] = bf_lo(a.x) * __builtin_amdgcn_rcpf(bf_lo(b.x)); r0[1] = bf_hi(a.x) * __builtin_amdgcn_rcpf(bf_hi(b.x)); r0[2] = bf_lo(a.y) * __builtin_amdgcn_rcpf(bf_lo(b.y)); r0[3] = bf_hi(a.y) * __builtin_amdgcn_rcpf(bf_hi(b.y));
                        r1[0] = bf_lo(a.z) * __builtin_amdgcn_rcpf(bf_lo(b.z)); r1[1] = bf_hi(a.z) * __builtin_amdgcn_rcpf(bf_hi(b.z)); r1[2] = bf_lo(a.w) * __builtin_amdgcn_rcpf(bf_lo(b.w)); r1[3] = bf_hi(a.w) * __builtin_amdgcn_rcpf(bf_hi(b.w));
                        acc[ai][bj][m][0] = acc[ai][bj][m][0] * r0; acc[ai][bj][m][1] = acc[ai][bj][m][1] * r1; } }
                asm volatile("" ::: "memory"); }
    }
    __device__ __forceinline__ void operator()(const f32x4 (&acc)[2][2][4][2], const Unit& u, int wr, int wc, int fr, int fq) const {
        const bf16_t* __restrict__ G = GT; bf16_t* __restrict__ Or = O;
        const int row0 = u.pm * BM + wr * 64 + fr, col0 = u.pn * BM + wc * 32 + 8 * fq;
#pragma unroll
        for (int ai = 0; ai < 2; ++ai) { u32x4 gb[4][2];
#pragma unroll
            for (int m = 0; m < 4; ++m)
#pragma unroll
                for (int bj = 0; bj < 2; ++bj) gb[m][bj] = *(const u32x4*)(G + (size_t)(row0 + ai * HALF + m * 16) * 2048 + 1024 + col0 + bj * HALF);
#pragma unroll
            for (int m = 0; m < 4; ++m) { bf16_t* rowp = Or + (size_t)(row0 + ai * HALF + m * 16) * 1024 + col0;
#pragma unroll
                for (int bj = 0; bj < 2; ++bj) { const u32x4 b = gb[m][bj]; const f32x4 v0 = acc[ai][bj][m][0], v1 = acc[ai][bj][m][1];
                    u32x4 w; w.x = cvt_pk_bf16(v0[0] * bf_lo(b.x), v0[1] * bf_hi(b.x)); w.y = cvt_pk_bf16(v0[2] * bf_lo(b.y), v0[3] * bf_hi(b.y));
                    w.z = cvt_pk_bf16(v1[0] * bf_lo(b.z), v1[1] * bf_hi(b.z)); w.w = cvt_pk_bf16(v1[2] * bf_lo(b.w), v1[3] * bf_hi(b.w));
                    *(u32x4*)(rowp + bj * HALF) = w; } } }
    }
};
struct EpiWout {
    static constexpr bool PERM = false, AFTER_DRAIN = false, HAS_MID = false, F8 = false, PREFETCH = false; static constexpr int WSCALE = 0x7F7F7F7F;
    const float* X; float* O; const float* MOD; float* SSQ;
    __device__ __forceinline__ void operator()(const f32x4 (&acc)[2][2][4][2], const Unit& u, int wr, int wc, int fr, int fq) const {
        const float* __restrict__ Xr = X; float* __restrict__ Or = O; float* __restrict__ Sr = SSQ;
        const int row0 = u.pm * BM + wr * 64 + fr, col0 = u.pn * BM + wc * 32 + 4 * fq;
        const float* g1p = MOD + (row0 >> 12) * 6144 + 2048 + col0;
        f32x4 g1[2][2];
#pragma unroll
        for (int bj = 0; bj < 2; ++bj)
#pragma unroll
            for (int n = 0; n < 2; ++n) g1[bj][n] = *(const f32x4*)(g1p + bj * HALF + n * 16);
#pragma unroll
        for (int ai = 0; ai < 2; ++ai)
#pragma unroll
            for (int mp = 0; mp < 2; ++mp) { f32x4 xv[2][2][2];
#pragma unroll
                for (int q = 0; q < 2; ++q) { const size_t off = (size_t)(row0 + ai * HALF + (2 * mp + q) * 16) * 1024 + col0;
#pragma unroll
                    for (int bj = 0; bj < 2; ++bj)
#pragma unroll
                        for (int n = 0; n < 2; ++n) xv[q][bj][n] = *(const f32x4*)(Xr + off + bj * HALF + n * 16); }
#pragma unroll
                for (int q = 0; q < 2; ++q) { const int m = 2 * mp + q; const int row = row0 + ai * HALF + m * 16; const size_t off = (size_t)row * 1024 + col0; float ss = 0.f;
#pragma unroll
                    for (int bj = 0; bj < 2; ++bj)
#pragma unroll
                        for (int n = 0; n < 2; ++n) { const f32x4 v = xv[q][bj][n] + g1[bj][n] * acc[ai][bj][m][n];
                            *(f32x4*)(Or + off + bj * HALF + n * 16) = v; ss += (v[0] * v[0] + v[1] * v[1]) + (v[2] * v[2] + v[3] * v[3]); }
                    ss += __shfl_xor(ss, 16); ss += __shfl_xor(ss, 32);
                    if (fq == 0) Sr[(size_t)row * 16 + u.pn * 4 + wc] = ss; } }
    }
};

struct MoeGatherOrder {
    static constexpr bool GATHER = true;
    StaticOrder so; const int* blke; const PG8_LAS unsigned short* tokl;
    __device__ __forceinline__ bool next(int i, Unit& u) const { if (!so.next(i, u)) return false; u.be = blke[u.pm]; return true; }
    __device__ __forceinline__ int gather_tok(int ui, int row) const { return (int)tokl[ui * 256 + row]; }
    __device__ __forceinline__ void a_ready(const Unit&) const {}
    __device__ __forceinline__ void done(const Unit&) const {}
};
template <bool F8> struct FragT { typedef bf16x8 A[4][2]; typedef bf16x8 B[2][2]; };
template <> struct FragT<true> { typedef v8i_t A[4]; typedef v8i_t B[2]; };
template <class Epi, class Sched, bool ALIGN_EPI = false, bool SP2 = false>
__device__ __forceinline__ void gemm_phase(PG8_LAS unsigned char* lds, const Gemm g, const Sched& S, const Epi& E) {
    const int tid = threadIdx.x, wid = __builtin_amdgcn_readfirstlane(tid >> 6), lane = tid & 63, wr = wid >> 2, wc = wid & 3, fr = lane & 15, fq = lane >> 4;
    const int K = g.K, nt = K / BK;
    unsigned voffA[2], voffB[2];
#pragma unroll
    for (int i = 0; i < 2; ++i) { int R, C; stage_rc(tid * 16 + i * 8192, R, C); const int Rb = Epi::PERM ? ((R & ~31) + perm32(R & 31)) : R;
        voffA[i] = (unsigned)(R * K + C) * 2u; voffB[i] = (unsigned)(Rb * K + C) * 2u; }
    const size_t kstep = (size_t)(BK * 2);
    const size_t hstep = (size_t)HALF * K * 2;
    const size_t tstep = 2 * hstep;
    const unsigned ldsw = (unsigned)wid * 1024u;
    const int aoff = lds_byte(wr * 64 + fr, fq * 8), boff = lds_byte(wc * 32 + fr, fq * 8);
    const int aoff8 = aoff, boff8 = boff;
#define PG8_SA(b, h) (((b) * 2 + (h)) * HTB)
#define PG8_SB(b, h) ((4 + (b) * 2 + (h)) * HTB)
#define PG8_STAGE(bufoff, gbase, voff) do { _Pragma("unroll") for (int _i = 0; _i < 2; ++_i) \
        __builtin_amdgcn_global_load_lds((const unsigned*)((const char*)(gbase) + (voff)[_i]), (PG8_LAS unsigned*)(lds + (bufoff) + ldsw + _i * 8192), 16, 0, 0); } while (0)
#define PG8_STAGE_A(bufoff, gbase, h, nx) do { if constexpr (Sched::GATHER) { unsigned gv_[2]; \
        if (nx) { _Pragma("unroll") for (int i_ = 0; i_ < 2; ++i_) { int R_, C_; stage_rc(tid * 16 + i_ * 8192, R_, C_); gv_[i_] = (unsigned)(S.gather_tok(ui + 1, 128 * (h) + R_) * K + C_) * 2u; } } \
        else { gv_[0] = cvA[h][0]; gv_[1] = cvA[h][1]; } \
        PG8_STAGE(bufoff, gbase, gv_); } \
        else { PG8_STAGE(bufoff, (gbase) + (h) * hstep, voffA); } } while (0)
#define PG8_LD32(off_) __builtin_shufflevector(__builtin_bit_cast(v4i_t, *(const PG8_LAS bf16x8*)(lds + (off_))), __builtin_bit_cast(v4i_t, *(const PG8_LAS bf16x8*)(lds + (off_) + 1024)), 0, 1, 2, 3, 4, 5, 6, 7)
#define PG8_LDA(dst, b, h) do { if constexpr (Epi::F8) { _Pragma("unroll") for (int m = 0; m < 4; ++m) dst[m] = PG8_LD32(PG8_SA(b, h) + aoff8 + m * 2048); } else { \
        _Pragma("unroll") for (int m = 0; m < 4; ++m) _Pragma("unroll") for (int k = 0; k < 2; ++k) dst[m][k] = *(const PG8_LAS bf16x8*)(lds + PG8_SA(b, h) + aoff + m * 2048 + k * 1024); } } while (0)
#define PG8_LDB(dst, b, h) do { if constexpr (Epi::F8) { _Pragma("unroll") for (int n = 0; n < 2; ++n) dst[n] = PG8_LD32(PG8_SB(b, h) + boff8 + n * 2048); } else { \
        _Pragma("unroll") for (int n = 0; n < 2; ++n) _Pragma("unroll") for (int k = 0; k < 2; ++k) dst[n][k] = *(const PG8_LAS bf16x8*)(lds + PG8_SB(b, h) + boff + n * 2048 + k * 1024); } } while (0)
#define PG8_MMA(ai, bj, At, Bt) do { __builtin_amdgcn_s_setprio(1); if constexpr (Epi::F8) { \
        _Pragma("unroll") for (int m = 0; m < 4; ++m) _Pragma("unroll") for (int n = 0; n < 2; ++n) \
            acc[ai][bj][m][n] = __builtin_amdgcn_mfma_scale_f32_16x16x128_f8f6f4(Bt[n], At[m], acc[ai][bj][m][n], 0, 0, 0, Epi::WSCALE, 0, 0x7F7F7F7F); \
        _Pragma("unroll") for (int m = 0; m < 4; ++m) _Pragma("unroll") for (int n = 0; n < 2; ++n) asm volatile("" : "+v"(acc[ai][bj][m][n])); } else { \
        _Pragma("unroll") for (int m = 0; m < 4; ++m) _Pragma("unroll") for (int n = 0; n < 2; ++n) _Pragma("unroll") for (int k = 0; k < 2; ++k) \
        acc[ai][bj][m][n] = __builtin_amdgcn_mfma_f32_16x16x32_bf16(Bt[n][k], At[m][k], acc[ai][bj][m][n], 0, 0, 0); } __builtin_amdgcn_s_setprio(0); } while (0)
#define PG8_WAIT_V(n) asm volatile("s_waitcnt vmcnt(" #n ")" ::: "memory")
#define PG8_WAIT_L(n) asm volatile("s_waitcnt lgkmcnt(" #n ")" ::: "memory")
#define PG8_BAR __builtin_amdgcn_s_barrier()
#define PG8_SCHED __builtin_amdgcn_sched_barrier(0)
    Unit cur, nxt; int ui = 0;
    if (!S.next(0, cur)) return;
    f32x4 acc[2][2][4][2];
#pragma unroll
    for (int a = 0; a < 2; ++a)
#pragma unroll
        for (int b = 0; b < 2; ++b)
#pragma unroll
            for (int m = 0; m < 4; ++m)
#pragma unroll
                for (int n = 0; n < 2; ++n) acc[a][b][m][n] = (f32x4){0.f, 0.f, 0.f, 0.f};
    typename FragT<Epi::F8>::A At; typename FragT<Epi::F8>::B B0, B1;
    const char* cA = (const char*)g.A + (Sched::GATHER ? (size_t)0 : (size_t)cur.pm * tstep);
    unsigned cvA[2][2];
    if constexpr (Sched::GATHER) {
#pragma unroll
        for (int h = 0; h < 2; ++h)
#pragma unroll
            for (int i = 0; i < 2; ++i) { int R, Cc; stage_rc(tid * 16 + i * 8192, R, Cc); cvA[h][i] = (unsigned)(S.gather_tok(0, 128 * h + R) * K + Cc) * 2u; } } const char* cB = (const char*)g.Bt + (size_t)cur.be * g.bstride + (size_t)cur.pn * tstep;
    S.a_ready(cur);
    if constexpr (Epi::PREFETCH) E.prefetch(cur, 0, wid, lane);
    if constexpr (SP2) {
        PG8_STAGE(PG8_SB(0, 0), cB, voffB); PG8_STAGE(PG8_SB(0, 1), cB + hstep, voffB); PG8_STAGE_A(PG8_SA(0, 0), cA, 0, false); PG8_STAGE_A(PG8_SA(0, 1), cA, 1, false);
        if (wr == 1) PG8_BAR;
        PG8_WAIT_V(2); PG8_BAR;
        PG8_STAGE(PG8_SB(1, 0), cB + kstep, voffB); PG8_STAGE_A(PG8_SA(1, 0), cA + kstep, 0, false); PG8_STAGE(PG8_SB(1, 1), cB + hstep + kstep, voffB);
        PG8_WAIT_V(6); PG8_BAR;
    } else {
        PG8_STAGE(PG8_SB(0, 0), cB, voffB); PG8_STAGE_A(PG8_SA(0, 0), cA, 0, false); PG8_STAGE(PG8_SB(0, 1), cB + hstep, voffB); PG8_STAGE_A(PG8_SA(0, 1), cA, 1, false);
        if (wr == 1) PG8_BAR;
        PG8_WAIT_V(4); PG8_BAR;
        PG8_STAGE(PG8_SB(1, 0), cB + kstep, voffB); PG8_STAGE_A(PG8_SA(1, 0), cA + kstep, 0, false); PG8_STAGE(PG8_SB(1, 1), cB + hstep + kstep, voffB);
        PG8_WAIT_V(6); PG8_BAR;
    }
    for (;;) {
        const bool has_next = S.next(ui + 1, nxt);
        const char* nA = (has_next && !Sched::GATHER) ? (const char*)g.A + (size_t)nxt.pm * tstep : cA;
 const char* nB = has_next ? (const char*)g.Bt + (size_t)nxt.be * g.bstride + (size_t)nxt.pn * tstep : cB;
        for (int t = 0; t < nt; t += 2) {
            const bool last = (t == nt - 2);
            const char* a1 = cA + (size_t)(t + 1) * kstep;
            const char* a2 = last ? nA : cA + (size_t)(t + 2) * kstep; const char* b2 = last ? nB : cB + (size_t)(t + 2) * kstep;
            const char* a3 = a2 + kstep; const char* b3 = b2 + kstep;
            if (last && has_next) S.a_ready(nxt);
            if constexpr (Epi::HAS_MID) { if (t == nt / 2) E.mid(acc, cur, wr, wc, fr, fq); }
            if constexpr (SP2) {
            PG8_LDB(B0, 0, 0); PG8_LDB(B1, 0, 1); PG8_SCHED; PG8_LDA(At, 0, 0); PG8_STAGE_A(PG8_SA(1, 1), a1, 1, false);
            PG8_WAIT_V(8); PG8_WAIT_L(0); PG8_BAR; PG8_MMA(0, 0, At, B0); PG8_MMA(0, 1, At, B1); PG8_BAR; PG8_SCHED;
            PG8_LDA(At, 0, 1); PG8_STAGE(PG8_SB(0, 0), b2, voffB); PG8_STAGE(PG8_SB(0, 1), b2 + hstep, voffB); PG8_STAGE_A(PG8_SA(0, 0), a2, 0, last && has_next);
            PG8_WAIT_V(8); PG8_WAIT_L(0); PG8_BAR; PG8_MMA(1, 0, At, B0); PG8_MMA(1, 1, At, B1); PG8_BAR; PG8_SCHED;
            PG8_LDB(B0, 1, 0); PG8_LDB(B1, 1, 1); PG8_SCHED; PG8_LDA(At, 1, 0); PG8_STAGE_A(PG8_SA(0, 1), a2, 1, last && has_next);
            PG8_WAIT_V(8); PG8_WAIT_L(0); PG8_BAR; PG8_MMA(0, 0, At, B0); PG8_MMA(0, 1, At, B1); PG8_BAR; PG8_SCHED;
            PG8_LDA(At, 1, 1); PG8_STAGE(PG8_SB(1, 0), b3, voffB); PG8_STAGE(PG8_SB(1, 1), b3 + hstep, voffB); PG8_STAGE_A(PG8_SA(1, 0), a3, 0, last && has_next);
            PG8_WAIT_V(8); PG8_WAIT_L(0); PG8_BAR; PG8_MMA(1, 0, At, B0); PG8_MMA(1, 1, At, B1); PG8_BAR; PG8_SCHED;
            } else {
            PG8_LDB(B0, 0, 0); PG8_SCHED; PG8_LDA(At, 0, 0); PG8_STAGE_A(PG8_SA(1, 1), a1, 1, false);
            PG8_WAIT_L(8); PG8_BAR; PG8_WAIT_L(0); PG8_MMA(0, 0, At, B0); PG8_BAR; PG8_SCHED;
            PG8_LDB(B1, 0, 1); PG8_STAGE(PG8_SB(0, 0), b2, voffB);
            PG8_BAR; PG8_WAIT_L(0); PG8_MMA(0, 1, At, B1); PG8_BAR;
            PG8_LDA(At, 0, 1); PG8_STAGE_A(PG8_SA(0, 0), a2, 0, last && has_next);
            PG8_BAR; PG8_WAIT_L(0); PG8_MMA(1, 0, At, B0); PG8_BAR; PG8_SCHED;
            PG8_STAGE(PG8_SB(0, 1), b2 + hstep, voffB);
            PG8_WAIT_V(6); PG8_BAR; PG8_MMA(1, 1, At, B1); PG8_BAR;
            PG8_LDB(B0, 1, 0); PG8_SCHED; PG8_LDA(At, 1, 0); PG8_STAGE_A(PG8_SA(0, 1), a2, 1, last && has_next);
            PG8_WAIT_L(8); PG8_BAR; PG8_WAIT_L(0); PG8_MMA(0, 0, At, B0); PG8_BAR; PG8_SCHED;
            PG8_LDB(B1, 1, 1); PG8_STAGE(PG8_SB(1, 0), b3, voffB);
            PG8_BAR; PG8_WAIT_L(0); PG8_MMA(0, 1, At, B1); PG8_BAR;
            PG8_LDA(At, 1, 1); PG8_STAGE_A(PG8_SA(1, 0), a3, 0, last && has_next);
            PG8_BAR; PG8_WAIT_L(0); PG8_MMA(1, 0, At, B0); PG8_BAR; PG8_SCHED;
            PG8_STAGE(PG8_SB(1, 1), b3 + hstep, voffB);
            PG8_WAIT_V(6); PG8_BAR; PG8_MMA(1, 1, At, B1); PG8_BAR;
            }
        }
        if constexpr (ALIGN_EPI) { if (wr == 0) PG8_BAR; }
        if constexpr (!Epi::AFTER_DRAIN) { cur.es = ui & 1; E(acc, cur, wr, wc, fr, fq); S.done(cur); }
        if (!has_next) break;
        if constexpr (Epi::PREFETCH) E.prefetch(nxt, (ui + 1) & 1, wid, lane);
#pragma unroll
        for (int a = 0; a < 2; ++a)
#pragma unroll
            for (int b = 0; b < 2; ++b)
#pragma unroll
                for (int m = 0; m < 4; ++m)
#pragma unroll
                    for (int n = 0; n < 2; ++n) acc[a][b][m][n] = (f32x4){0.f, 0.f, 0.f, 0.f};
        cur = nxt; cA = nA; cB = nB; ++ui;
        if constexpr (Sched::GATHER) {
#pragma unroll
            for (int h = 0; h < 2; ++h)
#pragma unroll
                for (int i = 0; i < 2; ++i) { int R, Cc; stage_rc(tid * 16 + i * 8192, R, Cc); cvA[h][i] = (unsigned)(S.gather_tok(ui, 128 * h + R) * K + Cc) * 2u; } }
        if constexpr (ALIGN_EPI) { if (wr == 1) PG8_BAR; }
    }
    PG8_WAIT_V(0);
    if constexpr (!ALIGN_EPI) { if (wr == 0) PG8_BAR; }
    PG8_BAR;
    if constexpr (Epi::AFTER_DRAIN) { E.fused(acc, cur, wr, wc, fr, fq, lds, wid, lane); S.done(cur); }
#undef PG8_SA
#undef PG8_SB
#undef PG8_STAGE
#undef PG8_STAGE_A
#undef PG8_LD32
#undef PG8_LDA
#undef PG8_LDB
#undef PG8_MMA
#undef PG8_WAIT_V
#undef PG8_WAIT_L
#undef PG8_BAR
#undef PG8_SCHED
}
}
namespace att {
using bf16 = __hip_bfloat16;
constexpr int   D = 128, NW = 8, QBLK = 32, KVBLK = 64;
constexpr float SCALE = 0.125f;
constexpr float THR = 8.f;
constexpr int SDEPTH = 2;
constexpr int LDQ = 8 * D, LDK = 4 * D, LDO = LDQ;
constexpr size_t SHM_V = KVBLK * D * 2, SHM_K = KVBLK * D * 2, SHM_ATTN = 2 * SHM_V + 2 * SHM_K + NW * 64 * 4;
using bf16x8 = __attribute__((ext_vector_type(8))) short;
using s16x4  = __attribute__((ext_vector_type(4))) short;
using f32x16 = __attribute__((ext_vector_type(16))) float;
using f32x8  = __attribute__((ext_vector_type(8))) float;
using u32x4  = __attribute__((ext_vector_type(4))) unsigned;
#define KSWZ(row, colB) ((row) * 256 + ((colB) ^ (((row) & 7) << 4)))
#define SBAR() __builtin_amdgcn_sched_barrier(0)
__device__ __forceinline__ int crow(int r, int hi) { return (r & 3) + 8 * (r >> 2) + 4 * hi; }
__device__ __forceinline__ unsigned cvtpk(float lo, float hi) {
  unsigned r; asm volatile("v_cvt_pk_bf16_f32 %0, %1, %2" : "=v"(r) : "v"(lo), "v"(hi)); return r;
}
template <typename TIn> struct Stage;
template <> struct Stage<bf16>  { using T = bf16x8;
  __device__ static __forceinline__ T ld8(const bf16* p) { return *reinterpret_cast<const bf16x8*>(p); }
  __device__ static __forceinline__ bf16x8 tobf(T x) { return x; } };
template <> struct Stage<float> { using T = f32x8;
  __device__ static __forceinline__ T ld8(const float* p) { return *reinterpret_cast<const f32x8*>(p); }
  __device__ static __forceinline__ bf16x8 tobf(T x) {
    u32x4 w = {cvtpk(x[0], x[1]), cvtpk(x[2], x[3]), cvtpk(x[4], x[5]), cvtpk(x[6], x[7])}; return *reinterpret_cast<bf16x8*>(&w); } };

__device__ __forceinline__ void partialSM(f32x16& p0, f32x16& p1, float& m_reg, float& mn, float& alpha) {
  constexpr float C = SCALE * 1.4426950408889634f;
  float pmax = p0[0]; for (int r = 1; r < 16; ++r) pmax = fmaxf(pmax, p0[r]); for (int r = 0; r < 16; ++r) pmax = fmaxf(pmax, p1[r]);
  { auto rr = __builtin_amdgcn_permlane32_swap(__float_as_uint(pmax), __float_as_uint(pmax), false, false);
    pmax = fmaxf(__uint_as_float(rr[0]), __uint_as_float(rr[1])); }
  if (__builtin_expect(__all(pmax - m_reg <= THR / SCALE), 1)) { mn = m_reg; alpha = 1.f; }
  else { mn = fmaxf(m_reg, pmax); alpha = __builtin_amdgcn_exp2f((m_reg - mn) * C); m_reg = mn; }
  float mnC = -mn * C;
  for (int r = 0; r < 16; ++r) p0[r] = fmaf(p0[r], C, mnC); for (int r = 0; r < 16; ++r) p1[r] = fmaf(p1[r], C, mnC);
  for (int r = 0; r < 16; ++r) p0[r] = __builtin_amdgcn_exp2f(p0[r]);
}
__device__ __forceinline__ void finishSM(f32x16& p0, f32x16& p1, float alpha, float& l_reg, bf16x8& pa0, bf16x8& pa1, bf16x8& pa2, bf16x8& pa3) {
  for (int r = 0; r < 16; ++r) p1[r] = __builtin_amdgcn_exp2f(p1[r]);
  float ps = 0; for (int r = 0; r < 16; ++r) ps += p0[r]; for (int r = 0; r < 16; ++r) ps += p1[r];
  { auto rr = __builtin_amdgcn_permlane32_swap(__float_as_uint(ps), __float_as_uint(ps), false, false);
    ps = __uint_as_float(rr[0]) + __uint_as_float(rr[1]); }
  l_reg = l_reg * alpha + ps;
#define PK4(P, BASE, OUT) do { unsigned a0 = cvtpk(P[BASE + 0], P[BASE + 1]), a1 = cvtpk(P[BASE + 2], P[BASE + 3]);   \
    unsigned b0 = cvtpk(P[BASE + 4], P[BASE + 5]), b1 = cvtpk(P[BASE + 6], P[BASE + 7]);                              \
    auto r0 = __builtin_amdgcn_permlane32_swap(a0, b0, false, false); auto r1 = __builtin_amdgcn_permlane32_swap(a1, b1, false, false); \
    u32x4 w = {r0[0], r1[0], r0[1], r1[1]}; OUT = *reinterpret_cast<bf16x8*>(&w); } while (0)
  PK4(p0, 0, pa0); PK4(p0, 8, pa1); PK4(p1, 0, pa2); PK4(p1, 8, pa3);
#undef PK4
}
__device__ __forceinline__ void qkt(f32x16& p0, f32x16& p1, const bf16* Ks, const bf16x8* qr, int r32, int hi) {
  p0 = f32x16{}; p1 = f32x16{};
  for (int d0 = 0; d0 < 8; ++d0) { int cb = (d0 * 16 + hi * 8) * 2;
    bf16x8 b0 = *reinterpret_cast<const bf16x8*>((const char*)Ks + KSWZ(r32, cb));
    bf16x8 b1 = *reinterpret_cast<const bf16x8*>((const char*)Ks + KSWZ(32 + r32, cb));
    p0 = __builtin_amdgcn_mfma_f32_32x32x16_bf16(b0, qr[d0], p0, 0, 0, 0);
    p1 = __builtin_amdgcn_mfma_f32_32x32x16_bf16(b1, qr[d0], p1, 0, 0, 0); }
}
__device__ __forceinline__ int v_st(int k, int c) { const int kk = (k & ~0xC) | ((k & 4) << 1) | ((k & 8) >> 1); return ((kk >> 3) * 4 + (c >> 5)) * 512 + ((kk & 7) * 32 + (c & 31)) * 2; }
__device__ __forceinline__ int v_rd_base(int lane) { return ((lane & 3) << 3) | (((lane >> 2) & 3) << 6) | (((lane >> 4) & 1) << 5) | (((lane >> 5) & 1) << 8); }
constexpr int v_rd_off(int d0, int ks, int half) { return d0 * 512 + ks * 4096 + half * 2048; }
template <int OFF> __device__ __forceinline__ s16x4 tr_read(int vb) {
  s16x4 r; asm volatile("ds_read_b64_tr_b16 %0, %1 offset:%2" : "=&v"(r) : "v"(vb), "i"(OFF) : "memory"); return r;
}
template <int D0> __device__ __forceinline__ void pv_one(f32x16& od, int vb, bf16x8 pa0, bf16x8 pa1, bf16x8 pa2, bf16x8 pa3) {
  const s16x4 l0 = tr_read<v_rd_off(D0, 0, 0)>(vb), h0 = tr_read<v_rd_off(D0, 0, 1)>(vb), l1 = tr_read<v_rd_off(D0, 1, 0)>(vb), h1 = tr_read<v_rd_off(D0, 1, 1)>(vb);
  const s16x4 l2 = tr_read<v_rd_off(D0, 2, 0)>(vb), h2 = tr_read<v_rd_off(D0, 2, 1)>(vb), l3 = tr_read<v_rd_off(D0, 3, 0)>(vb), h3 = tr_read<v_rd_off(D0, 3, 1)>(vb);
  asm volatile("s_waitcnt lgkmcnt(0)" ::: "memory"); SBAR();
#define PK(L, H) (bf16x8){L[0], L[1], L[2], L[3], H[0], H[1], H[2], H[3]}
  od = __builtin_amdgcn_mfma_f32_32x32x16_bf16(pa0, PK(l0, h0), od, 0, 0, 0);
  od = __builtin_amdgcn_mfma_f32_32x32x16_bf16(pa1, PK(l1, h1), od, 0, 0, 0);
  od = __builtin_amdgcn_mfma_f32_32x32x16_bf16(pa2, PK(l2, h2), od, 0, 0, 0);
  od = __builtin_amdgcn_mfma_f32_32x32x16_bf16(pa3, PK(l3, h3), od, 0, 0, 0);
#undef PK
}
__device__ __forceinline__ void pv_d0(f32x16* o, int vb, bf16x8 pa0, bf16x8 pa1, bf16x8 pa2, bf16x8 pa3) {
  pv_one<0>(o[0], vb, pa0, pa1, pa2, pa3); pv_one<1>(o[1], vb, pa0, pa1, pa2, pa3); pv_one<2>(o[2], vb, pa0, pa1, pa2, pa3); pv_one<3>(o[3], vb, pa0, pa1, pa2, pa3);
}

template <typename TQ>
__device__ __forceinline__ void attn_dense_body(const TQ* __restrict__ Qb, const bf16* __restrict__ Kh, const bf16* __restrict__ Vh,
                                                float* __restrict__ Ob, int seq, char* lds) {
  using St = Stage<bf16>; using SQ = Stage<TQ>;
  const int tid = threadIdx.x, wid = tid >> 6, lane = tid & 63, r32 = lane & 31, hi = lane >> 5;
  bf16* V_lds = (bf16*)lds; bf16* K_lds = (bf16*)(lds + 2 * SHM_V);
  float* ws = (float*)(lds + 2 * SHM_V + 2 * SHM_K) + wid * 64; float* li_l = ws; float* al_l = ws + 32;
  float m_reg = -1e30f, l_reg = 0; f32x16 o[4] = {}; bf16x8 qr[8];
  const TQ* Qw = Qb + (long)(wid * QBLK + r32) * LDQ + hi * 8;
#pragma unroll
  for (int d0 = 0; d0 < 8; ++d0) qr[d0] = SQ::tobf(SQ::ld8(Qw + d0 * 16));
  const int sr = tid >> 4, sc = (tid & 15) * 8, vst0 = v_st(sr, sc), vst1 = v_st(32 + sr, sc);
  const int vb0 = (int)(uintptr_t)V_lds + v_rd_base(lane);
  struct { typename St::T vs0, vs1, ks0, ks1; } sr_[SDEPTH];
#define SLOAD(i, k0) do { sr_[i].vs0 = St::ld8(&Vh[(long)((k0) + sr) * LDK + sc]); sr_[i].vs1 = St::ld8(&Vh[(long)((k0) + 32 + sr) * LDK + sc]); \
    sr_[i].ks0 = St::ld8(&Kh[(long)((k0) + sr) * LDK + sc]); sr_[i].ks1 = St::ld8(&Kh[(long)((k0) + 32 + sr) * LDK + sc]); } while (0)
#define SWRITE(b, i) do { *(bf16x8*)((char*)V_lds + (b) * SHM_V + vst0) = St::tobf(sr_[i].vs0);          \
    *(bf16x8*)((char*)V_lds + (b) * SHM_V + vst1) = St::tobf(sr_[i].vs1); int kc = sc * 2;               \
    *(bf16x8*)((char*)K_lds + (b) * SHM_K + KSWZ(sr, kc)) = St::tobf(sr_[i].ks0);                       \
    *(bf16x8*)((char*)K_lds + (b) * SHM_K + KSWZ(32 + sr, kc)) = St::tobf(sr_[i].ks1); } while (0)
#define SWAIT() do { if constexpr (SDEPTH == 2) asm volatile("s_waitcnt vmcnt(4)" ::: "memory"); else asm volatile("s_waitcnt vmcnt(0)" ::: "memory"); } while (0)
#define RESC(a) do { if (__any((a) < 1.f)) { if (hi == 0) al_l[r32] = (a); asm volatile("s_waitcnt lgkmcnt(0)" ::: "memory"); \
    for (int d = 0; d < 4; ++d) for (int r = 0; r < 16; ++r) o[d][r] *= al_l[crow(r, hi)]; } } while (0)
  f32x16 pA0, pA1, pB0, pB1; float mnA, mnB, alA, alB; bf16x8 pa0, pa1, pa2, pa3; const int NT = seq / KVBLK;
  constexpr int SE = 0, SO = SDEPTH - 1;
  SLOAD(SE, 0); asm volatile("s_waitcnt vmcnt(0)" ::: "memory"); SWRITE(0, SE); __syncthreads();
  qkt(pA0, pA1, K_lds, qr, r32, hi); partialSM(pA0, pA1, m_reg, mnA, alA);
  SLOAD(SO, KVBLK); if constexpr (SDEPTH == 2) { if (2 < NT) SLOAD(SE, 2 * KVBLK); }
  SWAIT(); SWRITE(1, SO); __syncthreads();
  for (int j = 1; j + 1 < NT; j += 2) {
    SBAR(); qkt(pB0, pB1, (bf16*)((char*)K_lds + SHM_K), qr, r32, hi);
    finishSM(pA0, pA1, alA, l_reg, pa0, pa1, pa2, pa3); SBAR();
    SLOAD(SO, (j + SDEPTH) * KVBLK); SBAR();
    pv_d0(o, vb0, pa0, pa1, pa2, pa3); partialSM(pB0, pB1, m_reg, mnB, alB);
    __syncthreads(); SWAIT(); SWRITE(0, SE);
    RESC(alB); __syncthreads();
    SBAR(); qkt(pA0, pA1, K_lds, qr, r32, hi);
    finishSM(pB0, pB1, alB, l_reg, pa0, pa1, pa2, pa3); SBAR();
    if (SDEPTH == 1 || j + 3 < NT) SLOAD(SE, (j + 1 + SDEPTH) * KVBLK); SBAR();
    pv_d0(o, vb0 + (int)SHM_V, pa0, pa1, pa2, pa3); partialSM(pA0, pA1, m_reg, mnA, alA);
    __syncthreads(); SWAIT(); SWRITE(1, SO);
    RESC(alA); __syncthreads();
  }
  SBAR(); qkt(pB0, pB1, (bf16*)((char*)K_lds + SHM_K), qr, r32, hi);
  finishSM(pA0, pA1, alA, l_reg, pa0, pa1, pa2, pa3); SBAR();
  pv_d0(o, vb0, pa0, pa1, pa2, pa3); partialSM(pB0, pB1, m_reg, mnB, alB);
  __syncthreads(); RESC(alB);
  finishSM(pB0, pB1, alB, l_reg, pa0, pa1, pa2, pa3); SBAR();
  pv_d0(o, vb0 + (int)SHM_V, pa0, pa1, pa2, pa3);
  if (hi == 0) li_l[r32] = l_reg; asm volatile("s_waitcnt lgkmcnt(0)" ::: "memory");
  float rli[16];
#pragma unroll
  for (int r = 0; r < 16; ++r) rli[r] = __builtin_amdgcn_rcpf(li_l[crow(r, hi)]);
  float* Ow = Ob + (long)(wid * QBLK) * LDO;
#pragma unroll
  for (int r = 0; r < 16; ++r) { int orow = crow(r, hi);
    for (int d0 = 0; d0 < 4; ++d0) Ow[(long)orow * LDO + d0 * 32 + r32] = o[d0][r] * rli[r]; }
#undef SLOAD
#undef SWRITE
#undef SWAIT
#undef RESC
}
__device__ __forceinline__ void qkt2(f32x16& p0, f32x16& p1, const bf16* Ks, const bf16x8* qr, int r32, int hi, int mp) {
  p0 = f32x16{}; p1 = f32x16{};
  __builtin_amdgcn_s_setprio(1);
#pragma unroll
  for (int d0 = 0; d0 < 4; ++d0) { int cb = (mp * 64 + d0 * 16 + hi * 8) * 2;
    bf16x8 b0 = *reinterpret_cast<const bf16x8*>((const char*)Ks + KSWZ(r32, cb));
    bf16x8 b1 = *reinterpret_cast<const bf16x8*>((const char*)Ks + KSWZ(32 + r32, cb));
    p0 = __builtin_amdgcn_mfma_f32_32x32x16_bf16(b0, qr[d0], p0, 0, 0, 0);
    p1 = __builtin_amdgcn_mfma_f32_32x32x16_bf16(b1, qr[d0], p1, 0, 0, 0); }
  __builtin_amdgcn_s_setprio(0);
}
constexpr int LDQ2 = 512, LDOB = 1024;
__device__ __forceinline__ void attn_diff_body(const bf16* __restrict__ Qb, const bf16* __restrict__ Kh, const bf16* __restrict__ Vh,
                                               unsigned short* __restrict__ Ob, int seq, char* lds, float lam, const float* __restrict__ subg, float osc) {
  using St = Stage<bf16>; using SQ = Stage<bf16>;
  const int tid = threadIdx.x, wid = tid >> 6, lane = tid & 63, r32 = lane & 31, hi = lane >> 5, mp = wid >> 2, wq = wid & 3;
  bf16* V_lds = (bf16*)lds; bf16* K_lds = (bf16*)(lds + 2 * SHM_V);
  float* ws = (float*)(lds + 2 * SHM_V + 2 * SHM_K) + wid * 64; float* li_l = ws; float* al_l = ws + 32;
  float m_reg = -1e30f, l_reg = 0; f32x16 o[4] = {}; bf16x8 qr[4];
  const bf16* Qw = Qb + (long)(wq * QBLK + r32) * LDQ2 + mp * 64 + hi * 8;
#pragma unroll
  for (int d0 = 0; d0 < 4; ++d0) qr[d0] = SQ::tobf(SQ::ld8(Qw + d0 * 16));
  const int sr = tid >> 4, sc = (tid & 15) * 8, vst0 = v_st(sr, sc), vst1 = v_st(32 + sr, sc);
  const int vb0 = (int)(uintptr_t)V_lds + v_rd_base(lane);
  struct { typename St::T vs0, vs1, ks0, ks1; } sr_[SDEPTH];
#define SLOAD(i, k0) do { sr_[i].vs0 = St::ld8(&Vh[(long)((k0) + sr) * LDK + sc]); sr_[i].vs1 = St::ld8(&Vh[(long)((k0) + 32 + sr) * LDK + sc]); \
    sr_[i].ks0 = St::ld8(&Kh[(long)((k0) + sr) * LDK + sc]); sr_[i].ks1 = St::ld8(&Kh[(long)((k0) + 32 + sr) * LDK + sc]); } while (0)
#define SWRITE(b, i) do { *(bf16x8*)((char*)V_lds + (b) * SHM_V + vst0) = St::tobf(sr_[i].vs0);          \
    *(bf16x8*)((char*)V_lds + (b) * SHM_V + vst1) = St::tobf(sr_[i].vs1); int kc = sc * 2;               \
    *(bf16x8*)((char*)K_lds + (b) * SHM_K + KSWZ(sr, kc)) = St::tobf(sr_[i].ks0);                       \
    *(bf16x8*)((char*)K_lds + (b) * SHM_K + KSWZ(32 + sr, kc)) = St::tobf(sr_[i].ks1); } while (0)
#define SWAIT() do { if constexpr (SDEPTH == 2) asm volatile("s_waitcnt vmcnt(4)" ::: "memory"); else asm volatile("s_waitcnt vmcnt(0)" ::: "memory"); } while (0)
#define RESC(a) do { if (__any((a) < 1.f)) { if (hi == 0) al_l[r32] = (a); asm volatile("s_waitcnt lgkmcnt(0)" ::: "memory"); \
    for (int d = 0; d < 4; ++d) for (int r = 0; r < 16; ++r) o[d][r] *= al_l[crow(r, hi)]; } } while (0)
  f32x16 pA0, pA1, pB0, pB1; float mnA, mnB, alA, alB; bf16x8 pa0, pa1, pa2, pa3; const int NT = seq / KVBLK;
  constexpr int SE = 0, SO = SDEPTH - 1;
  SLOAD(SE, 0); asm volatile("s_waitcnt vmcnt(0)" ::: "memory"); SWRITE(0, SE); __syncthreads();
  qkt2(pA0, pA1, K_lds, qr, r32, hi, mp); partialSM(pA0, pA1, m_reg, mnA, alA);
  SLOAD(SO, KVBLK); if constexpr (SDEPTH == 2) { if (2 < NT) SLOAD(SE, 2 * KVBLK); }
  SWAIT(); SWRITE(1, SO); __syncthreads();
  for (int j = 1; j + 1 < NT; j += 2) {
    SBAR(); qkt2(pB0, pB1, (bf16*)((char*)K_lds + SHM_K), qr, r32, hi, mp);
    finishSM(pA0, pA1, alA, l_reg, pa0, pa1, pa2, pa3); SBAR();
    SLOAD(SO, (j + SDEPTH) * KVBLK); SBAR();
    pv_d0(o, vb0, pa0, pa1, pa2, pa3); partialSM(pB0, pB1, m_reg, mnB, alB);
    __syncthreads(); SWAIT(); SWRITE(0, SE);
    RESC(alB); __syncthreads();
    SBAR(); qkt2(pA0, pA1, K_lds, qr, r32, hi, mp);
    finishSM(pB0, pB1, alB, l_reg, pa0, pa1, pa2, pa3); SBAR();
    if (SDEPTH == 1 || j + 3 < NT) SLOAD(SE, (j + 1 + SDEPTH) * KVBLK); SBAR();
    pv_d0(o, vb0 + (int)SHM_V, pa0, pa1, pa2, pa3); partialSM(pA0, pA1, m_reg, mnA, alA);
    __syncthreads(); SWAIT(); SWRITE(1, SO);
    RESC(alA); __syncthreads();
  }
  SBAR(); qkt2(pB0, pB1, (bf16*)((char*)K_lds + SHM_K), qr, r32, hi, mp);
  finishSM(pA0, pA1, alA, l_reg, pa0, pa1, pa2, pa3); SBAR();
  pv_d0(o, vb0, pa0, pa1, pa2, pa3); partialSM(pB0, pB1, m_reg, mnB, alB);
  __syncthreads(); RESC(alB);
  finishSM(pB0, pB1, alB, l_reg, pa0, pa1, pa2, pa3); SBAR();
  pv_d0(o, vb0 + (int)SHM_V, pa0, pa1, pa2, pa3);
  if (hi == 0) li_l[r32] = l_reg; asm volatile("s_waitcnt lgkmcnt(0)" ::: "memory");
  float rli[16];
#pragma unroll
  for (int r = 0; r < 16; ++r) rli[r] = __builtin_amdgcn_rcpf(li_l[crow(r, hi)]);
#pragma unroll
  for (int d0 = 0; d0 < 4; ++d0)
#pragma unroll
    for (int r = 0; r < 16; ++r) o[d0][r] *= rli[r];
  __syncthreads();
  float* xch = (float*)lds + wq * 4096 + lane;
  if (mp == 1) {
#pragma unroll
    for (int d0 = 0; d0 < 4; ++d0)
#pragma unroll
      for (int r = 0; r < 16; ++r) xch[(d0 * 16 + r) * 64] = o[d0][r]; }
  __syncthreads();
  if (mp == 0) {
    int lane_e = lane; asm volatile("" : "+v"(lane_e));
    const int r32e = lane_e & 31, hie = lane_e >> 5;
    float ssq[16];
#pragma unroll
    for (int r = 0; r < 16; ++r) ssq[r] = 0.f;
#pragma unroll
    for (int d0 = 0; d0 < 4; ++d0)
#pragma unroll
      for (int r = 0; r < 16; ++r) { const float v = o[d0][r] - lam * xch[(d0 * 16 + r) * 64]; o[d0][r] = v; ssq[r] += v * v; }
#pragma unroll
    for (int r = 0; r < 16; ++r) { float s = ssq[r]; s += __shfl_xor(s, 1); s += __shfl_xor(s, 2); s += __shfl_xor(s, 4); s += __shfl_xor(s, 8); s += __shfl_xor(s, 16); ssq[r] = rsqrtf(s * (1.0f / 128.0f) + 1e-6f) * osc; }
    unsigned short* Ow = Ob + (long)(wq * QBLK) * LDOB;
#pragma unroll
    for (int d0 = 0; d0 < 4; ++d0) { const float gsc = subg[d0 * 32 + r32e];
#pragma unroll
      for (int r = 0; r < 16; ++r) { const float v = o[d0][r] * ssq[r] * gsc; const unsigned u = __float_as_uint(v); Ow[(long)crow(r, hie) * LDOB + d0 * 32 + r32e] = (unsigned short)((u + 0x7fffu + ((u >> 16) & 1u)) >> 16); } } }
  __syncthreads();
#undef SLOAD
#undef SWRITE
#undef SWAIT
#undef RESC
}
__device__ __forceinline__ void qkt3(f32x16& p0, f32x16& p1, const bf16* Ks, const bf16x8* qr, const f32x16& negm, int r32, int hi, int mp) {
#pragma unroll
  for (int d0 = 0; d0 < 4; ++d0) { int cb = (mp * 64 + d0 * 16 + hi * 8) * 2;
    bf16x8 b0 = *reinterpret_cast<const bf16x8*>((const char*)Ks + KSWZ(r32, cb));
    bf16x8 b1 = *reinterpret_cast<const bf16x8*>((const char*)Ks + KSWZ(32 + r32, cb));
    if (d0 == 0) { p0 = __builtin_amdgcn_mfma_f32_32x32x16_bf16(b0, qr[0], negm, 0, 0, 0); p1 = __builtin_amdgcn_mfma_f32_32x32x16_bf16(b1, qr[0], negm, 0, 0, 0); }
    else { p0 = __builtin_amdgcn_mfma_f32_32x32x16_bf16(b0, qr[d0], p0, 0, 0, 0); p1 = __builtin_amdgcn_mfma_f32_32x32x16_bf16(b1, qr[d0], p1, 0, 0, 0); } }
}
constexpr float THR2 = THR * 1.4426950408889634f;
__device__ __forceinline__ void partialSM2(f32x16& p0, f32x16& p1, float& m_reg, f32x16& negm, float& alpha, bool nomax) {
  if (nomax) { alpha = 1.f; for (int r = 0; r < 16; ++r) p0[r] = __builtin_amdgcn_exp2f(p0[r]); return; }
  float pmax = p0[0]; for (int r = 1; r < 16; ++r) pmax = fmaxf(pmax, p0[r]); for (int r = 0; r < 16; ++r) pmax = fmaxf(pmax, p1[r]);
  { auto rr = __builtin_amdgcn_permlane32_swap(__float_as_uint(pmax), __float_as_uint(pmax), false, false);
    pmax = fmaxf(__uint_as_float(rr[0]), __uint_as_float(rr[1])); }
  if (__builtin_expect(__all(pmax <= THR2), 1)) { alpha = 1.f; }
  else { const float dl = fmaxf(pmax, 0.f); m_reg += dl; alpha = __builtin_amdgcn_exp2f(-dl);
    for (int r = 0; r < 16; ++r) { p0[r] -= dl; p1[r] -= dl; }
    for (int r = 0; r < 16; ++r) negm[r] = -m_reg; }
  for (int r = 0; r < 16; ++r) p0[r] = __builtin_amdgcn_exp2f(p0[r]);
}
__device__ __forceinline__ void finishSM2(f32x16& p0, f32x16& p1, float alpha, float& l_reg, bf16x8& pa0, bf16x8& pa1, bf16x8& pa2, bf16x8& pa3) {
  for (int r = 0; r < 16; ++r) p1[r] = __builtin_amdgcn_exp2f(p1[r]);
  float ps = 0; for (int r = 0; r < 16; ++r) ps += p0[r]; for (int r = 0; r < 16; ++r) ps += p1[r];
  { auto rr = __builtin_amdgcn_permlane32_swap(__float_as_uint(ps), __float_as_uint(ps), false, false);
    ps = __uint_as_float(rr[0]) + __uint_as_float(rr[1]); }
  l_reg = l_reg * alpha + ps;
#define PK8(P, BASE, OUT) do { u32x4 w = {cvtpk(P[BASE + 0], P[BASE + 1]), cvtpk(P[BASE + 2], P[BASE + 3]), cvtpk(P[BASE + 4], P[BASE + 5]), cvtpk(P[BASE + 6], P[BASE + 7])}; OUT = *reinterpret_cast<bf16x8*>(&w); } while (0)
  PK8(p0, 0, pa0); PK8(p0, 8, pa1); PK8(p1, 0, pa2); PK8(p1, 8, pa3);
#undef PK8
}
typedef short v4i16b_t __attribute__((ext_vector_type(4)));
__device__ __forceinline__ v4i16b_t vtrb(int vb, int off) { return __builtin_amdgcn_ds_read_tr16_b64_v4i16((__attribute__((address_space(3))) v4i16b_t*)(unsigned)(vb + off)); }
#define PVB_F(L, H) __builtin_bit_cast(bf16x8, __builtin_shufflevector(L, H, 0, 1, 2, 3, 4, 5, 6, 7))
template <int D0> __device__ __forceinline__ void pv_oneb(f32x16& od, int vb, bf16x8 pa0, bf16x8 pa1, bf16x8 pa2, bf16x8 pa3) {
  const v4i16b_t l0 = vtrb(vb, v_rd_off(D0, 0, 0)), h0 = vtrb(vb, v_rd_off(D0, 0, 1)), l1 = vtrb(vb, v_rd_off(D0, 1, 0)), h1 = vtrb(vb, v_rd_off(D0, 1, 1));
  const v4i16b_t l2 = vtrb(vb, v_rd_off(D0, 2, 0)), h2 = vtrb(vb, v_rd_off(D0, 2, 1)), l3 = vtrb(vb, v_rd_off(D0, 3, 0)), h3 = vtrb(vb, v_rd_off(D0, 3, 1));
  __builtin_amdgcn_s_setprio(1);
  od = __builtin_amdgcn_mfma_f32_32x32x16_bf16(pa0, PVB_F(l0, h0), od, 0, 0, 0);
  od = __builtin_amdgcn_mfma_f32_32x32x16_bf16(pa1, PVB_F(l1, h1), od, 0, 0, 0);
  od = __builtin_amdgcn_mfma_f32_32x32x16_bf16(pa2, PVB_F(l2, h2), od, 0, 0, 0);
  od = __builtin_amdgcn_mfma_f32_32x32x16_bf16(pa3, PVB_F(l3, h3), od, 0, 0, 0);
  __builtin_amdgcn_s_setprio(0);
}
__device__ __forceinline__ void pv_d0b(f32x16* o, int vb, bf16x8 pa0, bf16x8 pa1, bf16x8 pa2, bf16x8 pa3) {
  pv_oneb<0>(o[0], vb, pa0, pa1, pa2, pa3); SBAR(); pv_oneb<1>(o[1], vb, pa0, pa1, pa2, pa3); SBAR(); pv_oneb<2>(o[2], vb, pa0, pa1, pa2, pa3); SBAR(); pv_oneb<3>(o[3], vb, pa0, pa1, pa2, pa3);
}
#define PVP_RD(A, D0) do { A[0] = tr_read<v_rd_off(D0, 0, 0)>(vb); A[1] = tr_read<v_rd_off(D0, 0, 1)>(vb); A[2] = tr_read<v_rd_off(D0, 1, 0)>(vb); A[3] = tr_read<v_rd_off(D0, 1, 1)>(vb); \
    A[4] = tr_read<v_rd_off(D0, 2, 0)>(vb); A[5] = tr_read<v_rd_off(D0, 2, 1)>(vb); A[6] = tr_read<v_rd_off(D0, 3, 0)>(vb); A[7] = tr_read<v_rd_off(D0, 3, 1)>(vb); } while (0)
#define PVP_PK(L, H) (bf16x8){L[0], L[1], L[2], L[3], H[0], H[1], H[2], H[3]}
#define PVP_MM(OD, A) do { OD = __builtin_amdgcn_mfma_f32_32x32x16_bf16(pa0, PVP_PK(A[0], A[1]), OD, 0, 0, 0); OD = __builtin_amdgcn_mfma_f32_32x32x16_bf16(pa1, PVP_PK(A[2], A[3]), OD, 0, 0, 0); \
    OD = __builtin_amdgcn_mfma_f32_32x32x16_bf16(pa2, PVP_PK(A[4], A[5]), OD, 0, 0, 0); OD = __builtin_amdgcn_mfma_f32_32x32x16_bf16(pa3, PVP_PK(A[6], A[7]), OD, 0, 0, 0); } while (0)
__device__ __forceinline__ void pv_pipe(f32x16* o, int vb, bf16x8 pa0, bf16x8 pa1, bf16x8 pa2, bf16x8 pa3) {
  s16x4 A0[8], A1[8];
  PVP_RD(A0, 0); PVP_RD(A1, 1);
  asm volatile("s_waitcnt lgkmcnt(8)" ::: "memory"); SBAR(); PVP_MM(o[0], A0); SBAR();
  PVP_RD(A0, 2);
  asm volatile("s_waitcnt lgkmcnt(8)" ::: "memory"); SBAR(); PVP_MM(o[1], A1); SBAR();
  PVP_RD(A1, 3);
  asm volatile("s_waitcnt lgkmcnt(8)" ::: "memory"); SBAR(); PVP_MM(o[2], A0); SBAR();
  asm volatile("s_waitcnt lgkmcnt(0)" ::: "memory"); SBAR(); PVP_MM(o[3], A1);
}
#undef PVP_RD
#undef PVP_PK
#undef PVP_MM
__device__ __forceinline__ void attn_diff_body3(const bf16* __restrict__ Qb, const bf16* __restrict__ Kh, const bf16* __restrict__ Vh,
                                               unsigned short* __restrict__ Ob, int seq, char* lds, __attribute__((address_space(3))) unsigned char* ldsl, float lam, const float* __restrict__ subg, float osc, bool nomax) {
  using St = Stage<bf16>; using SQ = Stage<bf16>;
  const int tid = threadIdx.x, wid = tid >> 6, lane = tid & 63, r32 = lane & 31, hi = lane >> 5, mp = wid >> 2, wq = wid & 3;
  constexpr int VR = 0, KR = 3 * 16384, WSO = 6 * 16384;
  bf16* V_lds = (bf16*)(lds + VR); bf16* K_lds = (bf16*)(lds + KR);
  float* ws = (float*)(lds + WSO) + wid * 64; float* li_l = ws; float* al_l = ws + 32;
  float m_reg = 0.f, l_reg = 0; f32x16 o[4] = {}; bf16x8 qr[4]; f32x16 negm = {}; asm volatile("" : "+v"(negm));
  const bf16* Qw = Qb + (long)(wq * QBLK + r32) * LDQ2 + mp * 64 + hi * 8;
#pragma unroll
  for (int d0 = 0; d0 < 4; ++d0) qr[d0] = SQ::tobf(SQ::ld8(Qw + d0 * 16));
  const int vb0 = (int)(uintptr_t)V_lds + v_rd_base(lane);
  int kso[2], vso[2];
#pragma unroll
  for (int i = 0; i < 2; ++i) { const int ob = (i * 8 + wid) * 1024 + 16 * lane; const int row = ob >> 8, cb = (ob & 255) ^ ((row & 7) << 4); kso[i] = row * LDK + (cb >> 1);
    const int st = ob >> 9, e = (ob & 511) >> 1, kk = (st >> 2) * 8 + (e >> 5); vso[i] = kk * LDK + (st & 3) * 32 + (e & 31); }
  const int wu = __builtin_amdgcn_readfirstlane(wid);
  typedef __attribute__((address_space(3))) unsigned las_u32;
  const int NT = seq / KVBLK;
#define DMA_K(t, slot) do { const int tt_ = (t) < NT ? (t) : NT - 1; const bf16* g_ = Kh + (long)tt_ * KVBLK * LDK; _Pragma("unroll") for (int i_ = 0; i_ < 2; ++i_) \
    __builtin_amdgcn_global_load_lds((const unsigned*)(g_ + kso[i_]), (las_u32*)(ldsl + KR + (slot) * 16384 + (i_ * 8 + wu) * 1024), 16, 0, 0); } while (0)
#define DMA_V(t, slot) do { const int tt_ = (t) < NT ? (t) : NT - 1; const bf16* g_ = Vh + (long)tt_ * KVBLK * LDK; _Pragma("unroll") for (int i_ = 0; i_ < 2; ++i_) \
    __builtin_amdgcn_global_load_lds((const unsigned*)(g_ + vso[i_]), (las_u32*)(ldsl + VR + (slot) * 16384 + (i_ * 8 + wu) * 1024), 16, 0, 0); } while (0)
#define CLOSE() do { asm volatile("s_waitcnt vmcnt(4) lgkmcnt(0)" ::: "memory"); __builtin_amdgcn_s_barrier(); asm volatile("" ::: "memory"); } while (0)
#define RESC(a) do { if (__any((a) < 1.f)) { if (hi == 0) al_l[r32] = (a); asm volatile("s_waitcnt lgkmcnt(0)" ::: "memory"); \
    for (int d = 0; d < 4; ++d) for (int r = 0; r < 16; ++r) o[d][r] *= al_l[crow(r, hi)]; } } while (0)
  f32x16 pA0, pA1, pB0, pB1; float mnA, mnB, alA, alB; bf16x8 pa0, pa1, pa2, pa3;
  DMA_K(0, 0); DMA_K(1, 1); DMA_V(0, 0);
  asm volatile("s_waitcnt vmcnt(4)" ::: "memory"); __builtin_amdgcn_s_barrier(); asm volatile("" ::: "memory");
  DMA_K(2, 2); DMA_V(1, 1);
  qkt2(pA0, pA1, K_lds, qr, r32, hi, mp); partialSM2(pA0, pA1, m_reg, negm, alA, nomax);
  CLOSE();
  int kcur = 1, vcur = 0;
#define ROT3(x) ((x) == 2 ? 0 : (x) + 1)
#define PRV3(x) ((x) == 0 ? 2 : (x) - 1)
#define ITER(PC0, PC1, MNC, ALC, PP0, PP1, ALP, j_) do { \
    DMA_K((j_) + 2, PRV3(kcur)); DMA_V((j_) + 1, PRV3(vcur)); \
    SBAR(); if (__builtin_expect(__all(m_reg == 0.f), 1)) { qkt2(PC0, PC1, (bf16*)((char*)K_lds + kcur * 16384), qr, r32, hi, mp); } else { qkt3(PC0, PC1, (bf16*)((char*)K_lds + kcur * 16384), qr, negm, r32, hi, mp); } \
    finishSM2(PP0, PP1, ALP, l_reg, pa0, pa1, pa2, pa3); SBAR(); \
    pv_d0b(o, vb0 + vcur * 16384, pa0, pa1, pa2, pa3); partialSM2(PC0, PC1, m_reg, negm, ALC, nomax); \
    if (!nomax) { RESC(ALC); } CLOSE(); kcur = ROT3(kcur); vcur = ROT3(vcur); } while (0)
  for (int j = 1; j + 1 < NT; j += 2) {
    ITER(pB0, pB1, mnB, alB, pA0, pA1, alA, j);
    ITER(pA0, pA1, mnA, alA, pB0, pB1, alB, j + 1);
  }
  ITER(pB0, pB1, mnB, alB, pA0, pA1, alA, NT - 1);
  finishSM2(pB0, pB1, alB, l_reg, pa0, pa1, pa2, pa3); SBAR();
  pv_d0b(o, vb0 + vcur * 16384, pa0, pa1, pa2, pa3);
  asm volatile("s_waitcnt vmcnt(0)" ::: "memory");
#undef ITER
#undef ROT3
#undef PRV3
#undef DMA_K
#undef DMA_V
#undef CLOSE
  if (hi == 0) li_l[r32] = l_reg; asm volatile("s_waitcnt lgkmcnt(0)" ::: "memory");
  float rli[16];
#pragma unroll
  for (int r = 0; r < 16; ++r) rli[r] = __builtin_amdgcn_rcpf(li_l[crow(r, hi)]);
#pragma unroll
  for (int d0 = 0; d0 < 4; ++d0)
#pragma unroll
    for (int r = 0; r < 16; ++r) o[d0][r] *= rli[r];
  __syncthreads();
  float* xch = (float*)lds + wq * 4096 + lane;
  if (mp == 1) {
#pragma unroll
    for (int d0 = 0; d0 < 4; ++d0)
#pragma unroll
      for (int r = 0; r < 16; ++r) xch[(d0 * 16 + r) * 64] = o[d0][r]; }
  __syncthreads();
  if (mp == 0) {
    int lane_e = lane; asm volatile("" : "+v"(lane_e));
    const int r32e = lane_e & 31, hie = lane_e >> 5;
    float ssq[16];
#pragma unroll
    for (int r = 0; r < 16; ++r) ssq[r] = 0.f;
#pragma unroll
    for (int d0 = 0; d0 < 4; ++d0)
#pragma unroll
      for (int r = 0; r < 16; ++r) { const float v = o[d0][r] - lam * xch[(d0 * 16 + r) * 64]; o[d0][r] = v; ssq[r] += v * v; }
#pragma unroll
    for (int r = 0; r < 16; ++r) { float s = ssq[r]; s += __shfl_xor(s, 1); s += __shfl_xor(s, 2); s += __shfl_xor(s, 4); s += __shfl_xor(s, 8); s += __shfl_xor(s, 16); ssq[r] = rsqrtf(s * (1.0f / 128.0f) + 1e-6f) * osc; }
    unsigned short* Ow = Ob + (long)(wq * QBLK) * LDOB;
#pragma unroll
    for (int d0 = 0; d0 < 4; ++d0) { const float gsc = subg[d0 * 32 + r32e];
#pragma unroll
      for (int r = 0; r < 16; ++r) { const float v = o[d0][r] * ssq[r] * gsc; const unsigned u = __float_as_uint(v); Ow[(long)crow(r, hie) * LDOB + d0 * 32 + r32e] = (unsigned short)((u + 0x7fffu + ((u >> 16) & 1u)) >> 16); } } }
  __syncthreads();
#undef RESC
}
typedef int v8i_a8 __attribute__((ext_vector_type(8)));
typedef int v4i_a8 __attribute__((ext_vector_type(4)));
constexpr float THR8 = 8.5f;
__device__ __forceinline__ unsigned pk4f8(float a, float b, float c, float d) { int w = 0; w = __builtin_amdgcn_cvt_pk_fp8_f32(a, b, w, false); w = __builtin_amdgcn_cvt_pk_fp8_f32(c, d, w, true); return (unsigned)w; }
__device__ __forceinline__ void partialSM8(f32x16& p0, f32x16& p1, float& m_reg, float& alpha) {
  float pmax = p0[0]; for (int r = 1; r < 16; ++r) pmax = fmaxf(pmax, p0[r]); for (int r = 0; r < 16; ++r) pmax = fmaxf(pmax, p1[r]);
  { auto rr = __builtin_amdgcn_permlane32_swap(__float_as_uint(pmax), __float_as_uint(pmax), false, false);
    pmax = fmaxf(__uint_as_float(rr[0]), __uint_as_float(rr[1])); }
  if (__builtin_expect(__all(pmax <= THR8), 1)) { alpha = 1.f; }
  else { const float dl = fmaxf(pmax, 0.f); m_reg += dl; alpha = __builtin_amdgcn_exp2f(-dl);
    for (int r = 0; r < 16; ++r) { p0[r] -= dl; p1[r] -= dl; } }
  for (int r = 0; r < 16; ++r) p0[r] = __builtin_amdgcn_exp2f(p0[r]);
}
__device__ __forceinline__ void finishSM8(f32x16& p0, f32x16& p1, float alpha, float& l_reg, v8i_a8& pa) {
  for (int r = 0; r < 16; ++r) p1[r] = __builtin_amdgcn_exp2f(p1[r]);
  float ps = 0; for (int r = 0; r < 16; ++r) ps += p0[r]; for (int r = 0; r < 16; ++r) ps += p1[r];
  { auto rr = __builtin_amdgcn_permlane32_swap(__float_as_uint(ps), __float_as_uint(ps), false, false);
    ps = __uint_as_float(rr[0]) + __uint_as_float(rr[1]); }
  l_reg = l_reg * alpha + ps;
  pa[0] = (int)pk4f8(p0[0], p0[1], p0[2], p0[3]); pa[1] = (int)pk4f8(p0[4], p0[5], p0[6], p0[7]); pa[2] = (int)pk4f8(p0[8], p0[9], p0[10], p0[11]); pa[3] = (int)pk4f8(p0[12], p0[13], p0[14], p0[15]);
  pa[4] = (int)pk4f8(p1[0], p1[1], p1[2], p1[3]); pa[5] = (int)pk4f8(p1[4], p1[5], p1[6], p1[7]); pa[6] = (int)pk4f8(p1[8], p1[9], p1[10], p1[11]); pa[7] = (int)pk4f8(p1[12], p1[13], p1[14], p1[15]);
}
typedef __attribute__((address_space(3))) unsigned char las_u8;
__device__ __forceinline__ v8i_a8 kfrag8(const las_u8* kt, int row, int mp, int hi) {
  const int sw = (row >> 1) & 7, c0 = 4 * mp + 2 * hi;
  const v4i_a8 lo = *(const __attribute__((address_space(3))) v4i_a8*)(kt + row * 128 + ((c0 ^ sw) << 4)), hi4 = *(const __attribute__((address_space(3))) v4i_a8*)(kt + row * 128 + (((c0 + 1) ^ sw) << 4));
  return __builtin_shufflevector(lo, hi4, 0, 1, 2, 3, 4, 5, 6, 7);
}
#define QS8 0x7D7D7D7D
#define US8 0x7F7F7F7F
__device__ __forceinline__ void qkt8(f32x16& p0, f32x16& p1, const las_u8* kt, const v8i_a8& qf, const f32x16& c0, int r32, int hi, int mp) {
  const v8i_a8 k0 = kfrag8(kt, r32, mp, hi), k1 = kfrag8(kt, 32 + r32, mp, hi);
  p0 = __builtin_amdgcn_mfma_scale_f32_32x32x64_f8f6f4(k0, qf, c0, 0, 0, 0, US8, 0, QS8);
  p1 = __builtin_amdgcn_mfma_scale_f32_32x32x64_f8f6f4(k1, qf, c0, 0, 0, 0, US8, 0, QS8);
}
__device__ __forceinline__ void pv8(f32x16* o, const las_u8* vt, int lane, const v8i_a8& pa) {
#pragma unroll
  for (int d0 = 0; d0 < 4; ++d0) {
    const v4i_a8 lo = *(const __attribute__((address_space(3))) v4i_a8*)(vt + ((d0 * 2 + 0) * 64 + lane) * 16), hi4 = *(const __attribute__((address_space(3))) v4i_a8*)(vt + ((d0 * 2 + 1) * 64 + lane) * 16);
    const v8i_a8 vf = __builtin_shufflevector(lo, hi4, 0, 1, 2, 3, 4, 5, 6, 7);
    o[d0] = __builtin_amdgcn_mfma_scale_f32_32x32x64_f8f6f4(pa, vf, o[d0], 0, 0, 0, US8, 0, US8); }
}
__device__ __forceinline__ unsigned pk4b8(float a, float b, float c, float d) { int w = 0; w = __builtin_amdgcn_cvt_pk_bf8_f32(a, b, w, false); w = __builtin_amdgcn_cvt_pk_bf8_f32(c, d, w, true); return (unsigned)w; }
__device__ __forceinline__ void finishSM8b(f32x16& p0, f32x16& p1, v8i_a8& pa) {
  for (int r = 0; r < 16; ++r) p1[r] = __builtin_amdgcn_exp2f(p1[r]);
  pa[0] = (int)pk4b8(p0[0], p0[1], p0[2], p0[3]); pa[1] = (int)pk4b8(p0[4], p0[5], p0[6], p0[7]); pa[2] = (int)pk4b8(p0[8], p0[9], p0[10], p0[11]); pa[3] = (int)pk4b8(p0[12], p0[13], p0[14], p0[15]);
  pa[4] = (int)pk4b8(p1[0], p1[1], p1[2], p1[3]); pa[5] = (int)pk4b8(p1[4], p1[5], p1[6], p1[7]); pa[6] = (int)pk4b8(p1[8], p1[9], p1[10], p1[11]); pa[7] = (int)pk4b8(p1[12], p1[13], p1[14], p1[15]);
}
__device__ __forceinline__ void pv8b(f32x16* o, f32x16& osum, const v8i_a8& ones, const las_u8* vt, int lane, const v8i_a8& pa) {
  osum = __builtin_amdgcn_mfma_scale_f32_32x32x64_f8f6f4(pa, ones, osum, 1, 0, 0, US8, 0, US8);
#pragma unroll
  for (int d0 = 0; d0 < 4; ++d0) {
    const v4i_a8 lo = *(const __attribute__((address_space(3))) v4i_a8*)(vt + ((d0 * 2 + 0) * 64 + lane) * 16), hi4 = *(const __attribute__((address_space(3))) v4i_a8*)(vt + ((d0 * 2 + 1) * 64 + lane) * 16);
    const v8i_a8 vf = __builtin_shufflevector(lo, hi4, 0, 1, 2, 3, 4, 5, 6, 7);
    o[d0] = __builtin_amdgcn_mfma_scale_f32_32x32x64_f8f6f4(pa, vf, o[d0], 1, 0, 0, US8, 0, US8); }
}
template <bool NOMAX> __device__ __forceinline__ void attn_diff_body8(const unsigned char* __restrict__ Q8b, const unsigned char* __restrict__ K8h, const unsigned char* __restrict__ V8h,
                                               unsigned short* __restrict__ Ob, int seq, char* lds, las_u8* ldsl, float lam, const float* __restrict__ subg, float osc) {
  constexpr bool nomax = NOMAX;
  const int tid = threadIdx.x, wid = tid >> 6, lane = tid & 63, r32 = lane & 31, hi = lane >> 5, mp = wid >> 2, wq = wid & 3;
  constexpr int VR = 0, KR = 3 * 8192, WSO = 65536;
  typedef __attribute__((address_space(3))) float las_f32;
  las_f32* li_l = (las_f32*)(ldsl + WSO) + wid * 64; las_f32* al_l = li_l + 32;
  float m_reg = 0.f, l_reg = 0; f32x16 o[4] = {};
  v8i_a8 qf;
  { const unsigned char* qp = Q8b + (long)(wq * QBLK + r32) * 512 + mp * 64 + hi * 32; const v4i_a8 lo = *(const v4i_a8*)qp, h4 = *(const v4i_a8*)(qp + 16); qf = __builtin_shufflevector(lo, h4, 0, 1, 2, 3, 4, 5, 6, 7); }
  const int wu = __builtin_amdgcn_readfirstlane(wid);
  const int krow = 8 * wid + (lane >> 3), kso = krow * 512 + (((lane & 7) ^ ((krow >> 1) & 7)) << 4), vso = wid * 1024 + 16 * lane;
  typedef __attribute__((address_space(3))) unsigned las_u32;
  const int NT = seq / KVBLK;
#define DMA_K(t, slot) do { const int tt_ = (t) < NT ? (t) : NT - 1; __builtin_amdgcn_global_load_lds((const unsigned*)(K8h + (long)tt_ * KVBLK * 512 + kso), (las_u32*)(ldsl + KR + (slot) * 8192 + wu * 1024), 16, 0, 0); } while (0)
#define DMA_V(t, slot) do { const int tt_ = (t) < NT ? (t) : NT - 1; __builtin_amdgcn_global_load_lds((const unsigned*)(V8h + (long)tt_ * 8192 + vso), (las_u32*)(ldsl + VR + (slot) * 8192 + wu * 1024), 16, 0, 0); } while (0)
#define CLOSE() do { asm volatile("s_waitcnt vmcnt(2) lgkmcnt(0)" ::: "memory"); __builtin_amdgcn_s_barrier(); asm volatile("" ::: "memory"); } while (0)
#define RESC(a) do { if (__any((a) < 1.f)) { if (hi == 0) al_l[r32] = (a); asm volatile("s_waitcnt lgkmcnt(0)" ::: "memory"); \
    for (int d = 0; d < 4; ++d) for (int r = 0; r < 16; ++r) o[d][r] *= al_l[crow(r, hi)]; } } while (0)
  f32x16 pA0, pA1, pB0, pB1; float alA, alB; v8i_a8 pa;
  f32x16 osum = {}; v8i_a8 ones8;
  { const int ob = r32 == 0 ? 0x38383838 : 0; ones8 = (v8i_a8){ob, ob, ob, ob, ob, ob, ob, ob}; }
  int kcur = 1, vcur = 0;
  if constexpr (!nomax) {
  DMA_K(0, 0); DMA_K(1, 1); DMA_V(0, 0);
  asm volatile("s_waitcnt vmcnt(2)" ::: "memory"); __builtin_amdgcn_s_barrier(); asm volatile("" ::: "memory");
  DMA_K(2, 2); DMA_V(1, 1);
  { const f32x16 z0 = {}; qkt8(pA0, pA1, ldsl + KR, qf, z0, r32, hi, mp); }
  partialSM8(pA0, pA1, m_reg, alA);
  CLOSE();
  }
#define ROT3(x) ((x) == 2 ? 0 : (x) + 1)
#define PRV3(x) ((x) == 0 ? 2 : (x) - 1)
#define ITER(PC0, PC1, ALC, PP0, PP1, ALP, j_) do { \
    DMA_K((j_) + 2, PRV3(kcur)); DMA_V((j_) + 1, PRV3(vcur)); \
    SBAR(); if (__builtin_expect(__all(m_reg == 0.f), 1)) { const f32x16 z0_ = {}; qkt8(PC0, PC1, ldsl + KR + kcur * 8192, qf, z0_, r32, hi, mp); } \
    else { f32x16 nm_; _Pragma("unroll") for (int r_ = 0; r_ < 16; ++r_) nm_[r_] = -m_reg; qkt8(PC0, PC1, ldsl + KR + kcur * 8192, qf, nm_, r32, hi, mp); } \
    finishSM8(PP0, PP1, ALP, l_reg, pa); SBAR(); \
    pv8(o, ldsl + VR + vcur * 8192, lane, pa); partialSM8(PC0, PC1, m_reg, ALC); \
    RESC(ALC); CLOSE(); kcur = ROT3(kcur); vcur = ROT3(vcur); } while (0)
  if constexpr (nomax) {
    v8i_a8 kf0, kf1, vf0, vf1, vf2, vf3;
#define LDV8(d0_, vt_) ({ const v4i_a8 lo_ = *(const __attribute__((address_space(3))) v4i_a8*)((vt_) + (((d0_) * 2 + 0) * 64 + lane) * 16), hi_ = *(const __attribute__((address_space(3))) v4i_a8*)((vt_) + (((d0_) * 2 + 1) * 64 + lane) * 16); \
      (v8i_a8)__builtin_shufflevector(lo_, hi_, 0, 1, 2, 3, 4, 5, 6, 7); })
#define PVB() do { \
      osum = __builtin_amdgcn_mfma_scale_f32_32x32x64_f8f6f4(pa, ones8, osum, 1, 0, 0, US8, 0, US8); \
      o[0] = __builtin_amdgcn_mfma_scale_f32_32x32x64_f8f6f4(pa, vf0, o[0], 1, 0, 0, US8, 0, US8); o[1] = __builtin_amdgcn_mfma_scale_f32_32x32x64_f8f6f4(pa, vf1, o[1], 1, 0, 0, US8, 0, US8); \
      o[2] = __builtin_amdgcn_mfma_scale_f32_32x32x64_f8f6f4(pa, vf2, o[2], 1, 0, 0, US8, 0, US8); o[3] = __builtin_amdgcn_mfma_scale_f32_32x32x64_f8f6f4(pa, vf3, o[3], 1, 0, 0, US8, 0, US8); \
      asm volatile("" : "+v"(o[0]), "+v"(o[1]), "+v"(o[2]), "+v"(o[3]), "+v"(osum)); } while (0)
#define QKB(PC0, PC1) do { const f32x16 z0_ = {}; PC0 = __builtin_amdgcn_mfma_scale_f32_32x32x64_f8f6f4(kf0, qf, z0_, 0, 0, 0, US8, 0, QS8); PC1 = __builtin_amdgcn_mfma_scale_f32_32x32x64_f8f6f4(kf1, qf, z0_, 0, 0, 0, US8, 0, QS8); asm volatile("" : "+v"(PC0), "+v"(PC1)); } while (0)
#define LDK8(t_) do { const las_u8* kt_ = ldsl + KR + ((t_) & 3) * 8192; kf0 = kfrag8(kt_, r32, mp, hi); kf1 = kfrag8(kt_, 32 + r32, mp, hi); } while (0)
#define LDV01() do { const las_u8* vt_ = ldsl + VR + vcur * 8192; vf0 = LDV8(0, vt_); vf1 = LDV8(1, vt_); } while (0)
#define LDV23() do { const las_u8* vt_ = ldsl + VR + vcur * 8192; vf2 = LDV8(2, vt_); vf3 = LDV8(3, vt_); } while (0)
#define ITERC(PC0, PC1, PP0, PP1, j_) do { \
    DMA_K((j_) + 3, ((j_) + 3) & 3); DMA_V((j_) + 1, PRV3(vcur)); \
    SBAR(); QKB(PC0, PC1); SBAR(); \
    LDV01(); LDK8((j_) + 1); SBAR(); \
    finishSM8b(PP0, PP1, pa); SBAR(); LDV23(); SBAR(); \
    PVB(); \
    _Pragma("unroll") for (int r_ = 0; r_ < 16; ++r_) PC0[r_] = __builtin_amdgcn_exp2f(PC0[r_]); \
    CLOSE(); vcur = ROT3(vcur); } while (0)
    DMA_K(0, 0); DMA_V(0, 0); DMA_K(1, 1); DMA_K(2, 2);
    asm volatile("s_waitcnt vmcnt(1)" ::: "memory"); __builtin_amdgcn_s_barrier(); asm volatile("" ::: "memory");
    LDK8(0); QKB(pA0, pA1); SBAR(); LDK8(1); SBAR();
    DMA_K(3, 3); DMA_V(1, 1);
    for (int r = 0; r < 16; ++r) pA0[r] = __builtin_amdgcn_exp2f(pA0[r]);
    CLOSE();
    for (int j = 1; j + 1 < NT; j += 2) { ITERC(pB0, pB1, pA0, pA1, j); ITERC(pA0, pA1, pB0, pB1, j + 1); }
    ITERC(pB0, pB1, pA0, pA1, NT - 1);
    LDV01(); LDV23(); finishSM8b(pB0, pB1, pa); SBAR(); PVB();
#undef ITERC
#undef LDV01
#undef LDV23
#undef LDK8
#undef QKB
#undef PVB
#undef LDV8
  } else {
    for (int j = 1; j + 1 < NT; j += 2) { ITER(pB0, pB1, alB, pA0, pA1, alA, j); ITER(pA0, pA1, alA, pB0, pB1, alB, j + 1); }
    ITER(pB0, pB1, alB, pA0, pA1, alA, NT - 1);
    finishSM8(pB0, pB1, alB, l_reg, pa); SBAR(); pv8(o, ldsl + VR + vcur * 8192, lane, pa);
  }
  asm volatile("s_waitcnt vmcnt(0)" ::: "memory");
#undef ITER
#undef ROT3
#undef PRV3
#undef DMA_K
#undef DMA_V
#undef CLOSE
  if constexpr (nomax) { if (r32 == 0) {
#pragma unroll
      for (int r = 0; r < 16; ++r) li_l[crow(r, hi)] = osum[r]; } }
  else { if (hi == 0) li_l[r32] = l_reg; }
  asm volatile("s_waitcnt lgkmcnt(0)" ::: "memory");
  float rli[16];
#pragma unroll
  for (int r = 0; r < 16; ++r) rli[r] = __builtin_amdgcn_rcpf(li_l[crow(r, hi)]);
#pragma unroll
  for (int d0 = 0; d0 < 4; ++d0)
#pragma unroll
    for (int r = 0; r < 16; ++r) o[d0][r] *= rli[r];
  __syncthreads();
  las_f32* xch = (las_f32*)ldsl + wq * 4096 + lane;
  if (mp == 1) {
#pragma unroll
    for (int d0 = 0; d0 < 4; ++d0)
#pragma unroll
      for (int r = 0; r < 16; ++r) xch[(d0 * 16 + r) * 64] = o[d0][r]; }
  __syncthreads();
  if (mp == 0) {
    int lane_e = lane; asm volatile("" : "+v"(lane_e));
    const int r32e = lane_e & 31, hie = lane_e >> 5;
    float ssq[16];
#pragma unroll
    for (int r = 0; r < 16; ++r) ssq[r] = 0.f;
#pragma unroll
    for (int d0 = 0; d0 < 4; ++d0)
#pragma unroll
      for (int r = 0; r < 16; ++r) { const float v = o[d0][r] - lam * xch[(d0 * 16 + r) * 64]; o[d0][r] = v; ssq[r] += v * v; }
#pragma unroll
    for (int r = 0; r < 16; ++r) { float s = ssq[r]; s += __shfl_xor(s, 1); s += __shfl_xor(s, 2); s += __shfl_xor(s, 4); s += __shfl_xor(s, 8); s += __shfl_xor(s, 16); ssq[r] = rsqrtf(s * (1.0f / 128.0f) + 1e-6f) * osc; }
    unsigned short* Ow = Ob + (long)(wq * QBLK) * LDOB;
#pragma unroll
    for (int d0 = 0; d0 < 4; ++d0) { const float gsc = subg[d0 * 32 + r32e];
#pragma unroll
      for (int r = 0; r < 16; ++r) { const float v = o[d0][r] * ssq[r] * gsc; const unsigned u = __float_as_uint(v); Ow[(long)crow(r, hie) * LDOB + d0 * 32 + r32e] = (unsigned short)((u + 0x7fffu + ((u >> 16) & 1u)) >> 16); } } }
  __syncthreads();
#undef RESC
}
}
#define GAS __attribute__((address_space(1)))
#define LAS __attribute__((address_space(3)))
typedef unsigned short bf16;
typedef unsigned v4u __attribute__((ext_vector_type(4)));
typedef float f32x4 __attribute__((ext_vector_type(4)));
typedef short bf16x8 __attribute__((ext_vector_type(8)));
typedef GAS unsigned gu32;
typedef GAS unsigned long long gu64;
#define RLX_AGENT __ATOMIC_RELAXED, __HIP_MEMORY_SCOPE_AGENT
#define LDS_WAIT() asm volatile("s_waitcnt lgkmcnt(0)" ::: "memory")
#define VM_WAIT() asm volatile("s_waitcnt vmcnt(0)" ::: "memory")
__device__ __forceinline__ unsigned long long rt() { return __builtin_amdgcn_s_memrealtime(); }
__device__ __forceinline__ unsigned f2bf(float f) { unsigned u = __builtin_bit_cast(unsigned, f); return (u + 0x7fffu + ((u >> 16) & 1u)) >> 16; }
__device__ __forceinline__ unsigned pk2(float lo, float hi) { return f2bf(lo) | (f2bf(hi) << 16); }

#define XB_TMO      128
#define XB_XCNT(j)  (256  + 64 * (j))
#define XB_XSUB(j)  (1280 + 64 * (j))
#define XB_XGEN(j)  (2304 + 64 * (j))
#define XB_TOP      3328
#define XB_TOPGEN   3392
#define XCD_BAR_WORDS 3456
#define XB_SPIN_CAP (1u << 23)

__device__ __forceinline__ unsigned xb_ld(unsigned* p)              { return __hip_atomic_load(p, __ATOMIC_RELAXED, __HIP_MEMORY_SCOPE_AGENT); }
__device__ __forceinline__ unsigned xb_add(unsigned* p, unsigned v) { return __hip_atomic_fetch_add(p, v, __ATOMIC_RELAXED, __HIP_MEMORY_SCOPE_AGENT); }
__device__ __forceinline__ unsigned xb_xcc_id() { return (unsigned)__builtin_amdgcn_s_getreg((3 << 11) | 20) & 0xFu; }
#define XB_SPIN(cond, bar) do { unsigned _sp = 0; while (cond) { __builtin_amdgcn_s_sleep(1); \
    if ((++_sp & 255u) == 0u) { if (xb_ld(&(bar)[XB_TMO])) break; if (_sp > XB_SPIN_CAP) { atomicAdd(&(bar)[XB_TMO], 1u); break; } } } } while (0)

struct XcdBarrier {
    unsigned* bar; unsigned x;
    volatile LAS unsigned* st;
};

__device__ __forceinline__ XcdBarrier xcd_barrier_post(unsigned* bar, volatile LAS unsigned* st) {
    XcdBarrier b; b.bar = bar; b.x = xb_xcc_id(); b.st = st;
    if (threadIdx.x == 0) (void)xb_add(&bar[XB_XCNT(b.x)], 1u);
    return b;
}
__device__ __forceinline__ void xcd_barrier_complete(unsigned* bar, unsigned x, unsigned& nloc, unsigned& nx) {
    const unsigned G = gridDim.x * gridDim.y * gridDim.z;
    unsigned sum, cnt, mine, sp = 0u;
    for (;;) {
        sum = 0u; cnt = 0u; mine = 0u;
#pragma unroll
        for (unsigned j = 0; j < 16; ++j) { const unsigned c = xb_ld(&bar[XB_XCNT(j)]); sum += c; cnt += (c > 0u) ? 1u : 0u; mine = (j == x) ? c : mine; }
        if (sum == G) break;
        __builtin_amdgcn_s_sleep(1);
        if ((++sp & 255u) == 0u) { if (xb_ld(&bar[XB_TMO])) break; if (sp > XB_SPIN_CAP) { atomicAdd(&bar[XB_TMO], 1u); break; } }
    }
    nloc = mine > 0u ? mine : 1u; nx = cnt > 0u ? cnt : 1u;
}

__device__ __forceinline__ void xcd_barrier(const XcdBarrier& b) {
    asm volatile("s_waitcnt vmcnt(0)" ::: "memory");
    __syncthreads();
    if (threadIdx.x == 0) {
        unsigned* bar = b.bar;
        __builtin_amdgcn_s_waitcnt(0);
        unsigned nloc = b.st[0], nx = b.st[1];
        if (nloc == 0u) { xcd_barrier_complete(bar, b.x, nloc, nx); b.st[0] = nloc; b.st[1] = nx; }
        const unsigned old = xb_add(&bar[XB_XSUB(b.x)], 1u);
        const unsigned gen = old / nloc;
        if (old + 1u == (gen + 1u) * nloc) {
            __builtin_amdgcn_fence(__ATOMIC_RELEASE, "agent");
            asm volatile("s_waitcnt vmcnt(0)" ::: "memory");
            const unsigned og = xb_add(&bar[XB_TOP], 1u);
            const unsigned tg = og / nx;
            if (og + 1u == (tg + 1u) * nx) xb_add(&bar[XB_TOPGEN], 1u);
            else XB_SPIN(xb_ld(&bar[XB_TOPGEN]) == tg, bar);
            __builtin_amdgcn_fence(__ATOMIC_ACQUIRE, "agent");
            xb_add(&bar[XB_XGEN(b.x)], 1u);
            asm volatile("s_waitcnt vmcnt(0)" ::: "memory");
        } else {
            XB_SPIN(xb_ld(&bar[XB_XGEN(b.x)]) == gen, bar);
            __builtin_amdgcn_fence(__ATOMIC_ACQUIRE, "agent");
            asm volatile("s_waitcnt vmcnt(0)" ::: "memory");
        }
    }
    __syncthreads();
}
constexpr int DM = 1024, NB = 8, SEQ = 4096, CTX = 256, T = NB * SEQ, TC = NB * CTX, SKV = CTX + SEQ, MROWS = T + TC;
constexpr int NIN = 5120;
constexpr int C_Q = 0, C_K = 512, C_V = 1024, C_HY = 1536, C_G = 3072;
constexpr int NE = 32, TOPK = 4, NA = T * TOPK, NROWS = NA + NE * 256, NBLK = NROWS / 256;
constexpr float EPS = 1e-6f;
enum { IX_X = 0, IX_C, IX_CTX, IX_CCTX, IX_ADAW, IX_ADAB, IX_N1G, IX_N2G, IX_WIN, IX_BIN, IX_QNG, IX_KNG, IX_LQ1, IX_LK1, IX_LQ2, IX_LK2, IX_SUBG,
       IX_CONVW, IX_CONVB, IX_FW1, IX_FB1, IX_FW2, IX_FB2, IX_FW3, IX_FB3, IX_FW4, IX_FFREQ, IX_HBIAS, IX_WUA, IX_WUB, IX_WOUT, IX_RW, IX_RB,
       IX_EW1, IX_EB1, IX_EW2, IX_EB2, N_INPUTS };
constexpr size_t MiB = 1u << 20;
constexpr size_t WS_CTL = 0, CTL_BYTES = 1 * MiB;
constexpr size_t WS_MOD = 1 * MiB;
constexpr size_t WS_LAM = WS_MOD + 256 * 1024;
constexpr size_t WS_ROPEC = WS_LAM + 1024, WS_ROPES = WS_ROPEC + 4096;
constexpr size_t WS_BLKE = WS_ROPES + 4096;
constexpr size_t WS_CNTB = WS_BLKE + 4096;
constexpr size_t WS_TOPE = 2 * MiB, WS_TOPW = WS_TOPE + 512 * 1024, WS_TOKPOS = WS_TOPW + 512 * 1024;
constexpr size_t WS_ROWTOK = WS_TOKPOS + 512 * 1024, WS_ROWW = WS_ROWTOK + 576 * 1024;
static_assert(WS_CNTB + 32768 <= 2 * MiB && WS_ROWW + 576 * 1024 <= 5 * MiB && (size_t)NROWS * 4 <= 576 * 1024, "small tables");
constexpr size_t WS_HF = 6 * MiB;
constexpr size_t WS_WIN = 22 * MiB;
constexpr size_t WS_WIN8 = 5 * MiB + 512 * 1024;
constexpr size_t WS_WA = 32 * MiB, WS_WB = 33 * MiB, WS_WO = 34 * MiB;
constexpr size_t WS_W1 = 36 * MiB;
constexpr size_t WS_W2 = 164 * MiB;
constexpr size_t WS_ACT0 = 228 * MiB;
constexpr size_t WS_HY = 228 * MiB;
constexpr size_t WS_GT = 324 * MiB;
constexpr size_t WS_PX = WS_ACT0;
constexpr size_t WS_XM = 568 * MiB;
constexpr size_t WS_XM8 = 636 * MiB;
constexpr size_t WS_WG8 = 668 * MiB;
constexpr size_t WS_OATT = 568 * MiB;
constexpr size_t WS_QP = 696 * MiB;
constexpr size_t WS_V8T = 728 * MiB;
constexpr size_t WS_KA = 760 * MiB, WS_VA = 794 * MiB;
constexpr size_t WS_U = 828 * MiB;
constexpr size_t WS_UT = 828 * MiB, WS_YT = 860 * MiB;
constexpr size_t WS_CP = 956 * MiB;
constexpr size_t WS_OAB = 892 * MiB;
constexpr size_t WS_SSQ = 228 * MiB;
constexpr size_t WS_OB = 892 * MiB, WS_OA = 924 * MiB;
constexpr size_t WS_TA = 696 * MiB;
constexpr size_t WS_TB = 568 * MiB;
constexpr size_t WS_MB = 828 * MiB;
constexpr size_t WS_TM = 696 * MiB;
constexpr size_t WS_H = 568 * MiB;
constexpr size_t WS_HS = 228 * MiB;
constexpr size_t WS_ACT = 860 * MiB;
constexpr size_t WS_Y = 568 * MiB;
constexpr size_t WS_END = 1020 * MiB;
constexpr int CW_CNT = 0;
constexpr int CW_BAR = 4096;
constexpr int CW_NMAX = 1024;
constexpr int RING_BYTES = 131072, MISC_OFF = RING_BYTES + 320, LDS_BYTES = 163840;
constexpr int NWAVES = 8, NTHREADS = 512;

typedef __attribute__((address_space(3))) float lds_f32;
__device__ __forceinline__ float bf2f(bf16 v) { return __builtin_bit_cast(float, (unsigned)v << 16); }
__device__ __forceinline__ float wave_sum(float v) {
#pragma unroll
    for (int o = 1; o < 64; o <<= 1) v += __shfl_xor(v, o);
    return v;
}
__device__ __forceinline__ float sigmoidf_(float x) { return 1.0f / (1.0f + __expf(-x)); }

struct Ctx {
    float* out; unsigned char* ws;
    LAS unsigned char* lds; char* ldsg;
    int tid, lane, wave, gwave, nwaves, gtid, gthreads;
};
#define WSP(T_, off) ((T_*)(C.ws + (off)))
#define INP(i) (((const float* const __attribute__((address_space(4)))*)__builtin_amdgcn_kernarg_segment_ptr())[i])

__device__ __forceinline__ void tr_item(const float* W, int N, bf16* WT, int Kout, int k0, int n0, int orow0, LAS float* scr, int lane, bool perm = false) {
    { const int kr = lane >> 3, c4 = (lane & 7) * 4; f32x4 v[8];
#pragma unroll
      for (int i = 0; i < 8; ++i) v[i] = *(const f32x4*)(W + (size_t)(k0 + 8 * i + kr) * N + n0 + c4);
#pragma unroll
      for (int i = 0; i < 8; ++i) { LAS float* d = scr + (8 * i + kr) * 33 + c4; d[0] = v[i].x; d[1] = v[i].y; d[2] = v[i].z; d[3] = v[i].w; } }
    LDS_WAIT(); asm volatile("" ::: "memory");
    const int c = lane & 7;
#pragma unroll
    for (int j = 0; j < 4; ++j) { const int n = (lane >> 3) + 8 * j; const LAS float* s = scr + (8 * c) * 33 + n;
        v4u o; o.x = pk2(s[0 * 33], s[1 * 33]); o.y = pk2(s[2 * 33], s[3 * 33]); o.z = pk2(s[4 * 33], s[5 * 33]); o.w = pk2(s[6 * 33], s[7 * 33]);
        const int nr = perm ? (16 * ((n >> 2) & 1) + 4 * (n >> 3) + (n & 3)) : n;
        *(v4u*)(WT + (size_t)(orow0 + nr) * Kout + k0 + 8 * c) = o; }
    LDS_WAIT(); asm volatile("" ::: "memory");
}
__device__ __forceinline__ void tr_item8(const float* W, int N, unsigned char* WT, int Kout, int k0, int n0, int orow0, LAS float* scr, int lane, float mul, bool perm = false) {
    { const int kr = lane >> 3, c4 = (lane & 7) * 4; f32x4 v[8];
#pragma unroll
      for (int i = 0; i < 8; ++i) v[i] = *(const f32x4*)(W + (size_t)(k0 + 8 * i + kr) * N + n0 + c4);
#pragma unroll
      for (int i = 0; i < 8; ++i) { LAS float* d = scr + (8 * i + kr) * 33 + c4; d[0] = v[i].x; d[1] = v[i].y; d[2] = v[i].z; d[3] = v[i].w; } }
    LDS_WAIT(); asm volatile("" ::: "memory");
    const int c = lane & 7;
#pragma unroll
    for (int j = 0; j < 4; ++j) { const int n = (lane >> 3) + 8 * j; const LAS float* s = scr + (8 * c) * 33 + n;
        const unsigned lo = pg8::pk4_fp8(s[0 * 33] * mul, s[1 * 33] * mul, s[2 * 33] * mul, s[3 * 33] * mul), hi = pg8::pk4_fp8(s[4 * 33] * mul, s[5 * 33] * mul, s[6 * 33] * mul, s[7 * 33] * mul);
        const int nr = perm ? (16 * ((n >> 2) & 1) + 4 * (n >> 3) + (n & 3)) : n;
        *(unsigned long long*)(WT + (size_t)(orow0 + nr) * Kout + k0 + 8 * c) = (unsigned long long)lo | ((unsigned long long)hi << 32); }
    LDS_WAIT(); asm volatile("" ::: "memory");
}
struct PrepItem { const float* src; unsigned char* dst; int N, k0, n0, orow0, fl; };
__device__ __forceinline__ void prep_decode(const Ctx& C, int r, PrepItem& p) {
    constexpr int I_INB = 16 * 96, I_ING = 8 * 32, I_A = 8 * 32, I_O = 16 * 32, I_E1 = 8 * 32, I_E2 = 8 * 16;
    if (r < I_INB) { const int kb = r / 96, nb = r % 96; const int L0 = 32 * nb, pn = L0 >> 8;
        p.src = INP(IX_WIN); p.N = NIN; p.k0 = 64 * kb; p.n0 = L0; p.dst = WSP(unsigned char, WS_WIN);
        p.orow0 = pn < 4 ? (256 * pn + 128 * ((L0 >> 5) & 1) + 32 * ((L0 >> 6) & 3)) : L0; p.fl = pn >= 4 ? 2 : 0; return; } r -= I_INB;
    if (r < I_ING) { const int kb = r / 32, nb = r % 32; p.src = INP(IX_WIN); p.N = NIN; p.k0 = 128 * kb; p.n0 = 3072 + 64 * nb; p.dst = WSP(unsigned char, WS_WG8); p.orow0 = 64 * nb; p.fl = 3; return; } r -= I_ING;
    if (r < 2 * I_A) { const int hb = r >= I_A; if (hb) r -= I_A; const int kb = r / 32, nb = r % 32;
        p.src = hb ? INP(IX_WUB) : INP(IX_WUA); p.N = 1024; p.k0 = 64 * kb; p.n0 = 32 * nb; p.dst = WSP(unsigned char, WS_WA) + (hb ? 1024 : 0); p.orow0 = 32 * nb; p.fl = 0; return; } r -= 2 * I_A;
    if (r < I_O) { const int kb = r / 32, nb = r % 32; p.src = INP(IX_WOUT); p.N = 1024; p.k0 = 64 * kb; p.n0 = 32 * nb; p.dst = WSP(unsigned char, WS_WO); p.orow0 = 32 * nb; p.fl = 0; return; } r -= I_O;
    if (r < NE * I_E1) { const int e = r / I_E1, q = r % I_E1, kb = q / 32, nb = q % 32; const int L0 = 64 * nb, half = L0 >> 10, ch = L0 & 1023;
        p.src = INP(IX_EW1) + (size_t)e * 1024 * 2048; p.N = 2048; p.k0 = 128 * kb; p.n0 = L0; p.dst = WSP(unsigned char, WS_W1) + (size_t)e * 2048 * 1024; p.orow0 = (ch >> 7) * 256 + half * 128 + (ch & 127); p.fl = 1; return; }
    r -= NE * I_E1;
    { const int e = r / I_E2, q = r % I_E2, kb = q / 16, nb = q % 16;
      p.src = INP(IX_EW2) + (size_t)e * 1024 * 1024; p.N = 1024; p.k0 = 128 * kb; p.n0 = 64 * nb; p.dst = WSP(unsigned char, WS_W2) + (size_t)e * 1024 * 1024; p.orow0 = 64 * nb; p.fl = 1; }
}
__device__ __forceinline__ void ph_prep_weights(const Ctx& C) {
    LAS float* scr = (LAS float*)(C.lds + C.wave * 16384);
    constexpr int NIT = 16 * 96 + 8 * 32 + 2 * 8 * 32 + 16 * 32 + NE * (8 * 32 + 8 * 16);
    const int lane = C.lane;
    for (int it = C.gwave; it < NIT; it += C.nwaves) {
        PrepItem p; prep_decode(C, it, p);
        if (p.fl & 1) {
            const int kq = lane >> 4, c = lane & 15;
            const float* src = p.src + (size_t)(p.k0 + 32 * kq) * p.N + p.n0 + 4 * c;
            LAS unsigned char* sb = (LAS unsigned char*)scr;
#pragma unroll
            for (int h = 0; h < 2; ++h) { f32x4 v[16];
#pragma unroll
                for (int i = 0; i < 16; ++i) v[i] = *(const f32x4*)(src + (size_t)(16 * h + i) * p.N);
#pragma unroll
                for (int e = 0; e < 4; ++e) { v4u o;
                    o.x = pg8::pk4_fp8(v[0][e] * 32.0f, v[1][e] * 32.0f, v[2][e] * 32.0f, v[3][e] * 32.0f); o.y = pg8::pk4_fp8(v[4][e] * 32.0f, v[5][e] * 32.0f, v[6][e] * 32.0f, v[7][e] * 32.0f);
                    o.z = pg8::pk4_fp8(v[8][e] * 32.0f, v[9][e] * 32.0f, v[10][e] * 32.0f, v[11][e] * 32.0f); o.w = pg8::pk4_fp8(v[12][e] * 32.0f, v[13][e] * 32.0f, v[14][e] * 32.0f, v[15][e] * 32.0f);
                    *(LAS v4u*)(sb + (4 * c + e) * 144 + 32 * kq + 16 * h) = o; } }
            LDS_WAIT(); asm volatile("" ::: "memory");
#pragma unroll
            for (int j = 0; j < 8; ++j) { const int n = (lane >> 3) + 8 * j, ch = lane & 7; const v4u o = *(const LAS v4u*)(sb + n * 144 + 16 * ch);
                const int n32 = n & 31, nr = (p.fl & 2) ? (16 * ((n32 >> 2) & 1) + 4 * (n32 >> 3) + (n32 & 3)) : n32;
                *(v4u*)(p.dst + (size_t)(p.orow0 + (n & 32) + nr) * 1024 + p.k0 + 16 * ch) = o; }
        } else {
            const int kr = lane >> 3, c4 = (lane & 7) * 4;
            f32x4 v[8];
#pragma unroll
            for (int i = 0; i < 8; ++i) v[i] = *(const f32x4*)(p.src + (size_t)(p.k0 + 8 * i + kr) * p.N + p.n0 + c4);
#pragma unroll
            for (int i = 0; i < 8; ++i) { LAS float* d = scr + (8 * i + kr) * 33 + c4; d[0] = v[i].x; d[1] = v[i].y; d[2] = v[i].z; d[3] = v[i].w; }
            LDS_WAIT(); asm volatile("" ::: "memory");
            const int c = lane & 7;
#pragma unroll
            for (int j = 0; j < 4; ++j) { const int n = (lane >> 3) + 8 * j; const LAS float* s = scr + (8 * c) * 33 + n;
                v4u o; o.x = pk2(s[0 * 33], s[1 * 33]); o.y = pk2(s[2 * 33], s[3 * 33]); o.z = pk2(s[4 * 33], s[5 * 33]); o.w = pk2(s[6 * 33], s[7 * 33]);
                const int nr = (p.fl & 2) ? (16 * ((n >> 2) & 1) + 4 * (n >> 3) + (n & 3)) : n;
                *(v4u*)((bf16*)p.dst + (size_t)(p.orow0 + nr) * 1024 + p.k0 + 8 * c) = o; }
        }
        LDS_WAIT(); asm volatile("" ::: "memory");
    }
}
__device__ __forceinline__ void ph_prep_ada(const Ctx& C) {
    LAS float* s = (LAS float*)C.lds;
    LAS float* red = s + 9 * 1024;
    const float* W = INP(IX_ADAW); float* MOD = WSP(float, WS_MOD);
    for (int g = blockIdx.x; g < 192; g += gridDim.x) {
        __syncthreads();
        for (int i = C.tid; i < 9 * 1024; i += NTHREADS) { const int r = i >> 10, k = i & 1023; const float v = r < 8 ? INP(IX_C)[r * 1024 + k] : INP(IX_CCTX)[k]; s[i] = v / (1.0f + __expf(-v)); }
        __syncthreads();
        float acc[9];
#pragma unroll
        for (int r = 0; r < 9; ++r) acc[r] = 0.f;
        const int col = 32 * g + (C.lane & 31), kp = C.wave * 2 + (C.lane >> 5);
#pragma unroll 8
        for (int k = 64 * kp; k < 64 * kp + 64; ++k) { const float wv = W[(size_t)k * 6144 + col];
#pragma unroll
            for (int r = 0; r < 9; ++r) acc[r] += s[r * 1024 + k] * wv; }
#pragma unroll
        for (int r = 0; r < 9; ++r) red[(kp * 9 + r) * 32 + (C.lane & 31)] = acc[r];
        __syncthreads();
        for (int i = C.tid; i < 9 * 32; i += NTHREADS) { const int r = i >> 5, l = i & 31; float a = 0.f;
#pragma unroll
            for (int w = 0; w < 16; ++w) a += red[(w * 9 + r) * 32 + l];
            MOD[r * 6144 + 32 * g + l] = a + INP(IX_ADAB)[32 * g + l]; }
    }
    __syncthreads();
}
__device__ __forceinline__ void ph_prep_misc(const Ctx& C) {
    if (blockIdx.x == gridDim.x - 1) {
        if (C.wave == 0) { const float a = wave_sum(INP(IX_LQ1)[C.lane] * INP(IX_LK1)[C.lane]), b = wave_sum(INP(IX_LQ2)[C.lane] * INP(IX_LK2)[C.lane]);
            if (C.lane == 0) *WSP(float, WS_LAM) = expf(a) - expf(b) + 0.2f;
            float gq = fabsf(INP(IX_QNG)[C.lane]), gk = fabsf(INP(IX_KNG)[C.lane]);
#pragma unroll
            for (int o = 1; o < 64; o <<= 1) { gq = fmaxf(gq, __shfl_xor(gq, o)); gk = fmaxf(gk, __shfl_xor(gk, o)); }
            if (C.lane == 0) WSP(float, WS_LAM)[1] = 11.541560327111707f * gq * gk + 0.5f; }
        for (int i = C.tid; i < 64 * 16; i += NTHREADS) { const int p = i >> 4, f = i & 15; const double fr = pow(10000.0, -(double)f / 16.0), ang = (double)p * fr;
            WSP(float, WS_ROPEC)[i] = (float)cos(ang); WSP(float, WS_ROPES)[i] = (float)sin(ang); }
    }
}
__device__ __forceinline__ void ph_prep_filter(const Ctx& C) {
    LAS float* sc = (LAS float*)(C.lds + C.wave * 4096);
    LAS float* wl = (LAS float*)(C.lds + 32768);
    float* HF = WSP(float, WS_HF);
    const float* w4 = INP(IX_FW4);
    const int lane = C.lane; const float fq = INP(IX_FFREQ)[lane];
    for (int i = C.gtid; i < 512; i += C.gthreads) HF[i] = 0.f;
    __syncthreads();
    { const float* w1 = INP(IX_FW1); const float* w2 = INP(IX_FW2); const float* w3 = INP(IX_FW3);
      for (int i = C.tid; i < (33 + 64 + 64) * 16; i += NTHREADS) { const int e = 4 * i; const float* src = e < 33 * 64 ? w1 + e : (e < 97 * 64 ? w2 + (e - 33 * 64) : w3 + (e - 97 * 64));
          const f32x4 v = *(const f32x4*)src; LAS float* d = wl + e; d[0] = v.x; d[1] = v.y; d[2] = v.z; d[3] = v.w; } }
    __syncthreads();
    const float lo = logf(0.01f) / 1.5f, hi = logf(0.01f) / 0.3f;
    for (int pb = blockIdx.x; pb < SEQ / 16; pb += gridDim.x) {
        const int n0 = 16 * pb + 2 * C.wave;
#pragma unroll
        for (int p = 0; p < 2; ++p) { const int n = n0 + p; float zv = 0.f;
            if (lane == 0) zv = (float)n / 4095.0f;
            else if (lane <= 32) { const int i = (lane - 1) & 15; const double f = 1e-4 + (double)i * ((15.0 - 1e-4) / 15.0); const double ang = f * (6.283185307179586 * (double)n / 4096.0);
                zv = lane <= 16 ? (float)cos(ang) : -(float)sin(ang); }
            sc[p * 256 + lane] = zv; }
        LDS_WAIT();
        float a0, a1;
        a0 = a1 = INP(IX_FB1)[lane];
#pragma unroll 11
        for (int i = 0; i < 33; ++i) { const float wv = wl[i * 64 + lane]; a0 += sc[i] * wv; a1 += sc[256 + i] * wv; }
        sc[64 + lane] = sinf(fq * a0); sc[256 + 64 + lane] = sinf(fq * a1); LDS_WAIT();
        a0 = a1 = INP(IX_FB2)[lane];
#pragma unroll 16
        for (int i = 0; i < 64; ++i) { const float wv = wl[(33 + i) * 64 + lane]; a0 += sc[64 + i] * wv; a1 += sc[256 + 64 + i] * wv; }
        sc[128 + lane] = sinf(fq * a0); sc[256 + 128 + lane] = sinf(fq * a1); LDS_WAIT();
        a0 = a1 = INP(IX_FB3)[lane];
#pragma unroll 16
        for (int i = 0; i < 64; ++i) { const float wv = wl[(97 + i) * 64 + lane]; a0 += sc[128 + i] * wv; a1 += sc[256 + 128 + i] * wv; }
        sc[192 + lane] = sinf(fq * a0); sc[256 + 192 + lane] = sinf(fq * a1);
        __syncthreads();
        float acc0[16], acc1[16];
#pragma unroll
        for (int q = 0; q < 16; ++q) { acc0[q] = 0.f; acc1[q] = 0.f; }
        const int o0 = 128 * C.wave + lane;
#pragma unroll 1
        for (int j0 = 0; j0 < 64; j0 += 16) { float wa[16], wb[16];
#pragma unroll
            for (int j = 0; j < 16; ++j) { wa[j] = w4[(j0 + j) * 1024 + o0]; wb[j] = w4[(j0 + j) * 1024 + o0 + 64]; }
#pragma unroll
            for (int q = 0; q < 16; ++q) { const LAS float* hq = (const LAS float*)(C.lds + (q >> 1) * 4096 + (q & 1) * 1024) + 192 + j0;
#pragma unroll
                for (int j4 = 0; j4 < 16; j4 += 4) { const f32x4 h = *(const LAS f32x4*)(hq + j4);
                    acc0[q] += h.x * wa[j4] + h.y * wa[j4 + 1] + h.z * wa[j4 + 2] + h.w * wa[j4 + 3]; acc1[q] += h.x * wb[j4] + h.y * wb[j4 + 1] + h.z * wb[j4 + 2] + h.w * wb[j4 + 3]; } } }
#pragma unroll
        for (int cc = 0; cc < 2; ++cc) { const int o = o0 + 64 * cc, dir = o >> 9, c = o & 511; const float dl = fabsf(lo + (hi - lo) * ((float)c / 511.0f)); const float hb = INP(IX_HBIAS)[c];
#pragma unroll
            for (int q = 0; q < 16; ++q) { const int n = 16 * pb + q; const float tn = (float)n / 4095.0f;
                float v = (cc ? acc1[q] : acc0[q]) * expf(-tn * dl);
                if (dir == 0) { if (n == 0) v += hb; HF[(size_t)(4096 + n) * 512 + c] = v; }
                else if (n > 0) HF[(size_t)(4096 - n) * 512 + c] = v; } }
        __syncthreads();
    }
}
__device__ __forceinline__ void ph_modulate1(const Ctx& C) {
    const float* MOD = WSP(float, WS_MOD); bf16* XM = WSP(bf16, WS_XM); unsigned char* XM8 = WSP(unsigned char, WS_XM8); const float* g = INP(IX_N1G);
    for (int r0 = C.gwave; r0 < MROWS; r0 += 2 * C.nwaves) {
        f32x4 v[2][4];
#pragma unroll
        for (int q = 0; q < 2; ++q) { const int r = r0 + q * C.nwaves; if (r < MROWS) { const float* xr = r < T ? INP(IX_X) + (size_t)r * DM : INP(IX_CTX) + (size_t)(r - T) * DM;
#pragma unroll
            for (int j = 0; j < 4; ++j) v[q][j] = *(const f32x4*)(xr + 4 * C.lane + 256 * j); } }
#pragma unroll
        for (int q = 0; q < 2; ++q) { const int r = r0 + q * C.nwaves; if (r < MROWS) {
            const float* mrow = MOD + (r < T ? (r >> 12) : 8) * 6144;
            float ss = 0.f;
#pragma unroll
            for (int j = 0; j < 4; ++j) ss += (v[q][j].x * v[q][j].x + v[q][j].y * v[q][j].y) + (v[q][j].z * v[q][j].z + v[q][j].w * v[q][j].w);
            const float rstd = rsqrtf(wave_sum(ss) * (1.0f / DM) + EPS);
#pragma unroll
            for (int j = 0; j < 4; ++j) { const int col = 4 * C.lane + 256 * j; const f32x4 gg = *(const f32x4*)(g + col), sh = *(const f32x4*)(mrow + col), sc = *(const f32x4*)(mrow + 1024 + col);
                const f32x4 y = v[q][j] * rstd * gg * (sc + 1.0f) + sh;
                *(unsigned long long*)(XM + (size_t)r * DM + col) = (unsigned long long)pk2(y.x, y.y) | ((unsigned long long)pk2(y.z, y.w) << 32);
                if (r < T) *(unsigned*)(XM8 + (size_t)r * DM + col) = pg8::pk4_fp8(y.x, y.y, y.z, y.w); } } }
    }
}
__device__ __forceinline__ void ph_post_proj(const Ctx& C) {
    const bf16* PX = WSP(bf16, WS_PX); bf16* QP = WSP(bf16, WS_QP); bf16* KA = WSP(bf16, WS_KA); bf16* VA = WSP(bf16, WS_VA); float* U = WSP(float, WS_U);
    const float* RC = WSP(float, WS_ROPEC); const float* RS = WSP(float, WS_ROPES);
    const int lane = C.lane;
    for (int it = C.gwave; it < T * 16 + TC * 8; it += C.nwaves) {
        int r, which, h, m, rc = 0; bool latent;
        if (it < T * 16) { r = it >> 4; const int v = it & 15; which = v >> 3; h = (v >> 1) & 3; m = v & 1; latent = true; }
        else { const int j = it - T * 16; rc = j >> 3; const int v = j & 7; which = 1; h = v >> 1; m = v & 1; r = T + rc; latent = false; }
        const float x = bf2f(PX[(size_t)r * NIN + which * 512 + h * 128 + m * 64 + lane]);
        const float rstd = rsqrtf(wave_sum(x * x) * (1.0f / 64.0f) + EPS);
        float y = x * rstd * (which ? INP(IX_KNG)[lane] : INP(IX_QNG)[lane]);
        const int t = r & 4095;
        if (latent) { const int axis = lane >> 5, half = (lane >> 4) & 1, f = lane & 15, pos = axis ? (t & 63) : (t >> 6);
            const float cs = RC[pos * 16 + f], sn = RS[pos * 16 + f]; const float pr = __shfl_xor(y, 16);
            y = half == 0 ? y * cs - pr * sn : y * cs + pr * sn; }
        if (which == 0) { const size_t base = ((size_t)r * 8 + (h * 2 + m)) * 128; QP[base + m * 64 + lane] = (bf16)f2bf(y); QP[base + (1 - m) * 64 + lane] = 0; }
        else { const size_t krow = latent ? (size_t)(r >> 12) * SKV + CTX + t : (size_t)(rc >> 8) * SKV + (rc & 255); KA[krow * 512 + h * 128 + m * 64 + lane] = (bf16)f2bf(y); }
    }
    for (int i = C.gtid; i < MROWS * 64; i += C.gthreads) { const int r = i >> 6, ch = i & 63;
        const size_t vrow = r < T ? (size_t)(r >> 12) * SKV + CTX + (r & 4095) : (size_t)((r - T) >> 8) * SKV + ((r - T) & 255);
        *(v4u*)(VA + vrow * 512 + ch * 8) = *(const v4u*)(PX + (size_t)r * NIN + C_V + ch * 8); }
    const float* cw = INP(IX_CONVW); const float* cb = INP(IX_CONVB);
    for (int i = C.gtid; i < T * 512; i += C.gthreads) { const int r = i >> 9, c = i & 511, t = r & 4095; float z[2];
#pragma unroll
        for (int gsel = 0; gsel < 2; ++gsel) { const int chn = 512 * (gsel + 1) + c; const bf16* p = PX + (size_t)r * NIN + C_HY + chn;
            const float xm = t > 0 ? bf2f(p[-NIN]) : 0.f, x0 = bf2f(p[0]), xp = t < 4095 ? bf2f(p[NIN]) : 0.f;
            z[gsel] = xm * cw[chn] + x0 * cw[1536 + chn] + xp * cw[3072 + chn] + cb[chn]; }
        U[i] = z[0] * z[1]; }
}
__device__ __forceinline__ void ph_hyena_naive(const Ctx& C) {
    const float* U = WSP(float, WS_U); const float* HF = WSP(float, WS_HF); const bf16* PX = WSP(bf16, WS_PX); bf16* OB = WSP(bf16, WS_OB);
    const float* cw = INP(IX_CONVW); const float* cb = INP(IX_CONVB);
    for (int i = C.gtid; i < T * 512 / 8; i += C.gthreads) {
        const int c = i & 511, tg = i >> 9, b = tg >> 9, t0 = (tg & 511) * 8;
        float acc[8], tap[8];
#pragma unroll
        for (int j = 0; j < 8; ++j) { acc[j] = 0.f; tap[j] = HF[(size_t)(t0 + j + 4096) * 512 + c]; }
        const float* up = U + (size_t)b * SEQ * 512 + c; const float* hp = HF + (size_t)(t0 + 4095) * 512 + c;
        for (int s = 0; s < SEQ; ++s) { const float uv = up[(size_t)s * 512]; const float nt = hp[-(long)s * 512];
#pragma unroll
            for (int j = 0; j < 8; ++j) acc[j] += uv * tap[j];
#pragma unroll
            for (int j = 7; j > 0; --j) tap[j] = tap[j - 1];
            tap[0] = nt; }
#pragma unroll
        for (int j = 0; j < 8; ++j) { const int t = t0 + j; const size_t r = (size_t)b * SEQ + t; const bf16* p = PX + r * NIN + C_HY + c;
            const float xm = t > 0 ? bf2f(p[-NIN]) : 0.f, x0 = bf2f(p[0]), xp = t < 4095 ? bf2f(p[NIN]) : 0.f;
            const float z0 = xm * cw[c] + x0 * cw[1536 + c] + xp * cw[3072 + c] + cb[c];
            OB[r * 512 + c] = (bf16)f2bf(z0 * acc[j]); }
    }
}
__device__ __forceinline__ void ph_attn_post(const Ctx& C) {
    const float* O = WSP(float, WS_OATT); bf16* OA = WSP(bf16, WS_OA); const float lam = *WSP(float, WS_LAM); const float* sg = INP(IX_SUBG);
    for (int it = C.gwave; it < T * 4; it += C.nwaves) { const int r = it >> 2, h = it & 3; const float* p = O + (size_t)r * 1024 + h * 256 + C.lane;
        const float o0 = p[0] - lam * p[128], o1 = p[64] - lam * p[192];
        const float rstd = rsqrtf(wave_sum(o0 * o0 + o1 * o1) * (1.0f / 128.0f) + EPS);
        OA[(size_t)r * 512 + h * 128 + C.lane] = (bf16)f2bf(o0 * rstd * sg[C.lane] * 0.8f); OA[(size_t)r * 512 + h * 128 + 64 + C.lane] = (bf16)f2bf(o1 * rstd * sg[64 + C.lane] * 0.8f); }
}
__device__ __forceinline__ void ph_gate(const Ctx& C) {
    const float* TA = WSP(float, WS_TA); const float* TB = WSP(float, WS_TB); const bf16* GT = WSP(bf16, WS_GT); bf16* MB = WSP(bf16, WS_MB);
    for (int i = C.gtid; i < T * 256; i += C.gthreads) { const int r = i >> 8, c = (i & 255) * 4; const f32x4 a = *(const f32x4*)(TA + (size_t)r * 1024 + c), b = *(const f32x4*)(TB + (size_t)r * 1024 + c);
        const bf16* g = GT + (size_t)r * 2048 + c; float o[4];
#pragma unroll
        for (int e = 0; e < 4; ++e) o[e] = bf2f(g[e]) * a[e] + bf2f(g[1024 + e]) * b[e];
        *(unsigned long long*)(MB + (size_t)r * 1024 + c) = (unsigned long long)pk2(o[0], o[1]) | ((unsigned long long)pk2(o[2], o[3]) << 32); }
}
__device__ __forceinline__ void ph_router(const Ctx& C) {
    const float* MOD = WSP(float, WS_MOD); const float* TM = WSP(float, WS_TM); bf16* H = WSP(bf16, WS_H); const float* g2n = INP(IX_N2G); const float* RW = INP(IX_RW);
    int* TOPE = WSP(int, WS_TOPE); float* TOPW = WSP(float, WS_TOPW); unsigned* CNT = WSP(unsigned, WS_CTL) + CW_CNT;
    LAS unsigned* hist = (LAS unsigned*)C.lds;
    if (C.tid < 32) hist[C.tid] = 0u;
    __syncthreads();
    for (int r = C.gwave; r < T; r += C.nwaves) {
        const float* mrow = MOD + (r >> 12) * 6144;
        f32x4 v[4]; float ss = 0.f;
#pragma unroll
        for (int j = 0; j < 4; ++j) { const int col = 4 * C.lane + 256 * j; const f32x4 x = *(const f32x4*)(INP(IX_X) + (size_t)r * DM + col), tm = *(const f32x4*)(TM + (size_t)r * DM + col), g1 = *(const f32x4*)(mrow + 2048 + col);
            v[j] = x + g1 * tm; *(f32x4*)(C.out + (size_t)r * DM + col) = v[j]; ss += (v[j].x * v[j].x + v[j].y * v[j].y) + (v[j].z * v[j].z + v[j].w * v[j].w); }
        const float rstd = rsqrtf(wave_sum(ss) * (1.0f / DM) + EPS);
        f32x4 y[4];
#pragma unroll
        for (int j = 0; j < 4; ++j) { const int col = 4 * C.lane + 256 * j; const f32x4 gg = *(const f32x4*)(g2n + col), sh = *(const f32x4*)(mrow + 3072 + col), sc = *(const f32x4*)(mrow + 4096 + col);
            y[j] = v[j] * rstd * gg * (sc + 1.0f) + sh;
            *(unsigned long long*)(H + (size_t)r * DM + col) = (unsigned long long)pk2(y[j].x, y[j].y) | ((unsigned long long)pk2(y[j].z, y[j].w) << 32); }
        LAS float* lg = (LAS float*)(C.lds + 1024) + C.wave * 32;
#pragma unroll 1
        for (int e = 0; e < 32; ++e) { float a = 0.f;
#pragma unroll
            for (int j = 0; j < 4; ++j) { const float* wr = RW + (size_t)(4 * C.lane + 256 * j) * 32 + e; a += y[j].x * wr[0] + y[j].y * wr[32] + y[j].z * wr[64] + y[j].w * wr[96]; }
            a = wave_sum(a) + INP(IX_RB)[e];
            if (C.lane == 0) lg[e] = a; }
        LDS_WAIT();
        float p[32];
#pragma unroll
        for (int e = 0; e < 32; ++e) p[e] = lg[e];
        unsigned taken = 0u; float tv[4]; int ti[4];
#pragma unroll
        for (int k = 0; k < 4; ++k) { float best = -INFINITY; int bi = 0;
#pragma unroll
            for (int e = 0; e < 32; ++e) { const bool ok = !((taken >> e) & 1u) && p[e] > best; best = ok ? p[e] : best; bi = ok ? e : bi; }
            taken |= 1u << bi; tv[k] = best; ti[k] = bi; }
        const float e1 = __expf(tv[1] - tv[0]), e2 = __expf(tv[2] - tv[0]), e3 = __expf(tv[3] - tv[0]); const float inv = 1.0f / (1.0f + e1 + e2 + e3);
        if (C.lane == 0) { *(int4*)(TOPE + (size_t)r * 4) = make_int4(ti[0], ti[1], ti[2], ti[3]); *(f32x4*)(TOPW + (size_t)r * 4) = (f32x4){inv, e1 * inv, e2 * inv, e3 * inv};
            atomicAdd((unsigned*)&hist[ti[0]], 1u); atomicAdd((unsigned*)&hist[ti[1]], 1u); atomicAdd((unsigned*)&hist[ti[2]], 1u); atomicAdd((unsigned*)&hist[ti[3]], 1u); }
    }
    __syncthreads();
    if (C.tid < 32) atomicAdd(CNT + C.tid, hist[C.tid]);
}
__device__ __forceinline__ void ph_sort(const Ctx& C) {
    const unsigned* CNT = WSP(unsigned, WS_CTL) + CW_CNT; const int* TOPE = WSP(int, WS_TOPE); const float* TOPW = WSP(float, WS_TOPW);
    int* TOKPOS = WSP(int, WS_TOKPOS); int* ROWTOK = WSP(int, WS_ROWTOK); float* ROWW = WSP(float, WS_ROWW); int* BLKE = WSP(int, WS_BLKE);
    LAS int* wtot = (LAS int*)C.lds;
    for (int e = blockIdx.x; e < NE; e += gridDim.x) {
        int pstart = 0, cnt = 0, padded = 0;
        for (int i = 0; i <= e; ++i) { pstart += padded; cnt = (int)__hip_atomic_load(CNT + i, __ATOMIC_RELAXED, __HIP_MEMORY_SCOPE_AGENT); padded = (cnt + 255) / 256 * 256; }
        int running = 0;
        for (int a0 = 0; a0 < NA; a0 += NTHREADS) { const int a = a0 + C.tid; const bool flag = TOPE[a] == e;
            const unsigned long long bal = __ballot(flag); const int pre = __popcll(bal & ((1ull << C.lane) - 1ull)), tot = __popcll(bal);
            __syncthreads();
            if (C.lane == 0) wtot[C.wave] = tot;
            __syncthreads();
            int woff = 0, all = 0;
#pragma unroll
            for (int w = 0; w < 8; ++w) { const int x = wtot[w]; woff += (w < C.wave) ? x : 0; all += x; }
            if (flag) { const int pos = pstart + running + woff + pre; ROWTOK[pos] = a >> 2; ROWW[pos] = TOPW[a]; TOKPOS[a] = pos; }
            running += all; }
        for (int i = cnt + C.tid; i < padded; i += NTHREADS) { ROWTOK[pstart + i] = T; ROWW[pstart + i] = 0.f; }
        __syncthreads();
    }
    if (blockIdx.x == gridDim.x - 1) {
        for (int blk = C.tid; blk <= NBLK; blk += NTHREADS) { int pend = 0, e = 0; bool found = false;
            for (int i = 0; i < NE; ++i) { const int cnt = (int)__hip_atomic_load(CNT + i, __ATOMIC_RELAXED, __HIP_MEMORY_SCOPE_AGENT); pend += (cnt + 255) / 256 * 256; if (!found && blk * 256 < pend) { e = i; found = true; } }
            if (blk < NBLK) BLKE[blk] = found ? e : NE - 1; else BLKE[NBLK] = pend / 256; }
    }
}
__device__ __forceinline__ void ph_gather(const Ctx& C) {
    const int nrows = WSP(int, WS_BLKE)[NBLK] * 256; const int* ROWTOK = WSP(int, WS_ROWTOK); const bf16* H = WSP(bf16, WS_H); bf16* HS = WSP(bf16, WS_HS);
    for (int r = C.gwave; r < nrows; r += C.nwaves) { const int tok = ROWTOK[r]; v4u a = {0u, 0u, 0u, 0u}, b = {0u, 0u, 0u, 0u};
        if (tok < T) { a = *(const v4u*)(H + (size_t)tok * DM + C.lane * 16); b = *(const v4u*)(H + (size_t)tok * DM + C.lane * 16 + 8); }
        *(v4u*)(HS + (size_t)r * DM + C.lane * 16) = a; *(v4u*)(HS + (size_t)r * DM + C.lane * 16 + 8) = b; }
}
__device__ __forceinline__ void ph_combine(const Ctx& C) {
    const float* MOD = WSP(float, WS_MOD); const int* TOKPOS = WSP(int, WS_TOKPOS); const unsigned char* Y = WSP(unsigned char, WS_Y);
    typedef float f32x2_t __attribute__((ext_vector_type(2)));
    for (int i0 = C.gtid; i0 < T * 256; i0 += 4 * C.gthreads) {
        int4 ps[4]; f32x4 xo[4], g2[4]; unsigned w[4][4];
#pragma unroll
        for (int q = 0; q < 4; ++q) { const int i = i0 + q * C.gthreads; if (i < T * 256) ps[q] = *(const int4*)(TOKPOS + (size_t)(i >> 8) * 4); }
#pragma unroll
        for (int q = 0; q < 4; ++q) { const int i = i0 + q * C.gthreads; if (i < T * 256) { const int r = i >> 8, c = (i & 255) * 4;
            w[q][0] = *(const unsigned*)(Y + (size_t)ps[q].x * DM + c); w[q][1] = *(const unsigned*)(Y + (size_t)ps[q].y * DM + c); w[q][2] = *(const unsigned*)(Y + (size_t)ps[q].z * DM + c); w[q][3] = *(const unsigned*)(Y + (size_t)ps[q].w * DM + c);
            xo[q] = *(const f32x4*)(C.out + (size_t)r * DM + c); g2[q] = *(const f32x4*)(MOD + (r >> 12) * 6144 + 5120 + c); } }
#pragma unroll
        for (int q = 0; q < 4; ++q) { const int i = i0 + q * C.gthreads; if (i < T * 256) { const int r = i >> 8, c = (i & 255) * 4; f32x4 acc = {0.f, 0.f, 0.f, 0.f};
#pragma unroll
            for (int k = 0; k < 4; ++k) { const f32x2_t lo = __builtin_amdgcn_cvt_pk_f32_fp8((int)w[q][k], false), hi = __builtin_amdgcn_cvt_pk_f32_fp8((int)w[q][k], true); acc.x += lo.x; acc.y += lo.y; acc.z += hi.x; acc.w += hi.y; }
            *(f32x4*)(C.out + (size_t)r * DM + c) = xo[q] + g2[q] * acc * 0.0625f; } }
    }
}
__device__ __forceinline__ unsigned bfx(const v4u& w, int e) { const unsigned d = e < 2 ? w.x : e < 4 ? w.y : e < 6 ? w.z : w.w; return (e & 1) ? (d & 0xffff0000u) : (d << 16); }
__device__ __forceinline__ float bfe(const v4u& w, int e) { return __builtin_bit_cast(float, bfx(w, e)); }
__device__ __forceinline__ void ph_hyena_pre(const Ctx& C) {
    const bf16* HY = WSP(bf16, WS_HY); bf16* UT = WSP(bf16, WS_UT); bf16* CP = WSP(bf16, WS_CP); const float* HF = WSP(float, WS_HF);
    const float* cw = INP(IX_CONVW); const float* cb_ = INP(IX_CONVB);
    LAS bf16* tile = (LAS bf16*)C.lds;
    const int tid = C.tid;
    const bool skew = gridDim.x >= 64 && (gridDim.x & 7) == 0; const int vb0 = skew ? (int)blockIdx.x - 32 : (int)blockIdx.x, vnb = skew ? (int)gridDim.x - 32 : (int)gridDim.x;
    const bool fixc = (vnb & 7) == 0;
    const int tl = tid >> 3, c8 = (tid & 7) * 8;
    float w0[2][8], w1[2][8], w2[2][8], wb[2][8];
    if (fixc) {
#pragma unroll
        for (int gsel = 0; gsel < 2; ++gsel) { const int chn = 512 * (gsel + 1) + ((int)blockIdx.x & 7) * 64 + c8;
#pragma unroll
            for (int e = 0; e < 8; ++e) { w0[gsel][e] = cw[chn + e]; w1[gsel][e] = cw[1536 + chn + e]; w2[gsel][e] = cw[3072 + chn + e]; wb[gsel][e] = cb_[chn + e]; } } }
    const v4u zero4 = {0u, 0u, 0u, 0u};
#define HP_LOAD(IT, M, X, Q) do { const int cb_i = (IT) & 7, tb_i = ((IT) >> 3) & 63, b_i = (IT) >> 9; const int t_i = tb_i * 64 + tl; const size_t r_i = (size_t)b_i * SEQ + t_i; \
        _Pragma("unroll") for (int gsel = 0; gsel < 2; ++gsel) { const bf16* p_ = HY + r_i * 1536 + 512 * (gsel + 1) + cb_i * 64 + c8; \
            M[gsel] = t_i > 0 ? *(const v4u*)(p_ - 1536) : zero4; X[gsel] = *(const v4u*)p_; Q[gsel] = t_i < SEQ - 1 ? *(const v4u*)(p_ + 1536) : zero4; } } while (0)
    v4u cm[2], cx[2], cq[2], nm[2], nx[2], nq[2];
    int it = vb0 < 0 ? 8 * 64 * 8 : vb0;
    if (it < 8 * 64 * 8) HP_LOAD(it, cm, cx, cq);
    for (; it < 8 * 64 * 8; it += vnb) {
        const int cb = it & 7, tb = (it >> 3) & 63, b = it >> 9, c0 = cb * 64, t0 = tb * 64;
        const bool has_n = it + vnb < 8 * 64 * 8;
        if (has_n) HP_LOAD(it + vnb, nm, nx, nq);
        if (!fixc) {
#pragma unroll
            for (int gsel = 0; gsel < 2; ++gsel) { const int chn = 512 * (gsel + 1) + c0 + c8;
#pragma unroll
                for (int e = 0; e < 8; ++e) { w0[gsel][e] = cw[chn + e]; w1[gsel][e] = cw[1536 + chn + e]; w2[gsel][e] = cw[3072 + chn + e]; wb[gsel][e] = cb_[chn + e]; } } }
        float z[2][8];
#pragma unroll
        for (int gsel = 0; gsel < 2; ++gsel)
#pragma unroll
            for (int e = 0; e < 8; ++e) z[gsel][e] = bfe(cm[gsel], e) * w0[gsel][e] + bfe(cx[gsel], e) * w1[gsel][e] + bfe(cq[gsel], e) * w2[gsel][e] + wb[gsel][e];
        __syncthreads();
#pragma unroll
        for (int e = 0; e < 8; ++e) tile[(c8 + e) * 72 + tl] = (bf16)f2bf(z[0][e] * z[1][e]);
        __syncthreads();
        const v4u o = *(const LAS v4u*)(tile + (tid >> 3) * 72 + (tid & 7) * 8);
        *(v4u*)(UT + ((size_t)(c0 + (tid >> 3)) * 8 + b) * SEQ + t0 + (tid & 7) * 8) = o;
        if (has_n) {
#pragma unroll
            for (int gsel = 0; gsel < 2; ++gsel) { cm[gsel] = nm[gsel]; cx[gsel] = nx[gsel]; cq[gsel] = nq[gsel]; } }
    }
#undef HP_LOAD
    __syncthreads();
    LAS float* hfl = (LAS float*)(C.lds + 16384);
    for (int it = vb0 < 0 ? 8 * 128 : vb0; it < 8 * 128; it += vnb) {
        const int cb = it & 7, xb = it >> 3, c0 = cb * 64, x0 = xb * 64, mbase = 8192 - x0 - 70;
        __syncthreads();
        for (int idx = tid; idx < 71 * 64; idx += NTHREADS) { const int lr = idx >> 6, cc = idx & 63, mp = mbase + lr; hfl[lr * 65 + cc] = (mp >= 1 && mp <= 8191) ? HF[(size_t)mp * 512 + c0 + cc] : 0.f; }
        __syncthreads();
        const int c = tid >> 3, x8 = (tid & 7) * 8;
#pragma unroll
        for (int rho = 0; rho < 8; ++rho) { float v[8];
#pragma unroll
            for (int e = 0; e < 8; ++e) v[e] = hfl[(70 - (x8 + e) - rho) * 65 + c];
            v4u o; o.x = pk2(v[0], v[1]); o.y = pk2(v[2], v[3]); o.z = pk2(v[4], v[5]); o.w = pk2(v[6], v[7]);
            *(v4u*)(CP + ((size_t)(c0 + c) * 8 + rho) * 8192 + x0 + x8) = o; }
    }
    __syncthreads();
}
typedef float f32x16_t __attribute__((ext_vector_type(16)));
constexpr int HY_RING = 8, HY_TB = 65536;
__device__ __forceinline__ void ph_hyena_mfma(const Ctx& C) {
    const bf16* UT = WSP(bf16, WS_UT); const bf16* CP = WSP(bf16, WS_CP); bf16* YT = WSP(bf16, WS_YT);
    const int lane = C.lane, n = lane & 31, hh = lane >> 5, b = C.wave;
    LAS unsigned char* ub = C.lds + b * 8192;
    const unsigned ubo = (unsigned)b * 8192u, zrow = (unsigned)(HY_TB + HY_RING * 8192);
    const int rho = (-n) & 7, cn = (n + rho) >> 3;
    if (C.tid < 32) ((LAS unsigned*)(C.lds + HY_TB + HY_RING * 8192))[C.tid] = 0u;
    __syncthreads();
    const int fnb = b >> 2, fks = b & 3;
    const int wfix = 512 - 4 * fnb + 2 * fks + hh - cn;
    for (int c = blockIdx.x; c < 512; c += gridDim.x) {
        const bf16* src = UT + ((size_t)c * 8 + b) * SEQ;
#pragma unroll
        for (int it = 0; it < 8; ++it) { const int g = it * 64 + lane, p = g >> 3, ch = g & 7; const v4u v = *(const v4u*)(src + g * 8);
            *(LAS v4u*)(ub + p * 128 + ((ch ^ ((p >> 1) & 7)) << 4)) = v; }
        asm volatile("s_waitcnt vmcnt(0) lgkmcnt(0)" ::: "memory");
        f32x16_t acc[2][2];
#pragma unroll
        for (int i = 0; i < 2; ++i)
#pragma unroll
            for (int j = 0; j < 2; ++j)
#pragma unroll
                for (int r = 0; r < 16; ++r) acc[i][j][r] = 0.f;
        const bf16* cpl = CP + ((size_t)c * 8 + rho) * 8192;
#define HY_ISSUE2(D_, slot_) do { _Pragma("unroll") for (int h_ = 0; h_ < 2; ++h_) { const int sc_ = (2 * (D_) + h_) > 126 ? 126 : (2 * (D_) + h_); const int W_ = wfix - 8 * (sc_ - 63); \
        __builtin_amdgcn_global_load_lds((const unsigned*)(cpl + 8 * W_), (LAS unsigned*)(C.lds + HY_TB + (slot_) * 16384 + h_ * 8192 + b * 1024), 16, 0, 0); } } while (0)
#define HY_READ(TF, AF, s_, off_) do { const int d_ = (s_) - 63; const LAS unsigned char* tb_ = C.lds + HY_TB + (off_) + lane * 16; \
        _Pragma("unroll") for (int nb = 0; nb < 2; ++nb) _Pragma("unroll") for (int ks = 0; ks < 4; ++ks) TF[nb][ks] = *(const LAS bf16x8*)(tb_ + (nb * 4 + ks) * 1024); \
        _Pragma("unroll") for (int ib = 0; ib < 2; ++ib) { if (ib == 0 ? (d_ <= 31) : (d_ >= -31)) { const int p_ = 32 * ib - d_ + n; const bool v_ = (unsigned)p_ < 64u; \
            const unsigned a0_ = v_ ? (ubo + (unsigned)(p_ * 128 + (((p_ >> 1) & 7) << 4))) : zrow; \
            _Pragma("unroll") for (int ks = 0; ks < 4; ++ks) AF[ib][ks] = *(const LAS bf16x8*)(C.lds + (a0_ ^ (unsigned)((2 * ks + hh) << 4))); } } } while (0)
#define HY_MMA(TF, AF, s_) do { const int d_ = (s_) - 63; if ((s_) <= 126) { _Pragma("unroll") for (int ib = 0; ib < 2; ++ib) { if (ib == 0 ? (d_ <= 31) : (d_ >= -31)) { \
        _Pragma("unroll") for (int ks = 0; ks < 4; ++ks) _Pragma("unroll") for (int nb = 0; nb < 2; ++nb) acc[ib][nb] = __builtin_amdgcn_mfma_f32_32x32x16_bf16(AF[ib][ks], TF[nb][ks], acc[ib][nb], 0, 0, 0); } } } } while (0)
        HY_ISSUE2(0, 0); HY_ISSUE2(1, 1); HY_ISSUE2(2, 2);
        asm volatile("s_waitcnt vmcnt(2)" ::: "memory"); __builtin_amdgcn_s_barrier(); asm volatile("" ::: "memory");
        bf16x8 tfA[2][4], afA[2][4], tfB[2][4], afB[2][4];
        HY_READ(tfA, afA, 0, 0);
#pragma unroll 1
        for (int D = 0; D < 64; ++D) {
            const int slot = D & 3;
            HY_ISSUE2(D + 3, (D + 3) & 3);
            HY_READ(tfB, afB, 2 * D + 1, slot * 16384 + 8192);
            HY_MMA(tfA, afA, 2 * D);
            if (D < 63) HY_READ(tfA, afA, 2 * D + 2, ((D + 1) & 3) * 16384);
            HY_MMA(tfB, afB, 2 * D + 1);
            asm volatile("s_waitcnt vmcnt(2) lgkmcnt(0)" ::: "memory"); __builtin_amdgcn_s_barrier(); asm volatile("" ::: "memory");
        }
#undef HY_ISSUE2
#undef HY_READ
#undef HY_MMA
        asm volatile("s_waitcnt vmcnt(0)" ::: "memory");
        bf16* dst = YT + ((size_t)c * 8 + b) * SEQ;
#pragma unroll
        for (int ib = 0; ib < 2; ++ib)
#pragma unroll
            for (int nb = 0; nb < 2; ++nb)
#pragma unroll
                for (int r = 0; r < 16; ++r) { const int i = 32 * ib + (r & 3) + 8 * (r >> 2) + 4 * hh; dst[64 * i + 32 * nb + n] = (bf16)f2bf(acc[ib][nb][r]); }
        asm volatile("s_waitcnt vmcnt(0) lgkmcnt(0)" ::: "memory"); __builtin_amdgcn_s_barrier(); asm volatile("" ::: "memory");
    }
    __syncthreads();
}
__device__ __forceinline__ void ph_hyena_post(const Ctx& C) {
    const bf16* HY = WSP(bf16, WS_HY); const bf16* YT = WSP(bf16, WS_YT); bf16* OAB = WSP(bf16, WS_OAB);
    const float* cw = INP(IX_CONVW); const float* cb_ = INP(IX_CONVB);
    LAS bf16* tile = (LAS bf16*)C.lds; const int tid = C.tid;
    const int vb0 = (int)blockIdx.x, vnb = (int)gridDim.x; const bool fixc = (vnb & 7) == 0;
    const int tl = tid >> 3, c8 = (tid & 7) * 8;
    float w0[8], w1[8], w2[8], wb[8];
    if (fixc) { const int chn = (vb0 & 7) * 64 + c8;
#pragma unroll
        for (int e = 0; e < 8; ++e) { w0[e] = cw[chn + e]; w1[e] = cw[1536 + chn + e]; w2[e] = cw[3072 + chn + e]; wb[e] = cb_[chn + e]; } }
    const v4u zero4 = {0u, 0u, 0u, 0u};
#define HQ_LOAD(IT, YV, M, X, Q) do { const int cb_i = (IT) & 7, tb_i = ((IT) >> 3) & 63, b_i = (IT) >> 9; const int t_i = tb_i * 64 + tl; \
        YV = *(const v4u*)(YT + ((size_t)(cb_i * 64 + (tid >> 3)) * 8 + b_i) * SEQ + tb_i * 64 + (tid & 7) * 8); \
        const bf16* p_ = HY + ((size_t)b_i * SEQ + t_i) * 1536 + cb_i * 64 + c8; \
        M = *(const v4u*)(p_ - (t_i > 0 ? 1536 : 0)); X = *(const v4u*)p_; Q = *(const v4u*)(p_ + (t_i < SEQ - 1 ? 1536 : 0)); if (t_i == 0) M = zero4; if (t_i == SEQ - 1) Q = zero4; } while (0)
    v4u cy, cm, cx, cq, ny, nm, nx, nq, my, mm, mx, mq;
    int it = vb0;
    if (it < 8 * 64 * 8) HQ_LOAD(it, cy, cm, cx, cq);
    { const int i1_ = it + vnb < 8 * 64 * 8 ? it + vnb : 8 * 64 * 8 - 1; HQ_LOAD(i1_, ny, nm, nx, nq); }
    for (; it < 8 * 64 * 8; it += vnb) {
        const int cb = it & 7, tb = (it >> 3) & 63, b = it >> 9, c0 = cb * 64, t0 = tb * 64;
        const bool has_n = it + vnb < 8 * 64 * 8, has_m = it + 2 * vnb < 8 * 64 * 8;
        { const int i2_ = has_m ? it + 2 * vnb : 8 * 64 * 8 - 1; HQ_LOAD(i2_, my, mm, mx, mq); }
        if (!fixc) { const int chn = c0 + c8;
#pragma unroll
            for (int e = 0; e < 8; ++e) { w0[e] = cw[chn + e]; w1[e] = cw[1536 + chn + e]; w2[e] = cw[3072 + chn + e]; wb[e] = cb_[chn + e]; } }
        __syncthreads();
        *(LAS v4u*)(tile + (tid >> 3) * 72 + (tid & 7) * 8) = cy;
        __syncthreads();
        const int t = t0 + tl, chn = c0 + c8; const size_t r = (size_t)b * SEQ + t;
        float o[8];
#pragma unroll
        for (int e = 0; e < 8; ++e) { const float z0 = bfe(cm, e) * w0[e] + bfe(cx, e) * w1[e] + bfe(cq, e) * w2[e] + wb[e]; o[e] = z0 * bf2f(tile[(c8 + e) * 72 + tl]); }
        v4u w; w.x = pk2(o[0], o[1]); w.y = pk2(o[2], o[3]); w.z = pk2(o[4], o[5]); w.w = pk2(o[6], o[7]);
        *(v4u*)(OAB + r * 1024 + 512 + chn) = w;
        cy = ny; cm = nm; cx = nx; cq = nq; ny = my; nm = mm; nx = mx; nq = mq;
    }
#undef HQ_LOAD
    __syncthreads();
}

__device__ __forceinline__ void v8t_chunk(const bf16* VA, unsigned char* V8T, int b, int h, int tk, int ci) {
    const int d0 = ci >> 7, half = (ci >> 6) & 1, ln = ci & 63, n = ln & 31, kg = ln >> 5;
    const bf16* src = VA + ((size_t)b * SKV + 64 * tk + 32 * half + 4 * kg) * 512 + h * 128 + 32 * d0 + n;
    float v[16];
#pragma unroll
    for (int e = 0; e < 16; ++e) v[e] = bf2f(src[(size_t)((e & 3) + 8 * (e >> 2)) * 512]);
    v4u o; o.x = pg8::pk4_fp8(v[0], v[1], v[2], v[3]); o.y = pg8::pk4_fp8(v[4], v[5], v[6], v[7]); o.z = pg8::pk4_fp8(v[8], v[9], v[10], v[11]); o.w = pg8::pk4_fp8(v[12], v[13], v[14], v[15]);
    *(v4u*)(V8T + ((size_t)((b * 4 + h) * (SKV / 64) + tk) * 512 + ci) * 16) = o;
}
__device__ __forceinline__ void ph_v8t(const Ctx& C) {
    const bf16* VA = WSP(bf16, WS_VA); unsigned char* V8T = WSP(unsigned char, WS_V8T);
    constexpr int NTL = SKV / 64 - 4;
    const bool skew = gridDim.x >= 64; const int t0 = skew ? C.gtid - 32 * NTHREADS : C.gtid, tn = skew ? C.gthreads - 32 * NTHREADS : C.gthreads;
    for (int i = t0 < 0 ? NB * 4 * NTL * 512 : t0; i < NB * 4 * NTL * 512; i += tn) { const int ci = i & 511, tk = 4 + (i >> 9) % NTL, bh = (i >> 9) / NTL; v8t_chunk(VA, V8T, bh >> 2, bh & 3, tk, ci); }
}
__device__ __forceinline__ void ph_v8t_ctx(const Ctx& C, int b, int h0) {
    const bf16* VA = WSP(bf16, WS_VA); unsigned char* V8T = WSP(unsigned char, WS_V8T);
    for (int i = C.tid; i < 2 * 4 * 512; i += NTHREADS) v8t_chunk(VA, V8T, b, h0 + (i >> 11), (i >> 9) & 3, i & 511);
}
__device__ __forceinline__ unsigned char f8b(float v) { return (unsigned char)(pg8::pk4_fp8(v, 0.f, 0.f, 0.f) & 0xffu); }
__device__ __forceinline__ void ph_hyena_pre8(const Ctx& C) {
    const bf16* HY = WSP(bf16, WS_HY); unsigned char* UT = WSP(unsigned char, WS_UT); unsigned char* CP = WSP(unsigned char, WS_CP); const float* HF = WSP(float, WS_HF);
    const float* cw = INP(IX_CONVW); const float* cb_ = INP(IX_CONVB);
    LAS unsigned char* tile = C.lds;
    const int tid = C.tid;
    const bool skew = gridDim.x >= 64 && (gridDim.x & 7) == 0; const int vb0 = skew ? (int)blockIdx.x - 32 : (int)blockIdx.x, vnb = skew ? (int)gridDim.x - 32 : (int)gridDim.x;
    const bool fixc = (vnb & 7) == 0;
    const int tl = tid >> 3, c8 = (tid & 7) * 8;
    float w0[2][8], w1[2][8], w2[2][8], wb[2][8];
    if (fixc) {
#pragma unroll
        for (int gsel = 0; gsel < 2; ++gsel) { const int chn = 512 * (gsel + 1) + ((int)blockIdx.x & 7) * 64 + c8;
#pragma unroll
            for (int e = 0; e < 8; ++e) { w0[gsel][e] = cw[chn + e]; w1[gsel][e] = cw[1536 + chn + e]; w2[gsel][e] = cw[3072 + chn + e]; wb[gsel][e] = cb_[chn + e]; } } }
    const v4u zero4 = {0u, 0u, 0u, 0u};
#define HP_LOAD(IT, M, X, Q) do { const int cb_i = (IT) & 7, tb_i = ((IT) >> 3) & 63, b_i = (IT) >> 9; const int t_i = tb_i * 64 + tl; const size_t r_i = (size_t)b_i * SEQ + t_i; \
        _Pragma("unroll") for (int gsel = 0; gsel < 2; ++gsel) { const bf16* p_ = HY + r_i * 1536 + 512 * (gsel + 1) + cb_i * 64 + c8; \
            M[gsel] = *(const v4u*)(p_ - (t_i > 0 ? 1536 : 0)); X[gsel] = *(const v4u*)p_; Q[gsel] = *(const v4u*)(p_ + (t_i < SEQ - 1 ? 1536 : 0)); if (t_i == 0) M[gsel] = zero4; if (t_i == SEQ - 1) Q[gsel] = zero4; } } while (0)
    v4u cm[2], cx[2], cq[2], nm[2], nx[2], nq[2], mm[2], mx[2], mq[2];
    int it = vb0 < 0 ? 8 * 64 * 8 : vb0;
    if (it < 8 * 64 * 8) HP_LOAD(it, cm, cx, cq);
    if (it < 8 * 64 * 8) { const int i1_ = it + vnb < 8 * 64 * 8 ? it + vnb : 8 * 64 * 8 - 1; HP_LOAD(i1_, nm, nx, nq); }
    for (; it < 8 * 64 * 8; it += vnb) {
        const int cb = it & 7, tb = (it >> 3) & 63, b = it >> 9, c0 = cb * 64, t0 = tb * 64;
        const bool has_n = it + vnb < 8 * 64 * 8, has_m = it + 2 * vnb < 8 * 64 * 8;
        { const int i2_ = has_m ? it + 2 * vnb : 8 * 64 * 8 - 1; HP_LOAD(i2_, mm, mx, mq); }
        if (!fixc) {
#pragma unroll
            for (int gsel = 0; gsel < 2; ++gsel) { const int chn = 512 * (gsel + 1) + c0 + c8;
#pragma unroll
                for (int e = 0; e < 8; ++e) { w0[gsel][e] = cw[chn + e]; w1[gsel][e] = cw[1536 + chn + e]; w2[gsel][e] = cw[3072 + chn + e]; wb[gsel][e] = cb_[chn + e]; } } }
        float z[2][8];
#pragma unroll
        for (int gsel = 0; gsel < 2; ++gsel)
#pragma unroll
            for (int e = 0; e < 8; ++e) z[gsel][e] = bfe(cm[gsel], e) * w0[gsel][e] + bfe(cx[gsel], e) * w1[gsel][e] + bfe(cq[gsel], e) * w2[gsel][e] + wb[gsel][e];
        __syncthreads();
#pragma unroll
        for (int e = 0; e < 8; ++e) tile[(c8 + e) * 80 + tl] = f8b(z[0][e] * z[1][e]);
        __syncthreads();
        const unsigned long long o = *(const LAS unsigned long long*)(tile + (tid >> 3) * 80 + (tid & 7) * 8);
        *(unsigned long long*)(UT + ((size_t)(c0 + (tid >> 3)) * 8 + b) * SEQ + t0 + (tid & 7) * 8) = o;
#pragma unroll
        for (int gsel = 0; gsel < 2; ++gsel) { cm[gsel] = nm[gsel]; cx[gsel] = nx[gsel]; cq[gsel] = nq[gsel]; nm[gsel] = mm[gsel]; nx[gsel] = mx[gsel]; nq[gsel] = mq[gsel]; }
    }
#undef HP_LOAD
    __syncthreads();
    LAS float* hfl = (LAS float*)(C.lds + 16384);
    for (int it2 = vb0 < 0 ? 8 * 128 : vb0; it2 < 8 * 128; it2 += vnb) {
        const int cb = it2 & 7, xb = it2 >> 3, c0 = cb * 64, x0 = xb * 64, mbase = 8192 - x0 - 78;
        __syncthreads();
        for (int idx = tid; idx < 79 * 64; idx += NTHREADS) { const int lr = idx >> 6, cc = idx & 63, mp = mbase + lr; hfl[lr * 65 + cc] = (mp >= 1 && mp <= 8191) ? HF[(size_t)mp * 512 + c0 + cc] * 64.0f : 0.f; }
        __syncthreads();
        const int c = tid >> 3, x8 = (tid & 7) * 8;
#pragma unroll 4
        for (int rho = 0; rho < 16; ++rho) { float v[8];
#pragma unroll
            for (int e = 0; e < 8; ++e) v[e] = hfl[(78 - (x8 + e) - rho) * 65 + c];
            *(unsigned long long*)(CP + ((size_t)(c0 + c) * 16 + rho) * 8192 + x0 + x8) = (unsigned long long)pg8::pk4_fp8(v[0], v[1], v[2], v[3]) | ((unsigned long long)pg8::pk4_fp8(v[4], v[5], v[6], v[7]) << 32); }
    }
    __syncthreads();
}
typedef int v8i_h8 __attribute__((ext_vector_type(8)));
typedef int v4i_h8 __attribute__((ext_vector_type(4)));
constexpr int H8_TB = 32768, H8_Z = 65536;
__device__ __forceinline__ void ph_hyena_mfma8(const Ctx& C) {
    const unsigned char* UT = WSP(unsigned char, WS_UT); const unsigned char* CP = WSP(unsigned char, WS_CP); bf16* YT = WSP(bf16, WS_YT);
    const int lane = C.lane, n = lane & 31, hh = lane >> 5, b = C.wave;
    const unsigned ubo = (unsigned)b * 4096u, zrow = (unsigned)H8_Z;
    const int rho = (-n) & 15, cn = (n + rho) >> 4;
    if (C.tid < 16) ((LAS unsigned*)(C.lds + H8_Z))[C.tid] = 0u;
    __syncthreads();
    const int fh = b >> 2, fnb = (b >> 1) & 1, fhalf = b & 1;
    const int wfix = 256 - 2 * fnb + 2 * hh - cn;
    for (int c = blockIdx.x; c < 512; c += gridDim.x) {
        const unsigned char* src = UT + ((size_t)c * 8 + b) * SEQ;
#pragma unroll
        for (int it = 0; it < 4; ++it) { const int g = it * 64 + lane, p = g >> 2, c4 = g & 3; const v4u v = *(const v4u*)(src + g * 16);
            *(LAS v4u*)(C.lds + ubo + p * 64 + ((c4 ^ ((p >> 2) & 3)) << 4)) = v; }
        asm volatile("s_waitcnt vmcnt(0) lgkmcnt(0)" ::: "memory");
        f32x16_t acc[2][2];
#pragma unroll
        for (int i = 0; i < 2; ++i)
#pragma unroll
            for (int j = 0; j < 2; ++j)
#pragma unroll
                for (int r = 0; r < 16; ++r) acc[i][j][r] = 0.f;
        const unsigned char* cpl = CP + ((size_t)c * 16 + rho) * 8192 + 16 * fhalf;
#define H8_ISSUE(D_, slot_) do { const int sc_ = (2 * (D_) + fh) > 126 ? 126 : (2 * (D_) + fh); const int W_ = wfix - 4 * (sc_ - 63); \
        __builtin_amdgcn_global_load_lds((const unsigned*)(cpl + 16 * W_), (LAS unsigned*)(C.lds + H8_TB + (slot_) * 8192 + b * 1024), 16, 0, 0); } while (0)
#define H8_READ(TF, AF, s_, off_) do { const int d_ = (s_) - 63; const LAS unsigned char* tb_ = C.lds + H8_TB + (off_) + lane * 16; \
        _Pragma("unroll") for (int nb = 0; nb < 2; ++nb) { const v4i_h8 lo_ = *(const LAS v4i_h8*)(tb_ + (nb * 2 + 0) * 1024), hi_ = *(const LAS v4i_h8*)(tb_ + (nb * 2 + 1) * 1024); TF[nb] = __builtin_shufflevector(lo_, hi_, 0, 1, 2, 3, 4, 5, 6, 7); } \
        _Pragma("unroll") for (int ib = 0; ib < 2; ++ib) { if (ib == 0 ? (d_ <= 31) : (d_ >= -31)) { const int p_ = 32 * ib - d_ + n; const bool v_ = (unsigned)p_ < 64u; \
            const unsigned a0_ = v_ ? (ubo + (unsigned)(p_ * 64 + (((p_ >> 2) & 3) << 4))) : zrow; \
            const v4i_h8 lo_ = *(const LAS v4i_h8*)(C.lds + (a0_ ^ (unsigned)((2 * hh) << 4))), hi_ = *(const LAS v4i_h8*)(C.lds + (a0_ ^ (unsigned)((2 * hh + 1) << 4))); AF[ib] = __builtin_shufflevector(lo_, hi_, 0, 1, 2, 3, 4, 5, 6, 7); } } } while (0)
#define H8_MMA(TF, AF, s_) do { const int d_ = (s_) - 63; if ((s_) <= 126) { _Pragma("unroll") for (int ib = 0; ib < 2; ++ib) { if (ib == 0 ? (d_ <= 31) : (d_ >= -31)) { \
        _Pragma("unroll") for (int nb = 0; nb < 2; ++nb) acc[ib][nb] = __builtin_amdgcn_mfma_scale_f32_32x32x64_f8f6f4(AF[ib], TF[nb], acc[ib][nb], 0, 0, 0, 0x7F7F7F7F, 0, 0x79797979); } } } } while (0)
        H8_ISSUE(0, 0); H8_ISSUE(1, 1); H8_ISSUE(2, 2);
        asm volatile("s_waitcnt vmcnt(1)" ::: "memory"); __builtin_amdgcn_s_barrier(); asm volatile("" ::: "memory");
        v8i_h8 tfA[2], afA[2], tfB[2], afB[2];
#pragma unroll
        for (int i = 0; i < 2; ++i) { afA[i] = (v8i_h8){0, 0, 0, 0, 0, 0, 0, 0}; afB[i] = (v8i_h8){0, 0, 0, 0, 0, 0, 0, 0}; }
        H8_READ(tfA, afA, 0, 0);
#pragma unroll 1
        for (int D = 0; D < 64; ++D) {
            const int slot = D & 3;
            H8_ISSUE(D + 3, (D + 3) & 3);
            H8_READ(tfB, afB, 2 * D + 1, slot * 8192 + 4096);
            H8_MMA(tfA, afA, 2 * D);
            if (D < 63) H8_READ(tfA, afA, 2 * D + 2, ((D + 1) & 3) * 8192);
            H8_MMA(tfB, afB, 2 * D + 1);
            asm volatile("s_waitcnt vmcnt(1) lgkmcnt(0)" ::: "memory"); __builtin_amdgcn_s_barrier(); asm volatile("" ::: "memory");
        }
#undef H8_ISSUE
#undef H8_READ
#undef H8_MMA
        asm volatile("s_waitcnt vmcnt(0)" ::: "memory");
        bf16* dst = YT + ((size_t)c * 8 + b) * SEQ;
#pragma unroll
        for (int ib = 0; ib < 2; ++ib)
#pragma unroll
            for (int nb = 0; nb < 2; ++nb)
#pragma unroll
                for (int r = 0; r < 16; ++r) { const int i = 32 * ib + (r & 3) + 8 * (r >> 2) + 4 * hh; dst[64 * i + 32 * nb + n] = (bf16)f2bf(acc[ib][nb][r]); }
        asm volatile("s_waitcnt vmcnt(0) lgkmcnt(0)" ::: "memory"); __builtin_amdgcn_s_barrier(); asm volatile("" ::: "memory");
    }
    __syncthreads();
}
constexpr int LDS_HIST = RING_BYTES + 1024, LDS_LG = RING_BYTES + 2048;
__device__ __forceinline__ void ph_router2(const Ctx& C) {
    const float* MOD = WSP(float, WS_MOD); const float* SSQ = WSP(float, WS_SSQ); bf16* H = WSP(bf16, WS_H); const float* g2n = INP(IX_N2G); const float* RW = INP(IX_RW);
    int* TOPE = WSP(int, WS_TOPE); float* TOPW = WSP(float, WS_TOPW); unsigned* CNTB = WSP(unsigned, WS_CNTB);
    LAS unsigned* hist = (LAS unsigned*)(C.lds + LDS_HIST);
    const int lane = C.lane, tid = C.tid;
    for (int i = tid; i < 1024 * 8; i += NTHREADS) { const int k = i >> 3, ch = i & 7; const f32x4 w = *(const f32x4*)(RW + (size_t)k * 32 + ch * 4);
        *(LAS f32x4*)(C.lds + k * 128 + ((ch ^ ((k >> 1) & 7)) << 4)) = w; }
    const float rb = INP(IX_RB)[lane >> 1];
    for (int chk = blockIdx.x; chk < T / 128; chk += gridDim.x) {
        __syncthreads();
        if (tid < 32) hist[tid] = 0u;
        __syncthreads();
#pragma unroll 1
        for (int ri = 0; ri < 16; ++ri) {
            const int r = chk * 128 + C.wave * 16 + ri; const float* mrow = MOD + (r >> 12) * 6144;
            float v[16]; float ss = 0.f;
#pragma unroll
            for (int m = 0; m < 16; ++m) { const int col = lane + 64 * m; v[m] = C.out[(size_t)r * DM + col]; }
            ss = lane < 16 ? SSQ[(size_t)r * 16 + lane] : 0.f;
            const float rstd = rsqrtf(wave_sum(ss) * (1.0f / DM) + EPS);
            float p[32];
#pragma unroll
            for (int e = 0; e < 32; ++e) p[e] = 0.f;
#pragma unroll
            for (int m = 0; m < 16; ++m) { const int col = lane + 64 * m; const float y = v[m] * rstd * g2n[col] * (mrow[4096 + col] + 1.0f) + mrow[3072 + col];
                H[(size_t)r * DM + col] = (bf16)f2bf(y);
                const LAS unsigned char* wrow = C.lds + col * 128; const int sw = (col >> 1) & 7; asm volatile("" ::: "memory");
#pragma unroll
                for (int q = 0; q < 8; ++q) { const f32x4 w = *(const LAS f32x4*)(wrow + ((q ^ sw) << 4)); p[4 * q] += y * w.x; p[4 * q + 1] += y * w.y; p[4 * q + 2] += y * w.z; p[4 * q + 3] += y * w.w; } }
#define HALVE(N_, MASK_) _Pragma("unroll") for (int e = 0; e < (N_); ++e) { const float a = p[e], b2 = p[e + (N_)]; const bool up = (lane & (MASK_)) != 0; const float send = up ? a : b2, keep = up ? b2 : a; p[e] = keep + __shfl_xor(send, (MASK_)); }
            HALVE(16, 32) HALVE(8, 16) HALVE(4, 8) HALVE(2, 4) HALVE(1, 2)
#undef HALVE
            float lg = p[0] + __shfl_xor(p[0], 1) + rb;
            const int myid = lane >> 1;
            float tv[4]; int ti[4];
#pragma unroll
            for (int k = 0; k < 4; ++k) { float bv = lg; int bi = myid;
#pragma unroll
                for (int mask = 2; mask < 64; mask <<= 1) { const float ov = __shfl_xor(bv, mask); const int oi = __shfl_xor(bi, mask); const bool take = ov > bv || (ov == bv && oi < bi); bv = take ? ov : bv; bi = take ? oi : bi; }
                tv[k] = bv; ti[k] = bi; if (myid == bi) lg = -INFINITY; }
            const float e1 = __expf(tv[1] - tv[0]), e2 = __expf(tv[2] - tv[0]), e3 = __expf(tv[3] - tv[0]); const float inv = 1.0f / (1.0f + e1 + e2 + e3);
            if (lane == 0) { *(int4*)(TOPE + (size_t)r * 4) = make_int4(ti[0], ti[1], ti[2], ti[3]); *(f32x4*)(TOPW + (size_t)r * 4) = (f32x4){inv, e1 * inv, e2 * inv, e3 * inv};
                __hip_atomic_fetch_add(&hist[ti[0]], 1u, __ATOMIC_RELAXED, __HIP_MEMORY_SCOPE_WORKGROUP); __hip_atomic_fetch_add(&hist[ti[1]], 1u, __ATOMIC_RELAXED, __HIP_MEMORY_SCOPE_WORKGROUP);
                __hip_atomic_fetch_add(&hist[ti[2]], 1u, __ATOMIC_RELAXED, __HIP_MEMORY_SCOPE_WORKGROUP); __hip_atomic_fetch_add(&hist[ti[3]], 1u, __ATOMIC_RELAXED, __HIP_MEMORY_SCOPE_WORKGROUP); }
        }
        __syncthreads();
        if (tid < 32) CNTB[chk * 32 + tid] = hist[tid];
    }
    __syncthreads();
}
__device__ __forceinline__ void ph_sort2(const Ctx& C) {
    const unsigned* CNTB = WSP(unsigned, WS_CNTB); const int* TOPE = WSP(int, WS_TOPE); const float* TOPW = WSP(float, WS_TOPW);
    int* TOKPOS = WSP(int, WS_TOKPOS); int* ROWTOK = WSP(int, WS_ROWTOK); float* ROWW = WSP(float, WS_ROWW); int* BLKE = WSP(int, WS_BLKE);
    LAS int* ptot = (LAS int*)C.lds;
    LAS int* pbef = ptot + 512;
    LAS int* tot = pbef + 512;
    LAS int* base = tot + 32;
    LAS int* pst = base + 32;
    LAS int* wt = pst + 64;
    const int tid = C.tid, lane = C.lane;
    for (int chk = blockIdx.x; chk < T / 128; chk += gridDim.x) {
        __syncthreads();
        { const int e = tid & 31, part = tid >> 5; int s = 0, sb = 0;
          for (int c2 = part * 16; c2 < part * 16 + 16; ++c2) { const int v = (int)CNTB[c2 * 32 + e]; s += v; sb += (c2 < chk) ? v : 0; }
          ptot[part * 32 + e] = s; pbef[part * 32 + e] = sb; }
        __syncthreads();
        if (tid < 32) { int s = 0, sb = 0;
#pragma unroll
            for (int pp = 0; pp < 16; ++pp) { s += ptot[pp * 32 + tid]; sb += pbef[pp * 32 + tid]; }
            tot[tid] = s; base[tid] = sb; }
        __syncthreads();
        if (tid < 33) { int ps = 0; for (int i = 0; i < tid; ++i) ps += (tot[i] + 255) / 256 * 256; pst[tid] = ps; }
        __syncthreads();
        const int a = chk * 512 + tid; const int ea = TOPE[a]; int pre = 0;
#pragma unroll 4
        for (int e = 0; e < 32; ++e) { const unsigned long long bal = __ballot(ea == e); if (lane == 0) wt[C.wave * 32 + e] = __popcll(bal); if (ea == e) pre = __popcll(bal & ((1ull << lane) - 1ull)); }
        __syncthreads();
        int woff = 0;
#pragma unroll
        for (int w = 0; w < 8; ++w) woff += (w < C.wave) ? wt[w * 32 + ea] : 0;
        const int pos = pst[ea] + base[ea] + woff + pre;
        ROWTOK[pos] = a >> 2; ROWW[pos] = TOPW[a]; TOKPOS[a] = pos;
        if (chk < NE) { const int e = chk, st = pst[e] + tot[e], en = pst[e + 1]; for (int i = st + tid; i < en; i += NTHREADS) { ROWTOK[i] = T; ROWW[i] = 0.f; } }
        if (chk == 0 && tid < DM / 16) ((v4u*)(WSP(unsigned char, WS_H) + (size_t)T * DM))[tid] = (v4u){0u, 0u, 0u, 0u};
        if (chk == T / 128 - 1) { for (int blk = tid; blk <= NBLK; blk += NTHREADS) { int e = NE - 1;
#pragma unroll 1
                for (int i = NE - 1; i >= 0; --i) if (blk * 256 < pst[i + 1]) e = i;
                if (blk < NBLK) BLKE[blk] = e; else BLKE[NBLK] = pst[NE] / 256; } }
    }
    __syncthreads();
}
constexpr int LDS_GS = RING_BYTES + 4096;
__device__ __forceinline__ void ph_router3(const Ctx& C) {
    const float* MOD = WSP(float, WS_MOD); const float* SSQ = WSP(float, WS_SSQ); unsigned char* H = WSP(unsigned char, WS_H); const float* g2n = INP(IX_N2G); const float* RW = INP(IX_RW);
    int* TOPE = WSP(int, WS_TOPE); float* TOPW = WSP(float, WS_TOPW); unsigned* CNTB = WSP(unsigned, WS_CNTB);
    LAS unsigned char* Wl = C.lds; LAS float* gsl = (LAS float*)(C.lds + LDS_GS); LAS float* shl = gsl + 1024;
    LAS unsigned* hist = (LAS unsigned*)(C.lds + LDS_HIST);
    const int lane = C.lane, tid = C.tid, i = lane & 15, kk = lane >> 4;
    for (int g = tid; g < 128 * 32; g += NTHREADS) { const int ex = g & 31, kg = g >> 5; float wv[8];
#pragma unroll
        for (int j = 0; j < 8; ++j) wv[j] = RW[(size_t)(8 * kg + j) * 32 + ex];
        unsigned hi[4], lo[4];
#pragma unroll
        for (int j = 0; j < 4; ++j) { hi[j] = pg8::cvt_pk_bf16(wv[2 * j], wv[2 * j + 1]);
            const float r0_ = wv[2 * j] - __uint_as_float(hi[j] << 16), r1_ = wv[2 * j + 1] - __uint_as_float(hi[j] & 0xffff0000u); lo[j] = pg8::cvt_pk_bf16(r0_, r1_); }
        const int Q = kg >> 2, k2 = kg & 3, nb = ex >> 4, n = ex & 15; LAS unsigned char* d = Wl + (((Q * 2 + nb) * 2) * 64 + k2 * 16 + n) * 16;
        *(LAS v4u*)d = (v4u){hi[0], hi[1], hi[2], hi[3]}; *(LAS v4u*)(d + 1024) = (v4u){lo[0], lo[1], lo[2], lo[3]}; }
    const float rb0 = INP(IX_RB)[i], rb1 = INP(IX_RB)[16 + i];
    for (int chk = blockIdx.x; chk < T / 128; chk += gridDim.x) {
        __syncthreads();
        const float* mrow = MOD + (chk >> 5) * 6144;
        for (int k = tid; k < 1024; k += NTHREADS) { gsl[k] = g2n[k] * (1.0f + mrow[4096 + k]); shl[k] = mrow[3072 + k]; }
        if (tid < 32) hist[tid] = 0u;
        __syncthreads();
        const int r0 = chk * 128 + C.wave * 16, r = r0 + i;
        float ss; { const f32x4 s4 = *(const f32x4*)(SSQ + (size_t)r * 16 + 4 * kk); ss = (s4[0] + s4[1]) + (s4[2] + s4[3]); ss += __shfl_xor(ss, 16); ss += __shfl_xor(ss, 32); }
        const float rstd = rsqrtf(ss * (1.0f / DM) + EPS);
        f32x4 acc0 = {0.f, 0.f, 0.f, 0.f}, acc1 = {0.f, 0.f, 0.f, 0.f};
        const float* xr = C.out + (size_t)r * DM + 8 * kk; unsigned char* hr = H + (size_t)r * DM + 8 * kk;
#pragma unroll 4
        for (int Q = 0; Q < 32; ++Q) {
            const f32x4 xa = *(const f32x4*)(xr + 32 * Q), xb = *(const f32x4*)(xr + 32 * Q + 4);
            const f32x4 ga = *(const LAS f32x4*)(gsl + 32 * Q + 8 * kk), gb = *(const LAS f32x4*)(gsl + 32 * Q + 8 * kk + 4), sa = *(const LAS f32x4*)(shl + 32 * Q + 8 * kk), sb = *(const LAS f32x4*)(shl + 32 * Q + 8 * kk + 4);
            const f32x4 ha = xa * rstd * ga + sa, hb = xb * rstd * gb + sb;
            *(unsigned long long*)(hr + 32 * Q) = (unsigned long long)pg8::pk4_fp8(ha[0], ha[1], ha[2], ha[3]) | ((unsigned long long)pg8::pk4_fp8(hb[0], hb[1], hb[2], hb[3]) << 32);
            unsigned hh[4], hl[4];
            hh[0] = pg8::cvt_pk_bf16(ha[0], ha[1]); hh[1] = pg8::cvt_pk_bf16(ha[2], ha[3]); hh[2] = pg8::cvt_pk_bf16(hb[0], hb[1]); hh[3] = pg8::cvt_pk_bf16(hb[2], hb[3]);
            hl[0] = pg8::cvt_pk_bf16(ha[0] - __uint_as_float(hh[0] << 16), ha[1] - __uint_as_float(hh[0] & 0xffff0000u)); hl[1] = pg8::cvt_pk_bf16(ha[2] - __uint_as_float(hh[1] << 16), ha[3] - __uint_as_float(hh[1] & 0xffff0000u));
            hl[2] = pg8::cvt_pk_bf16(hb[0] - __uint_as_float(hh[2] << 16), hb[1] - __uint_as_float(hh[2] & 0xffff0000u)); hl[3] = pg8::cvt_pk_bf16(hb[2] - __uint_as_float(hh[3] << 16), hb[3] - __uint_as_float(hh[3] & 0xffff0000u));
            const pg8::bf16x8 ah = __builtin_bit_cast(pg8::bf16x8, (v4u){hh[0], hh[1], hh[2], hh[3]}), al = __builtin_bit_cast(pg8::bf16x8, (v4u){hl[0], hl[1], hl[2], hl[3]});
            const LAS unsigned char* wq = Wl + (size_t)(Q * 4) * 1024 + lane * 16;
            const pg8::bf16x8 w0h = *(const LAS pg8::bf16x8*)(wq), w0l = *(const LAS pg8::bf16x8*)(wq + 1024), w1h = *(const LAS pg8::bf16x8*)(wq + 2048), w1l = *(const LAS pg8::bf16x8*)(wq + 3072);
            acc0 = __builtin_amdgcn_mfma_f32_16x16x32_bf16(ah, w0h, acc0, 0, 0, 0); acc1 = __builtin_amdgcn_mfma_f32_16x16x32_bf16(ah, w1h, acc1, 0, 0, 0);
            acc0 = __builtin_amdgcn_mfma_f32_16x16x32_bf16(ah, w0l, acc0, 0, 0, 0); acc1 = __builtin_amdgcn_mfma_f32_16x16x32_bf16(ah, w1l, acc1, 0, 0, 0);
            acc0 = __builtin_amdgcn_mfma_f32_16x16x32_bf16(al, w0h, acc0, 0, 0, 0); acc1 = __builtin_amdgcn_mfma_f32_16x16x32_bf16(al, w1h, acc1, 0, 0, 0);
        }
#pragma unroll
        for (int reg = 0; reg < 4; ++reg) {
            float v0 = acc0[reg] + rb0, v1 = acc1[reg] + rb1; float tv[4]; int ti[4];
#pragma unroll
            for (int k = 0; k < 4; ++k) { const bool f0 = v0 >= v1; float bv = f0 ? v0 : v1; int bi = f0 ? i : 16 + i;
#pragma unroll
                for (int mask = 1; mask < 16; mask <<= 1) { const float ov = __shfl_xor(bv, mask); const int oi = __shfl_xor(bi, mask); const bool take = ov > bv || (ov == bv && oi < bi); bv = take ? ov : bv; bi = take ? oi : bi; }
                tv[k] = bv; ti[k] = bi; if (bi == i) v0 = -INFINITY; if (bi == 16 + i) v1 = -INFINITY; }
            const float e1 = __expf(tv[1] - tv[0]), e2 = __expf(tv[2] - tv[0]), e3 = __expf(tv[3] - tv[0]); const float inv = 1.0f / (1.0f + e1 + e2 + e3);
            if (i == 0) { const size_t row = (size_t)(r0 + 4 * kk + reg); *(int4*)(TOPE + row * 4) = make_int4(ti[0], ti[1], ti[2], ti[3]); *(f32x4*)(TOPW + row * 4) = (f32x4){inv, e1 * inv, e2 * inv, e3 * inv};
                __hip_atomic_fetch_add(&hist[ti[0]], 1u, __ATOMIC_RELAXED, __HIP_MEMORY_SCOPE_WORKGROUP); __hip_atomic_fetch_add(&hist[ti[1]], 1u, __ATOMIC_RELAXED, __HIP_MEMORY_SCOPE_WORKGROUP);
                __hip_atomic_fetch_add(&hist[ti[2]], 1u, __ATOMIC_RELAXED, __HIP_MEMORY_SCOPE_WORKGROUP); __hip_atomic_fetch_add(&hist[ti[3]], 1u, __ATOMIC_RELAXED, __HIP_MEMORY_SCOPE_WORKGROUP); }
        }
        __syncthreads();
        if (tid < 32) CNTB[chk * 32 + tid] = hist[tid];
    }
    __syncthreads();
}
__device__ __forceinline__ void ph_attention(const Ctx& C) {
    const unsigned char* Q8 = WSP(unsigned char, WS_QP); const unsigned char* K8 = WSP(unsigned char, WS_KA); const unsigned char* V8T = WSP(unsigned char, WS_V8T); bf16* OA = WSP(bf16, WS_OAB);
    const float lam = *WSP(float, WS_LAM); const float* sg = INP(IX_SUBG);
    const float sbound = 0.20358f * sqrtf(__uint_as_float(WSP(unsigned, WS_CTL)[CW_NMAX]) * __uint_as_float(WSP(unsigned, WS_CTL)[CW_NMAX + 64]));
    const bool nomax = __builtin_amdgcn_readfirstlane((int)(sbound > 0.f && sbound <= 15.6f)) != 0;
    const bool xl = gridDim.x == 256;
#define ATT_UNITS(NM) for (int it = 0; it < (xl ? 4 : (NB * 4 * (SEQ / 128) + (int)gridDim.x - 1) / (int)gridDim.x); ++it) { \
        int u; \
        if (xl) { const int x = blockIdx.x & 7, j = blockIdx.x >> 3; u = ((4 * x + it) << 5) | j; } else { u = blockIdx.x + it * gridDim.x; if (u >= NB * 4 * (SEQ / 128)) break; } \
        const int qb = u & 31, h = (u >> 5) & 3, b = u >> 7; \
        const long q0 = ((long)b * SEQ + qb * 128) * 512 + h * 128, k0 = (long)b * SKV * 512 + h * 128, o0 = ((long)b * SEQ + qb * 128) * 1024 + h * 128, v0 = (long)(b * 4 + h) * (SKV / 64) * 8192; \
        __syncthreads(); \
        att::attn_diff_body8<NM>(Q8 + q0, K8 + k0, V8T + v0, OA + o0, SKV, C.ldsg, C.lds, lam, sg, 0.8f); }
    if (nomax) { ATT_UNITS(true) } else { ATT_UNITS(false) }
#undef ATT_UNITS
    __syncthreads();
}
enum { PH_PREP = 0, PH_MOD1, PH_INPROJ, PH_POST, PH_ATTN, PH_HYENA, PH_ATTNPOST, PH_MERGEUP, PH_WOUT, PH_ROUTER, PH_SORT, PH_MOE1, PH_MOE2, PH_COMBINE, N_PHASES };
struct Args { const float* in[N_INPUTS]; float* out; unsigned char* ws; int ph_lo, ph_hi, li, pad; };
static_assert(sizeof(Args) == N_INPUTS * 8 + 8 + 8 + 16, "Args has no padding");

#ifndef PG8_ALIGN
#define PG8_ALIGN true
#endif
namespace cg = cooperative_groups;
__global__ void __launch_bounds__(NTHREADS, 2) fwd(Args args) {
    cg::grid_group grid_g = cg::this_grid();
    extern __shared__ __attribute__((aligned(16))) unsigned char lds_raw[];
    Ctx C;
    C.out = args.out; C.ws = args.ws; C.lds = (LAS unsigned char*)lds_raw; C.ldsg = (char*)lds_raw;
    C.tid = threadIdx.x; C.lane = C.tid & 63; C.wave = __builtin_amdgcn_readfirstlane(C.tid >> 6);
    C.gwave = blockIdx.x * NWAVES + C.wave; C.nwaves = gridDim.x * NWAVES; C.gtid = blockIdx.x * NTHREADS + C.tid; C.gthreads = gridDim.x * NTHREADS;
    const int lo = args.ph_lo, hi = args.ph_hi;
    volatile LAS unsigned* MISC = (volatile LAS unsigned*)(C.lds + MISC_OFF);
    if (C.tid < 32) MISC[C.tid] = 0u;
    __syncthreads();
    unsigned* barw = (unsigned*)(C.ws + WS_CTL) + CW_BAR + args.li * XCD_BAR_WORDS;
    XcdBarrier xbar; xbar.bar = barw; xbar.x = 0; xbar.st = nullptr;
    if (hi - lo > 1) xbar = xcd_barrier_post(barw, MISC + 8);
#define IN(k) (lo <= (k) && (k) < hi)
#define SEAM(k) do { if (IN(k) && IN((k) + 1)) { if (args.li < 0) grid_g.sync(); else xcd_barrier(xbar); } } while (0)
    if (IN(PH_PREP)) { ph_prep_weights(C); __syncthreads(); ph_prep_ada(C); __syncthreads(); ph_prep_misc(C); ph_prep_filter(C); }
    SEAM(PH_PREP);
    if (IN(PH_MOD1)) { ph_modulate1(C); }
    SEAM(PH_MOD1);
    if (IN(PH_INPROJ)) {
        {
            LAS float* tb = (LAS float*)(C.lds + RING_BYTES + 20480);
            for (int i = C.tid; i < 1024; i += NTHREADS) { tb[i] = WSP(float, WS_ROPEC)[i]; tb[1024 + i] = WSP(float, WS_ROPES)[i]; }
            if (C.tid < 64) { tb[2048 + C.tid] = INP(IX_QNG)[C.tid]; tb[2048 + 64 + C.tid] = INP(IX_KNG)[C.tid]; }
            __syncthreads(); }
        {
            pg8::Gemm g{WSP(bf16, WS_XM), WSP(bf16, WS_WIN), T, 3072, DM, 0}; pg8::WinOrder S; S.so.init(T, 3072, gridDim.x, (int)blockIdx.x); S.pn0 = 0;
            pg8::EpiInProj E{WSP(bf16, WS_QP), WSP(bf16, WS_KA), WSP(bf16, WS_VA), WSP(bf16, WS_HY), WSP(bf16, WS_GT), INP(IX_BIN), C.lds, T, SKV, CTX, WSP(unsigned, WS_CTL) + CW_NMAX};
            pg8::gemm_phase<pg8::EpiInProj, pg8::WinOrder, PG8_ALIGN, true>(C.lds, g, S, E); }
        {
            pg8::Gemm g{WSP(bf16, WS_XM8), (const bf16*)(WSP(unsigned char, WS_WG8) - (size_t)12 * 256 * 1024), T, 2048, DM / 2, 0}; pg8::WinOrder S; S.so.init(T, 2048, gridDim.x, (int)blockIdx.x); S.pn0 = 12;
            pg8::EpiInProjT<true> E{WSP(bf16, WS_QP), WSP(bf16, WS_KA), WSP(bf16, WS_VA), WSP(bf16, WS_HY), WSP(bf16, WS_GT), INP(IX_BIN), C.lds, T, SKV, CTX, WSP(unsigned, WS_CTL) + CW_NMAX};
            pg8::gemm_phase<pg8::EpiInProjT<true>, pg8::WinOrder, PG8_ALIGN, true>(C.lds, g, S, E); }
    }
    SEAM(PH_INPROJ);
    if (IN(PH_POST)) {
        {
            LAS float* tb = (LAS float*)(C.lds + RING_BYTES + 20480);
            for (int i = C.tid; i < 1024; i += NTHREADS) { tb[i] = WSP(float, WS_ROPEC)[i]; tb[1024 + i] = WSP(float, WS_ROPES)[i]; }
            if (C.tid < 64) { tb[2048 + C.tid] = INP(IX_QNG)[C.tid]; tb[2048 + 64 + C.tid] = INP(IX_KNG)[C.tid]; }
            __syncthreads(); }
        { pg8::Gemm g{WSP(bf16, WS_XM), WSP(bf16, WS_WIN), MROWS, NIN, DM, 0}; pg8::CtxOrder S{(int)gridDim.x, (int)blockIdx.x};
          pg8::EpiInProj E{WSP(bf16, WS_QP), WSP(bf16, WS_KA), WSP(bf16, WS_VA), WSP(bf16, WS_HY), WSP(bf16, WS_GT), INP(IX_BIN), C.lds, T, SKV, CTX, WSP(unsigned, WS_CTL) + CW_NMAX};
          pg8::gemm_phase<pg8::EpiInProj, pg8::CtxOrder, true, true>(C.lds, g, S, E); }
        asm volatile("s_waitcnt vmcnt(0)" ::: "memory"); __syncthreads();
        if (gridDim.x >= 32 && blockIdx.x >= 16 && blockIdx.x < 32) ph_v8t_ctx(C, (int)blockIdx.x & 7, 2 * (((int)blockIdx.x >> 3) - 2));
        __syncthreads(); ph_hyena_pre8(C); ph_v8t(C); }
    SEAM(PH_POST);
    if (IN(PH_ATTN)) { ph_attention(C); }
    if (IN(PH_HYENA)) { ph_hyena_mfma8(C); }
    SEAM(PH_HYENA);
    if (IN(PH_ATTNPOST)) { ph_hyena_post(C); }
    SEAM(PH_ATTNPOST);
    if (IN(PH_MERGEUP)) {
        pg8::Gemm g{WSP(bf16, WS_OAB), WSP(bf16, WS_WA), T, DM, DM, 0}; pg8::StaticOrder S; S.init(T, DM, gridDim.x, (int)blockIdx.x);
        pg8::EpiMerge E{WSP(bf16, WS_MB), WSP(bf16, WS_GT)}; pg8::gemm_phase<pg8::EpiMerge, pg8::StaticOrder, PG8_ALIGN, true>(C.lds, g, S, E);
    }
    SEAM(PH_MERGEUP);
    if (IN(PH_WOUT)) {
        pg8::Gemm g{WSP(bf16, WS_MB), WSP(bf16, WS_WO), T, DM, DM, 0}; pg8::StaticOrder S; S.init(T, DM, gridDim.x, (int)blockIdx.x);
        pg8::EpiWout E{INP(IX_X), C.out, WSP(float, WS_MOD), WSP(float, WS_SSQ)}; pg8::gemm_phase<pg8::EpiWout, pg8::StaticOrder, PG8_ALIGN, true>(C.lds, g, S, E);
    }
    SEAM(PH_WOUT);
    if (IN(PH_ROUTER)) { ph_router3(C); }
    SEAM(PH_ROUTER);
    if (IN(PH_SORT)) { ph_sort2(C); }
    SEAM(PH_SORT);
    if (IN(PH_MOE1)) {
        const int nblk = WSP(int, WS_BLKE)[NBLK];
        pg8::MoeGatherOrder S; S.so.init(nblk * 256, 2048, gridDim.x, (int)blockIdx.x); S.blke = WSP(int, WS_BLKE); S.tokl = (const LAS unsigned short*)(C.lds + LDS_GS);
        {
            LAS unsigned short* tl = (LAS unsigned short*)(C.lds + LDS_GS); const int* ROWTOK = WSP(int, WS_ROWTOK); pg8::Unit uu;
            LAS int* pml = (LAS int*)(C.lds + LDS_GS + 10240);
            if (C.tid == 0) { for (int ui = 0; ui < 20; ++ui) pml[ui] = S.so.next(ui, uu) ? uu.pm : -1; }
            __syncthreads();
#define TL_LD(u) const int pm##u = pml[u]; int tv##u = 0; if (pm##u >= 0 && C.tid < 256) tv##u = ROWTOK[pm##u * 256 + C.tid];
#define TL_ST(u) if (C.tid < 256) tl[(u) * 256 + C.tid] = (unsigned short)tv##u;
            TL_LD(0) TL_LD(1) TL_LD(2) TL_LD(3) TL_LD(4) TL_LD(5) TL_LD(6) TL_LD(7) TL_LD(8) TL_LD(9) TL_LD(10) TL_LD(11) TL_LD(12) TL_LD(13) TL_LD(14) TL_LD(15) TL_LD(16) TL_LD(17) TL_LD(18) TL_LD(19)
            TL_ST(0) TL_ST(1) TL_ST(2) TL_ST(3) TL_ST(4) TL_ST(5) TL_ST(6) TL_ST(7) TL_ST(8) TL_ST(9) TL_ST(10) TL_ST(11) TL_ST(12) TL_ST(13) TL_ST(14) TL_ST(15) TL_ST(16) TL_ST(17) TL_ST(18) TL_ST(19)
#undef TL_LD
#undef TL_ST
        }
        __syncthreads();
        pg8::Gemm g{WSP(bf16, WS_H), WSP(bf16, WS_W1), nblk * 256, 2048, DM / 2, (size_t)2048 * 1024};
        pg8::EpiSwiglu E{WSP(unsigned char, WS_ACT), INP(IX_EB1), C.lds}; pg8::gemm_phase<pg8::EpiSwiglu, pg8::MoeGatherOrder, PG8_ALIGN, true>(C.lds, g, S, E);
    }
    SEAM(PH_MOE1);
    if (IN(PH_MOE2)) {
        const int nblk = WSP(int, WS_BLKE)[NBLK];
        pg8::Gemm g{WSP(bf16, WS_ACT), WSP(bf16, WS_W2), nblk * 256, DM, DM / 2, (size_t)1024 * 1024}; pg8::MoeOrder S; S.so.init(nblk * 256, DM, gridDim.x, (int)blockIdx.x); S.blke = WSP(int, WS_BLKE);
        pg8::EpiY E{WSP(unsigned char, WS_Y), INP(IX_EB2), WSP(float, WS_ROWW), C.lds}; pg8::gemm_phase<pg8::EpiY, pg8::MoeOrder, PG8_ALIGN, true>(C.lds, g, S, E);
    }
    SEAM(PH_MOE2);
    if (IN(PH_COMBINE)) { ph_combine(C); }
#undef IN
#undef SEAM
}

extern "C" void kernel_launch(void* const* d_in, const int* in_sizes, int n_in, void* d_out, int out_size, void* d_ws, size_t ws_size, hipStream_t stream) {
    static int grid = 0;
    if (grid == 0) {
        if (n_in != N_INPUTS || in_sizes[0] != T * DM || out_size != T * DM || ws_size < WS_END) { fprintf(stderr, "kernel_launch: unexpected shapes n_in %d in0 %d out %d ws %zu (need %zu)\n", n_in, n_in > 0 ? in_sizes[0] : -1, out_size, ws_size, (size_t)WS_END); grid = -1; return; }
        int dev = 0, cus = 0;
        if (hipGetDevice(&dev) != hipSuccess || hipDeviceGetAttribute(&cus, hipDeviceAttributeMultiprocessorCount, dev) != hipSuccess) { grid = -1; return; }
        if (hipFuncSetAttribute((const void*)fwd, hipFuncAttributeMaxDynamicSharedMemorySize, LDS_BYTES) != hipSuccess) { fprintf(stderr, "kernel_launch: hipFuncSetAttribute failed\n"); grid = -1; return; }
        int per_cu = 0;
        if (hipOccupancyMaxActiveBlocksPerMultiprocessor(&per_cu, (const void*)fwd, NTHREADS, LDS_BYTES) != hipSuccess || per_cu < 1) { fprintf(stderr, "kernel_launch: occupancy query says %d blocks per CU\n", per_cu); grid = -1; return; }
        grid = cus;
    }
    if (grid < 0) return;
    (void)hipMemsetAsync((char*)d_ws + WS_CTL, 0, CTL_BYTES, stream);
    Args a{};
    for (int i = 0; i < N_INPUTS; ++i) a.in[i] = (const float*)d_in[i];
    a.out = (float*)d_out; a.ws = (unsigned char*)d_ws;
#ifndef PROBE_DUP
#define PROBE_DUP -1
#endif
    int cuts[5] = {0, N_PHASES, N_PHASES, N_PHASES, N_PHASES}, nl = 1;
    if (PROBE_DUP >= 0) { cuts[1] = PROBE_DUP + 1; cuts[2] = PROBE_DUP; cuts[3] = PROBE_DUP + 1; nl = 4; }
    for (int li = 0; li < (PROBE_DUP >= 0 ? 3 : 1); ++li) {
        if (PROBE_DUP >= 0) { a.ph_lo = li == 0 ? 0 : (li == 1 ? PROBE_DUP : PROBE_DUP + 1); a.ph_hi = li == 2 ? N_PHASES : PROBE_DUP + 1; } else { a.ph_lo = 0; a.ph_hi = N_PHASES; }
        a.li = li; (void)cuts; (void)nl;
        if (a.ph_lo >= a.ph_hi) continue;
        void* kargs[] = {&a};
        const hipError_t le = hipLaunchCooperativeKernel((const void*)fwd, dim3(grid), dim3(NTHREADS), kargs, LDS_BYTES, stream);
        if (le != hipSuccess) fprintf(stderr, "kernel_launch: cooperative launch failed: %s (grid %d)\n", hipGetErrorString(le), grid);
    }
}
```

```cpp
#include <hip/hip_runtime.h>
#include <hip/hip_bf16.h>
#include <hip/hip_cooperative_groups.h>
#include <cstdio>
#include <cstdint>
#include <cmath>
namespace pg8 {
#define PG8_LAS __attribute__((address_space(3)))
typedef unsigned short bf16_t;
typedef short bf16x8 __attribute__((ext_vector_type(8)));
typedef float f32x4 __attribute__((ext_vector_type(4)));
typedef unsigned u32x4 __attribute__((ext_vector_type(4)));
typedef int v4i_t __attribute__((ext_vector_type(4)));
typedef int v8i_t __attribute__((ext_vector_type(8)));
constexpr int EPI_OFF = 131072 + 16384;
constexpr int BM = 256, BK = 64, HALF = 128, HTB = HALF * BK * 2  , STAGE_BYTES = 8 * HTB, NXCD = 8, WGM = 8;

__host__ __device__ __forceinline__ int lds_byte(int r, int c) { const int st = (r >> 4) * 2 + (c >> 5), rr = r & 15, cc = c & 31, ob = rr * 64 + cc * 2; return st * 1024 + (ob ^ (((ob >> 9) & 1) << 5)); }
__host__ __device__ __forceinline__ void stage_rc(int b, int& R, int& C) { const int st = b / 1024, sb = b % 1024, swz = sb ^ (((sb >> 9) & 1) << 5); R = (st >> 1) * 16 + swz / 64; C = (st & 1) * 32 + (swz % 64) / 2; }
__host__ __device__ __forceinline__ int perm32(int rho) { const int n = rho >> 4, i = rho & 15; return 8 * (i >> 2) + 4 * n + (i & 3); }

struct Unit { int pm, pn, be, es; };
struct Gemm { const bf16_t* A; const bf16_t* Bt; int M, N, K; size_t bstride; };

struct StaticOrder {
    static constexpr bool GATHER = false;
    int nM, nN, nwg, G, c;
    __host__ __device__ __forceinline__ void init(int M, int N, int G_, int c_) { nM = M / BM; nN = N / BM; nwg = nM * nN; G = G_; c = c_; }
    __host__ __device__ __forceinline__ bool next(int i, Unit& u) const {
        const long L = (long)i * G + c; if (L >= nwg) return false;
        int wgid = (int)L; { const int q = nwg / NXCD, r = nwg % NXCD, xcd = wgid % NXCD, off = wgid / NXCD; wgid = (xcd < r ? xcd * (q + 1) : r * (q + 1) + (xcd - r) * q) + off; }
        const int nig = WGM * nN, gid = wgid / nig, fm = gid * WGM, gsz = (nM - fm) < WGM ? (nM - fm) : WGM;
        u.pm = fm + ((wgid % nig) % gsz); u.pn = (wgid % nig) / gsz; u.be = 0; u.es = 0; return true;
    }
    __device__ __forceinline__ void a_ready(const Unit&) const {}
    __device__ __forceinline__ void done(const Unit&) const {}
};

__device__ __forceinline__ unsigned cvt_pk_bf16(float lo, float hi) { unsigned r; asm volatile("v_cvt_pk_bf16_f32 %0, %1, %2" : "=v"(r) : "v"(lo), "v"(hi)); return r; }
typedef float f32x2 __attribute__((ext_vector_type(2)));
__device__ __forceinline__ f32x2 gelu_pk(f32x2 v) {
    const f32x2 av = __builtin_elementwise_abs(v), d = av * 0.2316418882f + 1.0f;
    f32x2 t; t.x = __builtin_amdgcn_rcpf(d.x); t.y = __builtin_amdgcn_rcpf(d.y);
    f32x2 q = t * 0.5307027145f + (-0.7265760135f); q = q * t + 0.7107068705f; q = q * t + (-0.142248368f); q = q * t + 0.127414796f; q = q * t;
    const f32x2 s = (v * v) * (-0.72134752044f);
    f32x2 e; e.x = __builtin_amdgcn_exp2f(s.x); e.y = __builtin_amdgcn_exp2f(s.y);
    const f32x2 m = v * (q * e), r = v - m;
    f32x2 o; o.x = v.x < 0.f ? m.x : r.x; o.y = v.y < 0.f ? m.y : r.y; return o;
}

template <int ACT  > struct EpiBf16 {
    static constexpr bool PERM = true, AFTER_DRAIN = false, HAS_MID = false, F8 = false, PREFETCH = false; static constexpr int WSCALE = 0x7F7F7F7F; static_assert(ACT == 0 || ACT == 1, "EpiBf16: ACT is 0 (none) or 1 (gelu_pk)");
    bf16_t* O; int ldc; const float* bias; int split_cols; size_t split_stride; float scale0;
    __device__ __forceinline__ void operator()(const f32x4 (&acc)[2][2][4][2], const Unit& u, int wr, int wc, int fr, int fq) const {
        const int row0 = u.pm * BM + wr * 64 + fr; int colt = u.pn * BM; bf16_t* base = O;
        float sc = 1.f; if (split_cols) { const int t = colt / split_cols; base += (size_t)t * split_stride; colt -= t * split_cols; if (t == 0) sc = scale0; }
        const int col0 = colt + wc * 32 + 8 * fq, bcol0 = u.pn * BM + wc * 32 + 8 * fq;
        f32x4 bv[2][2];
#pragma unroll
        for (int bj = 0; bj < 2; ++bj)
#pragma unroll
            for (int n = 0; n < 2; ++n) bv[bj][n] = bias ? *(const f32x4*)(bias + bcol0 + bj * HALF + 4 * n) : (f32x4){0.f, 0.f, 0.f, 0.f};
#pragma unroll
        for (int ai = 0; ai < 2; ++ai)
#pragma unroll
            for (int m = 0; m < 4; ++m) { bf16_t* rowp = base + (size_t)(row0 + ai * HALF + m * 16) * ldc + col0;
#pragma unroll
                for (int bj = 0; bj < 2; ++bj) { f32x4 v0 = acc[ai][bj][m][0] + bv[bj][0], v1 = acc[ai][bj][m][1] + bv[bj][1];
                    if (ACT == 1) { f32x2 a = gelu_pk((f32x2){v0[0], v0[1]}), b = gelu_pk((f32x2){v0[2], v0[3]}), c = gelu_pk((f32x2){v1[0], v1[1]}), d = gelu_pk((f32x2){v1[2], v1[3]});
                        v0 = (f32x4){a.x, a.y, b.x, b.y}; v1 = (f32x4){c.x, c.y, d.x, d.y}; }
                    v0 = v0 * sc; v1 = v1 * sc; u32x4 w; w.x = cvt_pk_bf16(v0[0], v0[1]); w.y = cvt_pk_bf16(v0[2], v0[3]); w.z = cvt_pk_bf16(v1[0], v1[1]); w.w = cvt_pk_bf16(v1[2], v1[3]);
                    *(u32x4*)(rowp + bj * HALF) = w; } }
    }
};
struct EpiF32 {
    static constexpr bool PERM = false, AFTER_DRAIN = false, HAS_MID = false, F8 = false, PREFETCH = false; static constexpr int WSCALE = 0x7F7F7F7F;
    float* C; int ldc; const float* bias;
    __device__ __forceinline__ void operator()(const f32x4 (&acc)[2][2][4][2], const Unit& u, int wr, int wc, int fr, int fq) const {
        const int row0 = u.pm * BM + wr * 64 + fr, col0 = u.pn * BM + wc * 32 + 4 * fq;
        f32x4 bv[2][2];
#pragma unroll
        for (int bj = 0; bj < 2; ++bj)
#pragma unroll
            for (int n = 0; n < 2; ++n) bv[bj][n] = bias ? *(const f32x4*)(bias + col0 + bj * HALF + n * 16) : (f32x4){0.f, 0.f, 0.f, 0.f};
#pragma unroll
        for (int ai = 0; ai < 2; ++ai)
#pragma unroll
            for (int m = 0; m < 4; ++m) { float* rowp = C + (size_t)(row0 + ai * HALF + m * 16) * ldc + col0;
#pragma unroll
                for (int bj = 0; bj < 2; ++bj)
#pragma unroll
                    for (int n = 0; n < 2; ++n) *(f32x4*)(rowp + bj * HALF + n * 16) = acc[ai][bj][m][n] + bv[bj][n]; }
    }
};
__device__ __forceinline__ void epi_dma(const void* src, PG8_LAS unsigned char* dst) { __builtin_amdgcn_global_load_lds((const unsigned*)src, (PG8_LAS unsigned*)dst, 16, 0, 0); }
__device__ __forceinline__ unsigned pk4_fp8(float a, float b, float c, float d) {
    a = __builtin_fminf(__builtin_fmaxf(a, -448.f), 448.f); b = __builtin_fminf(__builtin_fmaxf(b, -448.f), 448.f); c = __builtin_fminf(__builtin_fmaxf(c, -448.f), 448.f); d = __builtin_fminf(__builtin_fmaxf(d, -448.f), 448.f);
    int w = 0; w = __builtin_amdgcn_cvt_pk_fp8_f32(a, b, w, false); w = __builtin_amdgcn_cvt_pk_fp8_f32(c, d, w, true); return (unsigned)w; }
struct EpiSwiglu {
    static constexpr bool PERM = true, AFTER_DRAIN = false, HAS_MID = false, F8 = true, PREFETCH = true; static constexpr int WSCALE = 0x7A7A7A7A;
    unsigned char* O; const float* b1; PG8_LAS unsigned char* el;
    __device__ __forceinline__ void prefetch(const Unit& u, int slot, int wid, int lane) const {
        if (wid == 0) epi_dma(b1 + (size_t)u.be * 2048 + (lane >> 5) * 1024 + u.pn * HALF + (lane & 31) * 4, el + EPI_OFF + slot * 2048); }
    __device__ __forceinline__ void operator()(const f32x4 (&acc)[2][2][4][2], const Unit& u, int wr, int wc, int fr, int fq) const {
        const int row0 = u.pm * BM + wr * 64 + fr; const int ch0 = u.pn * HALF + wc * 32 + 8 * fq;
        const PG8_LAS float* bb = (const PG8_LAS float*)(el + EPI_OFF + u.es * 2048) + wc * 32 + 8 * fq;
        f32x4 bg[2], bu[2];
#pragma unroll
        for (int n = 0; n < 2; ++n) { bg[n] = *(const PG8_LAS f32x4*)(bb + 4 * n); bu[n] = *(const PG8_LAS f32x4*)(bb + 128 + 4 * n); }
#pragma unroll
        for (int ai = 0; ai < 2; ++ai)
#pragma unroll
            for (int m = 0; m < 4; ++m) { unsigned char* rowp = O + (size_t)(row0 + ai * HALF + m * 16) * 1024 + ch0;
                f32x4 a[2];
#pragma unroll
                for (int n = 0; n < 2; ++n) { const f32x4 g = acc[ai][0][m][n] + bg[n], up = acc[ai][1][m][n] + bu[n];
#pragma unroll
                    for (int e = 0; e < 4; ++e) { const float gg = fminf(g[e], 7.0f), uu = fminf(fmaxf(up[e], -7.0f), 7.0f);
                        const float sg = __builtin_amdgcn_rcpf(1.0f + __builtin_amdgcn_exp2f(-1.702f * 1.4426950408889634f * gg));
                        a[n][e] = (uu + 1.0f) * gg * sg; } }
                *(unsigned long long*)rowp = (unsigned long long)pk4_fp8(a[0][0], a[0][1], a[0][2], a[0][3]) | ((unsigned long long)pk4_fp8(a[1][0], a[1][1], a[1][2], a[1][3]) << 32); }
    }
};
struct EpiY {
    static constexpr bool PERM = true, AFTER_DRAIN = false, HAS_MID = false, F8 = true; static constexpr int WSCALE = 0x7A7A7A7A;
    unsigned char* O; const float* b2; const float* roww; PG8_LAS unsigned char* el;
    static constexpr bool PREFETCH = true;
    __device__ __forceinline__ void prefetch(const Unit& u, int slot, int wid, int lane) const {
        if (wid == 0) epi_dma(b2 + (size_t)u.be * 1024 + u.pn * BM + lane * 4, el + EPI_OFF + slot * 2048);
        if (wid == 1) epi_dma(roww + (size_t)u.pm * BM + lane * 4, el + EPI_OFF + slot * 2048 + 1024); }
    __device__ __forceinline__ void operator()(const f32x4 (&acc)[2][2][4][2], const Unit& u, int wr, int wc, int fr, int fq) const {
        const int row0 = u.pm * BM + wr * 64 + fr; const int col0 = u.pn * BM + wc * 32 + 8 * fq;
        const PG8_LAS float* sl = (const PG8_LAS float*)(el + EPI_OFF + u.es * 2048); const PG8_LAS float* bb = sl + wc * 32 + 8 * fq;
        f32x4 bv[2][2];
#pragma unroll
        for (int bj = 0; bj < 2; ++bj)
#pragma unroll
            for (int n = 0; n < 2; ++n) bv[bj][n] = *(const PG8_LAS f32x4*)(bb + bj * HALF + 4 * n);
#pragma unroll
        for (int ai = 0; ai < 2; ++ai)
#pragma unroll
            for (int m = 0; m < 4; ++m) { const int row = row0 + ai * HALF + m * 16; const float rw = sl[256 + ai * HALF + wr * 64 + m * 16 + fr] * 16.0f; unsigned char* rowp = O + (size_t)row * 1024 + col0;
#pragma unroll
                for (int bj = 0; bj < 2; ++bj) { const f32x4 v0 = (acc[ai][bj][m][0] + bv[bj][0]) * rw, v1 = (acc[ai][bj][m][1] + bv[bj][1]) * rw;
                    *(unsigned long long*)(rowp + bj * HALF) = (unsigned long long)pk4_fp8(v0[0], v0[1], v0[2], v0[3]) | ((unsigned long long)pk4_fp8(v1[0], v1[1], v1[2], v1[3]) << 32); } }
    }
};
struct MoeOrder {
    static constexpr bool GATHER = false;
    StaticOrder so; const int* blke;
    __device__ __forceinline__ bool next(int i, Unit& u) const { if (!so.next(i, u)) return false; u.be = blke[u.pm]; return true; }
    __device__ __forceinline__ void a_ready(const Unit&) const {}
    __device__ __forceinline__ void done(const Unit&) const {}
};
__device__ __forceinline__ void st_bf16x4(bf16_t* p, const f32x4& v) { *(unsigned long long*)p = (unsigned long long)cvt_pk_bf16(v[0], v[1]) | ((unsigned long long)cvt_pk_bf16(v[2], v[3]) << 32); }
template <bool F8_> struct EpiInProjT {
    static constexpr bool PERM = false, AFTER_DRAIN = false, HAS_MID = false, F8 = F8_, PREFETCH = true; static constexpr int WSCALE = F8_ ? 0x7A7A7A7A : 0x7F7F7F7F;
    bf16_t *QP, *KA, *VA, *HY, *GT; const float* bias; PG8_LAS unsigned char* el; int T_, SKV_, CTX_; unsigned* nmax;
    static constexpr int TAB_OFF = 131072 + 20480;
    __device__ __forceinline__ void prefetch(const Unit& u, int slot, int wid, int lane) const { if (wid == 0) epi_dma(bias + 256 * u.pn + lane * 4, el + EPI_OFF + slot * 2048); }
    __device__ __forceinline__ void operator()(const f32x4 (&acc)[2][2][4][2], const Unit& u, int wr, int wc, int fr_, int fq_) const {
        int fr = fr_, fq = fq_; asm volatile("" : "+v"(fr), "+v"(fq));
        const int pn = u.pn;
        if (pn < 4) {
            const bool isk = pn >= 2; const PG8_LAS float* g = (const PG8_LAS float*)(el + TAB_OFF + 8192 + (isk ? 256 : 0)); const PG8_LAS float* bsl = (const PG8_LAS float*)(el + EPI_OFF + u.es * 2048);
            const PG8_LAS float* rc = (const PG8_LAS float*)(el + TAB_OFF); const PG8_LAS float* rs = rc + 1024;
            f32x4 bv[2][2], gv[2][2];
#pragma unroll
            for (int bj = 0; bj < 2; ++bj)
#pragma unroll
                for (int n = 0; n < 2; ++n) { bv[bj][n] = *(const PG8_LAS f32x4*)(bsl + 64 * wc + 32 * bj + 16 * n + 4 * fq); gv[bj][n] = *(const PG8_LAS f32x4*)(g + 32 * bj + 16 * n + 4 * fq); }
            float nrm2 = 0.f;
#pragma unroll
            for (int ai = 0; ai < 2; ++ai)
#pragma unroll
                for (int m = 0; m < 4; ++m) { const int r = u.pm * BM + ai * HALF + wr * 64 + m * 16 + fr;
                    f32x4 x[2][2]; float ss = 0.f;
#pragma unroll
                    for (int bj = 0; bj < 2; ++bj)
#pragma unroll
                        for (int n = 0; n < 2; ++n) { x[bj][n] = acc[ai][bj][m][n] + bv[bj][n]; ss += (x[bj][n][0] * x[bj][n][0] + x[bj][n][1] * x[bj][n][1]) + (x[bj][n][2] * x[bj][n][2] + x[bj][n][3] * x[bj][n][3]); }
                    ss += __shfl_xor(ss, 16); ss += __shfl_xor(ss, 32);
                    const float rstd = rsqrtf(ss * (1.0f / 64.0f) + 1e-6f);
#pragma unroll
                    for (int bj = 0; bj < 2; ++bj)
#pragma unroll
                        for (int n = 0; n < 2; ++n) x[bj][n] = x[bj][n] * rstd * gv[bj][n];
                    { float s2 = 0.f;
#pragma unroll
                      for (int bj = 0; bj < 2; ++bj)
#pragma unroll
                        for (int n = 0; n < 2; ++n) s2 += (x[bj][n][0] * x[bj][n][0] + x[bj][n][1] * x[bj][n][1]) + (x[bj][n][2] * x[bj][n][2] + x[bj][n][3] * x[bj][n][3]);
                      s2 += __shfl_xor(s2, 16); s2 += __shfl_xor(s2, 32); nrm2 = fmaxf(nrm2, s2); }
                    const bool latent = r < T_; const int t = r & 4095;
                    if (latent) {
#pragma unroll
                        for (int bj = 0; bj < 2; ++bj) { const int pos = bj ? (t & 63) : (t >> 6); const f32x4 cs = *(const PG8_LAS f32x4*)(rc + pos * 16 + 4 * fq), sn = *(const PG8_LAS f32x4*)(rs + pos * 16 + 4 * fq);
                            const f32x4 x1 = x[bj][0], x2 = x[bj][1]; x[bj][0] = x1 * cs - x2 * sn; x[bj][1] = x2 * cs + x1 * sn; } }
                    if (!isk) { unsigned char* base = (unsigned char*)QP + (size_t)r * 512 + 256 * (pn & 1) + 64 * wc;
#pragma unroll
                        for (int bj = 0; bj < 2; ++bj)
#pragma unroll
                            for (int n = 0; n < 2; ++n) { const f32x4 v = x[bj][n] * 0.72134752044448170f; *(unsigned*)(base + 32 * bj + 16 * n + 4 * fq) = pk4_fp8(v[0], v[1], v[2], v[3]); } }
                    else { const size_t krow = latent ? (size_t)(r >> 12) * SKV_ + CTX_ + t : (size_t)((r - T_) >> 8) * SKV_ + ((r - T_) & 255); unsigned char* base = (unsigned char*)KA + krow * 512 + 256 * (pn & 1) + 64 * wc;
#pragma unroll
                        for (int bj = 0; bj < 2; ++bj)
#pragma unroll
                            for (int n = 0; n < 2; ++n) { const f32x4 v = x[bj][n]; *(unsigned*)(base + 32 * bj + 16 * n + 4 * fq) = pk4_fp8(v[0], v[1], v[2], v[3]); } }
                }
            nrm2 = fmaxf(nrm2, __shfl_xor(nrm2, 1)); nrm2 = fmaxf(nrm2, __shfl_xor(nrm2, 2)); nrm2 = fmaxf(nrm2, __shfl_xor(nrm2, 4)); nrm2 = fmaxf(nrm2, __shfl_xor(nrm2, 8));
            if (fr == 0 && fq == 0) (void)__hip_atomic_fetch_max(nmax + (isk ? 64 : 0), __float_as_uint(nrm2), __ATOMIC_RELAXED, __HIP_MEMORY_SCOPE_AGENT);
        } else {
            const int kind = pn < 6 ? 0 : (pn < 12 ? 1 : 2);
            const int lc0 = 32 * wc + 8 * fq;
            f32x4 bv[2][2];
#pragma unroll
            for (int bj = 0; bj < 2; ++bj)
#pragma unroll
                for (int n = 0; n < 2; ++n) bv[bj][n] = *(const PG8_LAS f32x4*)((const PG8_LAS float*)(el + EPI_OFF + u.es * 2048) + 128 * bj + lc0 + 4 * n);
#pragma unroll
            for (int ai = 0; ai < 2; ++ai)
#pragma unroll
                for (int m = 0; m < 4; ++m) { const int r = u.pm * BM + ai * HALF + wr * 64 + m * 16 + fr;
                    bf16_t* rowp;
                    if (kind == 0) { const size_t vrow = r < T_ ? (size_t)(r >> 12) * SKV_ + CTX_ + (r & 4095) : (size_t)((r - T_) >> 8) * SKV_ + ((r - T_) & 255); rowp = VA + vrow * 512 + 256 * (pn - 4) + lc0; }
                    else if (kind == 1) rowp = HY + (size_t)r * 1536 + 256 * (pn - 6) + lc0;
                    else rowp = GT + (size_t)r * 2048 + 256 * (pn - 12) + lc0;
#pragma unroll
                    for (int bj = 0; bj < 2; ++bj) { f32x4 v0 = acc[ai][bj][m][0] + bv[bj][0], v1 = acc[ai][bj][m][1] + bv[bj][1];
                        if (kind == 2) {
#pragma unroll
                            for (int e = 0; e < 4; ++e) { v0[e] = __builtin_amdgcn_rcpf(1.0f + __builtin_amdgcn_exp2f(-1.4426950408889634f * v0[e])); v1[e] = __builtin_amdgcn_rcpf(1.0f + __builtin_amdgcn_exp2f(-1.4426950408889634f * v1[e])); } }
                        u32x4 w; w.x = cvt_pk_bf16(v0[0], v0[1]); w.y = cvt_pk_bf16(v0[2], v0[3]); w.z = cvt_pk_bf16(v1[0], v1[1]); w.w = cvt_pk_bf16(v1[2], v1[3]);
                        *(u32x4*)(rowp + bj * HALF) = w; } }
        }
    }
};
typedef EpiInProjT<false> EpiInProj;
struct WinOrder {
    static constexpr bool GATHER = false;
    StaticOrder so; int pn0;
    __device__ __forceinline__ bool next(int i, Unit& u) const { if (!so.next(i, u)) return false; u.pn += pn0; return true; }
    __device__ __forceinline__ void a_ready(const Unit&) const {}
    __device__ __forceinline__ void done(const Unit&) const {}
};
struct CtxOrder {
    static constexpr bool GATHER = false;
    int G, c;
    __device__ __forceinline__ bool next(int i, Unit& u) const { const int L = i * G + c; if (L >= 32) return false; u.pm = 128 + (L & 7); u.pn = 2 + (L >> 3); u.be = 0; u.es = 0; return true; }
    __device__ __forceinline__ void a_ready(const Unit&) const {}
    __device__ __forceinline__ void done(const Unit&) const {}
};

__device__ __forceinline__ float bf_lo(unsigned d) { return __builtin_bit_cast(float, d << 16); }
__device__ __forceinline__ float bf_hi(unsigned d) { return __builtin_bit_cast(float, d & 0xffff0000u); }
struct EpiMerge {
    static constexpr bool PERM = true, AFTER_DRAIN = false, HAS_MID = true, F8 = false, PREFETCH = false; static constexpr int WSCALE = 0x7F7F7F7F;
    bf16_t* O; const bf16_t* GT;
    __device__ __forceinline__ void mid(f32x4 (&acc)[2][2][4][2], const Unit& u, int wr, int wc, int fr_, int fq_) const {
        int fr = fr_, fq = fq_; asm volatile("" : "+v"(fr), "+v"(fq));
        const bf16_t* __restrict__ G = GT;
        const int row0 = u.pm * BM + wr * 64 + fr, col0 = u.pn * BM + wc * 32 + 8 * fq;
#pragma unroll
        for (int ai = 0; ai < 2; ++ai)
#pragma unroll
            for (int mp = 0; mp < 2; ++mp) { u32x4 ga[2][2], gb[2][2];
#pragma unroll
                for (int q = 0; q < 2; ++q) { const bf16_t* gp = G + (size_t)(row0 + ai * HALF + (2 * mp + q) * 16) * 2048 + col0;
#pragma unroll
                    for (int bj = 0; bj < 2; ++bj) { ga[q][bj] = *(const u32x4*)(gp + bj * HALF); gb[q][bj] = *(const u32x4*)(gp + 1024 + bj * HALF); } }
#pragma unroll
                for (int q = 0; q < 2; ++q) { const int m = 2 * mp + q;
#pragma unroll
                    for (int bj = 0; bj < 2; ++bj) { const u32x4 a = ga[q][bj], b = gb[q][bj]; f32x4 r0, r1;
                        r0[0] = bf_lo(a.x) * __builtin_amdgcn_rcpf(bf_lo(b.x)); r0[1] = bf_hi(a.x) * __builtin_amdgcn_rcpf(bf_hi(b.x)); r0[2] = bf_lo(a.y) * __builtin_amdgcn_rcpf(bf_lo(b.y)); r0[3] = bf_hi(a.y) * __builtin_amdgcn_rcpf(bf_hi(b.y));
                        r1[0] = bf_lo(a.z) * __builtin_amdgcn_rcpf(bf_lo(b.z)); r1[1] = bf_hi(a.z) * __builtin_amdgcn_rcpf(bf_hi(b.z)); r1[2] = bf_lo(a.w) * __builtin_amdgcn_rcpf(bf_lo(b.w)); r1[3] = bf_hi(a.w) * __builtin_amdgcn_rcpf(bf_hi(b.w));
                        acc[ai][bj][m][0] = acc[ai][bj][m][0] * r0; acc[ai][bj][m][1] = acc[ai][bj][m][1] * r1; } }
                asm volatile("" ::: "memory"); }
    }
    __device__ __forceinline__ void operator()(const f32x4 (&acc)[2][2][4][2], const Unit& u, int wr, int wc, int fr, int fq) const {
        const bf16_t* __restrict__ G = GT; bf16_t* __restrict__ Or = O;
        const int row0 = u.pm * BM + wr * 64 + fr, col0 = u.pn * BM + wc * 32 + 8 * fq;
#pragma unroll
        for (int ai = 0; ai < 2; ++ai) { u32x4 gb[4][2];
#pragma unroll
            for (int m = 0; m < 4; ++m)
#pragma unroll
                for (int bj = 0; bj < 2; ++bj) gb[m][bj] = *(const u32x4*)(G + (size_t)(row0 + ai * HALF + m * 16) * 2048 + 1024 + col0 + bj * HALF);
#pragma unroll
            for (int m = 0; m < 4; ++m) { bf16_t* rowp = Or + (size_t)(row0 + ai * HALF + m * 16) * 1024 + col0;
#pragma unroll
                for (int bj = 0; bj < 2; ++bj) { const u32x4 b = gb[m][bj]; const f32x4 v0 = acc[ai][bj][m][0], v1 = acc[ai][bj][m][1];
                    u32x4 w; w.x = cvt_pk_bf16(v0[0] * bf_lo(b.x), v0[1] * bf_hi(b.x)); w.y = cvt_pk_bf16(v0[2] * bf_lo(b.y), v0[3] * bf_hi(b.y));
                    w.z = cvt_pk_bf16(v1[0] * bf_lo(b.z), v1[1] * bf_hi(b.z)); w.w = cvt_pk_bf16(v1[2] * bf_lo(b.w), v1[3] * bf_hi(b.w));
                    *(u32x4*)(rowp + bj * HALF) = w; } } }
    }
};
struct EpiWout {
    static constexpr bool PERM = false, AFTER_DRAIN = false, HAS_MID = false, F8 = false, PREFETCH = false; static constexpr int WSCALE = 0x7F7F7F7F;
    const float* X; float* O; const float* MOD; float* SSQ;
    __device__ __forceinline__ void operator()(const f32x4 (&acc)[2][2][4][2], const Unit& u, int wr, int wc, int fr, int fq) const {
        const float* __restrict__ Xr = X; float* __restrict__ Or = O; float* __restrict__ Sr = SSQ;
        const int row0 = u.pm * BM + wr * 64 + fr, col0 = u.pn * BM + wc * 32 + 4 * fq;
        const float* g1p = MOD + (row0 >> 12) * 6144 + 2048 + col0;
        f32x4 g1[2][2];
#pragma unroll
        for (int bj = 0; bj < 2; ++bj)
#pragma unroll
            for (int n = 0; n < 2; ++n) g1[bj][n] = *(const f32x4*)(g1p + bj * HALF + n * 16);
#pragma unroll
        for (int ai = 0; ai < 2; ++ai)
#pragma unroll
            for (int mp = 0; mp < 2; ++mp) { f32x4 xv[2][2][2];
#pragma unroll
                for (int q = 0; q < 2; ++q) { const size_t off = (size_t)(row0 + ai * HALF + (2 * mp + q) * 16) * 1024 + col0;
#pragma unroll
                    for (int bj = 0; bj < 2; ++bj)
#pragma unroll
                        for (int n = 0; n < 2; ++n) xv[q][bj][n] = *(const f32x4*)(Xr + off + bj * HALF + n * 16); }
#pragma unroll
                for (int q = 0; q < 2; ++q) { const int m = 2 * mp + q; const int row = row0 + ai * HALF + m * 16; const size_t off = (size_t)row * 1024 + col0; float ss = 0.f;
#pragma unroll
                    for (int bj = 0; bj < 2; ++bj)
#pragma unroll
                        for (int n = 0; n < 2; ++n) { const f32x4 v = xv[q][bj][n] + g1[bj][n] * acc[ai][bj][m][n];
                            *(f32x4*)(Or + off + bj * HALF + n * 16) = v; ss += (v[0] * v[0] + v[1] * v[1]) + (v[2] * v[2] + v[3] * v[3]); }
                    ss += __shfl_xor(ss, 16); ss += __shfl_xor(ss, 32);
                    if (fq == 0) Sr[(size_t)row * 16 + u.pn * 4 + wc] = ss; } }
    }
};

struct MoeGatherOrder {
    static constexpr bool GATHER = true;
    StaticOrder so; const int* blke; const PG8_LAS unsigned short* tokl;
    __device__ __forceinline__ bool next(int i, Unit& u) const { if (!so.next(i, u)) return false; u.be = blke[u.pm]; return true; }
    __device__ __forceinline__ int gather_tok(int ui, int row) const { return (int)tokl[ui * 256 + row]; }
    __device__ __forceinline__ void a_ready(const Unit&) const {}
    __device__ __forceinline__ void done(const Unit&) const {}
};
template <bool F8> struct FragT { typedef bf16x8 A[4][2]; typedef bf16x8 B[2][2]; };
template <> struct FragT<true> { typedef v8i_t A[4]; typedef v8i_t B[2]; };
template <class Epi, class Sched, bool ALIGN_EPI = false, bool SP2 = false>
__device__ __forceinline__ void gemm_phase(PG8_LAS unsigned char* lds, const Gemm g, const Sched& S, const Epi& E) {
    const int tid = threadIdx.x, wid = __builtin_amdgcn_readfirstlane(tid >> 6), lane = tid & 63, wr = wid >> 2, wc = wid & 3, fr = lane & 15, fq = lane >> 4;
    const int K = g.K, nt = K / BK;
    unsigned voffA[2], voffB[2];
#pragma unroll
    for (int i = 0; i < 2; ++i) { int R, C; stage_rc(tid * 16 + i * 8192, R, C); const int Rb = Epi::PERM ? ((R & ~31) + perm32(R & 31)) : R;
        voffA[i] = (unsigned)(R * K + C) * 2u; voffB[i] = (unsigned)(Rb * K + C) * 2u; }
    const size_t kstep = (size_t)(BK * 2);
    const size_t hstep = (size_t)HALF * K * 2;
    const size_t tstep = 2 * hstep;
    const unsigned ldsw = (unsigned)wid * 1024u;
    const int aoff = lds_byte(wr * 64 + fr, fq * 8), boff = lds_byte(wc * 32 + fr, fq * 8);
    const int aoff8 = aoff, boff8 = boff;
#define PG8_SA(b, h) (((b) * 2 + (h)) * HTB)
#define PG8_SB(b, h) ((4 + (b) * 2 + (h)) * HTB)
#define PG8_STAGE(bufoff, gbase, voff) do { _Pragma("unroll") for (int _i = 0; _i < 2; ++_i) \
        __builtin_amdgcn_global_load_lds((const unsigned*)((const char*)(gbase) + (voff)[_i]), (PG8_LAS unsigned*)(lds + (bufoff) + ldsw + _i * 8192), 16, 0, 0); } while (0)
#define PG8_STAGE_A(bufoff, gbase, h, nx) do { if constexpr (Sched::GATHER) { unsigned gv_[2]; \
        if (nx) { _Pragma("unroll") for (int i_ = 0; i_ < 2; ++i_) { int R_, C_; stage_rc(tid * 16 + i_ * 8192, R_, C_); gv_[i_] = (unsigned)(S.gather_tok(ui + 1, 128 * (h) + R_) * K + C_) * 2u; } } \
        else { gv_[0] = cvA[h][0]; gv_[1] = cvA[h][1]; } \
        PG8_STAGE(bufoff, gbase, gv_); } \
        else { PG8_STAGE(bufoff, (gbase) + (h) * hstep, voffA); } } while (0)
#define PG8_LD32(off_) __builtin_shufflevector(__builtin_bit_cast(v4i_t, *(const PG8_LAS bf16x8*)(lds + (off_))), __builtin_bit_cast(v4i_t, *(const PG8_LAS bf16x8*)(lds + (off_) + 1024)), 0, 1, 2, 3, 4, 5, 6, 7)
#define PG8_LDA(dst, b, h) do { if constexpr (Epi::F8) { _Pragma("unroll") for (int m = 0; m < 4; ++m) dst[m] = PG8_LD32(PG8_SA(b, h) + aoff8 + m * 2048); } else { \
        _Pragma("unroll") for (int m = 0; m < 4; ++m) _Pragma("unroll") for (int k = 0; k < 2; ++k) dst[m][k] = *(const PG8_LAS bf16x8*)(lds + PG8_SA(b, h) + aoff + m * 2048 + k * 1024); } } while (0)
#define PG8_LDB(dst, b, h) do { if constexpr (Epi::F8) { _Pragma("unroll") for (int n = 0; n < 2; ++n) dst[n] = PG8_LD32(PG8_SB(b, h) + boff8 + n * 2048); } else { \
        _Pragma("unroll") for (int n = 0; n < 2; ++n) _Pragma("unroll") for (int k = 0; k < 2; ++k) dst[n][k] = *(const PG8_LAS bf16x8*)(lds + PG8_SB(b, h) + boff + n * 2048 + k * 1024); } } while (0)
#define PG8_MMA(ai, bj, At, Bt) do { __builtin_amdgcn_s_setprio(1); if constexpr (Epi::F8) { \
        _Pragma("unroll") for (int m = 0; m < 4; ++m) _Pragma("unroll") for (int n = 0; n < 2; ++n) \
            acc[ai][bj][m][n] = __builtin_amdgcn_mfma_scale_f32_16x16x128_f8f6f4(Bt[n], At[m], acc[ai][bj][m][n], 0, 0, 0, Epi::WSCALE, 0, 0x7F7F7F7F); \
        _Pragma("unroll") for (int m = 0; m < 4; ++m) _Pragma("unroll") for (int n = 0; n < 2; ++n) asm volatile("" : "+v"(acc[ai][bj][m][n])); } else { \
        _Pragma("unroll") for (int m = 0; m < 4; ++m) _Pragma("unroll") for (int n = 0; n < 2; ++n) _Pragma("unroll") for (int k = 0; k < 2; ++k) \
        acc[ai][bj][m][n] = __builtin_amdgcn_mfma_f32_16x16x32_bf16(Bt[n][k], At[m][k], acc[ai][bj][m][n], 0, 0, 0); } __builtin_amdgcn_s_setprio(0); } while (0)
#define PG8_WAIT_V(n) asm volatile("s_waitcnt vmcnt(" #n ")" ::: "memory")
#define PG8_WAIT_L(n) asm volatile("s_waitcnt lgkmcnt(" #n ")" ::: "memory")
#define PG8_BAR __builtin_amdgcn_s_barrier()
#define PG8_SCHED __builtin_amdgcn_sched_barrier(0)
    Unit cur, nxt; int ui = 0;
    if (!S.next(0, cur)) return;
    f32x4 acc[2][2][4][2];
#pragma unroll
    for (int a = 0; a < 2; ++a)
#pragma unroll
        for (int b = 0; b < 2; ++b)
#pragma unroll
            for (int m = 0; m < 4; ++m)
#pragma unroll
                for (int n = 0; n < 2; ++n) acc[a][b][m][n] = (f32x4){0.f, 0.f, 0.f, 0.f};
    typename FragT<Epi::F8>::A At; typename FragT<Epi::F8>::B B0, B1;
    const char* cA = (const char*)g.A + (Sched::GATHER ? (size_t)0 : (size_t)cur.pm * tstep);
    unsigned cvA[2][2];
    if constexpr (Sched::GATHER) {
#pragma unroll
        for (int h = 0; h < 2; ++h)
#pragma unroll
            for (int i = 0; i < 2; ++i) { int R, Cc; stage_rc(tid * 16 + i * 8192, R, Cc); cvA[h][i] = (unsigned)(S.gather_tok(0, 128 * h + R) * K + Cc) * 2u; } } const char* cB = (const char*)g.Bt + (size_t)cur.be * g.bstride + (size_t)cur.pn * tstep;
    S.a_ready(cur);
    if constexpr (Epi::PREFETCH) E.prefetch(cur, 0, wid, lane);
    if constexpr (SP2) {
        PG8_STAGE(PG8_SB(0, 0), cB, voffB); PG8_STAGE(PG8_SB(0, 1), cB + hstep, voffB); PG8_STAGE_A(PG8_SA(0, 0), cA, 0, false); PG8_STAGE_A(PG8_SA(0, 1), cA, 1, false);
        if (wr == 1) PG8_BAR;
        PG8_WAIT_V(2); PG8_BAR;
        PG8_STAGE(PG8_SB(1, 0), cB + kstep, voffB); PG8_STAGE_A(PG8_SA(1, 0), cA + kstep, 0, false); PG8_STAGE(PG8_SB(1, 1), cB + hstep + kstep, voffB);
        PG8_WAIT_V(6); PG8_BAR;
    } else {
        PG8_STAGE(PG8_SB(0, 0), cB, voffB); PG8_STAGE_A(PG8_SA(0, 0), cA, 0, false); PG8_STAGE(PG8_SB(0, 1), cB + hstep, voffB); PG8_STAGE_A(PG8_SA(0, 1), cA, 1, false);
        if (wr == 1) PG8_BAR;
        PG8_WAIT_V(4); PG8_BAR;
        PG8_STAGE(PG8_SB(1, 0), cB + kstep, voffB); PG8_STAGE_A(PG8_SA(1, 0), cA + kstep, 0, false); PG8_STAGE(PG8_SB(1, 1), cB + hstep + kstep, voffB);
        PG8_WAIT_V(6); PG8_BAR;
    }
    for (;;) {
        const bool has_next = S.next(ui + 1, nxt);
        const char* nA = (has_next && !Sched::GATHER) ? (const char*)g.A + (size_t)nxt.pm * tstep : cA;
 const char* nB = has_next ? (const char*)g.Bt + (size_t)nxt.be * g.bstride + (size_t)nxt.pn * tstep : cB;
        for (int t = 0; t < nt; t += 2) {
            const bool last = (t == nt - 2);
            const char* a1 = cA + (size_t)(t + 1) * kstep;
            const char* a2 = last ? nA : cA + (size_t)(t + 2) * kstep; const char* b2 = last ? nB : cB + (size_t)(t + 2) * kstep;
            const char* a3 = a2 + kstep; const char* b3 = b2 + kstep;
            if (last && has_next) S.a_ready(nxt);
            if constexpr (Epi::HAS_MID) { if (t == nt / 2) E.mid(acc, cur, wr, wc, fr, fq); }
            if constexpr (SP2) {
            PG8_LDB(B0, 0, 0); PG8_LDB(B1, 0, 1); PG8_SCHED; PG8_LDA(At, 0, 0); PG8_STAGE_A(PG8_SA(1, 1), a1, 1, false);
            PG8_WAIT_V(8); PG8_WAIT_L(0); PG8_BAR; PG8_MMA(0, 0, At, B0); PG8_MMA(0, 1, At, B1); PG8_BAR; PG8_SCHED;
            PG8_LDA(At, 0, 1); PG8_STAGE(PG8_SB(0, 0), b2, voffB); PG8_STAGE(PG8_SB(0, 1), b2 + hstep, voffB); PG8_STAGE_A(PG8_SA(0, 0), a2, 0, last && has_next);
            PG8_WAIT_V(8); PG8_WAIT_L(0); PG8_BAR; PG8_MMA(1, 0, At, B0); PG8_MMA(1, 1, At, B1); PG8_BAR; PG8_SCHED;
            PG8_LDB(B0, 1, 0); PG8_LDB(B1, 1, 1); PG8_SCHED; PG8_LDA(At, 1, 0); PG8_STAGE_A(PG8_SA(0, 1), a2, 1, last && has_next);
            PG8_WAIT_V(8); PG8_WAIT_L(0); PG8_BAR; PG8_MMA(0, 0, At, B0); PG8_MMA(0, 1, At, B1); PG8_BAR; PG8_SCHED;
            PG8_LDA(At, 1, 1); PG8_STAGE(PG8_SB(1, 0), b3, voffB); PG8_STAGE(PG8_SB(1, 1), b3 + hstep, voffB); PG8_STAGE_A(PG8_SA(1, 0), a3, 0, last && has_next);
            PG8_WAIT_V(8); PG8_WAIT_L(0); PG8_BAR; PG8_MMA(1, 0, At, B0); PG8_MMA(1, 1, At, B1); PG8_BAR; PG8_SCHED;
            } else {
            PG8_LDB(B0, 0, 0); PG8_SCHED; PG8_LDA(At, 0, 0); PG8_STAGE_A(PG8_SA(1, 1), a1, 1, false);
            PG8_WAIT_L(8); PG8_BAR; PG8_WAIT_L(0); PG8_MMA(0, 0, At, B0); PG8_BAR; PG8_SCHED;
            PG8_LDB(B1, 0, 1); PG8_STAGE(PG8_SB(0, 0), b2, voffB);
            PG8_BAR; PG8_WAIT_L(0); PG8_MMA(0, 1, At, B1); PG8_BAR;
            PG8_LDA(At, 0, 1); PG8_STAGE_A(PG8_SA(0, 0), a2, 0, last && has_next);
            PG8_BAR; PG8_WAIT_L(0); PG8_MMA(1, 0, At, B0); PG8_BAR; PG8_SCHED;
            PG8_STAGE(PG8_SB(0, 1), b2 + hstep, voffB);
            PG8_WAIT_V(6); PG8_BAR; PG8_MMA(1, 1, At, B1); PG8_BAR;
            PG8_LDB(B0, 1, 0); PG8_SCHED; PG8_LDA(At, 1, 0); PG8_STAGE_A(PG8_SA(0, 1), a2, 1, last && has_next);
            PG8_WAIT_L(8); PG8_BAR; PG8_WAIT_L(0); PG8_MMA(0, 0, At, B0); PG8_BAR; PG8_SCHED;
            PG8_LDB(B1, 1, 1); PG8_STAGE(PG8_SB(1, 0), b3, voffB);
            PG8_BAR; PG8_WAIT_L(0); PG8_MMA(0, 1, At, B1); PG8_BAR;
            PG8_LDA(At, 1, 1); PG8_STAGE_A(PG8_SA(1, 0), a3, 0, last && has_next);
            PG8_BAR; PG8_WAIT_L(0); PG8_MMA(1, 0, At, B0); PG8_BAR; PG8_SCHED;
            PG8_STAGE(PG8_SB(1, 1), b3 + hstep, voffB);
            PG8_WAIT_V(6); PG8_BAR; PG8_MMA(1, 1, At, B1); PG8_BAR;
            }
        }
        if constexpr (ALIGN_EPI) { if (wr == 0) PG8_BAR; }
        if constexpr (!Epi::AFTER_DRAIN) { cur.es = ui & 1; E(acc, cur, wr, wc, fr, fq); S.done(cur); }
        if (!has_next) break;
        if constexpr (Epi::PREFETCH) E.prefetch(nxt, (ui + 1) & 1, wid, lane);
#pragma unroll
        for (int a = 0; a < 2; ++a)
#pragma unroll
            for (int b = 0; b < 2; ++b)
#pragma unroll
                for (int m = 0; m < 4; ++m)
#pragma unroll
                    for (int n = 0; n < 2; ++n) acc[a][b][m][n] = (f32x4){0.f, 0.f, 0.f, 0.f};
        cur = nxt; cA = nA; cB = nB; ++ui;
        if constexpr (Sched::GATHER) {
#pragma unroll
            for (int h = 0; h < 2; ++h)
#pragma unroll
                for (int i = 0; i < 2; ++i) { int R, Cc; stage_rc(tid * 16 + i * 8192, R, Cc); cvA[h][i] = (unsigned)(S.gather_tok(ui, 128 * h + R) * K + Cc) * 2u; } }
        if constexpr (ALIGN_EPI) { if (wr == 1) PG8_BAR; }
    }
    PG8_WAIT_V(0);
    if constexpr (!ALIGN_EPI) { if (wr == 0) PG8_BAR; }
    PG8_BAR;
    if constexpr (Epi::AFTER_DRAIN) { E.fused(acc, cur, wr, wc, fr, fq, lds, wid, lane); S.done(cur); }
#undef PG8_SA
#undef PG8_SB
#undef PG8_STAGE
#undef PG8_STAGE_A
#undef PG8_LD32
#undef PG8_LDA
#undef PG8_LDB
#undef PG8_MMA
#undef PG8_WAIT_V
#undef PG8_WAIT_L
#undef PG8_BAR
#undef PG8_SCHED
}
}
namespace att {
using bf16 = __hip_bfloat16;
constexpr int   D = 128, NW = 8, QBLK = 32, KVBLK = 64;
constexpr float SCALE = 0.125f;
constexpr float THR = 8.f;
constexpr int SDEPTH = 2;
constexpr int LDQ = 8 * D, LDK = 4 * D, LDO = LDQ;
constexpr size_t SHM_V = KVBLK * D * 2, SHM_K = KVBLK * D * 2, SHM_ATTN = 2 * SHM_V + 2 * SHM_K + NW * 64 * 4;
using bf16x8 = __attribute__((ext_vector_type(8))) short;
using s16x4  = __attribute__((ext_vector_type(4))) short;
using f32x16 = __attribute__((ext_vector_type(16))) float;
using f32x8  = __attribute__((ext_vector_type(8))) float;
using u32x4  = __attribute__((ext_vector_type(4))) unsigned;
#define KSWZ(row, colB) ((row) * 256 + ((colB) ^ (((row) & 7) << 4)))
#define SBAR() __builtin_amdgcn_sched_barrier(0)
__device__ __forceinline__ int crow(int r, int hi) { return (r & 3) + 8 * (r >> 2) + 4 * hi; }
__device__ __forceinline__ unsigned cvtpk(float lo, float hi) {
  unsigned r; asm volatile("v_cvt_pk_bf16_f32 %0, %1, %2" : "=v"(r) : "v"(lo), "v"(hi)); return r;
}
template <typename TIn> struct Stage;
template <> struct Stage<bf16>  { using T = bf16x8;
  __device__ static __forceinline__ T ld8(const bf16* p) { return *reinterpret_cast<const bf16x8*>(p); }
  __device__ static __forceinline__ bf16x8 tobf(T x) { return x; } };
template <> struct Stage<float> { using T = f32x8;
  __device__ static __forceinline__ T ld8(const float* p) { return *reinterpret_cast<const f32x8*>(p); }
  __device__ static __forceinline__ bf16x8 tobf(T x) {
    u32x4 w = {cvtpk(x[0], x[1]), cvtpk(x[2], x[3]), cvtpk(x[4], x[5]), cvtpk(x[6], x[7])}; return *reinterpret_cast<bf16x8*>(&w); } };

__device__ __forceinline__ void partialSM(f32x16& p0, f32x16& p1, float& m_reg, float& mn, float& alpha) {
  constexpr float C = SCALE * 1.4426950408889634f;
  float pmax = p0[0]; for (int r = 1; r < 16; ++r) pmax = fmaxf(pmax, p0[r]); for (int r = 0; r < 16; ++r) pmax = fmaxf(pmax, p1[r]);
  { auto rr = __builtin_amdgcn_permlane32_swap(__float_as_uint(pmax), __float_as_uint(pmax), false, false);
    pmax = fmaxf(__uint_as_float(rr[0]), __uint_as_float(rr[1])); }
  if (__builtin_expect(__all(pmax - m_reg <= THR / SCALE), 1)) { mn = m_reg; alpha = 1.f; }
  else { mn = fmaxf(m_reg, pmax); alpha = __builtin_amdgcn_exp2f((m_reg - mn) * C); m_reg = mn; }
  float mnC = -mn * C;
  for (int r = 0; r < 16; ++r) p0[r] = fmaf(p0[r], C, mnC); for (int r = 0; r < 16; ++r) p1[r] = fmaf(p1[r], C, mnC);
  for (int r = 0; r < 16; ++r) p0[r] = __builtin_amdgcn_exp2f(p0[r]);
}
__device__ __forceinline__ void finishSM(f32x16& p0, f32x16& p1, float alpha, float& l_reg, bf16x8& pa0, bf16x8& pa1, bf16x8& pa2, bf16x8& pa3) {
  for (int r = 0; r < 16; ++r) p1[r] = __builtin_amdgcn_exp2f(p1[r]);
  float ps = 0; for (int r = 0; r < 16; ++r) ps += p0[r]; for (int r = 0; r < 16; ++r) ps += p1[r];
  { auto rr = __builtin_amdgcn_permlane32_swap(__float_as_uint(ps), __float_as_uint(ps), false, false);
    ps = __uint_as_float(rr[0]) + __uint_as_float(rr[1]); }
  l_reg = l_reg * alpha + ps;
#define PK4(P, BASE, OUT) do { unsigned a0 = cvtpk(P[BASE + 0], P[BASE + 1]), a1 = cvtpk(P[BASE + 2], P[BASE + 3]);   \
    unsigned b0 = cvtpk(P[BASE + 4], P[BASE + 5]), b1 = cvtpk(P[BASE + 6], P[BASE + 7]);                              \
    auto r0 = __builtin_amdgcn_permlane32_swap(a0, b0, false, false); auto r1 = __builtin_amdgcn_permlane32_swap(a1, b1, false, false); \
    u32x4 w = {r0[0], r1[0], r0[1], r1[1]}; OUT = *reinterpret_cast<bf16x8*>(&w); } while (0)
  PK4(p0, 0, pa0); PK4(p0, 8, pa1); PK4(p1, 0, pa2); PK4(p1, 8, pa3);
#undef PK4
}
__device__ __forceinline__ void qkt(f32x16& p0, f32x16& p1, const bf16* Ks, const bf16x8* qr, int r32, int hi) {
  p0 = f32x16{}; p1 = f32x16{};
  for (int d0 = 0; d0 < 8; ++d0) { int cb = (d0 * 16 + hi * 8) * 2;
    bf16x8 b0 = *reinterpret_cast<const bf16x8*>((const char*)Ks + KSWZ(r32, cb));
    bf16x8 b1 = *reinterpret_cast<const bf16x8*>((const char*)Ks + KSWZ(32 + r32, cb));
    p0 = __builtin_amdgcn_mfma_f32_32x32x16_bf16(b0, qr[d0], p0, 0, 0, 0);
    p1 = __builtin_amdgcn_mfma_f32_32x32x16_bf16(b1, qr[d0], p1, 0, 0, 0); }
}
__device__ __forceinline__ int v_st(int k, int c) { const int kk = (k & ~0xC) | ((k & 4) << 1) | ((k & 8) >> 1); return ((kk >> 3) * 4 + (c >> 5)) * 512 + ((kk & 7) * 32 + (c & 31)) * 2; }
__device__ __forceinline__ int v_rd_base(int lane) { return ((lane & 3) << 3) | (((lane >> 2) & 3) << 6) | (((lane >> 4) & 1) << 5) | (((lane >> 5) & 1) << 8); }
constexpr int v_rd_off(int d0, int ks, int half) { return d0 * 512 + ks * 4096 + half * 2048; }
template <int OFF> __device__ __forceinline__ s16x4 tr_read(int vb) {
  s16x4 r; asm volatile("ds_read_b64_tr_b16 %0, %1 offset:%2" : "=&v"(r) : "v"(vb), "i"(OFF) : "memory"); return r;
}
template <int D0> __device__ __forceinline__ void pv_one(f32x16& od, int vb, bf16x8 pa0, bf16x8 pa1, bf16x8 pa2, bf16x8 pa3) {
  const s16x4 l0 = tr_read<v_rd_off(D0, 0, 0)>(vb), h0 = tr_read<v_rd_off(D0, 0, 1)>(vb), l1 = tr_read<v_rd_off(D0, 1, 0)>(vb), h1 = tr_read<v_rd_off(D0, 1, 1)>(vb);
  const s16x4 l2 = tr_read<v_rd_off(D0, 2, 0)>(vb), h2 = tr_read<v_rd_off(D0, 2, 1)>(vb), l3 = tr_read<v_rd_off(D0, 3, 0)>(vb), h3 = tr_read<v_rd_off(D0, 3, 1)>(vb);
  asm volatile("s_waitcnt lgkmcnt(0)" ::: "memory"); SBAR();
#define PK(L, H) (bf16x8){L[0], L[1], L[2], L[3], H[0], H[1], H[2], H[3]}
  od = __builtin_amdgcn_mfma_f32_32x32x16_bf16(pa0, PK(l0, h0), od, 0, 0, 0);
  od = __builtin_amdgcn_mfma_f32_32x32x16_bf16(pa1, PK(l1, h1), od, 0, 0, 0);
  od = __builtin_amdgcn_mfma_f32_32x32x16_bf16(pa2, PK(l2, h2), od, 0, 0, 0);
  od = __builtin_amdgcn_mfma_f32_32x32x16_bf16(pa3, PK(l3, h3), od, 0, 0, 0);
#undef PK
}
__device__ __forceinline__ void pv_d0(f32x16* o, int vb, bf16x8 pa0, bf16x8 pa1, bf16x8 pa2, bf16x8 pa3) {
  pv_one<0>(o[0], vb, pa0, pa1, pa2, pa3); pv_one<1>(o[1], vb, pa0, pa1, pa2, pa3); pv_one<2>(o[2], vb, pa0, pa1, pa2, pa3); pv_one<3>(o[3], vb, pa0, pa1, pa2, pa3);
}

template <typename TQ>
__device__ __forceinline__ void attn_dense_body(const TQ* __restrict__ Qb, const bf16* __restrict__ Kh, const bf16* __restrict__ Vh,
                                                float* __restrict__ Ob, int seq, char* lds) {
  using St = Stage<bf16>; using SQ = Stage<TQ>;
  const int tid = threadIdx.x, wid = tid >> 6, lane = tid & 63, r32 = lane & 31, hi = lane >> 5;
  bf16* V_lds = (bf16*)lds; bf16* K_lds = (bf16*)(lds + 2 * SHM_V);
  float* ws = (float*)(lds + 2 * SHM_V + 2 * SHM_K) + wid * 64; float* li_l = ws; float* al_l = ws + 32;
  float m_reg = -1e30f, l_reg = 0; f32x16 o[4] = {}; bf16x8 qr[8];
  const TQ* Qw = Qb + (long)(wid * QBLK + r32) * LDQ + hi * 8;
#pragma unroll
  for (int d0 = 0; d0 < 8; ++d0) qr[d0] = SQ::tobf(SQ::ld8(Qw + d0 * 16));
  const int sr = tid >> 4, sc = (tid & 15) * 8, vst0 = v_st(sr, sc), vst1 = v_st(32 + sr, sc);
  const int vb0 = (int)(uintptr_t)V_lds + v_rd_base(lane);
  struct { typename St::T vs0, vs1, ks0, ks1; } sr_[SDEPTH];
#define SLOAD(i, k0) do { sr_[i].vs0 = St::ld8(&Vh[(long)((k0) + sr) * LDK + sc]); sr_[i].vs1 = St::ld8(&Vh[(long)((k0) + 32 + sr) * LDK + sc]); \
    sr_[i].ks0 = St::ld8(&Kh[(long)((k0) + sr) * LDK + sc]); sr_[i].ks1 = St::ld8(&Kh[(long)((k0) + 32 + sr) * LDK + sc]); } while (0)
#define SWRITE(b, i) do { *(bf16x8*)((char*)V_lds + (b) * SHM_V + vst0) = St::tobf(sr_[i].vs0);          \
    *(bf16x8*)((char*)V_lds + (b) * SHM_V + vst1) = St::tobf(sr_[i].vs1); int kc = sc * 2;               \
    *(bf16x8*)((char*)K_lds + (b) * SHM_K + KSWZ(sr, kc)) = St::tobf(sr_[i].ks0);                       \
    *(bf16x8*)((char*)K_lds + (b) * SHM_K + KSWZ(32 + sr, kc)) = St::tobf(sr_[i].ks1); } while (0)
#define SWAIT() do { if constexpr (SDEPTH == 2) asm volatile("s_waitcnt vmcnt(4)" ::: "memory"); else asm volatile("s_waitcnt vmcnt(0)" ::: "memory"); } while (0)
#define RESC(a) do { if (__any((a) < 1.f)) { if (hi == 0) al_l[r32] = (a); asm volatile("s_waitcnt lgkmcnt(0)" ::: "memory"); \
    for (int d = 0; d < 4; ++d) for (int r = 0; r < 16; ++r) o[d][r] *= al_l[crow(r, hi)]; } } while (0)
  f32x16 pA0, pA1, pB0, pB1; float mnA, mnB, alA, alB; bf16x8 pa0, pa1, pa2, pa3; const int NT = seq / KVBLK;
  constexpr int SE = 0, SO = SDEPTH - 1;
  SLOAD(SE, 0); asm volatile("s_waitcnt vmcnt(0)" ::: "memory"); SWRITE(0, SE); __syncthreads();
  qkt(pA0, pA1, K_lds, qr, r32, hi); partialSM(pA0, pA1, m_reg, mnA, alA);
  SLOAD(SO, KVBLK); if constexpr (SDEPTH == 2) { if (2 < NT) SLOAD(SE, 2 * KVBLK); }
  SWAIT(); SWRITE(1, SO); __syncthreads();
  for (int j = 1; j + 1 < NT; j += 2) {
    SBAR(); qkt(pB0, pB1, (bf16*)((char*)K_lds + SHM_K), qr, r32, hi);
    finishSM(pA0, pA1, alA, l_reg, pa0, pa1, pa2, pa3); SBAR();
    SLOAD(SO, (j + SDEPTH) * KVBLK); SBAR();
    pv_d0(o, vb0, pa0, pa1, pa2, pa3); partialSM(pB0, pB1, m_reg, mnB, alB);
    __syncthreads(); SWAIT(); SWRITE(0, SE);
    RESC(alB); __syncthreads();
    SBAR(); qkt(pA0, pA1, K_lds, qr, r32, hi);
    finishSM(pB0, pB1, alB, l_reg, pa0, pa1, pa2, pa3); SBAR();
    if (SDEPTH == 1 || j + 3 < NT) SLOAD(SE, (j + 1 + SDEPTH) * KVBLK); SBAR();
    pv_d0(o, vb0 + (int)SHM_V, pa0, pa1, pa2, pa3); partialSM(pA0, pA1, m_reg, mnA, alA);
    __syncthreads(); SWAIT(); SWRITE(1, SO);
    RESC(alA); __syncthreads();
  }
  SBAR(); qkt(pB0, pB1, (bf16*)((char*)K_lds + SHM_K), qr, r32, hi);
  finishSM(pA0, pA1, alA, l_reg, pa0, pa1, pa2, pa3); SBAR();
  pv_d0(o, vb0, pa0, pa1, pa2, pa3); partialSM(pB0, pB1, m_reg, mnB, alB);
  __syncthreads(); RESC(alB);
  finishSM(pB0, pB1, alB, l_reg, pa0, pa1, pa2, pa3); SBAR();
  pv_d0(o, vb0 + (int)SHM_V, pa0, pa1, pa2, pa3);
  if (hi == 0) li_l[r32] = l_reg; asm volatile("s_waitcnt lgkmcnt(0)" ::: "memory");
  float rli[16];
#pragma unroll
  for (int r = 0; r < 16; ++r) rli[r] = __builtin_amdgcn_rcpf(li_l[crow(r, hi)]);
  float* Ow = Ob + (long)(wid * QBLK) * LDO;
#pragma unroll
  for (int r = 0; r < 16; ++r) { int orow = crow(r, hi);
    for (int d0 = 0; d0 < 4; ++d0) Ow[(long)orow * LDO + d0 * 32 + r32] = o[d0][r] * rli[r]; }
#undef SLOAD
#undef SWRITE
#undef SWAIT
#undef RESC
}
__device__ __forceinline__ void qkt2(f32x16& p0, f32x16& p1, const bf16* Ks, const bf16x8* qr, int r32, int hi, int mp) {
  p0 = f32x16{}; p1 = f32x16{};
  __builtin_amdgcn_s_setprio(1);
#pragma unroll
  for (int d0 = 0; d0 < 4; ++d0) { int cb = (mp * 64 + d0 * 16 + hi * 8) * 2;
    bf16x8 b0 = *reinterpret_cast<const bf16x8*>((const char*)Ks + KSWZ(r32, cb));
    bf16x8 b1 = *reinterpret_cast<const bf16x8*>((const char*)Ks + KSWZ(32 + r32, cb));
    p0 = __builtin_amdgcn_mfma_f32_32x32x16_bf16(b0, qr[d0], p0, 0, 0, 0);
    p1 = __builtin_amdgcn_mfma_f32_32x32x16_bf16(b1, qr[d0], p1, 0, 0, 0); }
  __builtin_amdgcn_s_setprio(0);
}
constexpr int LDQ2 = 512, LDOB = 1024;
__device__ __forceinline__ void attn_diff_body(const bf16* __restrict__ Qb, const bf16* __restrict__ Kh, const bf16* __restrict__ Vh,
                                               unsigned short* __restrict__ Ob, int seq, char* lds, float lam, const float* __restrict__ subg, float osc) {
  using St = Stage<bf16>; using SQ = Stage<bf16>;
  const int tid = threadIdx.x, wid = tid >> 6, lane = tid & 63, r32 = lane & 31, hi = lane >> 5, mp = wid >> 2, wq = wid & 3;
  bf16* V_lds = (bf16*)lds; bf16* K_lds = (bf16*)(lds + 2 * SHM_V);
  float* ws = (float*)(lds + 2 * SHM_V + 2 * SHM_K) + wid * 64; float* li_l = ws; float* al_l = ws + 32;
  float m_reg = -1e30f, l_reg = 0; f32x16 o[4] = {}; bf16x8 qr[4];
  const bf16* Qw = Qb + (long)(wq * QBLK + r32) * LDQ2 + mp * 64 + hi * 8;
#pragma unroll
  for (int d0 = 0; d0 < 4; ++d0) qr[d0] = SQ::tobf(SQ::ld8(Qw + d0 * 16));
  const int sr = tid >> 4, sc = (tid & 15) * 8, vst0 = v_st(sr, sc), vst1 = v_st(32 + sr, sc);
  const int vb0 = (int)(uintptr_t)V_lds + v_rd_base(lane);
  struct { typename St::T vs0, vs1, ks0, ks1; } sr_[SDEPTH];
#define SLOAD(i, k0) do { sr_[i].vs0 = St::ld8(&Vh[(long)((k0) + sr) * LDK + sc]); sr_[i].vs1 = St::ld8(&Vh[(long)((k0) + 32 + sr) * LDK + sc]); \
    sr_[i].ks0 = St::ld8(&Kh[(long)((k0) + sr) * LDK + sc]); sr_[i].ks1 = St::ld8(&Kh[(long)((k0) + 32 + sr) * LDK + sc]); } while (0)
#define SWRITE(b, i) do { *(bf16x8*)((char*)V_lds + (b) * SHM_V + vst0) = St::tobf(sr_[i].vs0);          \
    *(bf16x8*)((char*)V_lds + (b) * SHM_V + vst1) = St::tobf(sr_[i].vs1); int kc = sc * 2;               \
    *(bf16x8*)((char*)K_lds + (b) * SHM_K + KSWZ(sr, kc)) = St::tobf(sr_[i].ks0);                       \
    *(bf16x8*)((char*)K_lds + (b) * SHM_K + KSWZ(32 + sr, kc)) = St::tobf(sr_[i].ks1); } while (0)
#define SWAIT() do { if constexpr (SDEPTH == 2) asm volatile("s_waitcnt vmcnt(4)" ::: "memory"); else asm volatile("s_waitcnt vmcnt(0)" ::: "memory"); } while (0)
#define RESC(a) do { if (__any((a) < 1.f)) { if (hi == 0) al_l[r32] = (a); asm volatile("s_waitcnt lgkmcnt(0)" ::: "memory"); \
    for (int d = 0; d < 4; ++d) for (int r = 0; r < 16; ++r) o[d][r] *= al_l[crow(r, hi)]; } } while (0)
  f32x16 pA0, pA1, pB0, pB1; float mnA, mnB, alA, alB; bf16x8 pa0, pa1, pa2, pa3; const int NT = seq / KVBLK;
  constexpr int SE = 0, SO = SDEPTH - 1;
  SLOAD(SE, 0); asm volatile("s_waitcnt vmcnt(0)" ::: "memory"); SWRITE(0, SE); __syncthreads();
  qkt2(pA0, pA1, K_lds, qr, r32, hi, mp); partialSM(pA0, pA1, m_reg, mnA, alA);
  SLOAD(SO, KVBLK); if constexpr (SDEPTH == 2) { if (2 < NT) SLOAD(SE, 2 * KVBLK); }
  SWAIT(); SWRITE(1, SO); __syncthreads();
  for (int j = 1; j + 1 < NT; j += 2) {
    SBAR(); qkt2(pB0, pB1, (bf16*)((char*)K_lds + SHM_K), qr, r32, hi, mp);
    finishSM(pA0, pA1, alA, l_reg, pa0, pa1, pa2, pa3); SBAR();
    SLOAD(SO, (j + SDEPTH) * KVBLK); SBAR();
    pv_d0(o, vb0, pa0, pa1, pa2, pa3); partialSM(pB0, pB1, m_reg, mnB, alB);
    __syncthreads(); SWAIT(); SWRITE(0, SE);
    RESC(alB); __syncthreads();
    SBAR(); qkt2(pA0, pA1, K_lds, qr, r32, hi, mp);
    finishSM(pB0, pB1, alB, l_reg, pa0, pa1, pa2, pa3); SBAR();
    if (SDEPTH == 1 || j + 3 < NT) SLOAD(SE, (j + 1 + SDEPTH) * KVBLK); SBAR();
    pv_d0(o, vb0 + (int)SHM_V, pa0, pa1, pa2, pa3); partialSM(pA0, pA1, m_reg, mnA, alA);
    __syncthreads(); SWAIT(); SWRITE(1, SO);
    RESC(alA); __syncthreads();
  }
  SBAR(); qkt2(pB0, pB1, (bf16*)((char*)K_lds + SHM_K), qr, r32, hi, mp);
  finishSM(pA0, pA1, alA, l_reg, pa0, pa1, pa2, pa3); SBAR();
  pv_d0(o, vb0, pa0, pa1, pa2, pa3); partialSM(pB0, pB1, m_reg, mnB, alB);
  __syncthreads(); RESC(alB);
  finishSM(pB0, pB1, alB, l_reg, pa0, pa1, pa2, pa3); SBAR();
  pv_d0(o, vb0 + (int)SHM_V, pa0, pa1, pa2, pa3);
  if (hi == 0) li_l[r32] = l_reg; asm volatile("s_waitcnt lgkmcnt(0)" ::: "memory");
  float rli[16];
#pragma unroll
  for (int r = 0; r < 16; ++r) rli[r] = __builtin_amdgcn_rcpf(li_l[crow(r, hi)]);
#pragma unroll
  for (int d0 = 0; d0 < 4; ++d0)
#pragma unroll
    for (int r = 0; r < 16; ++r) o[d0][r] *= rli[r];
  __syncthreads();
  float* xch = (float*)lds + wq * 4096 + lane;
  if (mp == 1) {
#pragma unroll
    for (int d0 = 0; d0 < 4; ++d0)
#pragma unroll
      for (int r = 0; r < 16; ++r) xch[(d0 * 16 + r) * 64] = o[d0][r]; }
  __syncthreads();
  if (mp == 0) {
    int lane_e = lane; asm volatile("" : "+v"(lane_e));
    const int r32e = lane_e & 31, hie = lane_e >> 5;
    float ssq[16];
#pragma unroll
    for (int r = 0; r < 16; ++r) ssq[r] = 0.f;
#pragma unroll
    for (int d0 = 0; d0 < 4; ++d0)
#pragma unroll
      for (int r = 0; r < 16; ++r) { const float v = o[d0][r] - lam * xch[(d0 * 16 + r) * 64]; o[d0][r] = v; ssq[r] += v * v; }
#pragma unroll
    for (int r = 0; r < 16; ++r) { float s = ssq[r]; s += __shfl_xor(s, 1); s += __shfl_xor(s, 2); s += __shfl_xor(s, 4); s += __shfl_xor(s, 8); s += __shfl_xor(s, 16); ssq[r] = rsqrtf(s * (1.0f / 128.0f) + 1e-6f) * osc; }
    unsigned short* Ow = Ob + (long)(wq * QBLK) * LDOB;
#pragma unroll
    for (int d0 = 0; d0 < 4; ++d0) { const float gsc = subg[d0 * 32 + r32e];
#pragma unroll
      for (int r = 0; r < 16; ++r) { const float v = o[d0][r] * ssq[r] * gsc; const unsigned u = __float_as_uint(v); Ow[(long)crow(r, hie) * LDOB + d0 * 32 + r32e] = (unsigned short)((u + 0x7fffu + ((u >> 16) & 1u)) >> 16); } } }
  __syncthreads();
#undef SLOAD
#undef SWRITE
#undef SWAIT
#undef RESC
}
__device__ __forceinline__ void qkt3(f32x16& p0, f32x16& p1, const bf16* Ks, const bf16x8* qr, const f32x16& negm, int r32, int hi, int mp) {
#pragma unroll
  for (int d0 = 0; d0 < 4; ++d0) { int cb = (mp * 64 + d0 * 16 + hi * 8) * 2;
    bf16x8 b0 = *reinterpret_cast<const bf16x8*>((const char*)Ks + KSWZ(r32, cb));
    bf16x8 b1 = *reinterpret_cast<const bf16x8*>((const char*)Ks + KSWZ(32 + r32, cb));
    if (d0 == 0) { p0 = __builtin_amdgcn_mfma_f32_32x32x16_bf16(b0, qr[0], negm, 0, 0, 0); p1 = __builtin_amdgcn_mfma_f32_32x32x16_bf16(b1, qr[0], negm, 0, 0, 0); }
    else { p0 = __builtin_amdgcn_mfma_f32_32x32x16_bf16(b0, qr[d0], p0, 0, 0, 0); p1 = __builtin_amdgcn_mfma_f32_32x32x16_bf16(b1, qr[d0], p1, 0, 0, 0); } }
}
constexpr float THR2 = THR * 1.4426950408889634f;
__device__ __forceinline__ void partialSM2(f32x16& p0, f32x16& p1, float& m_reg, f32x16& negm, float& alpha, bool nomax) {
  if (nomax) { alpha = 1.f; for (int r = 0; r < 16; ++r) p0[r] = __builtin_amdgcn_exp2f(p0[r]); return; }
  float pmax = p0[0]; for (int r = 1; r < 16; ++r) pmax = fmaxf(pmax, p0[r]); for (int r = 0; r < 16; ++r) pmax = fmaxf(pmax, p1[r]);
  { auto rr = __builtin_amdgcn_permlane32_swap(__float_as_uint(pmax), __float_as_uint(pmax), false, false);
    pmax = fmaxf(__uint_as_float(rr[0]), __uint_as_float(rr[1])); }
  if (__builtin_expect(__all(pmax <= THR2), 1)) { alpha = 1.f; }
  else { const float dl = fmaxf(pmax, 0.f); m_reg += dl; alpha = __builtin_amdgcn_exp2f(-dl);
    for (int r = 0; r < 16; ++r) { p0[r] -= dl; p1[r] -= dl; }
    for (int r = 0; r < 16; ++r) negm[r] = -m_reg; }
  for (int r = 0; r < 16; ++r) p0[r] = __builtin_amdgcn_exp2f(p0[r]);
}
__device__ __forceinline__ void finishSM2(f32x16& p0, f32x16& p1, float alpha, float& l_reg, bf16x8& pa0, bf16x8& pa1, bf16x8& pa2, bf16x8& pa3) {
  for (int r = 0; r < 16; ++r) p1[r] = __builtin_amdgcn_exp2f(p1[r]);
  float ps = 0; for (int r = 0; r < 16; ++r) ps += p0[r]; for (int r = 0; r < 16; ++r) ps += p1[r];
  { auto rr = __builtin_amdgcn_permlane32_swap(__float_as_uint(ps), __float_as_uint(ps), false, false);
    ps = __uint_as_float(rr[0]) + __uint_as_float(rr[1]); }
  l_reg = l_reg * alpha + ps;
#define PK8(P, BASE, OUT) do { u32x4 w = {cvtpk(P[BASE + 0], P[BASE + 1]), cvtpk(P[BASE + 2], P[BASE + 3]), cvtpk(P[BASE + 4], P[BASE + 5]), cvtpk(P[BASE + 6], P[BASE + 7])}; OUT = *reinterpret_cast<bf16x8*>(&w); } while (0)
  PK8(p0, 0, pa0); PK8(p0, 8, pa1); PK8(p1, 0, pa2); PK8(p1, 8, pa3);
#undef PK8
}
typedef short v4i16b_t __attribute__((ext_vector_type(4)));
__device__ __forceinline__ v4i16b_t vtrb(int vb, int off) { return __builtin_amdgcn_ds_read_tr16_b64_v4i16((__attribute__((address_space(3))) v4i16b_t*)(unsigned)(vb + off)); }
#define PVB_F(L, H) __builtin_bit_cast(bf16x8, __builtin_shufflevector(L, H, 0, 1, 2, 3, 4, 5, 6, 7))
template <int D0> __device__ __forceinline__ void pv_oneb(f32x16& od, int vb, bf16x8 pa0, bf16x8 pa1, bf16x8 pa2, bf16x8 pa3) {
  const v4i16b_t l0 = vtrb(vb, v_rd_off(D0, 0, 0)), h0 = vtrb(vb, v_rd_off(D0, 0, 1)), l1 = vtrb(vb, v_rd_off(D0, 1, 0)), h1 = vtrb(vb, v_rd_off(D0, 1, 1));
  const v4i16b_t l2 = vtrb(vb, v_rd_off(D0, 2, 0)), h2 = vtrb(vb, v_rd_off(D0, 2, 1)), l3 = vtrb(vb, v_rd_off(D0, 3, 0)), h3 = vtrb(vb, v_rd_off(D0, 3, 1));
  __builtin_amdgcn_s_setprio(1);
  od = __builtin_amdgcn_mfma_f32_32x32x16_bf16(pa0, PVB_F(l0, h0), od, 0, 0, 0);
  od = __builtin_amdgcn_mfma_f32_32x32x16_bf16(pa1, PVB_F(l1, h1), od, 0, 0, 0);
  od = __builtin_amdgcn_mfma_f32_32x32x16_bf16(pa2, PVB_F(l2, h2), od, 0, 0, 0);
  od = __builtin_amdgcn_mfma_f32_32x32x16_bf16(pa3, PVB_F(l3, h3), od, 0, 0, 0);
  __builtin_amdgcn_s_setprio(0);
}
__device__ __forceinline__ void pv_d0b(f32x16* o, int vb, bf16x8 pa0, bf16x8 pa1, bf16x8 pa2, bf16x8 pa3) {
  pv_oneb<0>(o[0], vb, pa0, pa1, pa2, pa3); SBAR(); pv_oneb<1>(o[1], vb, pa0, pa1, pa2, pa3); SBAR(); pv_oneb<2>(o[2], vb, pa0, pa1, pa2, pa3); SBAR(); pv_oneb<3>(o[3], vb, pa0, pa1, pa2, pa3);
}
#define PVP_RD(A, D0) do { A[0] = tr_read<v_rd_off(D0, 0, 0)>(vb); A[1] = tr_read<v_rd_off(D0, 0, 1)>(vb); A[2] = tr_read<v_rd_off(D0, 1, 0)>(vb); A[3] = tr_read<v_rd_off(D0, 1, 1)>(vb); \
    A[4] = tr_read<v_rd_off(D0, 2, 0)>(vb); A[5] = tr_read<v_rd_off(D0, 2, 1)>(vb); A[6] = tr_read<v_rd_off(D0, 3, 0)>(vb); A[7] = tr_read<v_rd_off(D0, 3, 1)>(vb); } while (0)
#define PVP_PK(L, H) (bf16x8){L[0], L[1], L[2], L[3], H[0], H[1], H[2], H[3]}
#define PVP_MM(OD, A) do { OD = __builtin_amdgcn_mfma_f32_32x32x16_bf16(pa0, PVP_PK(A[0], A[1]), OD, 0, 0, 0); OD = __builtin_amdgcn_mfma_f32_32x32x16_bf16(pa1, PVP_PK(A[2], A[3]), OD, 0, 0, 0); \
    OD = __builtin_amdgcn_mfma_f32_32x32x16_bf16(pa2, PVP_PK(A[4], A[5]), OD, 0, 0, 0); OD = __builtin_amdgcn_mfma_f32_32x32x16_bf16(pa3, PVP_PK(A[6], A[7]), OD, 0, 0, 0); } while (0)
__device__ __forceinline__ void pv_pipe(f32x16* o, int vb, bf16x8 pa0, bf16x8 pa1, bf16x8 pa2, bf16x8 pa3) {
  s16x4 A0[8], A1[8];
  PVP_RD(A0, 0); PVP_RD(A1, 1);
  asm volatile("s_waitcnt lgkmcnt(8)" ::: "memory"); SBAR(); PVP_MM(o[0], A0); SBAR();
  PVP_RD(A0, 2);
  asm volatile("s_waitcnt lgkmcnt(8)" ::: "memory"); SBAR(); PVP_MM(o[1], A1); SBAR();
  PVP_RD(A1, 3);
  asm volatile("s_waitcnt lgkmcnt(8)" ::: "memory"); SBAR(); PVP_MM(o[2], A0); SBAR();
  asm volatile("s_waitcnt lgkmcnt(0)" ::: "memory"); SBAR(); PVP_MM(o[3], A1);
}
#undef PVP_RD
#undef PVP_PK
#undef PVP_MM
__device__ __forceinline__ void attn_diff_body3(const bf16* __restrict__ Qb, const bf16* __restrict__ Kh, const bf16* __restrict__ Vh,
                                               unsigned short* __restrict__ Ob, int seq, char* lds, __attribute__((address_space(3))) unsigned char* ldsl, float lam, const float* __restrict__ subg, float osc, bool nomax) {
  using St = Stage<bf16>; using SQ = Stage<bf16>;
  const int tid = threadIdx.x, wid = tid >> 6, lane = tid & 63, r32 = lane & 31, hi = lane >> 5, mp = wid >> 2, wq = wid & 3;
  constexpr int VR = 0, KR = 3 * 16384, WSO = 6 * 16384;
  bf16* V_lds = (bf16*)(lds + VR); bf16* K_lds = (bf16*)(lds + KR);
  float* ws = (float*)(lds + WSO) + wid * 64; float* li_l = ws; float* al_l = ws + 32;
  float m_reg = 0.f, l_reg = 0; f32x16 o[4] = {}; bf16x8 qr[4]; f32x16 negm = {}; asm volatile("" : "+v"(negm));
  const bf16* Qw = Qb + (long)(wq * QBLK + r32) * LDQ2 + mp * 64 + hi * 8;
#pragma unroll
  for (int d0 = 0; d0 < 4; ++d0) qr[d0] = SQ::tobf(SQ::ld8(Qw + d0 * 16));
  const int vb0 = (int)(uintptr_t)V_lds + v_rd_base(lane);
  int kso[2], vso[2];
#pragma unroll
  for (int i = 0; i < 2; ++i) { const int ob = (i * 8 + wid) * 1024 + 16 * lane; const int row = ob >> 8, cb = (ob & 255) ^ ((row & 7) << 4); kso[i] = row * LDK + (cb >> 1);
    const int st = ob >> 9, e = (ob & 511) >> 1, kk = (st >> 2) * 8 + (e >> 5); vso[i] = kk * LDK + (st & 3) * 32 + (e & 31); }
  const int wu = __builtin_amdgcn_readfirstlane(wid);
  typedef __attribute__((address_space(3))) unsigned las_u32;
  const int NT = seq / KVBLK;
#define DMA_K(t, slot) do { const int tt_ = (t) < NT ? (t) : NT - 1; const bf16* g_ = Kh + (long)tt_ * KVBLK * LDK; _Pragma("unroll") for (int i_ = 0; i_ < 2; ++i_) \
    __builtin_amdgcn_global_load_lds((const unsigned*)(g_ + kso[i_]), (las_u32*)(ldsl + KR + (slot) * 16384 + (i_ * 8 + wu) * 1024), 16, 0, 0); } while (0)
#define DMA_V(t, slot) do { const int tt_ = (t) < NT ? (t) : NT - 1; const bf16* g_ = Vh + (long)tt_ * KVBLK * LDK; _Pragma("unroll") for (int i_ = 0; i_ < 2; ++i_) \
    __builtin_amdgcn_global_load_lds((const unsigned*)(g_ + vso[i_]), (las_u32*)(ldsl + VR + (slot) * 16384 + (i_ * 8 + wu) * 1024), 16, 0, 0); } while (0)
#define CLOSE() do { asm volatile("s_waitcnt vmcnt(4) lgkmcnt(0)" ::: "memory"); __builtin_amdgcn_s_barrier(); asm volatile("" ::: "memory"); } while (0)
#define RESC(a) do { if (__any((a) < 1.f)) { if (hi == 0) al_l[r32] = (a); asm volatile("s_waitcnt lgkmcnt(0)" ::: "memory"); \
    for (int d = 0; d < 4; ++d) for (int r = 0; r < 16; ++r) o[d][r] *= al_l[crow(r, hi)]; } } while (0)
  f32x16 pA0, pA1, pB0, pB1; float mnA, mnB, alA, alB; bf16x8 pa0, pa1, pa2, pa3;
  DMA_K(0, 0); DMA_K(1, 1); DMA_V(0, 0);
  asm volatile("s_waitcnt vmcnt(4)" ::: "memory"); __builtin_amdgcn_s_barrier(); asm volatile("" ::: "memory");
  DMA_K(2, 2); DMA_V(1, 1);
  qkt2(pA0, pA1, K_lds, qr, r32, hi, mp); partialSM2(pA0, pA1, m_reg, negm, alA, nomax);
  CLOSE();
  int kcur = 1, vcur = 0;
#define ROT3(x) ((x) == 2 ? 0 : (x) + 1)
#define PRV3(x) ((x) == 0 ? 2 : (x) - 1)
#define ITER(PC0, PC1, MNC, ALC, PP0, PP1, ALP, j_) do { \
    DMA_K((j_) + 2, PRV3(kcur)); DMA_V((j_) + 1, PRV3(vcur)); \
    SBAR(); if (__builtin_expect(__all(m_reg == 0.f), 1)) { qkt2(PC0, PC1, (bf16*)((char*)K_lds + kcur * 16384), qr, r32, hi, mp); } else { qkt3(PC0, PC1, (bf16*)((char*)K_lds + kcur * 16384), qr, negm, r32, hi, mp); } \
    finishSM2(PP0, PP1, ALP, l_reg, pa0, pa1, pa2, pa3); SBAR(); \
    pv_d0b(o, vb0 + vcur * 16384, pa0, pa1, pa2, pa3); partialSM2(PC0, PC1, m_reg, negm, ALC, nomax); \
    if (!nomax) { RESC(ALC); } CLOSE(); kcur = ROT3(kcur); vcur = ROT3(vcur); } while (0)
  for (int j = 1; j + 1 < NT; j += 2) {
    ITER(pB0, pB1, mnB, alB, pA0, pA1, alA, j);
    ITER(pA0, pA1, mnA, alA, pB0, pB1, alB, j + 1);
  }
  ITER(pB0, pB1, mnB, alB, pA0, pA1, alA, NT - 1);
  finishSM2(pB0, pB1, alB, l_reg, pa0, pa1, pa2, pa3); SBAR();
  pv_d0b(o, vb0 + vcur * 16384, pa0, pa1, pa2, pa3);
  asm volatile("s_waitcnt vmcnt(0)" ::: "memory");
#undef ITER
#undef ROT3
#undef PRV3
#undef DMA_K
#undef DMA_V
#undef CLOSE
  if (hi == 0) li_l[r32] = l_reg; asm volatile("s_waitcnt lgkmcnt(0)" ::: "memory");
  float rli[16];
#pragma unroll
  for (int r = 0; r < 16; ++r) rli[r] = __builtin_amdgcn_rcpf(li_l[crow(r, hi)]);
#pragma unroll
  for (int d0 = 0; d0 < 4; ++d0)
#pragma unroll
    for (int r = 0; r < 16; ++r) o[d0][r] *= rli[r];
  __syncthreads();
  float* xch = (float*)lds + wq * 4096 + lane;
  if (mp == 1) {
#pragma unroll
    for (int d0 = 0; d0 < 4; ++d0)
#pragma unroll
      for (int r = 0; r < 16; ++r) xch[(d0 * 16 + r) * 64] = o[d0][r]; }
  __syncthreads();
  if (mp == 0) {
    int lane_e = lane; asm volatile("" : "+v"(lane_e));
    const int r32e = lane_e & 31, hie = lane_e >> 5;
    float ssq[16];
#pragma unroll
    for (int r = 0; r < 16; ++r) ssq[r] = 0.f;
#pragma unroll
    for (int d0 = 0; d0 < 4; ++d0)
#pragma unroll
      for (int r = 0; r < 16; ++r) { const float v = o[d0][r] - lam * xch[(d0 * 16 + r) * 64]; o[d0][r] = v; ssq[r] += v * v; }
#pragma unroll
    for (int r = 0; r < 16; ++r) { float s = ssq[r]; s += __shfl_xor(s, 1); s += __shfl_xor(s, 2); s += __shfl_xor(s, 4); s += __shfl_xor(s, 8); s += __shfl_xor(s, 16); ssq[r] = rsqrtf(s * (1.0f / 128.0f) + 1e-6f) * osc; }
    unsigned short* Ow = Ob + (long)(wq * QBLK) * LDOB;
#pragma unroll
    for (int d0 = 0; d0 < 4; ++d0) { const float gsc = subg[d0 * 32 + r32e];
#pragma unroll
      for (int r = 0; r < 16; ++r) { const float v = o[d0][r] * ssq[r] * gsc; const unsigned u = __float_as_uint(v); Ow[(long)crow(r, hie) * LDOB + d0 * 32 + r32e] = (unsigned short)((u + 0x7fffu + ((u >> 16) & 1u)) >> 16); } } }
  __syncthreads();
#undef RESC
}
typedef int v8i_a8 __attribute__((ext_vector_type(8)));
typedef int v4i_a8 __attribute__((ext_vector_type(4)));
constexpr float THR8 = 8.5f;
__device__ __forceinline__ unsigned pk4f8(float a, float b, float c, float d) { int w = 0; w = __builtin_amdgcn_cvt_pk_fp8_f32(a, b, w, false); w = __builtin_amdgcn_cvt_pk_fp8_f32(c, d, w, true); return (unsigned)w; }
__device__ __forceinline__ void partialSM8(f32x16& p0, f32x16& p1, float& m_reg, float& alpha) {
  float pmax = p0[0]; for (int r = 1; r < 16; ++r) pmax = fmaxf(pmax, p0[r]); for (int r = 0; r < 16; ++r) pmax = fmaxf(pmax, p1[r]);
  { auto rr = __builtin_amdgcn_permlane32_swap(__float_as_uint(pmax), __float_as_uint(pmax), false, false);
    pmax = fmaxf(__uint_as_float(rr[0]), __uint_as_float(rr[1])); }
  if (__builtin_expect(__all(pmax <= THR8), 1)) { alpha = 1.f; }
  else { const float dl = fmaxf(pmax, 0.f); m_reg += dl; alpha = __builtin_amdgcn_exp2f(-dl);
    for (int r = 0; r < 16; ++r) { p0[r] -= dl; p1[r] -= dl; } }
  for (int r = 0; r < 16; ++r) p0[r] = __builtin_amdgcn_exp2f(p0[r]);
}
__device__ __forceinline__ void finishSM8(f32x16& p0, f32x16& p1, float alpha, float& l_reg, v8i_a8& pa) {
  for (int r = 0; r < 16; ++r) p1[r] = __builtin_amdgcn_exp2f(p1[r]);
  float ps = 0; for (int r = 0; r < 16; ++r) ps += p0[r]; for (int r = 0; r < 16; ++r) ps += p1[r];
  { auto rr = __builtin_amdgcn_permlane32_swap(__float_as_uint(ps), __float_as_uint(ps), false, false);
    ps = __uint_as_float(rr[0]) + __uint_as_float(rr[1]); }
  l_reg = l_reg * alpha + ps;
  pa[0] = (int)pk4f8(p0[0], p0[1], p0[2], p0[3]); pa[1] = (int)pk4f8(p0[4], p0[5], p0[6], p0[7]); pa[2] = (int)pk4f8(p0[8], p0[9], p0[10], p0[11]); pa[3] = (int)pk4f8(p0[12], p0[13], p0[14], p0[15]);
  pa[4] = (int)pk4f8(p1[0], p1[1], p1[2], p1[3]); pa[5] = (int)pk4f8(p1[4], p1[5], p1[6], p1[7]); pa[6] = (int)pk4f8(p1[8], p1[9], p1[10], p1[11]); pa[7] = (int)pk4f8(p1[12], p1[13], p1[14], p1[15]);
}
typedef __attribute__((address_space(3))) unsigned char las_u8;
__device__ __forceinline__ v8i_a8 kfrag8(const las_u8* kt, int row, int mp, int hi) {
  const int sw = (row >> 1) & 7, c0 = 4 * mp + 2 * hi;
  const v4i_a8 lo = *(const __attribute__((address_space(3))) v4i_a8*)(kt + row * 128 + ((c0 ^ sw) << 4)), hi4 = *(const __attribute__((address_space(3))) v4i_a8*)(kt + row * 128 + (((c0 + 1) ^ sw) << 4));
  return __builtin_shufflevector(lo, hi4, 0, 1, 2, 3, 4, 5, 6, 7);
}
#define QS8 0x7D7D7D7D
#define US8 0x7F7F7F7F
__device__ __forceinline__ void qkt8(f32x16& p0, f32x16& p1, const las_u8* kt, const v8i_a8& qf, const f32x16& c0, int r32, int hi, int mp) {
  const v8i_a8 k0 = kfrag8(kt, r32, mp, hi), k1 = kfrag8(kt, 32 + r32, mp, hi);
  p0 = __builtin_amdgcn_mfma_scale_f32_32x32x64_f8f6f4(k0, qf, c0, 0, 0, 0, US8, 0, QS8);
  p1 = __builtin_amdgcn_mfma_scale_f32_32x32x64_f8f6f4(k1, qf, c0, 0, 0, 0, US8, 0, QS8);
}
__device__ __forceinline__ void pv8(f32x16* o, const las_u8* vt, int lane, const v8i_a8& pa) {
#pragma unroll
  for (int d0 = 0; d0 < 4; ++d0) {
    const v4i_a8 lo = *(const __attribute__((address_space(3))) v4i_a8*)(vt + ((d0 * 2 + 0) * 64 + lane) * 16), hi4 = *(const __attribute__((address_space(3))) v4i_a8*)(vt + ((d0 * 2 + 1) * 64 + lane) * 16);
    const v8i_a8 vf = __builtin_shufflevector(lo, hi4, 0, 1, 2, 3, 4, 5, 6, 7);
    o[d0] = __builtin_amdgcn_mfma_scale_f32_32x32x64_f8f6f4(pa, vf, o[d0], 0, 0, 0, US8, 0, US8); }
}
__device__ __forceinline__ unsigned pk4b8(float a, float b, float c, float d) { int w = 0; w = __builtin_amdgcn_cvt_pk_bf8_f32(a, b, w, false); w = __builtin_amdgcn_cvt_pk_bf8_f32(c, d, w, true); return (unsigned)w; }
__device__ __forceinline__ void finishSM8b(f32x16& p0, f32x16& p1, v8i_a8& pa) {
  for (int r = 0; r < 16; ++r) p1[r] = __builtin_amdgcn_exp2f(p1[r]);
  pa[0] = (int)pk4b8(p0[0], p0[1], p0[2], p0[3]); pa[1] = (int)pk4b8(p0[4], p0[5], p0[6], p0[7]); pa[2] = (int)pk4b8(p0[8], p0[9], p0[10], p0[11]); pa[3] = (int)pk4b8(p0[12], p0[13], p0[14], p0[15]);
  pa[4] = (int)pk4b8(p1[0], p1[1], p1[2], p1[3]); pa[5] = (int)pk4b8(p1[4], p1[5], p1[6], p1[7]); pa[6] = (int)pk4b8(p1[8], p1[9], p1[10], p1[11]); pa[7] = (int)pk4b8(p1[12], p1[13], p1[14], p1[15]);
}
__device__ __forceinline__ void pv8b(f32x16* o, f32x16& osum, const v8i_a8& ones, const las_u8* vt, int lane, const v8i_a8& pa) {
  osum = __builtin_amdgcn_mfma_scale_f32_32x32x64_f8f6f4(pa, ones, osum, 1, 0, 0, US8, 0, US8);
#pragma unroll
  for (int d0 = 0; d0 < 4; ++d0) {
    const v4i_a8 lo = *(const __attribute__((address_space(3))) v4i_a8*)(vt + ((d0 * 2 + 0) * 64 + lane) * 16), hi4 = *(const __attribute__((address_space(3))) v4i_a8*)(vt + ((d0 * 2 + 1) * 64 + lane) * 16);
    const v8i_a8 vf = __builtin_shufflevector(lo, hi4, 0, 1, 2, 3, 4, 5, 6, 7);
    o[d0] = __builtin_amdgcn_mfma_scale_f32_32x32x64_f8f6f4(pa, vf, o[d0], 1, 0, 0, US8, 0, US8); }
}
template <bool NOMAX> __device__ __forceinline__ void attn_diff_body8(const unsigned char* __restrict__ Q8b, const unsigned char* __restrict__ K8h, const unsigned char* __restrict__ V8h,
                                               unsigned short* __restrict__ Ob, int seq, char* lds, las_u8* ldsl, float lam, const float* __restrict__ subg, float osc) {
  constexpr bool nomax = NOMAX;
  const int tid = threadIdx.x, wid = tid >> 6, lane = tid & 63, r32 = lane & 31, hi = lane >> 5, mp = wid >> 2, wq = wid & 3;
  constexpr int VR = 0, KR = 3 * 8192, WSO = 65536;
  typedef __attribute__((address_space(3))) float las_f32;
  las_f32* li_l = (las_f32*)(ldsl + WSO) + wid * 64; las_f32* al_l = li_l + 32;
  float m_reg = 0.f, l_reg = 0; f32x16 o[4] = {};
  v8i_a8 qf;
  { const unsigned char* qp = Q8b + (long)(wq * QBLK + r32) * 512 + mp * 64 + hi * 32; const v4i_a8 lo = *(const v4i_a8*)qp, h4 = *(const v4i_a8*)(qp + 16); qf = __builtin_shufflevector(lo, h4, 0, 1, 2, 3, 4, 5, 6, 7); }
  const int wu = __builtin_amdgcn_readfirstlane(wid);
  const int krow = 8 * wid + (lane >> 3), kso = krow * 512 + (((lane & 7) ^ ((krow >> 1) & 7)) << 4), vso = wid * 1024 + 16 * lane;
  typedef __attribute__((address_space(3))) unsigned las_u32;
  const int NT = seq / KVBLK;
#define DMA_K(t, slot) do { const int tt_ = (t) < NT ? (t) : NT - 1; __builtin_amdgcn_global_load_lds((const unsigned*)(K8h + (long)tt_ * KVBLK * 512 + kso), (las_u32*)(ldsl + KR + (slot) * 8192 + wu * 1024), 16, 0, 0); } while (0)
#define DMA_V(t, slot) do { const int tt_ = (t) < NT ? (t) : NT - 1; __builtin_amdgcn_global_load_lds((const unsigned*)(V8h + (long)tt_ * 8192 + vso), (las_u32*)(ldsl + VR + (slot) * 8192 + wu * 1024), 16, 0, 0); } while (0)
#define CLOSE() do { asm volatile("s_waitcnt vmcnt(2) lgkmcnt(0)" ::: "memory"); __builtin_amdgcn_s_barrier(); asm volatile("" ::: "memory"); } while (0)
#define RESC(a) do { if (__any((a) < 1.f)) { if (hi == 0) al_l[r32] = (a); asm volatile("s_waitcnt lgkmcnt(0)" ::: "memory"); \
    for (int d = 0; d < 4; ++d) for (int r = 0; r < 16; ++r) o[d][r] *= al_l[crow(r, hi)]; } } while (0)
  f32x16 pA0, pA1, pB0, pB1; float alA, alB; v8i_a8 pa;
  f32x16 osum = {}; v8i_a8 ones8;
  { const int ob = r32 == 0 ? 0x38383838 : 0; ones8 = (v8i_a8){ob, ob, ob, ob, ob, ob, ob, ob}; }
  int kcur = 1, vcur = 0;
  if constexpr (!nomax) {
  DMA_K(0, 0); DMA_K(1, 1); DMA_V(0, 0);
  asm volatile("s_waitcnt vmcnt(2)" ::: "memory"); __builtin_amdgcn_s_barrier(); asm volatile("" ::: "memory");
  DMA_K(2, 2); DMA_V(1, 1);
  { const f32x16 z0 = {}; qkt8(pA0, pA1, ldsl + KR, qf, z0, r32, hi, mp); }
  partialSM8(pA0, pA1, m_reg, alA);
  CLOSE();
  }
#define ROT3(x) ((x) == 2 ? 0 : (x) + 1)
#define PRV3(x) ((x) == 0 ? 2 : (x) - 1)
#define ITER(PC0, PC1, ALC, PP0, PP1, ALP, j_) do { \
    DMA_K((j_) + 2, PRV3(kcur)); DMA_V((j_) + 1, PRV3(vcur)); \
    SBAR(); if (__builtin_expect(__all(m_reg == 0.f), 1)) { const f32x16 z0_ = {}; qkt8(PC0, PC1, ldsl + KR + kcur * 8192, qf, z0_, r32, hi, mp); } \
    else { f32x16 nm_; _Pragma("unroll") for (int r_ = 0; r_ < 16; ++r_) nm_[r_] = -m_reg; qkt8(PC0, PC1, ldsl + KR + kcur * 8192, qf, nm_, r32, hi, mp); } \
    finishSM8(PP0, PP1, ALP, l_reg, pa); SBAR(); \
    pv8(o, ldsl + VR + vcur * 8192, lane, pa); partialSM8(PC0, PC1, m_reg, ALC); \
    RESC(ALC); CLOSE(); kcur = ROT3(kcur); vcur = ROT3(vcur); } while (0)
  if constexpr (nomax) {
    v8i_a8 kf0, kf1, vf0, vf1, vf2, vf3;
#define LDV8(d0_, vt_) ({ const v4i_a8 lo_ = *(const __attribute__((address_space(3))) v4i_a8*)((vt_) + (((d0_) * 2 + 0) * 64 + lane) * 16), hi_ = *(const __attribute__((address_space(3))) v4i_a8*)((vt_) + (((d0_) * 2 + 1) * 64 + lane) * 16); \
      (v8i_a8)__builtin_shufflevector(lo_, hi_, 0, 1, 2, 3, 4, 5, 6, 7); })
#define PVB() do { \
      osum = __builtin_amdgcn_mfma_scale_f32_32x32x64_f8f6f4(pa, ones8, osum, 1, 0, 0, US8, 0, US8); \
      o[0] = __builtin_amdgcn_mfma_scale_f32_32x32x64_f8f6f4(pa, vf0, o[0], 1, 0, 0, US8, 0, US8); o[1] = __builtin_amdgcn_mfma_scale_f32_32x32x64_f8f6f4(pa, vf1, o[1], 1, 0, 0, US8, 0, US8); \
      o[2] = __builtin_amdgcn_mfma_scale_f32_32x32x64_f8f6f4(pa, vf2, o[2], 1, 0, 0, US8, 0, US8); o[3] = __builtin_amdgcn_mfma_scale_f32_32x32x64_f8f6f4(pa, vf3, o[3], 1, 0, 0, US8, 0, US8); \
      asm volatile("" : "+v"(o[0]), "+v"(o[1]), "+v"(o[2]), "+v"(o[3]), "+v"(osum)); } while (0)
#define QKB(PC0, PC1) do { const f32x16 z0_ = {}; PC0 = __builtin_amdgcn_mfma_scale_f32_32x32x64_f8f6f4(kf0, qf, z0_, 0, 0, 0, US8, 0, QS8); PC1 = __builtin_amdgcn_mfma_scale_f32_32x32x64_f8f6f4(kf1, qf, z0_, 0, 0, 0, US8, 0, QS8); asm volatile("" : "+v"(PC0), "+v"(PC1)); } while (0)
#define LDK8(t_) do { const las_u8* kt_ = ldsl + KR + ((t_) & 3) * 8192; kf0 = kfrag8(kt_, r32, mp, hi); kf1 = kfrag8(kt_, 32 + r32, mp, hi); } while (0)
#define LDV01() do { const las_u8* vt_ = ldsl + VR + vcur * 8192; vf0 = LDV8(0, vt_); vf1 = LDV8(1, vt_); } while (0)
#define LDV23() do { const las_u8* vt_ = ldsl + VR + vcur * 8192; vf2 = LDV8(2, vt_); vf3 = LDV8(3, vt_); } while (0)
#define ITERC(PC0, PC1, PP0, PP1, j_) do { \
    DMA_K((j_) + 3, ((j_) + 3) & 3); DMA_V((j_) + 1, PRV3(vcur)); \
    SBAR(); QKB(PC0, PC1); SBAR(); \
    LDV01(); LDK8((j_) + 1); SBAR(); \
    finishSM8b(PP0, PP1, pa); SBAR(); LDV23(); SBAR(); \
    PVB(); \
    _Pragma("unroll") for (int r_ = 0; r_ < 16; ++r_) PC0[r_] = __builtin_amdgcn_exp2f(PC0[r_]); \
    CLOSE(); vcur = ROT3(vcur); } while (0)
    DMA_K(0, 0); DMA_V(0, 0); DMA_K(1, 1); DMA_K(2, 2);
    asm volatile("s_waitcnt vmcnt(1)" ::: "memory"); __builtin_amdgcn_s_barrier(); asm volatile("" ::: "memory");
    LDK8(0); QKB(pA0, pA1); SBAR(); LDK8(1); SBAR();
    DMA_K(3, 3); DMA_V(1, 1);
    for (int r = 0; r < 16; ++r) pA0[r] = __builtin_amdgcn_exp2f(pA0[r]);
    CLOSE();
    for (int j = 1; j + 1 < NT; j += 2) { ITERC(pB0, pB1, pA0, pA1, j); ITERC(pA0, pA1, pB0, pB1, j + 1); }
    ITERC(pB0, pB1, pA0, pA1, NT - 1);
    LDV01(); LDV23(); finishSM8b(pB0, pB1, pa); SBAR(); PVB();
#undef ITERC
#undef LDV01
#undef LDV23
#undef LDK8
#undef QKB
#undef PVB
#undef LDV8
  } else {
    for (int j = 1; j + 1 < NT; j += 2) { ITER(pB0, pB1, alB, pA0, pA1, alA, j); ITER(pA0, pA1, alA, pB0, pB1, alB, j + 1); }
    ITER(pB0, pB1, alB, pA0, pA1, alA, NT - 1);
    finishSM8(pB0, pB1, alB, l_reg, pa); SBAR(); pv8(o, ldsl + VR + vcur * 8192, lane, pa);
  }
  asm volatile("s_waitcnt vmcnt(0)" ::: "memory");
#undef ITER
#undef ROT3
#undef PRV3
#undef DMA_K
#undef DMA_V
#undef CLOSE
  if constexpr (nomax) { if (r32 == 0) {
#pragma unroll
      for (int r = 0; r < 16; ++r) li_l[crow(r, hi)] = osum[r]; } }
  else { if (hi == 0) li_l[r32] = l_reg; }
  asm volatile("s_waitcnt lgkmcnt(0)" ::: "memory");
  float rli[16];
#pragma unroll
  for (int r = 0; r < 16; ++r) rli[r] = __builtin_amdgcn_rcpf(li_l[crow(r, hi)]);
#pragma unroll
  for (int d0 = 0; d0 < 4; ++d0)
#pragma unroll
    for (int r = 0; r < 16; ++r) o[d0][r] *= rli[r];
  __syncthreads();
  las_f32* xch = (las_f32*)ldsl + wq * 4096 + lane;
  if (mp == 1) {
#pragma unroll
    for (int d0 = 0; d0 < 4; ++d0)
#pragma unroll
      for (int r = 0; r < 16; ++r) xch[(d0 * 16 + r) * 64] = o[d0][r]; }
  __syncthreads();
  if (mp == 0) {
    int lane_e = lane; asm volatile("" : "+v"(lane_e));
    const int r32e = lane_e & 31, hie = lane_e >> 5;
    float ssq[16];
#pragma unroll
    for (int r = 0; r < 16; ++r) ssq[r] = 0.f;
#pragma unroll
    for (int d0 = 0; d0 < 4; ++d0)
#pragma unroll
      for (int r = 0; r < 16; ++r) { const float v = o[d0][r] - lam * xch[(d0 * 16 + r) * 64]; o[d0][r] = v; ssq[r] += v * v; }
#pragma unroll
    for (int r = 0; r < 16; ++r) { float s = ssq[r]; s += __shfl_xor(s, 1); s += __shfl_xor(s, 2); s += __shfl_xor(s, 4); s += __shfl_xor(s, 8); s += __shfl_xor(s, 16); ssq[r] = rsqrtf(s * (1.0f / 128.0f) + 1e-6f) * osc; }
    unsigned short* Ow = Ob + (long)(wq * QBLK) * LDOB;
#pragma unroll
    for (int d0 = 0; d0 < 4; ++d0) { const float gsc = subg[d0 * 32 + r32e];
#pragma unroll
      for (int r = 0; r < 16; ++r) { const float v = o[d0][r] * ssq[r] * gsc; const unsigned u = __float_as_uint(v); Ow[(long)crow(r, hie) * LDOB + d0 * 32 + r32e] = (unsigned short)((u + 0x7fffu + ((u >> 16) & 1u)) >> 16); } } }
  __syncthreads();
#undef RESC
}
}
#define GAS __attribute__((address_space(1)))
#define LAS __attribute__((address_space(3)))
typedef unsigned short bf16;
typedef unsigned v4u __attribute__((ext_vector_type(4)));
typedef float f32x4 __attribute__((ext_vector_type(4)));
typedef short bf16x8 __attribute__((ext_vector_type(8)));
typedef GAS unsigned gu32;
typedef GAS unsigned long long gu64;
#define RLX_AGENT __ATOMIC_RELAXED, __HIP_MEMORY_SCOPE_AGENT
#define LDS_WAIT() asm volatile("s_waitcnt lgkmcnt(0)" ::: "memory")
#define VM_WAIT() asm volatile("s_waitcnt vmcnt(0)" ::: "memory")
__device__ __forceinline__ unsigned long long rt() { return __builtin_amdgcn_s_memrealtime(); }
__device__ __forceinline__ unsigned f2bf(float f) { unsigned u = __builtin_bit_cast(unsigned, f); return (u + 0x7fffu + ((u >> 16) & 1u)) >> 16; }
__device__ __forceinline__ unsigned pk2(float lo, float hi) { return f2bf(lo) | (f2bf(hi) << 16); }

#define XB_TMO      128
#define XB_XCNT(j)  (256  + 64 * (j))
#define XB_XSUB(j)  (1280 + 64 * (j))
#define XB_XGEN(j)  (2304 + 64 * (j))
#define XB_TOP      3328
#define XB_TOPGEN   3392
#define XCD_BAR_WORDS 3456
#define XB_SPIN_CAP (1u << 23)

__device__ __forceinline__ unsigned xb_ld(unsigned* p)              { return __hip_atomic_load(p, __ATOMIC_RELAXED, __HIP_MEMORY_SCOPE_AGENT); }
__device__ __forceinline__ unsigned xb_add(unsigned* p, unsigned v) { return __hip_atomic_fetch_add(p, v, __ATOMIC_RELAXED, __HIP_MEMORY_SCOPE_AGENT); }
__device__ __forceinline__ unsigned xb_xcc_id() { return (unsigned)__builtin_amdgcn_s_getreg((3 << 11) | 20) & 0xFu; }
#define XB_SPIN(cond, bar) do { unsigned _sp = 0; while (cond) { __builtin_amdgcn_s_sleep(1); \
    if ((++_sp & 255u) == 0u) { if (xb_ld(&(bar)[XB_TMO])) break; if (_sp > XB_SPIN_CAP) { atomicAdd(&(bar)[XB_TMO], 1u); break; } } } } while (0)

struct XcdBarrier {
    unsigned* bar; unsigned x;
    volatile LAS unsigned* st;
};

__device__ __forceinline__ XcdBarrier xcd_barrier_post(unsigned* bar, volatile LAS unsigned* st) {
    XcdBarrier b; b.bar = bar; b.x = xb_xcc_id(); b.st = st;
    if (threadIdx.x == 0) (void)xb_add(&bar[XB_XCNT(b.x)], 1u);
    return b;
}
__device__ __forceinline__ void xcd_barrier_complete(unsigned* bar, unsigned x, unsigned& nloc, unsigned& nx) {
    const unsigned G = gridDim.x * gridDim.y * gridDim.z;
    unsigned sum, cnt, mine, sp = 0u;
    for (;;) {
        sum = 0u; cnt = 0u; mine = 0u;
#pragma unroll
        for (unsigned j = 0; j < 16; ++j) { const unsigned c = xb_ld(&bar[XB_XCNT(j)]); sum += c; cnt += (c > 0u) ? 1u : 0u; mine = (j == x) ? c : mine; }
        if (sum == G) break;
        __builtin_amdgcn_s_sleep(1);
        if ((++sp & 255u) == 0u) { if (xb_ld(&bar[XB_TMO])) break; if (sp > XB_SPIN_CAP) { atomicAdd(&bar[XB_TMO], 1u); break; } }
    }
    nloc = mine > 0u ? mine : 1u; nx = cnt > 0u ? cnt : 1u;
}

__device__ __forceinline__ void xcd_barrier(const XcdBarrier& b) {
    asm volatile("s_waitcnt vmcnt(0)" ::: "memory");
    __syncthreads();
    if (threadIdx.x == 0) {
        unsigned* bar = b.bar;
        __builtin_amdgcn_s_waitcnt(0);
        unsigned nloc = b.st[0], nx = b.st[1];
        if (nloc == 0u) { xcd_barrier_complete(bar, b.x, nloc, nx); b.st[0] = nloc; b.st[1] = nx; }
        const unsigned old = xb_add(&bar[XB_XSUB(b.x)], 1u);
        const unsigned gen = old / nloc;
        if (old + 1u == (gen + 1u) * nloc) {
            __builtin_amdgcn_fence(__ATOMIC_RELEASE, "agent");
            asm volatile("s_waitcnt vmcnt(0)" ::: "memory");
            const unsigned og = xb_add(&bar[XB_TOP], 1u);
            const unsigned tg = og / nx;
            if (og + 1u == (tg + 1u) * nx) xb_add(&bar[XB_TOPGEN], 1u);
            else XB_SPIN(xb_ld(&bar[XB_TOPGEN]) == tg, bar);
            __builtin_amdgcn_fence(__ATOMIC_ACQUIRE, "agent");
            xb_add(&bar[XB_XGEN(b.x)], 1u);
            asm volatile("s_waitcnt vmcnt(0)" ::: "memory");
        } else {
            XB_SPIN(xb_ld(&bar[XB_XGEN(b.x)]) == gen, bar);
            __builtin_amdgcn_fence(__ATOMIC_ACQUIRE, "agent");
            asm volatile("s_waitcnt vmcnt(0)" ::: "memory");
        }
    }
    __syncthreads();
}
constexpr int DM = 1024, NB = 8, SEQ = 4096, CTX = 256, T = NB * SEQ, TC = NB * CTX, SKV = CTX + SEQ, MROWS = T + TC;
constexpr int NIN = 5120;
constexpr int C_Q = 0, C_K = 512, C_V = 1024, C_HY = 1536, C_G = 3072;
constexpr int NE = 32, TOPK = 4, NA = T * TOPK, NROWS = NA + NE * 256, NBLK = NROWS / 256;
constexpr float EPS = 1e-6f;
enum { IX_X = 0, IX_C, IX_CTX, IX_CCTX, IX_ADAW, IX_ADAB, IX_N1G, IX_N2G, IX_WIN, IX_BIN, IX_QNG, IX_KNG, IX_LQ1, IX_LK1, IX_LQ2, IX_LK2, IX_SUBG,
       IX_CONVW, IX_CONVB, IX_FW1, IX_FB1, IX_FW2, IX_FB2, IX_FW3, IX_FB3, IX_FW4, IX_FFREQ, IX_HBIAS, IX_WUA, IX_WUB, IX_WOUT, IX_RW, IX_RB,
       IX_EW1, IX_EB1, IX_EW2, IX_EB2, N_INPUTS };
constexpr size_t MiB = 1u << 20;
constexpr size_t WS_CTL = 0, CTL_BYTES = 1 * MiB;
constexpr size_t WS_MOD = 1 * MiB;
constexpr size_t WS_LAM = WS_MOD + 256 * 1024;
constexpr size_t WS_ROPEC = WS_LAM + 1024, WS_ROPES = WS_ROPEC + 4096;
constexpr size_t WS_BLKE = WS_ROPES + 4096;
constexpr size_t WS_CNTB = WS_BLKE + 4096;
constexpr size_t WS_TOPE = 2 * MiB, WS_TOPW = WS_TOPE + 512 * 1024, WS_TOKPOS = WS_TOPW + 512 * 1024;
constexpr size_t WS_ROWTOK = WS_TOKPOS + 512 * 1024, WS_ROWW = WS_ROWTOK + 576 * 1024;
static_assert(WS_CNTB + 32768 <= 2 * MiB && WS_ROWW + 576 * 1024 <= 5 * MiB && (size_t)NROWS * 4 <= 576 * 1024, "small tables");
constexpr size_t WS_HF = 6 * MiB;
constexpr size_t WS_WIN = 22 * MiB;
constexpr size_t WS_WIN8 = 5 * MiB + 512 * 1024;
constexpr size_t WS_WA = 32 * MiB, WS_WB = 33 * MiB, WS_WO = 34 * MiB;
constexpr size_t WS_W1 = 36 * MiB;
constexpr size_t WS_W2 = 164 * MiB;
constexpr size_t WS_ACT0 = 228 * MiB;
constexpr size_t WS_HY = 228 * MiB;
constexpr size_t WS_GT = 324 * MiB;
constexpr size_t WS_PX = WS_ACT0;
constexpr size_t WS_XM = 568 * MiB;
constexpr size_t WS_XM8 = 636 * MiB;
constexpr size_t WS_WG8 = 668 * MiB;
constexpr size_t WS_OATT = 568 * MiB;
constexpr size_t WS_QP = 696 * MiB;
constexpr size_t WS_V8T = 728 * MiB;
constexpr size_t WS_KA = 760 * MiB, WS_VA = 794 * MiB;
constexpr size_t WS_U = 828 * MiB;
constexpr size_t WS_UT = 828 * MiB, WS_YT = 860 * MiB;
constexpr size_t WS_CP = 956 * MiB;
constexpr size_t WS_OAB = 892 * MiB;
constexpr size_t WS_SSQ = 228 * MiB;
constexpr size_t WS_OB = 892 * MiB, WS_OA = 924 * MiB;
constexpr size_t WS_TA = 696 * MiB;
constexpr size_t WS_TB = 568 * MiB;
constexpr size_t WS_MB = 828 * MiB;
constexpr size_t WS_TM = 696 * MiB;
constexpr size_t WS_H = 568 * MiB;
constexpr size_t WS_HS = 228 * MiB;
constexpr size_t WS_ACT = 860 * MiB;
constexpr size_t WS_Y = 568 * MiB;
constexpr size_t WS_END = 1020 * MiB;
constexpr int CW_CNT = 0;
constexpr int CW_BAR = 4096;
constexpr int CW_NMAX = 1024;
constexpr int RING_BYTES = 131072, MISC_OFF = RING_BYTES + 320, LDS_BYTES = 163840;
constexpr int NWAVES = 8, NTHREADS = 512;

typedef __attribute__((address_space(3))) float lds_f32;
__device__ __forceinline__ float bf2f(bf16 v) { return __builtin_bit_cast(float, (unsigned)v << 16); }
__device__ __forceinline__ float wave_sum(float v) {
#pragma unroll
    for (int o = 1; o < 64; o <<= 1) v += __shfl_xor(v, o);
    return v;
}
__device__ __forceinline__ float sigmoidf_(float x) { return 1.0f / (1.0f + __expf(-x)); }

struct Ctx {
    float* out; unsigned char* ws;
    LAS unsigned char* lds; char* ldsg;
    int tid, lane, wave, gwave, nwaves, gtid, gthreads;
};
#define WSP(T_, off) ((T_*)(C.ws + (off)))
#define INP(i) (((const float* const __attribute__((address_space(4)))*)__builtin_amdgcn_kernarg_segment_ptr())[i])

__device__ __forceinline__ void tr_item(const float* W, int N, bf16* WT, int Kout, int k0, int n0, int orow0, LAS float* scr, int lane, bool perm = false) {
    { const int kr = lane >> 3, c4 = (lane & 7) * 4; f32x4 v[8];
#pragma unroll
      for (int i = 0; i < 8; ++i) v[i] = *(const f32x4*)(W + (size_t)(k0 + 8 * i + kr) * N + n0 + c4);
#pragma unroll
      for (int i = 0; i < 8; ++i) { LAS float* d = scr + (8 * i + kr) * 33 + c4; d[0] = v[i].x; d[1] = v[i].y; d[2] = v[i].z; d[3] = v[i].w; } }
    LDS_WAIT(); asm volatile("" ::: "memory");
    const int c = lane & 7;
#pragma unroll
    for (int j = 0; j < 4; ++j) { const int n = (lane >> 3) + 8 * j; const LAS float* s = scr + (8 * c) * 33 + n;
        v4u o; o.x = pk2(s[0 * 33], s[1 * 33]); o.y = pk2(s[2 * 33], s[3 * 33]); o.z = pk2(s[4 * 33], s[5 * 33]); o.w = pk2(s[6 * 33], s[7 * 33]);
        const int nr = perm ? (16 * ((n >> 2) & 1) + 4 * (n >> 3) + (n & 3)) : n;
        *(v4u*)(WT + (size_t)(orow0 + nr) * Kout + k0 + 8 * c) = o; }
    LDS_WAIT(); asm volatile("" ::: "memory");
}
__device__ __forceinline__ void tr_item8(const float* W, int N, unsigned char* WT, int Kout, int k0, int n0, int orow0, LAS float* scr, int lane, float mul, bool perm = false) {
    { const int kr = lane >> 3, c4 = (lane & 7) * 4; f32x4 v[8];
#pragma unroll
      for (int i = 0; i < 8; ++i) v[i] = *(const f32x4*)(W + (size_t)(k0 + 8 * i + kr) * N + n0 + c4);
#pragma unroll
      for (int i = 0; i < 8; ++i) { LAS float* d = scr + (8 * i + kr) * 33 + c4; d[0] = v[i].x; d[1] = v[i].y; d[2] = v[i].z; d[3] = v[i].w; } }
    LDS_WAIT(); asm volatile("" ::: "memory");
    const int c = lane & 7;
#pragma unroll
    for (int j = 0; j < 4; ++j) { const int n = (lane >> 3) + 8 * j; const LAS float* s = scr + (8 * c) * 33 + n;
        const unsigned lo = pg8::pk4_fp8(s[0 * 33] * mul, s[1 * 33] * mul, s[2 * 33] * mul, s[3 * 33] * mul), hi = pg8::pk4_fp8(s[4 * 33] * mul, s[5 * 33] * mul, s[6 * 33] * mul, s[7 * 33] * mul);
        const int nr = perm ? (16 * ((n >> 2) & 1) + 4 * (n >> 3) + (n & 3)) : n;
        *(unsigned long long*)(WT + (size_t)(orow0 + nr) * Kout + k0 + 8 * c) = (unsigned long long)lo | ((unsigned long long)hi << 32); }
    LDS_WAIT(); asm volatile("" ::: "memory");
}
struct PrepItem { const float* src; unsigned char* dst; int N, k0, n0, orow0, fl; };
__device__ __forceinline__ void prep_decode(const Ctx& C, int r, PrepItem& p) {
    constexpr int I_INB = 16 * 96, I_ING = 8 * 32, I_A = 8 * 32, I_O = 16 * 32, I_E1 = 8 * 32, I_E2 = 8 * 16;
    if (r < I_INB) { const int kb = r / 96, nb = r % 96; const int L0 = 32 * nb, pn = L0 >> 8;
        p.src = INP(IX_WIN); p.N = NIN; p.k0 = 64 * kb; p.n0 = L0; p.dst = WSP(unsigned char, WS_WIN);
        p.orow0 = pn < 4 ? (256 * pn + 128 * ((L0 >> 5) & 1) + 32 * ((L0 >> 6) & 3)) : L0; p.fl = pn >= 4 ? 2 : 0; return; } r -= I_INB;
    if (r < I_ING) { const int kb = r / 32, nb = r % 32; p.src = INP(IX_WIN); p.N = NIN; p.k0 = 128 * kb; p.n0 = 3072 + 64 * nb; p.dst = WSP(unsigned char, WS_WG8); p.orow0 = 64 * nb; p.fl = 3; return; } r -= I_ING;
    if (r < 2 * I_A) { const int hb = r >= I_A; if (hb) r -= I_A; const int kb = r / 32, nb = r % 32;
        p.src = hb ? INP(IX_WUB) : INP(IX_WUA); p.N = 1024; p.k0 = 64 * kb; p.n0 = 32 * nb; p.dst = WSP(unsigned char, WS_WA) + (hb ? 1024 : 0); p.orow0 = 32 * nb; p.fl = 0; return; } r -= 2 * I_A;
    if (r < I_O) { const int kb = r / 32, nb = r % 32; p.src = INP(IX_WOUT); p.N = 1024; p.k0 = 64 * kb; p.n0 = 32 * nb; p.dst = WSP(unsigned char, WS_WO); p.orow0 = 32 * nb; p.fl = 0; return; } r -= I_O;
    if (r < NE * I_E1) { const int e = r / I_E1, q = r % I_E1, kb = q / 32, nb = q % 32; const int L0 = 64 * nb, half = L0 >> 10, ch = L0 & 1023;
        p.src = INP(IX_EW1) + (size_t)e * 1024 * 2048; p.N = 2048; p.k0 = 128 * kb; p.n0 = L0; p.dst = WSP(unsigned char, WS_W1) + (size_t)e * 2048 * 1024; p.orow0 = (ch >> 7) * 256 + half * 128 + (ch & 127); p.fl = 1; return; }
    r -= NE * I_E1;
    { const int e = r / I_E2, q = r % I_E2, kb = q / 16, nb = q % 16;
      p.src = INP(IX_EW2) + (size_t)e * 1024 * 1024; p.N = 1024; p.k0 = 128 * kb; p.n0 = 64 * nb; p.dst = WSP(unsigned char, WS_W2) + (size_t)e * 1024 * 1024; p.orow0 = 64 * nb; p.fl = 1; }
}
__device__ __forceinline__ void ph_prep_weights(const Ctx& C) {
    LAS float* scr = (LAS float*)(C.lds + C.wave * 16384);
    constexpr int NIT = 16 * 96 + 8 * 32 + 2 * 8 * 32 + 16 * 32 + NE * (8 * 32 + 8 * 16);
    const int lane = C.lane;
    for (int it = C.gwave; it < NIT; it += C.nwaves) {
        PrepItem p; prep_decode(C, it, p);
        if (p.fl & 1) {
            const int kq = lane >> 4, c = lane & 15;
            const float* src = p.src + (size_t)(p.k0 + 32 * kq) * p.N + p.n0 + 4 * c;
            LAS unsigned char* sb = (LAS unsigned char*)scr;
#pragma unroll
            for (int h = 0; h < 2; ++h) { f32x4 v[16];
#pragma unroll
                for (int i = 0; i < 16; ++i) v[i] = *(const f32x4*)(src + (size_t)(16 * h + i) * p.N);
#pragma unroll
                for (int e = 0; e < 4; ++e) { v4u o;
                    o.x = pg8::pk4_fp8(v[0][e] * 32.0f, v[1][e] * 32.0f, v[2][e] * 32.0f, v[3][e] * 32.0f); o.y = pg8::pk4_fp8(v[4][e] * 32.0f, v[5][e] * 32.0f, v[6][e] * 32.0f, v[7][e] * 32.0f);
                    o.z = pg8::pk4_fp8(v[8][e] * 32.0f, v[9][e] * 32.0f, v[10][e] * 32.0f, v[11][e] * 32.0f); o.w = pg8::pk4_fp8(v[12][e] * 32.0f, v[13][e] * 32.0f, v[14][e] * 32.0f, v[15][e] * 32.0f);
                    *(LAS v4u*)(sb + (4 * c + e) * 144 + 32 * kq + 16 * h) = o; } }
            LDS_WAIT(); asm volatile("" ::: "memory");
#pragma unroll
            for (int j = 0; j < 8; ++j) { const int n = (lane >> 3) + 8 * j, ch = lane & 7; const v4u o = *(const LAS v4u*)(sb + n * 144 + 16 * ch);
                const int n32 = n & 31, nr = (p.fl & 2) ? (16 * ((n32 >> 2) & 1) + 4 * (n32 >> 3) + (n32 & 3)) : n32;
                *(v4u*)(p.dst + (size_t)(p.orow0 + (n & 32) + nr) * 1024 + p.k0 + 16 * ch) = o; }
        } else {
            const int kr = lane >> 3, c4 = (lane & 7) * 4;
            f32x4 v[8];
#pragma unroll
            for (int i = 0; i < 8; ++i) v[i] = *(const f32x4*)(p.src + (size_t)(p.k0 + 8 * i + kr) * p.N + p.n0 + c4);
#pragma unroll
            for (int i = 0; i < 8; ++i) { LAS float* d = scr + (8 * i + kr) * 33 + c4; d[0] = v[i].x; d[1] = v[i].y; d[2] = v[i].z; d[3] = v[i].w; }
            LDS_WAIT(); asm volatile("" ::: "memory");
            const int c = lane & 7;
#pragma unroll
            for (int j = 0; j < 4; ++j) { const int n = (lane >> 3) + 8 * j; const LAS float* s = scr + (8 * c) * 33 + n;
                v4u o; o.x = pk2(s[0 * 33], s[1 * 33]); o.y = pk2(s[2 * 33], s[3 * 33]); o.z = pk2(s[4 * 33], s[5 * 33]); o.w = pk2(s[6 * 33], s[7 * 33]);
                const int nr = (p.fl & 2) ? (16 * ((n >> 2) & 1) + 4 * (n >> 3) + (n & 3)) : n;
                *(v4u*)((bf16*)p.dst + (size_t)(p.orow0 + nr) * 1024 + p.k0 + 8 * c) = o; }
        }
        LDS_WAIT(); asm volatile("" ::: "memory");
    }
}
__device__ __forceinline__ void ph_prep_ada(const Ctx& C) {
    LAS float* s = (LAS float*)C.lds;
    LAS float* red = s + 9 * 1024;
    const float* W = INP(IX_ADAW); float* MOD = WSP(float, WS_MOD);
    for (int g = blockIdx.x; g < 192; g += gridDim.x) {
        __syncthreads();
        for (int i = C.tid; i < 9 * 1024; i += NTHREADS) { const int r = i >> 10, k = i & 1023; const float v = r < 8 ? INP(IX_C)[r * 1024 + k] : INP(IX_CCTX)[k]; s[i] = v / (1.0f + __expf(-v)); }
        __syncthreads();
        float acc[9];
#pragma unroll
        for (int r = 0; r < 9; ++r) acc[r] = 0.f;
        const int col = 32 * g + (C.lane & 31), kp = C.wave * 2 + (C.lane >> 5);
#pragma unroll 8
        for (int k = 64 * kp; k < 64 * kp + 64; ++k) { const float wv = W[(size_t)k * 6144 + col];
#pragma unroll
            for (int r = 0; r < 9; ++r) acc[r] += s[r * 1024 + k] * wv; }
#pragma unroll
        for (int r = 0; r < 9; ++r) red[(kp * 9 + r) * 32 + (C.lane & 31)] = acc[r];
        __syncthreads();
        for (int i = C.tid; i < 9 * 32; i += NTHREADS) { const int r = i >> 5, l = i & 31; float a = 0.f;
#pragma unroll
            for (int w = 0; w < 16; ++w) a += red[(w * 9 + r) * 32 + l];
            MOD[r * 6144 + 32 * g + l] = a + INP(IX_ADAB)[32 * g + l]; }
    }
    __syncthreads();
}
__device__ __forceinline__ void ph_prep_misc(const Ctx& C) {
    if (blockIdx.x == gridDim.x - 1) {
        if (C.wave == 0) { const float a = wave_sum(INP(IX_LQ1)[C.lane] * INP(IX_LK1)[C.lane]), b = wave_sum(INP(IX_LQ2)[C.lane] * INP(IX_LK2)[C.lane]);
            if (C.lane == 0) *WSP(float, WS_LAM) = expf(a) - expf(b) + 0.2f;
            float gq = fabsf(INP(IX_QNG)[C.lane]), gk = fabsf(INP(IX_KNG)[C.lane]);
#pragma unroll
            for (int o = 1; o < 64; o <<= 1) { gq = fmaxf(gq, __shfl_xor(gq, o)); gk = fmaxf(gk, __shfl_xor(gk, o)); }
            if (C.lane == 0) WSP(float, WS_LAM)[1] = 11.541560327111707f * gq * gk + 0.5f; }
        for (int i = C.tid; i < 64 * 16; i += NTHREADS) { const int p = i >> 4, f = i & 15; const double fr = pow(10000.0, -(double)f / 16.0), ang = (double)p * fr;
            WSP(float, WS_ROPEC)[i] = (float)cos(ang); WSP(float, WS_ROPES)[i] = (float)sin(ang); }
    }
}
__device__ __forceinline__ void ph_prep_filter(const Ctx& C) {
    LAS float* sc = (LAS float*)(C.lds + C.wave * 4096);
    LAS float* wl = (LAS float*)(C.lds + 32768);
    float* HF = WSP(float, WS_HF);
    const float* w4 = INP(IX_FW4);
    const int lane = C.lane; const float fq = INP(IX_FFREQ)[lane];
    for (int i = C.gtid; i < 512; i += C.gthreads) HF[i] = 0.f;
    __syncthreads();
    { const float* w1 = INP(IX_FW1); const float* w2 = INP(IX_FW2); const float* w3 = INP(IX_FW3);
      for (int i = C.tid; i < (33 + 64 + 64) * 16; i += NTHREADS) { const int e = 4 * i; const float* src = e < 33 * 64 ? w1 + e : (e < 97 * 64 ? w2 + (e - 33 * 64) : w3 + (e - 97 * 64));
          const f32x4 v = *(const f32x4*)src; LAS float* d = wl + e; d[0] = v.x; d[1] = v.y; d[2] = v.z; d[3] = v.w; } }
    __syncthreads();
    const float lo = logf(0.01f) / 1.5f, hi = logf(0.01f) / 0.3f;
    for (int pb = blockIdx.x; pb < SEQ / 16; pb += gridDim.x) {
        const int n0 = 16 * pb + 2 * C.wave;
#pragma unroll
        for (int p = 0; p < 2; ++p) { const int n = n0 + p; float zv = 0.f;
            if (lane == 0) zv = (float)n / 4095.0f;
            else if (lane <= 32) { const int i = (lane - 1) & 15; const double f = 1e-4 + (double)i * ((15.0 - 1e-4) / 15.0); const double ang = f * (6.283185307179586 * (double)n / 4096.0);
                zv = lane <= 16 ? (float)cos(ang) : -(float)sin(ang); }
            sc[p * 256 + lane] = zv; }
        LDS_WAIT();
        float a0, a1;
        a0 = a1 = INP(IX_FB1)[lane];
#pragma unroll 11
        for (int i = 0; i < 33; ++i) { const float wv = wl[i * 64 + lane]; a0 += sc[i] * wv; a1 += sc[256 + i] * wv; }
        sc[64 + lane] = sinf(fq * a0); sc[256 + 64 + lane] = sinf(fq * a1); LDS_WAIT();
        a0 = a1 = INP(IX_FB2)[lane];
#pragma unroll 16
        for (int i = 0; i < 64; ++i) { const float wv = wl[(33 + i) * 64 + lane]; a0 += sc[64 + i] * wv; a1 += sc[256 + 64 + i] * wv; }
        sc[128 + lane] = sinf(fq * a0); sc[256 + 128 + lane] = sinf(fq * a1); LDS_WAIT();
        a0 = a1 = INP(IX_FB3)[lane];
#pragma unroll 16
        for (int i = 0; i < 64; ++i) { const float wv = wl[(97 + i) * 64 + lane]; a0 += sc[128 + i] * wv; a1 += sc[256 + 128 + i] * wv; }
        sc[192 + lane] = sinf(fq * a0); sc[256 + 192 + lane] = sinf(fq * a1);
        __syncthreads();
        float acc0[16], acc1[16];
#pragma unroll
        for (int q = 0; q < 16; ++q) { acc0[q] = 0.f; acc1[q] = 0.f; }
        const int o0 = 128 * C.wave + lane;
#pragma unroll 1
        for (int j0 = 0; j0 < 64; j0 += 16) { float wa[16], wb[16];
#pragma unroll
            for (int j = 0; j < 16; ++j) { wa[j] = w4[(j0 + j) * 1024 + o0]; wb[j] = w4[(j0 + j) * 1024 + o0 + 64]; }
#pragma unroll
            for (int q = 0; q < 16; ++q) { const LAS float* hq = (const LAS float*)(C.lds + (q >> 1) * 4096 + (q & 1) * 1024) + 192 + j0;
#pragma unroll
                for (int j4 = 0; j4 < 16; j4 += 4) { const f32x4 h = *(const LAS f32x4*)(hq + j4);
                    acc0[q] += h.x * wa[j4] + h.y * wa[j4 + 1] + h.z * wa[j4 + 2] + h.w * wa[j4 + 3]; acc1[q] += h.x * wb[j4] + h.y * wb[j4 + 1] + h.z * wb[j4 + 2] + h.w * wb[j4 + 3]; } } }
#pragma unroll
        for (int cc = 0; cc < 2; ++cc) { const int o = o0 + 64 * cc, dir = o >> 9, c = o & 511; const float dl = fabsf(lo + (hi - lo) * ((float)c / 511.0f)); const float hb = INP(IX_HBIAS)[c];
#pragma unroll
            for (int q = 0; q < 16; ++q) { const int n = 16 * pb + q; const float tn = (float)n / 4095.0f;
                float v = (cc ? acc1[q] : acc0[q]) * expf(-tn * dl);
                if (dir == 0) { if (n == 0) v += hb; HF[(size_t)(4096 + n) * 512 + c] = v; }
                else if (n > 0) HF[(size_t)(4096 - n) * 512 + c] = v; } }
        __syncthreads();
    }
}
__device__ __forceinline__ void ph_modulate1(const Ctx& C) {
    const float* MOD = WSP(float, WS_MOD); bf16* XM = WSP(bf16, WS_XM); unsigned char* XM8 = WSP(unsigned char, WS_XM8);
    LAS float* ml = (LAS float*)C.lds; LAS float* gl = ml + 9 * 2048;
    for (int i = C.tid; i < 9 * 2048; i += NTHREADS) { const int rr = i >> 11, j = i & 2047; const float v = MOD[rr * 6144 + j]; ml[i] = j < 1024 ? v : v + 1.0f; }
    for (int i = C.tid; i < 1024; i += NTHREADS) gl[i] = INP(IX_N1G)[i];
    __syncthreads();
#define M1_LOAD(V, R0) do { _Pragma("unroll") for (int q_ = 0; q_ < 2; ++q_) { int r_ = (R0) + q_ * C.nwaves; r_ = r_ < MROWS ? r_ : MROWS - 1; \
        const float* xr_ = r_ < T ? INP(IX_X) + (size_t)r_ * DM : INP(IX_CTX) + (size_t)(r_ - T) * DM; \
        _Pragma("unroll") for (int j_ = 0; j_ < 4; ++j_) V[q_][j_] = *(const f32x4*)(xr_ + 4 * C.lane + 256 * j_); } } while (0)
    f32x4 v[2][4], w[2][4];
    int r0 = C.gwave;
    M1_LOAD(v, r0);
    for (; r0 < MROWS; r0 += 2 * C.nwaves) {
        M1_LOAD(w, r0 + 2 * C.nwaves);
#pragma unroll
        for (int q = 0; q < 2; ++q) { const int r = r0 + q * C.nwaves; if (r < MROWS) {
            const LAS float* mrow = ml + (r < T ? (r >> 12) : 8) * 2048;
            float ss = 0.f;
#pragma unroll
            for (int j = 0; j < 4; ++j) ss += (v[q][j].x * v[q][j].x + v[q][j].y * v[q][j].y) + (v[q][j].z * v[q][j].z + v[q][j].w * v[q][j].w);
            const float rstd = rsqrtf(wave_sum(ss) * (1.0f / DM) + EPS);
#pragma unroll
            for (int j = 0; j < 4; ++j) { const int col = 4 * C.lane + 256 * j; const f32x4 gg = *(const LAS f32x4*)(gl + col), sh = *(const LAS f32x4*)(mrow + col), sc = *(const LAS f32x4*)(mrow + 1024 + col);
                const f32x4 y = v[q][j] * rstd * gg * sc + sh;
                *(unsigned long long*)(XM + (size_t)r * DM + col) = (unsigned long long)pk2(y.x, y.y) | ((unsigned long long)pk2(y.z, y.w) << 32);
                if (r < T) *(unsigned*)(XM8 + (size_t)r * DM + col) = pg8::pk4_fp8(y.x, y.y, y.z, y.w); } } }
#pragma unroll
        for (int q = 0; q < 2; ++q)
#pragma unroll
            for (int j = 0; j < 4; ++j) v[q][j] = w[q][j];
    }
#undef M1_LOAD
    __syncthreads();
}
__device__ __forceinline__ void ph_post_proj(const Ctx& C) {
    const bf16* PX = WSP(bf16, WS_PX); bf16* QP = WSP(bf16, WS_QP); bf16* KA = WSP(bf16, WS_KA); bf16* VA = WSP(bf16, WS_VA); float* U = WSP(float, WS_U);
    const float* RC = WSP(float, WS_ROPEC); const float* RS = WSP(float, WS_ROPES);
    const int lane = C.lane;
    for (int it = C.gwave; it < T * 16 + TC * 8; it += C.nwaves) {
        int r, which, h, m, rc = 0; bool latent;
        if (it < T * 16) { r = it >> 4; const int v = it & 15; which = v >> 3; h = (v >> 1) & 3; m = v & 1; latent = true; }
        else { const int j = it - T * 16; rc = j >> 3; const int v = j & 7; which = 1; h = v >> 1; m = v & 1; r = T + rc; latent = false; }
        const float x = bf2f(PX[(size_t)r * NIN + which * 512 + h * 128 + m * 64 + lane]);
        const float rstd = rsqrtf(wave_sum(x * x) * (1.0f / 64.0f) + EPS);
        float y = x * rstd * (which ? INP(IX_KNG)[lane] : INP(IX_QNG)[lane]);
        const int t = r & 4095;
        if (latent) { const int axis = lane >> 5, half = (lane >> 4) & 1, f = lane & 15, pos = axis ? (t & 63) : (t >> 6);
            const float cs = RC[pos * 16 + f], sn = RS[pos * 16 + f]; const float pr = __shfl_xor(y, 16);
            y = half == 0 ? y * cs - pr * sn : y * cs + pr * sn; }
        if (which == 0) { const size_t base = ((size_t)r * 8 + (h * 2 + m)) * 128; QP[base + m * 64 + lane] = (bf16)f2bf(y); QP[base + (1 - m) * 64 + lane] = 0; }
        else { const size_t krow = latent ? (size_t)(r >> 12) * SKV + CTX + t : (size_t)(rc >> 8) * SKV + (rc & 255); KA[krow * 512 + h * 128 + m * 64 + lane] = (bf16)f2bf(y); }
    }
    for (int i = C.gtid; i < MROWS * 64; i += C.gthreads) { const int r = i >> 6, ch = i & 63;
        const size_t vrow = r < T ? (size_t)(r >> 12) * SKV + CTX + (r & 4095) : (size_t)((r - T) >> 8) * SKV + ((r - T) & 255);
        *(v4u*)(VA + vrow * 512 + ch * 8) = *(const v4u*)(PX + (size_t)r * NIN + C_V + ch * 8); }
    const float* cw = INP(IX_CONVW); const float* cb = INP(IX_CONVB);
    for (int i = C.gtid; i < T * 512; i += C.gthreads) { const int r = i >> 9, c = i & 511, t = r & 4095; float z[2];
#pragma unroll
        for (int gsel = 0; gsel < 2; ++gsel) { const int chn = 512 * (gsel + 1) + c; const bf16* p = PX + (size_t)r * NIN + C_HY + chn;
            const float xm = t > 0 ? bf2f(p[-NIN]) : 0.f, x0 = bf2f(p[0]), xp = t < 4095 ? bf2f(p[NIN]) : 0.f;
            z[gsel] = xm * cw[chn] + x0 * cw[1536 + chn] + xp * cw[3072 + chn] + cb[chn]; }
        U[i] = z[0] * z[1]; }
}
__device__ __forceinline__ void ph_hyena_naive(const Ctx& C) {
    const float* U = WSP(float, WS_U); const float* HF = WSP(float, WS_HF); const bf16* PX = WSP(bf16, WS_PX); bf16* OB = WSP(bf16, WS_OB);
    const float* cw = INP(IX_CONVW); const float* cb = INP(IX_CONVB);
    for (int i = C.gtid; i < T * 512 / 8; i += C.gthreads) {
        const int c = i & 511, tg = i >> 9, b = tg >> 9, t0 = (tg & 511) * 8;
        float acc[8], tap[8];
#pragma unroll
        for (int j = 0; j < 8; ++j) { acc[j] = 0.f; tap[j] = HF[(size_t)(t0 + j + 4096) * 512 + c]; }
        const float* up = U + (size_t)b * SEQ * 512 + c; const float* hp = HF + (size_t)(t0 + 4095) * 512 + c;
        for (int s = 0; s < SEQ; ++s) { const float uv = up[(size_t)s * 512]; const float nt = hp[-(long)s * 512];
#pragma unroll
            for (int j = 0; j < 8; ++j) acc[j] += uv * tap[j];
#pragma unroll
            for (int j = 7; j > 0; --j) tap[j] = tap[j - 1];
            tap[0] = nt; }
#pragma unroll
        for (int j = 0; j < 8; ++j) { const int t = t0 + j; const size_t r = (size_t)b * SEQ + t; const bf16* p = PX + r * NIN + C_HY + c;
            const float xm = t > 0 ? bf2f(p[-NIN]) : 0.f, x0 = bf2f(p[0]), xp = t < 4095 ? bf2f(p[NIN]) : 0.f;
            const float z0 = xm * cw[c] + x0 * cw[1536 + c] + xp * cw[3072 + c] + cb[c];
            OB[r * 512 + c] = (bf16)f2bf(z0 * acc[j]); }
    }
}
__device__ __forceinline__ void ph_attn_post(const Ctx& C) {
    const float* O = WSP(float, WS_OATT); bf16* OA = WSP(bf16, WS_OA); const float lam = *WSP(float, WS_LAM); const float* sg = INP(IX_SUBG);
    for (int it = C.gwave; it < T * 4; it += C.nwaves) { const int r = it >> 2, h = it & 3; const float* p = O + (size_t)r * 1024 + h * 256 + C.lane;
        const float o0 = p[0] - lam * p[128], o1 = p[64] - lam * p[192];
        const float rstd = rsqrtf(wave_sum(o0 * o0 + o1 * o1) * (1.0f / 128.0f) + EPS);
        OA[(size_t)r * 512 + h * 128 + C.lane] = (bf16)f2bf(o0 * rstd * sg[C.lane] * 0.8f); OA[(size_t)r * 512 + h * 128 + 64 + C.lane] = (bf16)f2bf(o1 * rstd * sg[64 + C.lane] * 0.8f); }
}
__device__ __forceinline__ void ph_gate(const Ctx& C) {
    const float* TA = WSP(float, WS_TA); const float* TB = WSP(float, WS_TB); const bf16* GT = WSP(bf16, WS_GT); bf16* MB = WSP(bf16, WS_MB);
    for (int i = C.gtid; i < T * 256; i += C.gthreads) { const int r = i >> 8, c = (i & 255) * 4; const f32x4 a = *(const f32x4*)(TA + (size_t)r * 1024 + c), b = *(const f32x4*)(TB + (size_t)r * 1024 + c);
        const bf16* g = GT + (size_t)r * 2048 + c; float o[4];
#pragma unroll
        for (int e = 0; e < 4; ++e) o[e] = bf2f(g[e]) * a[e] + bf2f(g[1024 + e]) * b[e];
        *(unsigned long long*)(MB + (size_t)r * 1024 + c) = (unsigned long long)pk2(o[0], o[1]) | ((unsigned long long)pk2(o[2], o[3]) << 32); }
}
__device__ __forceinline__ void ph_router(const Ctx& C) {
    const float* MOD = WSP(float, WS_MOD); const float* TM = WSP(float, WS_TM); bf16* H = WSP(bf16, WS_H); const float* g2n = INP(IX_N2G); const float* RW = INP(IX_RW);
    int* TOPE = WSP(int, WS_TOPE); float* TOPW = WSP(float, WS_TOPW); unsigned* CNT = WSP(unsigned, WS_CTL) + CW_CNT;
    LAS unsigned* hist = (LAS unsigned*)C.lds;
    if (C.tid < 32) hist[C.tid] = 0u;
    __syncthreads();
    for (int r = C.gwave; r < T; r += C.nwaves) {
        const float* mrow = MOD + (r >> 12) * 6144;
        f32x4 v[4]; float ss = 0.f;
#pragma unroll
        for (int j = 0; j < 4; ++j) { const int col = 4 * C.lane + 256 * j; const f32x4 x = *(const f32x4*)(INP(IX_X) + (size_t)r * DM + col), tm = *(const f32x4*)(TM + (size_t)r * DM + col), g1 = *(const f32x4*)(mrow + 2048 + col);
            v[j] = x + g1 * tm; *(f32x4*)(C.out + (size_t)r * DM + col) = v[j]; ss += (v[j].x * v[j].x + v[j].y * v[j].y) + (v[j].z * v[j].z + v[j].w * v[j].w); }
        const float rstd = rsqrtf(wave_sum(ss) * (1.0f / DM) + EPS);
        f32x4 y[4];
#pragma unroll
        for (int j = 0; j < 4; ++j) { const int col = 4 * C.lane + 256 * j; const f32x4 gg = *(const f32x4*)(g2n + col), sh = *(const f32x4*)(mrow + 3072 + col), sc = *(const f32x4*)(mrow + 4096 + col);
            y[j] = v[j] * rstd * gg * (sc + 1.0f) + sh;
            *(unsigned long long*)(H + (size_t)r * DM + col) = (unsigned long long)pk2(y[j].x, y[j].y) | ((unsigned long long)pk2(y[j].z, y[j].w) << 32); }
        LAS float* lg = (LAS float*)(C.lds + 1024) + C.wave * 32;
#pragma unroll 1
        for (int e = 0; e < 32; ++e) { float a = 0.f;
#pragma unroll
            for (int j = 0; j < 4; ++j) { const float* wr = RW + (size_t)(4 * C.lane + 256 * j) * 32 + e; a += y[j].x * wr[0] + y[j].y * wr[32] + y[j].z * wr[64] + y[j].w * wr[96]; }
            a = wave_sum(a) + INP(IX_RB)[e];
            if (C.lane == 0) lg[e] = a; }
        LDS_WAIT();
        float p[32];
#pragma unroll
        for (int e = 0; e < 32; ++e) p[e] = lg[e];
        unsigned taken = 0u; float tv[4]; int ti[4];
#pragma unroll
        for (int k = 0; k < 4; ++k) { float best = -INFINITY; int bi = 0;
#pragma unroll
            for (int e = 0; e < 32; ++e) { const bool ok = !((taken >> e) & 1u) && p[e] > best; best = ok ? p[e] : best; bi = ok ? e : bi; }
            taken |= 1u << bi; tv[k] = best; ti[k] = bi; }
        const float e1 = __expf(tv[1] - tv[0]), e2 = __expf(tv[2] - tv[0]), e3 = __expf(tv[3] - tv[0]); const float inv = 1.0f / (1.0f + e1 + e2 + e3);
        if (C.lane == 0) { *(int4*)(TOPE + (size_t)r * 4) = make_int4(ti[0], ti[1], ti[2], ti[3]); *(f32x4*)(TOPW + (size_t)r * 4) = (f32x4){inv, e1 * inv, e2 * inv, e3 * inv};
            atomicAdd((unsigned*)&hist[ti[0]], 1u); atomicAdd((unsigned*)&hist[ti[1]], 1u); atomicAdd((unsigned*)&hist[ti[2]], 1u); atomicAdd((unsigned*)&hist[ti[3]], 1u); }
    }
    __syncthreads();
    if (C.tid < 32) atomicAdd(CNT + C.tid, hist[C.tid]);
}
__device__ __forceinline__ void ph_sort(const Ctx& C) {
    const unsigned* CNT = WSP(unsigned, WS_CTL) + CW_CNT; const int* TOPE = WSP(int, WS_TOPE); const float* TOPW = WSP(float, WS_TOPW);
    int* TOKPOS = WSP(int, WS_TOKPOS); int* ROWTOK = WSP(int, WS_ROWTOK); float* ROWW = WSP(float, WS_ROWW); int* BLKE = WSP(int, WS_BLKE);
    LAS int* wtot = (LAS int*)C.lds;
    for (int e = blockIdx.x; e < NE; e += gridDim.x) {
        int pstart = 0, cnt = 0, padded = 0;
        for (int i = 0; i <= e; ++i) { pstart += padded; cnt = (int)__hip_atomic_load(CNT + i, __ATOMIC_RELAXED, __HIP_MEMORY_SCOPE_AGENT); padded = (cnt + 255) / 256 * 256; }
        int running = 0;
        for (int a0 = 0; a0 < NA; a0 += NTHREADS) { const int a = a0 + C.tid; const bool flag = TOPE[a] == e;
            const unsigned long long bal = __ballot(flag); const int pre = __popcll(bal & ((1ull << C.lane) - 1ull)), tot = __popcll(bal);
            __syncthreads();
            if (C.lane == 0) wtot[C.wave] = tot;
            __syncthreads();
            int woff = 0, all = 0;
#pragma unroll
            for (int w = 0; w < 8; ++w) { const int x = wtot[w]; woff += (w < C.wave) ? x : 0; all += x; }
            if (flag) { const int pos = pstart + running + woff + pre; ROWTOK[pos] = a >> 2; ROWW[pos] = TOPW[a]; TOKPOS[a] = pos; }
            running += all; }
        for (int i = cnt + C.tid; i < padded; i += NTHREADS) { ROWTOK[pstart + i] = T; ROWW[pstart + i] = 0.f; }
        __syncthreads();
    }
    if (blockIdx.x == gridDim.x - 1) {
        for (int blk = C.tid; blk <= NBLK; blk += NTHREADS) { int pend = 0, e = 0; bool found = false;
            for (int i = 0; i < NE; ++i) { const int cnt = (int)__hip_atomic_load(CNT + i, __ATOMIC_RELAXED, __HIP_MEMORY_SCOPE_AGENT); pend += (cnt + 255) / 256 * 256; if (!found && blk * 256 < pend) { e = i; found = true; } }
            if (blk < NBLK) BLKE[blk] = found ? e : NE - 1; else BLKE[NBLK] = pend / 256; }
    }
}
__device__ __forceinline__ void ph_gather(const Ctx& C) {
    const int nrows = WSP(int, WS_BLKE)[NBLK] * 256; const int* ROWTOK = WSP(int, WS_ROWTOK); const bf16* H = WSP(bf16, WS_H); bf16* HS = WSP(bf16, WS_HS);
    for (int r = C.gwave; r < nrows; r += C.nwaves) { const int tok = ROWTOK[r]; v4u a = {0u, 0u, 0u, 0u}, b = {0u, 0u, 0u, 0u};
        if (tok < T) { a = *(const v4u*)(H + (size_t)tok * DM + C.lane * 16); b = *(const v4u*)(H + (size_t)tok * DM + C.lane * 16 + 8); }
        *(v4u*)(HS + (size_t)r * DM + C.lane * 16) = a; *(v4u*)(HS + (size_t)r * DM + C.lane * 16 + 8) = b; }
}
__device__ __forceinline__ void ph_combine(const Ctx& C) {
    const float* MOD = WSP(float, WS_MOD); const int* TOKPOS = WSP(int, WS_TOKPOS); const unsigned char* Y = WSP(unsigned char, WS_Y);
    typedef float f32x2_t __attribute__((ext_vector_type(2)));
    for (int i0 = C.gtid; i0 < T * 256; i0 += 4 * C.gthreads) {
        int4 ps[4]; f32x4 xo[4], g2[4]; unsigned w[4][4];
#pragma unroll
        for (int q = 0; q < 4; ++q) { const int i = i0 + q * C.gthreads; if (i < T * 256) ps[q] = *(const int4*)(TOKPOS + (size_t)(i >> 8) * 4); }
#pragma unroll
        for (int q = 0; q < 4; ++q) { const int i = i0 + q * C.gthreads; if (i < T * 256) { const int r = i >> 8, c = (i & 255) * 4;
            w[q][0] = *(const unsigned*)(Y + (size_t)ps[q].x * DM + c); w[q][1] = *(const unsigned*)(Y + (size_t)ps[q].y * DM + c); w[q][2] = *(const unsigned*)(Y + (size_t)ps[q].z * DM + c); w[q][3] = *(const unsigned*)(Y + (size_t)ps[q].w * DM + c);
            xo[q] = *(const f32x4*)(C.out + (size_t)r * DM + c); g2[q] = *(const f32x4*)(MOD + (r >> 12) * 6144 + 5120 + c); } }
#pragma unroll
        for (int q = 0; q < 4; ++q) { const int i = i0 + q * C.gthreads; if (i < T * 256) { const int r = i >> 8, c = (i & 255) * 4; f32x4 acc = {0.f, 0.f, 0.f, 0.f};
#pragma unroll
            for (int k = 0; k < 4; ++k) { const f32x2_t lo = __builtin_amdgcn_cvt_pk_f32_fp8((int)w[q][k], false), hi = __builtin_amdgcn_cvt_pk_f32_fp8((int)w[q][k], true); acc.x += lo.x; acc.y += lo.y; acc.z += hi.x; acc.w += hi.y; }
            *(f32x4*)(C.out + (size_t)r * DM + c) = xo[q] + g2[q] * acc * 0.0625f; } }
    }
}
__device__ __forceinline__ unsigned bfx(const v4u& w, int e) { const unsigned d = e < 2 ? w.x : e < 4 ? w.y : e < 6 ? w.z : w.w; return (e & 1) ? (d & 0xffff0000u) : (d << 16); }
__device__ __forceinline__ float bfe(const v4u& w, int e) { return __builtin_bit_cast(float, bfx(w, e)); }
__device__ __forceinline__ void ph_hyena_pre(const Ctx& C) {
    const bf16* HY = WSP(bf16, WS_HY); bf16* UT = WSP(bf16, WS_UT); bf16* CP = WSP(bf16, WS_CP); const float* HF = WSP(float, WS_HF);
    const float* cw = INP(IX_CONVW); const float* cb_ = INP(IX_CONVB);
    LAS bf16* tile = (LAS bf16*)C.lds;
    const int tid = C.tid;
    const bool skew = gridDim.x >= 64 && (gridDim.x & 7) == 0; const int vb0 = skew ? (int)blockIdx.x - 32 : (int)blockIdx.x, vnb = skew ? (int)gridDim.x - 32 : (int)gridDim.x;
    const bool fixc = (vnb & 7) == 0;
    const int tl = tid >> 3, c8 = (tid & 7) * 8;
    float w0[2][8], w1[2][8], w2[2][8], wb[2][8];
    if (fixc) {
#pragma unroll
        for (int gsel = 0; gsel < 2; ++gsel) { const int chn = 512 * (gsel + 1) + ((int)blockIdx.x & 7) * 64 + c8;
#pragma unroll
            for (int e = 0; e < 8; ++e) { w0[gsel][e] = cw[chn + e]; w1[gsel][e] = cw[1536 + chn + e]; w2[gsel][e] = cw[3072 + chn + e]; wb[gsel][e] = cb_[chn + e]; } } }
    const v4u zero4 = {0u, 0u, 0u, 0u};
#define HP_LOAD(IT, M, X, Q) do { const int cb_i = (IT) & 7, tb_i = ((IT) >> 3) & 63, b_i = (IT) >> 9; const int t_i = tb_i * 64 + tl; const size_t r_i = (size_t)b_i * SEQ + t_i; \
        _Pragma("unroll") for (int gsel = 0; gsel < 2; ++gsel) { const bf16* p_ = HY + r_i * 1536 + 512 * (gsel + 1) + cb_i * 64 + c8; \
            M[gsel] = t_i > 0 ? *(const v4u*)(p_ - 1536) : zero4; X[gsel] = *(const v4u*)p_; Q[gsel] = t_i < SEQ - 1 ? *(const v4u*)(p_ + 1536) : zero4; } } while (0)
    v4u cm[2], cx[2], cq[2], nm[2], nx[2], nq[2];
    int it = vb0 < 0 ? 8 * 64 * 8 : vb0;
    if (it < 8 * 64 * 8) HP_LOAD(it, cm, cx, cq);
    for (; it < 8 * 64 * 8; it += vnb) {
        const int cb = it & 7, tb = (it >> 3) & 63, b = it >> 9, c0 = cb * 64, t0 = tb * 64;
        const bool has_n = it + vnb < 8 * 64 * 8;
        if (has_n) HP_LOAD(it + vnb, nm, nx, nq);
        if (!fixc) {
#pragma unroll
            for (int gsel = 0; gsel < 2; ++gsel) { const int chn = 512 * (gsel + 1) + c0 + c8;
#pragma unroll
                for (int e = 0; e < 8; ++e) { w0[gsel][e] = cw[chn + e]; w1[gsel][e] = cw[1536 + chn + e]; w2[gsel][e] = cw[3072 + chn + e]; wb[gsel][e] = cb_[chn + e]; } } }
        float z[2][8];
#pragma unroll
        for (int gsel = 0; gsel < 2; ++gsel)
#pragma unroll
            for (int e = 0; e < 8; ++e) z[gsel][e] = bfe(cm[gsel], e) * w0[gsel][e] + bfe(cx[gsel], e) * w1[gsel][e] + bfe(cq[gsel], e) * w2[gsel][e] + wb[gsel][e];
        __syncthreads();
#pragma unroll
        for (int e = 0; e < 8; ++e) tile[(c8 + e) * 72 + tl] = (bf16)f2bf(z[0][e] * z[1][e]);
        __syncthreads();
        const v4u o = *(const LAS v4u*)(tile + (tid >> 3) * 72 + (tid & 7) * 8);
        *(v4u*)(UT + ((size_t)(c0 + (tid >> 3)) * 8 + b) * SEQ + t0 + (tid & 7) * 8) = o;
        if (has_n) {
#pragma unroll
            for (int gsel = 0; gsel < 2; ++gsel) { cm[gsel] = nm[gsel]; cx[gsel] = nx[gsel]; cq[gsel] = nq[gsel]; } }
    }
#undef HP_LOAD
    __syncthreads();
    LAS float* hfl = (LAS float*)(C.lds + 16384);
    for (int it = vb0 < 0 ? 8 * 128 : vb0; it < 8 * 128; it += vnb) {
        const int cb = it & 7, xb = it >> 3, c0 = cb * 64, x0 = xb * 64, mbase = 8192 - x0 - 70;
        __syncthreads();
        for (int idx = tid; idx < 71 * 64; idx += NTHREADS) { const int lr = idx >> 6, cc = idx & 63, mp = mbase + lr; hfl[lr * 65 + cc] = (mp >= 1 && mp <= 8191) ? HF[(size_t)mp * 512 + c0 + cc] : 0.f; }
        __syncthreads();
        const int c = tid >> 3, x8 = (tid & 7) * 8;
#pragma unroll
        for (int rho = 0; rho < 8; ++rho) { float v[8];
#pragma unroll
            for (int e = 0; e < 8; ++e) v[e] = hfl[(70 - (x8 + e) - rho) * 65 + c];
            v4u o; o.x = pk2(v[0], v[1]); o.y = pk2(v[2], v[3]); o.z = pk2(v[4], v[5]); o.w = pk2(v[6], v[7]);
            *(v4u*)(CP + ((size_t)(c0 + c) * 8 + rho) * 8192 + x0 + x8) = o; }
    }
    __syncthreads();
}
typedef float f32x16_t __attribute__((ext_vector_type(16)));
constexpr int HY_RING = 8, HY_TB = 65536;
__device__ __forceinline__ void ph_hyena_mfma(const Ctx& C) {
    const bf16* UT = WSP(bf16, WS_UT); const bf16* CP = WSP(bf16, WS_CP); bf16* YT = WSP(bf16, WS_YT);
    const int lane = C.lane, n = lane & 31, hh = lane >> 5, b = C.wave;
    LAS unsigned char* ub = C.lds + b * 8192;
    const unsigned ubo = (unsigned)b * 8192u, zrow = (unsigned)(HY_TB + HY_RING * 8192);
    const int rho = (-n) & 7, cn = (n + rho) >> 3;
    if (C.tid < 32) ((LAS unsigned*)(C.lds + HY_TB + HY_RING * 8192))[C.tid] = 0u;
    __syncthreads();
    const int fnb = b >> 2, fks = b & 3;
    const int wfix = 512 - 4 * fnb + 2 * fks + hh - cn;
    for (int c = blockIdx.x; c < 512; c += gridDim.x) {
        const bf16* src = UT + ((size_t)c * 8 + b) * SEQ;
#pragma unroll
        for (int it = 0; it < 8; ++it) { const int g = it * 64 + lane, p = g >> 3, ch = g & 7; const v4u v = *(const v4u*)(src + g * 8);
            *(LAS v4u*)(ub + p * 128 + ((ch ^ ((p >> 1) & 7)) << 4)) = v; }
        asm volatile("s_waitcnt vmcnt(0) lgkmcnt(0)" ::: "memory");
        f32x16_t acc[2][2];
#pragma unroll
        for (int i = 0; i < 2; ++i)
#pragma unroll
            for (int j = 0; j < 2; ++j)
#pragma unroll
                for (int r = 0; r < 16; ++r) acc[i][j][r] = 0.f;
        const bf16* cpl = CP + ((size_t)c * 8 + rho) * 8192;
#define HY_ISSUE2(D_, slot_) do { _Pragma("unroll") for (int h_ = 0; h_ < 2; ++h_) { const int sc_ = (2 * (D_) + h_) > 126 ? 126 : (2 * (D_) + h_); const int W_ = wfix - 8 * (sc_ - 63); \
        __builtin_amdgcn_global_load_lds((const unsigned*)(cpl + 8 * W_), (LAS unsigned*)(C.lds + HY_TB + (slot_) * 16384 + h_ * 8192 + b * 1024), 16, 0, 0); } } while (0)
#define HY_READ(TF, AF, s_, off_) do { const int d_ = (s_) - 63; const LAS unsigned char* tb_ = C.lds + HY_TB + (off_) + lane * 16; \
        _Pragma("unroll") for (int nb = 0; nb < 2; ++nb) _Pragma("unroll") for (int ks = 0; ks < 4; ++ks) TF[nb][ks] = *(const LAS bf16x8*)(tb_ + (nb * 4 + ks) * 1024); \
        _Pragma("unroll") for (int ib = 0; ib < 2; ++ib) { if (ib == 0 ? (d_ <= 31) : (d_ >= -31)) { const int p_ = 32 * ib - d_ + n; const bool v_ = (unsigned)p_ < 64u; \
            const unsigned a0_ = v_ ? (ubo + (unsigned)(p_ * 128 + (((p_ >> 1) & 7) << 4))) : zrow; \
            _Pragma("unroll") for (int ks = 0; ks < 4; ++ks) AF[ib][ks] = *(const LAS bf16x8*)(C.lds + (a0_ ^ (unsigned)((2 * ks + hh) << 4))); } } } while (0)
#define HY_MMA(TF, AF, s_) do { const int d_ = (s_) - 63; if ((s_) <= 126) { _Pragma("unroll") for (int ib = 0; ib < 2; ++ib) { if (ib == 0 ? (d_ <= 31) : (d_ >= -31)) { \
        _Pragma("unroll") for (int ks = 0; ks < 4; ++ks) _Pragma("unroll") for (int nb = 0; nb < 2; ++nb) acc[ib][nb] = __builtin_amdgcn_mfma_f32_32x32x16_bf16(AF[ib][ks], TF[nb][ks], acc[ib][nb], 0, 0, 0); } } } } while (0)
        HY_ISSUE2(0, 0); HY_ISSUE2(1, 1); HY_ISSUE2(2, 2);
        asm volatile("s_waitcnt vmcnt(2)" ::: "memory"); __builtin_amdgcn_s_barrier(); asm volatile("" ::: "memory");
        bf16x8 tfA[2][4], afA[2][4], tfB[2][4], afB[2][4];
        HY_READ(tfA, afA, 0, 0);
#pragma unroll 1
        for (int D = 0; D < 64; ++D) {
            const int slot = D & 3;
            HY_ISSUE2(D + 3, (D + 3) & 3);
            HY_READ(tfB, afB, 2 * D + 1, slot * 16384 + 8192);
            HY_MMA(tfA, afA, 2 * D);
            if (D < 63) HY_READ(tfA, afA, 2 * D + 2, ((D + 1) & 3) * 16384);
            HY_MMA(tfB, afB, 2 * D + 1);
            asm volatile("s_waitcnt vmcnt(2) lgkmcnt(0)" ::: "memory"); __builtin_amdgcn_s_barrier(); asm volatile("" ::: "memory");
        }
#undef HY_ISSUE2
#undef HY_READ
#undef HY_MMA
        asm volatile("s_waitcnt vmcnt(0)" ::: "memory");
        bf16* dst = YT + ((size_t)c * 8 + b) * SEQ;
#pragma unroll
        for (int ib = 0; ib < 2; ++ib)
#pragma unroll
            for (int nb = 0; nb < 2; ++nb)
#pragma unroll
                for (int r = 0; r < 16; ++r) { const int i = 32 * ib + (r & 3) + 8 * (r >> 2) + 4 * hh; dst[64 * i + 32 * nb + n] = (bf16)f2bf(acc[ib][nb][r]); }
        asm volatile("s_waitcnt vmcnt(0) lgkmcnt(0)" ::: "memory"); __builtin_amdgcn_s_barrier(); asm volatile("" ::: "memory");
    }
    __syncthreads();
}
__device__ __forceinline__ void ph_hyena_post(const Ctx& C) {
    const bf16* HY = WSP(bf16, WS_HY); const bf16* YT = WSP(bf16, WS_YT); bf16* OAB = WSP(bf16, WS_OAB);
    const float* cw = INP(IX_CONVW); const float* cb_ = INP(IX_CONVB);
    LAS bf16* tile = (LAS bf16*)C.lds; const int tid = C.tid;
    const int vb0 = (int)blockIdx.x, vnb = (int)gridDim.x; const bool fixc = (vnb & 7) == 0;
    const int tl = tid >> 3, c8 = (tid & 7) * 8;
    float w0[8], w1[8], w2[8], wb[8];
    if (fixc) { const int chn = (vb0 & 7) * 64 + c8;
#pragma unroll
        for (int e = 0; e < 8; ++e) { w0[e] = cw[chn + e]; w1[e] = cw[1536 + chn + e]; w2[e] = cw[3072 + chn + e]; wb[e] = cb_[chn + e]; } }
    const v4u zero4 = {0u, 0u, 0u, 0u};
#define HQ_LOAD(IT, YV, M, X, Q) do { const int cb_i = (IT) & 7, tb_i = ((IT) >> 3) & 63, b_i = (IT) >> 9; const int t_i = tb_i * 64 + tl; \
        YV = *(const v4u*)(YT + ((size_t)(cb_i * 64 + (tid >> 3)) * 8 + b_i) * SEQ + tb_i * 64 + (tid & 7) * 8); \
        const bf16* p_ = HY + ((size_t)b_i * SEQ + t_i) * 1536 + cb_i * 64 + c8; \
        M = *(const v4u*)(p_ - (t_i > 0 ? 1536 : 0)); X = *(const v4u*)p_; Q = *(const v4u*)(p_ + (t_i < SEQ - 1 ? 1536 : 0)); if (t_i == 0) M = zero4; if (t_i == SEQ - 1) Q = zero4; } while (0)
    v4u cy, cm, cx, cq, ny, nm, nx, nq, my, mm, mx, mq;
    int it = vb0;
    if (it < 8 * 64 * 8) HQ_LOAD(it, cy, cm, cx, cq);
    { const int i1_ = it + vnb < 8 * 64 * 8 ? it + vnb : 8 * 64 * 8 - 1; HQ_LOAD(i1_, ny, nm, nx, nq); }
    for (; it < 8 * 64 * 8; it += vnb) {
        const int cb = it & 7, tb = (it >> 3) & 63, b = it >> 9, c0 = cb * 64, t0 = tb * 64;
        const bool has_n = it + vnb < 8 * 64 * 8, has_m = it + 2 * vnb < 8 * 64 * 8;
        { const int i2_ = has_m ? it + 2 * vnb : 8 * 64 * 8 - 1; HQ_LOAD(i2_, my, mm, mx, mq); }
        if (!fixc) { const int chn = c0 + c8;
#pragma unroll
            for (int e = 0; e < 8; ++e) { w0[e] = cw[chn + e]; w1[e] = cw[1536 + chn + e]; w2[e] = cw[3072 + chn + e]; wb[e] = cb_[chn + e]; } }
        __syncthreads();
        *(LAS v4u*)(tile + (tid >> 3) * 72 + (tid & 7) * 8) = cy;
        __syncthreads();
        const int t = t0 + tl, chn = c0 + c8; const size_t r = (size_t)b * SEQ + t;
        float o[8];
#pragma unroll
        for (int e = 0; e < 8; ++e) { const float z0 = bfe(cm, e) * w0[e] + bfe(cx, e) * w1[e] + bfe(cq, e) * w2[e] + wb[e]; o[e] = z0 * bf2f(tile[(c8 + e) * 72 + tl]); }
        v4u w; w.x = pk2(o[0], o[1]); w.y = pk2(o[2], o[3]); w.z = pk2(o[4], o[5]); w.w = pk2(o[6], o[7]);
        *(v4u*)(OAB + r * 1024 + 512 + chn) = w;
        cy = ny; cm = nm; cx = nx; cq = nq; ny = my; nm = mm; nx = mx; nq = mq;
    }
#undef HQ_LOAD
    __syncthreads();
}

__device__ __forceinline__ void v8t_chunk(const bf16* VA, unsigned char* V8T, int b, int h, int tk, int ci) {
    const int d0 = ci >> 7, half = (ci >> 6) & 1, ln = ci & 63, n = ln & 31, kg = ln >> 5;
    const bf16* src = VA + ((size_t)b * SKV + 64 * tk + 32 * half + 4 * kg) * 512 + h * 128 + 32 * d0 + n;
    float v[16];
#pragma unroll
    for (int e = 0; e < 16; ++e) v[e] = bf2f(src[(size_t)((e & 3) + 8 * (e >> 2)) * 512]);
    v4u o; o.x = pg8::pk4_fp8(v[0], v[1], v[2], v[3]); o.y = pg8::pk4_fp8(v[4], v[5], v[6], v[7]); o.z = pg8::pk4_fp8(v[8], v[9], v[10], v[11]); o.w = pg8::pk4_fp8(v[12], v[13], v[14], v[15]);
    *(v4u*)(V8T + ((size_t)((b * 4 + h) * (SKV / 64) + tk) * 512 + ci) * 16) = o;
}
__device__ __forceinline__ void ph_v8t(const Ctx& C) {
    const bf16* VA = WSP(bf16, WS_VA); unsigned char* V8T = WSP(unsigned char, WS_V8T);
    constexpr int NTL = SKV / 64 - 4;
    const bool skew = gridDim.x >= 64; const int t0 = skew ? C.gtid - 32 * NTHREADS : C.gtid, tn = skew ? C.gthreads - 32 * NTHREADS : C.gthreads;
    for (int i = t0 < 0 ? NB * 4 * NTL * 512 : t0; i < NB * 4 * NTL * 512; i += tn) { const int ci = i & 511, tk = 4 + (i >> 9) % NTL, bh = (i >> 9) / NTL; v8t_chunk(VA, V8T, bh >> 2, bh & 3, tk, ci); }
}
__device__ __forceinline__ void ph_v8t_ctx(const Ctx& C, int b, int h0) {
    const bf16* VA = WSP(bf16, WS_VA); unsigned char* V8T = WSP(unsigned char, WS_V8T);
    for (int i = C.tid; i < 2 * 4 * 512; i += NTHREADS) v8t_chunk(VA, V8T, b, h0 + (i >> 11), (i >> 9) & 3, i & 511);
}
__device__ __forceinline__ unsigned char f8b(float v) { return (unsigned char)(pg8::pk4_fp8(v, 0.f, 0.f, 0.f) & 0xffu); }
__device__ __forceinline__ void ph_hyena_pre8(const Ctx& C) {
    const bf16* HY = WSP(bf16, WS_HY); unsigned char* UT = WSP(unsigned char, WS_UT); unsigned char* CP = WSP(unsigned char, WS_CP); const float* HF = WSP(float, WS_HF);
    const float* cw = INP(IX_CONVW); const float* cb_ = INP(IX_CONVB);
    LAS unsigned char* tile = C.lds;
    const int tid = C.tid;
    const bool skew = gridDim.x >= 64 && (gridDim.x & 7) == 0; const int vb0 = skew ? (int)blockIdx.x - 32 : (int)blockIdx.x, vnb = skew ? (int)gridDim.x - 32 : (int)gridDim.x;
    const bool fixc = (vnb & 7) == 0;
    const int tl = tid >> 3, c8 = (tid & 7) * 8;
    float w0[2][8], w1[2][8], w2[2][8], wb[2][8];
    if (fixc) {
#pragma unroll
        for (int gsel = 0; gsel < 2; ++gsel) { const int chn = 512 * (gsel + 1) + ((int)blockIdx.x & 7) * 64 + c8;
#pragma unroll
            for (int e = 0; e < 8; ++e) { w0[gsel][e] = cw[chn + e]; w1[gsel][e] = cw[1536 + chn + e]; w2[gsel][e] = cw[3072 + chn + e]; wb[gsel][e] = cb_[chn + e]; } } }
    const v4u zero4 = {0u, 0u, 0u, 0u};
#define HP_LOAD(IT, M, X, Q) do { const int cb_i = (IT) & 7, tb_i = ((IT) >> 3) & 63, b_i = (IT) >> 9; const int t_i = tb_i * 64 + tl; const size_t r_i = (size_t)b_i * SEQ + t_i; \
        _Pragma("unroll") for (int gsel = 0; gsel < 2; ++gsel) { const bf16* p_ = HY + r_i * 1536 + 512 * (gsel + 1) + cb_i * 64 + c8; \
            M[gsel] = *(const v4u*)(p_ - (t_i > 0 ? 1536 : 0)); X[gsel] = *(const v4u*)p_; Q[gsel] = *(const v4u*)(p_ + (t_i < SEQ - 1 ? 1536 : 0)); if (t_i == 0) M[gsel] = zero4; if (t_i == SEQ - 1) Q[gsel] = zero4; } } while (0)
    v4u cm[2], cx[2], cq[2], nm[2], nx[2], nq[2], mm[2], mx[2], mq[2];
    int it = vb0 < 0 ? 8 * 64 * 8 : vb0;
    if (it < 8 * 64 * 8) HP_LOAD(it, cm, cx, cq);
    if (it < 8 * 64 * 8) { const int i1_ = it + vnb < 8 * 64 * 8 ? it + vnb : 8 * 64 * 8 - 1; HP_LOAD(i1_, nm, nx, nq); }
    for (; it < 8 * 64 * 8; it += vnb) {
        const int cb = it & 7, tb = (it >> 3) & 63, b = it >> 9, c0 = cb * 64, t0 = tb * 64;
        const bool has_n = it + vnb < 8 * 64 * 8, has_m = it + 2 * vnb < 8 * 64 * 8;
        { const int i2_ = has_m ? it + 2 * vnb : 8 * 64 * 8 - 1; HP_LOAD(i2_, mm, mx, mq); }
        if (!fixc) {
#pragma unroll
            for (int gsel = 0; gsel < 2; ++gsel) { const int chn = 512 * (gsel + 1) + c0 + c8;
#pragma unroll
                for (int e = 0; e < 8; ++e) { w0[gsel][e] = cw[chn + e]; w1[gsel][e] = cw[1536 + chn + e]; w2[gsel][e] = cw[3072 + chn + e]; wb[gsel][e] = cb_[chn + e]; } } }
        float z[2][8];
#pragma unroll
        for (int gsel = 0; gsel < 2; ++gsel)
#pragma unroll
            for (int e = 0; e < 8; ++e) z[gsel][e] = bfe(cm[gsel], e) * w0[gsel][e] + bfe(cx[gsel], e) * w1[gsel][e] + bfe(cq[gsel], e) * w2[gsel][e] + wb[gsel][e];
        __syncthreads();
#pragma unroll
        for (int e = 0; e < 8; ++e) tile[(c8 + e) * 80 + tl] = f8b(z[0][e] * z[1][e]);
        __syncthreads();
        const unsigned long long o = *(const LAS unsigned long long*)(tile + (tid >> 3) * 80 + (tid & 7) * 8);
        *(unsigned long long*)(UT + ((size_t)(c0 + (tid >> 3)) * 8 + b) * SEQ + t0 + (tid & 7) * 8) = o;
#pragma unroll
        for (int gsel = 0; gsel < 2; ++gsel) { cm[gsel] = nm[gsel]; cx[gsel] = nx[gsel]; cq[gsel] = nq[gsel]; nm[gsel] = mm[gsel]; nx[gsel] = mx[gsel]; nq[gsel] = mq[gsel]; }
    }
#undef HP_LOAD
    __syncthreads();
    LAS float* hfl = (LAS float*)(C.lds + 16384);
    for (int it2 = vb0 < 0 ? 8 * 128 : vb0; it2 < 8 * 128; it2 += vnb) {
        const int cb = it2 & 7, xb = it2 >> 3, c0 = cb * 64, x0 = xb * 64, mbase = 8192 - x0 - 78;
        __syncthreads();
        for (int idx = tid; idx < 79 * 64; idx += NTHREADS) { const int lr = idx >> 6, cc = idx & 63, mp = mbase + lr; hfl[lr * 65 + cc] = (mp >= 1 && mp <= 8191) ? HF[(size_t)mp * 512 + c0 + cc] * 64.0f : 0.f; }
        __syncthreads();
        const int c = tid >> 3, x8 = (tid & 7) * 8;
#pragma unroll 4
        for (int rho = 0; rho < 16; ++rho) { float v[8];
#pragma unroll
            for (int e = 0; e < 8; ++e) v[e] = hfl[(78 - (x8 + e) - rho) * 65 + c];
            *(unsigned long long*)(CP + ((size_t)(c0 + c) * 16 + rho) * 8192 + x0 + x8) = (unsigned long long)pg8::pk4_fp8(v[0], v[1], v[2], v[3]) | ((unsigned long long)pg8::pk4_fp8(v[4], v[5], v[6], v[7]) << 32); }
    }
    __syncthreads();
}
typedef int v8i_h8 __attribute__((ext_vector_type(8)));
typedef int v4i_h8 __attribute__((ext_vector_type(4)));
constexpr int H8_TB = 32768, H8_Z = 65536;
__device__ __forceinline__ void ph_hyena_mfma8(const Ctx& C) {
    const unsigned char* UT = WSP(unsigned char, WS_UT); const unsigned char* CP = WSP(unsigned char, WS_CP); bf16* YT = WSP(bf16, WS_YT);
    const int lane = C.lane, n = lane & 31, hh = lane >> 5, b = C.wave;
    const unsigned ubo = (unsigned)b * 4096u, zrow = (unsigned)H8_Z;
    const int rho = (-n) & 15, cn = (n + rho) >> 4;
    if (C.tid < 16) ((LAS unsigned*)(C.lds + H8_Z))[C.tid] = 0u;
    __syncthreads();
    const int fh = b >> 2, fnb = (b >> 1) & 1, fhalf = b & 1;
    const int wfix = 256 - 2 * fnb + 2 * hh - cn;
    for (int c = blockIdx.x; c < 512; c += gridDim.x) {
        const unsigned char* src = UT + ((size_t)c * 8 + b) * SEQ;
#pragma unroll
        for (int it = 0; it < 4; ++it) { const int g = it * 64 + lane, p = g >> 2, c4 = g & 3; const v4u v = *(const v4u*)(src + g * 16);
            *(LAS v4u*)(C.lds + ubo + p * 64 + ((c4 ^ ((p >> 2) & 3)) << 4)) = v; }
        asm volatile("s_waitcnt vmcnt(0) lgkmcnt(0)" ::: "memory");
        f32x16_t acc[2][2];
#pragma unroll
        for (int i = 0; i < 2; ++i)
#pragma unroll
            for (int j = 0; j < 2; ++j)
#pragma unroll
                for (int r = 0; r < 16; ++r) acc[i][j][r] = 0.f;
        const unsigned char* cpl = CP + ((size_t)c * 16 + rho) * 8192 + 16 * fhalf;
#define H8_ISSUE(D_, slot_) do { const int sc_ = (2 * (D_) + fh) > 126 ? 126 : (2 * (D_) + fh); const int W_ = wfix - 4 * (sc_ - 63); \
        __builtin_amdgcn_global_load_lds((const unsigned*)(cpl + 16 * W_), (LAS unsigned*)(C.lds + H8_TB + (slot_) * 8192 + b * 1024), 16, 0, 0); } while (0)
#define H8_READ(TF, AF, s_, off_) do { const int d_ = (s_) - 63; const LAS unsigned char* tb_ = C.lds + H8_TB + (off_) + lane * 16; \
        _Pragma("unroll") for (int nb = 0; nb < 2; ++nb) { const v4i_h8 lo_ = *(const LAS v4i_h8*)(tb_ + (nb * 2 + 0) * 1024), hi_ = *(const LAS v4i_h8*)(tb_ + (nb * 2 + 1) * 1024); TF[nb] = __builtin_shufflevector(lo_, hi_, 0, 1, 2, 3, 4, 5, 6, 7); } \
        _Pragma("unroll") for (int ib = 0; ib < 2; ++ib) { if (ib == 0 ? (d_ <= 31) : (d_ >= -31)) { const int p_ = 32 * ib - d_ + n; const bool v_ = (unsigned)p_ < 64u; \
            const unsigned a0_ = v_ ? (ubo + (unsigned)(p_ * 64 + (((p_ >> 2) & 3) << 4))) : zrow; \
            const v4i_h8 lo_ = *(const LAS v4i_h8*)(C.lds + (a0_ ^ (unsigned)((2 * hh) << 4))), hi_ = *(const LAS v4i_h8*)(C.lds + (a0_ ^ (unsigned)((2 * hh + 1) << 4))); AF[ib] = __builtin_shufflevector(lo_, hi_, 0, 1, 2, 3, 4, 5, 6, 7); } } } while (0)
#define H8_MMA(TF, AF, s_) do { const int d_ = (s_) - 63; if ((s_) <= 126) { _Pragma("unroll") for (int ib = 0; ib < 2; ++ib) { if (ib == 0 ? (d_ <= 31) : (d_ >= -31)) { \
        _Pragma("unroll") for (int nb = 0; nb < 2; ++nb) acc[ib][nb] = __builtin_amdgcn_mfma_scale_f32_32x32x64_f8f6f4(AF[ib], TF[nb], acc[ib][nb], 0, 0, 0, 0x7F7F7F7F, 0, 0x79797979); } } } } while (0)
        H8_ISSUE(0, 0); H8_ISSUE(1, 1); H8_ISSUE(2, 2);
        asm volatile("s_waitcnt vmcnt(1)" ::: "memory"); __builtin_amdgcn_s_barrier(); asm volatile("" ::: "memory");
        v8i_h8 tfA[2], afA[2], tfB[2], afB[2];
#pragma unroll
        for (int i = 0; i < 2; ++i) { afA[i] = (v8i_h8){0, 0, 0, 0, 0, 0, 0, 0}; afB[i] = (v8i_h8){0, 0, 0, 0, 0, 0, 0, 0}; }
        H8_READ(tfA, afA, 0, 0);
#pragma unroll 1
        for (int D = 0; D < 64; ++D) {
            const int slot = D & 3;
            H8_ISSUE(D + 3, (D + 3) & 3);
            H8_READ(tfB, afB, 2 * D + 1, slot * 8192 + 4096);
            H8_MMA(tfA, afA, 2 * D);
            if (D < 63) H8_READ(tfA, afA, 2 * D + 2, ((D + 1) & 3) * 8192);
            H8_MMA(tfB, afB, 2 * D + 1);
            asm volatile("s_waitcnt vmcnt(1) lgkmcnt(0)" ::: "memory"); __builtin_amdgcn_s_barrier(); asm volatile("" ::: "memory");
        }
#undef H8_ISSUE
#undef H8_READ
#undef H8_MMA
        asm volatile("s_waitcnt vmcnt(0)" ::: "memory");
        bf16* dst = YT + ((size_t)c * 8 + b) * SEQ;
#pragma unroll
        for (int ib = 0; ib < 2; ++ib)
#pragma unroll
            for (int nb = 0; nb < 2; ++nb)
#pragma unroll
                for (int r = 0; r < 16; ++r) { const int i = 32 * ib + (r & 3) + 8 * (r >> 2) + 4 * hh; dst[64 * i + 32 * nb + n] = (bf16)f2bf(acc[ib][nb][r]); }
        asm volatile("s_waitcnt vmcnt(0) lgkmcnt(0)" ::: "memory"); __builtin_amdgcn_s_barrier(); asm volatile("" ::: "memory");
    }
    __syncthreads();
}
constexpr int LDS_HIST = RING_BYTES + 1024, LDS_LG = RING_BYTES + 2048;
__device__ __forceinline__ void ph_router2(const Ctx& C) {
    const float* MOD = WSP(float, WS_MOD); const float* SSQ = WSP(float, WS_SSQ); bf16* H = WSP(bf16, WS_H); const float* g2n = INP(IX_N2G); const float* RW = INP(IX_RW);
    int* TOPE = WSP(int, WS_TOPE); float* TOPW = WSP(float, WS_TOPW); unsigned* CNTB = WSP(unsigned, WS_CNTB);
    LAS unsigned* hist = (LAS unsigned*)(C.lds + LDS_HIST);
    const int lane = C.lane, tid = C.tid;
    for (int i = tid; i < 1024 * 8; i += NTHREADS) { const int k = i >> 3, ch = i & 7; const f32x4 w = *(const f32x4*)(RW + (size_t)k * 32 + ch * 4);
        *(LAS f32x4*)(C.lds + k * 128 + ((ch ^ ((k >> 1) & 7)) << 4)) = w; }
    const float rb = INP(IX_RB)[lane >> 1];
    for (int chk = blockIdx.x; chk < T / 128; chk += gridDim.x) {
        __syncthreads();
        if (tid < 32) hist[tid] = 0u;
        __syncthreads();
#pragma unroll 1
        for (int ri = 0; ri < 16; ++ri) {
            const int r = chk * 128 + C.wave * 16 + ri; const float* mrow = MOD + (r >> 12) * 6144;
            float v[16]; float ss = 0.f;
#pragma unroll
            for (int m = 0; m < 16; ++m) { const int col = lane + 64 * m; v[m] = C.out[(size_t)r * DM + col]; }
            ss = lane < 16 ? SSQ[(size_t)r * 16 + lane] : 0.f;
            const float rstd = rsqrtf(wave_sum(ss) * (1.0f / DM) + EPS);
            float p[32];
#pragma unroll
            for (int e = 0; e < 32; ++e) p[e] = 0.f;
#pragma unroll
            for (int m = 0; m < 16; ++m) { const int col = lane + 64 * m; const float y = v[m] * rstd * g2n[col] * (mrow[4096 + col] + 1.0f) + mrow[3072 + col];
                H[(size_t)r * DM + col] = (bf16)f2bf(y);
                const LAS unsigned char* wrow = C.lds + col * 128; const int sw = (col >> 1) & 7; asm volatile("" ::: "memory");
#pragma unroll
                for (int q = 0; q < 8; ++q) { const f32x4 w = *(const LAS f32x4*)(wrow + ((q ^ sw) << 4)); p[4 * q] += y * w.x; p[4 * q + 1] += y * w.y; p[4 * q + 2] += y * w.z; p[4 * q + 3] += y * w.w; } }
#define HALVE(N_, MASK_) _Pragma("unroll") for (int e = 0; e < (N_); ++e) { const float a = p[e], b2 = p[e + (N_)]; const bool up = (lane & (MASK_)) != 0; const float send = up ? a : b2, keep = up ? b2 : a; p[e] = keep + __shfl_xor(send, (MASK_)); }
            HALVE(16, 32) HALVE(8, 16) HALVE(4, 8) HALVE(2, 4) HALVE(1, 2)
#undef HALVE
            float lg = p[0] + __shfl_xor(p[0], 1) + rb;
            const int myid = lane >> 1;
            float tv[4]; int ti[4];
#pragma unroll
            for (int k = 0; k < 4; ++k) { float bv = lg; int bi = myid;
#pragma unroll
                for (int mask = 2; mask < 64; mask <<= 1) { const float ov = __shfl_xor(bv, mask); const int oi = __shfl_xor(bi, mask); const bool take = ov > bv || (ov == bv && oi < bi); bv = take ? ov : bv; bi = take ? oi : bi; }
                tv[k] = bv; ti[k] = bi; if (myid == bi) lg = -INFINITY; }
            const float e1 = __expf(tv[1] - tv[0]), e2 = __expf(tv[2] - tv[0]), e3 = __expf(tv[3] - tv[0]); const float inv = 1.0f / (1.0f + e1 + e2 + e3);
            if (lane == 0) { *(int4*)(TOPE + (size_t)r * 4) = make_int4(ti[0], ti[1], ti[2], ti[3]); *(f32x4*)(TOPW + (size_t)r * 4) = (f32x4){inv, e1 * inv, e2 * inv, e3 * inv};
                __hip_atomic_fetch_add(&hist[ti[0]], 1u, __ATOMIC_RELAXED, __HIP_MEMORY_SCOPE_WORKGROUP); __hip_atomic_fetch_add(&hist[ti[1]], 1u, __ATOMIC_RELAXED, __HIP_MEMORY_SCOPE_WORKGROUP);
                __hip_atomic_fetch_add(&hist[ti[2]], 1u, __ATOMIC_RELAXED, __HIP_MEMORY_SCOPE_WORKGROUP); __hip_atomic_fetch_add(&hist[ti[3]], 1u, __ATOMIC_RELAXED, __HIP_MEMORY_SCOPE_WORKGROUP); }
        }
        __syncthreads();
        if (tid < 32) CNTB[chk * 32 + tid] = hist[tid];
    }
    __syncthreads();
}
__device__ __forceinline__ void ph_sort2(const Ctx& C) {
    const unsigned* CNTB = WSP(unsigned, WS_CNTB); const int* TOPE = WSP(int, WS_TOPE); const float* TOPW = WSP(float, WS_TOPW);
    int* TOKPOS = WSP(int, WS_TOKPOS); int* ROWTOK = WSP(int, WS_ROWTOK); float* ROWW = WSP(float, WS_ROWW); int* BLKE = WSP(int, WS_BLKE);
    LAS int* ptot = (LAS int*)C.lds;
    LAS int* pbef = ptot + 512;
    LAS int* tot = pbef + 512;
    LAS int* base = tot + 32;
    LAS int* pst = base + 32;
    LAS int* wt = pst + 64;
    const int tid = C.tid, lane = C.lane;
    for (int chk = blockIdx.x; chk < T / 128; chk += gridDim.x) {
        __syncthreads();
        { const int e = tid & 31, part = tid >> 5; int s = 0, sb = 0;
          for (int c2 = part * 16; c2 < part * 16 + 16; ++c2) { const int v = (int)CNTB[c2 * 32 + e]; s += v; sb += (c2 < chk) ? v : 0; }
          ptot[part * 32 + e] = s; pbef[part * 32 + e] = sb; }
        __syncthreads();
        if (tid < 32) { int s = 0, sb = 0;
#pragma unroll
            for (int pp = 0; pp < 16; ++pp) { s += ptot[pp * 32 + tid]; sb += pbef[pp * 32 + tid]; }
            tot[tid] = s; base[tid] = sb; }
        __syncthreads();
        if (tid < 33) { int ps = 0; for (int i = 0; i < tid; ++i) ps += (tot[i] + 255) / 256 * 256; pst[tid] = ps; }
        __syncthreads();
        const int a = chk * 512 + tid; const int ea = TOPE[a]; int pre = 0;
#pragma unroll 4
        for (int e = 0; e < 32; ++e) { const unsigned long long bal = __ballot(ea == e); if (lane == 0) wt[C.wave * 32 + e] = __popcll(bal); if (ea == e) pre = __popcll(bal & ((1ull << lane) - 1ull)); }
        __syncthreads();
        int woff = 0;
#pragma unroll
        for (int w = 0; w < 8; ++w) woff += (w < C.wave) ? wt[w * 32 + ea] : 0;
        const int pos = pst[ea] + base[ea] + woff + pre;
        ROWTOK[pos] = a >> 2; ROWW[pos] = TOPW[a]; TOKPOS[a] = pos;
        if (chk < NE) { const int e = chk, st = pst[e] + tot[e], en = pst[e + 1]; for (int i = st + tid; i < en; i += NTHREADS) { ROWTOK[i] = T; ROWW[i] = 0.f; } }
        if (chk == 0 && tid < DM / 16) ((v4u*)(WSP(unsigned char, WS_H) + (size_t)T * DM))[tid] = (v4u){0u, 0u, 0u, 0u};
        if (chk == T / 128 - 1) { for (int blk = tid; blk <= NBLK; blk += NTHREADS) { int e = NE - 1;
#pragma unroll 1
                for (int i = NE - 1; i >= 0; --i) if (blk * 256 < pst[i + 1]) e = i;
                if (blk < NBLK) BLKE[blk] = e; else BLKE[NBLK] = pst[NE] / 256; } }
    }
    __syncthreads();
}
constexpr int LDS_GS = RING_BYTES + 4096;
__device__ __forceinline__ void ph_router3(const Ctx& C) {
    const float* MOD = WSP(float, WS_MOD); const float* SSQ = WSP(float, WS_SSQ); unsigned char* H = WSP(unsigned char, WS_H); const float* g2n = INP(IX_N2G); const float* RW = INP(IX_RW);
    int* TOPE = WSP(int, WS_TOPE); float* TOPW = WSP(float, WS_TOPW); unsigned* CNTB = WSP(unsigned, WS_CNTB);
    LAS unsigned char* Wl = C.lds; LAS float* gsl = (LAS float*)(C.lds + LDS_GS); LAS float* shl = gsl + 1024;
    LAS unsigned* hist = (LAS unsigned*)(C.lds + LDS_HIST);
    const int lane = C.lane, tid = C.tid, i = lane & 15, kk = lane >> 4;
    for (int g = tid; g < 128 * 32; g += NTHREADS) { const int ex = g & 31, kg = g >> 5; float wv[8];
#pragma unroll
        for (int j = 0; j < 8; ++j) wv[j] = RW[(size_t)(8 * kg + j) * 32 + ex];
        unsigned hi[4], lo[4];
#pragma unroll
        for (int j = 0; j < 4; ++j) { hi[j] = pg8::cvt_pk_bf16(wv[2 * j], wv[2 * j + 1]);
            const float r0_ = wv[2 * j] - __uint_as_float(hi[j] << 16), r1_ = wv[2 * j + 1] - __uint_as_float(hi[j] & 0xffff0000u); lo[j] = pg8::cvt_pk_bf16(r0_, r1_); }
        const int Q = kg >> 2, k2 = kg & 3, nb = ex >> 4, n = ex & 15; LAS unsigned char* d = Wl + (((Q * 2 + nb) * 2) * 64 + k2 * 16 + n) * 16;
        *(LAS v4u*)d = (v4u){hi[0], hi[1], hi[2], hi[3]}; *(LAS v4u*)(d + 1024) = (v4u){lo[0], lo[1], lo[2], lo[3]}; }
    const float rb0 = INP(IX_RB)[i], rb1 = INP(IX_RB)[16 + i];
    for (int chk = blockIdx.x; chk < T / 128; chk += gridDim.x) {
        __syncthreads();
        const float* mrow = MOD + (chk >> 5) * 6144;
        for (int k = tid; k < 1024; k += NTHREADS) { gsl[k] = g2n[k] * (1.0f + mrow[4096 + k]); shl[k] = mrow[3072 + k]; }
        if (tid < 32) hist[tid] = 0u;
        __syncthreads();
        const int r0 = chk * 128 + C.wave * 16, r = r0 + i;
        float ss; { const f32x4 s4 = *(const f32x4*)(SSQ + (size_t)r * 16 + 4 * kk); ss = (s4[0] + s4[1]) + (s4[2] + s4[3]); ss += __shfl_xor(ss, 16); ss += __shfl_xor(ss, 32); }
        const float rstd = rsqrtf(ss * (1.0f / DM) + EPS);
        f32x4 acc0 = {0.f, 0.f, 0.f, 0.f}, acc1 = {0.f, 0.f, 0.f, 0.f};
        const float* xr = C.out + (size_t)r * DM + 8 * kk; unsigned char* hr = H + (size_t)r * DM + 8 * kk;
#pragma unroll 4
        for (int Q = 0; Q < 32; ++Q) {
            const f32x4 xa = *(const f32x4*)(xr + 32 * Q), xb = *(const f32x4*)(xr + 32 * Q + 4);
            const f32x4 ga = *(const LAS f32x4*)(gsl + 32 * Q + 8 * kk), gb = *(const LAS f32x4*)(gsl + 32 * Q + 8 * kk + 4), sa = *(const LAS f32x4*)(shl + 32 * Q + 8 * kk), sb = *(const LAS f32x4*)(shl + 32 * Q + 8 * kk + 4);
            const f32x4 ha = xa * rstd * ga + sa, hb = xb * rstd * gb + sb;
            *(unsigned long long*)(hr + 32 * Q) = (unsigned long long)pg8::pk4_fp8(ha[0], ha[1], ha[2], ha[3]) | ((unsigned long long)pg8::pk4_fp8(hb[0], hb[1], hb[2], hb[3]) << 32);
            unsigned hh[4], hl[4];
            hh[0] = pg8::cvt_pk_bf16(ha[0], ha[1]); hh[1] = pg8::cvt_pk_bf16(ha[2], ha[3]); hh[2] = pg8::cvt_pk_bf16(hb[0], hb[1]); hh[3] = pg8::cvt_pk_bf16(hb[2], hb[3]);
            hl[0] = pg8::cvt_pk_bf16(ha[0] - __uint_as_float(hh[0] << 16), ha[1] - __uint_as_float(hh[0] & 0xffff0000u)); hl[1] = pg8::cvt_pk_bf16(ha[2] - __uint_as_float(hh[1] << 16), ha[3] - __uint_as_float(hh[1] & 0xffff0000u));
            hl[2] = pg8::cvt_pk_bf16(hb[0] - __uint_as_float(hh[2] << 16), hb[1] - __uint_as_float(hh[2] & 0xffff0000u)); hl[3] = pg8::cvt_pk_bf16(hb[2] - __uint_as_float(hh[3] << 16), hb[3] - __uint_as_float(hh[3] & 0xffff0000u));
            const pg8::bf16x8 ah = __builtin_bit_cast(pg8::bf16x8, (v4u){hh[0], hh[1], hh[2], hh[3]}), al = __builtin_bit_cast(pg8::bf16x8, (v4u){hl[0], hl[1], hl[2], hl[3]});
            const LAS unsigned char* wq = Wl + (size_t)(Q * 4) * 1024 + lane * 16;
            const pg8::bf16x8 w0h = *(const LAS pg8::bf16x8*)(wq), w0l = *(const LAS pg8::bf16x8*)(wq + 1024), w1h = *(const LAS pg8::bf16x8*)(wq + 2048), w1l = *(const LAS pg8::bf16x8*)(wq + 3072);
            acc0 = __builtin_amdgcn_mfma_f32_16x16x32_bf16(ah, w0h, acc0, 0, 0, 0); acc1 = __builtin_amdgcn_mfma_f32_16x16x32_bf16(ah, w1h, acc1, 0, 0, 0);
            acc0 = __builtin_amdgcn_mfma_f32_16x16x32_bf16(ah, w0l, acc0, 0, 0, 0); acc1 = __builtin_amdgcn_mfma_f32_16x16x32_bf16(ah, w1l, acc1, 0, 0, 0);
            acc0 = __builtin_amdgcn_mfma_f32_16x16x32_bf16(al, w0h, acc0, 0, 0, 0); acc1 = __builtin_amdgcn_mfma_f32_16x16x32_bf16(al, w1h, acc1, 0, 0, 0);
        }
#pragma unroll
        for (int reg = 0; reg < 4; ++reg) {
            float v0 = acc0[reg] + rb0, v1 = acc1[reg] + rb1; float tv[4]; int ti[4];
#pragma unroll
            for (int k = 0; k < 4; ++k) { const bool f0 = v0 >= v1; float bv = f0 ? v0 : v1; int bi = f0 ? i : 16 + i;
#pragma unroll
                for (int mask = 1; mask < 16; mask <<= 1) { const float ov = __shfl_xor(bv, mask); const int oi = __shfl_xor(bi, mask); const bool take = ov > bv || (ov == bv && oi < bi); bv = take ? ov : bv; bi = take ? oi : bi; }
                tv[k] = bv; ti[k] = bi; if (bi == i) v0 = -INFINITY; if (bi == 16 + i) v1 = -INFINITY; }
            const float e1 = __expf(tv[1] - tv[0]), e2 = __expf(tv[2] - tv[0]), e3 = __expf(tv[3] - tv[0]); const float inv = 1.0f / (1.0f + e1 + e2 + e3);
            if (i == 0) { const size_t row = (size_t)(r0 + 4 * kk + reg); *(int4*)(TOPE + row * 4) = make_int4(ti[0], ti[1], ti[2], ti[3]); *(f32x4*)(TOPW + row * 4) = (f32x4){inv, e1 * inv, e2 * inv, e3 * inv};
                __hip_atomic_fetch_add(&hist[ti[0]], 1u, __ATOMIC_RELAXED, __HIP_MEMORY_SCOPE_WORKGROUP); __hip_atomic_fetch_add(&hist[ti[1]], 1u, __ATOMIC_RELAXED, __HIP_MEMORY_SCOPE_WORKGROUP);
                __hip_atomic_fetch_add(&hist[ti[2]], 1u, __ATOMIC_RELAXED, __HIP_MEMORY_SCOPE_WORKGROUP); __hip_atomic_fetch_add(&hist[ti[3]], 1u, __ATOMIC_RELAXED, __HIP_MEMORY_SCOPE_WORKGROUP); }
        }
        __syncthreads();
        if (tid < 32) CNTB[chk * 32 + tid] = hist[tid];
    }
    __syncthreads();
}
__device__ __forceinline__ void ph_attention(const Ctx& C) {
    const unsigned char* Q8 = WSP(unsigned char, WS_QP); const unsigned char* K8 = WSP(unsigned char, WS_KA); const unsigned char* V8T = WSP(unsigned char, WS_V8T); bf16* OA = WSP(bf16, WS_OAB);
    const float lam = *WSP(float, WS_LAM); const float* sg = INP(IX_SUBG);
    const float sbound = 0.20358f * sqrtf(__uint_as_float(WSP(unsigned, WS_CTL)[CW_NMAX]) * __uint_as_float(WSP(unsigned, WS_CTL)[CW_NMAX + 64]));
    const bool nomax = __builtin_amdgcn_readfirstlane((int)(sbound > 0.f && sbound <= 15.6f)) != 0;
    const bool xl = gridDim.x == 256;
#define ATT_UNITS(NM) for (int it = 0; it < (xl ? 4 : (NB * 4 * (SEQ / 128) + (int)gridDim.x - 1) / (int)gridDim.x); ++it) { \
        int u; \
        if (xl) { const int x = blockIdx.x & 7, j = blockIdx.x >> 3; u = ((4 * x + it) << 5) | j; } else { u = blockIdx.x + it * gridDim.x; if (u >= NB * 4 * (SEQ / 128)) break; } \
        const int qb = u & 31, h = (u >> 5) & 3, b = u >> 7; \
        const long q0 = ((long)b * SEQ + qb * 128) * 512 + h * 128, k0 = (long)b * SKV * 512 + h * 128, o0 = ((long)b * SEQ + qb * 128) * 1024 + h * 128, v0 = (long)(b * 4 + h) * (SKV / 64) * 8192; \
        __syncthreads(); \
        att::attn_diff_body8<NM>(Q8 + q0, K8 + k0, V8T + v0, OA + o0, SKV, C.ldsg, C.lds, lam, sg, 0.8f); }
    if (nomax) { ATT_UNITS(true) } else { ATT_UNITS(false) }
#undef ATT_UNITS
    __syncthreads();
}
enum { PH_PREP = 0, PH_MOD1, PH_INPROJ, PH_POST, PH_ATTN, PH_HYENA, PH_ATTNPOST, PH_MERGEUP, PH_WOUT, PH_ROUTER, PH_SORT, PH_MOE1, PH_MOE2, PH_COMBINE, N_PHASES };
struct Args { const float* in[N_INPUTS]; float* out; unsigned char* ws; int ph_lo, ph_hi, li, pad; };
static_assert(sizeof(Args) == N_INPUTS * 8 + 8 + 8 + 16, "Args has no padding");

#ifndef PG8_ALIGN
#define PG8_ALIGN true
#endif
namespace cg = cooperative_groups;
__global__ void __launch_bounds__(NTHREADS, 2) fwd(Args args) {
    cg::grid_group grid_g = cg::this_grid();
    extern __shared__ __attribute__((aligned(16))) unsigned char lds_raw[];
    Ctx C;
    C.out = args.out; C.ws = args.ws; C.lds = (LAS unsigned char*)lds_raw; C.ldsg = (char*)lds_raw;
    C.tid = threadIdx.x; C.lane = C.tid & 63; C.wave = __builtin_amdgcn_readfirstlane(C.tid >> 6);
    C.gwave = blockIdx.x * NWAVES + C.wave; C.nwaves = gridDim.x * NWAVES; C.gtid = blockIdx.x * NTHREADS + C.tid; C.gthreads = gridDim.x * NTHREADS;
    const int lo = args.ph_lo, hi = args.ph_hi;
    volatile LAS unsigned* MISC = (volatile LAS unsigned*)(C.lds + MISC_OFF);
    if (C.tid < 32) MISC[C.tid] = 0u;
    __syncthreads();
    unsigned* barw = (unsigned*)(C.ws + WS_CTL) + CW_BAR + args.li * XCD_BAR_WORDS;
    XcdBarrier xbar; xbar.bar = barw; xbar.x = 0; xbar.st = nullptr;
    if (hi - lo > 1) xbar = xcd_barrier_post(barw, MISC + 8);
#define IN(k) (lo <= (k) && (k) < hi)
#define SEAM(k) do { if (IN(k) && IN((k) + 1)) { if (args.li < 0) grid_g.sync(); else xcd_barrier(xbar); } } while (0)
    if (IN(PH_PREP)) { ph_prep_weights(C); __syncthreads(); ph_prep_ada(C); __syncthreads(); ph_prep_misc(C); ph_prep_filter(C); }
    SEAM(PH_PREP);
    if (IN(PH_MOD1)) { ph_modulate1(C); }
    SEAM(PH_MOD1);
    if (IN(PH_INPROJ)) {
        {
            LAS float* tb = (LAS float*)(C.lds + RING_BYTES + 20480);
            for (int i = C.tid; i < 1024; i += NTHREADS) { tb[i] = WSP(float, WS_ROPEC)[i]; tb[1024 + i] = WSP(float, WS_ROPES)[i]; }
            if (C.tid < 64) { tb[2048 + C.tid] = INP(IX_QNG)[C.tid]; tb[2048 + 64 + C.tid] = INP(IX_KNG)[C.tid]; }
            __syncthreads(); }
        {
            pg8::Gemm g{WSP(bf16, WS_XM), WSP(bf16, WS_WIN), T, 3072, DM, 0}; pg8::WinOrder S; S.so.init(T, 3072, gridDim.x, (int)blockIdx.x); S.pn0 = 0;
            pg8::EpiInProj E{WSP(bf16, WS_QP), WSP(bf16, WS_KA), WSP(bf16, WS_VA), WSP(bf16, WS_HY), WSP(bf16, WS_GT), INP(IX_BIN), C.lds, T, SKV, CTX, WSP(unsigned, WS_CTL) + CW_NMAX};
            pg8::gemm_phase<pg8::EpiInProj, pg8::WinOrder, PG8_ALIGN, true>(C.lds, g, S, E); }
        {
            pg8::Gemm g{WSP(bf16, WS_XM8), (const bf16*)(WSP(unsigned char, WS_WG8) - (size_t)12 * 256 * 1024), T, 2048, DM / 2, 0}; pg8::WinOrder S; S.so.init(T, 2048, gridDim.x, (int)blockIdx.x); S.pn0 = 12;
            pg8::EpiInProjT<true> E{WSP(bf16, WS_QP), WSP(bf16, WS_KA), WSP(bf16, WS_VA), WSP(bf16, WS_HY), WSP(bf16, WS_GT), INP(IX_BIN), C.lds, T, SKV, CTX, WSP(unsigned, WS_CTL) + CW_NMAX};
            pg8::gemm_phase<pg8::EpiInProjT<true>, pg8::WinOrder, PG8_ALIGN, true>(C.lds, g, S, E); }
    }
    SEAM(PH_INPROJ);
    if (IN(PH_POST)) {
        {
            LAS float* tb = (LAS float*)(C.lds + RING_BYTES + 20480);
            for (int i = C.tid; i < 1024; i += NTHREADS) { tb[i] = WSP(float, WS_ROPEC)[i]; tb[1024 + i] = WSP(float, WS_ROPES)[i]; }
            if (C.tid < 64) { tb[2048 + C.tid] = INP(IX_QNG)[C.tid]; tb[2048 + 64 + C.tid] = INP(IX_KNG)[C.tid]; }
            __syncthreads(); }
        { pg8::Gemm g{WSP(bf16, WS_XM), WSP(bf16, WS_WIN), MROWS, NIN, DM, 0}; pg8::CtxOrder S{(int)gridDim.x, (int)blockIdx.x};
          pg8::EpiInProj E{WSP(bf16, WS_QP), WSP(bf16, WS_KA), WSP(bf16, WS_VA), WSP(bf16, WS_HY), WSP(bf16, WS_GT), INP(IX_BIN), C.lds, T, SKV, CTX, WSP(unsigned, WS_CTL) + CW_NMAX};
          pg8::gemm_phase<pg8::EpiInProj, pg8::CtxOrder, true, true>(C.lds, g, S, E); }
        asm volatile("s_waitcnt vmcnt(0)" ::: "memory"); __syncthreads();
        if (gridDim.x >= 32 && blockIdx.x >= 16 && blockIdx.x < 32) ph_v8t_ctx(C, (int)blockIdx.x & 7, 2 * (((int)blockIdx.x >> 3) - 2));
        __syncthreads(); ph_hyena_pre8(C); ph_v8t(C); }
    SEAM(PH_POST);
    if (IN(PH_ATTN)) { ph_attention(C); }
    if (IN(PH_HYENA)) { ph_hyena_mfma8(C); }
    SEAM(PH_HYENA);
    if (IN(PH_ATTNPOST)) { ph_hyena_post(C); }
    SEAM(PH_ATTNPOST);
    if (IN(PH_MERGEUP)) {
        pg8::Gemm g{WSP(bf16, WS_OAB), WSP(bf16, WS_WA), T, DM, DM, 0}; pg8::StaticOrder S; S.init(T, DM, gridDim.x, (int)blockIdx.x);
        pg8::EpiMerge E{WSP(bf16, WS_MB), WSP(bf16, WS_GT)}; pg8::gemm_phase<pg8::EpiMerge, pg8::StaticOrder, PG8_ALIGN, true>(C.lds, g, S, E);
    }
    SEAM(PH_MERGEUP);
    if (IN(PH_WOUT)) {
        pg8::Gemm g{WSP(bf16, WS_MB), WSP(bf16, WS_WO), T, DM, DM, 0}; pg8::StaticOrder S; S.init(T, DM, gridDim.x, (int)blockIdx.x);
        pg8::EpiWout E{INP(IX_X), C.out, WSP(float, WS_MOD), WSP(float, WS_SSQ)}; pg8::gemm_phase<pg8::EpiWout, pg8::StaticOrder, PG8_ALIGN, true>(C.lds, g, S, E);
    }
    SEAM(PH_WOUT);
    if (IN(PH_ROUTER)) { ph_router3(C); }
    SEAM(PH_ROUTER);
    if (IN(PH_SORT)) { ph_sort2(C); }
    SEAM(PH_SORT);
    if (IN(PH_MOE1)) {
        const int nblk = WSP(int, WS_BLKE)[NBLK];
        pg8::MoeGatherOrder S; S.so.init(nblk * 256, 2048, gridDim.x, (int)blockIdx.x); S.blke = WSP(int, WS_BLKE); S.tokl = (const LAS unsigned short*)(C.lds + LDS_GS);
        {
            LAS unsigned short* tl = (LAS unsigned short*)(C.lds + LDS_GS); const int* ROWTOK = WSP(int, WS_ROWTOK); pg8::Unit uu;
            LAS int* pml = (LAS int*)(C.lds + LDS_GS + 10240);
            if (C.tid == 0) { for (int ui = 0; ui < 20; ++ui) pml[ui] = S.so.next(ui, uu) ? uu.pm : -1; }
            __syncthreads();
#define TL_LD(u) const int pm##u = pml[u]; int tv##u = 0; if (pm##u >= 0 && C.tid < 256) tv##u = ROWTOK[pm##u * 256 + C.tid];
#define TL_ST(u) if (C.tid < 256) tl[(u) * 256 + C.tid] = (unsigned short)tv##u;
            TL_LD(0) TL_LD(1) TL_LD(2) TL_LD(3) TL_LD(4) TL_LD(5) TL_LD(6) TL_LD(7) TL_LD(8) TL_LD(9) TL_LD(10) TL_LD(11) TL_LD(12) TL_LD(13) TL_LD(14) TL_LD(15) TL_LD(16) TL_LD(17) TL_LD(18) TL_LD(19)
            TL_ST(0) TL_ST(1) TL_ST(2) TL_ST(3) TL_ST(4) TL_ST(5) TL_ST(6) TL_ST(7) TL_ST(8) TL_ST(9) TL_ST(10) TL_ST(11) TL_ST(12) TL_ST(13) TL_ST(14) TL_ST(15) TL_ST(16) TL_ST(17) TL_ST(18) TL_ST(19)
#undef TL_LD
#undef TL_ST
        }
        __syncthreads();
        pg8::Gemm g{WSP(bf16, WS_H), WSP(bf16, WS_W1), nblk * 256, 2048, DM / 2, (size_t)2048 * 1024};
        pg8::EpiSwiglu E{WSP(unsigned char, WS_ACT), INP(IX_EB1), C.lds}; pg8::gemm_phase<pg8::EpiSwiglu, pg8::MoeGatherOrder, PG8_ALIGN, true>(C.lds, g, S, E);
    }
    SEAM(PH_MOE1);
    if (IN(PH_MOE2)) {
        const int nblk = WSP(int, WS_BLKE)[NBLK];
        pg8::Gemm g{WSP(bf16, WS_ACT), WSP(bf16, WS_W2), nblk * 256, DM, DM / 2, (size_t)1024 * 1024}; pg8::MoeOrder S; S.so.init(nblk * 256, DM, gridDim.x, (int)blockIdx.x); S.blke = WSP(int, WS_BLKE);
        pg8::EpiY E{WSP(unsigned char, WS_Y), INP(IX_EB2), WSP(float, WS_ROWW), C.lds}; pg8::gemm_phase<pg8::EpiY, pg8::MoeOrder, PG8_ALIGN, true>(C.lds, g, S, E);
    }
    SEAM(PH_MOE2);
    if (IN(PH_COMBINE)) { ph_combine(C); }
#undef IN
#undef SEAM
}

extern "C" void kernel_launch(void* const* d_in, const int* in_sizes, int n_in, void* d_out, int out_size, void* d_ws, size_t ws_size, hipStream_t stream) {
    static int grid = 0;
    if (grid == 0) {
        if (n_in != N_INPUTS || in_sizes[0] != T * DM || out_size != T * DM || ws_size < WS_END) { fprintf(stderr, "kernel_launch: unexpected shapes n_in %d in0 %d out %d ws %zu (need %zu)\n", n_in, n_in > 0 ? in_sizes[0] : -1, out_size, ws_size, (size_t)WS_END); grid = -1; return; }
        int dev = 0, cus = 0;
        if (hipGetDevice(&dev) != hipSuccess || hipDeviceGetAttribute(&cus, hipDeviceAttributeMultiprocessorCount, dev) != hipSuccess) { grid = -1; return; }
        if (hipFuncSetAttribute((const void*)fwd, hipFuncAttributeMaxDynamicSharedMemorySize, LDS_BYTES) != hipSuccess) { fprintf(stderr, "kernel_launch: hipFuncSetAttribute failed\n"); grid = -1; return; }
        int per_cu = 0;
        if (hipOccupancyMaxActiveBlocksPerMultiprocessor(&per_cu, (const void*)fwd, NTHREADS, LDS_BYTES) != hipSuccess || per_cu < 1) { fprintf(stderr, "kernel_launch: occupancy query says %d blocks per CU\n", per_cu); grid = -1; return; }
        grid = cus;
    }
    if (grid < 0) return;
    (void)hipMemsetAsync((char*)d_ws + WS_CTL, 0, CTL_BYTES, stream);
    Args a{};
    for (int i = 0; i < N_INPUTS; ++i) a.in[i] = (const float*)d_in[i];
    a.out = (float*)d_out; a.ws = (unsigned char*)d_ws;
#ifndef PROBE_DUP
#define PROBE_DUP -1
#endif
    int cuts[5] = {0, N_PHASES, N_PHASES, N_PHASES, N_PHASES}, nl = 1;
    if (PROBE_DUP >= 0) { cuts[1] = PROBE_DUP + 1; cuts[2] = PROBE_DUP; cuts[3] = PROBE_DUP + 1; nl = 4; }
    for (int li = 0; li < (PROBE_DUP >= 0 ? 3 : 1); ++li) {
        if (PROBE_DUP >= 0) { a.ph_lo = li == 0 ? 0 : (li == 1 ? PROBE_DUP : PROBE_DUP + 1); a.ph_hi = li == 2 ? N_PHASES : PROBE_DUP + 1; } else { a.ph_lo = 0; a.ph_hi = N_PHASES; }
        a.li = li; (void)cuts; (void)nl;
        if (a.ph_lo >= a.ph_hi) continue;
        void* kargs[] = {&a};
        const hipError_t le = hipLaunchCooperativeKernel((const void*)fwd, dim3(grid), dim3(NTHREADS), kargs, LDS_BYTES, stream);
        if (le != hipSuccess) fprintf(stderr, "kernel_launch: cooperative launch failed: %s (grid %d)\n", hipGetErrorString(le), grid);
    }
}
```

```cpp
#include <hip/hip_runtime.h>
#include <hip/hip_bf16.h>
#include <hip/hip_cooperative_groups.h>
#include <cstdio>
#include <cstdint>
#include <cmath>
namespace pg8 {
#define PG8_LAS __attribute__((address_space(3)))
typedef unsigned short bf16_t;
typedef short bf16x8 __attribute__((ext_vector_type(8)));
typedef float f32x4 __attribute__((ext_vector_type(4)));
typedef unsigned u32x4 __attribute__((ext_vector_type(4)));
typedef int v4i_t __attribute__((ext_vector_type(4)));
typedef int v8i_t __attribute__((ext_vector_type(8)));
constexpr int EPI_OFF = 131072 + 16384;
constexpr int BM = 256, BK = 64, HALF = 128, HTB = HALF * BK * 2  , STAGE_BYTES = 8 * HTB, NXCD = 8, WGM = 8;

__host__ __device__ __forceinline__ int lds_byte(int r, int c) { const int st = (r >> 4) * 2 + (c >> 5), rr = r & 15, cc = c & 31, ob = rr * 64 + cc * 2; return st * 1024 + (ob ^ (((ob >> 9) & 1) << 5)); }
__host__ __device__ __forceinline__ void stage_rc(int b, int& R, int& C) { const int st = b / 1024, sb = b % 1024, swz = sb ^ (((sb >> 9) & 1) << 5); R = (st >> 1) * 16 + swz / 64; C = (st & 1) * 32 + (swz % 64) / 2; }
__host__ __device__ __forceinline__ int perm32(int rho) { const int n = rho >> 4, i = rho & 15; return 8 * (i >> 2) + 4 * n + (i & 3); }

struct Unit { int pm, pn, be, es; };
struct Gemm { const bf16_t* A; const bf16_t* Bt; int M, N, K; size_t bstride; };

struct StaticOrder {
    static constexpr bool GATHER = false;
    int nM, nN, nwg, G, c;
    __host__ __device__ __forceinline__ void init(int M, int N, int G_, int c_) { nM = M / BM; nN = N / BM; nwg = nM * nN; G = G_; c = c_; }
    __host__ __device__ __forceinline__ bool next(int i, Unit& u) const {
        const long L = (long)i * G + c; if (L >= nwg) return false;
        int wgid = (int)L; { const int q = nwg / NXCD, r = nwg % NXCD, xcd = wgid % NXCD, off = wgid / NXCD; wgid = (xcd < r ? xcd * (q + 1) : r * (q + 1) + (xcd - r) * q) + off; }
        const int nig = WGM * nN, gid = wgid / nig, fm = gid * WGM, gsz = (nM - fm) < WGM ? (nM - fm) : WGM;
        u.pm = fm + ((wgid % nig) % gsz); u.pn = (wgid % nig) / gsz; u.be = 0; u.es = 0; return true;
    }
    __device__ __forceinline__ void a_ready(const Unit&) const {}
    __device__ __forceinline__ void done(const Unit&) const {}
};

__device__ __forceinline__ unsigned cvt_pk_bf16(float lo, float hi) { unsigned r; asm volatile("v_cvt_pk_bf16_f32 %0, %1, %2" : "=v"(r) : "v"(lo), "v"(hi)); return r; }
typedef float f32x2 __attribute__((ext_vector_type(2)));
__device__ __forceinline__ f32x2 gelu_pk(f32x2 v) {
    const f32x2 av = __builtin_elementwise_abs(v), d = av * 0.2316418882f + 1.0f;
    f32x2 t; t.x = __builtin_amdgcn_rcpf(d.x); t.y = __builtin_amdgcn_rcpf(d.y);
    f32x2 q = t * 0.5307027145f + (-0.7265760135f); q = q * t + 0.7107068705f; q = q * t + (-0.142248368f); q = q * t + 0.127414796f; q = q * t;
    const f32x2 s = (v * v) * (-0.72134752044f);
    f32x2 e; e.x = __builtin_amdgcn_exp2f(s.x); e.y = __builtin_amdgcn_exp2f(s.y);
    const f32x2 m = v * (q * e), r = v - m;
    f32x2 o; o.x = v.x < 0.f ? m.x : r.x; o.y = v.y < 0.f ? m.y : r.y; return o;
}

template <int ACT  > struct EpiBf16 {
    static constexpr bool PERM = true, AFTER_DRAIN = false, HAS_MID = false, F8 = false, PREFETCH = false; static constexpr int WSCALE = 0x7F7F7F7F; static_assert(ACT == 0 || ACT == 1, "EpiBf16: ACT is 0 (none) or 1 (gelu_pk)");
    bf16_t* O; int ldc; const float* bias; int split_cols; size_t split_stride; float scale0;
    __device__ __forceinline__ void operator()(const f32x4 (&acc)[2][2][4][2], const Unit& u, int wr, int wc, int fr, int fq) const {
        const int row0 = u.pm * BM + wr * 64 + fr; int colt = u.pn * BM; bf16_t* base = O;
        float sc = 1.f; if (split_cols) { const int t = colt / split_cols; base += (size_t)t * split_stride; colt -= t * split_cols; if (t == 0) sc = scale0; }
        const int col0 = colt + wc * 32 + 8 * fq, bcol0 = u.pn * BM + wc * 32 + 8 * fq;
        f32x4 bv[2][2];
#pragma unroll
        for (int bj = 0; bj < 2; ++bj)
#pragma unroll
            for (int n = 0; n < 2; ++n) bv[bj][n] = bias ? *(const f32x4*)(bias + bcol0 + bj * HALF + 4 * n) : (f32x4){0.f, 0.f, 0.f, 0.f};
#pragma unroll
        for (int ai = 0; ai < 2; ++ai)
#pragma unroll
            for (int m = 0; m < 4; ++m) { bf16_t* rowp = base + (size_t)(row0 + ai * HALF + m * 16) * ldc + col0;
#pragma unroll
                for (int bj = 0; bj < 2; ++bj) { f32x4 v0 = acc[ai][bj][m][0] + bv[bj][0], v1 = acc[ai][bj][m][1] + bv[bj][1];
                    if (ACT == 1) { f32x2 a = gelu_pk((f32x2){v0[0], v0[1]}), b = gelu_pk((f32x2){v0[2], v0[3]}), c = gelu_pk((f32x2){v1[0], v1[1]}), d = gelu_pk((f32x2){v1[2], v1[3]});
                        v0 = (f32x4){a.x, a.y, b.x, b.y}; v1 = (f32x4){c.x, c.y, d.x, d.y}; }
                    v0 = v0 * sc; v1 = v1 * sc; u32x4 w; w.x = cvt_pk_bf16(v0[0], v0[1]); w.y = cvt_pk_bf16(v0[2], v0[3]); w.z = cvt_pk_bf16(v1[0], v1[1]); w.w = cvt_pk_bf16(v1[2], v1[3]);
                    *(u32x4*)(rowp + bj * HALF) = w; } }
    }
};
struct EpiF32 {
    static constexpr bool PERM = false, AFTER_DRAIN = false, HAS_MID = false, F8 = false, PREFETCH = false; static constexpr int WSCALE = 0x7F7F7F7F;
    float* C; int ldc; const float* bias;
    __device__ __forceinline__ void operator()(const f32x4 (&acc)[2][2][4][2], const Unit& u, int wr, int wc, int fr, int fq) const {
        const int row0 = u.pm * BM + wr * 64 + fr, col0 = u.pn * BM + wc * 32 + 4 * fq;
        f32x4 bv[2][2];
#pragma unroll
        for (int bj = 0; bj < 2; ++bj)
#pragma unroll
            for (int n = 0; n < 2; ++n) bv[bj][n] = bias ? *(const f32x4*)(bias + col0 + bj * HALF + n * 16) : (f32x4){0.f, 0.f, 0.f, 0.f};
#pragma unroll
        for (int ai = 0; ai < 2; ++ai)
#pragma unroll
            for (int m = 0; m < 4; ++m) { float* rowp = C + (size_t)(row0 + ai * HALF + m * 16) * ldc + col0;
#pragma unroll
                for (int bj = 0; bj < 2; ++bj)
#pragma unroll
                    for (int n = 0; n < 2; ++n) *(f32x4*)(rowp + bj * HALF + n * 16) = acc[ai][bj][m][n] + bv[bj][n]; }
    }
};
__device__ __forceinline__ void epi_dma(const void* src, PG8_LAS unsigned char* dst) { __builtin_amdgcn_global_load_lds((const unsigned*)src, (PG8_LAS unsigned*)dst, 16, 0, 0); }
__device__ __forceinline__ unsigned pk4_fp8(float a, float b, float c, float d) {
    a = __builtin_fminf(__builtin_fmaxf(a, -448.f), 448.f); b = __builtin_fminf(__builtin_fmaxf(b, -448.f), 448.f); c = __builtin_fminf(__builtin_fmaxf(c, -448.f), 448.f); d = __builtin_fminf(__builtin_fmaxf(d, -448.f), 448.f);
    int w = 0; w = __builtin_amdgcn_cvt_pk_fp8_f32(a, b, w, false); w = __builtin_amdgcn_cvt_pk_fp8_f32(c, d, w, true); return (unsigned)w; }
__device__ __forceinline__ unsigned pk4_fp8_nc(float a, float b, float c, float d) { int w; asm volatile("" : "=v"(w)); w = __builtin_amdgcn_cvt_pk_fp8_f32(a, b, w, false); w = __builtin_amdgcn_cvt_pk_fp8_f32(c, d, w, true); return (unsigned)w; }
struct EpiSwiglu {
    static constexpr bool PERM = true, AFTER_DRAIN = false, HAS_MID = false, F8 = true, PREFETCH = true; static constexpr int WSCALE = 0x7A7A7A7A;
    unsigned char* O; const float* b1; PG8_LAS unsigned char* el;
    __device__ __forceinline__ void prefetch(const Unit& u, int slot, int wid, int lane) const {
        if (wid == 0) epi_dma(b1 + (size_t)u.be * 2048 + (lane >> 5) * 1024 + u.pn * HALF + (lane & 31) * 4, el + EPI_OFF + slot * 2048); }
    __device__ __forceinline__ void operator()(const f32x4 (&acc)[2][2][4][2], const Unit& u, int wr, int wc, int fr, int fq) const {
        const int row0 = u.pm * BM + wr * 64 + fr; const int ch0 = u.pn * HALF + wc * 32 + 8 * fq;
        const PG8_LAS float* bb = (const PG8_LAS float*)(el + EPI_OFF + u.es * 2048) + wc * 32 + 8 * fq;
        f32x4 bg[2], bu[2];
#pragma unroll
        for (int n = 0; n < 2; ++n) { bg[n] = *(const PG8_LAS f32x4*)(bb + 4 * n); bu[n] = *(const PG8_LAS f32x4*)(bb + 128 + 4 * n); }
#pragma unroll
        for (int ai = 0; ai < 2; ++ai)
#pragma unroll
            for (int m = 0; m < 4; ++m) { unsigned char* rowp = O + (size_t)(row0 + ai * HALF + m * 16) * 1024 + ch0;
                f32x4 a[2];
#pragma unroll
                for (int n = 0; n < 2; ++n) { const f32x4 g = acc[ai][0][m][n] + bg[n], up = acc[ai][1][m][n] + bu[n];
#pragma unroll
                    for (int e = 0; e < 4; ++e) { const float gg = fminf(g[e], 7.0f), uu = fminf(fmaxf(up[e], -7.0f), 7.0f);
                        const float sg = __builtin_amdgcn_rcpf(1.0f + __builtin_amdgcn_exp2f(-1.702f * 1.4426950408889634f * gg));
                        const float t = gg * sg; a[n][e] = __builtin_fmaf(uu, t, t); } }
                *(unsigned long long*)rowp = (unsigned long long)pk4_fp8_nc(a[0][0], a[0][1], a[0][2], a[0][3]) | ((unsigned long long)pk4_fp8_nc(a[1][0], a[1][1], a[1][2], a[1][3]) << 32); }
    }
};
struct EpiY {
    static constexpr bool PERM = true, AFTER_DRAIN = false, HAS_MID = false, F8 = true; static constexpr int WSCALE = 0x7A7A7A7A;
    unsigned char* O; const float* b2; const float* roww; PG8_LAS unsigned char* el;
    static constexpr bool PREFETCH = true;
    __device__ __forceinline__ void prefetch(const Unit& u, int slot, int wid, int lane) const {
        if (wid == 0) epi_dma(b2 + (size_t)u.be * 1024 + u.pn * BM + lane * 4, el + EPI_OFF + slot * 2048);
        if (wid == 1) epi_dma(roww + (size_t)u.pm * BM + lane * 4, el + EPI_OFF + slot * 2048 + 1024); }
    __device__ __forceinline__ void operator()(const f32x4 (&acc)[2][2][4][2], const Unit& u, int wr, int wc, int fr, int fq) const {
        const int row0 = u.pm * BM + wr * 64 + fr; const int col0 = u.pn * BM + wc * 32 + 8 * fq;
        const PG8_LAS float* sl = (const PG8_LAS float*)(el + EPI_OFF + u.es * 2048); const PG8_LAS float* bb = sl + wc * 32 + 8 * fq;
        f32x4 bv[2][2];
#pragma unroll
        for (int bj = 0; bj < 2; ++bj)
#pragma unroll
            for (int n = 0; n < 2; ++n) bv[bj][n] = *(const PG8_LAS f32x4*)(bb + bj * HALF + 4 * n);
#pragma unroll
        for (int ai = 0; ai < 2; ++ai)
#pragma unroll
            for (int m = 0; m < 4; ++m) { const int row = row0 + ai * HALF + m * 16; const float rw = sl[256 + ai * HALF + wr * 64 + m * 16 + fr] * 16.0f; unsigned char* rowp = O + (size_t)row * 1024 + col0;
#pragma unroll
                for (int bj = 0; bj < 2; ++bj) { const f32x4 v0 = (acc[ai][bj][m][0] + bv[bj][0]) * rw, v1 = (acc[ai][bj][m][1] + bv[bj][1]) * rw;
                    *(unsigned long long*)(rowp + bj * HALF) = (unsigned long long)pk4_fp8(v0[0], v0[1], v0[2], v0[3]) | ((unsigned long long)pk4_fp8(v1[0], v1[1], v1[2], v1[3]) << 32); } }
    }
};
struct MoeOrder {
    static constexpr bool GATHER = false;
    StaticOrder so; const int* blke;
    __device__ __forceinline__ bool next(int i, Unit& u) const { if (!so.next(i, u)) return false; u.be = blke[u.pm]; return true; }
    __device__ __forceinline__ void a_ready(const Unit&) const {}
    __device__ __forceinline__ void done(const Unit&) const {}
};
__device__ __forceinline__ void st_bf16x4(bf16_t* p, const f32x4& v) { *(unsigned long long*)p = (unsigned long long)cvt_pk_bf16(v[0], v[1]) | ((unsigned long long)cvt_pk_bf16(v[2], v[3]) << 32); }
template <bool F8_> struct EpiInProjT {
    static constexpr bool PERM = false, AFTER_DRAIN = false, HAS_MID = false, F8 = F8_, PREFETCH = true; static constexpr int WSCALE = F8_ ? 0x7A7A7A7A : 0x7F7F7F7F;
    bf16_t *QP, *KA, *VA, *HY, *GT; const float* bias; PG8_LAS unsigned char* el; int T_, SKV_, CTX_; unsigned* nmax;
    static constexpr int TAB_OFF = 131072 + 20480;
    __device__ __forceinline__ void prefetch(const Unit& u, int slot, int wid, int lane) const { if (wid == 0) epi_dma(bias + 256 * u.pn + lane * 4, el + EPI_OFF + slot * 2048); }
    __device__ __forceinline__ void operator()(const f32x4 (&acc)[2][2][4][2], const Unit& u, int wr, int wc, int fr_, int fq_) const {
        int fr = fr_, fq = fq_; asm volatile("" : "+v"(fr), "+v"(fq));
        const int pn = u.pn;
        if (pn < 4) {
            const bool isk = pn >= 2; const PG8_LAS float* g = (const PG8_LAS float*)(el + TAB_OFF + 8192 + (isk ? 256 : 0)); const PG8_LAS float* bsl = (const PG8_LAS float*)(el + EPI_OFF + u.es * 2048);
            const PG8_LAS float* rc = (const PG8_LAS float*)(el + TAB_OFF); const PG8_LAS float* rs = rc + 1024;
            f32x4 bv[2][2], gv[2][2];
#pragma unroll
            for (int bj = 0; bj < 2; ++bj)
#pragma unroll
                for (int n = 0; n < 2; ++n) { bv[bj][n] = *(const PG8_LAS f32x4*)(bsl + 64 * wc + 32 * bj + 16 * n + 4 * fq); gv[bj][n] = *(const PG8_LAS f32x4*)(g + 32 * bj + 16 * n + 4 * fq); }
            float nrm2 = 0.f;
#pragma unroll
            for (int ai = 0; ai < 2; ++ai)
#pragma unroll
                for (int m = 0; m < 4; ++m) { const int r = u.pm * BM + ai * HALF + wr * 64 + m * 16 + fr;
                    f32x4 x[2][2]; float ss = 0.f;
#pragma unroll
                    for (int bj = 0; bj < 2; ++bj)
#pragma unroll
                        for (int n = 0; n < 2; ++n) { x[bj][n] = acc[ai][bj][m][n] + bv[bj][n]; ss += (x[bj][n][0] * x[bj][n][0] + x[bj][n][1] * x[bj][n][1]) + (x[bj][n][2] * x[bj][n][2] + x[bj][n][3] * x[bj][n][3]); }
                    ss += __shfl_xor(ss, 16); ss += __shfl_xor(ss, 32);
                    const float rstd = rsqrtf(ss * (1.0f / 64.0f) + 1e-6f);
#pragma unroll
                    for (int bj = 0; bj < 2; ++bj)
#pragma unroll
                        for (int n = 0; n < 2; ++n) x[bj][n] = x[bj][n] * rstd * gv[bj][n];
                    { float s2 = 0.f;
#pragma unroll
                      for (int bj = 0; bj < 2; ++bj)
#pragma unroll
                        for (int n = 0; n < 2; ++n) s2 += (x[bj][n][0] * x[bj][n][0] + x[bj][n][1] * x[bj][n][1]) + (x[bj][n][2] * x[bj][n][2] + x[bj][n][3] * x[bj][n][3]);
                      s2 += __shfl_xor(s2, 16); s2 += __shfl_xor(s2, 32); nrm2 = fmaxf(nrm2, s2); }
                    const bool latent = r < T_; const int t = r & 4095;
                    if (latent) {
#pragma unroll
                        for (int bj = 0; bj < 2; ++bj) { const int pos = bj ? (t & 63) : (t >> 6); const f32x4 cs = *(const PG8_LAS f32x4*)(rc + pos * 16 + 4 * fq), sn = *(const PG8_LAS f32x4*)(rs + pos * 16 + 4 * fq);
                            const f32x4 x1 = x[bj][0], x2 = x[bj][1]; x[bj][0] = x1 * cs - x2 * sn; x[bj][1] = x2 * cs + x1 * sn; } }
                    if (!isk) { unsigned char* base = (unsigned char*)QP + (size_t)r * 512 + 256 * (pn & 1) + 64 * wc;
#pragma unroll
                        for (int bj = 0; bj < 2; ++bj)
#pragma unroll
                            for (int n = 0; n < 2; ++n) { const f32x4 v = x[bj][n] * 0.72134752044448170f; *(unsigned*)(base + 32 * bj + 16 * n + 4 * fq) = pk4_fp8(v[0], v[1], v[2], v[3]); } }
                    else { const size_t krow = latent ? (size_t)(r >> 12) * SKV_ + CTX_ + t : (size_t)((r - T_) >> 8) * SKV_ + ((r - T_) & 255); unsigned char* base = (unsigned char*)KA + krow * 512 + 256 * (pn & 1) + 64 * wc;
#pragma unroll
                        for (int bj = 0; bj < 2; ++bj)
#pragma unroll
                            for (int n = 0; n < 2; ++n) { const f32x4 v = x[bj][n]; *(unsigned*)(base + 32 * bj + 16 * n + 4 * fq) = pk4_fp8(v[0], v[1], v[2], v[3]); } }
                }
            nrm2 = fmaxf(nrm2, __shfl_xor(nrm2, 1)); nrm2 = fmaxf(nrm2, __shfl_xor(nrm2, 2)); nrm2 = fmaxf(nrm2, __shfl_xor(nrm2, 4)); nrm2 = fmaxf(nrm2, __shfl_xor(nrm2, 8));
            if (fr == 0 && fq == 0) (void)__hip_atomic_fetch_max(nmax + (isk ? 64 : 0), __float_as_uint(nrm2), __ATOMIC_RELAXED, __HIP_MEMORY_SCOPE_AGENT);
        } else {
            const int kind = pn < 6 ? 0 : (pn < 12 ? 1 : 2);
            const int lc0 = 32 * wc + 8 * fq;
            f32x4 bv[2][2];
#pragma unroll
            for (int bj = 0; bj < 2; ++bj)
#pragma unroll
                for (int n = 0; n < 2; ++n) bv[bj][n] = *(const PG8_LAS f32x4*)((const PG8_LAS float*)(el + EPI_OFF + u.es * 2048) + 128 * bj + lc0 + 4 * n);
#pragma unroll
            for (int ai = 0; ai < 2; ++ai)
#pragma unroll
                for (int m = 0; m < 4; ++m) { const int r = u.pm * BM + ai * HALF + wr * 64 + m * 16 + fr;
                    bf16_t* rowp;
                    if (kind == 0) { const size_t vrow = r < T_ ? (size_t)(r >> 12) * SKV_ + CTX_ + (r & 4095) : (size_t)((r - T_) >> 8) * SKV_ + ((r - T_) & 255); rowp = VA + vrow * 512 + 256 * (pn - 4) + lc0; }
                    else if (kind == 1) rowp = HY + (size_t)r * 1536 + 256 * (pn - 6) + lc0;
                    else rowp = GT + (size_t)r * 2048 + 256 * (pn - 12) + lc0;
                    if constexpr (F8_) { if (kind == 0) {
                        const int kidx = CTX_ + (r & 4095), tk = kidx >> 6, k32 = kidx & 31, half = (kidx >> 5) & 1, kg = (k32 >> 2) & 1, e_ = (k32 & 3) + 4 * (k32 >> 3);
                        unsigned char* img = (unsigned char*)VA + ((size_t)((r >> 12) * 4 + 2 * (pn - 4)) * (SKV_ / 64) + tk) * 8192 + ((wc * 2 + half) * 64 + 8 * fq + 32 * kg) * 16 + e_;
#pragma unroll
                        for (int bj = 0; bj < 2; ++bj) { const f32x4 v0 = acc[ai][bj][m][0] + bv[bj][0], v1 = acc[ai][bj][m][1] + bv[bj][1]; unsigned char* ib = img + (size_t)bj * (SKV_ / 64) * 8192;
#pragma unroll
                            for (int j = 0; j < 4; ++j) { ib[16 * j] = (unsigned char)(pk4_fp8(v0[j], 0.f, 0.f, 0.f) & 0xffu); ib[16 * (4 + j)] = (unsigned char)(pk4_fp8(v1[j], 0.f, 0.f, 0.f) & 0xffu); } }
                        continue; } }
#pragma unroll
                    for (int bj = 0; bj < 2; ++bj) { f32x4 v0 = acc[ai][bj][m][0] + bv[bj][0], v1 = acc[ai][bj][m][1] + bv[bj][1];
                        if (kind == 2) {
#pragma unroll
                            for (int e = 0; e < 4; ++e) { v0[e] = __builtin_amdgcn_rcpf(1.0f + __builtin_amdgcn_exp2f(-1.4426950408889634f * v0[e])); v1[e] = __builtin_amdgcn_rcpf(1.0f + __builtin_amdgcn_exp2f(-1.4426950408889634f * v1[e])); } }
                        u32x4 w; w.x = cvt_pk_bf16(v0[0], v0[1]); w.y = cvt_pk_bf16(v0[2], v0[3]); w.z = cvt_pk_bf16(v1[0], v1[1]); w.w = cvt_pk_bf16(v1[2], v1[3]);
                        __builtin_nontemporal_store(w, (u32x4*)(rowp + bj * HALF)); } }
        }
    }
};
typedef EpiInProjT<false> EpiInProj;
struct WinOrder {
    static constexpr bool GATHER = false;
    StaticOrder so; int split, add0, add1;
    __device__ __forceinline__ bool next(int i, Unit& u) const { if (!so.next(i, u)) return false; u.pn += u.pn < split ? add0 : add1; return true; }
    __device__ __forceinline__ void a_ready(const Unit&) const {}
    __device__ __forceinline__ void done(const Unit&) const {}
};
struct CtxOrder {
    static constexpr bool GATHER = false;
    int G, c;
    __device__ __forceinline__ bool next(int i, Unit& u) const { const int L = i * G + c; if (L >= 32) return false; u.pm = 128 + (L & 7); u.pn = 2 + (L >> 3); u.be = 0; u.es = 0; return true; }
    __device__ __forceinline__ void a_ready(const Unit&) const {}
    __device__ __forceinline__ void done(const Unit&) const {}
};

__device__ __forceinline__ float bf_lo(unsigned d) { return __builtin_bit_cast(float, d << 16); }
__device__ __forceinline__ float bf_hi(unsigned d) { return __builtin_bit_cast(float, d & 0xffff0000u); }
struct EpiMerge {
    static constexpr bool PERM = true, AFTER_DRAIN = false, HAS_MID = true, F8 = false, PREFETCH = false; static constexpr int WSCALE = 0x7F7F7F7F;
    bf16_t* O; const bf16_t* GT;
    __device__ __forceinline__ void mid(f32x4 (&acc)[2][2][4][2], const Unit& u, int wr, int wc, int fr_, int fq_) const {
        int fr = fr_, fq = fq_; asm volatile("" : "+v"(fr), "+v"(fq));
        const bf16_t* __restrict__ G = GT;
        const int row0 = u.pm * BM + wr * 64 + fr, col0 = u.pn * BM + wc * 32 + 8 * fq;
#pragma unroll
        for (int ai = 0; ai < 2; ++ai)
#pragma unroll
            for (int mp = 0; mp < 2; ++mp) { u32x4 ga[2][2], gb[2][2];
#pragma unroll
                for (int q = 0; q < 2; ++q) { const bf16_t* gp = G + (size_t)(row0 + ai * HALF + (2 * mp + q) * 16) * 2048 + col0;
#pragma unroll
                    for (int bj = 0; bj < 2; ++bj) { ga[q][bj] = __builtin_nontemporal_load((const u32x4*)(gp + bj * HALF)); gb[q][bj] = *(const u32x4*)(gp + 1024 + bj * HALF); } }
#pragma unroll
                for (int q = 0; q < 2; ++q) { const int m = 2 * mp + q;
#pragma unroll
                    for (int bj = 0; bj < 2; ++bj) { const u32x4 a = ga[q][bj], b = gb[q][bj]; f32x4 r0, r1;
                        r0[0] = bf_lo(a.x) * __builtin_amdgcn_rcpf(bf_lo(b.x)); r0[1] = bf_hi(a.x) * __builtin_amdgcn_rcpf(bf_hi(b.x)); r0[2] = bf_lo(a.y) * __builtin_amdgcn_rcpf(bf_lo(b.y)); r0[3] = bf_hi(a.y) * __builtin_amdgcn_rcpf(bf_hi(b.y));
                        r1[0] = bf_lo(a.z) * __builtin_amdgcn_rcpf(bf_lo(b.z)); r1[1] = bf_hi(a.z) * __builtin_amdgcn_rcpf(bf_hi(b.z)); r1[2] = bf_lo(a.w) * __builtin_amdgcn_rcpf(bf_lo(b.w)); r1[3] = bf_hi(a.w) * __builtin_amdgcn_rcpf(bf_hi(b.w));
                        acc[ai][bj][m][0] = acc[ai][bj][m][0] * r0; acc[ai][bj][m][1] = acc[ai][bj][m][1] * r1; } }
                asm volatile("" ::: "memory"); }
    }
    __device__ __forceinline__ void operator()(const f32x4 (&acc)[2][2][4][2], const Unit& u, int wr, int wc, int fr, int fq) const {
        const bf16_t* __restrict__ G = GT; bf16_t* __restrict__ Or = O;
        const int row0 = u.pm * BM + wr * 64 + fr, col0 = u.pn * BM + wc * 32 + 8 * fq;
#pragma unroll
        for (int ai = 0; ai < 2; ++ai) { u32x4 gb[4][2];
#pragma unroll
            for (int m = 0; m < 4; ++m)
#pragma unroll
                for (int bj = 0; bj < 2; ++bj) gb[m][bj] = *(const u32x4*)(G + (size_t)(row0 + ai * HALF + m * 16) * 2048 + 1024 + col0 + bj * HALF);
#pragma unroll
            for (int m = 0; m < 4; ++m) { bf16_t* rowp = Or + (size_t)(row0 + ai * HALF + m * 16) * 1024 + col0;
#pragma unroll
                for (int bj = 0; bj < 2; ++bj) { const u32x4 b = gb[m][bj]; const f32x4 v0 = acc[ai][bj][m][0], v1 = acc[ai][bj][m][1];
                    u32x4 w; w.x = cvt_pk_bf16(v0[0] * bf_lo(b.x), v0[1] * bf_hi(b.x)); w.y = cvt_pk_bf16(v0[2] * bf_lo(b.y), v0[3] * bf_hi(b.y));
                    w.z = cvt_pk_bf16(v1[0] * bf_lo(b.z), v1[1] * bf_hi(b.z)); w.w = cvt_pk_bf16(v1[2] * bf_lo(b.w), v1[3] * bf_hi(b.w));
                    *(u32x4*)(rowp + bj * HALF) = w; } } }
    }
};
struct EpiWout {
    static constexpr bool PERM = false, AFTER_DRAIN = false, HAS_MID = false, F8 = false, PREFETCH = false; static constexpr int WSCALE = 0x7F7F7F7F;
    const float* X; float* O; const float* MOD; float* SSQ;
    __device__ __forceinline__ void operator()(const f32x4 (&acc)[2][2][4][2], const Unit& u, int wr, int wc, int fr, int fq) const {
        const float* __restrict__ Xr = X; float* __restrict__ Or = O; float* __restrict__ Sr = SSQ;
        const int row0 = u.pm * BM + wr * 64 + fr, col0 = u.pn * BM + wc * 32 + 4 * fq;
        const float* g1p = MOD + (row0 >> 12) * 6144 + 2048 + col0;
        f32x4 g1[2][2];
#pragma unroll
        for (int bj = 0; bj < 2; ++bj)
#pragma unroll
            for (int n = 0; n < 2; ++n) g1[bj][n] = *(const f32x4*)(g1p + bj * HALF + n * 16);
#pragma unroll
        for (int ai = 0; ai < 2; ++ai)
#pragma unroll
            for (int mp = 0; mp < 2; ++mp) { f32x4 xv[2][2][2];
#pragma unroll
                for (int q = 0; q < 2; ++q) { const size_t off = (size_t)(row0 + ai * HALF + (2 * mp + q) * 16) * 1024 + col0;
#pragma unroll
                    for (int bj = 0; bj < 2; ++bj)
#pragma unroll
                        for (int n = 0; n < 2; ++n) xv[q][bj][n] = __builtin_nontemporal_load((const f32x4*)(Xr + off + bj * HALF + n * 16)); }
#pragma unroll
                for (int q = 0; q < 2; ++q) { const int m = 2 * mp + q; const int row = row0 + ai * HALF + m * 16; const size_t off = (size_t)row * 1024 + col0; float ss = 0.f;
#pragma unroll
                    for (int bj = 0; bj < 2; ++bj)
#pragma unroll
                        for (int n = 0; n < 2; ++n) { const f32x4 v = xv[q][bj][n] + g1[bj][n] * acc[ai][bj][m][n];
                            *(f32x4*)(Or + off + bj * HALF + n * 16) = v; ss += (v[0] * v[0] + v[1] * v[1]) + (v[2] * v[2] + v[3] * v[3]); }
                    ss += __shfl_xor(ss, 16); ss += __shfl_xor(ss, 32);
                    if (fq == 0) Sr[(size_t)row * 16 + u.pn * 4 + wc] = ss; } }
    }
};

struct MoeGatherOrder {
    static constexpr bool GATHER = true;
    StaticOrder so; const int* blke; const PG8_LAS unsigned short* tokl;
    __device__ __forceinline__ bool next(int i, Unit& u) const { if (!so.next(i, u)) return false; u.be = blke[u.pm]; return true; }
    __device__ __forceinline__ int gather_tok(int ui, int row) const { return (int)tokl[ui * 256 + row]; }
    __device__ __forceinline__ void a_ready(const Unit&) const {}
    __device__ __forceinline__ void done(const Unit&) const {}
};
template <bool F8> struct FragT { typedef bf16x8 A[4][2]; typedef bf16x8 B[2][2]; };
template <> struct FragT<true> { typedef v8i_t A[4]; typedef v8i_t B[2]; };
template <class Epi, class Sched, bool ALIGN_EPI = false, bool SP2 = false>
__device__ __forceinline__ void gemm_phase(PG8_LAS unsigned char* lds, const Gemm g, const Sched& S, const Epi& E) {
    const int tid = threadIdx.x, wid = __builtin_amdgcn_readfirstlane(tid >> 6), lane = tid & 63, wr = wid >> 2, wc = wid & 3, fr = lane & 15, fq = lane >> 4;
    const int K = g.K, nt = K / BK;
    unsigned voffA[2], voffB[2];
#pragma unroll
    for (int i = 0; i < 2; ++i) { int R, C; stage_rc(tid * 16 + i * 8192, R, C); const int Rb = Epi::PERM ? ((R & ~31) + perm32(R & 31)) : R;
        voffA[i] = (unsigned)(R * K + C) * 2u; voffB[i] = (unsigned)(Rb * K + C) * 2u; }
    const size_t kstep = (size_t)(BK * 2);
    const size_t hstep = (size_t)HALF * K * 2;
    const size_t tstep = 2 * hstep;
    const unsigned ldsw = (unsigned)wid * 1024u;
    const int aoff = lds_byte(wr * 64 + fr, fq * 8), boff = lds_byte(wc * 32 + fr, fq * 8);
    const int aoff8 = aoff, boff8 = boff;
#define PG8_SA(b, h) (((b) * 2 + (h)) * HTB)
#define PG8_SB(b, h) ((4 + (b) * 2 + (h)) * HTB)
#define PG8_STAGE(bufoff, gbase, voff) do { _Pragma("unroll") for (int _i = 0; _i < 2; ++_i) \
        __builtin_amdgcn_global_load_lds((const unsigned*)((const char*)(gbase) + (voff)[_i]), (PG8_LAS unsigned*)(lds + (bufoff) + ldsw + _i * 8192), 16, 0, 0); } while (0)
#define PG8_STAGE_A(bufoff, gbase, h, nx) do { if constexpr (Sched::GATHER) { unsigned gv_[2]; \
        if (nx) { _Pragma("unroll") for (int i_ = 0; i_ < 2; ++i_) { int R_, C_; stage_rc(tid * 16 + i_ * 8192, R_, C_); gv_[i_] = (unsigned)(S.gather_tok(ui + 1, 128 * (h) + R_) * K + C_) * 2u; } } \
        else { gv_[0] = cvA[h][0]; gv_[1] = cvA[h][1]; } \
        PG8_STAGE(bufoff, gbase, gv_); } \
        else { PG8_STAGE(bufoff, (gbase) + (h) * hstep, voffA); } } while (0)
#define PG8_LD32(off_) __builtin_shufflevector(__builtin_bit_cast(v4i_t, *(const PG8_LAS bf16x8*)(lds + (off_))), __builtin_bit_cast(v4i_t, *(const PG8_LAS bf16x8*)(lds + (off_) + 1024)), 0, 1, 2, 3, 4, 5, 6, 7)
#define PG8_LDA(dst, b, h) do { if constexpr (Epi::F8) { _Pragma("unroll") for (int m = 0; m < 4; ++m) dst[m] = PG8_LD32(PG8_SA(b, h) + aoff8 + m * 2048); } else { \
        _Pragma("unroll") for (int m = 0; m < 4; ++m) _Pragma("unroll") for (int k = 0; k < 2; ++k) dst[m][k] = *(const PG8_LAS bf16x8*)(lds + PG8_SA(b, h) + aoff + m * 2048 + k * 1024); } } while (0)
#define PG8_LDB(dst, b, h) do { if constexpr (Epi::F8) { _Pragma("unroll") for (int n = 0; n < 2; ++n) dst[n] = PG8_LD32(PG8_SB(b, h) + boff8 + n * 2048); } else { \
        _Pragma("unroll") for (int n = 0; n < 2; ++n) _Pragma("unroll") for (int k = 0; k < 2; ++k) dst[n][k] = *(const PG8_LAS bf16x8*)(lds + PG8_SB(b, h) + boff + n * 2048 + k * 1024); } } while (0)
#define PG8_MMA(ai, bj, At, Bt) do { __builtin_amdgcn_s_setprio(1); if constexpr (Epi::F8) { \
        _Pragma("unroll") for (int m = 0; m < 4; ++m) _Pragma("unroll") for (int n = 0; n < 2; ++n) \
            acc[ai][bj][m][n] = __builtin_amdgcn_mfma_scale_f32_16x16x128_f8f6f4(Bt[n], At[m], acc[ai][bj][m][n], 0, 0, 0, Epi::WSCALE, 0, 0x7F7F7F7F); \
        _Pragma("unroll") for (int m = 0; m < 4; ++m) _Pragma("unroll") for (int n = 0; n < 2; ++n) asm volatile("" : "+v"(acc[ai][bj][m][n])); } else { \
        _Pragma("unroll") for (int m = 0; m < 4; ++m) _Pragma("unroll") for (int n = 0; n < 2; ++n) _Pragma("unroll") for (int k = 0; k < 2; ++k) \
        acc[ai][bj][m][n] = __builtin_amdgcn_mfma_f32_16x16x32_bf16(Bt[n][k], At[m][k], acc[ai][bj][m][n], 0, 0, 0); } __builtin_amdgcn_s_setprio(0); } while (0)
#define PG8_WAIT_V(n) asm volatile("s_waitcnt vmcnt(" #n ")" ::: "memory")
#define PG8_WAIT_L(n) asm volatile("s_waitcnt lgkmcnt(" #n ")" ::: "memory")
#define PG8_BAR __builtin_amdgcn_s_barrier()
#define PG8_SCHED __builtin_amdgcn_sched_barrier(0)
    Unit cur, nxt; int ui = 0;
    if (!S.next(0, cur)) return;
    f32x4 acc[2][2][4][2];
#pragma unroll
    for (int a = 0; a < 2; ++a)
#pragma unroll
        for (int b = 0; b < 2; ++b)
#pragma unroll
            for (int m = 0; m < 4; ++m)
#pragma unroll
                for (int n = 0; n < 2; ++n) acc[a][b][m][n] = (f32x4){0.f, 0.f, 0.f, 0.f};
    typename FragT<Epi::F8>::A At; typename FragT<Epi::F8>::B B0, B1;
    const char* cA = (const char*)g.A + (Sched::GATHER ? (size_t)0 : (size_t)cur.pm * tstep);
    unsigned cvA[2][2];
    if constexpr (Sched::GATHER) {
#pragma unroll
        for (int h = 0; h < 2; ++h)
#pragma unroll
            for (int i = 0; i < 2; ++i) { int R, Cc; stage_rc(tid * 16 + i * 8192, R, Cc); cvA[h][i] = (unsigned)(S.gather_tok(0, 128 * h + R) * K + Cc) * 2u; } } const char* cB = (const char*)g.Bt + (size_t)cur.be * g.bstride + (size_t)cur.pn * tstep;
    S.a_ready(cur);
    if constexpr (Epi::PREFETCH) E.prefetch(cur, 0, wid, lane);
    if constexpr (SP2) {
        PG8_STAGE(PG8_SB(0, 0), cB, voffB); PG8_STAGE(PG8_SB(0, 1), cB + hstep, voffB); PG8_STAGE_A(PG8_SA(0, 0), cA, 0, false); PG8_STAGE_A(PG8_SA(0, 1), cA, 1, false);
        if (wr == 1) PG8_BAR;
        PG8_WAIT_V(2); PG8_BAR;
        PG8_STAGE(PG8_SB(1, 0), cB + kstep, voffB); PG8_STAGE_A(PG8_SA(1, 0), cA + kstep, 0, false); PG8_STAGE(PG8_SB(1, 1), cB + hstep + kstep, voffB);
        PG8_WAIT_V(6); PG8_BAR;
    } else {
        PG8_STAGE(PG8_SB(0, 0), cB, voffB); PG8_STAGE_A(PG8_SA(0, 0), cA, 0, false); PG8_STAGE(PG8_SB(0, 1), cB + hstep, voffB); PG8_STAGE_A(PG8_SA(0, 1), cA, 1, false);
        if (wr == 1) PG8_BAR;
        PG8_WAIT_V(4); PG8_BAR;
        PG8_STAGE(PG8_SB(1, 0), cB + kstep, voffB); PG8_STAGE_A(PG8_SA(1, 0), cA + kstep, 0, false); PG8_STAGE(PG8_SB(1, 1), cB + hstep + kstep, voffB);
        PG8_WAIT_V(6); PG8_BAR;
    }
    for (;;) {
        const bool has_next = S.next(ui + 1, nxt);
        const char* nA = (has_next && !Sched::GATHER) ? (const char*)g.A + (size_t)nxt.pm * tstep : cA;
 const char* nB = has_next ? (const char*)g.Bt + (size_t)nxt.be * g.bstride + (size_t)nxt.pn * tstep : cB;
        for (int t = 0; t < nt; t += 2) {
            const bool last = (t == nt - 2);
            const char* a1 = cA + (size_t)(t + 1) * kstep;
            const char* a2 = last ? nA : cA + (size_t)(t + 2) * kstep; const char* b2 = last ? nB : cB + (size_t)(t + 2) * kstep;
            const char* a3 = a2 + kstep; const char* b3 = b2 + kstep;
            if (last && has_next) S.a_ready(nxt);
            if constexpr (Epi::HAS_MID) { if (t == nt / 2) E.mid(acc, cur, wr, wc, fr, fq); }
            if constexpr (SP2) {
            PG8_LDB(B0, 0, 0); PG8_LDB(B1, 0, 1); PG8_SCHED; PG8_LDA(At, 0, 0); PG8_STAGE_A(PG8_SA(1, 1), a1, 1, false);
            PG8_WAIT_V(8); PG8_WAIT_L(0); PG8_BAR; PG8_MMA(0, 0, At, B0); PG8_MMA(0, 1, At, B1); PG8_BAR; PG8_SCHED;
            PG8_LDA(At, 0, 1); PG8_STAGE(PG8_SB(0, 0), b2, voffB); PG8_STAGE(PG8_SB(0, 1), b2 + hstep, voffB); PG8_STAGE_A(PG8_SA(0, 0), a2, 0, last && has_next);
            PG8_WAIT_V(8); PG8_WAIT_L(0); PG8_BAR; PG8_MMA(1, 0, At, B0); PG8_MMA(1, 1, At, B1); PG8_BAR; PG8_SCHED;
            PG8_LDB(B0, 1, 0); PG8_LDB(B1, 1, 1); PG8_SCHED; PG8_LDA(At, 1, 0); PG8_STAGE_A(PG8_SA(0, 1), a2, 1, last && has_next);
            PG8_WAIT_V(8); PG8_WAIT_L(0); PG8_BAR; PG8_MMA(0, 0, At, B0); PG8_MMA(0, 1, At, B1); PG8_BAR; PG8_SCHED;
            PG8_LDA(At, 1, 1); PG8_STAGE(PG8_SB(1, 0), b3, voffB); PG8_STAGE(PG8_SB(1, 1), b3 + hstep, voffB); PG8_STAGE_A(PG8_SA(1, 0), a3, 0, last && has_next);
            PG8_WAIT_V(8); PG8_WAIT_L(0); PG8_BAR; PG8_MMA(1, 0, At, B0); PG8_MMA(1, 1, At, B1); PG8_BAR; PG8_SCHED;
            } else {
            PG8_LDB(B0, 0, 0); PG8_SCHED; PG8_LDA(At, 0, 0); PG8_STAGE_A(PG8_SA(1, 1), a1, 1, false);
            PG8_WAIT_L(8); PG8_BAR; PG8_WAIT_L(0); PG8_MMA(0, 0, At, B0); PG8_BAR; PG8_SCHED;
            PG8_LDB(B1, 0, 1); PG8_STAGE(PG8_SB(0, 0), b2, voffB);
            PG8_BAR; PG8_WAIT_L(0); PG8_MMA(0, 1, At, B1); PG8_BAR;
            PG8_LDA(At, 0, 1); PG8_STAGE_A(PG8_SA(0, 0), a2, 0, last && has_next);
            PG8_BAR; PG8_WAIT_L(0); PG8_MMA(1, 0, At, B0); PG8_BAR; PG8_SCHED;
            PG8_STAGE(PG8_SB(0, 1), b2 + hstep, voffB);
            PG8_WAIT_V(6); PG8_BAR; PG8_MMA(1, 1, At, B1); PG8_BAR;
            PG8_LDB(B0, 1, 0); PG8_SCHED; PG8_LDA(At, 1, 0); PG8_STAGE_A(PG8_SA(0, 1), a2, 1, last && has_next);
            PG8_WAIT_L(8); PG8_BAR; PG8_WAIT_L(0); PG8_MMA(0, 0, At, B0); PG8_BAR; PG8_SCHED;
            PG8_LDB(B1, 1, 1); PG8_STAGE(PG8_SB(1, 0), b3, voffB);
            PG8_BAR; PG8_WAIT_L(0); PG8_MMA(0, 1, At, B1); PG8_BAR;
            PG8_LDA(At, 1, 1); PG8_STAGE_A(PG8_SA(1, 0), a3, 0, last && has_next);
            PG8_BAR; PG8_WAIT_L(0); PG8_MMA(1, 0, At, B0); PG8_BAR; PG8_SCHED;
            PG8_STAGE(PG8_SB(1, 1), b3 + hstep, voffB);
            PG8_WAIT_V(6); PG8_BAR; PG8_MMA(1, 1, At, B1); PG8_BAR;
            }
        }
        if constexpr (ALIGN_EPI) { if (wr == 0) PG8_BAR; }
        if constexpr (!Epi::AFTER_DRAIN) { cur.es = ui & 1; E(acc, cur, wr, wc, fr, fq); S.done(cur); }
        if (!has_next) break;
        if constexpr (Epi::PREFETCH) E.prefetch(nxt, (ui + 1) & 1, wid, lane);
#pragma unroll
        for (int a = 0; a < 2; ++a)
#pragma unroll
            for (int b = 0; b < 2; ++b)
#pragma unroll
                for (int m = 0; m < 4; ++m)
#pragma unroll
                    for (int n = 0; n < 2; ++n) acc[a][b][m][n] = (f32x4){0.f, 0.f, 0.f, 0.f};
        cur = nxt; cA = nA; cB = nB; ++ui;
        if constexpr (Sched::GATHER) {
#pragma unroll
            for (int h = 0; h < 2; ++h)
#pragma unroll
                for (int i = 0; i < 2; ++i) { int R, Cc; stage_rc(tid * 16 + i * 8192, R, Cc); cvA[h][i] = (unsigned)(S.gather_tok(ui, 128 * h + R) * K + Cc) * 2u; } }
        if constexpr (ALIGN_EPI) { if (wr == 1) PG8_BAR; }
    }
    PG8_WAIT_V(0);
    if constexpr (!ALIGN_EPI) { if (wr == 0) PG8_BAR; }
    PG8_BAR;
    if constexpr (Epi::AFTER_DRAIN) { E.fused(acc, cur, wr, wc, fr, fq, lds, wid, lane); S.done(cur); }
#undef PG8_SA
#undef PG8_SB
#undef PG8_STAGE
#undef PG8_STAGE_A
#undef PG8_LD32
#undef PG8_LDA
#undef PG8_LDB
#undef PG8_MMA
#undef PG8_WAIT_V
#undef PG8_WAIT_L
#undef PG8_BAR
#undef PG8_SCHED
}
}
namespace att {
using bf16 = __hip_bfloat16;
constexpr int   D = 128, NW = 8, QBLK = 32, KVBLK = 64;
constexpr float SCALE = 0.125f;
constexpr float THR = 8.f;
constexpr int SDEPTH = 2;
constexpr int LDQ = 8 * D, LDK = 4 * D, LDO = LDQ;
constexpr size_t SHM_V = KVBLK * D * 2, SHM_K = KVBLK * D * 2, SHM_ATTN = 2 * SHM_V + 2 * SHM_K + NW * 64 * 4;
using bf16x8 = __attribute__((ext_vector_type(8))) short;
using s16x4  = __attribute__((ext_vector_type(4))) short;
using f32x16 = __attribute__((ext_vector_type(16))) float;
using f32x8  = __attribute__((ext_vector_type(8))) float;
using u32x4  = __attribute__((ext_vector_type(4))) unsigned;
#define KSWZ(row, colB) ((row) * 256 + ((colB) ^ (((row) & 7) << 4)))
#define SBAR() __builtin_amdgcn_sched_barrier(0)
__device__ __forceinline__ int crow(int r, int hi) { return (r & 3) + 8 * (r >> 2) + 4 * hi; }
__device__ __forceinline__ unsigned cvtpk(float lo, float hi) {
  unsigned r; asm volatile("v_cvt_pk_bf16_f32 %0, %1, %2" : "=v"(r) : "v"(lo), "v"(hi)); return r;
}
template <typename TIn> struct Stage;
template <> struct Stage<bf16>  { using T = bf16x8;
  __device__ static __forceinline__ T ld8(const bf16* p) { return *reinterpret_cast<const bf16x8*>(p); }
  __device__ static __forceinline__ bf16x8 tobf(T x) { return x; } };
template <> struct Stage<float> { using T = f32x8;
  __device__ static __forceinline__ T ld8(const float* p) { return *reinterpret_cast<const f32x8*>(p); }
  __device__ static __forceinline__ bf16x8 tobf(T x) {
    u32x4 w = {cvtpk(x[0], x[1]), cvtpk(x[2], x[3]), cvtpk(x[4], x[5]), cvtpk(x[6], x[7])}; return *reinterpret_cast<bf16x8*>(&w); } };

__device__ __forceinline__ void partialSM(f32x16& p0, f32x16& p1, float& m_reg, float& mn, float& alpha) {
  constexpr float C = SCALE * 1.4426950408889634f;
  float pmax = p0[0]; for (int r = 1; r < 16; ++r) pmax = fmaxf(pmax, p0[r]); for (int r = 0; r < 16; ++r) pmax = fmaxf(pmax, p1[r]);
  { auto rr = __builtin_amdgcn_permlane32_swap(__float_as_uint(pmax), __float_as_uint(pmax), false, false);
    pmax = fmaxf(__uint_as_float(rr[0]), __uint_as_float(rr[1])); }
  if (__builtin_expect(__all(pmax - m_reg <= THR / SCALE), 1)) { mn = m_reg; alpha = 1.f; }
  else { mn = fmaxf(m_reg, pmax); alpha = __builtin_amdgcn_exp2f((m_reg - mn) * C); m_reg = mn; }
  float mnC = -mn * C;
  for (int r = 0; r < 16; ++r) p0[r] = fmaf(p0[r], C, mnC); for (int r = 0; r < 16; ++r) p1[r] = fmaf(p1[r], C, mnC);
  for (int r = 0; r < 16; ++r) p0[r] = __builtin_amdgcn_exp2f(p0[r]);
}
__device__ __forceinline__ void finishSM(f32x16& p0, f32x16& p1, float alpha, float& l_reg, bf16x8& pa0, bf16x8& pa1, bf16x8& pa2, bf16x8& pa3) {
  for (int r = 0; r < 16; ++r) p1[r] = __builtin_amdgcn_exp2f(p1[r]);
  float ps = 0; for (int r = 0; r < 16; ++r) ps += p0[r]; for (int r = 0; r < 16; ++r) ps += p1[r];
  { auto rr = __builtin_amdgcn_permlane32_swap(__float_as_uint(ps), __float_as_uint(ps), false, false);
    ps = __uint_as_float(rr[0]) + __uint_as_float(rr[1]); }
  l_reg = l_reg * alpha + ps;
#define PK4(P, BASE, OUT) do { unsigned a0 = cvtpk(P[BASE + 0], P[BASE + 1]), a1 = cvtpk(P[BASE + 2], P[BASE + 3]);   \
    unsigned b0 = cvtpk(P[BASE + 4], P[BASE + 5]), b1 = cvtpk(P[BASE + 6], P[BASE + 7]);                              \
    auto r0 = __builtin_amdgcn_permlane32_swap(a0, b0, false, false); auto r1 = __builtin_amdgcn_permlane32_swap(a1, b1, false, false); \
    u32x4 w = {r0[0], r1[0], r0[1], r1[1]}; OUT = *reinterpret_cast<bf16x8*>(&w); } while (0)
  PK4(p0, 0, pa0); PK4(p0, 8, pa1); PK4(p1, 0, pa2); PK4(p1, 8, pa3);
#undef PK4
}
__device__ __forceinline__ void qkt(f32x16& p0, f32x16& p1, const bf16* Ks, const bf16x8* qr, int r32, int hi) {
  p0 = f32x16{}; p1 = f32x16{};
  for (int d0 = 0; d0 < 8; ++d0) { int cb = (d0 * 16 + hi * 8) * 2;
    bf16x8 b0 = *reinterpret_cast<const bf16x8*>((const char*)Ks + KSWZ(r32, cb));
    bf16x8 b1 = *reinterpret_cast<const bf16x8*>((const char*)Ks + KSWZ(32 + r32, cb));
    p0 = __builtin_amdgcn_mfma_f32_32x32x16_bf16(b0, qr[d0], p0, 0, 0, 0);
    p1 = __builtin_amdgcn_mfma_f32_32x32x16_bf16(b1, qr[d0], p1, 0, 0, 0); }
}
__device__ __forceinline__ int v_st(int k, int c) { const int kk = (k & ~0xC) | ((k & 4) << 1) | ((k & 8) >> 1); return ((kk >> 3) * 4 + (c >> 5)) * 512 + ((kk & 7) * 32 + (c & 31)) * 2; }
__device__ __forceinline__ int v_rd_base(int lane) { return ((lane & 3) << 3) | (((lane >> 2) & 3) << 6) | (((lane >> 4) & 1) << 5) | (((lane >> 5) & 1) << 8); }
constexpr int v_rd_off(int d0, int ks, int half) { return d0 * 512 + ks * 4096 + half * 2048; }
template <int OFF> __device__ __forceinline__ s16x4 tr_read(int vb) {
  s16x4 r; asm volatile("ds_read_b64_tr_b16 %0, %1 offset:%2" : "=&v"(r) : "v"(vb), "i"(OFF) : "memory"); return r;
}
template <int D0> __device__ __forceinline__ void pv_one(f32x16& od, int vb, bf16x8 pa0, bf16x8 pa1, bf16x8 pa2, bf16x8 pa3) {
  const s16x4 l0 = tr_read<v_rd_off(D0, 0, 0)>(vb), h0 = tr_read<v_rd_off(D0, 0, 1)>(vb), l1 = tr_read<v_rd_off(D0, 1, 0)>(vb), h1 = tr_read<v_rd_off(D0, 1, 1)>(vb);
  const s16x4 l2 = tr_read<v_rd_off(D0, 2, 0)>(vb), h2 = tr_read<v_rd_off(D0, 2, 1)>(vb), l3 = tr_read<v_rd_off(D0, 3, 0)>(vb), h3 = tr_read<v_rd_off(D0, 3, 1)>(vb);
  asm volatile("s_waitcnt lgkmcnt(0)" ::: "memory"); SBAR();
#define PK(L, H) (bf16x8){L[0], L[1], L[2], L[3], H[0], H[1], H[2], H[3]}
  od = __builtin_amdgcn_mfma_f32_32x32x16_bf16(pa0, PK(l0, h0), od, 0, 0, 0);
  od = __builtin_amdgcn_mfma_f32_32x32x16_bf16(pa1, PK(l1, h1), od, 0, 0, 0);
  od = __builtin_amdgcn_mfma_f32_32x32x16_bf16(pa2, PK(l2, h2), od, 0, 0, 0);
  od = __builtin_amdgcn_mfma_f32_32x32x16_bf16(pa3, PK(l3, h3), od, 0, 0, 0);
#undef PK
}
__device__ __forceinline__ void pv_d0(f32x16* o, int vb, bf16x8 pa0, bf16x8 pa1, bf16x8 pa2, bf16x8 pa3) {
  pv_one<0>(o[0], vb, pa0, pa1, pa2, pa3); pv_one<1>(o[1], vb, pa0, pa1, pa2, pa3); pv_one<2>(o[2], vb, pa0, pa1, pa2, pa3); pv_one<3>(o[3], vb, pa0, pa1, pa2, pa3);
}

template <typename TQ>
__device__ __forceinline__ void attn_dense_body(const TQ* __restrict__ Qb, const bf16* __restrict__ Kh, const bf16* __restrict__ Vh,
                                                float* __restrict__ Ob, int seq, char* lds) {
  using St = Stage<bf16>; using SQ = Stage<TQ>;
  const int tid = threadIdx.x, wid = tid >> 6, lane = tid & 63, r32 = lane & 31, hi = lane >> 5;
  bf16* V_lds = (bf16*)lds; bf16* K_lds = (bf16*)(lds + 2 * SHM_V);
  float* ws = (float*)(lds + 2 * SHM_V + 2 * SHM_K) + wid * 64; float* li_l = ws; float* al_l = ws + 32;
  float m_reg = -1e30f, l_reg = 0; f32x16 o[4] = {}; bf16x8 qr[8];
  const TQ* Qw = Qb + (long)(wid * QBLK + r32) * LDQ + hi * 8;
#pragma unroll
  for (int d0 = 0; d0 < 8; ++d0) qr[d0] = SQ::tobf(SQ::ld8(Qw + d0 * 16));
  const int sr = tid >> 4, sc = (tid & 15) * 8, vst0 = v_st(sr, sc), vst1 = v_st(32 + sr, sc);
  const int vb0 = (int)(uintptr_t)V_lds + v_rd_base(lane);
  struct { typename St::T vs0, vs1, ks0, ks1; } sr_[SDEPTH];
#define SLOAD(i, k0) do { sr_[i].vs0 = St::ld8(&Vh[(long)((k0) + sr) * LDK + sc]); sr_[i].vs1 = St::ld8(&Vh[(long)((k0) + 32 + sr) * LDK + sc]); \
    sr_[i].ks0 = St::ld8(&Kh[(long)((k0) + sr) * LDK + sc]); sr_[i].ks1 = St::ld8(&Kh[(long)((k0) + 32 + sr) * LDK + sc]); } while (0)
#define SWRITE(b, i) do { *(bf16x8*)((char*)V_lds + (b) * SHM_V + vst0) = St::tobf(sr_[i].vs0);          \
    *(bf16x8*)((char*)V_lds + (b) * SHM_V + vst1) = St::tobf(sr_[i].vs1); int kc = sc * 2;               \
    *(bf16x8*)((char*)K_lds + (b) * SHM_K + KSWZ(sr, kc)) = St::tobf(sr_[i].ks0);                       \
    *(bf16x8*)((char*)K_lds + (b) * SHM_K + KSWZ(32 + sr, kc)) = St::tobf(sr_[i].ks1); } while (0)
#define SWAIT() do { if constexpr (SDEPTH == 2) asm volatile("s_waitcnt vmcnt(4)" ::: "memory"); else asm volatile("s_waitcnt vmcnt(0)" ::: "memory"); } while (0)
#define RESC(a) do { if (__any((a) < 1.f)) { if (hi == 0) al_l[r32] = (a); asm volatile("s_waitcnt lgkmcnt(0)" ::: "memory"); \
    for (int d = 0; d < 4; ++d) for (int r = 0; r < 16; ++r) o[d][r] *= al_l[crow(r, hi)]; } } while (0)
  f32x16 pA0, pA1, pB0, pB1; float mnA, mnB, alA, alB; bf16x8 pa0, pa1, pa2, pa3; const int NT = seq / KVBLK;
  constexpr int SE = 0, SO = SDEPTH - 1;
  SLOAD(SE, 0); asm volatile("s_waitcnt vmcnt(0)" ::: "memory"); SWRITE(0, SE); __syncthreads();
  qkt(pA0, pA1, K_lds, qr, r32, hi); partialSM(pA0, pA1, m_reg, mnA, alA);
  SLOAD(SO, KVBLK); if constexpr (SDEPTH == 2) { if (2 < NT) SLOAD(SE, 2 * KVBLK); }
  SWAIT(); SWRITE(1, SO); __syncthreads();
  for (int j = 1; j + 1 < NT; j += 2) {
    SBAR(); qkt(pB0, pB1, (bf16*)((char*)K_lds + SHM_K), qr, r32, hi);
    finishSM(pA0, pA1, alA, l_reg, pa0, pa1, pa2, pa3); SBAR();
    SLOAD(SO, (j + SDEPTH) * KVBLK); SBAR();
    pv_d0(o, vb0, pa0, pa1, pa2, pa3); partialSM(pB0, pB1, m_reg, mnB, alB);
    __syncthreads(); SWAIT(); SWRITE(0, SE);
    RESC(alB); __syncthreads();
    SBAR(); qkt(pA0, pA1, K_lds, qr, r32, hi);
    finishSM(pB0, pB1, alB, l_reg, pa0, pa1, pa2, pa3); SBAR();
    if (SDEPTH == 1 || j + 3 < NT) SLOAD(SE, (j + 1 + SDEPTH) * KVBLK); SBAR();
    pv_d0(o, vb0 + (int)SHM_V, pa0, pa1, pa2, pa3); partialSM(pA0, pA1, m_reg, mnA, alA);
    __syncthreads(); SWAIT(); SWRITE(1, SO);
    RESC(alA); __syncthreads();
  }
  SBAR(); qkt(pB0, pB1, (bf16*)((char*)K_lds + SHM_K), qr, r32, hi);
  finishSM(pA0, pA1, alA, l_reg, pa0, pa1, pa2, pa3); SBAR();
  pv_d0(o, vb0, pa0, pa1, pa2, pa3); partialSM(pB0, pB1, m_reg, mnB, alB);
  __syncthreads(); RESC(alB);
  finishSM(pB0, pB1, alB, l_reg, pa0, pa1, pa2, pa3); SBAR();
  pv_d0(o, vb0 + (int)SHM_V, pa0, pa1, pa2, pa3);
  if (hi == 0) li_l[r32] = l_reg; asm volatile("s_waitcnt lgkmcnt(0)" ::: "memory");
  float rli[16];
#pragma unroll
  for (int r = 0; r < 16; ++r) rli[r] = __builtin_amdgcn_rcpf(li_l[crow(r, hi)]);
  float* Ow = Ob + (long)(wid * QBLK) * LDO;
#pragma unroll
  for (int r = 0; r < 16; ++r) { int orow = crow(r, hi);
    for (int d0 = 0; d0 < 4; ++d0) Ow[(long)orow * LDO + d0 * 32 + r32] = o[d0][r] * rli[r]; }
#undef SLOAD
#undef SWRITE
#undef SWAIT
#undef RESC
}
__device__ __forceinline__ void qkt2(f32x16& p0, f32x16& p1, const bf16* Ks, const bf16x8* qr, int r32, int hi, int mp) {
  p0 = f32x16{}; p1 = f32x16{};
  __builtin_amdgcn_s_setprio(1);
#pragma unroll
  for (int d0 = 0; d0 < 4; ++d0) { int cb = (mp * 64 + d0 * 16 + hi * 8) * 2;
    bf16x8 b0 = *reinterpret_cast<const bf16x8*>((const char*)Ks + KSWZ(r32, cb));
    bf16x8 b1 = *reinterpret_cast<const bf16x8*>((const char*)Ks + KSWZ(32 + r32, cb));
    p0 = __builtin_amdgcn_mfma_f32_32x32x16_bf16(b0, qr[d0], p0, 0, 0, 0);
    p1 = __builtin_amdgcn_mfma_f32_32x32x16_bf16(b1, qr[d0], p1, 0, 0, 0); }
  __builtin_amdgcn_s_setprio(0);
}
constexpr int LDQ2 = 512, LDOB = 1024;
__device__ __forceinline__ void attn_diff_body(const bf16* __restrict__ Qb, const bf16* __restrict__ Kh, const bf16* __restrict__ Vh,
                                               unsigned short* __restrict__ Ob, int seq, char* lds, float lam, const float* __restrict__ subg, float osc) {
  using St = Stage<bf16>; using SQ = Stage<bf16>;
  const int tid = threadIdx.x, wid = tid >> 6, lane = tid & 63, r32 = lane & 31, hi = lane >> 5, mp = wid >> 2, wq = wid & 3;
  bf16* V_lds = (bf16*)lds; bf16* K_lds = (bf16*)(lds + 2 * SHM_V);
  float* ws = (float*)(lds + 2 * SHM_V + 2 * SHM_K) + wid * 64; float* li_l = ws; float* al_l = ws + 32;
  float m_reg = -1e30f, l_reg = 0; f32x16 o[4] = {}; bf16x8 qr[4];
  const bf16* Qw = Qb + (long)(wq * QBLK + r32) * LDQ2 + mp * 64 + hi * 8;
#pragma unroll
  for (int d0 = 0; d0 < 4; ++d0) qr[d0] = SQ::tobf(SQ::ld8(Qw + d0 * 16));
  const int sr = tid >> 4, sc = (tid & 15) * 8, vst0 = v_st(sr, sc), vst1 = v_st(32 + sr, sc);
  const int vb0 = (int)(uintptr_t)V_lds + v_rd_base(lane);
  struct { typename St::T vs0, vs1, ks0, ks1; } sr_[SDEPTH];
#define SLOAD(i, k0) do { sr_[i].vs0 = St::ld8(&Vh[(long)((k0) + sr) * LDK + sc]); sr_[i].vs1 = St::ld8(&Vh[(long)((k0) + 32 + sr) * LDK + sc]); \
    sr_[i].ks0 = St::ld8(&Kh[(long)((k0) + sr) * LDK + sc]); sr_[i].ks1 = St::ld8(&Kh[(long)((k0) + 32 + sr) * LDK + sc]); } while (0)
#define SWRITE(b, i) do { *(bf16x8*)((char*)V_lds + (b) * SHM_V + vst0) = St::tobf(sr_[i].vs0);          \
    *(bf16x8*)((char*)V_lds + (b) * SHM_V + vst1) = St::tobf(sr_[i].vs1); int kc = sc * 2;               \
    *(bf16x8*)((char*)K_lds + (b) * SHM_K + KSWZ(sr, kc)) = St::tobf(sr_[i].ks0);                       \
    *(bf16x8*)((char*)K_lds + (b) * SHM_K + KSWZ(32 + sr, kc)) = St::tobf(sr_[i].ks1); } while (0)
#define SWAIT() do { if constexpr (SDEPTH == 2) asm volatile("s_waitcnt vmcnt(4)" ::: "memory"); else asm volatile("s_waitcnt vmcnt(0)" ::: "memory"); } while (0)
#define RESC(a) do { if (__any((a) < 1.f)) { if (hi == 0) al_l[r32] = (a); asm volatile("s_waitcnt lgkmcnt(0)" ::: "memory"); \
    for (int d = 0; d < 4; ++d) for (int r = 0; r < 16; ++r) o[d][r] *= al_l[crow(r, hi)]; } } while (0)
  f32x16 pA0, pA1, pB0, pB1; float mnA, mnB, alA, alB; bf16x8 pa0, pa1, pa2, pa3; const int NT = seq / KVBLK;
  constexpr int SE = 0, SO = SDEPTH - 1;
  SLOAD(SE, 0); asm volatile("s_waitcnt vmcnt(0)" ::: "memory"); SWRITE(0, SE); __syncthreads();
  qkt2(pA0, pA1, K_lds, qr, r32, hi, mp); partialSM(pA0, pA1, m_reg, mnA, alA);
  SLOAD(SO, KVBLK); if constexpr (SDEPTH == 2) { if (2 < NT) SLOAD(SE, 2 * KVBLK); }
  SWAIT(); SWRITE(1, SO); __syncthreads();
  for (int j = 1; j + 1 < NT; j += 2) {
    SBAR(); qkt2(pB0, pB1, (bf16*)((char*)K_lds + SHM_K), qr, r32, hi, mp);
    finishSM(pA0, pA1, alA, l_reg, pa0, pa1, pa2, pa3); SBAR();
    SLOAD(SO, (j + SDEPTH) * KVBLK); SBAR();
    pv_d0(o, vb0, pa0, pa1, pa2, pa3); partialSM(pB0, pB1, m_reg, mnB, alB);
    __syncthreads(); SWAIT(); SWRITE(0, SE);
    RESC(alB); __syncthreads();
    SBAR(); qkt2(pA0, pA1, K_lds, qr, r32, hi, mp);
    finishSM(pB0, pB1, alB, l_reg, pa0, pa1, pa2, pa3); SBAR();
    if (SDEPTH == 1 || j + 3 < NT) SLOAD(SE, (j + 1 + SDEPTH) * KVBLK); SBAR();
    pv_d0(o, vb0 + (int)SHM_V, pa0, pa1, pa2, pa3); partialSM(pA0, pA1, m_reg, mnA, alA);
    __syncthreads(); SWAIT(); SWRITE(1, SO);
    RESC(alA); __syncthreads();
  }
  SBAR(); qkt2(pB0, pB1, (bf16*)((char*)K_lds + SHM_K), qr, r32, hi, mp);
  finishSM(pA0, pA1, alA, l_reg, pa0, pa1, pa2, pa3); SBAR();
  pv_d0(o, vb0, pa0, pa1, pa2, pa3); partialSM(pB0, pB1, m_reg, mnB, alB);
  __syncthreads(); RESC(alB);
  finishSM(pB0, pB1, alB, l_reg, pa0, pa1, pa2, pa3); SBAR();
  pv_d0(o, vb0 + (int)SHM_V, pa0, pa1, pa2, pa3);
  if (hi == 0) li_l[r32] = l_reg; asm volatile("s_waitcnt lgkmcnt(0)" ::: "memory");
  float rli[16];
#pragma unroll
  for (int r = 0; r < 16; ++r) rli[r] = __builtin_amdgcn_rcpf(li_l[crow(r, hi)]);
#pragma unroll
  for (int d0 = 0; d0 < 4; ++d0)
#pragma unroll
    for (int r = 0; r < 16; ++r) o[d0][r] *= rli[r];
  __syncthreads();
  float* xch = (float*)lds + wq * 4096 + lane;
  if (mp == 1) {
#pragma unroll
    for (int d0 = 0; d0 < 4; ++d0)
#pragma unroll
      for (int r = 0; r < 16; ++r) xch[(d0 * 16 + r) * 64] = o[d0][r]; }
  __syncthreads();
  if (mp == 0) {
    int lane_e = lane; asm volatile("" : "+v"(lane_e));
    const int r32e = lane_e & 31, hie = lane_e >> 5;
    float ssq[16];
#pragma unroll
    for (int r = 0; r < 16; ++r) ssq[r] = 0.f;
#pragma unroll
    for (int d0 = 0; d0 < 4; ++d0)
#pragma unroll
      for (int r = 0; r < 16; ++r) { const float v = o[d0][r] - lam * xch[(d0 * 16 + r) * 64]; o[d0][r] = v; ssq[r] += v * v; }
#pragma unroll
    for (int r = 0; r < 16; ++r) { float s = ssq[r]; s += __shfl_xor(s, 1); s += __shfl_xor(s, 2); s += __shfl_xor(s, 4); s += __shfl_xor(s, 8); s += __shfl_xor(s, 16); ssq[r] = rsqrtf(s * (1.0f / 128.0f) + 1e-6f) * osc; }
    unsigned short* Ow = Ob + (long)(wq * QBLK) * LDOB;
#pragma unroll
    for (int d0 = 0; d0 < 4; ++d0) { const float gsc = subg[d0 * 32 + r32e];
#pragma unroll
      for (int r = 0; r < 16; ++r) { const float v = o[d0][r] * ssq[r] * gsc; const unsigned u = __float_as_uint(v); Ow[(long)crow(r, hie) * LDOB + d0 * 32 + r32e] = (unsigned short)((u + 0x7fffu + ((u >> 16) & 1u)) >> 16); } } }
  __syncthreads();
#undef SLOAD
#undef SWRITE
#undef SWAIT
#undef RESC
}
__device__ __forceinline__ void qkt3(f32x16& p0, f32x16& p1, const bf16* Ks, const bf16x8* qr, const f32x16& negm, int r32, int hi, int mp) {
#pragma unroll
  for (int d0 = 0; d0 < 4; ++d0) { int cb = (mp * 64 + d0 * 16 + hi * 8) * 2;
    bf16x8 b0 = *reinterpret_cast<const bf16x8*>((const char*)Ks + KSWZ(r32, cb));
    bf16x8 b1 = *reinterpret_cast<const bf16x8*>((const char*)Ks + KSWZ(32 + r32, cb));
    if (d0 == 0) { p0 = __builtin_amdgcn_mfma_f32_32x32x16_bf16(b0, qr[0], negm, 0, 0, 0); p1 = __builtin_amdgcn_mfma_f32_32x32x16_bf16(b1, qr[0], negm, 0, 0, 0); }
    else { p0 = __builtin_amdgcn_mfma_f32_32x32x16_bf16(b0, qr[d0], p0, 0, 0, 0); p1 = __builtin_amdgcn_mfma_f32_32x32x16_bf16(b1, qr[d0], p1, 0, 0, 0); } }
}
constexpr float THR2 = THR * 1.4426950408889634f;
__device__ __forceinline__ void partialSM2(f32x16& p0, f32x16& p1, float& m_reg, f32x16& negm, float& alpha, bool nomax) {
  if (nomax) { alpha = 1.f; for (int r = 0; r < 16; ++r) p0[r] = __builtin_amdgcn_exp2f(p0[r]); return; }
  float pmax = p0[0]; for (int r = 1; r < 16; ++r) pmax = fmaxf(pmax, p0[r]); for (int r = 0; r < 16; ++r) pmax = fmaxf(pmax, p1[r]);
  { auto rr = __builtin_amdgcn_permlane32_swap(__float_as_uint(pmax), __float_as_uint(pmax), false, false);
    pmax = fmaxf(__uint_as_float(rr[0]), __uint_as_float(rr[1])); }
  if (__builtin_expect(__all(pmax <= THR2), 1)) { alpha = 1.f; }
  else { const float dl = fmaxf(pmax, 0.f); m_reg += dl; alpha = __builtin_amdgcn_exp2f(-dl);
    for (int r = 0; r < 16; ++r) { p0[r] -= dl; p1[r] -= dl; }
    for (int r = 0; r < 16; ++r) negm[r] = -m_reg; }
  for (int r = 0; r < 16; ++r) p0[r] = __builtin_amdgcn_exp2f(p0[r]);
}
__device__ __forceinline__ void finishSM2(f32x16& p0, f32x16& p1, float alpha, float& l_reg, bf16x8& pa0, bf16x8& pa1, bf16x8& pa2, bf16x8& pa3) {
  for (int r = 0; r < 16; ++r) p1[r] = __builtin_amdgcn_exp2f(p1[r]);
  float ps = 0; for (int r = 0; r < 16; ++r) ps += p0[r]; for (int r = 0; r < 16; ++r) ps += p1[r];
  { auto rr = __builtin_amdgcn_permlane32_swap(__float_as_uint(ps), __float_as_uint(ps), false, false);
    ps = __uint_as_float(rr[0]) + __uint_as_float(rr[1]); }
  l_reg = l_reg * alpha + ps;
#define PK8(P, BASE, OUT) do { u32x4 w = {cvtpk(P[BASE + 0], P[BASE + 1]), cvtpk(P[BASE + 2], P[BASE + 3]), cvtpk(P[BASE + 4], P[BASE + 5]), cvtpk(P[BASE + 6], P[BASE + 7])}; OUT = *reinterpret_cast<bf16x8*>(&w); } while (0)
  PK8(p0, 0, pa0); PK8(p0, 8, pa1); PK8(p1, 0, pa2); PK8(p1, 8, pa3);
#undef PK8
}
typedef short v4i16b_t __attribute__((ext_vector_type(4)));
__device__ __forceinline__ v4i16b_t vtrb(int vb, int off) { return __builtin_amdgcn_ds_read_tr16_b64_v4i16((__attribute__((address_space(3))) v4i16b_t*)(unsigned)(vb + off)); }
#define PVB_F(L, H) __builtin_bit_cast(bf16x8, __builtin_shufflevector(L, H, 0, 1, 2, 3, 4, 5, 6, 7))
template <int D0> __device__ __forceinline__ void pv_oneb(f32x16& od, int vb, bf16x8 pa0, bf16x8 pa1, bf16x8 pa2, bf16x8 pa3) {
  const v4i16b_t l0 = vtrb(vb, v_rd_off(D0, 0, 0)), h0 = vtrb(vb, v_rd_off(D0, 0, 1)), l1 = vtrb(vb, v_rd_off(D0, 1, 0)), h1 = vtrb(vb, v_rd_off(D0, 1, 1));
  const v4i16b_t l2 = vtrb(vb, v_rd_off(D0, 2, 0)), h2 = vtrb(vb, v_rd_off(D0, 2, 1)), l3 = vtrb(vb, v_rd_off(D0, 3, 0)), h3 = vtrb(vb, v_rd_off(D0, 3, 1));
  __builtin_amdgcn_s_setprio(1);
  od = __builtin_amdgcn_mfma_f32_32x32x16_bf16(pa0, PVB_F(l0, h0), od, 0, 0, 0);
  od = __builtin_amdgcn_mfma_f32_32x32x16_bf16(pa1, PVB_F(l1, h1), od, 0, 0, 0);
  od = __builtin_amdgcn_mfma_f32_32x32x16_bf16(pa2, PVB_F(l2, h2), od, 0, 0, 0);
  od = __builtin_amdgcn_mfma_f32_32x32x16_bf16(pa3, PVB_F(l3, h3), od, 0, 0, 0);
  __builtin_amdgcn_s_setprio(0);
}
__device__ __forceinline__ void pv_d0b(f32x16* o, int vb, bf16x8 pa0, bf16x8 pa1, bf16x8 pa2, bf16x8 pa3) {
  pv_oneb<0>(o[0], vb, pa0, pa1, pa2, pa3); SBAR(); pv_oneb<1>(o[1], vb, pa0, pa1, pa2, pa3); SBAR(); pv_oneb<2>(o[2], vb, pa0, pa1, pa2, pa3); SBAR(); pv_oneb<3>(o[3], vb, pa0, pa1, pa2, pa3);
}
#define PVP_RD(A, D0) do { A[0] = tr_read<v_rd_off(D0, 0, 0)>(vb); A[1] = tr_read<v_rd_off(D0, 0, 1)>(vb); A[2] = tr_read<v_rd_off(D0, 1, 0)>(vb); A[3] = tr_read<v_rd_off(D0, 1, 1)>(vb); \
    A[4] = tr_read<v_rd_off(D0, 2, 0)>(vb); A[5] = tr_read<v_rd_off(D0, 2, 1)>(vb); A[6] = tr_read<v_rd_off(D0, 3, 0)>(vb); A[7] = tr_read<v_rd_off(D0, 3, 1)>(vb); } while (0)
#define PVP_PK(L, H) (bf16x8){L[0], L[1], L[2], L[3], H[0], H[1], H[2], H[3]}
#define PVP_MM(OD, A) do { OD = __builtin_amdgcn_mfma_f32_32x32x16_bf16(pa0, PVP_PK(A[0], A[1]), OD, 0, 0, 0); OD = __builtin_amdgcn_mfma_f32_32x32x16_bf16(pa1, PVP_PK(A[2], A[3]), OD, 0, 0, 0); \
    OD = __builtin_amdgcn_mfma_f32_32x32x16_bf16(pa2, PVP_PK(A[4], A[5]), OD, 0, 0, 0); OD = __builtin_amdgcn_mfma_f32_32x32x16_bf16(pa3, PVP_PK(A[6], A[7]), OD, 0, 0, 0); } while (0)
__device__ __forceinline__ void pv_pipe(f32x16* o, int vb, bf16x8 pa0, bf16x8 pa1, bf16x8 pa2, bf16x8 pa3) {
  s16x4 A0[8], A1[8];
  PVP_RD(A0, 0); PVP_RD(A1, 1);
  asm volatile("s_waitcnt lgkmcnt(8)" ::: "memory"); SBAR(); PVP_MM(o[0], A0); SBAR();
  PVP_RD(A0, 2);
  asm volatile("s_waitcnt lgkmcnt(8)" ::: "memory"); SBAR(); PVP_MM(o[1], A1); SBAR();
  PVP_RD(A1, 3);
  asm volatile("s_waitcnt lgkmcnt(8)" ::: "memory"); SBAR(); PVP_MM(o[2], A0); SBAR();
  asm volatile("s_waitcnt lgkmcnt(0)" ::: "memory"); SBAR(); PVP_MM(o[3], A1);
}
#undef PVP_RD
#undef PVP_PK
#undef PVP_MM
__device__ __forceinline__ void attn_diff_body3(const bf16* __restrict__ Qb, const bf16* __restrict__ Kh, const bf16* __restrict__ Vh,
                                               unsigned short* __restrict__ Ob, int seq, char* lds, __attribute__((address_space(3))) unsigned char* ldsl, float lam, const float* __restrict__ subg, float osc, bool nomax) {
  using St = Stage<bf16>; using SQ = Stage<bf16>;
  const int tid = threadIdx.x, wid = tid >> 6, lane = tid & 63, r32 = lane & 31, hi = lane >> 5, mp = wid >> 2, wq = wid & 3;
  constexpr int VR = 0, KR = 3 * 16384, WSO = 6 * 16384;
  bf16* V_lds = (bf16*)(lds + VR); bf16* K_lds = (bf16*)(lds + KR);
  float* ws = (float*)(lds + WSO) + wid * 64; float* li_l = ws; float* al_l = ws + 32;
  float m_reg = 0.f, l_reg = 0; f32x16 o[4] = {}; bf16x8 qr[4]; f32x16 negm = {}; asm volatile("" : "+v"(negm));
  const bf16* Qw = Qb + (long)(wq * QBLK + r32) * LDQ2 + mp * 64 + hi * 8;
#pragma unroll
  for (int d0 = 0; d0 < 4; ++d0) qr[d0] = SQ::tobf(SQ::ld8(Qw + d0 * 16));
  const int vb0 = (int)(uintptr_t)V_lds + v_rd_base(lane);
  int kso[2], vso[2];
#pragma unroll
  for (int i = 0; i < 2; ++i) { const int ob = (i * 8 + wid) * 1024 + 16 * lane; const int row = ob >> 8, cb = (ob & 255) ^ ((row & 7) << 4); kso[i] = row * LDK + (cb >> 1);
    const int st = ob >> 9, e = (ob & 511) >> 1, kk = (st >> 2) * 8 + (e >> 5); vso[i] = kk * LDK + (st & 3) * 32 + (e & 31); }
  const int wu = __builtin_amdgcn_readfirstlane(wid);
  typedef __attribute__((address_space(3))) unsigned las_u32;
  const int NT = seq / KVBLK;
#define DMA_K(t, slot) do { const int tt_ = (t) < NT ? (t) : NT - 1; const bf16* g_ = Kh + (long)tt_ * KVBLK * LDK; _Pragma("unroll") for (int i_ = 0; i_ < 2; ++i_) \
    __builtin_amdgcn_global_load_lds((const unsigned*)(g_ + kso[i_]), (las_u32*)(ldsl + KR + (slot) * 16384 + (i_ * 8 + wu) * 1024), 16, 0, 0); } while (0)
#define DMA_V(t, slot) do { const int tt_ = (t) < NT ? (t) : NT - 1; const bf16* g_ = Vh + (long)tt_ * KVBLK * LDK; _Pragma("unroll") for (int i_ = 0; i_ < 2; ++i_) \
    __builtin_amdgcn_global_load_lds((const unsigned*)(g_ + vso[i_]), (las_u32*)(ldsl + VR + (slot) * 16384 + (i_ * 8 + wu) * 1024), 16, 0, 0); } while (0)
#define CLOSE() do { asm volatile("s_waitcnt vmcnt(4) lgkmcnt(0)" ::: "memory"); __builtin_amdgcn_s_barrier(); asm volatile("" ::: "memory"); } while (0)
#define RESC(a) do { if (__any((a) < 1.f)) { if (hi == 0) al_l[r32] = (a); asm volatile("s_waitcnt lgkmcnt(0)" ::: "memory"); \
    for (int d = 0; d < 4; ++d) for (int r = 0; r < 16; ++r) o[d][r] *= al_l[crow(r, hi)]; } } while (0)
  f32x16 pA0, pA1, pB0, pB1; float mnA, mnB, alA, alB; bf16x8 pa0, pa1, pa2, pa3;
  DMA_K(0, 0); DMA_K(1, 1); DMA_V(0, 0);
  asm volatile("s_waitcnt vmcnt(4)" ::: "memory"); __builtin_amdgcn_s_barrier(); asm volatile("" ::: "memory");
  DMA_K(2, 2); DMA_V(1, 1);
  qkt2(pA0, pA1, K_lds, qr, r32, hi, mp); partialSM2(pA0, pA1, m_reg, negm, alA, nomax);
  CLOSE();
  int kcur = 1, vcur = 0;
#define ROT3(x) ((x) == 2 ? 0 : (x) + 1)
#define PRV3(x) ((x) == 0 ? 2 : (x) - 1)
#define ITER(PC0, PC1, MNC, ALC, PP0, PP1, ALP, j_) do { \
    DMA_K((j_) + 2, PRV3(kcur)); DMA_V((j_) + 1, PRV3(vcur)); \
    SBAR(); if (__builtin_expect(__all(m_reg == 0.f), 1)) { qkt2(PC0, PC1, (bf16*)((char*)K_lds + kcur * 16384), qr, r32, hi, mp); } else { qkt3(PC0, PC1, (bf16*)((char*)K_lds + kcur * 16384), qr, negm, r32, hi, mp); } \
    finishSM2(PP0, PP1, ALP, l_reg, pa0, pa1, pa2, pa3); SBAR(); \
    pv_d0b(o, vb0 + vcur * 16384, pa0, pa1, pa2, pa3); partialSM2(PC0, PC1, m_reg, negm, ALC, nomax); \
    if (!nomax) { RESC(ALC); } CLOSE(); kcur = ROT3(kcur); vcur = ROT3(vcur); } while (0)
  for (int j = 1; j + 1 < NT; j += 2) {
    ITER(pB0, pB1, mnB, alB, pA0, pA1, alA, j);
    ITER(pA0, pA1, mnA, alA, pB0, pB1, alB, j + 1);
  }
  ITER(pB0, pB1, mnB, alB, pA0, pA1, alA, NT - 1);
  finishSM2(pB0, pB1, alB, l_reg, pa0, pa1, pa2, pa3); SBAR();
  pv_d0b(o, vb0 + vcur * 16384, pa0, pa1, pa2, pa3);
  asm volatile("s_waitcnt vmcnt(0)" ::: "memory");
#undef ITER
#undef ROT3
#undef PRV3
#undef DMA_K
#undef DMA_V
#undef CLOSE
  if (hi == 0) li_l[r32] = l_reg; asm volatile("s_waitcnt lgkmcnt(0)" ::: "memory");
  float rli[16];
#pragma unroll
  for (int r = 0; r < 16; ++r) rli[r] = __builtin_amdgcn_rcpf(li_l[crow(r, hi)]);
#pragma unroll
  for (int d0 = 0; d0 < 4; ++d0)
#pragma unroll
    for (int r = 0; r < 16; ++r) o[d0][r] *= rli[r];
  __syncthreads();
  float* xch = (float*)lds + wq * 4096 + lane;
  if (mp == 1) {
#pragma unroll
    for (int d0 = 0; d0 < 4; ++d0)
#pragma unroll
      for (int r = 0; r < 16; ++r) xch[(d0 * 16 + r) * 64] = o[d0][r]; }
  __syncthreads();
  if (mp == 0) {
    int lane_e = lane; asm volatile("" : "+v"(lane_e));
    const int r32e = lane_e & 31, hie = lane_e >> 5;
    float ssq[16];
#pragma unroll
    for (int r = 0; r < 16; ++r) ssq[r] = 0.f;
#pragma unroll
    for (int d0 = 0; d0 < 4; ++d0)
#pragma unroll
      for (int r = 0; r < 16; ++r) { const float v = o[d0][r] - lam * xch[(d0 * 16 + r) * 64]; o[d0][r] = v; ssq[r] += v * v; }
#pragma unroll
    for (int r = 0; r < 16; ++r) { float s = ssq[r]; s += __shfl_xor(s, 1); s += __shfl_xor(s, 2); s += __shfl_xor(s, 4); s += __shfl_xor(s, 8); s += __shfl_xor(s, 16); ssq[r] = rsqrtf(s * (1.0f / 128.0f) + 1e-6f) * osc; }
    unsigned short* Ow = Ob + (long)(wq * QBLK) * LDOB;
#pragma unroll
    for (int d0 = 0; d0 < 4; ++d0) { const float gsc = subg[d0 * 32 + r32e];
#pragma unroll
      for (int r = 0; r < 16; ++r) { const float v = o[d0][r] * ssq[r] * gsc; const unsigned u = __float_as_uint(v); Ow[(long)crow(r, hie) * LDOB + d0 * 32 + r32e] = (unsigned short)((u + 0x7fffu + ((u >> 16) & 1u)) >> 16); } } }
  __syncthreads();
#undef RESC
}
typedef int v8i_a8 __attribute__((ext_vector_type(8)));
typedef int v4i_a8 __attribute__((ext_vector_type(4)));
constexpr float THR8 = 8.5f;
__device__ __forceinline__ unsigned pk4f8(float a, float b, float c, float d) { int w = 0; w = __builtin_amdgcn_cvt_pk_fp8_f32(a, b, w, false); w = __builtin_amdgcn_cvt_pk_fp8_f32(c, d, w, true); return (unsigned)w; }
__device__ __forceinline__ void partialSM8(f32x16& p0, f32x16& p1, float& m_reg, float& alpha) {
  float pmax = p0[0]; for (int r = 1; r < 16; ++r) pmax = fmaxf(pmax, p0[r]); for (int r = 0; r < 16; ++r) pmax = fmaxf(pmax, p1[r]);
  { auto rr = __builtin_amdgcn_permlane32_swap(__float_as_uint(pmax), __float_as_uint(pmax), false, false);
    pmax = fmaxf(__uint_as_float(rr[0]), __uint_as_float(rr[1])); }
  if (__builtin_expect(__all(pmax <= THR8), 1)) { alpha = 1.f; }
  else { const float dl = fmaxf(pmax, 0.f); m_reg += dl; alpha = __builtin_amdgcn_exp2f(-dl);
    for (int r = 0; r < 16; ++r) { p0[r] -= dl; p1[r] -= dl; } }
  for (int r = 0; r < 16; ++r) p0[r] = __builtin_amdgcn_exp2f(p0[r]);
}
__device__ __forceinline__ void finishSM8(f32x16& p0, f32x16& p1, float alpha, float& l_reg, v8i_a8& pa) {
  for (int r = 0; r < 16; ++r) p1[r] = __builtin_amdgcn_exp2f(p1[r]);
  float ps = 0; for (int r = 0; r < 16; ++r) ps += p0[r]; for (int r = 0; r < 16; ++r) ps += p1[r];
  { auto rr = __builtin_amdgcn_permlane32_swap(__float_as_uint(ps), __float_as_uint(ps), false, false);
    ps = __uint_as_float(rr[0]) + __uint_as_float(rr[1]); }
  l_reg = l_reg * alpha + ps;
  pa[0] = (int)pk4f8(p0[0], p0[1], p0[2], p0[3]); pa[1] = (int)pk4f8(p0[4], p0[5], p0[6], p0[7]); pa[2] = (int)pk4f8(p0[8], p0[9], p0[10], p0[11]); pa[3] = (int)pk4f8(p0[12], p0[13], p0[14], p0[15]);
  pa[4] = (int)pk4f8(p1[0], p1[1], p1[2], p1[3]); pa[5] = (int)pk4f8(p1[4], p1[5], p1[6], p1[7]); pa[6] = (int)pk4f8(p1[8], p1[9], p1[10], p1[11]); pa[7] = (int)pk4f8(p1[12], p1[13], p1[14], p1[15]);
}
typedef __attribute__((address_space(3))) unsigned char las_u8;
__device__ __forceinline__ v8i_a8 kfrag8(const las_u8* kt, int row, int mp, int hi) {
  const int sw = (row >> 1) & 7, c0 = 4 * mp + 2 * hi;
  const v4i_a8 lo = *(const __attribute__((address_space(3))) v4i_a8*)(kt + row * 128 + ((c0 ^ sw) << 4)), hi4 = *(const __attribute__((address_space(3))) v4i_a8*)(kt + row * 128 + (((c0 + 1) ^ sw) << 4));
  return __builtin_shufflevector(lo, hi4, 0, 1, 2, 3, 4, 5, 6, 7);
}
#define QS8 0x7D7D7D7D
#define US8 0x7F7F7F7F
__device__ __forceinline__ void qkt8(f32x16& p0, f32x16& p1, const las_u8* kt, const v8i_a8& qf, const f32x16& c0, int r32, int hi, int mp) {
  const v8i_a8 k0 = kfrag8(kt, r32, mp, hi), k1 = kfrag8(kt, 32 + r32, mp, hi);
  p0 = __builtin_amdgcn_mfma_scale_f32_32x32x64_f8f6f4(k0, qf, c0, 0, 0, 0, US8, 0, QS8);
  p1 = __builtin_amdgcn_mfma_scale_f32_32x32x64_f8f6f4(k1, qf, c0, 0, 0, 0, US8, 0, QS8);
}
__device__ __forceinline__ void pv8(f32x16* o, const las_u8* vt, int lane, const v8i_a8& pa) {
#pragma unroll
  for (int d0 = 0; d0 < 4; ++d0) {
    const v4i_a8 lo = *(const __attribute__((address_space(3))) v4i_a8*)(vt + ((d0 * 2 + 0) * 64 + lane) * 16), hi4 = *(const __attribute__((address_space(3))) v4i_a8*)(vt + ((d0 * 2 + 1) * 64 + lane) * 16);
    const v8i_a8 vf = __builtin_shufflevector(lo, hi4, 0, 1, 2, 3, 4, 5, 6, 7);
    o[d0] = __builtin_amdgcn_mfma_scale_f32_32x32x64_f8f6f4(pa, vf, o[d0], 0, 0, 0, US8, 0, US8); }
}
__device__ __forceinline__ unsigned pk4b8(float a, float b, float c, float d) { int w = 0; w = __builtin_amdgcn_cvt_pk_bf8_f32(a, b, w, false); w = __builtin_amdgcn_cvt_pk_bf8_f32(c, d, w, true); return (unsigned)w; }
__device__ __forceinline__ int pk4b8i(float a, float b, float c, float d) { int w; asm volatile("" : "=v"(w)); w = __builtin_amdgcn_cvt_pk_bf8_f32(a, b, w, false); return __builtin_amdgcn_cvt_pk_bf8_f32(c, d, w, true); }
__device__ __forceinline__ void finishSM8b(f32x16& p0, f32x16& p1, v8i_a8& pa) {
  for (int r = 0; r < 16; ++r) p1[r] = __builtin_amdgcn_exp2f(p1[r]);
  pa[0] = pk4b8i(p0[0], p0[1], p0[2], p0[3]); pa[1] = pk4b8i(p0[4], p0[5], p0[6], p0[7]); pa[2] = pk4b8i(p0[8], p0[9], p0[10], p0[11]); pa[3] = pk4b8i(p0[12], p0[13], p0[14], p0[15]);
  pa[4] = pk4b8i(p1[0], p1[1], p1[2], p1[3]); pa[5] = pk4b8i(p1[4], p1[5], p1[6], p1[7]); pa[6] = pk4b8i(p1[8], p1[9], p1[10], p1[11]); pa[7] = pk4b8i(p1[12], p1[13], p1[14], p1[15]);
}
__device__ __forceinline__ void pv8b(f32x16* o, f32x16& osum, const v8i_a8& ones, const las_u8* vt, int lane, const v8i_a8& pa) {
  osum = __builtin_amdgcn_mfma_scale_f32_32x32x64_f8f6f4(pa, ones, osum, 1, 0, 0, US8, 0, US8);
#pragma unroll
  for (int d0 = 0; d0 < 4; ++d0) {
    const v4i_a8 lo = *(const __attribute__((address_space(3))) v4i_a8*)(vt + ((d0 * 2 + 0) * 64 + lane) * 16), hi4 = *(const __attribute__((address_space(3))) v4i_a8*)(vt + ((d0 * 2 + 1) * 64 + lane) * 16);
    const v8i_a8 vf = __builtin_shufflevector(lo, hi4, 0, 1, 2, 3, 4, 5, 6, 7);
    o[d0] = __builtin_amdgcn_mfma_scale_f32_32x32x64_f8f6f4(pa, vf, o[d0], 1, 0, 0, US8, 0, US8); }
}
template <bool NOMAX> __device__ __forceinline__ void attn_diff_body8(const unsigned char* __restrict__ Q8b, const unsigned char* __restrict__ K8h, const unsigned char* __restrict__ V8h,
                                               unsigned short* __restrict__ Ob, int seq, char* lds, las_u8* ldsl, float lam, const float* __restrict__ subg, float osc) {
  constexpr bool nomax = NOMAX;
  const int tid = threadIdx.x, wid = tid >> 6, lane = tid & 63, r32 = lane & 31, hi = lane >> 5, mp = wid >> 2, wq = wid & 3;
  constexpr int VR = 0, KR = 4 * 8192, WSO = 65536;
  typedef __attribute__((address_space(3))) float las_f32;
  las_f32* li_l = (las_f32*)(ldsl + WSO) + wid * 64; las_f32* al_l = li_l + 32;
  float m_reg = 0.f, l_reg = 0; f32x16 o[4] = {};
  v8i_a8 qf;
  { const unsigned char* qp = Q8b + (long)(wq * QBLK + r32) * 512 + mp * 64 + hi * 32; const v4i_a8 lo = *(const v4i_a8*)qp, h4 = *(const v4i_a8*)(qp + 16); qf = __builtin_shufflevector(lo, h4, 0, 1, 2, 3, 4, 5, 6, 7); }
  const int wu = __builtin_amdgcn_readfirstlane(wid);
  const int krow = 8 * wid + (lane >> 3), kso = krow * 512 + (((lane & 7) ^ ((krow >> 1) & 7)) << 4), vso = wid * 1024 + 16 * lane;
  typedef __attribute__((address_space(3))) unsigned las_u32;
  const int NT = seq / KVBLK;
#define DMA_K(t, slot) do { const int tt_ = (t) < NT ? (t) : NT - 1; __builtin_amdgcn_global_load_lds((const unsigned*)(K8h + (long)tt_ * KVBLK * 512 + kso), (las_u32*)(ldsl + KR + (slot) * 8192 + wu * 1024), 16, 0, 0); } while (0)
#define DMA_V(t, slot) do { const int tt_ = (t) < NT ? (t) : NT - 1; __builtin_amdgcn_global_load_lds((const unsigned*)(V8h + (long)tt_ * 8192 + vso), (las_u32*)(ldsl + VR + (slot) * 8192 + wu * 1024), 16, 0, 0); } while (0)
#define CLOSE() do { asm volatile("s_waitcnt vmcnt(2) lgkmcnt(0)" ::: "memory"); __builtin_amdgcn_s_barrier(); asm volatile("" ::: "memory"); } while (0)
#define RESC(a) do { if (__any((a) < 1.f)) { if (hi == 0) al_l[r32] = (a); asm volatile("s_waitcnt lgkmcnt(0)" ::: "memory"); \
    for (int d = 0; d < 4; ++d) for (int r = 0; r < 16; ++r) o[d][r] *= al_l[crow(r, hi)]; } } while (0)
  f32x16 pA0, pA1, pB0, pB1; float alA, alB; v8i_a8 pa;
  f32x16 osum = {}; v8i_a8 ones8;
  { const int ob = r32 == 0 ? 0x38383838 : 0; ones8 = (v8i_a8){ob, ob, ob, ob, ob, ob, ob, ob}; }
  int kcur = 1, vcur = 0;
  if constexpr (!nomax) {
  DMA_K(0, 0); DMA_K(1, 1); DMA_V(0, 0);
  asm volatile("s_waitcnt vmcnt(2)" ::: "memory"); __builtin_amdgcn_s_barrier(); asm volatile("" ::: "memory");
  DMA_K(2, 2); DMA_V(1, 1);
  { const f32x16 z0 = {}; qkt8(pA0, pA1, ldsl + KR, qf, z0, r32, hi, mp); }
  partialSM8(pA0, pA1, m_reg, alA);
  CLOSE();
  }
#define ROT3(x) ((x) == 2 ? 0 : (x) + 1)
#define PRV3(x) ((x) == 0 ? 2 : (x) - 1)
#define ITER(PC0, PC1, ALC, PP0, PP1, ALP, j_) do { \
    DMA_K((j_) + 2, PRV3(kcur)); DMA_V((j_) + 1, PRV3(vcur)); \
    SBAR(); if (__builtin_expect(__all(m_reg == 0.f), 1)) { const f32x16 z0_ = {}; qkt8(PC0, PC1, ldsl + KR + kcur * 8192, qf, z0_, r32, hi, mp); } \
    else { f32x16 nm_; _Pragma("unroll") for (int r_ = 0; r_ < 16; ++r_) nm_[r_] = -m_reg; qkt8(PC0, PC1, ldsl + KR + kcur * 8192, qf, nm_, r32, hi, mp); } \
    finishSM8(PP0, PP1, ALP, l_reg, pa); SBAR(); \
    pv8(o, ldsl + VR + vcur * 8192, lane, pa); partialSM8(PC0, PC1, m_reg, ALC); \
    RESC(ALC); CLOSE(); kcur = ROT3(kcur); vcur = ROT3(vcur); } while (0)
  if constexpr (nomax) {
    v8i_a8 kf0, kf1, vf0, vf1, vf2, vf3;
#define LDV8(d0_, vt_) ({ const v4i_a8 lo_ = *(const __attribute__((address_space(3))) v4i_a8*)((vt_) + (((d0_) * 2 + 0) * 64 + lane) * 16), hi_ = *(const __attribute__((address_space(3))) v4i_a8*)((vt_) + (((d0_) * 2 + 1) * 64 + lane) * 16); \
      (v8i_a8)__builtin_shufflevector(lo_, hi_, 0, 1, 2, 3, 4, 5, 6, 7); })
#define PVB() do { \
      osum = __builtin_amdgcn_mfma_scale_f32_32x32x64_f8f6f4(pa, ones8, osum, 1, 0, 0, US8, 0, US8); \
      o[0] = __builtin_amdgcn_mfma_scale_f32_32x32x64_f8f6f4(pa, vf0, o[0], 1, 0, 0, US8, 0, US8); o[1] = __builtin_amdgcn_mfma_scale_f32_32x32x64_f8f6f4(pa, vf1, o[1], 1, 0, 0, US8, 0, US8); \
      o[2] = __builtin_amdgcn_mfma_scale_f32_32x32x64_f8f6f4(pa, vf2, o[2], 1, 0, 0, US8, 0, US8); o[3] = __builtin_amdgcn_mfma_scale_f32_32x32x64_f8f6f4(pa, vf3, o[3], 1, 0, 0, US8, 0, US8); \
      asm volatile("" : "+v"(o[0]), "+v"(o[1]), "+v"(o[2]), "+v"(o[3]), "+v"(osum)); } while (0)
#define QKB(PC0, PC1) do { const f32x16 z0_ = {}; PC0 = __builtin_amdgcn_mfma_scale_f32_32x32x64_f8f6f4(kf0, qf, z0_, 0, 0, 0, US8, 0, QS8); PC1 = __builtin_amdgcn_mfma_scale_f32_32x32x64_f8f6f4(kf1, qf, z0_, 0, 0, 0, US8, 0, QS8); asm volatile("" : "+v"(PC0), "+v"(PC1)); } while (0)
#define LDK8(s_) do { const las_u8* kt_ = ldsl + KR + (s_) * 8192; kf0 = kfrag8(kt_, r32, mp, hi); kf1 = kfrag8(kt_, 32 + r32, mp, hi); } while (0)
#define LDV01(s_) do { const las_u8* vt_ = ldsl + VR + (s_) * 8192; vf0 = LDV8(0, vt_); vf1 = LDV8(1, vt_); } while (0)
#define LDV23(s_) do { const las_u8* vt_ = ldsl + VR + (s_) * 8192; vf2 = LDV8(2, vt_); vf3 = LDV8(3, vt_); } while (0)
#define ITERC(PC0, PC1, PP0, PP1, j_, U_) do { \
    DMA_K((j_) + 3, ((U_) + 3) & 3); DMA_V((j_) + 1, ((U_) + 1) & 3); \
    SBAR(); QKB(PC0, PC1); SBAR(); \
    LDV01(((U_) + 3) & 3); LDK8(((U_) + 1) & 3); SBAR(); \
    finishSM8b(PP0, PP1, pa); SBAR(); LDV23(((U_) + 3) & 3); SBAR(); \
    PVB(); \
    _Pragma("unroll") for (int r_ = 0; r_ < 16; ++r_) PC0[r_] = __builtin_amdgcn_exp2f(PC0[r_]); \
    CLOSE(); } while (0)
    DMA_K(0, 0); DMA_V(0, 0); DMA_K(1, 1); DMA_K(2, 2);
    asm volatile("s_waitcnt vmcnt(1)" ::: "memory"); __builtin_amdgcn_s_barrier(); asm volatile("" ::: "memory");
    LDK8(0); QKB(pA0, pA1); SBAR(); LDK8(1); SBAR();
    DMA_K(3, 3); DMA_V(1, 1);
    for (int r = 0; r < 16; ++r) pA0[r] = __builtin_amdgcn_exp2f(pA0[r]);
    CLOSE();
    int j = 1;
    for (; j + 3 < NT; j += 4) { ITERC(pB0, pB1, pA0, pA1, j, 1); ITERC(pA0, pA1, pB0, pB1, j + 1, 2); ITERC(pB0, pB1, pA0, pA1, j + 2, 3); ITERC(pA0, pA1, pB0, pB1, j + 3, 0); }
    const int rem = NT - j;
    if (rem >= 1) ITERC(pB0, pB1, pA0, pA1, j, 1);
    if (rem >= 2) ITERC(pA0, pA1, pB0, pB1, j + 1, 2);
    if (rem >= 3) ITERC(pB0, pB1, pA0, pA1, j + 2, 3);
    { const las_u8* vt_ = ldsl + VR + ((NT - 1) & 3) * 8192; vf0 = LDV8(0, vt_); vf1 = LDV8(1, vt_); vf2 = LDV8(2, vt_); vf3 = LDV8(3, vt_); }
    if (rem == 1 || rem == 3) finishSM8b(pB0, pB1, pa); else finishSM8b(pA0, pA1, pa);
    SBAR(); PVB();
#undef ITERC
#undef LDV01
#undef LDV23
#undef LDK8
#undef QKB
#undef PVB
#undef LDV8
  } else {
    for (int j = 1; j + 1 < NT; j += 2) { ITER(pB0, pB1, alB, pA0, pA1, alA, j); ITER(pA0, pA1, alA, pB0, pB1, alB, j + 1); }
    ITER(pB0, pB1, alB, pA0, pA1, alA, NT - 1);
    finishSM8(pB0, pB1, alB, l_reg, pa); SBAR(); pv8(o, ldsl + VR + vcur * 8192, lane, pa);
  }
  asm volatile("s_waitcnt vmcnt(0)" ::: "memory");
#undef ITER
#undef ROT3
#undef PRV3
#undef DMA_K
#undef DMA_V
#undef CLOSE
  if constexpr (nomax) { if (r32 == 0) {
#pragma unroll
      for (int r = 0; r < 16; ++r) li_l[crow(r, hi)] = osum[r]; } }
  else { if (hi == 0) li_l[r32] = l_reg; }
  asm volatile("s_waitcnt lgkmcnt(0)" ::: "memory");
  float rli[16];
#pragma unroll
  for (int r = 0; r < 16; ++r) rli[r] = __builtin_amdgcn_rcpf(li_l[crow(r, hi)]);
#pragma unroll
  for (int d0 = 0; d0 < 4; ++d0)
#pragma unroll
    for (int r = 0; r < 16; ++r) o[d0][r] *= rli[r];
  __syncthreads();
  las_f32* xch = (las_f32*)ldsl + wq * 4096 + lane;
  if (mp == 1) {
#pragma unroll
    for (int d0 = 0; d0 < 4; ++d0)
#pragma unroll
      for (int r = 0; r < 16; ++r) xch[(d0 * 16 + r) * 64] = o[d0][r]; }
  __syncthreads();
  if (mp == 0) {
    int lane_e = lane; asm volatile("" : "+v"(lane_e));
    const int r32e = lane_e & 31, hie = lane_e >> 5;
    float ssq[16];
#pragma unroll
    for (int r = 0; r < 16; ++r) ssq[r] = 0.f;
#pragma unroll
    for (int d0 = 0; d0 < 4; ++d0)
#pragma unroll
      for (int r = 0; r < 16; ++r) { const float v = o[d0][r] - lam * xch[(d0 * 16 + r) * 64]; o[d0][r] = v; ssq[r] += v * v; }
#pragma unroll
    for (int r = 0; r < 16; ++r) { float s = ssq[r]; s += __shfl_xor(s, 1); s += __shfl_xor(s, 2); s += __shfl_xor(s, 4); s += __shfl_xor(s, 8); s += __shfl_xor(s, 16); ssq[r] = rsqrtf(s * (1.0f / 128.0f) + 1e-6f) * osc; }
    unsigned short* Ow = Ob + (long)(wq * QBLK) * LDOB;
#pragma unroll
    for (int d0 = 0; d0 < 4; ++d0) { const float gsc = subg[d0 * 32 + r32e];
#pragma unroll
      for (int r = 0; r < 16; ++r) { const float v = o[d0][r] * ssq[r] * gsc; const unsigned u = __float_as_uint(v); Ow[(long)crow(r, hie) * LDOB + d0 * 32 + r32e] = (unsigned short)((u + 0x7fffu + ((u >> 16) & 1u)) >> 16); } } }
  __syncthreads();
#undef RESC
}
}
#define GAS __attribute__((address_space(1)))
#define LAS __attribute__((address_space(3)))
typedef unsigned short bf16;
typedef unsigned v4u __attribute__((ext_vector_type(4)));
typedef float f32x4 __attribute__((ext_vector_type(4)));
typedef short bf16x8 __attribute__((ext_vector_type(8)));
typedef GAS unsigned gu32;
typedef GAS unsigned long long gu64;
#define RLX_AGENT __ATOMIC_RELAXED, __HIP_MEMORY_SCOPE_AGENT
#define LDS_WAIT() asm volatile("s_waitcnt lgkmcnt(0)" ::: "memory")
#define VM_WAIT() asm volatile("s_waitcnt vmcnt(0)" ::: "memory")
__device__ __forceinline__ unsigned long long rt() { return __builtin_amdgcn_s_memrealtime(); }
__device__ __forceinline__ unsigned f2bf(float f) { unsigned u = __builtin_bit_cast(unsigned, f); return (u + 0x7fffu + ((u >> 16) & 1u)) >> 16; }
__device__ __forceinline__ unsigned pk2(float lo, float hi) { return f2bf(lo) | (f2bf(hi) << 16); }

#define XB_TMO      128
#define XB_XCNT(j)  (256  + 64 * (j))
#define XB_XSUB(j)  (1280 + 64 * (j))
#define XB_XGEN(j)  (2304 + 64 * (j))
#define XB_TOP      3328
#define XB_TOPGEN   3392
#define XCD_BAR_WORDS 3456
#define XB_SPIN_CAP (1u << 23)

__device__ __forceinline__ unsigned xb_ld(unsigned* p)              { return __hip_atomic_load(p, __ATOMIC_RELAXED, __HIP_MEMORY_SCOPE_AGENT); }
__device__ __forceinline__ unsigned xb_add(unsigned* p, unsigned v) { return __hip_atomic_fetch_add(p, v, __ATOMIC_RELAXED, __HIP_MEMORY_SCOPE_AGENT); }
__device__ __forceinline__ unsigned xb_xcc_id() { return (unsigned)__builtin_amdgcn_s_getreg((3 << 11) | 20) & 0xFu; }
#define XB_SPIN(cond, bar) do { unsigned _sp = 0; while (cond) { __builtin_amdgcn_s_sleep(1); \
    if ((++_sp & 255u) == 0u) { if (xb_ld(&(bar)[XB_TMO])) break; if (_sp > XB_SPIN_CAP) { atomicAdd(&(bar)[XB_TMO], 1u); break; } } } } while (0)

struct XcdBarrier {
    unsigned* bar; unsigned x;
    volatile LAS unsigned* st;
};

__device__ __forceinline__ XcdBarrier xcd_barrier_post(unsigned* bar, volatile LAS unsigned* st) {
    XcdBarrier b; b.bar = bar; b.x = xb_xcc_id(); b.st = st;
    if (threadIdx.x == 0) (void)xb_add(&bar[XB_XCNT(b.x)], 1u);
    return b;
}
__device__ __forceinline__ void xcd_barrier_complete(unsigned* bar, unsigned x, unsigned& nloc, unsigned& nx) {
    const unsigned G = gridDim.x * gridDim.y * gridDim.z;
    unsigned sum, cnt, mine, sp = 0u;
    for (;;) {
        sum = 0u; cnt = 0u; mine = 0u;
#pragma unroll
        for (unsigned j = 0; j < 16; ++j) { const unsigned c = xb_ld(&bar[XB_XCNT(j)]); sum += c; cnt += (c > 0u) ? 1u : 0u; mine = (j == x) ? c : mine; }
        if (sum == G) break;
        __builtin_amdgcn_s_sleep(1);
        if ((++sp & 255u) == 0u) { if (xb_ld(&bar[XB_TMO])) break; if (sp > XB_SPIN_CAP) { atomicAdd(&bar[XB_TMO], 1u); break; } }
    }
    nloc = mine > 0u ? mine : 1u; nx = cnt > 0u ? cnt : 1u;
}

__device__ __forceinline__ void xcd_barrier(const XcdBarrier& b) {
    asm volatile("s_waitcnt vmcnt(0)" ::: "memory");
    __syncthreads();
    if (threadIdx.x == 0) {
        unsigned* bar = b.bar;
        __builtin_amdgcn_s_waitcnt(0);
        unsigned nloc = b.st[0], nx = b.st[1];
        if (nloc == 0u) { xcd_barrier_complete(bar, b.x, nloc, nx); b.st[0] = nloc; b.st[1] = nx; }
        const unsigned old = xb_add(&bar[XB_XSUB(b.x)], 1u);
        const unsigned gen = old / nloc;
        if (old + 1u == (gen + 1u) * nloc) {
            __builtin_amdgcn_fence(__ATOMIC_RELEASE, "agent");
            asm volatile("s_waitcnt vmcnt(0)" ::: "memory");
            const unsigned og = xb_add(&bar[XB_TOP], 1u);
            const unsigned tg = og / nx;
            if (og + 1u == (tg + 1u) * nx) xb_add(&bar[XB_TOPGEN], 1u);
            else XB_SPIN(xb_ld(&bar[XB_TOPGEN]) == tg, bar);
            xb_add(&bar[XB_XGEN(b.x)], 1u);
            __builtin_amdgcn_fence(__ATOMIC_ACQUIRE, "agent");
            asm volatile("s_waitcnt vmcnt(0)" ::: "memory");
        } else {
            XB_SPIN(xb_ld(&bar[XB_XGEN(b.x)]) == gen, bar);
            __builtin_amdgcn_fence(__ATOMIC_ACQUIRE, "agent");
            asm volatile("s_waitcnt vmcnt(0)" ::: "memory");
        }
    }
    __syncthreads();
}
constexpr int DM = 1024, NB = 8, SEQ = 4096, CTX = 256, T = NB * SEQ, TC = NB * CTX, SKV = CTX + SEQ, MROWS = T + TC;
constexpr int NIN = 5120;
constexpr int C_Q = 0, C_K = 512, C_V = 1024, C_HY = 1536, C_G = 3072;
constexpr int NE = 32, TOPK = 4, NA = T * TOPK, NROWS = NA + NE * 256, NBLK = NROWS / 256;
constexpr float EPS = 1e-6f;
enum { IX_X = 0, IX_C, IX_CTX, IX_CCTX, IX_ADAW, IX_ADAB, IX_N1G, IX_N2G, IX_WIN, IX_BIN, IX_QNG, IX_KNG, IX_LQ1, IX_LK1, IX_LQ2, IX_LK2, IX_SUBG,
       IX_CONVW, IX_CONVB, IX_FW1, IX_FB1, IX_FW2, IX_FB2, IX_FW3, IX_FB3, IX_FW4, IX_FFREQ, IX_HBIAS, IX_WUA, IX_WUB, IX_WOUT, IX_RW, IX_RB,
       IX_EW1, IX_EB1, IX_EW2, IX_EB2, N_INPUTS };
constexpr size_t MiB = 1u << 20;
constexpr size_t WS_CTL = 0, CTL_BYTES = 1 * MiB;
constexpr size_t WS_MOD = 1 * MiB;
constexpr size_t WS_LAM = WS_MOD + 256 * 1024;
constexpr size_t WS_ROPEC = WS_LAM + 1024, WS_ROPES = WS_ROPEC + 4096;
constexpr size_t WS_BLKE = WS_ROPES + 4096;
constexpr size_t WS_CNTB = WS_BLKE + 4096;
constexpr size_t WS_TOPE = 2 * MiB, WS_TOPW = WS_TOPE + 512 * 1024, WS_TOKPOS = WS_TOPW + 512 * 1024;
constexpr size_t WS_ROWTOK = WS_TOKPOS + 512 * 1024, WS_ROWW = WS_ROWTOK + 576 * 1024;
static_assert(WS_CNTB + 32768 <= 2 * MiB && WS_ROWW + 576 * 1024 <= 5 * MiB && (size_t)NROWS * 4 <= 576 * 1024, "small tables");
constexpr size_t WS_HF = 6 * MiB;
constexpr size_t WS_WIN = 22 * MiB;
constexpr size_t WS_WIN8 = 670 * MiB;
constexpr int IN8_LO = 0, IN8_HI = 1536;
constexpr size_t WS_WA = 32 * MiB, WS_WB = 33 * MiB, WS_WO = 34 * MiB;
constexpr size_t WS_W1 = 36 * MiB;
constexpr size_t WS_W2 = 164 * MiB;
constexpr size_t WS_ACT0 = 228 * MiB;
constexpr size_t WS_HY = 228 * MiB;
constexpr size_t WS_GT = 324 * MiB;
constexpr size_t WS_PX = WS_ACT0;
constexpr size_t WS_XM = 568 * MiB;
constexpr size_t WS_XM8 = 636 * MiB;
constexpr size_t WS_WG8 = 668 * MiB;
constexpr size_t WS_OATT = 568 * MiB;
constexpr size_t WS_QP = 696 * MiB;
constexpr size_t WS_V8T = 728 * MiB;
constexpr size_t WS_KA = 760 * MiB, WS_VA = 794 * MiB;
constexpr size_t WS_U = 828 * MiB;
constexpr size_t WS_UT = 828 * MiB, WS_YT = 860 * MiB;
constexpr size_t WS_CP = 956 * MiB;
constexpr size_t WS_OAB = 892 * MiB;
constexpr size_t WS_SSQ = 228 * MiB;
constexpr size_t WS_OB = 892 * MiB, WS_OA = 924 * MiB;
constexpr size_t WS_TA = 696 * MiB;
constexpr size_t WS_TB = 568 * MiB;
constexpr size_t WS_MB = 828 * MiB;
constexpr size_t WS_TM = 696 * MiB;
constexpr size_t WS_H = 568 * MiB;
constexpr size_t WS_HS = 228 * MiB;
constexpr size_t WS_ACT = 860 * MiB;
constexpr size_t WS_Y = 568 * MiB;
constexpr size_t WS_END = 1020 * MiB;
constexpr int CW_CNT = 0;
constexpr int CW_BAR = 4096;
constexpr int CW_NMAX = 1024;
constexpr int RING_BYTES = 131072, MISC_OFF = RING_BYTES + 320, LDS_BYTES = 163840;
constexpr int NWAVES = 8, NTHREADS = 512;

typedef __attribute__((address_space(3))) float lds_f32;
__device__ __forceinline__ float bf2f(bf16 v) { return __builtin_bit_cast(float, (unsigned)v << 16); }
__device__ __forceinline__ float wave_sum(float v) {
#pragma unroll
    for (int o = 1; o < 64; o <<= 1) v += __shfl_xor(v, o);
    return v;
}
__device__ __forceinline__ float sigmoidf_(float x) { return 1.0f / (1.0f + __expf(-x)); }

struct Ctx {
    float* out; unsigned char* ws;
    LAS unsigned char* lds; char* ldsg;
    int tid, lane, wave, gwave, nwaves, gtid, gthreads;
};
#define WSP(T_, off) ((T_*)(C.ws + (off)))
#define INP(i) (((const float* const __attribute__((address_space(4)))*)__builtin_amdgcn_kernarg_segment_ptr())[i])

__device__ __forceinline__ void tr_item(const float* W, int N, bf16* WT, int Kout, int k0, int n0, int orow0, LAS float* scr, int lane, bool perm = false) {
    { const int kr = lane >> 3, c4 = (lane & 7) * 4; f32x4 v[8];
#pragma unroll
      for (int i = 0; i < 8; ++i) v[i] = *(const f32x4*)(W + (size_t)(k0 + 8 * i + kr) * N + n0 + c4);
#pragma unroll
      for (int i = 0; i < 8; ++i) { LAS float* d = scr + (8 * i + kr) * 33 + c4; d[0] = v[i].x; d[1] = v[i].y; d[2] = v[i].z; d[3] = v[i].w; } }
    LDS_WAIT(); asm volatile("" ::: "memory");
    const int c = lane & 7;
#pragma unroll
    for (int j = 0; j < 4; ++j) { const int n = (lane >> 3) + 8 * j; const LAS float* s = scr + (8 * c) * 33 + n;
        v4u o; o.x = pk2(s[0 * 33], s[1 * 33]); o.y = pk2(s[2 * 33], s[3 * 33]); o.z = pk2(s[4 * 33], s[5 * 33]); o.w = pk2(s[6 * 33], s[7 * 33]);
        const int nr = perm ? (16 * ((n >> 2) & 1) + 4 * (n >> 3) + (n & 3)) : n;
        *(v4u*)(WT + (size_t)(orow0 + nr) * Kout + k0 + 8 * c) = o; }
    LDS_WAIT(); asm volatile("" ::: "memory");
}
__device__ __forceinline__ void tr_item8(const float* W, int N, unsigned char* WT, int Kout, int k0, int n0, int orow0, LAS float* scr, int lane, float mul, bool perm = false) {
    { const int kr = lane >> 3, c4 = (lane & 7) * 4; f32x4 v[8];
#pragma unroll
      for (int i = 0; i < 8; ++i) v[i] = *(const f32x4*)(W + (size_t)(k0 + 8 * i + kr) * N + n0 + c4);
#pragma unroll
      for (int i = 0; i < 8; ++i) { LAS float* d = scr + (8 * i + kr) * 33 + c4; d[0] = v[i].x; d[1] = v[i].y; d[2] = v[i].z; d[3] = v[i].w; } }
    LDS_WAIT(); asm volatile("" ::: "memory");
    const int c = lane & 7;
#pragma unroll
    for (int j = 0; j < 4; ++j) { const int n = (lane >> 3) + 8 * j; const LAS float* s = scr + (8 * c) * 33 + n;
        const unsigned lo = pg8::pk4_fp8(s[0 * 33] * mul, s[1 * 33] * mul, s[2 * 33] * mul, s[3 * 33] * mul), hi = pg8::pk4_fp8(s[4 * 33] * mul, s[5 * 33] * mul, s[6 * 33] * mul, s[7 * 33] * mul);
        const int nr = perm ? (16 * ((n >> 2) & 1) + 4 * (n >> 3) + (n & 3)) : n;
        *(unsigned long long*)(WT + (size_t)(orow0 + nr) * Kout + k0 + 8 * c) = (unsigned long long)lo | ((unsigned long long)hi << 32); }
    LDS_WAIT(); asm volatile("" ::: "memory");
}
struct PrepItem { const float* src; unsigned char* dst; int N, k0, n0, orow0, fl, g1; };
__device__ __forceinline__ void prep_decode(const Ctx& C, int r, PrepItem& p) {
    constexpr int I_INB = 16 * 96, I_ING = 8 * 32, I_INF = 8 * ((IN8_HI - IN8_LO) / 64), I_A = 8 * 32, I_O = 16 * 32, I_E1 = 8 * 32, I_E2 = 8 * 16;
    p.g1 = 32;
    if (r < I_INB) { const int kb = r / 96, nb = r % 96; const int L0 = 32 * nb, pn = L0 >> 8;
        p.src = INP(IX_WIN); p.N = NIN; p.k0 = 64 * kb; p.n0 = L0; p.dst = WSP(unsigned char, WS_WIN);
        p.orow0 = pn < 4 ? (256 * pn + 128 * ((L0 >> 5) & 1) + 32 * ((L0 >> 6) & 3)) : L0; p.fl = pn >= 4 ? 2 : 0; return; } r -= I_INB;
    if (r < I_ING) { const int kb = r / 32, nb = r % 32; p.src = INP(IX_WIN); p.N = NIN; p.k0 = 128 * kb; p.n0 = 3072 + 64 * nb; p.dst = WSP(unsigned char, WS_WIN8); p.orow0 = 3072 + 64 * nb; p.fl = 3; return; } r -= I_ING;
    if (r < I_INF) { constexpr int NBF = (IN8_HI - IN8_LO) / 64; const int kb = r / NBF, nb = r % NBF; const int L0 = IN8_LO + 64 * nb, pn = L0 >> 8;
        p.src = INP(IX_WIN); p.N = NIN; p.k0 = 128 * kb; p.n0 = L0; p.dst = WSP(unsigned char, WS_WIN8);
        if (pn < 4) { p.orow0 = 256 * pn + 32 * ((L0 >> 6) & 3); p.fl = 1; p.g1 = 128; } else { p.orow0 = L0; p.fl = 3; }
        return; } r -= I_INF;
    if (r < 2 * I_A) { const int hb = r >= I_A; if (hb) r -= I_A; const int kb = r / 32, nb = r % 32;
        p.src = hb ? INP(IX_WUB) : INP(IX_WUA); p.N = 1024; p.k0 = 64 * kb; p.n0 = 32 * nb; p.dst = WSP(unsigned char, WS_WA) + (hb ? 1024 : 0); p.orow0 = 32 * nb; p.fl = 0; return; } r -= 2 * I_A;
    if (r < I_O) { const int kb = r / 32, nb = r % 32; p.src = INP(IX_WOUT); p.N = 1024; p.k0 = 64 * kb; p.n0 = 32 * nb; p.dst = WSP(unsigned char, WS_WO); p.orow0 = 32 * nb; p.fl = 0; return; } r -= I_O;
    if (r < NE * I_E1) { const int e = r / I_E1, q = r % I_E1, kb = q / 32, nb = q % 32; const int L0 = 64 * nb, half = L0 >> 10, ch = L0 & 1023;
        p.src = INP(IX_EW1) + (size_t)e * 1024 * 2048; p.N = 2048; p.k0 = 128 * kb; p.n0 = L0; p.dst = WSP(unsigned char, WS_W1) + (size_t)e * 2048 * 1024; p.orow0 = (ch >> 7) * 256 + half * 128 + (ch & 127); p.fl = 1; return; }
    r -= NE * I_E1;
    { const int e = r / I_E2, q = r % I_E2, kb = q / 16, nb = q % 16;
      p.src = INP(IX_EW2) + (size_t)e * 1024 * 1024; p.N = 1024; p.k0 = 128 * kb; p.n0 = 64 * nb; p.dst = WSP(unsigned char, WS_W2) + (size_t)e * 1024 * 1024; p.orow0 = 64 * nb; p.fl = 1; }
}
constexpr int PREP_N0 = 16 * 96 + 8 * 32 + 8 * ((IN8_HI - IN8_LO) / 64) + 2 * 8 * 32 + 16 * 32, PREP_NIT = PREP_N0 + NE * (8 * 32 + 8 * 16);
__device__ __forceinline__ void ph_prep_weights(const Ctx& C, int lo, int hi) {
    LAS float* scr = (LAS float*)(C.lds + C.wave * 16384);
    const int lane = C.lane;
    for (int it = lo + C.gwave; it < hi; it += C.nwaves) {
        PrepItem p; prep_decode(C, it, p);
        if (p.fl & 1) {
            const int kq = lane >> 4, c = lane & 15;
            const float* src = p.src + (size_t)(p.k0 + 32 * kq) * p.N + p.n0 + 4 * c;
            LAS unsigned char* sb = (LAS unsigned char*)scr;
#pragma unroll
            for (int h = 0; h < 2; ++h) { f32x4 v[16];
#pragma unroll
                for (int i = 0; i < 16; ++i) v[i] = *(const f32x4*)(src + (size_t)(16 * h + i) * p.N);
#pragma unroll
                for (int e = 0; e < 4; ++e) { v4u o;
                    o.x = pg8::pk4_fp8(v[0][e] * 32.0f, v[1][e] * 32.0f, v[2][e] * 32.0f, v[3][e] * 32.0f); o.y = pg8::pk4_fp8(v[4][e] * 32.0f, v[5][e] * 32.0f, v[6][e] * 32.0f, v[7][e] * 32.0f);
                    o.z = pg8::pk4_fp8(v[8][e] * 32.0f, v[9][e] * 32.0f, v[10][e] * 32.0f, v[11][e] * 32.0f); o.w = pg8::pk4_fp8(v[12][e] * 32.0f, v[13][e] * 32.0f, v[14][e] * 32.0f, v[15][e] * 32.0f);
                    *(LAS v4u*)(sb + (4 * c + e) * 144 + 32 * kq + 16 * h) = o; } }
            LDS_WAIT(); asm volatile("" ::: "memory");
#pragma unroll
            for (int j = 0; j < 8; ++j) { const int n = (lane >> 3) + 8 * j, ch = lane & 7; const v4u o = *(const LAS v4u*)(sb + n * 144 + 16 * ch);
                const int n32 = n & 31, nr = (p.fl & 2) ? (16 * ((n32 >> 2) & 1) + 4 * (n32 >> 3) + (n32 & 3)) : n32;
                *(v4u*)(p.dst + (size_t)(p.orow0 + ((n & 32) ? p.g1 : 0) + nr) * 1024 + p.k0 + 16 * ch) = o; }
        } else {
            const int kr = lane >> 3, c4 = (lane & 7) * 4;
            f32x4 v[8];
#pragma unroll
            for (int i = 0; i < 8; ++i) v[i] = *(const f32x4*)(p.src + (size_t)(p.k0 + 8 * i + kr) * p.N + p.n0 + c4);
#pragma unroll
            for (int i = 0; i < 8; ++i) { LAS float* d = scr + (8 * i + kr) * 33 + c4; d[0] = v[i].x; d[1] = v[i].y; d[2] = v[i].z; d[3] = v[i].w; }
            LDS_WAIT(); asm volatile("" ::: "memory");
            const int c = lane & 7;
#pragma unroll
            for (int j = 0; j < 4; ++j) { const int n = (lane >> 3) + 8 * j; const LAS float* s = scr + (8 * c) * 33 + n;
                v4u o; o.x = pk2(s[0 * 33], s[1 * 33]); o.y = pk2(s[2 * 33], s[3 * 33]); o.z = pk2(s[4 * 33], s[5 * 33]); o.w = pk2(s[6 * 33], s[7 * 33]);
                const int nr = (p.fl & 2) ? (16 * ((n >> 2) & 1) + 4 * (n >> 3) + (n & 3)) : n;
                *(v4u*)((bf16*)p.dst + (size_t)(p.orow0 + nr) * 1024 + p.k0 + 8 * c) = o; }
        }
        LDS_WAIT(); asm volatile("" ::: "memory");
    }
}
__device__ __forceinline__ void ph_prep_ada(const Ctx& C) {
    LAS float* s = (LAS float*)C.lds;
    LAS float* red = s + 9 * 1024;
    const float* W = INP(IX_ADAW); float* MOD = WSP(float, WS_MOD);
    for (int g = blockIdx.x; g < 192; g += gridDim.x) {
        __syncthreads();
        { float cv[18];
#pragma unroll
          for (int u = 0; u < 18; ++u) { const int i = C.tid + u * NTHREADS, r = i >> 10, k = i & 1023; cv[u] = r < 8 ? INP(IX_C)[r * 1024 + k] : INP(IX_CCTX)[k]; }
#pragma unroll
          for (int u = 0; u < 18; ++u) s[C.tid + u * NTHREADS] = cv[u] / (1.0f + __expf(-cv[u])); }
        __syncthreads();
        float acc[9];
#pragma unroll
        for (int r = 0; r < 9; ++r) acc[r] = 0.f;
        const int col = 32 * g + (C.lane & 31), kp = C.wave * 2 + (C.lane >> 5);
#pragma unroll 4
        for (int k = 64 * kp; k < 64 * kp + 64; ++k) { const float wv = W[(size_t)k * 6144 + col];
#pragma unroll
            for (int r = 0; r < 9; ++r) acc[r] += s[r * 1024 + k] * wv; }
#pragma unroll
        for (int r = 0; r < 9; ++r) red[(kp * 9 + r) * 32 + (C.lane & 31)] = acc[r];
        __syncthreads();
        for (int i = C.tid; i < 9 * 32; i += NTHREADS) { const int r = i >> 5, l = i & 31; float a = 0.f;
#pragma unroll
            for (int w = 0; w < 16; ++w) a += red[(w * 9 + r) * 32 + l];
            MOD[r * 6144 + 32 * g + l] = a + INP(IX_ADAB)[32 * g + l]; }
    }
    __syncthreads();
}
__device__ __forceinline__ void ph_prep_misc(const Ctx& C) {
    if (blockIdx.x == gridDim.x - 1) {
        if (C.wave == 0) { const float a = wave_sum(INP(IX_LQ1)[C.lane] * INP(IX_LK1)[C.lane]), b = wave_sum(INP(IX_LQ2)[C.lane] * INP(IX_LK2)[C.lane]);
            if (C.lane == 0) *WSP(float, WS_LAM) = expf(a) - expf(b) + 0.2f;
            float gq = fabsf(INP(IX_QNG)[C.lane]), gk = fabsf(INP(IX_KNG)[C.lane]);
#pragma unroll
            for (int o = 1; o < 64; o <<= 1) { gq = fmaxf(gq, __shfl_xor(gq, o)); gk = fmaxf(gk, __shfl_xor(gk, o)); }
            if (C.lane == 0) WSP(float, WS_LAM)[1] = 11.541560327111707f * gq * gk + 0.5f; }
        for (int i = C.tid; i < 64 * 16; i += NTHREADS) { const int p = i >> 4, f = i & 15; const double fr = pow(10000.0, -(double)f / 16.0), ang = (double)p * fr;
            WSP(float, WS_ROPEC)[i] = (float)cos(ang); WSP(float, WS_ROPES)[i] = (float)sin(ang); }
    }
}
__device__ __forceinline__ void ph_prep_filter(const Ctx& C) {
    LAS float* sc = (LAS float*)(C.lds + C.wave * 4096);
    LAS float* wl = (LAS float*)(C.lds + 32768);
    float* HF = WSP(float, WS_HF);
    const float* w4 = INP(IX_FW4);
    const int lane = C.lane; const float fq = INP(IX_FFREQ)[lane];
    for (int i = C.gtid; i < 512; i += C.gthreads) HF[i] = 0.f;
    __syncthreads();
    { const float* w1 = INP(IX_FW1); const float* w2 = INP(IX_FW2); const float* w3 = INP(IX_FW3);
      for (int i = C.tid; i < (33 + 64 + 64) * 16; i += NTHREADS) { const int e = 4 * i; const float* src = e < 33 * 64 ? w1 + e : (e < 97 * 64 ? w2 + (e - 33 * 64) : w3 + (e - 97 * 64));
          const f32x4 v = *(const f32x4*)src; LAS float* d = wl + e; d[0] = v.x; d[1] = v.y; d[2] = v.z; d[3] = v.w; } }
    __syncthreads();
    const float lo = logf(0.01f) / 1.5f, hi = logf(0.01f) / 0.3f;
    for (int pb = blockIdx.x; pb < SEQ / 16; pb += gridDim.x) {
        const int n0 = 16 * pb + 2 * C.wave;
#pragma unroll
        for (int p = 0; p < 2; ++p) { const int n = n0 + p; float zv = 0.f;
            if (lane == 0) zv = (float)n / 4095.0f;
            else if (lane <= 32) { const int i = (lane - 1) & 15; const double f = 1e-4 + (double)i * ((15.0 - 1e-4) / 15.0); const double ang = f * (6.283185307179586 * (double)n / 4096.0);
                zv = lane <= 16 ? (float)cos(ang) : -(float)sin(ang); }
            sc[p * 256 + lane] = zv; }
        LDS_WAIT();
        float a0, a1;
        a0 = a1 = INP(IX_FB1)[lane];
#pragma unroll 11
        for (int i = 0; i < 33; ++i) { const float wv = wl[i * 64 + lane]; a0 += sc[i] * wv; a1 += sc[256 + i] * wv; }
        sc[64 + lane] = sinf(fq * a0); sc[256 + 64 + lane] = sinf(fq * a1); LDS_WAIT();
        a0 = a1 = INP(IX_FB2)[lane];
#pragma unroll 16
        for (int i = 0; i < 64; ++i) { const float wv = wl[(33 + i) * 64 + lane]; a0 += sc[64 + i] * wv; a1 += sc[256 + 64 + i] * wv; }
        sc[128 + lane] = sinf(fq * a0); sc[256 + 128 + lane] = sinf(fq * a1); LDS_WAIT();
        a0 = a1 = INP(IX_FB3)[lane];
#pragma unroll 16
        for (int i = 0; i < 64; ++i) { const float wv = wl[(97 + i) * 64 + lane]; a0 += sc[128 + i] * wv; a1 += sc[256 + 128 + i] * wv; }
        sc[192 + lane] = sinf(fq * a0); sc[256 + 192 + lane] = sinf(fq * a1);
        __syncthreads();
        float acc0[16], acc1[16];
#pragma unroll
        for (int q = 0; q < 16; ++q) { acc0[q] = 0.f; acc1[q] = 0.f; }
        const int o0 = 128 * C.wave + lane;
#pragma unroll 1
        for (int j0 = 0; j0 < 64; j0 += 16) { float wa[16], wb[16];
#pragma unroll
            for (int j = 0; j < 16; ++j) { wa[j] = w4[(j0 + j) * 1024 + o0]; wb[j] = w4[(j0 + j) * 1024 + o0 + 64]; }
#pragma unroll
            for (int q = 0; q < 16; ++q) { const LAS float* hq = (const LAS float*)(C.lds + (q >> 1) * 4096 + (q & 1) * 1024) + 192 + j0;
#pragma unroll
                for (int j4 = 0; j4 < 16; j4 += 4) { const f32x4 h = *(const LAS f32x4*)(hq + j4);
                    acc0[q] += h.x * wa[j4] + h.y * wa[j4 + 1] + h.z * wa[j4 + 2] + h.w * wa[j4 + 3]; acc1[q] += h.x * wb[j4] + h.y * wb[j4 + 1] + h.z * wb[j4 + 2] + h.w * wb[j4 + 3]; } } }
#pragma unroll
        for (int cc = 0; cc < 2; ++cc) { const int o = o0 + 64 * cc, dir = o >> 9, c = o & 511; const float dl = fabsf(lo + (hi - lo) * ((float)c / 511.0f)); const float hb = INP(IX_HBIAS)[c];
#pragma unroll
            for (int q = 0; q < 16; ++q) { const int n = 16 * pb + q; const float tn = (float)n / 4095.0f;
                float v = (cc ? acc1[q] : acc0[q]) * expf(-tn * dl);
                if (dir == 0) { if (n == 0) v += hb; HF[(size_t)(4096 + n) * 512 + c] = v; }
                else if (n > 0) HF[(size_t)(4096 - n) * 512 + c] = v; } }
        __syncthreads();
    }
}
__device__ __forceinline__ void ph_modulate1(const Ctx& C) {
    const float* MOD = WSP(float, WS_MOD); bf16* XM = WSP(bf16, WS_XM); unsigned char* XM8 = WSP(unsigned char, WS_XM8);
    LAS float* ml = (LAS float*)C.lds; LAS float* gl = ml + 9 * 2048;
    for (int i = C.tid; i < 9 * 2048; i += NTHREADS) { const int rr = i >> 11, j = i & 2047; const float v = MOD[rr * 6144 + j]; ml[i] = j < 1024 ? v : v + 1.0f; }
    for (int i = C.tid; i < 1024; i += NTHREADS) gl[i] = INP(IX_N1G)[i];
    __syncthreads();
#define M1_LOAD(V, R0) do { _Pragma("unroll") for (int q_ = 0; q_ < 2; ++q_) { int r_ = (R0) + q_ * C.nwaves; r_ = r_ < MROWS ? r_ : MROWS - 1; \
        const float* xr_ = r_ < T ? INP(IX_X) + (size_t)r_ * DM : INP(IX_CTX) + (size_t)(r_ - T) * DM; \
        _Pragma("unroll") for (int j_ = 0; j_ < 4; ++j_) V[q_][j_] = __builtin_nontemporal_load((const f32x4*)(xr_ + 4 * C.lane + 256 * j_)); } } while (0)
    f32x4 v[2][4], w[2][4];
    int r0 = C.gwave;
    M1_LOAD(v, r0);
    for (; r0 < MROWS; r0 += 2 * C.nwaves) {
        M1_LOAD(w, r0 + 2 * C.nwaves);
#pragma unroll
        for (int q = 0; q < 2; ++q) { const int r = r0 + q * C.nwaves; if (r < MROWS) {
            const LAS float* mrow = ml + (r < T ? (r >> 12) : 8) * 2048;
            float ss = 0.f;
#pragma unroll
            for (int j = 0; j < 4; ++j) ss += (v[q][j].x * v[q][j].x + v[q][j].y * v[q][j].y) + (v[q][j].z * v[q][j].z + v[q][j].w * v[q][j].w);
            const float rstd = rsqrtf(wave_sum(ss) * (1.0f / DM) + EPS);
#pragma unroll
            for (int j = 0; j < 4; ++j) { const int col = 4 * C.lane + 256 * j; const f32x4 gg = *(const LAS f32x4*)(gl + col), sh = *(const LAS f32x4*)(mrow + col), sc = *(const LAS f32x4*)(mrow + 1024 + col);
                const f32x4 y = v[q][j] * rstd * gg * sc + sh;
                *(unsigned long long*)(XM + (size_t)r * DM + col) = (unsigned long long)pk2(y.x, y.y) | ((unsigned long long)pk2(y.z, y.w) << 32);
                if (r < T) *(unsigned*)(XM8 + (size_t)r * DM + col) = pg8::pk4_fp8(y.x, y.y, y.z, y.w); } } }
#pragma unroll
        for (int q = 0; q < 2; ++q)
#pragma unroll
            for (int j = 0; j < 4; ++j) v[q][j] = w[q][j];
    }
#undef M1_LOAD
    __syncthreads();
}
__device__ __forceinline__ void ph_post_proj(const Ctx& C) {
    const bf16* PX = WSP(bf16, WS_PX); bf16* QP = WSP(bf16, WS_QP); bf16* KA = WSP(bf16, WS_KA); bf16* VA = WSP(bf16, WS_VA); float* U = WSP(float, WS_U);
    const float* RC = WSP(float, WS_ROPEC); const float* RS = WSP(float, WS_ROPES);
    const int lane = C.lane;
    for (int it = C.gwave; it < T * 16 + TC * 8; it += C.nwaves) {
        int r, which, h, m, rc = 0; bool latent;
        if (it < T * 16) { r = it >> 4; const int v = it & 15; which = v >> 3; h = (v >> 1) & 3; m = v & 1; latent = true; }
        else { const int j = it - T * 16; rc = j >> 3; const int v = j & 7; which = 1; h = v >> 1; m = v & 1; r = T + rc; latent = false; }
        const float x = bf2f(PX[(size_t)r * NIN + which * 512 + h * 128 + m * 64 + lane]);
        const float rstd = rsqrtf(wave_sum(x * x) * (1.0f / 64.0f) + EPS);
        float y = x * rstd * (which ? INP(IX_KNG)[lane] : INP(IX_QNG)[lane]);
        const int t = r & 4095;
        if (latent) { const int axis = lane >> 5, half = (lane >> 4) & 1, f = lane & 15, pos = axis ? (t & 63) : (t >> 6);
            const float cs = RC[pos * 16 + f], sn = RS[pos * 16 + f]; const float pr = __shfl_xor(y, 16);
            y = half == 0 ? y * cs - pr * sn : y * cs + pr * sn; }
        if (which == 0) { const size_t base = ((size_t)r * 8 + (h * 2 + m)) * 128; QP[base + m * 64 + lane] = (bf16)f2bf(y); QP[base + (1 - m) * 64 + lane] = 0; }
        else { const size_t krow = latent ? (size_t)(r >> 12) * SKV + CTX + t : (size_t)(rc >> 8) * SKV + (rc & 255); KA[krow * 512 + h * 128 + m * 64 + lane] = (bf16)f2bf(y); }
    }
    for (int i = C.gtid; i < MROWS * 64; i += C.gthreads) { const int r = i >> 6, ch = i & 63;
        const size_t vrow = r < T ? (size_t)(r >> 12) * SKV + CTX + (r & 4095) : (size_t)((r - T) >> 8) * SKV + ((r - T) & 255);
        *(v4u*)(VA + vrow * 512 + ch * 8) = *(const v4u*)(PX + (size_t)r * NIN + C_V + ch * 8); }
    const float* cw = INP(IX_CONVW); const float* cb = INP(IX_CONVB);
    for (int i = C.gtid; i < T * 512; i += C.gthreads) { const int r = i >> 9, c = i & 511, t = r & 4095; float z[2];
#pragma unroll
        for (int gsel = 0; gsel < 2; ++gsel) { const int chn = 512 * (gsel + 1) + c; const bf16* p = PX + (size_t)r * NIN + C_HY + chn;
            const float xm = t > 0 ? bf2f(p[-NIN]) : 0.f, x0 = bf2f(p[0]), xp = t < 4095 ? bf2f(p[NIN]) : 0.f;
            z[gsel] = xm * cw[chn] + x0 * cw[1536 + chn] + xp * cw[3072 + chn] + cb[chn]; }
        U[i] = z[0] * z[1]; }
}
__device__ __forceinline__ void ph_hyena_naive(const Ctx& C) {
    const float* U = WSP(float, WS_U); const float* HF = WSP(float, WS_HF); const bf16* PX = WSP(bf16, WS_PX); bf16* OB = WSP(bf16, WS_OB);
    const float* cw = INP(IX_CONVW); const float* cb = INP(IX_CONVB);
    for (int i = C.gtid; i < T * 512 / 8; i += C.gthreads) {
        const int c = i & 511, tg = i >> 9, b = tg >> 9, t0 = (tg & 511) * 8;
        float acc[8], tap[8];
#pragma unroll
        for (int j = 0; j < 8; ++j) { acc[j] = 0.f; tap[j] = HF[(size_t)(t0 + j + 4096) * 512 + c]; }
        const float* up = U + (size_t)b * SEQ * 512 + c; const float* hp = HF + (size_t)(t0 + 4095) * 512 + c;
        for (int s = 0; s < SEQ; ++s) { const float uv = up[(size_t)s * 512]; const float nt = hp[-(long)s * 512];
#pragma unroll
            for (int j = 0; j < 8; ++j) acc[j] += uv * tap[j];
#pragma unroll
            for (int j = 7; j > 0; --j) tap[j] = tap[j - 1];
            tap[0] = nt; }
#pragma unroll
        for (int j = 0; j < 8; ++j) { const int t = t0 + j; const size_t r = (size_t)b * SEQ + t; const bf16* p = PX + r * NIN + C_HY + c;
            const float xm = t > 0 ? bf2f(p[-NIN]) : 0.f, x0 = bf2f(p[0]), xp = t < 4095 ? bf2f(p[NIN]) : 0.f;
            const float z0 = xm * cw[c] + x0 * cw[1536 + c] + xp * cw[3072 + c] + cb[c];
            OB[r * 512 + c] = (bf16)f2bf(z0 * acc[j]); }
    }
}
__device__ __forceinline__ void ph_attn_post(const Ctx& C) {
    const float* O = WSP(float, WS_OATT); bf16* OA = WSP(bf16, WS_OA); const float lam = *WSP(float, WS_LAM); const float* sg = INP(IX_SUBG);
    for (int it = C.gwave; it < T * 4; it += C.nwaves) { const int r = it >> 2, h = it & 3; const float* p = O + (size_t)r * 1024 + h * 256 + C.lane;
        const float o0 = p[0] - lam * p[128], o1 = p[64] - lam * p[192];
        const float rstd = rsqrtf(wave_sum(o0 * o0 + o1 * o1) * (1.0f / 128.0f) + EPS);
        OA[(size_t)r * 512 + h * 128 + C.lane] = (bf16)f2bf(o0 * rstd * sg[C.lane] * 0.8f); OA[(size_t)r * 512 + h * 128 + 64 + C.lane] = (bf16)f2bf(o1 * rstd * sg[64 + C.lane] * 0.8f); }
}
__device__ __forceinline__ void ph_gate(const Ctx& C) {
    const float* TA = WSP(float, WS_TA); const float* TB = WSP(float, WS_TB); const bf16* GT = WSP(bf16, WS_GT); bf16* MB = WSP(bf16, WS_MB);
    for (int i = C.gtid; i < T * 256; i += C.gthreads) { const int r = i >> 8, c = (i & 255) * 4; const f32x4 a = *(const f32x4*)(TA + (size_t)r * 1024 + c), b = *(const f32x4*)(TB + (size_t)r * 1024 + c);
        const bf16* g = GT + (size_t)r * 2048 + c; float o[4];
#pragma unroll
        for (int e = 0; e < 4; ++e) o[e] = bf2f(g[e]) * a[e] + bf2f(g[1024 + e]) * b[e];
        *(unsigned long long*)(MB + (size_t)r * 1024 + c) = (unsigned long long)pk2(o[0], o[1]) | ((unsigned long long)pk2(o[2], o[3]) << 32); }
}
__device__ __forceinline__ void ph_router(const Ctx& C) {
    const float* MOD = WSP(float, WS_MOD); const float* TM = WSP(float, WS_TM); bf16* H = WSP(bf16, WS_H); const float* g2n = INP(IX_N2G); const float* RW = INP(IX_RW);
    int* TOPE = WSP(int, WS_TOPE); float* TOPW = WSP(float, WS_TOPW); unsigned* CNT = WSP(unsigned, WS_CTL) + CW_CNT;
    LAS unsigned* hist = (LAS unsigned*)C.lds;
    if (C.tid < 32) hist[C.tid] = 0u;
    __syncthreads();
    for (int r = C.gwave; r < T; r += C.nwaves) {
        const float* mrow = MOD + (r >> 12) * 6144;
        f32x4 v[4]; float ss = 0.f;
#pragma unroll
        for (int j = 0; j < 4; ++j) { const int col = 4 * C.lane + 256 * j; const f32x4 x = *(const f32x4*)(INP(IX_X) + (size_t)r * DM + col), tm = *(const f32x4*)(TM + (size_t)r * DM + col), g1 = *(const f32x4*)(mrow + 2048 + col);
            v[j] = x + g1 * tm; *(f32x4*)(C.out + (size_t)r * DM + col) = v[j]; ss += (v[j].x * v[j].x + v[j].y * v[j].y) + (v[j].z * v[j].z + v[j].w * v[j].w); }
        const float rstd = rsqrtf(wave_sum(ss) * (1.0f / DM) + EPS);
        f32x4 y[4];
#pragma unroll
        for (int j = 0; j < 4; ++j) { const int col = 4 * C.lane + 256 * j; const f32x4 gg = *(const f32x4*)(g2n + col), sh = *(const f32x4*)(mrow + 3072 + col), sc = *(const f32x4*)(mrow + 4096 + col);
            y[j] = v[j] * rstd * gg * (sc + 1.0f) + sh;
            *(unsigned long long*)(H + (size_t)r * DM + col) = (unsigned long long)pk2(y[j].x, y[j].y) | ((unsigned long long)pk2(y[j].z, y[j].w) << 32); }
        LAS float* lg = (LAS float*)(C.lds + 1024) + C.wave * 32;
#pragma unroll 1
        for (int e = 0; e < 32; ++e) { float a = 0.f;
#pragma unroll
            for (int j = 0; j < 4; ++j) { const float* wr = RW + (size_t)(4 * C.lane + 256 * j) * 32 + e; a += y[j].x * wr[0] + y[j].y * wr[32] + y[j].z * wr[64] + y[j].w * wr[96]; }
            a = wave_sum(a) + INP(IX_RB)[e];
            if (C.lane == 0) lg[e] = a; }
        LDS_WAIT();
        float p[32];
#pragma unroll
        for (int e = 0; e < 32; ++e) p[e] = lg[e];
        unsigned taken = 0u; float tv[4]; int ti[4];
#pragma unroll
        for (int k = 0; k < 4; ++k) { float best = -INFINITY; int bi = 0;
#pragma unroll
            for (int e = 0; e < 32; ++e) { const bool ok = !((taken >> e) & 1u) && p[e] > best; best = ok ? p[e] : best; bi = ok ? e : bi; }
            taken |= 1u << bi; tv[k] = best; ti[k] = bi; }
        const float e1 = __expf(tv[1] - tv[0]), e2 = __expf(tv[2] - tv[0]), e3 = __expf(tv[3] - tv[0]); const float inv = 1.0f / (1.0f + e1 + e2 + e3);
        if (C.lane == 0) { *(int4*)(TOPE + (size_t)r * 4) = make_int4(ti[0], ti[1], ti[2], ti[3]); *(f32x4*)(TOPW + (size_t)r * 4) = (f32x4){inv, e1 * inv, e2 * inv, e3 * inv};
            atomicAdd((unsigned*)&hist[ti[0]], 1u); atomicAdd((unsigned*)&hist[ti[1]], 1u); atomicAdd((unsigned*)&hist[ti[2]], 1u); atomicAdd((unsigned*)&hist[ti[3]], 1u); }
    }
    __syncthreads();
    if (C.tid < 32) atomicAdd(CNT + C.tid, hist[C.tid]);
}
__device__ __forceinline__ void ph_sort(const Ctx& C) {
    const unsigned* CNT = WSP(unsigned, WS_CTL) + CW_CNT; const int* TOPE = WSP(int, WS_TOPE); const float* TOPW = WSP(float, WS_TOPW);
    int* TOKPOS = WSP(int, WS_TOKPOS); int* ROWTOK = WSP(int, WS_ROWTOK); float* ROWW = WSP(float, WS_ROWW); int* BLKE = WSP(int, WS_BLKE);
    LAS int* wtot = (LAS int*)C.lds;
    for (int e = blockIdx.x; e < NE; e += gridDim.x) {
        int pstart = 0, cnt = 0, padded = 0;
        for (int i = 0; i <= e; ++i) { pstart += padded; cnt = (int)__hip_atomic_load(CNT + i, __ATOMIC_RELAXED, __HIP_MEMORY_SCOPE_AGENT); padded = (cnt + 255) / 256 * 256; }
        int running = 0;
        for (int a0 = 0; a0 < NA; a0 += NTHREADS) { const int a = a0 + C.tid; const bool flag = TOPE[a] == e;
            const unsigned long long bal = __ballot(flag); const int pre = __popcll(bal & ((1ull << C.lane) - 1ull)), tot = __popcll(bal);
            __syncthreads();
            if (C.lane == 0) wtot[C.wave] = tot;
            __syncthreads();
            int woff = 0, all = 0;
#pragma unroll
            for (int w = 0; w < 8; ++w) { const int x = wtot[w]; woff += (w < C.wave) ? x : 0; all += x; }
            if (flag) { const int pos = pstart + running + woff + pre; ROWTOK[pos] = a >> 2; ROWW[pos] = TOPW[a]; TOKPOS[a] = pos; }
            running += all; }
        for (int i = cnt + C.tid; i < padded; i += NTHREADS) { ROWTOK[pstart + i] = T; ROWW[pstart + i] = 0.f; }
        __syncthreads();
    }
    if (blockIdx.x == gridDim.x - 1) {
        for (int blk = C.tid; blk <= NBLK; blk += NTHREADS) { int pend = 0, e = 0; bool found = false;
            for (int i = 0; i < NE; ++i) { const int cnt = (int)__hip_atomic_load(CNT + i, __ATOMIC_RELAXED, __HIP_MEMORY_SCOPE_AGENT); pend += (cnt + 255) / 256 * 256; if (!found && blk * 256 < pend) { e = i; found = true; } }
            if (blk < NBLK) BLKE[blk] = found ? e : NE - 1; else BLKE[NBLK] = pend / 256; }
    }
}
__device__ __forceinline__ void ph_gather(const Ctx& C) {
    const int nrows = WSP(int, WS_BLKE)[NBLK] * 256; const int* ROWTOK = WSP(int, WS_ROWTOK); const bf16* H = WSP(bf16, WS_H); bf16* HS = WSP(bf16, WS_HS);
    for (int r = C.gwave; r < nrows; r += C.nwaves) { const int tok = ROWTOK[r]; v4u a = {0u, 0u, 0u, 0u}, b = {0u, 0u, 0u, 0u};
        if (tok < T) { a = *(const v4u*)(H + (size_t)tok * DM + C.lane * 16); b = *(const v4u*)(H + (size_t)tok * DM + C.lane * 16 + 8); }
        *(v4u*)(HS + (size_t)r * DM + C.lane * 16) = a; *(v4u*)(HS + (size_t)r * DM + C.lane * 16 + 8) = b; }
}
__device__ __forceinline__ void ph_combine(const Ctx& C) {
    const float* MOD = WSP(float, WS_MOD); const int* TOKPOS = WSP(int, WS_TOKPOS); const unsigned char* Y = WSP(unsigned char, WS_Y);
    typedef float f32x2_t __attribute__((ext_vector_type(2)));
    for (int i0 = C.gtid; i0 < T * 256; i0 += 4 * C.gthreads) {
        int4 ps[4]; f32x4 xo[4], g2[4]; unsigned w[4][4];
#pragma unroll
        for (int q = 0; q < 4; ++q) { const int i = i0 + q * C.gthreads; if (i < T * 256) ps[q] = *(const int4*)(TOKPOS + (size_t)(i >> 8) * 4); }
#pragma unroll
        for (int q = 0; q < 4; ++q) { const int i = i0 + q * C.gthreads; if (i < T * 256) { const int r = i >> 8, c = (i & 255) * 4;
            w[q][0] = *(const unsigned*)(Y + (size_t)ps[q].x * DM + c); w[q][1] = *(const unsigned*)(Y + (size_t)ps[q].y * DM + c); w[q][2] = *(const unsigned*)(Y + (size_t)ps[q].z * DM + c); w[q][3] = *(const unsigned*)(Y + (size_t)ps[q].w * DM + c);
            xo[q] = __builtin_nontemporal_load((const f32x4*)(C.out + (size_t)r * DM + c)); g2[q] = *(const f32x4*)(MOD + (r >> 12) * 6144 + 5120 + c); } }
#pragma unroll
        for (int q = 0; q < 4; ++q) { const int i = i0 + q * C.gthreads; if (i < T * 256) { const int r = i >> 8, c = (i & 255) * 4; f32x4 acc = {0.f, 0.f, 0.f, 0.f};
#pragma unroll
            for (int k = 0; k < 4; ++k) { const f32x2_t lo = __builtin_amdgcn_cvt_pk_f32_fp8((int)w[q][k], false), hi = __builtin_amdgcn_cvt_pk_f32_fp8((int)w[q][k], true); acc.x += lo.x; acc.y += lo.y; acc.z += hi.x; acc.w += hi.y; }
            __builtin_nontemporal_store(xo[q] + g2[q] * acc * 0.0625f, (f32x4*)(C.out + (size_t)r * DM + c)); } }
    }
}
__device__ __forceinline__ unsigned bfx(const v4u& w, int e) { const unsigned d = e < 2 ? w.x : e < 4 ? w.y : e < 6 ? w.z : w.w; return (e & 1) ? (d & 0xffff0000u) : (d << 16); }
__device__ __forceinline__ float bfe(const v4u& w, int e) { return __builtin_bit_cast(float, bfx(w, e)); }
__device__ __forceinline__ void ph_hyena_pre(const Ctx& C) {
    const bf16* HY = WSP(bf16, WS_HY); bf16* UT = WSP(bf16, WS_UT); bf16* CP = WSP(bf16, WS_CP); const float* HF = WSP(float, WS_HF);
    const float* cw = INP(IX_CONVW); const float* cb_ = INP(IX_CONVB);
    LAS bf16* tile = (LAS bf16*)C.lds;
    const int tid = C.tid;
    const bool skew = gridDim.x >= 64 && (gridDim.x & 7) == 0; const int vb0 = skew ? (int)blockIdx.x - 32 : (int)blockIdx.x, vnb = skew ? (int)gridDim.x - 32 : (int)gridDim.x;
    const bool fixc = (vnb & 7) == 0;
    const int tl = tid >> 3, c8 = (tid & 7) * 8;
    float w0[2][8], w1[2][8], w2[2][8], wb[2][8];
    if (fixc) {
#pragma unroll
        for (int gsel = 0; gsel < 2; ++gsel) { const int chn = 512 * (gsel + 1) + ((int)blockIdx.x & 7) * 64 + c8;
#pragma unroll
            for (int e = 0; e < 8; ++e) { w0[gsel][e] = cw[chn + e]; w1[gsel][e] = cw[1536 + chn + e]; w2[gsel][e] = cw[3072 + chn + e]; wb[gsel][e] = cb_[chn + e]; } } }
    const v4u zero4 = {0u, 0u, 0u, 0u};
#define HP_LOAD(IT, M, X, Q) do { const int cb_i = (IT) & 7, tb_i = ((IT) >> 3) & 63, b_i = (IT) >> 9; const int t_i = tb_i * 64 + tl; const size_t r_i = (size_t)b_i * SEQ + t_i; \
        _Pragma("unroll") for (int gsel = 0; gsel < 2; ++gsel) { const bf16* p_ = HY + r_i * 1536 + 512 * (gsel + 1) + cb_i * 64 + c8; \
            M[gsel] = t_i > 0 ? *(const v4u*)(p_ - 1536) : zero4; X[gsel] = *(const v4u*)p_; Q[gsel] = t_i < SEQ - 1 ? *(const v4u*)(p_ + 1536) : zero4; } } while (0)
    v4u cm[2], cx[2], cq[2], nm[2], nx[2], nq[2];
    int it = vb0 < 0 ? 8 * 64 * 8 : vb0;
    if (it < 8 * 64 * 8) HP_LOAD(it, cm, cx, cq);
    for (; it < 8 * 64 * 8; it += vnb) {
        const int cb = it & 7, tb = (it >> 3) & 63, b = it >> 9, c0 = cb * 64, t0 = tb * 64;
        const bool has_n = it + vnb < 8 * 64 * 8;
        if (has_n) HP_LOAD(it + vnb, nm, nx, nq);
        if (!fixc) {
#pragma unroll
            for (int gsel = 0; gsel < 2; ++gsel) { const int chn = 512 * (gsel + 1) + c0 + c8;
#pragma unroll
                for (int e = 0; e < 8; ++e) { w0[gsel][e] = cw[chn + e]; w1[gsel][e] = cw[1536 + chn + e]; w2[gsel][e] = cw[3072 + chn + e]; wb[gsel][e] = cb_[chn + e]; } } }
        float z[2][8];
#pragma unroll
        for (int gsel = 0; gsel < 2; ++gsel)
#pragma unroll
            for (int e = 0; e < 8; ++e) z[gsel][e] = bfe(cm[gsel], e) * w0[gsel][e] + bfe(cx[gsel], e) * w1[gsel][e] + bfe(cq[gsel], e) * w2[gsel][e] + wb[gsel][e];
        __syncthreads();
#pragma unroll
        for (int e = 0; e < 8; ++e) tile[(c8 + e) * 72 + tl] = (bf16)f2bf(z[0][e] * z[1][e]);
        __syncthreads();
        const v4u o = *(const LAS v4u*)(tile + (tid >> 3) * 72 + (tid & 7) * 8);
        *(v4u*)(UT + ((size_t)(c0 + (tid >> 3)) * 8 + b) * SEQ + t0 + (tid & 7) * 8) = o;
        if (has_n) {
#pragma unroll
            for (int gsel = 0; gsel < 2; ++gsel) { cm[gsel] = nm[gsel]; cx[gsel] = nx[gsel]; cq[gsel] = nq[gsel]; } }
    }
#undef HP_LOAD
    __syncthreads();
    LAS float* hfl = (LAS float*)(C.lds + 16384);
    for (int it = vb0 < 0 ? 8 * 128 : vb0; it < 8 * 128; it += vnb) {
        const int cb = it & 7, xb = it >> 3, c0 = cb * 64, x0 = xb * 64, mbase = 8192 - x0 - 70;
        __syncthreads();
        for (int idx = tid; idx < 71 * 64; idx += NTHREADS) { const int lr = idx >> 6, cc = idx & 63, mp = mbase + lr; hfl[lr * 65 + cc] = (mp >= 1 && mp <= 8191) ? HF[(size_t)mp * 512 + c0 + cc] : 0.f; }
        __syncthreads();
        const int c = tid >> 3, x8 = (tid & 7) * 8;
#pragma unroll
        for (int rho = 0; rho < 8; ++rho) { float v[8];
#pragma unroll
            for (int e = 0; e < 8; ++e) v[e] = hfl[(70 - (x8 + e) - rho) * 65 + c];
            v4u o; o.x = pk2(v[0], v[1]); o.y = pk2(v[2], v[3]); o.z = pk2(v[4], v[5]); o.w = pk2(v[6], v[7]);
            *(v4u*)(CP + ((size_t)(c0 + c) * 8 + rho) * 8192 + x0 + x8) = o; }
    }
    __syncthreads();
}
typedef float f32x16_t __attribute__((ext_vector_type(16)));
constexpr int HY_RING = 8, HY_TB = 65536;
__device__ __forceinline__ void ph_hyena_mfma(const Ctx& C) {
    const bf16* UT = WSP(bf16, WS_UT); const bf16* CP = WSP(bf16, WS_CP); bf16* YT = WSP(bf16, WS_YT);
    const int lane = C.lane, n = lane & 31, hh = lane >> 5, b = C.wave;
    LAS unsigned char* ub = C.lds + b * 8192;
    const unsigned ubo = (unsigned)b * 8192u, zrow = (unsigned)(HY_TB + HY_RING * 8192);
    const int rho = (-n) & 7, cn = (n + rho) >> 3;
    if (C.tid < 32) ((LAS unsigned*)(C.lds + HY_TB + HY_RING * 8192))[C.tid] = 0u;
    __syncthreads();
    const int fnb = b >> 2, fks = b & 3;
    const int wfix = 512 - 4 * fnb + 2 * fks + hh - cn;
    for (int c = blockIdx.x; c < 512; c += gridDim.x) {
        const bf16* src = UT + ((size_t)c * 8 + b) * SEQ;
#pragma unroll
        for (int it = 0; it < 8; ++it) { const int g = it * 64 + lane, p = g >> 3, ch = g & 7; const v4u v = *(const v4u*)(src + g * 8);
            *(LAS v4u*)(ub + p * 128 + ((ch ^ ((p >> 1) & 7)) << 4)) = v; }
        asm volatile("s_waitcnt vmcnt(0) lgkmcnt(0)" ::: "memory");
        f32x16_t acc[2][2];
#pragma unroll
        for (int i = 0; i < 2; ++i)
#pragma unroll
            for (int j = 0; j < 2; ++j)
#pragma unroll
                for (int r = 0; r < 16; ++r) acc[i][j][r] = 0.f;
        const bf16* cpl = CP + ((size_t)c * 8 + rho) * 8192;
#define HY_ISSUE2(D_, slot_) do { _Pragma("unroll") for (int h_ = 0; h_ < 2; ++h_) { const int sc_ = (2 * (D_) + h_) > 126 ? 126 : (2 * (D_) + h_); const int W_ = wfix - 8 * (sc_ - 63); \
        __builtin_amdgcn_global_load_lds((const unsigned*)(cpl + 8 * W_), (LAS unsigned*)(C.lds + HY_TB + (slot_) * 16384 + h_ * 8192 + b * 1024), 16, 0, 0); } } while (0)
#define HY_READ(TF, AF, s_, off_) do { const int d_ = (s_) - 63; const LAS unsigned char* tb_ = C.lds + HY_TB + (off_) + lane * 16; \
        _Pragma("unroll") for (int nb = 0; nb < 2; ++nb) _Pragma("unroll") for (int ks = 0; ks < 4; ++ks) TF[nb][ks] = *(const LAS bf16x8*)(tb_ + (nb * 4 + ks) * 1024); \
        _Pragma("unroll") for (int ib = 0; ib < 2; ++ib) { if (ib == 0 ? (d_ <= 31) : (d_ >= -31)) { const int p_ = 32 * ib - d_ + n; const bool v_ = (unsigned)p_ < 64u; \
            const unsigned a0_ = v_ ? (ubo + (unsigned)(p_ * 128 + (((p_ >> 1) & 7) << 4))) : zrow; \
            _Pragma("unroll") for (int ks = 0; ks < 4; ++ks) AF[ib][ks] = *(const LAS bf16x8*)(C.lds + (a0_ ^ (unsigned)((2 * ks + hh) << 4))); } } } while (0)
#define HY_MMA(TF, AF, s_) do { const int d_ = (s_) - 63; if ((s_) <= 126) { _Pragma("unroll") for (int ib = 0; ib < 2; ++ib) { if (ib == 0 ? (d_ <= 31) : (d_ >= -31)) { \
        _Pragma("unroll") for (int ks = 0; ks < 4; ++ks) _Pragma("unroll") for (int nb = 0; nb < 2; ++nb) acc[ib][nb] = __builtin_amdgcn_mfma_f32_32x32x16_bf16(AF[ib][ks], TF[nb][ks], acc[ib][nb], 0, 0, 0); } } } } while (0)
        HY_ISSUE2(0, 0); HY_ISSUE2(1, 1); HY_ISSUE2(2, 2);
        asm volatile("s_waitcnt vmcnt(2)" ::: "memory"); __builtin_amdgcn_s_barrier(); asm volatile("" ::: "memory");
        bf16x8 tfA[2][4], afA[2][4], tfB[2][4], afB[2][4];
        HY_READ(tfA, afA, 0, 0);
#pragma unroll 1
        for (int D = 0; D < 64; ++D) {
            const int slot = D & 3;
            HY_ISSUE2(D + 3, (D + 3) & 3);
            HY_READ(tfB, afB, 2 * D + 1, slot * 16384 + 8192);
            HY_MMA(tfA, afA, 2 * D);
            if (D < 63) HY_READ(tfA, afA, 2 * D + 2, ((D + 1) & 3) * 16384);
            HY_MMA(tfB, afB, 2 * D + 1);
            asm volatile("s_waitcnt vmcnt(2) lgkmcnt(0)" ::: "memory"); __builtin_amdgcn_s_barrier(); asm volatile("" ::: "memory");
        }
#undef HY_ISSUE2
#undef HY_READ
#undef HY_MMA
        asm volatile("s_waitcnt vmcnt(0)" ::: "memory");
        bf16* dst = YT + ((size_t)c * 8 + b) * SEQ;
#pragma unroll
        for (int ib = 0; ib < 2; ++ib)
#pragma unroll
            for (int nb = 0; nb < 2; ++nb)
#pragma unroll
                for (int r = 0; r < 16; ++r) { const int i = 32 * ib + (r & 3) + 8 * (r >> 2) + 4 * hh; dst[64 * i + 32 * nb + n] = (bf16)f2bf(acc[ib][nb][r]); }
        asm volatile("s_waitcnt vmcnt(0) lgkmcnt(0)" ::: "memory"); __builtin_amdgcn_s_barrier(); asm volatile("" ::: "memory");
    }
    __syncthreads();
}
__device__ __forceinline__ void ph_hyena_post(const Ctx& C) {
    const bf16* HY = WSP(bf16, WS_HY); const bf16* YT = WSP(bf16, WS_YT); bf16* OAB = WSP(bf16, WS_OAB);
    const float* cw = INP(IX_CONVW); const float* cb_ = INP(IX_CONVB);
    LAS bf16* tile = (LAS bf16*)C.lds; const int tid = C.tid;
    const int vb0 = (int)blockIdx.x, vnb = (int)gridDim.x; const bool fixc = (vnb & 7) == 0;
    const int tl = tid >> 3, c8 = (tid & 7) * 8;
    float w0[8], w1[8], w2[8], wb[8];
    if (fixc) { const int chn = (vb0 & 7) * 64 + c8;
#pragma unroll
        for (int e = 0; e < 8; ++e) { w0[e] = cw[chn + e]; w1[e] = cw[1536 + chn + e]; w2[e] = cw[3072 + chn + e]; wb[e] = cb_[chn + e]; } }
    const v4u zero4 = {0u, 0u, 0u, 0u};
#define HQ_LOAD(IT, YV, M, X, Q) do { const int cb_i = (IT) & 7, tb_i = ((IT) >> 3) & 63, b_i = (IT) >> 9; const int t_i = tb_i * 64 + tl; \
        YV = *(const v4u*)(YT + ((size_t)(cb_i * 64 + (tid >> 3)) * 8 + b_i) * SEQ + tb_i * 64 + (tid & 7) * 8); \
        const bf16* p_ = HY + ((size_t)b_i * SEQ + t_i) * 1536 + cb_i * 64 + c8; \
        M = *(const v4u*)(p_ - (t_i > 0 ? 1536 : 0)); X = *(const v4u*)p_; Q = *(const v4u*)(p_ + (t_i < SEQ - 1 ? 1536 : 0)); if (t_i == 0) M = zero4; if (t_i == SEQ - 1) Q = zero4; } while (0)
    v4u cy, cm, cx, cq, ny, nm, nx, nq, my, mm, mx, mq;
    int it = vb0;
    if (it < 8 * 64 * 8) HQ_LOAD(it, cy, cm, cx, cq);
    { const int i1_ = it + vnb < 8 * 64 * 8 ? it + vnb : 8 * 64 * 8 - 1; HQ_LOAD(i1_, ny, nm, nx, nq); }
    for (; it < 8 * 64 * 8; it += vnb) {
        const int cb = it & 7, tb = (it >> 3) & 63, b = it >> 9, c0 = cb * 64, t0 = tb * 64;
        const bool has_n = it + vnb < 8 * 64 * 8, has_m = it + 2 * vnb < 8 * 64 * 8;
        { const int i2_ = has_m ? it + 2 * vnb : 8 * 64 * 8 - 1; HQ_LOAD(i2_, my, mm, mx, mq); }
        if (!fixc) { const int chn = c0 + c8;
#pragma unroll
            for (int e = 0; e < 8; ++e) { w0[e] = cw[chn + e]; w1[e] = cw[1536 + chn + e]; w2[e] = cw[3072 + chn + e]; wb[e] = cb_[chn + e]; } }
        __syncthreads();
        *(LAS v4u*)(tile + (tid >> 3) * 72 + (tid & 7) * 8) = cy;
        __syncthreads();
        const int t = t0 + tl, chn = c0 + c8; const size_t r = (size_t)b * SEQ + t;
        float o[8];
#pragma unroll
        for (int e = 0; e < 8; ++e) { const float z0 = bfe(cm, e) * w0[e] + bfe(cx, e) * w1[e] + bfe(cq, e) * w2[e] + wb[e]; o[e] = z0 * bf2f(tile[(c8 + e) * 72 + tl]); }
        v4u w; w.x = pk2(o[0], o[1]); w.y = pk2(o[2], o[3]); w.z = pk2(o[4], o[5]); w.w = pk2(o[6], o[7]);
        *(v4u*)(OAB + r * 1024 + 512 + chn) = w;
        cy = ny; cm = nm; cx = nx; cq = nq; ny = my; nm = mm; nx = mx; nq = mq;
    }
#undef HQ_LOAD
    __syncthreads();
}

__device__ __forceinline__ void v8t_chunk(const bf16* VA, unsigned char* V8T, int b, int h, int tk, int ci) {
    const int d0 = ci >> 7, half = (ci >> 6) & 1, ln = ci & 63, n = ln & 31, kg = ln >> 5;
    const bf16* src = VA + ((size_t)b * SKV + 64 * tk + 32 * half + 4 * kg) * 512 + h * 128 + 32 * d0 + n;
    float v[16];
#pragma unroll
    for (int e = 0; e < 16; ++e) v[e] = bf2f(src[(size_t)((e & 3) + 8 * (e >> 2)) * 512]);
    v4u o; o.x = pg8::pk4_fp8(v[0], v[1], v[2], v[3]); o.y = pg8::pk4_fp8(v[4], v[5], v[6], v[7]); o.z = pg8::pk4_fp8(v[8], v[9], v[10], v[11]); o.w = pg8::pk4_fp8(v[12], v[13], v[14], v[15]);
    *(v4u*)(V8T + ((size_t)((b * 4 + h) * (SKV / 64) + tk) * 512 + ci) * 16) = o;
}
__device__ __forceinline__ void ph_v8t(const Ctx& C) {
    const bf16* VA = WSP(bf16, WS_VA); unsigned char* V8T = WSP(unsigned char, WS_V8T);
    constexpr int NTL = SKV / 64 - 4;
    const bool skew = gridDim.x >= 64; const int t0 = skew ? C.gtid - 32 * NTHREADS : C.gtid, tn = skew ? C.gthreads - 32 * NTHREADS : C.gthreads;
    for (int i = t0 < 0 ? NB * 4 * NTL * 512 : t0; i < NB * 4 * NTL * 512; i += tn) { const int ci = i & 511, tk = 4 + (i >> 9) % NTL, bh = (i >> 9) / NTL; v8t_chunk(VA, V8T, bh >> 2, bh & 3, tk, ci); }
}
__device__ __forceinline__ void ph_v8t_ctx(const Ctx& C, int b, int h0) {
    const bf16* VA = WSP(bf16, WS_VA); unsigned char* V8T = WSP(unsigned char, WS_V8T);
    for (int i = C.tid; i < 2 * 4 * 512; i += NTHREADS) v8t_chunk(VA, V8T, b, h0 + (i >> 11), (i >> 9) & 3, i & 511);
}
__device__ __forceinline__ unsigned char f8b(float v) { return (unsigned char)(pg8::pk4_fp8(v, 0.f, 0.f, 0.f) & 0xffu); }
__device__ __forceinline__ void ph_hyena_pre8(const Ctx& C) {
    const bf16* HY = WSP(bf16, WS_HY); unsigned char* UT = WSP(unsigned char, WS_UT); unsigned char* CP = WSP(unsigned char, WS_CP); const float* HF = WSP(float, WS_HF);
    const float* cw = INP(IX_CONVW); const float* cb_ = INP(IX_CONVB);
    LAS unsigned char* tile = C.lds;
    const int tid = C.tid;
    const bool skew = gridDim.x >= 64 && (gridDim.x & 7) == 0; const int vb0 = skew ? (int)blockIdx.x - 32 : (int)blockIdx.x, vnb = skew ? (int)gridDim.x - 32 : (int)gridDim.x;
    const bool fixc = (vnb & 7) == 0;
    const int tl = tid >> 3, c8 = (tid & 7) * 8;
    float w0[2][8], w1[2][8], w2[2][8], wb[2][8];
    if (fixc) {
#pragma unroll
        for (int gsel = 0; gsel < 2; ++gsel) { const int chn = 512 * (gsel + 1) + ((int)blockIdx.x & 7) * 64 + c8;
#pragma unroll
            for (int e = 0; e < 8; ++e) { w0[gsel][e] = cw[chn + e]; w1[gsel][e] = cw[1536 + chn + e]; w2[gsel][e] = cw[3072 + chn + e]; wb[gsel][e] = cb_[chn + e]; } } }
    const v4u zero4 = {0u, 0u, 0u, 0u};
#define HP_LOAD(IT, M, X, Q) do { const int cb_i = (IT) & 7, tb_i = ((IT) >> 3) & 63, b_i = (IT) >> 9; const int t_i = tb_i * 64 + tl; const size_t r_i = (size_t)b_i * SEQ + t_i; \
        _Pragma("unroll") for (int gsel = 0; gsel < 2; ++gsel) { const bf16* p_ = HY + r_i * 1536 + 512 * (gsel + 1) + cb_i * 64 + c8; \
            M[gsel] = *(const v4u*)(p_ - (t_i > 0 ? 1536 : 0)); X[gsel] = *(const v4u*)p_; Q[gsel] = *(const v4u*)(p_ + (t_i < SEQ - 1 ? 1536 : 0)); if (t_i == 0) M[gsel] = zero4; if (t_i == SEQ - 1) Q[gsel] = zero4; } } while (0)
    v4u cm[2], cx[2], cq[2], nm[2], nx[2], nq[2], mm[2], mx[2], mq[2];
    int it = vb0 < 0 ? 8 * 64 * 8 : vb0;
    if (it < 8 * 64 * 8) HP_LOAD(it, cm, cx, cq);
    if (it < 8 * 64 * 8) { const int i1_ = it + vnb < 8 * 64 * 8 ? it + vnb : 8 * 64 * 8 - 1; HP_LOAD(i1_, nm, nx, nq); }
    for (; it < 8 * 64 * 8; it += vnb) {
        const int cb = it & 7, tb = (it >> 3) & 63, b = it >> 9, c0 = cb * 64, t0 = tb * 64;
        const bool has_n = it + vnb < 8 * 64 * 8, has_m = it + 2 * vnb < 8 * 64 * 8;
        { const int i2_ = has_m ? it + 2 * vnb : 8 * 64 * 8 - 1; HP_LOAD(i2_, mm, mx, mq); }
        if (!fixc) {
#pragma unroll
            for (int gsel = 0; gsel < 2; ++gsel) { const int chn = 512 * (gsel + 1) + c0 + c8;
#pragma unroll
                for (int e = 0; e < 8; ++e) { w0[gsel][e] = cw[chn + e]; w1[gsel][e] = cw[1536 + chn + e]; w2[gsel][e] = cw[3072 + chn + e]; wb[gsel][e] = cb_[chn + e]; } } }
        float z[2][8];
#pragma unroll
        for (int gsel = 0; gsel < 2; ++gsel)
#pragma unroll
            for (int e = 0; e < 8; ++e) z[gsel][e] = bfe(cm[gsel], e) * w0[gsel][e] + bfe(cx[gsel], e) * w1[gsel][e] + bfe(cq[gsel], e) * w2[gsel][e] + wb[gsel][e];
        __syncthreads();
#pragma unroll
        for (int e = 0; e < 8; ++e) tile[(c8 + e) * 80 + tl] = f8b(z[0][e] * z[1][e]);
        __syncthreads();
        const unsigned long long o = *(const LAS unsigned long long*)(tile + (tid >> 3) * 80 + (tid & 7) * 8);
        *(unsigned long long*)(UT + ((size_t)(c0 + (tid >> 3)) * 8 + b) * SEQ + t0 + (tid & 7) * 8) = o;
#pragma unroll
        for (int gsel = 0; gsel < 2; ++gsel) { cm[gsel] = nm[gsel]; cx[gsel] = nx[gsel]; cq[gsel] = nq[gsel]; nm[gsel] = mm[gsel]; nx[gsel] = mx[gsel]; nq[gsel] = mq[gsel]; }
    }
#undef HP_LOAD
    __syncthreads();
    LAS float* hfl = (LAS float*)(C.lds + 16384);
    float pf[10];
#define CP_LOAD(IT2) do { const int it_ = (IT2) < 8 * 128 ? (IT2) : 8 * 128 - 1; const int c0_ = (it_ & 7) * 64, mb_ = 8192 - (it_ >> 3) * 64 - 78; \
        _Pragma("unroll") for (int u_ = 0; u_ < 10; ++u_) { int idx_ = tid + u_ * NTHREADS; idx_ = idx_ < 79 * 64 ? idx_ : 79 * 64 - 1; const int mp_ = mb_ + (idx_ >> 6); \
            const int mc_ = mp_ < 1 ? 1 : (mp_ > 8191 ? 8191 : mp_); const float v_ = HF[(size_t)mc_ * 512 + c0_ + (idx_ & 63)]; pf[u_] = (mp_ >= 1 && mp_ <= 8191) ? v_ * 64.0f : 0.f; } } while (0)
    int it2 = vb0 < 0 ? 8 * 128 : vb0;
    if (it2 < 8 * 128) CP_LOAD(it2);
    for (; it2 < 8 * 128; it2 += vnb) {
        const int cb = it2 & 7, xb = it2 >> 3, c0 = cb * 64, x0 = xb * 64;
        __syncthreads();
#pragma unroll
        for (int u = 0; u < 10; ++u) { const int idx = tid + u * NTHREADS; if (idx < 79 * 64) hfl[(idx >> 6) * 65 + (idx & 63)] = pf[u]; }
        CP_LOAD(it2 + vnb);
        __syncthreads();
        const int c = tid >> 3, x8 = (tid & 7) * 8;
#pragma unroll 4
        for (int rho = 0; rho < 16; ++rho) { float v[8];
#pragma unroll
            for (int e = 0; e < 8; ++e) v[e] = hfl[(78 - (x8 + e) - rho) * 65 + c];
            *(unsigned long long*)(CP + ((size_t)(c0 + c) * 16 + rho) * 8192 + x0 + x8) = (unsigned long long)pg8::pk4_fp8(v[0], v[1], v[2], v[3]) | ((unsigned long long)pg8::pk4_fp8(v[4], v[5], v[6], v[7]) << 32); }
    }
#undef CP_LOAD
    __syncthreads();
}
typedef int v8i_h8 __attribute__((ext_vector_type(8)));
typedef int v4i_h8 __attribute__((ext_vector_type(4)));
constexpr int H8_TB = 32768, H8_Z = 65536;
__device__ __forceinline__ void ph_hyena_mfma8(const Ctx& C, int pass_lo, int pass_hi) {
    const unsigned char* UT = WSP(unsigned char, WS_UT); const unsigned char* CP = WSP(unsigned char, WS_CP); bf16* YT = WSP(bf16, WS_YT);
    const int lane = C.lane, n = lane & 31, hh = lane >> 5, b = C.wave;
    const unsigned ubo = (unsigned)b * 4096u, zrow = (unsigned)H8_Z;
    const int rho = (-n) & 15, cn = (n + rho) >> 4;
    if (C.tid < 16) ((LAS unsigned*)(C.lds + H8_Z))[C.tid] = 0u;
    __syncthreads();
    const int fh = b >> 2, fnb = (b >> 1) & 1, fhalf = b & 1;
    const int wfix = 256 - 2 * fnb + 2 * hh - cn;
    for (int c = blockIdx.x + pass_lo * gridDim.x, ps_ = pass_lo; c < 512 && ps_ < pass_hi; c += gridDim.x, ++ps_) {
        const unsigned char* src = UT + ((size_t)c * 8 + b) * SEQ;
#pragma unroll
        for (int it = 0; it < 4; ++it) { const int g = it * 64 + lane, p = g >> 2, c4 = g & 3; const v4u v = *(const v4u*)(src + g * 16);
            *(LAS v4u*)(C.lds + ubo + p * 64 + ((c4 ^ ((p >> 2) & 3)) << 4)) = v; }
        asm volatile("s_waitcnt vmcnt(0) lgkmcnt(0)" ::: "memory");
        f32x16_t acc[2][2];
#pragma unroll
        for (int i = 0; i < 2; ++i)
#pragma unroll
            for (int j = 0; j < 2; ++j)
#pragma unroll
                for (int r = 0; r < 16; ++r) acc[i][j][r] = 0.f;
        const unsigned char* cpl = CP + ((size_t)c * 16 + rho) * 8192 + 16 * fhalf;
#define H8_ISSUE(D_, slot_) do { const int sc_ = (2 * (D_) + fh) > 126 ? 126 : (2 * (D_) + fh); const int W_ = wfix - 4 * (sc_ - 63); \
        __builtin_amdgcn_global_load_lds((const unsigned*)(cpl + 16 * W_), (LAS unsigned*)(C.lds + H8_TB + (slot_) * 8192 + b * 1024), 16, 0, 0); } while (0)
#define H8_READ(TF, AF, s_, off_) do { const int d_ = (s_) - 63; const LAS unsigned char* tb_ = C.lds + H8_TB + (off_) + lane * 16; \
        _Pragma("unroll") for (int nb = 0; nb < 2; ++nb) { const v4i_h8 lo_ = *(const LAS v4i_h8*)(tb_ + (nb * 2 + 0) * 1024), hi_ = *(const LAS v4i_h8*)(tb_ + (nb * 2 + 1) * 1024); TF[nb] = __builtin_shufflevector(lo_, hi_, 0, 1, 2, 3, 4, 5, 6, 7); } \
        _Pragma("unroll") for (int ib = 0; ib < 2; ++ib) { const int p_ = 32 * ib - d_ + n; const bool v_ = (unsigned)p_ < 64u; \
            const unsigned a0_ = v_ ? (ubo + (unsigned)(p_ * 64 + (((p_ >> 2) & 3) << 4))) : zrow; \
            const v4i_h8 lo_ = *(const LAS v4i_h8*)(C.lds + (a0_ ^ (unsigned)((2 * hh) << 4))), hi_ = *(const LAS v4i_h8*)(C.lds + (a0_ ^ (unsigned)((2 * hh + 1) << 4))); AF[ib] = __builtin_shufflevector(lo_, hi_, 0, 1, 2, 3, 4, 5, 6, 7); } } while (0)
#define H8_MMA(TF, AF, M0_, M1_) do { \
        if (M0_) { acc[0][0] = __builtin_amdgcn_mfma_scale_f32_32x32x64_f8f6f4(AF[0], TF[0], acc[0][0], 0, 0, 0, 0x7F7F7F7F, 0, 0x79797979); acc[0][1] = __builtin_amdgcn_mfma_scale_f32_32x32x64_f8f6f4(AF[0], TF[1], acc[0][1], 0, 0, 0, 0x7F7F7F7F, 0, 0x79797979); } \
        if (M1_) { acc[1][0] = __builtin_amdgcn_mfma_scale_f32_32x32x64_f8f6f4(AF[1], TF[0], acc[1][0], 0, 0, 0, 0x7F7F7F7F, 0, 0x79797979); acc[1][1] = __builtin_amdgcn_mfma_scale_f32_32x32x64_f8f6f4(AF[1], TF[1], acc[1][1], 0, 0, 0, 0x7F7F7F7F, 0, 0x79797979); } \
        asm volatile("" : "+v"(acc[0][0]), "+v"(acc[0][1]), "+v"(acc[1][0]), "+v"(acc[1][1])); } while (0)
#define H8_BODY(D_, M0_, M1_, SECOND_) do { \
        H8_ISSUE((D_) + 3, ((D_) + 3) & 3); \
        if (SECOND_) H8_READ(tfB, afB, 2 * (D_) + 1, ((D_) & 3) * 8192 + 4096); \
        __builtin_amdgcn_sched_barrier(0); H8_MMA(tfA, afA, M0_, M1_); __builtin_amdgcn_sched_barrier(0); \
        if (SECOND_) { H8_READ(tfA, afA, 2 * (D_) + 2, (((D_) + 1) & 3) * 8192); __builtin_amdgcn_sched_barrier(0); H8_MMA(tfB, afB, M0_, M1_); __builtin_amdgcn_sched_barrier(0); } \
        asm volatile("s_waitcnt vmcnt(1) lgkmcnt(0)" ::: "memory"); __builtin_amdgcn_s_barrier(); asm volatile("" ::: "memory"); } while (0)
        H8_ISSUE(0, 0); H8_ISSUE(1, 1); H8_ISSUE(2, 2);
        asm volatile("s_waitcnt vmcnt(1)" ::: "memory"); __builtin_amdgcn_s_barrier(); asm volatile("" ::: "memory");
        v8i_h8 tfA[2], afA[2], tfB[2], afB[2];
        H8_READ(tfA, afA, 0, 0);
#pragma unroll 1
        for (int D = 0; D < 16; ++D) H8_BODY(D, true, false, true);
#pragma unroll 1
        for (int D = 16; D < 48; ++D) H8_BODY(D, true, true, true);
#pragma unroll 1
        for (int D = 48; D < 63; ++D) H8_BODY(D, false, true, true);
        H8_BODY(63, false, true, false);
#undef H8_BODY
#undef H8_ISSUE
#undef H8_READ
#undef H8_MMA
        asm volatile("s_waitcnt vmcnt(0)" ::: "memory");
        bf16* dst = YT + ((size_t)c * 8 + b) * SEQ;
#pragma unroll
        for (int ib = 0; ib < 2; ++ib)
#pragma unroll
            for (int nb = 0; nb < 2; ++nb)
#pragma unroll
                for (int r = 0; r < 16; ++r) { const int i = 32 * ib + (r & 3) + 8 * (r >> 2) + 4 * hh; dst[64 * i + 32 * nb + n] = (bf16)f2bf(acc[ib][nb][r]); }
        asm volatile("s_waitcnt vmcnt(0) lgkmcnt(0)" ::: "memory"); __builtin_amdgcn_s_barrier(); asm volatile("" ::: "memory");
    }
    __syncthreads();
}
constexpr int LDS_HIST = RING_BYTES + 1024, LDS_LG = RING_BYTES + 2048;
__device__ __forceinline__ void ph_router2(const Ctx& C) {
    const float* MOD = WSP(float, WS_MOD); const float* SSQ = WSP(float, WS_SSQ); bf16* H = WSP(bf16, WS_H); const float* g2n = INP(IX_N2G); const float* RW = INP(IX_RW);
    int* TOPE = WSP(int, WS_TOPE); float* TOPW = WSP(float, WS_TOPW); unsigned* CNTB = WSP(unsigned, WS_CNTB);
    LAS unsigned* hist = (LAS unsigned*)(C.lds + LDS_HIST);
    const int lane = C.lane, tid = C.tid;
    for (int i = tid; i < 1024 * 8; i += NTHREADS) { const int k = i >> 3, ch = i & 7; const f32x4 w = *(const f32x4*)(RW + (size_t)k * 32 + ch * 4);
        *(LAS f32x4*)(C.lds + k * 128 + ((ch ^ ((k >> 1) & 7)) << 4)) = w; }
    const float rb = INP(IX_RB)[lane >> 1];
    for (int chk = blockIdx.x; chk < T / 128; chk += gridDim.x) {
        __syncthreads();
        if (tid < 32) hist[tid] = 0u;
        __syncthreads();
#pragma unroll 1
        for (int ri = 0; ri < 16; ++ri) {
            const int r = chk * 128 + C.wave * 16 + ri; const float* mrow = MOD + (r >> 12) * 6144;
            float v[16]; float ss = 0.f;
#pragma unroll
            for (int m = 0; m < 16; ++m) { const int col = lane + 64 * m; v[m] = C.out[(size_t)r * DM + col]; }
            ss = lane < 16 ? SSQ[(size_t)r * 16 + lane] : 0.f;
            const float rstd = rsqrtf(wave_sum(ss) * (1.0f / DM) + EPS);
            float p[32];
#pragma unroll
            for (int e = 0; e < 32; ++e) p[e] = 0.f;
#pragma unroll
            for (int m = 0; m < 16; ++m) { const int col = lane + 64 * m; const float y = v[m] * rstd * g2n[col] * (mrow[4096 + col] + 1.0f) + mrow[3072 + col];
                H[(size_t)r * DM + col] = (bf16)f2bf(y);
                const LAS unsigned char* wrow = C.lds + col * 128; const int sw = (col >> 1) & 7; asm volatile("" ::: "memory");
#pragma unroll
                for (int q = 0; q < 8; ++q) { const f32x4 w = *(const LAS f32x4*)(wrow + ((q ^ sw) << 4)); p[4 * q] += y * w.x; p[4 * q + 1] += y * w.y; p[4 * q + 2] += y * w.z; p[4 * q + 3] += y * w.w; } }
#define HALVE(N_, MASK_) _Pragma("unroll") for (int e = 0; e < (N_); ++e) { const float a = p[e], b2 = p[e + (N_)]; const bool up = (lane & (MASK_)) != 0; const float send = up ? a : b2, keep = up ? b2 : a; p[e] = keep + __shfl_xor(send, (MASK_)); }
            HALVE(16, 32) HALVE(8, 16) HALVE(4, 8) HALVE(2, 4) HALVE(1, 2)
#undef HALVE
            float lg = p[0] + __shfl_xor(p[0], 1) + rb;
            const int myid = lane >> 1;
            float tv[4]; int ti[4];
#pragma unroll
            for (int k = 0; k < 4; ++k) { float bv = lg; int bi = myid;
#pragma unroll
                for (int mask = 2; mask < 64; mask <<= 1) { const float ov = __shfl_xor(bv, mask); const int oi = __shfl_xor(bi, mask); const bool take = ov > bv || (ov == bv && oi < bi); bv = take ? ov : bv; bi = take ? oi : bi; }
                tv[k] = bv; ti[k] = bi; if (myid == bi) lg = -INFINITY; }
            const float e1 = __expf(tv[1] - tv[0]), e2 = __expf(tv[2] - tv[0]), e3 = __expf(tv[3] - tv[0]); const float inv = 1.0f / (1.0f + e1 + e2 + e3);
            if (lane == 0) { *(int4*)(TOPE + (size_t)r * 4) = make_int4(ti[0], ti[1], ti[2], ti[3]); *(f32x4*)(TOPW + (size_t)r * 4) = (f32x4){inv, e1 * inv, e2 * inv, e3 * inv};
                __hip_atomic_fetch_add(&hist[ti[0]], 1u, __ATOMIC_RELAXED, __HIP_MEMORY_SCOPE_WORKGROUP); __hip_atomic_fetch_add(&hist[ti[1]], 1u, __ATOMIC_RELAXED, __HIP_MEMORY_SCOPE_WORKGROUP);
                __hip_atomic_fetch_add(&hist[ti[2]], 1u, __ATOMIC_RELAXED, __HIP_MEMORY_SCOPE_WORKGROUP); __hip_atomic_fetch_add(&hist[ti[3]], 1u, __ATOMIC_RELAXED, __HIP_MEMORY_SCOPE_WORKGROUP); }
        }
        __syncthreads();
        if (tid < 32) CNTB[chk * 32 + tid] = hist[tid];
    }
    __syncthreads();
}
__device__ __forceinline__ void ph_sort2(const Ctx& C) {
    const unsigned* CNTB = WSP(unsigned, WS_CNTB); const int* TOPE = WSP(int, WS_TOPE); const float* TOPW = WSP(float, WS_TOPW);
    int* TOKPOS = WSP(int, WS_TOKPOS); int* ROWTOK = WSP(int, WS_ROWTOK); float* ROWW = WSP(float, WS_ROWW); int* BLKE = WSP(int, WS_BLKE);
    LAS int* ptot = (LAS int*)C.lds;
    LAS int* pbef = ptot + 512;
    LAS int* tot = pbef + 512;
    LAS int* base = tot + 32;
    LAS int* pst = base + 32;
    LAS int* wt = pst + 64;
    const int tid = C.tid, lane = C.lane;
    for (int chk = blockIdx.x; chk < T / 128; chk += gridDim.x) {
        __syncthreads();
        { const int e = tid & 31, part = tid >> 5; int s = 0, sb = 0;
          for (int c2 = part * 16; c2 < part * 16 + 16; ++c2) { const int v = (int)CNTB[c2 * 32 + e]; s += v; sb += (c2 < chk) ? v : 0; }
          ptot[part * 32 + e] = s; pbef[part * 32 + e] = sb; }
        __syncthreads();
        if (tid < 32) { int s = 0, sb = 0;
#pragma unroll
            for (int pp = 0; pp < 16; ++pp) { s += ptot[pp * 32 + tid]; sb += pbef[pp * 32 + tid]; }
            tot[tid] = s; base[tid] = sb; }
        __syncthreads();
        if (tid < 33) { int ps = 0; for (int i = 0; i < tid; ++i) ps += (tot[i] + 255) / 256 * 256; pst[tid] = ps; }
        __syncthreads();
        const int a = chk * 512 + tid; const int ea = TOPE[a]; int pre = 0;
#pragma unroll 4
        for (int e = 0; e < 32; ++e) { const unsigned long long bal = __ballot(ea == e); if (lane == 0) wt[C.wave * 32 + e] = __popcll(bal); if (ea == e) pre = __popcll(bal & ((1ull << lane) - 1ull)); }
        __syncthreads();
        int woff = 0;
#pragma unroll
        for (int w = 0; w < 8; ++w) woff += (w < C.wave) ? wt[w * 32 + ea] : 0;
        const int pos = pst[ea] + base[ea] + woff + pre;
        ROWTOK[pos] = a >> 2; ROWW[pos] = TOPW[a]; TOKPOS[a] = pos;
        if (chk < NE) { const int e = chk, st = pst[e] + tot[e], en = pst[e + 1]; for (int i = st + tid; i < en; i += NTHREADS) { ROWTOK[i] = T; ROWW[i] = 0.f; } }
        if (chk == 0 && tid < DM / 16) ((v4u*)(WSP(unsigned char, WS_H) + (size_t)T * DM))[tid] = (v4u){0u, 0u, 0u, 0u};
        if (chk == T / 128 - 1) { for (int blk = tid; blk <= NBLK; blk += NTHREADS) { int e = NE - 1;
#pragma unroll 1
                for (int i = NE - 1; i >= 0; --i) if (blk * 256 < pst[i + 1]) e = i;
                if (blk < NBLK) BLKE[blk] = e; else BLKE[NBLK] = pst[NE] / 256; } }
    }
    __syncthreads();
}
constexpr int LDS_GS = RING_BYTES + 4096;
__device__ __forceinline__ void ph_router3(const Ctx& C) {
    const float* MOD = WSP(float, WS_MOD); const float* SSQ = WSP(float, WS_SSQ); unsigned char* H = WSP(unsigned char, WS_H); const float* g2n = INP(IX_N2G); const float* RW = INP(IX_RW);
    int* TOPE = WSP(int, WS_TOPE); float* TOPW = WSP(float, WS_TOPW); unsigned* CNTB = WSP(unsigned, WS_CNTB);
    LAS unsigned char* Wl = C.lds; LAS float* gsl = (LAS float*)(C.lds + LDS_GS); LAS float* shl = gsl + 1024;
    LAS unsigned* hist = (LAS unsigned*)(C.lds + LDS_HIST);
    const int lane = C.lane, tid = C.tid, i = lane & 15, kk = lane >> 4;
    for (int g0 = tid; g0 < 128 * 32; g0 += 4 * NTHREADS) { float wv[4][8];
#pragma unroll
        for (int u = 0; u < 4; ++u) { const int g = g0 + u * NTHREADS, ex = g & 31, kg = g >> 5;
#pragma unroll
            for (int j = 0; j < 8; ++j) wv[u][j] = RW[(size_t)(8 * kg + j) * 32 + ex]; }
#pragma unroll
        for (int u = 0; u < 4; ++u) { const int g = g0 + u * NTHREADS, ex = g & 31, kg = g >> 5; unsigned hi[4], lo[4];
#pragma unroll
            for (int j = 0; j < 4; ++j) { hi[j] = pg8::cvt_pk_bf16(wv[u][2 * j], wv[u][2 * j + 1]);
                const float r0_ = wv[u][2 * j] - __uint_as_float(hi[j] << 16), r1_ = wv[u][2 * j + 1] - __uint_as_float(hi[j] & 0xffff0000u); lo[j] = pg8::cvt_pk_bf16(r0_, r1_); }
            const int Q = kg >> 2, k2 = kg & 3, nb = ex >> 4, n = ex & 15; LAS unsigned char* d = Wl + (((Q * 2 + nb) * 2) * 64 + k2 * 16 + n) * 16;
            *(LAS v4u*)d = (v4u){hi[0], hi[1], hi[2], hi[3]}; *(LAS v4u*)(d + 1024) = (v4u){lo[0], lo[1], lo[2], lo[3]}; } }
    const float rb0 = INP(IX_RB)[i], rb1 = INP(IX_RB)[16 + i];
    for (int chk = blockIdx.x; chk < T / 128; chk += gridDim.x) {
        __syncthreads();
        const float* mrow = MOD + (chk >> 5) * 6144;
        for (int k = tid; k < 1024; k += NTHREADS) { gsl[k] = g2n[k] * (1.0f + mrow[4096 + k]); shl[k] = mrow[3072 + k]; }
        if (tid < 32) hist[tid] = 0u;
        __syncthreads();
        const int r0 = chk * 128 + C.wave * 16, r = r0 + i;
        float ss; { const f32x4 s4 = *(const f32x4*)(SSQ + (size_t)r * 16 + 4 * kk); ss = (s4[0] + s4[1]) + (s4[2] + s4[3]); ss += __shfl_xor(ss, 16); ss += __shfl_xor(ss, 32); }
        const float rstd = rsqrtf(ss * (1.0f / DM) + EPS);
        f32x4 acc0 = {0.f, 0.f, 0.f, 0.f}, acc1 = {0.f, 0.f, 0.f, 0.f};
        const float* xr = C.out + (size_t)r * DM + 8 * kk; unsigned char* hr = H + (size_t)r * DM + 8 * kk;
#pragma unroll 1
        for (int Qh = 0; Qh < 32; Qh += 16) { f32x4 xv[16][2];
#pragma unroll
          for (int u = 0; u < 16; ++u) { xv[u][0] = *(const f32x4*)(xr + 32 * (Qh + u)); xv[u][1] = *(const f32x4*)(xr + 32 * (Qh + u) + 4); }
#pragma unroll
          for (int u = 0; u < 16; ++u) { const int Q = Qh + u;
            const f32x4 xa = xv[u][0], xb = xv[u][1];
            const f32x4 ga = *(const LAS f32x4*)(gsl + 32 * Q + 8 * kk), gb = *(const LAS f32x4*)(gsl + 32 * Q + 8 * kk + 4), sa = *(const LAS f32x4*)(shl + 32 * Q + 8 * kk), sb = *(const LAS f32x4*)(shl + 32 * Q + 8 * kk + 4);
            const f32x4 ha = xa * rstd * ga + sa, hb = xb * rstd * gb + sb;
            *(unsigned long long*)(hr + 32 * Q) = (unsigned long long)pg8::pk4_fp8(ha[0], ha[1], ha[2], ha[3]) | ((unsigned long long)pg8::pk4_fp8(hb[0], hb[1], hb[2], hb[3]) << 32);
            unsigned hh[4], hl[4];
            hh[0] = pg8::cvt_pk_bf16(ha[0], ha[1]); hh[1] = pg8::cvt_pk_bf16(ha[2], ha[3]); hh[2] = pg8::cvt_pk_bf16(hb[0], hb[1]); hh[3] = pg8::cvt_pk_bf16(hb[2], hb[3]);
            hl[0] = pg8::cvt_pk_bf16(ha[0] - __uint_as_float(hh[0] << 16), ha[1] - __uint_as_float(hh[0] & 0xffff0000u)); hl[1] = pg8::cvt_pk_bf16(ha[2] - __uint_as_float(hh[1] << 16), ha[3] - __uint_as_float(hh[1] & 0xffff0000u));
            hl[2] = pg8::cvt_pk_bf16(hb[0] - __uint_as_float(hh[2] << 16), hb[1] - __uint_as_float(hh[2] & 0xffff0000u)); hl[3] = pg8::cvt_pk_bf16(hb[2] - __uint_as_float(hh[3] << 16), hb[3] - __uint_as_float(hh[3] & 0xffff0000u));
            const pg8::bf16x8 ah = __builtin_bit_cast(pg8::bf16x8, (v4u){hh[0], hh[1], hh[2], hh[3]}), al = __builtin_bit_cast(pg8::bf16x8, (v4u){hl[0], hl[1], hl[2], hl[3]});
            const LAS unsigned char* wq = Wl + (size_t)(Q * 4) * 1024 + lane * 16;
            const pg8::bf16x8 w0h = *(const LAS pg8::bf16x8*)(wq), w0l = *(const LAS pg8::bf16x8*)(wq + 1024), w1h = *(const LAS pg8::bf16x8*)(wq + 2048), w1l = *(const LAS pg8::bf16x8*)(wq + 3072);
            acc0 = __builtin_amdgcn_mfma_f32_16x16x32_bf16(ah, w0h, acc0, 0, 0, 0); acc1 = __builtin_amdgcn_mfma_f32_16x16x32_bf16(ah, w1h, acc1, 0, 0, 0);
            acc0 = __builtin_amdgcn_mfma_f32_16x16x32_bf16(ah, w0l, acc0, 0, 0, 0); acc1 = __builtin_amdgcn_mfma_f32_16x16x32_bf16(ah, w1l, acc1, 0, 0, 0);
            acc0 = __builtin_amdgcn_mfma_f32_16x16x32_bf16(al, w0h, acc0, 0, 0, 0); acc1 = __builtin_amdgcn_mfma_f32_16x16x32_bf16(al, w1h, acc1, 0, 0, 0);
          } }
#pragma unroll
        for (int reg = 0; reg < 4; ++reg) {
            float v0 = acc0[reg] + rb0, v1 = acc1[reg] + rb1; float tv[4]; int ti[4];
#pragma unroll
            for (int k = 0; k < 4; ++k) { const bool f0 = v0 >= v1; float bv = f0 ? v0 : v1; int bi = f0 ? i : 16 + i;
#pragma unroll
                for (int mask = 1; mask < 16; mask <<= 1) { const float ov = __shfl_xor(bv, mask); const int oi = __shfl_xor(bi, mask); const bool take = ov > bv || (ov == bv && oi < bi); bv = take ? ov : bv; bi = take ? oi : bi; }
                tv[k] = bv; ti[k] = bi; if (bi == i) v0 = -INFINITY; if (bi == 16 + i) v1 = -INFINITY; }
            const float e1 = __expf(tv[1] - tv[0]), e2 = __expf(tv[2] - tv[0]), e3 = __expf(tv[3] - tv[0]); const float inv = 1.0f / (1.0f + e1 + e2 + e3);
            if (i == 0) { const size_t row = (size_t)(r0 + 4 * kk + reg); *(int4*)(TOPE + row * 4) = make_int4(ti[0], ti[1], ti[2], ti[3]); *(f32x4*)(TOPW + row * 4) = (f32x4){inv, e1 * inv, e2 * inv, e3 * inv};
                __hip_atomic_fetch_add(&hist[ti[0]], 1u, __ATOMIC_RELAXED, __HIP_MEMORY_SCOPE_WORKGROUP); __hip_atomic_fetch_add(&hist[ti[1]], 1u, __ATOMIC_RELAXED, __HIP_MEMORY_SCOPE_WORKGROUP);
                __hip_atomic_fetch_add(&hist[ti[2]], 1u, __ATOMIC_RELAXED, __HIP_MEMORY_SCOPE_WORKGROUP); __hip_atomic_fetch_add(&hist[ti[3]], 1u, __ATOMIC_RELAXED, __HIP_MEMORY_SCOPE_WORKGROUP); }
        }
        __syncthreads();
        if (tid < 32) CNTB[chk * 32 + tid] = hist[tid];
    }
    __syncthreads();
}
__device__ __forceinline__ void ph_attention(const Ctx& C, int it_lo, int it_hi) {
    const unsigned char* Q8 = WSP(unsigned char, WS_QP); const unsigned char* K8 = WSP(unsigned char, WS_KA); const unsigned char* V8T = WSP(unsigned char, WS_V8T); bf16* OA = WSP(bf16, WS_OAB);
    const float lam = *WSP(float, WS_LAM); const float* sg = INP(IX_SUBG);
    const float sbound = 0.20358f * sqrtf(__uint_as_float(WSP(unsigned, WS_CTL)[CW_NMAX]) * __uint_as_float(WSP(unsigned, WS_CTL)[CW_NMAX + 64]));
    const bool nomax = __builtin_amdgcn_readfirstlane((int)(sbound > 0.f && sbound <= 15.6f)) != 0;
    const bool xl = gridDim.x == 256;
#define ATT_UNITS(NM) for (int it = it_lo; it < it_hi && it < (xl ? 4 : (NB * 4 * (SEQ / 128) + (int)gridDim.x - 1) / (int)gridDim.x); ++it) { \
        int u; \
        if (xl) { const int x = blockIdx.x & 7, j = blockIdx.x >> 3; u = ((4 * x + it) << 5) | j; } else { u = blockIdx.x + it * gridDim.x; if (u >= NB * 4 * (SEQ / 128)) break; } \
        const int qb = u & 31, h = (u >> 5) & 3, b = u >> 7; \
        const long q0 = ((long)b * SEQ + qb * 128) * 512 + h * 128, k0 = (long)b * SKV * 512 + h * 128, o0 = ((long)b * SEQ + qb * 128) * 1024 + h * 128, v0 = (long)(b * 4 + h) * (SKV / 64) * 8192; \
        __syncthreads(); \
        att::attn_diff_body8<NM>(Q8 + q0, K8 + k0, V8T + v0, OA + o0, SKV, C.ldsg, C.lds, lam, sg, 0.8f); }
    if (nomax) { ATT_UNITS(true) } else { ATT_UNITS(false) }
#undef ATT_UNITS
    __syncthreads();
}
enum { PH_PREP = 0, PH_MOD1, PH_INPROJ, PH_POST, PH_ATTN, PH_HYENA, PH_ATTNPOST, PH_MERGEUP, PH_WOUT, PH_ROUTER, PH_SORT, PH_MOE1, PH_MOE2, PH_COMBINE, N_PHASES };
struct Args { const float* in[N_INPUTS]; float* out; unsigned char* ws; int ph_lo, ph_hi, li, pad; };
static_assert(sizeof(Args) == N_INPUTS * 8 + 8 + 8 + 16, "Args has no padding");

#ifndef PG8_ALIGN
#define PG8_ALIGN true
#endif
namespace cg = cooperative_groups;
__global__ void __launch_bounds__(NTHREADS, 2) fwd(Args args) {
    cg::grid_group grid_g = cg::this_grid();
    extern __shared__ __attribute__((aligned(16))) unsigned char lds_raw[];
    Ctx C;
    C.out = args.out; C.ws = args.ws; C.lds = (LAS unsigned char*)lds_raw; C.ldsg = (char*)lds_raw;
    C.tid = threadIdx.x; C.lane = C.tid & 63; C.wave = __builtin_amdgcn_readfirstlane(C.tid >> 6);
    C.gwave = blockIdx.x * NWAVES + C.wave; C.nwaves = gridDim.x * NWAVES; C.gtid = blockIdx.x * NTHREADS + C.tid; C.gthreads = gridDim.x * NTHREADS;
    const int lo = args.ph_lo, hi = args.ph_hi;
    volatile LAS unsigned* MISC = (volatile LAS unsigned*)(C.lds + MISC_OFF);
    if (C.tid < 32) MISC[C.tid] = 0u;
    __syncthreads();
    unsigned* barw = (unsigned*)(C.ws + WS_CTL) + CW_BAR + args.li * XCD_BAR_WORDS;
    XcdBarrier xbar; xbar.bar = barw; xbar.x = 0; xbar.st = nullptr;
    if (hi - lo > 1) xbar = xcd_barrier_post(barw, MISC + 8);
#define IN(k) (lo <= (k) && (k) < hi)
#define SEAM(k) do { if (IN(k) && IN((k) + 1)) { if (args.li < 0) grid_g.sync(); else xcd_barrier(xbar); } } while (0)
    if (IN(PH_PREP)) { ph_prep_weights(C, 0, gridDim.x == 256 ? PREP_N0 : PREP_NIT); __syncthreads(); ph_prep_ada(C); __syncthreads(); ph_prep_misc(C); ph_prep_filter(C); }
    SEAM(PH_PREP);
    if (IN(PH_MOD1)) { ph_modulate1(C); }
    SEAM(PH_MOD1);
    if (IN(PH_INPROJ)) {
        {
            LAS float* tb = (LAS float*)(C.lds + RING_BYTES + 20480);
            for (int i = C.tid; i < 1024; i += NTHREADS) { tb[i] = WSP(float, WS_ROPEC)[i]; tb[1024 + i] = WSP(float, WS_ROPES)[i]; }
            if (C.tid < 64) { tb[2048 + C.tid] = INP(IX_QNG)[C.tid]; tb[2048 + 64 + C.tid] = INP(IX_KNG)[C.tid]; }
            __syncthreads(); }
        {
            constexpr int NB16 = (3072 - (IN8_HI - IN8_LO)) / 256;
            pg8::Gemm g{WSP(bf16, WS_XM), WSP(bf16, WS_WIN), T, NB16 * 256, DM, 0}; pg8::WinOrder S; S.so.init(T, NB16 * 256, gridDim.x, (int)blockIdx.x); S.split = IN8_LO / 256; S.add0 = 0; S.add1 = (IN8_HI - IN8_LO) / 256;
            pg8::EpiInProj E{WSP(bf16, WS_QP), WSP(bf16, WS_KA), WSP(bf16, WS_VA), WSP(bf16, WS_HY), WSP(bf16, WS_GT), INP(IX_BIN), C.lds, T, SKV, CTX, WSP(unsigned, WS_CTL) + CW_NMAX};
            pg8::gemm_phase<pg8::EpiInProj, pg8::WinOrder, PG8_ALIGN, true>(C.lds, g, S, E); }
        {
            constexpr int NF8 = (IN8_HI - IN8_LO) / 256;
            pg8::Gemm g{WSP(bf16, WS_XM8), (const bf16*)WSP(unsigned char, WS_WIN8), T, (NF8 + 8) * 256, DM / 2, 0}; pg8::WinOrder S; S.so.init(T, (NF8 + 8) * 256, gridDim.x, (int)blockIdx.x); S.split = NF8; S.add0 = IN8_LO / 256; S.add1 = 12 - NF8;
            pg8::EpiInProjT<true> E{WSP(bf16, WS_QP), WSP(bf16, WS_KA), WSP(bf16, WS_V8T), WSP(bf16, WS_HY), WSP(bf16, WS_GT), INP(IX_BIN), C.lds, T, SKV, CTX, WSP(unsigned, WS_CTL) + CW_NMAX};
            pg8::gemm_phase<pg8::EpiInProjT<true>, pg8::WinOrder, PG8_ALIGN, true>(C.lds, g, S, E); }
    }
    SEAM(PH_INPROJ);
    if (IN(PH_POST)) {
        {
            LAS float* tb = (LAS float*)(C.lds + RING_BYTES + 20480);
            for (int i = C.tid; i < 1024; i += NTHREADS) { tb[i] = WSP(float, WS_ROPEC)[i]; tb[1024 + i] = WSP(float, WS_ROPES)[i]; }
            if (C.tid < 64) { tb[2048 + C.tid] = INP(IX_QNG)[C.tid]; tb[2048 + 64 + C.tid] = INP(IX_KNG)[C.tid]; }
            __syncthreads(); }
        { pg8::Gemm g{WSP(bf16, WS_XM), WSP(bf16, WS_WIN), MROWS, NIN, DM, 0}; pg8::CtxOrder S{(int)gridDim.x, (int)blockIdx.x};
          pg8::EpiInProj E{WSP(bf16, WS_QP), WSP(bf16, WS_KA), WSP(bf16, WS_VA), WSP(bf16, WS_HY), WSP(bf16, WS_GT), INP(IX_BIN), C.lds, T, SKV, CTX, WSP(unsigned, WS_CTL) + CW_NMAX};
          pg8::gemm_phase<pg8::EpiInProj, pg8::CtxOrder, true, true>(C.lds, g, S, E); }
        asm volatile("s_waitcnt vmcnt(0)" ::: "memory"); __syncthreads();
        if (gridDim.x >= 32 && blockIdx.x >= 16 && blockIdx.x < 32) ph_v8t_ctx(C, (int)blockIdx.x & 7, 2 * (((int)blockIdx.x >> 3) - 2));
        __syncthreads(); ph_hyena_pre8(C); }
    SEAM(PH_POST);
    const int cgrp = gridDim.x == 256 ? (((int)blockIdx.x >> 3) % 5) : -1;
#define CONV_SLOT(g_) do { if (cgrp == (g_)) { __syncthreads(); ph_prep_weights(C, PREP_N0, PREP_NIT); __syncthreads(); } } while (0)
    if (IN(PH_ATTN)) { CONV_SLOT(0); if (cgrp >= 0) { ph_attention(C, 0, 2); CONV_SLOT(1); ph_attention(C, 2, 4); CONV_SLOT(2); } else ph_attention(C, 0, 1 << 30); }
    if (IN(PH_HYENA)) { if (cgrp >= 0) { ph_hyena_mfma8(C, 0, 1); CONV_SLOT(3); ph_hyena_mfma8(C, 1, 2); CONV_SLOT(4); } else ph_hyena_mfma8(C, 0, 1 << 30); }
#undef CONV_SLOT
    SEAM(PH_HYENA);
    if (IN(PH_ATTNPOST)) { ph_hyena_post(C); }
    SEAM(PH_ATTNPOST);
    if (IN(PH_MERGEUP)) {
        pg8::Gemm g{WSP(bf16, WS_OAB), WSP(bf16, WS_WA), T, DM, DM, 0}; pg8::StaticOrder S; S.init(T, DM, gridDim.x, (int)blockIdx.x);
        pg8::EpiMerge E{WSP(bf16, WS_MB), WSP(bf16, WS_GT)}; pg8::gemm_phase<pg8::EpiMerge, pg8::StaticOrder, PG8_ALIGN, true>(C.lds, g, S, E);
    }
    SEAM(PH_MERGEUP);
    if (IN(PH_WOUT)) {
        pg8::Gemm g{WSP(bf16, WS_MB), WSP(bf16, WS_WO), T, DM, DM, 0}; pg8::StaticOrder S; S.init(T, DM, gridDim.x, (int)blockIdx.x);
        pg8::EpiWout E{INP(IX_X), C.out, WSP(float, WS_MOD), WSP(float, WS_SSQ)}; pg8::gemm_phase<pg8::EpiWout, pg8::StaticOrder, PG8_ALIGN, true>(C.lds, g, S, E);
    }
    SEAM(PH_WOUT);
    if (IN(PH_ROUTER)) { ph_router3(C); }
    SEAM(PH_ROUTER);
    if (IN(PH_SORT)) { ph_sort2(C); }
    SEAM(PH_SORT);
    if (IN(PH_MOE1)) {
        const int nblk = WSP(int, WS_BLKE)[NBLK];
        pg8::MoeGatherOrder S; S.so.init(nblk * 256, 2048, gridDim.x, (int)blockIdx.x); S.blke = WSP(int, WS_BLKE); S.tokl = (const LAS unsigned short*)(C.lds + LDS_GS);
        {
            LAS unsigned short* tl = (LAS unsigned short*)(C.lds + LDS_GS); const int* ROWTOK = WSP(int, WS_ROWTOK); pg8::Unit uu;
            LAS int* pml = (LAS int*)(C.lds + LDS_GS + 10240);
            if (C.tid == 0) { for (int ui = 0; ui < 20; ++ui) pml[ui] = S.so.next(ui, uu) ? uu.pm : -1; }
            __syncthreads();
#define TL_LD(u) const int pm##u = pml[u]; int tv##u = 0; if (pm##u >= 0 && C.tid < 256) tv##u = ROWTOK[pm##u * 256 + C.tid];
#define TL_ST(u) if (C.tid < 256) tl[(u) * 256 + C.tid] = (unsigned short)tv##u;
            TL_LD(0) TL_LD(1) TL_LD(2) TL_LD(3) TL_LD(4) TL_LD(5) TL_LD(6) TL_LD(7) TL_LD(8) TL_LD(9) TL_LD(10) TL_LD(11) TL_LD(12) TL_LD(13) TL_LD(14) TL_LD(15) TL_LD(16) TL_LD(17) TL_LD(18) TL_LD(19)
            TL_ST(0) TL_ST(1) TL_ST(2) TL_ST(3) TL_ST(4) TL_ST(5) TL_ST(6) TL_ST(7) TL_ST(8) TL_ST(9) TL_ST(10) TL_ST(11) TL_ST(12) TL_ST(13) TL_ST(14) TL_ST(15) TL_ST(16) TL_ST(17) TL_ST(18) TL_ST(19)
#undef TL_LD
#undef TL_ST
        }
        __syncthreads();
        pg8::Gemm g{WSP(bf16, WS_H), WSP(bf16, WS_W1), nblk * 256, 2048, DM / 2, (size_t)2048 * 1024};
        pg8::EpiSwiglu E{WSP(unsigned char, WS_ACT), INP(IX_EB1), C.lds}; pg8::gemm_phase<pg8::EpiSwiglu, pg8::MoeGatherOrder, PG8_ALIGN, true>(C.lds, g, S, E);
    }
    SEAM(PH_MOE1);
    if (IN(PH_MOE2)) {
        const int nblk = WSP(int, WS_BLKE)[NBLK];
        pg8::Gemm g{WSP(bf16, WS_ACT), WSP(bf16, WS_W2), nblk * 256, DM, DM / 2, (size_t)1024 * 1024}; pg8::MoeOrder S; S.so.init(nblk * 256, DM, gridDim.x, (int)blockIdx.x); S.blke = WSP(int, WS_BLKE);
        pg8::EpiY E{WSP(unsigned char, WS_Y), INP(IX_EB2), WSP(float, WS_ROWW), C.lds}; pg8::gemm_phase<pg8::EpiY, pg8::MoeOrder, PG8_ALIGN, true>(C.lds, g, S, E);
    }
    SEAM(PH_MOE2);
    if (IN(PH_COMBINE)) { ph_combine(C); }
#undef IN
#undef SEAM
}

extern "C" void kernel_launch(void* const* d_in, const int* in_sizes, int n_in, void* d_out, int out_size, void* d_ws, size_t ws_size, hipStream_t stream) {
    static int grid = 0;
    if (grid == 0) {
        if (n_in != N_INPUTS || in_sizes[0] != T * DM || out_size != T * DM || ws_size < WS_END) { fprintf(stderr, "kernel_launch: unexpected shapes n_in %d in0 %d out %d ws %zu (need %zu)\n", n_in, n_in > 0 ? in_sizes[0] : -1, out_size, ws_size, (size_t)WS_END); grid = -1; return; }
        int dev = 0, cus = 0;
        if (hipGetDevice(&dev) != hipSuccess || hipDeviceGetAttribute(&cus, hipDeviceAttributeMultiprocessorCount, dev) != hipSuccess) { grid = -1; return; }
        if (hipFuncSetAttribute((const void*)fwd, hipFuncAttributeMaxDynamicSharedMemorySize, LDS_BYTES) != hipSuccess) { fprintf(stderr, "kernel_launch: hipFuncSetAttribute failed\n"); grid = -1; return; }
        int per_cu = 0;
        if (hipOccupancyMaxActiveBlocksPerMultiprocessor(&per_cu, (const void*)fwd, NTHREADS, LDS_BYTES) != hipSuccess || per_cu < 1) { fprintf(stderr, "kernel_launch: occupancy query says %d blocks per CU\n", per_cu); grid = -1; return; }
        grid = cus;
    }
    if (grid < 0) return;
    (void)hipMemsetAsync((char*)d_ws + WS_CTL, 0, CTL_BYTES, stream);
    Args a{};
    for (int i = 0; i < N_INPUTS; ++i) a.in[i] = (const float*)d_in[i];
    a.out = (float*)d_out; a.ws = (unsigned char*)d_ws;
#ifndef PROBE_DUP
#define PROBE_DUP -1
#endif
    int cuts[5] = {0, N_PHASES, N_PHASES, N_PHASES, N_PHASES}, nl = 1;
    if (PROBE_DUP >= 0) { cuts[1] = PROBE_DUP + 1; cuts[2] = PROBE_DUP; cuts[3] = PROBE_DUP + 1; nl = 4; }
    for (int li = 0; li < (PROBE_DUP >= 0 ? 3 : 1); ++li) {
        if (PROBE_DUP >= 0) { a.ph_lo = li == 0 ? 0 : (li == 1 ? PROBE_DUP : PROBE_DUP + 1); a.ph_hi = li == 2 ? N_PHASES : PROBE_DUP + 1; } else { a.ph_lo = 0; a.ph_hi = N_PHASES; }
        a.li = li; (void)cuts; (void)nl;
        if (a.ph_lo >= a.ph_hi) continue;
        void* kargs[] = {&a};
        const hipError_t le = hipLaunchCooperativeKernel((const void*)fwd, dim3(grid), dim3(NTHREADS), kargs, LDS_BYTES, stream);
        if (le != hipSuccess) fprintf(stderr, "kernel_launch: cooperative launch failed: %s (grid %d)\n", hipGetErrorString(le), grid);
    }
}
```
